# Optimizing an MI355X kernel written in HIP

```python
import math
import jax, jax.numpy as jnp
from jax import lax
import numpy as np

D_MODEL = 1024
BATCH = 8
SEQ = 2048
DEPTH = 1

CTX_LEN = 256
GRID_W = 64
EPS = 1e-6
SHORT_CONV = 3

D_HYENA = D_MODEL // 2
HYENA_ORDER = 2
HYENA_BANDS = 8
HYENA_EMB = 1 + 2 * HYENA_BANDS
HYENA_FILTER_HID = 64
HYENA_FAST_DECAY = 0.3
HYENA_SLOW_DECAY = 1.5
HYENA_TARGET = 1e-2

D_SSD = D_MODEL // 2
SSD_HEAD_DIM = 64
SSD_HEADS = D_SSD // SSD_HEAD_DIM
SSD_GROUPS = 2
SSD_HPG = SSD_HEADS // SSD_GROUPS
SSD_STATE = 128
SSD_CHUNK = 128

D_MIX = D_HYENA + D_SSD
D_XBC = D_SSD + 2 * SSD_GROUPS * SSD_STATE
HY_COLS = (HYENA_ORDER + 1) * D_HYENA
D_IN = HY_COLS + D_SSD + D_XBC + 2 * SSD_HEADS

MOE_GROUPS = 8
EXPERTS_PER_GROUP = 8
N_EXPERTS = MOE_GROUPS * EXPERTS_PER_GROUP
TOP_K = 2
D_EXPERT = 512
MOE_BLOCK = 128

kernel_name = 'hymba_hyena_ssd_hmoe_dit_block'


def rmsnorm(x, g):
    xf = x.astype(jnp.float32)
    y = xf * lax.rsqrt(jnp.mean(xf * xf, axis=-1, keepdims=True) + EPS)
    return y.astype(x.dtype) * g


def modulate(h, shift, scale):
    return h * (1 + scale) + shift


def short_conv_rows(u, w, b, n_rows):
    bsz, L, C = u.shape
    row_len = L // n_rows
    pad = SHORT_CONV // 2
    ur = jnp.pad(u.reshape(bsz, n_rows, row_len, C), ((0, 0), (0, 0), (pad, pad), (0, 0)))
    y = b + sum(ur[:, :, k:k + row_len] * w[k] for k in range(SHORT_CONV))
    return y.reshape(bsz, L, C)


def hyena_filters(L, f_w1, f_b1, f_freq, f_w2, f_b2, f_w3):
    f32 = jnp.float32
    pos = jnp.arange(L, dtype=f32)
    t = pos / max(L - 1, 1)
    bands = jnp.linspace(1e-4, HYENA_BANDS - 1, HYENA_BANDS, dtype=f32)
    ang = (2 * math.pi / L) * pos[:, None] * bands[None, :]
    feats = jnp.concatenate([t[:, None], jnp.cos(ang), -jnp.sin(ang)], axis=-1)
    freq = f_freq.astype(f32)
    h = jnp.sin(freq * (feats @ f_w1.astype(f32) + f_b1.astype(f32)))
    h = jnp.sin(freq * (h @ f_w2.astype(f32) + f_b2.astype(f32)))
    k = (h @ f_w3.astype(f32)).reshape(L, HYENA_ORDER, 2, D_HYENA)
    deltas = jnp.abs(jnp.linspace(math.log(HYENA_TARGET) / HYENA_SLOW_DECAY,
                                  math.log(HYENA_TARGET) / HYENA_FAST_DECAY, D_HYENA, dtype=f32))
    window = jnp.exp(-t[:, None] * deltas[None, :])
    return k * window[:, None, None, :]


def long_conv_bidir(z, k_f, k_b, bias):
    L = z.shape[1]
    k_full = jnp.concatenate([k_f, jnp.zeros_like(k_f[:1]), jnp.flip(k_b[1:], axis=0)], axis=0)
    zf = jnp.fft.rfft(z, n=2 * L, axis=1)
    kf = jnp.fft.rfft(k_full, axis=0)
    y = jnp.fft.irfft(zf * kf[None], n=2 * L, axis=1)[:, :L]
    return y + z * bias


def hyena_branch(p, conv_w, conv_b, f_w1, f_b1, f_freq, f_w2, f_b2, f_w3, h_bias, n_rows):
    L = p.shape[1]
    u = short_conv_rows(p, conv_w, conv_b, n_rows).astype(jnp.float32)
    parts = jnp.split(u, HYENA_ORDER + 1, axis=-1)
    k = hyena_filters(L, f_w1, f_b1, f_freq, f_w2, f_b2, f_w3)
    hb = h_bias.astype(jnp.float32)
    z = parts[0]
    for o in range(HYENA_ORDER):
        z = parts[o + 1] * long_conv_bidir(z, k[:, o, 0], k[:, o, 1], hb[o])
    return z.astype(p.dtype)


def ssd_prep(p, conv_w, conv_b, a_log, dt_bias, n_rows):
    bsz, L, _ = p.shape
    G, R, P, N = SSD_GROUPS, SSD_HPG, SSD_HEAD_DIM, SSD_STATE
    z = p[..., :D_SSD]
    xbc = jax.nn.silu(short_conv_rows(p[..., D_SSD:D_SSD + D_XBC], conv_w, conv_b, n_rows))
    xs = xbc[..., :D_SSD].reshape(bsz, L, G, R, P)
    bm = xbc[..., D_SSD:D_SSD + G * N].reshape(bsz, L, G, N)
    cm = xbc[..., D_SSD + G * N:].reshape(bsz, L, G, N)
    dt_raw = p[..., D_SSD + D_XBC:].astype(jnp.float32).reshape(bsz, L, 2, G, R)
    dt = jax.nn.softplus(dt_raw + dt_bias.astype(jnp.float32).reshape(2, G, R))
    a = -jnp.exp(a_log.astype(jnp.float32)).reshape(2, G, R) * dt
    return z, xs, bm, cm, dt, a


def ssd_scan(xs, a, bm, cm, h0):
    bsz, L, G, R, P = xs.shape
    N = bm.shape[-1]
    nc = L // SSD_CHUNK
    xs = xs.reshape(bsz, nc, SSD_CHUNK, G, R, P)
    a = a.reshape(bsz, nc, SSD_CHUNK, G, R)
    bm = bm.reshape(bsz, nc, SSD_CHUNK, G, N)
    cm = cm.reshape(bsz, nc, SSD_CHUNK, G, N)
    a_cum = jnp.cumsum(a, axis=2)
    lower = jnp.tril(jnp.ones((SSD_CHUNK, SSD_CHUNK), bool))[:, :, None, None]
    seg = a_cum[:, :, :, None] - a_cum[:, :, None, :]
    decay = jnp.exp(jnp.where(lower, seg, -jnp.inf))
    cb = jnp.einsum('bclgn,bcsgn->bclsg', cm, bm)
    y_diag = jnp.einsum('bclsg,bclsgr,bcsgrp->bclgrp', cb, decay, xs)
    to_end = jnp.exp(a_cum[:, :, -1:] - a_cum)
    chunk_states = jnp.einsum('bclgn,bclgr,bclgrp->bcgrpn', bm, to_end, xs)
    chunk_decay = jnp.exp(a_cum[:, :, -1])

    def step(h, inp):
        s_c, d_c = inp
        return h * d_c[..., None, None] + s_c, h

    h_final, h_in = lax.scan(step, h0, (jnp.moveaxis(chunk_states, 1, 0), jnp.moveaxis(chunk_decay, 1, 0)))
    h_in = jnp.moveaxis(h_in, 0, 1)
    y_off = jnp.einsum('bclgn,bcgrpn,bclgr->bclgrp', cm, h_in, jnp.exp(a_cum))
    return (y_diag + y_off).reshape(bsz, L, G, R, P), h_final


def ssd_final_state(xs, a, bm):
    a_cum = jnp.cumsum(a, axis=1)
    w = jnp.exp(a_cum[:, -1:] - a_cum)
    return jnp.einsum('blgn,blgr,blgrp->bgrpn', bm, w, xs)


def _rev(t):
    return jnp.flip(t, axis=1)


def ssd_context_states(prep):
    _, xs, bm, _, dt, a = prep
    xf = xs.astype(jnp.float32)
    bf = bm.astype(jnp.float32)
    h_f = ssd_final_state(xf * dt[:, :, 0, :, :, None], a[:, :, 0], bf)
    h_b = ssd_final_state(_rev(xf * dt[:, :, 1, :, :, None]), _rev(a[:, :, 1]), _rev(bf))
    return h_f, h_b


def ssd_branch(prep, d_skip, norm_g, h0_f, h0_b):
    z, xs, bm, cm, dt, a = prep
    bsz, L = z.shape[:2]
    xf = xs.astype(jnp.float32)
    bf = bm.astype(jnp.float32)
    cf = cm.astype(jnp.float32)
    y_f, h_f = ssd_scan(xf * dt[:, :, 0, :, :, None], a[:, :, 0], bf, cf, h0_f)
    y_b, h_b = ssd_scan(_rev(xf * dt[:, :, 1, :, :, None]), _rev(a[:, :, 1]), _rev(bf), _rev(cf), h0_b)
    y = y_f + _rev(y_b) + d_skip.astype(jnp.float32).reshape(SSD_GROUPS, SSD_HPG)[..., None] * xf
    y = y.reshape(bsz, L, D_SSD) * jax.nn.silu(z.astype(jnp.float32))
    y = y.reshape(bsz, L, SSD_GROUPS, D_SSD // SSD_GROUPS)
    y = y * lax.rsqrt(jnp.mean(y * y, axis=-1, keepdims=True) + EPS)
    y = y.reshape(bsz, L, D_SSD) * norm_g
    return y.astype(z.dtype), h_f, h_b


def moe_ffn(h, w_group, b_group, w_expert, b_expert, w1, w3, w2):
    T, D = h.shape
    group_prob = jax.nn.softmax((h @ w_group + b_group).astype(jnp.float32), axis=-1)
    p_group, g_sel = lax.top_k(group_prob, 1)
    exp_logits = (h @ w_expert + b_expert).astype(jnp.float32).reshape(T, MOE_GROUPS, EXPERTS_PER_GROUP)
    in_group = exp_logits[jnp.arange(T), g_sel[:, 0]]
    top_logit, top_idx = lax.top_k(in_group, TOP_K)
    gate = jax.nn.softmax(top_logit, axis=-1) * p_group
    expert_id = g_sel * EXPERTS_PER_GROUP + top_idx
    M = T * TOP_K
    eid = expert_id.reshape(M)
    tok = jnp.repeat(jnp.arange(T), TOP_K)
    order = jnp.argsort(eid)
    eid_s, tok_s, gate_s = eid[order], tok[order], gate.reshape(M)[order]
    counts = jnp.bincount(eid, length=N_EXPERTS)
    padded = (counts + MOE_BLOCK - 1) // MOE_BLOCK * MOE_BLOCK
    ends = jnp.cumsum(padded)
    dest = (ends - padded)[eid_s] + jnp.arange(M) - (jnp.cumsum(counts) - counts)[eid_s]
    n_blocks = -(-M // MOE_BLOCK) + N_EXPERTS
    buf = jnp.zeros((n_blocks * MOE_BLOCK, D), h.dtype).at[dest].set(h[tok_s])
    block_eid = jnp.minimum(jnp.searchsorted(ends, jnp.arange(n_blocks) * MOE_BLOCK, side='right'), N_EXPERTS - 1)

    def expert_block(args):
        xb, e = args
        return (jax.nn.silu(xb @ w1[e]) * (xb @ w3[e])) @ w2[e]

    yb = lax.map(expert_block, (buf.reshape(n_blocks, MOE_BLOCK, D), block_eid))
    contrib = yb.reshape(-1, D)[dest] * gate_s[:, None].astype(h.dtype)
    return jnp.zeros_like(h).at[tok_s].add(contrib)


def setup_inputs(seed: int = 0) -> dict:
    key = jax.random.key(seed)
    ks = jax.random.split(key, 40)

    def nrm(i, shape, s):
        return jax.random.normal(ks[i], shape, jnp.float32) * s

    NL = DEPTH
    FH = HYENA_FILTER_HID
    dt0 = jnp.exp(jax.random.uniform(ks[30], (NL, 2, SSD_HEADS)) * (math.log(0.1) - math.log(1e-3)) + math.log(1e-3))
    return {
        'x': nrm(0, (BATCH, SEQ, D_MODEL), 1.0),
        'c': nrm(1, (BATCH, D_MODEL), 1.0),
        'ctx': nrm(2, (BATCH, CTX_LEN, D_MODEL), 1.0),
        'c_ctx': nrm(3, (D_MODEL,), 1.0),
        'w_ada': nrm(4, (NL, D_MODEL, 6 * D_MODEL), D_MODEL ** -0.5),
        'b_ada': nrm(5, (NL, 6 * D_MODEL), 0.02),
        'g_norm1': 1.0 + nrm(6, (NL, D_MODEL), 0.05),
        'g_norm2': 1.0 + nrm(7, (NL, D_MODEL), 0.05),
        'w_in': nrm(8, (NL, D_MODEL, D_IN), D_MODEL ** -0.5),
        'hy_conv_w': nrm(9, (NL, SHORT_CONV, HY_COLS), SHORT_CONV ** -0.5),
        'hy_conv_b': nrm(10, (NL, HY_COLS), 0.02),
        'hy_f_w1': nrm(11, (NL, HYENA_EMB, FH), HYENA_EMB ** -0.5),
        'hy_f_b1': nrm(12, (NL, FH), 0.02),
        'hy_f_freq': 1.0 + nrm(13, (NL, FH), 0.05),
        'hy_f_w2': nrm(14, (NL, FH, FH), FH ** -0.5),
        'hy_f_b2': nrm(15, (NL, FH), 0.02),
        'hy_f_w3': nrm(16, (NL, FH, HYENA_ORDER * 2 * D_HYENA), 0.05 * FH ** -0.5),
        'hy_bias': nrm(17, (NL, HYENA_ORDER, D_HYENA), 0.5),
        'ssd_conv_w': nrm(18, (NL, SHORT_CONV, D_XBC), SHORT_CONV ** -0.5),
        'ssd_conv_b': nrm(19, (NL, D_XBC), 0.02),
        'ssd_a_log': jnp.log(jax.random.uniform(ks[31], (NL, 2, SSD_HEADS), minval=1.0, maxval=16.0)),
        'ssd_dt_bias': dt0 + jnp.log(-jnp.expm1(-dt0)),
        'ssd_d': 1.0 + nrm(20, (NL, SSD_HEADS), 0.1),
        'ssd_norm_g': 1.0 + nrm(21, (NL, D_SSD), 0.05),
        'w_out': nrm(22, (NL, D_MIX, D_MODEL), D_MIX ** -0.5),
        'w_group': nrm(23, (NL, D_MODEL, MOE_GROUPS), D_MODEL ** -0.5),
        'b_group': nrm(24, (NL, MOE_GROUPS), 0.01),
        'w_expert': nrm(25, (NL, D_MODEL, N_EXPERTS), D_MODEL ** -0.5),
        'b_expert': nrm(26, (NL, N_EXPERTS), 0.01),
        'w1': nrm(27, (NL, N_EXPERTS, D_MODEL, D_EXPERT), D_MODEL ** -0.5),
        'w3': nrm(28, (NL, N_EXPERTS, D_MODEL, D_EXPERT), D_MODEL ** -0.5),
        'w2': nrm(29, (NL, N_EXPERTS, D_EXPERT, D_MODEL), D_EXPERT ** -0.5),
        'g_final': 1.0 + nrm(32, (D_MODEL,), 0.05),
    }


def reference(x, c, ctx, c_ctx, w_ada, b_ada, g_norm1, g_norm2, w_in, hy_conv_w, hy_conv_b,
              hy_f_w1, hy_f_b1, hy_f_freq, hy_f_w2, hy_f_b2, hy_f_w3, hy_bias,
              ssd_conv_w, ssd_conv_b, ssd_a_log, ssd_dt_bias, ssd_d, ssd_norm_g, w_out,
              w_group, b_group, w_expert, b_expert, w1, w3, w2, g_final):
    bsz, seq_len, _ = x.shape
    rows = seq_len // GRID_W
    for l in range(DEPTH):
        last = l == DEPTH - 1
        hy_p = (hy_conv_w[l], hy_conv_b[l], hy_f_w1[l], hy_f_b1[l], hy_f_freq[l],
                hy_f_w2[l], hy_f_b2[l], hy_f_w3[l], hy_bias[l])
        ssd_p = (ssd_conv_w[l], ssd_conv_b[l], ssd_a_log[l], ssd_dt_bias[l])
        moe_p = (w_group[l], b_group[l], w_expert[l], b_expert[l], w1[l], w3[l], w2[l])
        sh1, sc1, ga1, sh2, sc2, ga2 = jnp.split((jax.nn.silu(c) @ w_ada[l] + b_ada[l])[:, None, :], 6, axis=-1)
        csh1, csc1, cga1, csh2, csc2, cga2 = jnp.split(jax.nn.silu(c_ctx) @ w_ada[l] + b_ada[l], 6, axis=-1)

        pc = modulate(rmsnorm(ctx, g_norm1[l]), csh1, csc1) @ w_in[l]
        prep_c = ssd_prep(pc[..., HY_COLS:], *ssd_p, 1)
        if last:
            h_f, h_b = ssd_context_states(prep_c)
        else:
            h_zero = jnp.zeros((bsz, SSD_GROUPS, SSD_HPG, SSD_HEAD_DIM, SSD_STATE), jnp.float32)
            yc_ssd, h_f, h_b = ssd_branch(prep_c, ssd_d[l], ssd_norm_g[l], h_zero, h_zero)
            yc_hy = hyena_branch(pc[..., :HY_COLS], *hy_p, 1)
            ctx = ctx + cga1 * (jnp.concatenate([yc_hy, yc_ssd], axis=-1) @ w_out[l])
            hcn = modulate(rmsnorm(ctx, g_norm2[l]), csh2, csc2)
            ctx = ctx + cga2 * moe_ffn(hcn.reshape(-1, D_MODEL), *moe_p).reshape(ctx.shape)

        px = modulate(rmsnorm(x, g_norm1[l]), sh1, sc1) @ w_in[l]
        y_hy = hyena_branch(px[..., :HY_COLS], *hy_p, rows)
        prep_x = ssd_prep(px[..., HY_COLS:], *ssd_p, rows)
        y_ssd, _, _ = ssd_branch(prep_x, ssd_d[l], ssd_norm_g[l], h_f, h_b)
        x = x + ga1 * (jnp.concatenate([y_hy, y_ssd], axis=-1) @ w_out[l])

        hxn = modulate(rmsnorm(x, g_norm2[l]), sh2, sc2)
        x = x + ga2 * moe_ffn(hxn.reshape(-1, D_MODEL), *moe_p).reshape(x.shape)
    return rmsnorm(x, g_final)
```

```cpp
#include <hip/hip_runtime.h>
#include <hip/hip_cooperative_groups.h>
#include <cstdio>
#include <cstdint>
namespace cg = cooperative_groups;

constexpr int D = 1024, NB = 8, L = 2048, LC = 256;
constexpr int T = NB * L;
constexpr int TC = NB * LC;
constexpr int TT = T + TC;
constexpr int DH = 512, HYC = 1536, DS = 512, DXBC = 1024, DIN = 3088;
constexpr int COL_Z = 1536, COL_XBC = 2048, COL_DT = 3072;
constexpr int NE = 64, DE = 512;
constexpr float EPS = 1e-6f;

struct Params {
  const float *x, *c, *ctx, *c_ctx, *w_ada, *b_ada, *g1, *g2, *w_in, *hy_conv_w, *hy_conv_b;
  const float *f_w1, *f_b1, *f_freq, *f_w2, *f_b2, *f_w3, *hy_bias;
  const float *ssd_conv_w, *ssd_conv_b, *a_log, *dt_bias, *ssd_d, *ssd_norm_g, *w_out;
  const float *w_group, *b_group, *w_expert, *b_expert, *w1, *w3, *w2, *g_final;
  float* out;
  float *MOD, *FILT, *XN, *PX, *Z1, *YF, *YB, *YMIX, *XBC, *DT, *X1, *H2, *HB, *YB2, *GATE;
  int *CNT, *LIST;
  int lo, hi;
};

__device__ __forceinline__ float silu_f(float v) { return v / (1.f + __expf(-v)); }
__device__ __forceinline__ float softplus_f(float v) { return v > 20.f ? v : log1pf(expf(v)); }

__device__ __forceinline__ float block_sum(float v, float* red) {
#pragma unroll
  for (int o = 32; o > 0; o >>= 1) v += __shfl_xor(v, o);
  __syncthreads();
  if ((threadIdx.x & 63) == 0) red[threadIdx.x >> 6] = v;
  __syncthreads();
  float r = red[0] + red[1] + red[2] + red[3];
  return r;
}

__device__ void ph_adaln(const Params& p) {
  const int tid = threadIdx.x;
  if (blockIdx.x == 0 && tid < NE) p.CNT[tid] = 0;
  for (int idx = blockIdx.x * 256 + tid; idx < 9 * 6144; idx += gridDim.x * 256) {
    int r = idx / 6144, j = idx - r * 6144;
    const float* cv = (r < 8) ? (p.c + r * D) : p.c_ctx;
    float acc = 0.f;
    for (int k = 0; k < D; ++k) acc += silu_f(cv[k]) * p.w_ada[(size_t)k * 6144 + j];
    p.MOD[idx] = acc + p.b_ada[j];
  }
}

__device__ void ph_filters(const Params& p, float* sm) {
  const int tid = threadIdx.x;
  float* feats = sm;
  float* h1 = sm + 32;
  float* h2 = sm + 96;
  for (int t = blockIdx.x; t < L; t += gridDim.x) {
    const float tn = (float)t / (float)(L - 1);
    if (tid < 17) {
      float f;
      if (tid == 0) f = tn;
      else {
        int i = (tid - 1) & 7;
        double band = 1e-4 + (double)i * ((7.0 - 1e-4) / 7.0);
        float bandf = (float)band;
        float ang = (float)(2.0 * 3.14159265358979323846 / (double)L) * (float)t * bandf;
        f = (tid <= 8) ? cosf(ang) : -sinf(ang);
      }
      feats[tid] = f;
    }
    __syncthreads();
    if (tid < 64) {
      float a = p.f_b1[tid];
      for (int i = 0; i < 17; ++i) a += feats[i] * p.f_w1[i * 64 + tid];
      h1[tid] = sinf(p.f_freq[tid] * a);
    }
    __syncthreads();
    if (tid < 64) {
      float a = p.f_b2[tid];
      for (int i = 0; i < 64; ++i) a += h1[i] * p.f_w2[i * 64 + tid];
      h2[tid] = sinf(p.f_freq[tid] * a);
    }
    __syncthreads();
    for (int col = tid; col < 2048; col += 256) {
      float a = 0.f;
      for (int i = 0; i < 64; ++i) a += h2[i] * p.f_w3[i * 2048 + col];
      int cch = col & 511;
      const float d0 = -4.605170185988091f / 1.5f, d1 = -4.605170185988091f / 0.3f;
      float delta = fabsf(d0 + (float)cch * ((d1 - d0) / 511.f));
      p.FILT[(size_t)t * 2048 + col] = a * expf(-tn * delta);
    }
    __syncthreads();
  }
}

__device__ void ph_norm1(const Params& p, float* sm) {
  const int tid = threadIdx.x;
  for (int row = blockIdx.x; row < TT; row += gridDim.x) {
    const float* src = (row < T) ? (p.x + (size_t)row * D) : (p.ctx + (size_t)(row - T) * D);
    const int mr = (row < T) ? (row / L) : 8;
    const float* sh = p.MOD + mr * 6144;
    const float* sc = sh + 1024;
    float4 v = *(const float4*)(src + tid * 4);
    float ss = v.x * v.x + v.y * v.y + v.z * v.z + v.w * v.w;
    ss = block_sum(ss, sm);
    float rstd = rsqrtf(ss * (1.f / D) + EPS);
    float4 g = *(const float4*)(p.g1 + tid * 4);
    float4 s4 = *(const float4*)(sc + tid * 4);
    float4 h4 = *(const float4*)(sh + tid * 4);
    float4 o;
    o.x = v.x * rstd * g.x * (1.f + s4.x) + h4.x;
    o.y = v.y * rstd * g.y * (1.f + s4.y) + h4.y;
    o.z = v.z * rstd * g.z * (1.f + s4.z) + h4.z;
    o.w = v.w * rstd * g.w * (1.f + s4.w) + h4.w;
    *(float4*)(p.XN + (size_t)row * D + tid * 4) = o;
  }
}

__device__ __forceinline__ void gemm64(float (&acc)[4][4], const float* arow, const float* B, int ldb,
                                       int K, int n0, int N, float* sm) {
  const int tid = threadIdx.x;
  float* As = sm;
  float* Bs = sm + 16 * 68;
  const int am = tid >> 2, akq = (tid & 3) * 4;
  const int bk = tid >> 4, bnq = (tid & 15) * 4;
  const int ty = tid >> 4, tx = tid & 15;
  const bool bok = (n0 + bnq) < N;
  for (int k0 = 0; k0 < K; k0 += 16) {
    float4 av = make_float4(0.f, 0.f, 0.f, 0.f);
    if (arow) av = *(const float4*)(arow + k0 + akq);
    float4 bv = make_float4(0.f, 0.f, 0.f, 0.f);
    if (bok) bv = *(const float4*)(B + (size_t)(k0 + bk) * ldb + n0 + bnq);
    As[(akq + 0) * 68 + am] = av.x;
    As[(akq + 1) * 68 + am] = av.y;
    As[(akq + 2) * 68 + am] = av.z;
    As[(akq + 3) * 68 + am] = av.w;
    *(float4*)&Bs[bk * 64 + bnq] = bv;
    __syncthreads();
#pragma unroll
    for (int kk = 0; kk < 16; ++kk) {
      float4 a = *(const float4*)&As[kk * 68 + ty * 4];
      float4 b = *(const float4*)&Bs[kk * 64 + tx * 4];
      float aa[4] = {a.x, a.y, a.z, a.w};
      float bb[4] = {b.x, b.y, b.z, b.w};
#pragma unroll
      for (int i = 0; i < 4; ++i)
#pragma unroll
        for (int j = 0; j < 4; ++j) acc[i][j] += aa[i] * bb[j];
    }
    __syncthreads();
  }
}

__device__ void ph_inproj(const Params& p, float* sm) {
  const int tid = threadIdx.x;
  constexpr int NT = 49, MT = TT / 64;
  for (int item = blockIdx.x; item < MT * NT; item += gridDim.x) {
    int mt = item / NT, nt = item - mt * NT;
    int m0 = mt * 64, n0 = nt * 64;
    float acc[4][4] = {};
    const float* arow = p.XN + (size_t)(m0 + (tid >> 2)) * D;
    gemm64(acc, arow, p.w_in, DIN, D, n0, DIN, sm);
    const int ty = tid >> 4, tx = tid & 15;
    if (n0 + tx * 4 < DIN) {
#pragma unroll
      for (int i = 0; i < 4; ++i) {
        float4 o = make_float4(acc[i][0], acc[i][1], acc[i][2], acc[i][3]);
        *(float4*)(p.PX + (size_t)(m0 + ty * 4 + i) * DIN + n0 + tx * 4) = o;
      }
    }
  }
}

__device__ __forceinline__ float hy_u(const Params& p, int row, int col) {
  const int i = row & 63;
  const float* px = p.PX + (size_t)row * DIN + col;
  float v = p.hy_conv_b[col] + p.hy_conv_w[HYC + col] * px[0];
  if (i > 0) v += p.hy_conv_w[col] * px[-DIN];
  if (i < 63) v += p.hy_conv_w[2 * HYC + col] * px[DIN];
  return v;
}

__device__ void hyena_item(const Params& p, int item, int o, float* sm) {
  const int tid = threadIdx.x;
  const int tt = item & 63, ct = (item >> 6) & 7, b = item >> 9;
  const int t0 = tt * 32, c0 = ct * 64;
  const int c = tid & 63, tg = tid >> 6;
  float* zs = sm;
  float* fs = sm + 4096;
  float acc[8];
#pragma unroll
  for (int i = 0; i < 8; ++i) acc[i] = 0.f;
  for (int s0 = 0; s0 < L; s0 += 64) {
    for (int e = tid; e < 4096; e += 256) {
      int sj = e >> 6, cc = e & 63;
      int row = b * L + s0 + sj;
      zs[e] = (o == 0) ? hy_u(p, row, c0 + cc) : p.Z1[(size_t)row * DH + c0 + cc];
    }
    for (int e = tid; e < 95 * 64; e += 256) {
      int di = e >> 6, cc = e & 63;
      int d = t0 - s0 - 63 + di;
      float f;
      if (d >= 0) f = p.FILT[(size_t)d * 2048 + o * 1024 + c0 + cc];
      else f = p.FILT[(size_t)(-d) * 2048 + o * 1024 + 512 + c0 + cc];
      fs[e] = f;
    }
    __syncthreads();
#pragma unroll 4
    for (int sj = 0; sj < 64; ++sj) {
      float zv = zs[sj * 64 + c];
      const float* fp = fs + (tg * 8 - sj + 63) * 64 + c;
#pragma unroll
      for (int i = 0; i < 8; ++i) acc[i] += fp[i * 64] * zv;
    }
    __syncthreads();
  }
#pragma unroll
  for (int i = 0; i < 8; ++i) {
    int t = t0 + tg * 8 + i;
    int row = b * L + t;
    float zt = (o == 0) ? hy_u(p, row, c0 + c) : p.Z1[(size_t)row * DH + c0 + c];
    float conv = acc[i] + zt * p.hy_bias[o * 512 + c0 + c];
    float gate = hy_u(p, row, (o + 1) * 512 + c0 + c);
    float outv = gate * conv;
    if (o == 0) p.Z1[(size_t)row * DH + c0 + c] = outv;
    else p.YMIX[(size_t)row * D + c0 + c] = outv;
  }
}

__device__ void ph_ssd_prep(const Params& p) {
  const int tid = threadIdx.x;
  for (int row = blockIdx.x; row < TT; row += gridDim.x) {
    bool has_prev, has_next;
    if (row < T) { int i = row & 63; has_prev = i > 0; has_next = i < 63; }
    else { int i = (row - T) & (LC - 1); has_prev = i > 0; has_next = i < LC - 1; }
    const float* px = p.PX + (size_t)row * DIN;
    for (int ch = tid; ch < DXBC; ch += 256) {
      float v = p.ssd_conv_b[ch] + p.ssd_conv_w[DXBC + ch] * px[COL_XBC + ch];
      if (has_prev) v += p.ssd_conv_w[ch] * px[COL_XBC + ch - DIN];
      if (has_next) v += p.ssd_conv_w[2 * DXBC + ch] * px[COL_XBC + ch + DIN];
      p.XBC[(size_t)row * DXBC + ch] = silu_f(v);
    }
    if (tid < 16) p.DT[(size_t)row * 16 + tid] = softplus_f(px[COL_DT + tid] + p.dt_bias[tid]);
  }
}

__device__ void ssd_scan_item(const Params& p, int item) {
  const int tid = threadIdx.x;
  const int dir = item & 1, h = (item >> 1) & 7, b = item >> 4;
  const int g = h >> 2;
  const int pch = tid >> 2, q = tid & 3;
  const float A = expf(p.a_log[dir * 8 + h]);
  float* Y = dir ? p.YB : p.YF;
  float st[32];
#pragma unroll
  for (int j = 0; j < 32; ++j) st[j] = 0.f;
  const int nsteps = LC + L;
  for (int s = 0; s < nsteps; ++s) {
    int row; bool latent;
    if (s < LC) { int t = dir ? (LC - 1 - s) : s; row = T + b * LC + t; latent = false; }
    else { int t = dir ? (L - 1 - (s - LC)) : (s - LC); row = b * L + t; latent = true; }
    const float* xb = p.XBC + (size_t)row * DXBC;
    float dtv = p.DT[(size_t)row * 16 + dir * 8 + h];
    float dec = expf(-A * dtv);
    float xv = xb[h * 64 + pch] * dtv;
    const float* Bp = xb + 512 + g * 128 + q * 32;
    const float* Cp = xb + 768 + g * 128 + q * 32;
    float y = 0.f;
#pragma unroll
    for (int j4 = 0; j4 < 8; ++j4) {
      float4 bv = *(const float4*)(Bp + j4 * 4);
      float4 cv = *(const float4*)(Cp + j4 * 4);
      st[j4 * 4 + 0] = dec * st[j4 * 4 + 0] + bv.x * xv; y += cv.x * st[j4 * 4 + 0];
      st[j4 * 4 + 1] = dec * st[j4 * 4 + 1] + bv.y * xv; y += cv.y * st[j4 * 4 + 1];
      st[j4 * 4 + 2] = dec * st[j4 * 4 + 2] + bv.z * xv; y += cv.z * st[j4 * 4 + 2];
      st[j4 * 4 + 3] = dec * st[j4 * 4 + 3] + bv.w * xv; y += cv.w * st[j4 * 4 + 3];
    }
    if (latent) {
      y += __shfl_xor(y, 1);
      y += __shfl_xor(y, 2);
      if (q == 0) Y[(size_t)row * DS + h * 64 + pch] = y;
    }
  }
}

__device__ void ph_ssd_finish(const Params& p, float* sm) {
  const int tid = threadIdx.x;
  for (int row = blockIdx.x; row < T; row += gridDim.x) {
    float yv[2];
#pragma unroll
    for (int gi = 0; gi < 2; ++gi) {
      int ch = gi * 256 + tid;
      float xs = p.XBC[(size_t)row * DXBC + ch];
      float y = p.YF[(size_t)row * DS + ch] + p.YB[(size_t)row * DS + ch] + p.ssd_d[ch >> 6] * xs;
      float z = p.PX[(size_t)row * DIN + COL_Z + ch];
      yv[gi] = y * silu_f(z);
    }
    float s0 = block_sum(yv[0] * yv[0], sm);
    float s1 = block_sum(yv[1] * yv[1], sm + 8);
    float r0 = rsqrtf(s0 * (1.f / 256.f) + EPS), r1 = rsqrtf(s1 * (1.f / 256.f) + EPS);
    p.YMIX[(size_t)row * D + 512 + tid] = yv[0] * r0 * p.ssd_norm_g[tid];
    p.YMIX[(size_t)row * D + 768 + tid] = yv[1] * r1 * p.ssd_norm_g[256 + tid];
  }
}

__device__ void ph_outproj(const Params& p, float* sm) {
  const int tid = threadIdx.x;
  constexpr int NT = 16, MT = T / 64;
  for (int item = blockIdx.x; item < MT * NT; item += gridDim.x) {
    int mt = item / NT, nt = item - mt * NT;
    int m0 = mt * 64, n0 = nt * 64;
    float acc[4][4] = {};
    const float* arow = p.YMIX + (size_t)(m0 + (tid >> 2)) * D;
    gemm64(acc, arow, p.w_out, D, D, n0, D, sm);
    const int ty = tid >> 4, tx = tid & 15;
    const float* ga1 = p.MOD + (m0 / L) * 6144 + 2048;
#pragma unroll
    for (int i = 0; i < 4; ++i) {
      size_t off = (size_t)(m0 + ty * 4 + i) * D + n0 + tx * 4;
      float4 xv = *(const float4*)(p.x + off);
      float4 gv = *(const float4*)(ga1 + n0 + tx * 4);
      float4 o;
      o.x = xv.x + gv.x * acc[i][0];
      o.y = xv.y + gv.y * acc[i][1];
      o.z = xv.z + gv.z * acc[i][2];
      o.w = xv.w + gv.w * acc[i][3];
      *(float4*)(p.X1 + off) = o;
    }
  }
}

__device__ void ph_router(const Params& p, float* sm) {
  const int tid = threadIdx.x;
  float* hs = sm + 16;
  float* lg = sm + 16 + 1024;
  for (int row = blockIdx.x; row < T; row += gridDim.x) {
    const float* src = p.X1 + (size_t)row * D;
    const float* sh = p.MOD + (row / L) * 6144 + 3072;
    const float* sc = sh + 1024;
    float4 v = *(const float4*)(src + tid * 4);
    float ss = v.x * v.x + v.y * v.y + v.z * v.z + v.w * v.w;
    ss = block_sum(ss, sm);
    float rstd = rsqrtf(ss * (1.f / D) + EPS);
    float4 g = *(const float4*)(p.g2 + tid * 4);
    float4 s4 = *(const float4*)(sc + tid * 4);
    float4 h4 = *(const float4*)(sh + tid * 4);
    float4 o;
    o.x = v.x * rstd * g.x * (1.f + s4.x) + h4.x;
    o.y = v.y * rstd * g.y * (1.f + s4.y) + h4.y;
    o.z = v.z * rstd * g.z * (1.f + s4.z) + h4.z;
    o.w = v.w * rstd * g.w * (1.f + s4.w) + h4.w;
    *(float4*)(p.H2 + (size_t)row * D + tid * 4) = o;
    *(float4*)(hs + tid * 4) = o;
    __syncthreads();
    if (tid < 72) {
      float a;
      if (tid < 64) {
        a = p.b_expert[tid];
        for (int k = 0; k < D; ++k) a += hs[k] * p.w_expert[k * 64 + tid];
      } else {
        int j = tid - 64;
        a = p.b_group[j];
        for (int k = 0; k < D; ++k) a += hs[k] * p.w_group[k * 8 + j];
      }
      lg[tid] = a;
    }
    __syncthreads();
    if (tid == 0) {
      int gs = 0; float gm = lg[64];
      for (int j = 1; j < 8; ++j) if (lg[64 + j] > gm) { gm = lg[64 + j]; gs = j; }
      float den = 0.f;
      for (int j = 0; j < 8; ++j) den += expf(lg[64 + j] - gm);
      float pg = 1.f / den;
      const float* el = lg + gs * 8;
      int i0 = 0; float l0 = el[0];
      for (int j = 1; j < 8; ++j) if (el[j] > l0) { l0 = el[j]; i0 = j; }
      int i1 = -1; float l1 = -3.0e38f;
      for (int j = 0; j < 8; ++j) if (j != i0 && el[j] > l1) { l1 = el[j]; i1 = j; }
      float e1 = expf(l1 - l0);
      float w0 = 1.f / (1.f + e1), w1 = e1 / (1.f + e1);
      p.GATE[row * 2 + 0] = w0 * pg;
      p.GATE[row * 2 + 1] = w1 * pg;
      int ea = gs * 8 + i0, eb = gs * 8 + i1;
      int sa = atomicAdd(&p.CNT[ea], 1);
      p.LIST[ea * T + sa] = row * 2 + 0;
      int sb = atomicAdd(&p.CNT[eb], 1);
      p.LIST[eb * T + sb] = row * 2 + 1;
    }
    __syncthreads();
  }
}

__device__ __forceinline__ void moe_prefix(const Params& p, int* pre) {
  if (threadIdx.x == 0) {
    int a = 0;
    for (int e = 0; e < NE; ++e) { pre[e] = a; a += (p.CNT[e] + 63) >> 6; }
    pre[NE] = a;
  }
  __syncthreads();
}

__device__ void ph_expert_up(const Params& p, float* sm) {
  const int tid = threadIdx.x;
  int* pre = (int*)(sm + 16 * 68 + 16 * 64);
  moe_prefix(p, pre);
  const int total = pre[NE] * 8;
  for (int item = blockIdx.x; item < total; item += gridDim.x) {
    int mtg = item >> 3, nt = item & 7;
    int e = 0;
    while (pre[e + 1] <= mtg) ++e;
    int mt = mtg - pre[e];
    int cnt = p.CNT[e];
    int m0 = mt * 64, n0 = nt * 64;
    int ml = m0 + (tid >> 2);
    const float* arow = nullptr;
    if (ml < cnt) arow = p.H2 + (size_t)(p.LIST[e * T + ml] >> 1) * D;
    float acc1[4][4] = {}, acc3[4][4] = {};
    gemm64(acc1, arow, p.w1 + (size_t)e * D * DE, DE, D, n0, DE, sm);
    gemm64(acc3, arow, p.w3 + (size_t)e * D * DE, DE, D, n0, DE, sm);
    const int ty = tid >> 4, tx = tid & 15;
#pragma unroll
    for (int i = 0; i < 4; ++i) {
      int m = m0 + ty * 4 + i;
      if (m < cnt) {
        int pair = p.LIST[e * T + m];
        float4 o;
        o.x = silu_f(acc1[i][0]) * acc3[i][0];
        o.y = silu_f(acc1[i][1]) * acc3[i][1];
        o.z = silu_f(acc1[i][2]) * acc3[i][2];
        o.w = silu_f(acc1[i][3]) * acc3[i][3];
        *(float4*)(p.HB + (size_t)pair * DE + n0 + tx * 4) = o;
      }
    }
  }
}

__device__ void ph_expert_down(const Params& p, float* sm) {
  const int tid = threadIdx.x;
  int* pre = (int*)(sm + 16 * 68 + 16 * 64);
  moe_prefix(p, pre);
  const int total = pre[NE] * 16;
  for (int item = blockIdx.x; item < total; item += gridDim.x) {
    int mtg = item >> 4, nt = item & 15;
    int e = 0;
    while (pre[e + 1] <= mtg) ++e;
    int mt = mtg - pre[e];
    int cnt = p.CNT[e];
    int m0 = mt * 64, n0 = nt * 64;
    int ml = m0 + (tid >> 2);
    const float* arow = nullptr;
    if (ml < cnt) arow = p.HB + (size_t)p.LIST[e * T + ml] * DE;
    float acc[4][4] = {};
    gemm64(acc, arow, p.w2 + (size_t)e * DE * D, D, DE, n0, D, sm);
    const int ty = tid >> 4, tx = tid & 15;
#pragma unroll
    for (int i = 0; i < 4; ++i) {
      int m = m0 + ty * 4 + i;
      if (m < cnt) {
        int pair = p.LIST[e * T + m];
        float4 o = make_float4(acc[i][0], acc[i][1], acc[i][2], acc[i][3]);
        *(float4*)(p.YB2 + (size_t)pair * D + n0 + tx * 4) = o;
      }
    }
  }
}

__device__ void ph_final(const Params& p, float* sm) {
  const int tid = threadIdx.x;
  for (int row = blockIdx.x; row < T; row += gridDim.x) {
    const float* ga2 = p.MOD + (row / L) * 6144 + 5120;
    float g0 = p.GATE[row * 2], g1 = p.GATE[row * 2 + 1];
    float4 xv = *(const float4*)(p.X1 + (size_t)row * D + tid * 4);
    float4 a = *(const float4*)(p.YB2 + (size_t)(row * 2) * D + tid * 4);
    float4 b = *(const float4*)(p.YB2 + (size_t)(row * 2 + 1) * D + tid * 4);
    float4 ga = *(const float4*)(ga2 + tid * 4);
    float4 v;
    v.x = xv.x + ga.x * (g0 * a.x + g1 * b.x);
    v.y = xv.y + ga.y * (g0 * a.y + g1 * b.y);
    v.z = xv.z + ga.z * (g0 * a.z + g1 * b.z);
    v.w = xv.w + ga.w * (g0 * a.w + g1 * b.w);
    float ss = v.x * v.x + v.y * v.y + v.z * v.z + v.w * v.w;
    ss = block_sum(ss, sm);
    float rstd = rsqrtf(ss * (1.f / D) + EPS);
    float4 gf = *(const float4*)(p.g_final + tid * 4);
    float4 o;
    o.x = v.x * rstd * gf.x; o.y = v.y * rstd * gf.y; o.z = v.z * rstd * gf.z; o.w = v.w * rstd * gf.w;
    *(float4*)(p.out + (size_t)row * D + tid * 4) = o;
  }
}

constexpr int NPHASE = 11;
constexpr int SMEM_FLOATS = 4096 + 95 * 64 + 64;

__global__ void __launch_bounds__(256) mega(Params p) {
  __shared__ __attribute__((aligned(16))) float sm[SMEM_FLOATS];
  cg::grid_group grid = cg::this_grid();
  for (int ph = p.lo; ph < p.hi; ++ph) {
    switch (ph) {
      case 0: ph_adaln(p); ph_filters(p, sm); break;
      case 1: ph_norm1(p, sm); break;
      case 2: ph_inproj(p, sm); break;
      case 3:
        ph_ssd_prep(p);
        for (int it = blockIdx.x; it < 4096; it += gridDim.x) hyena_item(p, it, 0, sm);
        break;
      case 4:
        for (int it = blockIdx.x; it < 128 + 4096; it += gridDim.x) {
          if (it < 128) ssd_scan_item(p, it); else hyena_item(p, it - 128, 1, sm);
        }
        break;
      case 5: ph_ssd_finish(p, sm); break;
      case 6: ph_outproj(p, sm); break;
      case 7: ph_router(p, sm); break;
      case 8: ph_expert_up(p, sm); break;
      case 9: ph_expert_down(p, sm); break;
      case 10: ph_final(p, sm); break;
    }
    if (ph + 1 < p.hi) grid.sync();
  }
}

extern "C" void kernel_launch(void* const* d_in, const int* in_sizes, int n_in, void* d_out, int out_size,
                              void* d_ws, size_t ws_size, hipStream_t stream) {
  Params p{};
  const float* const* in = (const float* const*)d_in;
  p.x = in[0]; p.c = in[1]; p.ctx = in[2]; p.c_ctx = in[3]; p.w_ada = in[4]; p.b_ada = in[5];
  p.g1 = in[6]; p.g2 = in[7]; p.w_in = in[8]; p.hy_conv_w = in[9]; p.hy_conv_b = in[10];
  p.f_w1 = in[11]; p.f_b1 = in[12]; p.f_freq = in[13]; p.f_w2 = in[14]; p.f_b2 = in[15]; p.f_w3 = in[16];
  p.hy_bias = in[17]; p.ssd_conv_w = in[18]; p.ssd_conv_b = in[19]; p.a_log = in[20]; p.dt_bias = in[21];
  p.ssd_d = in[22]; p.ssd_norm_g = in[23]; p.w_out = in[24]; p.w_group = in[25]; p.b_group = in[26];
  p.w_expert = in[27]; p.b_expert = in[28]; p.w1 = in[29]; p.w3 = in[30]; p.w2 = in[31]; p.g_final = in[32];
  p.out = (float*)d_out;

  char* ws = (char*)d_ws;
  size_t off = 0;
  auto take = [&](size_t bytes) { char* r = ws + off; off += (bytes + 255) & ~(size_t)255; return r; };
  p.MOD = (float*)take((size_t)9 * 6144 * 4);
  p.CNT = (int*)take(NE * 4);
  p.GATE = (float*)take((size_t)T * 2 * 4);
  p.LIST = (int*)take((size_t)NE * T * 4);
  p.DT = (float*)take((size_t)TT * 16 * 4);
  p.FILT = (float*)take((size_t)L * 2048 * 4);
  p.YMIX = (float*)take((size_t)T * D * 4);
  p.YB = (float*)take((size_t)T * DS * 4);
  p.XBC = (float*)take((size_t)TT * DXBC * 4);
  p.X1 = p.XBC;
  char* regA = take((size_t)TT * D * 4 + (size_t)TT * DIN * 4);
  p.XN = (float*)regA;
  p.PX = (float*)(regA + (size_t)TT * D * 4);
  p.Z1 = (float*)regA;
  p.YF = (float*)(regA + (size_t)T * DH * 4);
  p.H2 = (float*)regA;
  p.HB = (float*)(regA + (size_t)T * D * 4);
  p.YB2 = (float*)(regA + (size_t)T * D * 4 + (size_t)2 * T * DE * 4);
  if (off > ws_size) { fprintf(stderr, "workspace too small: need %zu have %zu\n", off, ws_size); return; }

  static int grid_blocks = 0;
  if (!grid_blocks) {
    int dev = 0, cus = 0, per_cu = 0;
    hipGetDevice(&dev);
    hipDeviceGetAttribute(&cus, hipDeviceAttributeMultiprocessorCount, dev);
    hipOccupancyMaxActiveBlocksPerMultiprocessor(&per_cu, mega, 256, 0);
    if (per_cu > 2) per_cu = 2;
    if (per_cu < 1) per_cu = 1;
    grid_blocks = cus * per_cu;
  }
#ifndef ONE_LAUNCH
  for (int ph = 0; ph < NPHASE; ++ph) {
    p.lo = ph; p.hi = ph + 1;
    hipLaunchKernelGGL(mega, dim3(grid_blocks), dim3(256), 0, stream, p);
  }
#else
  p.lo = 0; p.hi = NPHASE;
  void* args[] = {&p};
  hipError_t e = hipLaunchCooperativeKernel((void*)mega, dim3(grid_blocks), dim3(256), args, 0, stream);
  if (e != hipSuccess) fprintf(stderr, "cooperative launch failed: %s (grid %d)\n", hipGetErrorString(e), grid_blocks);
#endif
}
```

```cpp
#define ONE_LAUNCH 1
#include <hip/hip_runtime.h>
#include <hip/hip_cooperative_groups.h>
#include <cstdio>
#include <cstdint>
namespace cg = cooperative_groups;

constexpr int D = 1024, NB = 8, L = 2048, LC = 256;
constexpr int T = NB * L;
constexpr int TC = NB * LC;
constexpr int TT = T + TC;
constexpr int DH = 512, HYC = 1536, DS = 512, DXBC = 1024, DIN = 3088;
constexpr int COL_Z = 1536, COL_XBC = 2048, COL_DT = 3072;
constexpr int NE = 64, DE = 512;
constexpr float EPS = 1e-6f;

struct Params {
  const float *x, *c, *ctx, *c_ctx, *w_ada, *b_ada, *g1, *g2, *w_in, *hy_conv_w, *hy_conv_b;
  const float *f_w1, *f_b1, *f_freq, *f_w2, *f_b2, *f_w3, *hy_bias;
  const float *ssd_conv_w, *ssd_conv_b, *a_log, *dt_bias, *ssd_d, *ssd_norm_g, *w_out;
  const float *w_group, *b_group, *w_expert, *b_expert, *w1, *w3, *w2, *g_final;
  float* out;
  float *MOD, *FILT, *XN, *PX, *Z1, *YF, *YB, *YMIX, *XBC, *DT, *X1, *H2, *HB, *YB2, *GATE;
  int *CNT, *LIST;
  int lo, hi;
};

__device__ __forceinline__ float silu_f(float v) { return v / (1.f + __expf(-v)); }
__device__ __forceinline__ float softplus_f(float v) { return v > 20.f ? v : log1pf(expf(v)); }

__device__ __forceinline__ float block_sum(float v, float* red) {
#pragma unroll
  for (int o = 32; o > 0; o >>= 1) v += __shfl_xor(v, o);
  __syncthreads();
  if ((threadIdx.x & 63) == 0) red[threadIdx.x >> 6] = v;
  __syncthreads();
  float r = red[0] + red[1] + red[2] + red[3];
  return r;
}

__device__ void ph_adaln(const Params& p) {
  const int tid = threadIdx.x;
  if (blockIdx.x == 0 && tid < NE) p.CNT[tid] = 0;
  for (int idx = blockIdx.x * 256 + tid; idx < 9 * 6144; idx += gridDim.x * 256) {
    int r = idx / 6144, j = idx - r * 6144;
    const float* cv = (r < 8) ? (p.c + r * D) : p.c_ctx;
    float acc = 0.f;
    for (int k = 0; k < D; ++k) acc += silu_f(cv[k]) * p.w_ada[(size_t)k * 6144 + j];
    p.MOD[idx] = acc + p.b_ada[j];
  }
}

__device__ void ph_filters(const Params& p, float* sm) {
  const int tid = threadIdx.x;
  float* feats = sm;
  float* h1 = sm + 32;
  float* h2 = sm + 96;
  for (int t = blockIdx.x; t < L; t += gridDim.x) {
    const float tn = (float)t / (float)(L - 1);
    if (tid < 17) {
      float f;
      if (tid == 0) f = tn;
      else {
        int i = (tid - 1) & 7;
        double band = 1e-4 + (double)i * ((7.0 - 1e-4) / 7.0);
        float bandf = (float)band;
        float ang = (float)(2.0 * 3.14159265358979323846 / (double)L) * (float)t * bandf;
        f = (tid <= 8) ? cosf(ang) : -sinf(ang);
      }
      feats[tid] = f;
    }
    __syncthreads();
    if (tid < 64) {
      float a = p.f_b1[tid];
      for (int i = 0; i < 17; ++i) a += feats[i] * p.f_w1[i * 64 + tid];
      h1[tid] = sinf(p.f_freq[tid] * a);
    }
    __syncthreads();
    if (tid < 64) {
      float a = p.f_b2[tid];
      for (int i = 0; i < 64; ++i) a += h1[i] * p.f_w2[i * 64 + tid];
      h2[tid] = sinf(p.f_freq[tid] * a);
    }
    __syncthreads();
    for (int col = tid; col < 2048; col += 256) {
      float a = 0.f;
      for (int i = 0; i < 64; ++i) a += h2[i] * p.f_w3[i * 2048 + col];
      int cch = col & 511;
      const float d0 = -4.605170185988091f / 1.5f, d1 = -4.605170185988091f / 0.3f;
      float delta = fabsf(d0 + (float)cch * ((d1 - d0) / 511.f));
      p.FILT[(size_t)t * 2048 + col] = a * expf(-tn * delta);
    }
    __syncthreads();
  }
}

__device__ void ph_norm1(const Params& p, float* sm) {
  const int tid = threadIdx.x;
  for (int row = blockIdx.x; row < TT; row += gridDim.x) {
    const float* src = (row < T) ? (p.x + (size_t)row * D) : (p.ctx + (size_t)(row - T) * D);
    const int mr = (row < T) ? (row / L) : 8;
    const float* sh = p.MOD + mr * 6144;
    const float* sc = sh + 1024;
    float4 v = *(const float4*)(src + tid * 4);
    float ss = v.x * v.x + v.y * v.y + v.z * v.z + v.w * v.w;
    ss = block_sum(ss, sm);
    float rstd = rsqrtf(ss * (1.f / D) + EPS);
    float4 g = *(const float4*)(p.g1 + tid * 4);
    float4 s4 = *(const float4*)(sc + tid * 4);
    float4 h4 = *(const float4*)(sh + tid * 4);
    float4 o;
    o.x = v.x * rstd * g.x * (1.f + s4.x) + h4.x;
    o.y = v.y * rstd * g.y * (1.f + s4.y) + h4.y;
    o.z = v.z * rstd * g.z * (1.f + s4.z) + h4.z;
    o.w = v.w * rstd * g.w * (1.f + s4.w) + h4.w;
    *(float4*)(p.XN + (size_t)row * D + tid * 4) = o;
  }
}

__device__ __forceinline__ void gemm64(float (&acc)[4][4], const float* arow, const float* B, int ldb,
                                       int K, int n0, int N, float* sm) {
  const int tid = threadIdx.x;
  float* As = sm;
  float* Bs = sm + 16 * 68;
  const int am = tid >> 2, akq = (tid & 3) * 4;
  const int bk = tid >> 4, bnq = (tid & 15) * 4;
  const int ty = tid >> 4, tx = tid & 15;
  const bool bok = (n0 + bnq) < N;
  for (int k0 = 0; k0 < K; k0 += 16) {
    float4 av = make_float4(0.f, 0.f, 0.f, 0.f);
    if (arow) av = *(const float4*)(arow + k0 + akq);
    float4 bv = make_float4(0.f, 0.f, 0.f, 0.f);
    if (bok) bv = *(const float4*)(B + (size_t)(k0 + bk) * ldb + n0 + bnq);
    As[(akq + 0) * 68 + am] = av.x;
    As[(akq + 1) * 68 + am] = av.y;
    As[(akq + 2) * 68 + am] = av.z;
    As[(akq + 3) * 68 + am] = av.w;
    *(float4*)&Bs[bk * 64 + bnq] = bv;
    __syncthreads();
#pragma unroll
    for (int kk = 0; kk < 16; ++kk) {
      float4 a = *(const float4*)&As[kk * 68 + ty * 4];
      float4 b = *(const float4*)&Bs[kk * 64 + tx * 4];
      float aa[4] = {a.x, a.y, a.z, a.w};
      float bb[4] = {b.x, b.y, b.z, b.w};
#pragma unroll
      for (int i = 0; i < 4; ++i)
#pragma unroll
        for (int j = 0; j < 4; ++j) acc[i][j] += aa[i] * bb[j];
    }
    __syncthreads();
  }
}

__device__ void ph_inproj(const Params& p, float* sm) {
  const int tid = threadIdx.x;
  constexpr int NT = 49, MT = TT / 64;
  for (int item = blockIdx.x; item < MT * NT; item += gridDim.x) {
    int mt = item / NT, nt = item - mt * NT;
    int m0 = mt * 64, n0 = nt * 64;
    float acc[4][4] = {};
    const float* arow = p.XN + (size_t)(m0 + (tid >> 2)) * D;
    gemm64(acc, arow, p.w_in, DIN, D, n0, DIN, sm);
    const int ty = tid >> 4, tx = tid & 15;
    if (n0 + tx * 4 < DIN) {
#pragma unroll
      for (int i = 0; i < 4; ++i) {
        float4 o = make_float4(acc[i][0], acc[i][1], acc[i][2], acc[i][3]);
        *(float4*)(p.PX + (size_t)(m0 + ty * 4 + i) * DIN + n0 + tx * 4) = o;
      }
    }
  }
}

__device__ __forceinline__ float hy_u(const Params& p, int row, int col) {
  const int i = row & 63;
  const float* px = p.PX + (size_t)row * DIN + col;
  float v = p.hy_conv_b[col] + p.hy_conv_w[HYC + col] * px[0];
  if (i > 0) v += p.hy_conv_w[col] * px[-DIN];
  if (i < 63) v += p.hy_conv_w[2 * HYC + col] * px[DIN];
  return v;
}

__device__ void hyena_item(const Params& p, int item, int o, float* sm) {
  const int tid = threadIdx.x;
  const int tt = item & 63, ct = (item >> 6) & 7, b = item >> 9;
  const int t0 = tt * 32, c0 = ct * 64;
  const int c = tid & 63, tg = tid >> 6;
  float* zs = sm;
  float* fs = sm + 4096;
  float acc[8];
#pragma unroll
  for (int i = 0; i < 8; ++i) acc[i] = 0.f;
  for (int s0 = 0; s0 < L; s0 += 64) {
    for (int e = tid; e < 4096; e += 256) {
      int sj = e >> 6, cc = e & 63;
      int row = b * L + s0 + sj;
      zs[e] = (o == 0) ? hy_u(p, row, c0 + cc) : p.Z1[(size_t)row * DH + c0 + cc];
    }
    for (int e = tid; e < 95 * 64; e += 256) {
      int di = e >> 6, cc = e & 63;
      int d = t0 - s0 - 63 + di;
      float f;
      if (d >= 0) f = p.FILT[(size_t)d * 2048 + o * 1024 + c0 + cc];
      else f = p.FILT[(size_t)(-d) * 2048 + o * 1024 + 512 + c0 + cc];
      fs[e] = f;
    }
    __syncthreads();
#pragma unroll 4
    for (int sj = 0; sj < 64; ++sj) {
      float zv = zs[sj * 64 + c];
      const float* fp = fs + (tg * 8 - sj + 63) * 64 + c;
#pragma unroll
      for (int i = 0; i < 8; ++i) acc[i] += fp[i * 64] * zv;
    }
    __syncthreads();
  }
#pragma unroll
  for (int i = 0; i < 8; ++i) {
    int t = t0 + tg * 8 + i;
    int row = b * L + t;
    float zt = (o == 0) ? hy_u(p, row, c0 + c) : p.Z1[(size_t)row * DH + c0 + c];
    float conv = acc[i] + zt * p.hy_bias[o * 512 + c0 + c];
    float gate = hy_u(p, row, (o + 1) * 512 + c0 + c);
    float outv = gate * conv;
    if (o == 0) p.Z1[(size_t)row * DH + c0 + c] = outv;
    else p.YMIX[(size_t)row * D + c0 + c] = outv;
  }
}

__device__ void ph_ssd_prep(const Params& p) {
  const int tid = threadIdx.x;
  for (int row = blockIdx.x; row < TT; row += gridDim.x) {
    bool has_prev, has_next;
    if (row < T) { int i = row & 63; has_prev = i > 0; has_next = i < 63; }
    else { int i = (row - T) & (LC - 1); has_prev = i > 0; has_next = i < LC - 1; }
    const float* px = p.PX + (size_t)row * DIN;
    for (int ch = tid; ch < DXBC; ch += 256) {
      float v = p.ssd_conv_b[ch] + p.ssd_conv_w[DXBC + ch] * px[COL_XBC + ch];
      if (has_prev) v += p.ssd_conv_w[ch] * px[COL_XBC + ch - DIN];
      if (has_next) v += p.ssd_conv_w[2 * DXBC + ch] * px[COL_XBC + ch + DIN];
      p.XBC[(size_t)row * DXBC + ch] = silu_f(v);
    }
    if (tid < 16) p.DT[(size_t)row * 16 + tid] = softplus_f(px[COL_DT + tid] + p.dt_bias[tid]);
  }
}

__device__ void ssd_scan_item(const Params& p, int item) {
  const int tid = threadIdx.x;
  const int dir = item & 1, h = (item >> 1) & 7, b = item >> 4;
  const int g = h >> 2;
  const int pch = tid >> 2, q = tid & 3;
  const float A = expf(p.a_log[dir * 8 + h]);
  float* Y = dir ? p.YB : p.YF;
  float st[32];
#pragma unroll
  for (int j = 0; j < 32; ++j) st[j] = 0.f;
  const int nsteps = LC + L;
  for (int s = 0; s < nsteps; ++s) {
    int row; bool latent;
    if (s < LC) { int t = dir ? (LC - 1 - s) : s; row = T + b * LC + t; latent = false; }
    else { int t = dir ? (L - 1 - (s - LC)) : (s - LC); row = b * L + t; latent = true; }
    const float* xb = p.XBC + (size_t)row * DXBC;
    float dtv = p.DT[(size_t)row * 16 + dir * 8 + h];
    float dec = expf(-A * dtv);
    float xv = xb[h * 64 + pch] * dtv;
    const float* Bp = xb + 512 + g * 128 + q * 32;
    const float* Cp = xb + 768 + g * 128 + q * 32;
    float y = 0.f;
#pragma unroll
    for (int j4 = 0; j4 < 8; ++j4) {
      float4 bv = *(const float4*)(Bp + j4 * 4);
      float4 cv = *(const float4*)(Cp + j4 * 4);
      st[j4 * 4 + 0] = dec * st[j4 * 4 + 0] + bv.x * xv; y += cv.x * st[j4 * 4 + 0];
      st[j4 * 4 + 1] = dec * st[j4 * 4 + 1] + bv.y * xv; y += cv.y * st[j4 * 4 + 1];
      st[j4 * 4 + 2] = dec * st[j4 * 4 + 2] + bv.z * xv; y += cv.z * st[j4 * 4 + 2];
      st[j4 * 4 + 3] = dec * st[j4 * 4 + 3] + bv.w * xv; y += cv.w * st[j4 * 4 + 3];
    }
    if (latent) {
      y += __shfl_xor(y, 1);
      y += __shfl_xor(y, 2);
      if (q == 0) Y[(size_t)row * DS + h * 64 + pch] = y;
    }
  }
}

__device__ void ph_ssd_finish(const Params& p, float* sm) {
  const int tid = threadIdx.x;
  for (int row = blockIdx.x; row < T; row += gridDim.x) {
    float yv[2];
#pragma unroll
    for (int gi = 0; gi < 2; ++gi) {
      int ch = gi * 256 + tid;
      float xs = p.XBC[(size_t)row * DXBC + ch];
      float y = p.YF[(size_t)row * DS + ch] + p.YB[(size_t)row * DS + ch] + p.ssd_d[ch >> 6] * xs;
      float z = p.PX[(size_t)row * DIN + COL_Z + ch];
      yv[gi] = y * silu_f(z);
    }
    float s0 = block_sum(yv[0] * yv[0], sm);
    float s1 = block_sum(yv[1] * yv[1], sm + 8);
    float r0 = rsqrtf(s0 * (1.f / 256.f) + EPS), r1 = rsqrtf(s1 * (1.f / 256.f) + EPS);
    p.YMIX[(size_t)row * D + 512 + tid] = yv[0] * r0 * p.ssd_norm_g[tid];
    p.YMIX[(size_t)row * D + 768 + tid] = yv[1] * r1 * p.ssd_norm_g[256 + tid];
  }
}

__device__ void ph_outproj(const Params& p, float* sm) {
  const int tid = threadIdx.x;
  constexpr int NT = 16, MT = T / 64;
  for (int item = blockIdx.x; item < MT * NT; item += gridDim.x) {
    int mt = item / NT, nt = item - mt * NT;
    int m0 = mt * 64, n0 = nt * 64;
    float acc[4][4] = {};
    const float* arow = p.YMIX + (size_t)(m0 + (tid >> 2)) * D;
    gemm64(acc, arow, p.w_out, D, D, n0, D, sm);
    const int ty = tid >> 4, tx = tid & 15;
    const float* ga1 = p.MOD + (m0 / L) * 6144 + 2048;
#pragma unroll
    for (int i = 0; i < 4; ++i) {
      size_t off = (size_t)(m0 + ty * 4 + i) * D + n0 + tx * 4;
      float4 xv = *(const float4*)(p.x + off);
      float4 gv = *(const float4*)(ga1 + n0 + tx * 4);
      float4 o;
      o.x = xv.x + gv.x * acc[i][0];
      o.y = xv.y + gv.y * acc[i][1];
      o.z = xv.z + gv.z * acc[i][2];
      o.w = xv.w + gv.w * acc[i][3];
      *(float4*)(p.X1 + off) = o;
    }
  }
}

__device__ void ph_router(const Params& p, float* sm) {
  const int tid = threadIdx.x;
  float* hs = sm + 16;
  float* lg = sm + 16 + 1024;
  for (int row = blockIdx.x; row < T; row += gridDim.x) {
    const float* src = p.X1 + (size_t)row * D;
    const float* sh = p.MOD + (row / L) * 6144 + 3072;
    const float* sc = sh + 1024;
    float4 v = *(const float4*)(src + tid * 4);
    float ss = v.x * v.x + v.y * v.y + v.z * v.z + v.w * v.w;
    ss = block_sum(ss, sm);
    float rstd = rsqrtf(ss * (1.f / D) + EPS);
    float4 g = *(const float4*)(p.g2 + tid * 4);
    float4 s4 = *(const float4*)(sc + tid * 4);
    float4 h4 = *(const float4*)(sh + tid * 4);
    float4 o;
    o.x = v.x * rstd * g.x * (1.f + s4.x) + h4.x;
    o.y = v.y * rstd * g.y * (1.f + s4.y) + h4.y;
    o.z = v.z * rstd * g.z * (1.f + s4.z) + h4.z;
    o.w = v.w * rstd * g.w * (1.f + s4.w) + h4.w;
    *(float4*)(p.H2 + (size_t)row * D + tid * 4) = o;
    *(float4*)(hs + tid * 4) = o;
    __syncthreads();
    if (tid < 72) {
      float a;
      if (tid < 64) {
        a = p.b_expert[tid];
        for (int k = 0; k < D; ++k) a += hs[k] * p.w_expert[k * 64 + tid];
      } else {
        int j = tid - 64;
        a = p.b_group[j];
        for (int k = 0; k < D; ++k) a += hs[k] * p.w_group[k * 8 + j];
      }
      lg[tid] = a;
    }
    __syncthreads();
    if (tid == 0) {
      int gs = 0; float gm = lg[64];
      for (int j = 1; j < 8; ++j) if (lg[64 + j] > gm) { gm = lg[64 + j]; gs = j; }
      float den = 0.f;
      for (int j = 0; j < 8; ++j) den += expf(lg[64 + j] - gm);
      float pg = 1.f / den;
      const float* el = lg + gs * 8;
      int i0 = 0; float l0 = el[0];
      for (int j = 1; j < 8; ++j) if (el[j] > l0) { l0 = el[j]; i0 = j; }
      int i1 = -1; float l1 = -3.0e38f;
      for (int j = 0; j < 8; ++j) if (j != i0 && el[j] > l1) { l1 = el[j]; i1 = j; }
      float e1 = expf(l1 - l0);
      float w0 = 1.f / (1.f + e1), w1 = e1 / (1.f + e1);
      p.GATE[row * 2 + 0] = w0 * pg;
      p.GATE[row * 2 + 1] = w1 * pg;
      int ea = gs * 8 + i0, eb = gs * 8 + i1;
      int sa = atomicAdd(&p.CNT[ea], 1);
      p.LIST[ea * T + sa] = row * 2 + 0;
      int sb = atomicAdd(&p.CNT[eb], 1);
      p.LIST[eb * T + sb] = row * 2 + 1;
    }
    __syncthreads();
  }
}

__device__ __forceinline__ void moe_prefix(const Params& p, int* pre) {
  if (threadIdx.x == 0) {
    int a = 0;
    for (int e = 0; e < NE; ++e) { pre[e] = a; a += (p.CNT[e] + 63) >> 6; }
    pre[NE] = a;
  }
  __syncthreads();
}

__device__ void ph_expert_up(const Params& p, float* sm) {
  const int tid = threadIdx.x;
  int* pre = (int*)(sm + 16 * 68 + 16 * 64);
  moe_prefix(p, pre);
  const int total = pre[NE] * 8;
  for (int item = blockIdx.x; item < total; item += gridDim.x) {
    int mtg = item >> 3, nt = item & 7;
    int e = 0;
    while (pre[e + 1] <= mtg) ++e;
    int mt = mtg - pre[e];
    int cnt = p.CNT[e];
    int m0 = mt * 64, n0 = nt * 64;
    int ml = m0 + (tid >> 2);
    const float* arow = nullptr;
    if (ml < cnt) arow = p.H2 + (size_t)(p.LIST[e * T + ml] >> 1) * D;
    float acc1[4][4] = {}, acc3[4][4] = {};
    gemm64(acc1, arow, p.w1 + (size_t)e * D * DE, DE, D, n0, DE, sm);
    gemm64(acc3, arow, p.w3 + (size_t)e * D * DE, DE, D, n0, DE, sm);
    const int ty = tid >> 4, tx = tid & 15;
#pragma unroll
    for (int i = 0; i < 4; ++i) {
      int m = m0 + ty * 4 + i;
      if (m < cnt) {
        int pair = p.LIST[e * T + m];
        float4 o;
        o.x = silu_f(acc1[i][0]) * acc3[i][0];
        o.y = silu_f(acc1[i][1]) * acc3[i][1];
        o.z = silu_f(acc1[i][2]) * acc3[i][2];
        o.w = silu_f(acc1[i][3]) * acc3[i][3];
        *(float4*)(p.HB + (size_t)pair * DE + n0 + tx * 4) = o;
      }
    }
  }
}

__device__ void ph_expert_down(const Params& p, float* sm) {
  const int tid = threadIdx.x;
  int* pre = (int*)(sm + 16 * 68 + 16 * 64);
  moe_prefix(p, pre);
  const int total = pre[NE] * 16;
  for (int item = blockIdx.x; item < total; item += gridDim.x) {
    int mtg = item >> 4, nt = item & 15;
    int e = 0;
    while (pre[e + 1] <= mtg) ++e;
    int mt = mtg - pre[e];
    int cnt = p.CNT[e];
    int m0 = mt * 64, n0 = nt * 64;
    int ml = m0 + (tid >> 2);
    const float* arow = nullptr;
    if (ml < cnt) arow = p.HB + (size_t)p.LIST[e * T + ml] * DE;
    float acc[4][4] = {};
    gemm64(acc, arow, p.w2 + (size_t)e * DE * D, D, DE, n0, D, sm);
    const int ty = tid >> 4, tx = tid & 15;
#pragma unroll
    for (int i = 0; i < 4; ++i) {
      int m = m0 + ty * 4 + i;
      if (m < cnt) {
        int pair = p.LIST[e * T + m];
        float4 o = make_float4(acc[i][0], acc[i][1], acc[i][2], acc[i][3]);
        *(float4*)(p.YB2 + (size_t)pair * D + n0 + tx * 4) = o;
      }
    }
  }
}

__device__ void ph_final(const Params& p, float* sm) {
  const int tid = threadIdx.x;
  for (int row = blockIdx.x; row < T; row += gridDim.x) {
    const float* ga2 = p.MOD + (row / L) * 6144 + 5120;
    float g0 = p.GATE[row * 2], g1 = p.GATE[row * 2 + 1];
    float4 xv = *(const float4*)(p.X1 + (size_t)row * D + tid * 4);
    float4 a = *(const float4*)(p.YB2 + (size_t)(row * 2) * D + tid * 4);
    float4 b = *(const float4*)(p.YB2 + (size_t)(row * 2 + 1) * D + tid * 4);
    float4 ga = *(const float4*)(ga2 + tid * 4);
    float4 v;
    v.x = xv.x + ga.x * (g0 * a.x + g1 * b.x);
    v.y = xv.y + ga.y * (g0 * a.y + g1 * b.y);
    v.z = xv.z + ga.z * (g0 * a.z + g1 * b.z);
    v.w = xv.w + ga.w * (g0 * a.w + g1 * b.w);
    float ss = v.x * v.x + v.y * v.y + v.z * v.z + v.w * v.w;
    ss = block_sum(ss, sm);
    float rstd = rsqrtf(ss * (1.f / D) + EPS);
    float4 gf = *(const float4*)(p.g_final + tid * 4);
    float4 o;
    o.x = v.x * rstd * gf.x; o.y = v.y * rstd * gf.y; o.z = v.z * rstd * gf.z; o.w = v.w * rstd * gf.w;
    *(float4*)(p.out + (size_t)row * D + tid * 4) = o;
  }
}

constexpr int NPHASE = 11;
constexpr int SMEM_FLOATS = 4096 + 95 * 64 + 64;

__global__ void __launch_bounds__(256) mega(Params p) {
  __shared__ __attribute__((aligned(16))) float sm[SMEM_FLOATS];
  cg::grid_group grid = cg::this_grid();
  for (int ph = p.lo; ph < p.hi; ++ph) {
    switch (ph) {
      case 0: ph_adaln(p); ph_filters(p, sm); break;
      case 1: ph_norm1(p, sm); break;
      case 2: ph_inproj(p, sm); break;
      case 3:
        ph_ssd_prep(p);
        for (int it = blockIdx.x; it < 4096; it += gridDim.x) hyena_item(p, it, 0, sm);
        break;
      case 4:
        for (int it = blockIdx.x; it < 128 + 4096; it += gridDim.x) {
          if (it < 128) ssd_scan_item(p, it); else hyena_item(p, it - 128, 1, sm);
        }
        break;
      case 5: ph_ssd_finish(p, sm); break;
      case 6: ph_outproj(p, sm); break;
      case 7: ph_router(p, sm); break;
      case 8: ph_expert_up(p, sm); break;
      case 9: ph_expert_down(p, sm); break;
      case 10: ph_final(p, sm); break;
    }
    if (ph + 1 < p.hi) grid.sync();
  }
}

extern "C" void kernel_launch(void* const* d_in, const int* in_sizes, int n_in, void* d_out, int out_size,
                              void* d_ws, size_t ws_size, hipStream_t stream) {
  Params p{};
  const float* const* in = (const float* const*)d_in;
  p.x = in[0]; p.c = in[1]; p.ctx = in[2]; p.c_ctx = in[3]; p.w_ada = in[4]; p.b_ada = in[5];
  p.g1 = in[6]; p.g2 = in[7]; p.w_in = in[8]; p.hy_conv_w = in[9]; p.hy_conv_b = in[10];
  p.f_w1 = in[11]; p.f_b1 = in[12]; p.f_freq = in[13]; p.f_w2 = in[14]; p.f_b2 = in[15]; p.f_w3 = in[16];
  p.hy_bias = in[17]; p.ssd_conv_w = in[18]; p.ssd_conv_b = in[19]; p.a_log = in[20]; p.dt_bias = in[21];
  p.ssd_d = in[22]; p.ssd_norm_g = in[23]; p.w_out = in[24]; p.w_group = in[25]; p.b_group = in[26];
  p.w_expert = in[27]; p.b_expert = in[28]; p.w1 = in[29]; p.w3 = in[30]; p.w2 = in[31]; p.g_final = in[32];
  p.out = (float*)d_out;

  char* ws = (char*)d_ws;
  size_t off = 0;
  auto take = [&](size_t bytes) { char* r = ws + off; off += (bytes + 255) & ~(size_t)255; return r; };
  p.MOD = (float*)take((size_t)9 * 6144 * 4);
  p.CNT = (int*)take(NE * 4);
  p.GATE = (float*)take((size_t)T * 2 * 4);
  p.LIST = (int*)take((size_t)NE * T * 4);
  p.DT = (float*)take((size_t)TT * 16 * 4);
  p.FILT = (float*)take((size_t)L * 2048 * 4);
  p.YMIX = (float*)take((size_t)T * D * 4);
  p.YB = (float*)take((size_t)T * DS * 4);
  p.XBC = (float*)take((size_t)TT * DXBC * 4);
  p.X1 = p.XBC;
  char* regA = take((size_t)TT * D * 4 + (size_t)TT * DIN * 4);
  p.XN = (float*)regA;
  p.PX = (float*)(regA + (size_t)TT * D * 4);
  p.Z1 = (float*)regA;
  p.YF = (float*)(regA + (size_t)T * DH * 4);
  p.H2 = (float*)regA;
  p.HB = (float*)(regA + (size_t)T * D * 4);
  p.YB2 = (float*)(regA + (size_t)T * D * 4 + (size_t)2 * T * DE * 4);
  if (off > ws_size) { fprintf(stderr, "workspace too small: need %zu have %zu\n", off, ws_size); return; }

  static int grid_blocks = 0;
  if (!grid_blocks) {
    int dev = 0, cus = 0, per_cu = 0;
    hipGetDevice(&dev);
    hipDeviceGetAttribute(&cus, hipDeviceAttributeMultiprocessorCount, dev);
    hipOccupancyMaxActiveBlocksPerMultiprocessor(&per_cu, mega, 256, 0);
    if (per_cu > 2) per_cu = 2;
    if (per_cu < 1) per_cu = 1;
    grid_blocks = cus * per_cu;
  }
#ifndef ONE_LAUNCH
  for (int ph = 0; ph < NPHASE; ++ph) {
    p.lo = ph; p.hi = ph + 1;
    hipLaunchKernelGGL(mega, dim3(grid_blocks), dim3(256), 0, stream, p);
  }
#else
  p.lo = 0; p.hi = NPHASE;
  void* args[] = {&p};
  hipError_t e = hipLaunchCooperativeKernel((void*)mega, dim3(grid_blocks), dim3(256), args, 0, stream);
  if (e != hipSuccess) fprintf(stderr, "cooperative launch failed: %s (grid %d)\n", hipGetErrorString(e), grid_blocks);
#endif
}
```

```cpp
#define ONE_LAUNCH 1
#include <hip/hip_runtime.h>
#include <hip/hip_cooperative_groups.h>
#include <cstdio>
#include <cstdint>
namespace cg = cooperative_groups;

constexpr int D = 1024, NB = 8, L = 2048, LC = 256;
constexpr int T = NB * L;
constexpr int TC = NB * LC;
constexpr int TT = T + TC;
constexpr int DH = 512, HYC = 1536, DS = 512, DXBC = 1024, DIN = 3088, DP = 3072;
constexpr int COL_Z = 1536, COL_XBC = 2048, COL_DT = 3072;
constexpr int NE = 64, DE = 512;
constexpr float EPS = 1e-6f;
constexpr int NTHR = 512;
constexpr int LDS_BYTES = 132 * 1024;

typedef unsigned short bf16_t;

struct Params {
  const float *x, *c, *ctx, *c_ctx, *w_ada, *b_ada, *g1, *g2, *w_in, *hy_conv_w, *hy_conv_b;
  const float *f_w1, *f_b1, *f_freq, *f_w2, *f_b2, *f_w3, *hy_bias;
  const float *ssd_conv_w, *ssd_conv_b, *a_log, *dt_bias, *ssd_d, *ssd_norm_g, *w_out;
  const float *w_group, *b_group, *w_expert, *b_expert, *w1, *w3, *w2, *g_final;
  float* out;
  float *MOD, *FILT, *Z1, *YF, *YB, *DT, *X1, *H2, *HB, *GATE;
  bf16_t *XNb, *WinT, *WoutT, *PXb, *XBCb, *YMIXb, *YB2b;
  int *CNT, *LIST;
  int lo, hi;
};

__device__ __forceinline__ float silu_f(float v) { return v / (1.f + __expf(-v)); }
__device__ __forceinline__ float softplus_f(float v) { return v > 20.f ? v : log1pf(expf(v)); }
__device__ __forceinline__ float bf2f(bf16_t v) { return __uint_as_float(((unsigned)v) << 16); }
__device__ __forceinline__ unsigned cvt_pk_bf16(float lo, float hi) {
  unsigned r;
  asm volatile("v_cvt_pk_bf16_f32 %0, %1, %2" : "=v"(r) : "v"(lo), "v"(hi));
  return r;
}
__device__ __forceinline__ bf16_t f2bf(float f) { return (bf16_t)(cvt_pk_bf16(f, 0.f) & 0xffffu); }
__device__ __forceinline__ float wave_sum(float v) {
#pragma unroll
  for (int o = 32; o > 0; o >>= 1) v += __shfl_xor(v, o);
  return v;
}

namespace pg8 {
#define PG8_LAS __attribute__((address_space(3)))
typedef short bf16x8 __attribute__((ext_vector_type(8)));
typedef float f32x4 __attribute__((ext_vector_type(4)));
typedef unsigned u32x4 __attribute__((ext_vector_type(4)));
typedef unsigned u32x2 __attribute__((ext_vector_type(2)));
constexpr int BM = 256, BK = 64, HALF = 128, HTB = HALF * BK * 2, STAGE_BYTES = 8 * HTB, NXCD = 8, WGM = 8;

__host__ __device__ __forceinline__ int lds_byte(int r, int c) {
  const int st = (r >> 4) * 2 + (c >> 5), rr = r & 15, cc = c & 31, ob = rr * 64 + cc * 2;
  return st * 1024 + (ob ^ (((ob >> 9) & 1) << 5));
}
__host__ __device__ __forceinline__ void stage_rc(int b, int& R, int& C) {
  const int st = b / 1024, sb = b % 1024, swz = sb ^ (((sb >> 9) & 1) << 5);
  R = (st >> 1) * 16 + swz / 64; C = (st & 1) * 32 + (swz % 64) / 2;
}
__host__ __device__ __forceinline__ int perm32(int rho) { const int n = rho >> 4, i = rho & 15; return 8 * (i >> 2) + 4 * n + (i & 3); }

struct Unit { int pm, pn; };
struct Gemm { const bf16_t* A; const bf16_t* Bt; int M, N, K; };

struct StaticOrder {
  int nM, nN, nwg, G, c;
  __host__ __device__ void init(int M, int N, int G_, int c_) { nM = M / BM; nN = N / BM; nwg = nM * nN; G = G_; c = c_; }
  __host__ __device__ bool next(int i, Unit& u) const {
    const long Lx = (long)i * G + c; if (Lx >= nwg) return false;
    int wgid = (int)Lx;
    { const int q = nwg / NXCD, r = nwg % NXCD, xcd = wgid % NXCD, off = wgid / NXCD; wgid = (xcd < r ? xcd * (q + 1) : r * (q + 1) + (xcd - r) * q) + off; }
    const int nig = WGM * nN, gid = wgid / nig, fm = gid * WGM, gsz = (nM - fm) < WGM ? (nM - fm) : WGM;
    u.pm = fm + ((wgid % nig) % gsz); u.pn = (wgid % nig) / gsz; return true;
  }
  __device__ __forceinline__ void a_ready(const Unit&) const {}
  __device__ __forceinline__ void done(const Unit&) const {}
};

struct EpiBf16 {
  static constexpr bool PERM = true;
  bf16_t* O; int ldc;
  __device__ __forceinline__ void operator()(const f32x4 (&acc)[2][2][4][2], const Unit& u, int wr, int wc, int fr, int fq) const {
    const int row0 = u.pm * BM + wr * 64 + fr;
    const int col0 = u.pn * BM + wc * 32 + 8 * fq;
#pragma unroll
    for (int ai = 0; ai < 2; ++ai)
#pragma unroll
      for (int m = 0; m < 4; ++m) {
        bf16_t* rowp = O + (size_t)(row0 + ai * HALF + m * 16) * ldc + col0;
#pragma unroll
        for (int bj = 0; bj < 2; ++bj) {
          f32x4 v0 = acc[ai][bj][m][0], v1 = acc[ai][bj][m][1];
          u32x4 w; w.x = cvt_pk_bf16(v0[0], v0[1]); w.y = cvt_pk_bf16(v0[2], v0[3]); w.z = cvt_pk_bf16(v1[0], v1[1]); w.w = cvt_pk_bf16(v1[2], v1[3]);
          *(u32x4*)(rowp + bj * HALF) = w;
        }
      }
  }
};

struct EpiX1 {
  static constexpr bool PERM = false;
  const float* x; const float* mod; float* X1;
  __device__ __forceinline__ void operator()(const f32x4 (&acc)[2][2][4][2], const Unit& u, int wr, int wc, int fr, int fq) const {
    const int row0 = u.pm * BM + wr * 64 + fr, col0 = u.pn * BM + wc * 32 + 4 * fq;
    const float* ga = mod + ((u.pm * BM) / L) * 6144 + 2048 + col0;
    f32x4 gv[2][2];
#pragma unroll
    for (int bj = 0; bj < 2; ++bj)
#pragma unroll
      for (int n = 0; n < 2; ++n) gv[bj][n] = *(const f32x4*)(ga + bj * HALF + n * 16);
#pragma unroll
    for (int ai = 0; ai < 2; ++ai)
#pragma unroll
      for (int m = 0; m < 4; ++m) {
        const size_t off = (size_t)(row0 + ai * HALF + m * 16) * D + col0;
#pragma unroll
        for (int bj = 0; bj < 2; ++bj)
#pragma unroll
          for (int n = 0; n < 2; ++n) {
            const f32x4 xv = *(const f32x4*)(x + off + bj * HALF + n * 16);
            *(f32x4*)(X1 + off + bj * HALF + n * 16) = xv + gv[bj][n] * acc[ai][bj][m][n];
          }
      }
  }
};

template <class Epi, class Sched>
__device__ __forceinline__ void gemm_phase(PG8_LAS unsigned char* lds, const Gemm g, const Sched& S, const Epi& E) {
  const int tid = threadIdx.x, wid = __builtin_amdgcn_readfirstlane(tid >> 6), lane = tid & 63, wr = wid >> 2, wc = wid & 3, fr = lane & 15, fq = lane >> 4;
  const int K = g.K, nt = K / BK;
  unsigned voffA[2], voffB[2];
#pragma unroll
  for (int i = 0; i < 2; ++i) {
    int R, C; stage_rc(tid * 16 + i * 8192, R, C);
    const int Rb = Epi::PERM ? ((R & ~31) + perm32(R & 31)) : R;
    voffA[i] = (unsigned)(R * K + C) * 2u; voffB[i] = (unsigned)(Rb * K + C) * 2u;
  }
  const size_t kstep = (size_t)(BK * 2);
  const size_t hstep = (size_t)HALF * K * 2;
  const size_t tstep = 2 * hstep;
  const unsigned ldsw = (unsigned)wid * 1024u;
  const int aoff = lds_byte(wr * 64 + fr, fq * 8), boff = lds_byte(wc * 32 + fr, fq * 8);
#define PG8_SA(b, h) (((b) * 2 + (h)) * HTB)
#define PG8_SB(b, h) ((4 + (b) * 2 + (h)) * HTB)
#define PG8_STAGE(bufoff, gbase, voff) do { _Pragma("unroll") for (int _i = 0; _i < 2; ++_i) \
    __builtin_amdgcn_global_load_lds((const unsigned*)((const char*)(gbase) + (voff)[_i]), (PG8_LAS unsigned*)(lds + (bufoff) + ldsw + _i * 8192), 16, 0, 0); } while (0)
#define PG8_LDA(dst, b, h) do { _Pragma("unroll") for (int m = 0; m < 4; ++m) _Pragma("unroll") for (int k = 0; k < 2; ++k) dst[m][k] = *(const PG8_LAS bf16x8*)(lds + PG8_SA(b, h) + aoff + m * 2048 + k * 1024); } while (0)
#define PG8_LDB(dst, b, h) do { _Pragma("unroll") for (int n = 0; n < 2; ++n) _Pragma("unroll") for (int k = 0; k < 2; ++k) dst[n][k] = *(const PG8_LAS bf16x8*)(lds + PG8_SB(b, h) + boff + n * 2048 + k * 1024); } while (0)
#define PG8_MMA(ai, bj, At, Bt) do { __builtin_amdgcn_s_setprio(1); _Pragma("unroll") for (int m = 0; m < 4; ++m) _Pragma("unroll") for (int n = 0; n < 2; ++n) _Pragma("unroll") for (int k = 0; k < 2; ++k) \
    acc[ai][bj][m][n] = __builtin_amdgcn_mfma_f32_16x16x32_bf16(Bt[n][k], At[m][k], acc[ai][bj][m][n], 0, 0, 0); __builtin_amdgcn_s_setprio(0); } while (0)
#define PG8_WAIT_V(n) asm volatile("s_waitcnt vmcnt(" #n ")" ::: "memory")
#define PG8_WAIT_L(n) asm volatile("s_waitcnt lgkmcnt(" #n ")" ::: "memory")
#define PG8_BAR __builtin_amdgcn_s_barrier()
#define PG8_SCHED __builtin_amdgcn_sched_barrier(0)
  Unit cur, nxt; int ui = 0;
  if (!S.next(0, cur)) return;
  f32x4 acc[2][2][4][2];
#pragma unroll
  for (int a = 0; a < 2; ++a)
#pragma unroll
    for (int b = 0; b < 2; ++b)
#pragma unroll
      for (int m = 0; m < 4; ++m)
#pragma unroll
        for (int n = 0; n < 2; ++n) acc[a][b][m][n] = (f32x4){0.f, 0.f, 0.f, 0.f};
  bf16x8 At[4][2], B0[2][2], B1[2][2];
  const char* cA = (const char*)g.A + (size_t)cur.pm * tstep; const char* cB = (const char*)g.Bt + (size_t)cur.pn * tstep;
  S.a_ready(cur);
  PG8_STAGE(PG8_SB(0, 0), cB, voffB); PG8_STAGE(PG8_SA(0, 0), cA, voffA); PG8_STAGE(PG8_SB(0, 1), cB + hstep, voffB); PG8_STAGE(PG8_SA(0, 1), cA + hstep, voffA);
  if (wr == 1) PG8_BAR;
  PG8_WAIT_V(4); PG8_BAR;
  PG8_STAGE(PG8_SB(1, 0), cB + kstep, voffB); PG8_STAGE(PG8_SA(1, 0), cA + kstep, voffA); PG8_STAGE(PG8_SB(1, 1), cB + hstep + kstep, voffB);
  PG8_WAIT_V(6); PG8_BAR;
  for (;;) {
    const bool has_next = S.next(ui + 1, nxt);
    const char* nA = has_next ? (const char*)g.A + (size_t)nxt.pm * tstep : cA; const char* nB = has_next ? (const char*)g.Bt + (size_t)nxt.pn * tstep : cB;
    for (int t = 0; t < nt; t += 2) {
      const bool last = (t == nt - 2);
      const char* a1 = cA + (size_t)(t + 1) * kstep;
      const char* a2 = last ? nA : cA + (size_t)(t + 2) * kstep; const char* b2 = last ? nB : cB + (size_t)(t + 2) * kstep;
      const char* a3 = a2 + kstep; const char* b3 = b2 + kstep;
      if (last && has_next) S.a_ready(nxt);
      PG8_LDB(B0, 0, 0); PG8_SCHED; PG8_LDA(At, 0, 0); PG8_STAGE(PG8_SA(1, 1), a1 + hstep, voffA);
      PG8_WAIT_L(8); PG8_BAR; PG8_WAIT_L(0); PG8_MMA(0, 0, At, B0); PG8_BAR; PG8_SCHED;
      PG8_LDB(B1, 0, 1); PG8_STAGE(PG8_SB(0, 0), b2, voffB);
      PG8_BAR; PG8_WAIT_L(0); PG8_MMA(0, 1, At, B1); PG8_BAR;
      PG8_LDA(At, 0, 1); PG8_STAGE(PG8_SA(0, 0), a2, voffA);
      PG8_BAR; PG8_WAIT_L(0); PG8_MMA(1, 0, At, B0); PG8_BAR; PG8_SCHED;
      PG8_STAGE(PG8_SB(0, 1), b2 + hstep, voffB);
      PG8_WAIT_V(6); PG8_BAR; PG8_MMA(1, 1, At, B1); PG8_BAR;
      PG8_LDB(B0, 1, 0); PG8_SCHED; PG8_LDA(At, 1, 0); PG8_STAGE(PG8_SA(0, 1), a2 + hstep, voffA);
      PG8_WAIT_L(8); PG8_BAR; PG8_WAIT_L(0); PG8_MMA(0, 0, At, B0); PG8_BAR; PG8_SCHED;
      PG8_LDB(B1, 1, 1); PG8_STAGE(PG8_SB(1, 0), b3, voffB);
      PG8_BAR; PG8_WAIT_L(0); PG8_MMA(0, 1, At, B1); PG8_BAR;
      PG8_LDA(At, 1, 1); PG8_STAGE(PG8_SA(1, 0), a3, voffA);
      PG8_BAR; PG8_WAIT_L(0); PG8_MMA(1, 0, At, B0); PG8_BAR; PG8_SCHED;
      PG8_STAGE(PG8_SB(1, 1), b3 + hstep, voffB);
      PG8_WAIT_V(6); PG8_BAR; PG8_MMA(1, 1, At, B1); PG8_BAR;
    }
    E(acc, cur, wr, wc, fr, fq); S.done(cur);
    if (!has_next) break;
#pragma unroll
    for (int a = 0; a < 2; ++a)
#pragma unroll
      for (int b = 0; b < 2; ++b)
#pragma unroll
        for (int m = 0; m < 4; ++m)
#pragma unroll
          for (int n = 0; n < 2; ++n) acc[a][b][m][n] = (f32x4){0.f, 0.f, 0.f, 0.f};
    cur = nxt; cA = nA; cB = nB; ++ui;
  }
  PG8_WAIT_V(0);
  if (wr == 0) PG8_BAR;
  PG8_BAR;
#undef PG8_SA
#undef PG8_SB
#undef PG8_STAGE
#undef PG8_LDA
#undef PG8_LDB
#undef PG8_MMA
#undef PG8_WAIT_V
#undef PG8_WAIT_L
#undef PG8_BAR
#undef PG8_SCHED
}
}

__device__ void ph_adaln(const Params& p) {
  const int tid = threadIdx.x;
  if (blockIdx.x == 0 && tid < NE) p.CNT[tid] = 0;
  for (int idx = blockIdx.x * NTHR + tid; idx < 9 * 6144; idx += gridDim.x * NTHR) {
    int r = idx / 6144, j = idx - r * 6144;
    const float* cv = (r < 8) ? (p.c + r * D) : p.c_ctx;
    float acc = 0.f;
    for (int k = 0; k < D; ++k) acc += silu_f(cv[k]) * p.w_ada[(size_t)k * 6144 + j];
    p.MOD[idx] = acc + p.b_ada[j];
  }
}

__device__ void ph_filters(const Params& p, float* sm) {
  const int tid = threadIdx.x;
  float* feats = sm;
  float* h1 = sm + 32;
  float* h2 = sm + 96;
  for (int t = blockIdx.x; t < L; t += gridDim.x) {
    const float tn = (float)t / (float)(L - 1);
    if (tid < 17) {
      float f;
      if (tid == 0) f = tn;
      else {
        int i = (tid - 1) & 7;
        double band = 1e-4 + (double)i * ((7.0 - 1e-4) / 7.0);
        float bandf = (float)band;
        float ang = (float)(2.0 * 3.14159265358979323846 / (double)L) * (float)t * bandf;
        f = (tid <= 8) ? cosf(ang) : -sinf(ang);
      }
      feats[tid] = f;
    }
    __syncthreads();
    if (tid < 64) {
      float a = p.f_b1[tid];
      for (int i = 0; i < 17; ++i) a += feats[i] * p.f_w1[i * 64 + tid];
      h1[tid] = sinf(p.f_freq[tid] * a);
    }
    __syncthreads();
    if (tid < 64) {
      float a = p.f_b2[tid];
      for (int i = 0; i < 64; ++i) a += h1[i] * p.f_w2[i * 64 + tid];
      h2[tid] = sinf(p.f_freq[tid] * a);
    }
    __syncthreads();
    for (int col = tid; col < 2048; col += NTHR) {
      float a = 0.f;
      for (int i = 0; i < 64; ++i) a += h2[i] * p.f_w3[i * 2048 + col];
      int cch = col & 511;
      const float d0 = -4.605170185988091f / 1.5f, d1 = -4.605170185988091f / 0.3f;
      float delta = fabsf(d0 + (float)cch * ((d1 - d0) / 511.f));
      p.FILT[(size_t)t * 2048 + col] = a * expf(-tn * delta);
    }
    __syncthreads();
  }
}

__device__ __forceinline__ void cvt_tile(const float* src, int ld, int k0, int n0, bf16_t* dst, int ldd, int drow0, float* sm) {
  const int tid = threadIdx.x;
  float* ts = sm;
  for (int e = tid; e < 1024; e += NTHR) {
    int k = e >> 4, n4 = (e & 15) * 4;
    float4 v = *(const float4*)(src + (size_t)(k0 + k) * ld + n0 + n4);
    ts[k * 65 + n4 + 0] = v.x; ts[k * 65 + n4 + 1] = v.y; ts[k * 65 + n4 + 2] = v.z; ts[k * 65 + n4 + 3] = v.w;
  }
  __syncthreads();
  {
    int n = tid >> 3, kq = (tid & 7) * 8;
    uint4 w;
    w.x = cvt_pk_bf16(ts[(kq + 0) * 65 + n], ts[(kq + 1) * 65 + n]);
    w.y = cvt_pk_bf16(ts[(kq + 2) * 65 + n], ts[(kq + 3) * 65 + n]);
    w.z = cvt_pk_bf16(ts[(kq + 4) * 65 + n], ts[(kq + 5) * 65 + n]);
    w.w = cvt_pk_bf16(ts[(kq + 6) * 65 + n], ts[(kq + 7) * 65 + n]);
    *(uint4*)(dst + (size_t)(drow0 + n) * ldd + k0 + kq) = w;
  }
  __syncthreads();
}

__device__ void ph_wcvt(const Params& p, float* sm) {
  for (int it = blockIdx.x; it < 768 + 256; it += gridDim.x) {
    if (it < 768) { int kt = it / 48, nt = it - kt * 48; cvt_tile(p.w_in, DIN, kt * 64, nt * 64, p.WinT, D, nt * 64, sm); }
    else { int i = it - 768; int kt = i >> 4, nt = i & 15; cvt_tile(p.w_out, D, kt * 64, nt * 64, p.WoutT, D, nt * 64, sm); }
  }
}

__device__ void ph_norm1(const Params& p, float* sm) {
  const int tid = threadIdx.x, wid = tid >> 6, lane = tid & 63;
  float* wdt = sm;
  float* xs = sm + 16448 + wid * 1056;
  for (int e = tid; e < 4096; e += NTHR) {
    int k = e >> 2, q = e & 3;
    float4 v = *(const float4*)(p.w_in + (size_t)k * DIN + COL_DT + q * 4);
    *(float4*)(wdt + k * 16 + (k >> 8) * 16 + q * 4) = v;
  }
  __syncthreads();
  for (int row = blockIdx.x * 8 + wid; row < TT; row += gridDim.x * 8) {
    const float* src = (row < T) ? (p.x + (size_t)row * D) : (p.ctx + (size_t)(row - T) * D);
    const int mr = (row < T) ? (row / L) : 8;
    const float* sh = p.MOD + mr * 6144;
    const float* sc = sh + 1024;
    float4 v[4];
    float ss = 0.f;
#pragma unroll
    for (int i = 0; i < 4; ++i) {
      v[i] = *(const float4*)(src + i * 256 + lane * 4);
      ss += v[i].x * v[i].x + v[i].y * v[i].y + v[i].z * v[i].z + v[i].w * v[i].w;
    }
    ss = wave_sum(ss);
    const float rstd = rsqrtf(ss * (1.f / D) + EPS);
#pragma unroll
    for (int i = 0; i < 4; ++i) {
      const int col = i * 256 + lane * 4;
      float4 g = *(const float4*)(p.g1 + col);
      float4 s4 = *(const float4*)(sc + col);
      float4 h4 = *(const float4*)(sh + col);
      float4 o;
      o.x = v[i].x * rstd * g.x * (1.f + s4.x) + h4.x;
      o.y = v[i].y * rstd * g.y * (1.f + s4.y) + h4.y;
      o.z = v[i].z * rstd * g.z * (1.f + s4.z) + h4.z;
      o.w = v[i].w * rstd * g.w * (1.f + s4.w) + h4.w;
      uint2 w; w.x = cvt_pk_bf16(o.x, o.y); w.y = cvt_pk_bf16(o.z, o.w);
      *(uint2*)(p.XNb + (size_t)row * D + col) = w;
      *(float4*)(xs + col + i * 8) = o;
    }
    {
      const int j = lane & 15, ks = lane >> 4;
      const float* xp = xs + ks * 256 + ks * 8;
      const float* wp = wdt + (ks * 256) * 16 + ks * 16 + j;
      float a = 0.f;
#pragma unroll 8
      for (int k = 0; k < 256; ++k) a += xp[k] * wp[k * 16];
      a += __shfl_xor(a, 16);
      a += __shfl_xor(a, 32);
      if (lane < 16) p.DT[(size_t)row * 16 + j] = softplus_f(a + p.dt_bias[j]);
    }
  }
}

__device__ __forceinline__ float hy_u(const Params& p, int row, int col) {
  const int i = row & 63;
  const bf16_t* px = p.PXb + (size_t)row * DP + col;
  float v = p.hy_conv_b[col] + p.hy_conv_w[HYC + col] * bf2f(px[0]);
  if (i > 0) v += p.hy_conv_w[col] * bf2f(px[-DP]);
  if (i < 63) v += p.hy_conv_w[2 * HYC + col] * bf2f(px[DP]);
  return v;
}

__device__ void hyena_item(const Params& p, int item, int o, float* sm) {
  const int tid = threadIdx.x;
  const int tt = item & 31, ct = (item >> 5) & 7, b = item >> 8;
  const int t0 = tt * 64, c0 = ct * 64;
  const int c = tid & 63, tg = tid >> 6;
  float* zs = sm;
  float* fs = sm + 4096;
  float acc[8];
#pragma unroll
  for (int i = 0; i < 8; ++i) acc[i] = 0.f;
  for (int s0 = 0; s0 < L; s0 += 64) {
    for (int e = tid; e < 4096; e += NTHR) {
      int sj = e >> 6, cc = e & 63;
      int row = b * L + s0 + sj;
      zs[e] = (o == 0) ? hy_u(p, row, c0 + cc) : p.Z1[(size_t)row * DH + c0 + cc];
    }
    for (int e = tid; e < 127 * 64; e += NTHR) {
      int di = e >> 6, cc = e & 63;
      int d = t0 - s0 - 63 + di;
      float f;
      if (d >= 0) f = p.FILT[(size_t)d * 2048 + o * 1024 + c0 + cc];
      else f = p.FILT[(size_t)(-d) * 2048 + o * 1024 + 512 + c0 + cc];
      fs[e] = f;
    }
    __syncthreads();
#pragma unroll 4
    for (int sj = 0; sj < 64; ++sj) {
      float zv = zs[sj * 64 + c];
      const float* fp = fs + (tg * 8 - sj + 63) * 64 + c;
#pragma unroll
      for (int i = 0; i < 8; ++i) acc[i] += fp[i * 64] * zv;
    }
    __syncthreads();
  }
#pragma unroll
  for (int i = 0; i < 8; ++i) {
    int t = t0 + tg * 8 + i;
    int row = b * L + t;
    float zt = (o == 0) ? hy_u(p, row, c0 + c) : p.Z1[(size_t)row * DH + c0 + c];
    float conv = acc[i] + zt * p.hy_bias[o * 512 + c0 + c];
    float gate = hy_u(p, row, (o + 1) * 512 + c0 + c);
    float outv = gate * conv;
    if (o == 0) p.Z1[(size_t)row * DH + c0 + c] = outv;
    else p.YMIXb[(size_t)row * D + c0 + c] = f2bf(outv);
  }
}

__device__ void ph_ssd_prep(const Params& p) {
  const int tid = threadIdx.x;
  for (int row = blockIdx.x; row < TT; row += gridDim.x) {
    bool has_prev, has_next;
    if (row < T) { int i = row & 63; has_prev = i > 0; has_next = i < 63; }
    else { int i = (row - T) & (LC - 1); has_prev = i > 0; has_next = i < LC - 1; }
    const bf16_t* px = p.PXb + (size_t)row * DP + COL_XBC;
    for (int ch = tid; ch < DXBC; ch += NTHR) {
      float v = p.ssd_conv_b[ch] + p.ssd_conv_w[DXBC + ch] * bf2f(px[ch]);
      if (has_prev) v += p.ssd_conv_w[ch] * bf2f(px[ch - DP]);
      if (has_next) v += p.ssd_conv_w[2 * DXBC + ch] * bf2f(px[ch + DP]);
      p.XBCb[(size_t)row * DXBC + ch] = f2bf(silu_f(v));
    }
  }
}

__device__ void ssd_scan_item(const Params& p, int item) {
  const int tid = threadIdx.x;
  const int dir = item & 1, h = (item >> 1) & 7, b = item >> 4;
  const int g = h >> 2;
  const int pch = tid >> 3, q = tid & 7;
  const float A = expf(p.a_log[dir * 8 + h]);
  float* Y = dir ? p.YB : p.YF;
  float st[16];
#pragma unroll
  for (int j = 0; j < 16; ++j) st[j] = 0.f;
  const int nsteps = LC + L;
  for (int s = 0; s < nsteps; ++s) {
    int row; bool latent;
    if (s < LC) { int t = dir ? (LC - 1 - s) : s; row = T + b * LC + t; latent = false; }
    else { int t = dir ? (L - 1 - (s - LC)) : (s - LC); row = b * L + t; latent = true; }
    const bf16_t* xb = p.XBCb + (size_t)row * DXBC;
    float dtv = p.DT[(size_t)row * 16 + dir * 8 + h];
    float dec = expf(-A * dtv);
    float xv = bf2f(xb[h * 64 + pch]) * dtv;
    const uint4* Bp = (const uint4*)(xb + 512 + g * 128 + q * 16);
    const uint4* Cp = (const uint4*)(xb + 768 + g * 128 + q * 16);
    float y = 0.f;
#pragma unroll
    for (int j8 = 0; j8 < 2; ++j8) {
      uint4 bv = Bp[j8], cv = Cp[j8];
      unsigned bw[4] = {bv.x, bv.y, bv.z, bv.w};
      unsigned cw[4] = {cv.x, cv.y, cv.z, cv.w};
#pragma unroll
      for (int u = 0; u < 4; ++u) {
        float b0 = __uint_as_float(bw[u] << 16), b1 = __uint_as_float(bw[u] & 0xffff0000u);
        float c0 = __uint_as_float(cw[u] << 16), c1 = __uint_as_float(cw[u] & 0xffff0000u);
        st[j8 * 8 + u * 2 + 0] = dec * st[j8 * 8 + u * 2 + 0] + b0 * xv; y += c0 * st[j8 * 8 + u * 2 + 0];
        st[j8 * 8 + u * 2 + 1] = dec * st[j8 * 8 + u * 2 + 1] + b1 * xv; y += c1 * st[j8 * 8 + u * 2 + 1];
      }
    }
    if (latent) {
      y += __shfl_xor(y, 1);
      y += __shfl_xor(y, 2);
      y += __shfl_xor(y, 4);
      if (q == 0) Y[(size_t)row * DS + h * 64 + pch] = y;
    }
  }
}

__device__ void ph_ssd_finish(const Params& p, float* sm) {
  const int tid = threadIdx.x, wid = tid >> 6;
  for (int row = blockIdx.x; row < T; row += gridDim.x) {
    const int ch = tid;
    float xs = bf2f(p.XBCb[(size_t)row * DXBC + ch]);
    float y = p.YF[(size_t)row * DS + ch] + p.YB[(size_t)row * DS + ch] + p.ssd_d[ch >> 6] * xs;
    float z = bf2f(p.PXb[(size_t)row * DP + COL_Z + ch]);
    float yv = y * silu_f(z);
    float s = wave_sum(yv * yv);
    __syncthreads();
    if ((tid & 63) == 0) sm[wid] = s;
    __syncthreads();
    const int hb = (wid >> 2) * 4;
    float tot = sm[hb] + sm[hb + 1] + sm[hb + 2] + sm[hb + 3];
    float r = rsqrtf(tot * (1.f / 256.f) + EPS);
    p.YMIXb[(size_t)row * D + 512 + ch] = f2bf(yv * r * p.ssd_norm_g[ch]);
  }
}

__device__ void ph_router(const Params& p, float* sm) {
  const int tid = threadIdx.x, wid = tid >> 6, lane = tid & 63;
  float* hs = sm + wid * 1200;
  float* lg = hs + 1024;
  for (int row = blockIdx.x * 8 + wid; row < T; row += gridDim.x * 8) {
    const float* src = p.X1 + (size_t)row * D;
    const float* sh = p.MOD + (row / L) * 6144 + 3072;
    const float* sc = sh + 1024;
    float4 v[4];
    float ss = 0.f;
#pragma unroll
    for (int i = 0; i < 4; ++i) {
      v[i] = *(const float4*)(src + i * 256 + lane * 4);
      ss += v[i].x * v[i].x + v[i].y * v[i].y + v[i].z * v[i].z + v[i].w * v[i].w;
    }
    ss = wave_sum(ss);
    const float rstd = rsqrtf(ss * (1.f / D) + EPS);
#pragma unroll
    for (int i = 0; i < 4; ++i) {
      const int col = i * 256 + lane * 4;
      float4 g = *(const float4*)(p.g2 + col);
      float4 s4 = *(const float4*)(sc + col);
      float4 h4 = *(const float4*)(sh + col);
      float4 o;
      o.x = v[i].x * rstd * g.x * (1.f + s4.x) + h4.x;
      o.y = v[i].y * rstd * g.y * (1.f + s4.y) + h4.y;
      o.z = v[i].z * rstd * g.z * (1.f + s4.z) + h4.z;
      o.w = v[i].w * rstd * g.w * (1.f + s4.w) + h4.w;
      *(float4*)(p.H2 + (size_t)row * D + col) = o;
      *(float4*)(hs + col) = o;
    }
    {
      float a = p.b_expert[lane];
      const float* wp = p.w_expert + lane;
#pragma unroll 8
      for (int k = 0; k < D; ++k) a += hs[k] * wp[k * 64];
      lg[lane] = a;
      const int j = lane & 7, ks = lane >> 3;
      float gsum = 0.f;
      const float* gp = p.w_group + (ks * 128) * 8 + j;
      const float* hp = hs + ks * 128;
#pragma unroll 8
      for (int k = 0; k < 128; ++k) gsum += hp[k] * gp[k * 8];
      gsum += __shfl_xor(gsum, 8);
      gsum += __shfl_xor(gsum, 16);
      gsum += __shfl_xor(gsum, 32);
      if (lane < 8) lg[64 + lane] = gsum + p.b_group[lane];
    }
    if (lane == 0) {
      int gs = 0; float gm = lg[64];
      for (int j = 1; j < 8; ++j) if (lg[64 + j] > gm) { gm = lg[64 + j]; gs = j; }
      float den = 0.f;
      for (int j = 0; j < 8; ++j) den += expf(lg[64 + j] - gm);
      float pg = 1.f / den;
      const float* el = lg + gs * 8;
      int i0 = 0; float l0 = el[0];
      for (int j = 1; j < 8; ++j) if (el[j] > l0) { l0 = el[j]; i0 = j; }
      int i1 = -1; float l1 = -3.0e38f;
      for (int j = 0; j < 8; ++j) if (j != i0 && el[j] > l1) { l1 = el[j]; i1 = j; }
      float e1 = expf(l1 - l0);
      float w0 = 1.f / (1.f + e1), w1 = e1 / (1.f + e1);
      p.GATE[row * 2 + 0] = w0 * pg;
      p.GATE[row * 2 + 1] = w1 * pg;
      int ea = gs * 8 + i0, eb = gs * 8 + i1;
      int sa = atomicAdd(&p.CNT[ea], 1);
      p.LIST[ea * T + sa] = row * 2 + 0;
      int sb = atomicAdd(&p.CNT[eb], 1);
      p.LIST[eb * T + sb] = row * 2 + 1;
    }
  }
}

__device__ __forceinline__ void gemm128(float (&acc)[4][4], const float* arow, const float* B, int ldb, int K, int n0, float* sm) {
  const int tid = threadIdx.x;
  float* As = sm;
  float* Bs = sm + 16 * 132;
  const int am = tid >> 2, akq = (tid & 3) * 4;
  const int bk = (tid & 255) >> 4, bnq = (tid & 15) * 4;
  const bool bload = tid < 256;
  const int ty = tid >> 4, tx = tid & 15;
  for (int k0 = 0; k0 < K; k0 += 16) {
    float4 av = make_float4(0.f, 0.f, 0.f, 0.f);
    if (arow) av = *(const float4*)(arow + k0 + akq);
    As[(akq + 0) * 132 + am] = av.x;
    As[(akq + 1) * 132 + am] = av.y;
    As[(akq + 2) * 132 + am] = av.z;
    As[(akq + 3) * 132 + am] = av.w;
    if (bload) *(float4*)&Bs[bk * 64 + bnq] = *(const float4*)(B + (size_t)(k0 + bk) * ldb + n0 + bnq);
    __syncthreads();
#pragma unroll
    for (int kk = 0; kk < 16; ++kk) {
      float4 a = *(const float4*)&As[kk * 132 + ty * 4];
      float4 b = *(const float4*)&Bs[kk * 64 + tx * 4];
      float aa[4] = {a.x, a.y, a.z, a.w};
      float bb[4] = {b.x, b.y, b.z, b.w};
#pragma unroll
      for (int i = 0; i < 4; ++i)
#pragma unroll
        for (int j = 0; j < 4; ++j) acc[i][j] += aa[i] * bb[j];
    }
    __syncthreads();
  }
}

__device__ __forceinline__ void moe_prefix(const Params& p, int* pre) {
  if (threadIdx.x == 0) {
    int a = 0;
    for (int e = 0; e < NE; ++e) { pre[e] = a; a += (p.CNT[e] + 127) >> 7; }
    pre[NE] = a;
  }
  __syncthreads();
}

__device__ void ph_expert_up(const Params& p, float* sm) {
  const int tid = threadIdx.x;
  int* pre = (int*)(sm + 16 * 132 + 16 * 64);
  moe_prefix(p, pre);
  const int total = pre[NE] * 8;
  for (int item = blockIdx.x; item < total; item += gridDim.x) {
    int mtg = item >> 3, nt = item & 7;
    int e = 0;
    while (pre[e + 1] <= mtg) ++e;
    int mt = mtg - pre[e];
    int cnt = p.CNT[e];
    int m0 = mt * 128, n0 = nt * 64;
    int ml = m0 + (tid >> 2);
    const float* arow = nullptr;
    if (ml < cnt) arow = p.H2 + (size_t)(p.LIST[e * T + ml] >> 1) * D;
    float acc1[4][4] = {}, acc3[4][4] = {};
    gemm128(acc1, arow, p.w1 + (size_t)e * D * DE, DE, D, n0, sm);
    gemm128(acc3, arow, p.w3 + (size_t)e * D * DE, DE, D, n0, sm);
    const int ty = tid >> 4, tx = tid & 15;
#pragma unroll
    for (int i = 0; i < 4; ++i) {
      int m = m0 + ty * 4 + i;
      if (m < cnt) {
        int pair = p.LIST[e * T + m];
        float4 o;
        o.x = silu_f(acc1[i][0]) * acc3[i][0];
        o.y = silu_f(acc1[i][1]) * acc3[i][1];
        o.z = silu_f(acc1[i][2]) * acc3[i][2];
        o.w = silu_f(acc1[i][3]) * acc3[i][3];
        *(float4*)(p.HB + (size_t)pair * DE + n0 + tx * 4) = o;
      }
    }
  }
}

__device__ void ph_expert_down(const Params& p, float* sm) {
  const int tid = threadIdx.x;
  int* pre = (int*)(sm + 16 * 132 + 16 * 64);
  moe_prefix(p, pre);
  const int total = pre[NE] * 16;
  for (int item = blockIdx.x; item < total; item += gridDim.x) {
    int mtg = item >> 4, nt = item & 15;
    int e = 0;
    while (pre[e + 1] <= mtg) ++e;
    int mt = mtg - pre[e];
    int cnt = p.CNT[e];
    int m0 = mt * 128, n0 = nt * 64;
    int ml = m0 + (tid >> 2);
    const float* arow = nullptr;
    if (ml < cnt) arow = p.HB + (size_t)p.LIST[e * T + ml] * DE;
    float acc[4][4] = {};
    gemm128(acc, arow, p.w2 + (size_t)e * DE * D, D, DE, n0, sm);
    const int ty = tid >> 4, tx = tid & 15;
#pragma unroll
    for (int i = 0; i < 4; ++i) {
      int m = m0 + ty * 4 + i;
      if (m < cnt) {
        int pair = p.LIST[e * T + m];
        float gt = p.GATE[pair];
        uint2 w; w.x = cvt_pk_bf16(gt * acc[i][0], gt * acc[i][1]); w.y = cvt_pk_bf16(gt * acc[i][2], gt * acc[i][3]);
        *(uint2*)(p.YB2b + (size_t)pair * D + n0 + tx * 4) = w;
      }
    }
  }
}

__device__ void ph_final(const Params& p) {
  const int tid = threadIdx.x, wid = tid >> 6, lane = tid & 63;
  for (int row = blockIdx.x * 8 + wid; row < T; row += gridDim.x * 8) {
    const float* ga2 = p.MOD + (row / L) * 6144 + 5120;
    float4 v[4];
    float ss = 0.f;
#pragma unroll
    for (int i = 0; i < 4; ++i) {
      const int col = i * 256 + lane * 4;
      float4 xv = *(const float4*)(p.X1 + (size_t)row * D + col);
      uint2 a = *(const uint2*)(p.YB2b + (size_t)(row * 2) * D + col);
      uint2 b = *(const uint2*)(p.YB2b + (size_t)(row * 2 + 1) * D + col);
      float4 ga = *(const float4*)(ga2 + col);
      v[i].x = xv.x + ga.x * (__uint_as_float(a.x << 16) + __uint_as_float(b.x << 16));
      v[i].y = xv.y + ga.y * (__uint_as_float(a.x & 0xffff0000u) + __uint_as_float(b.x & 0xffff0000u));
      v[i].z = xv.z + ga.z * (__uint_as_float(a.y << 16) + __uint_as_float(b.y << 16));
      v[i].w = xv.w + ga.w * (__uint_as_float(a.y & 0xffff0000u) + __uint_as_float(b.y & 0xffff0000u));
      ss += v[i].x * v[i].x + v[i].y * v[i].y + v[i].z * v[i].z + v[i].w * v[i].w;
    }
    ss = wave_sum(ss);
    const float rstd = rsqrtf(ss * (1.f / D) + EPS);
#pragma unroll
    for (int i = 0; i < 4; ++i) {
      const int col = i * 256 + lane * 4;
      float4 gf = *(const float4*)(p.g_final + col);
      float4 o;
      o.x = v[i].x * rstd * gf.x; o.y = v[i].y * rstd * gf.y; o.z = v[i].z * rstd * gf.z; o.w = v[i].w * rstd * gf.w;
      *(float4*)(p.out + (size_t)row * D + col) = o;
    }
  }
}

constexpr int NPHASE = 11;

__global__ void __launch_bounds__(NTHR, 2) mega(Params p) {
  extern __shared__ __attribute__((aligned(16))) unsigned char lds_raw[];
  float* sm = (float*)lds_raw;
  PG8_LAS unsigned char* lds = (PG8_LAS unsigned char*)lds_raw;
  cg::grid_group grid = cg::this_grid();
  const int lo = p.lo, hi = p.hi;
#define IN(k) (lo <= (k) && (k) < hi)
#define SYNC(k) do { if (IN(k) && IN((k) + 1)) grid.sync(); } while (0)
#ifndef SKIP_OTHER
  if (IN(0)) { ph_adaln(p); ph_filters(p, sm); ph_wcvt(p, sm); }
  SYNC(0);
  if (IN(1)) ph_norm1(p, sm);
  SYNC(1);
#endif
#ifndef SKIP_GEMM
  if (IN(2)) {
    pg8::Gemm g{p.XNb, p.WinT, TT, DP, D};
    pg8::StaticOrder S; S.init(TT, DP, gridDim.x, blockIdx.x);
    pg8::EpiBf16 E{p.PXb, DP};
    pg8::gemm_phase<pg8::EpiBf16, pg8::StaticOrder>(lds, g, S, E);
  }
  SYNC(2);
#endif
#ifndef SKIP_OTHER
  if (IN(3)) {
    ph_ssd_prep(p);
    for (int it = blockIdx.x; it < 2048; it += gridDim.x) hyena_item(p, it, 0, sm);
  }
  SYNC(3);
  if (IN(4)) {
    for (int it = blockIdx.x; it < 128 + 2048; it += gridDim.x) {
      if (it < 128) ssd_scan_item(p, it); else hyena_item(p, it - 128, 1, sm);
    }
  }
  SYNC(4);
  if (IN(5)) ph_ssd_finish(p, sm);
  SYNC(5);
#endif
#ifndef SKIP_GEMM
  if (IN(6)) {
    pg8::Gemm g{p.YMIXb, p.WoutT, T, D, D};
    pg8::StaticOrder S; S.init(T, D, gridDim.x, blockIdx.x);
    pg8::EpiX1 E{p.x, p.MOD, p.X1};
    pg8::gemm_phase<pg8::EpiX1, pg8::StaticOrder>(lds, g, S, E);
  }
  SYNC(6);
#endif
#ifndef SKIP_OTHER
  if (IN(7)) ph_router(p, sm);
  SYNC(7);
  if (IN(8)) ph_expert_up(p, sm);
  SYNC(8);
  if (IN(9)) ph_expert_down(p, sm);
  SYNC(9);
  if (IN(10)) ph_final(p);
#endif
#undef IN
#undef SYNC
}

extern "C" void kernel_launch(void* const* d_in, const int* in_sizes, int n_in, void* d_out, int out_size,
                              void* d_ws, size_t ws_size, hipStream_t stream) {
  Params p{};
  const float* const* in = (const float* const*)d_in;
  p.x = in[0]; p.c = in[1]; p.ctx = in[2]; p.c_ctx = in[3]; p.w_ada = in[4]; p.b_ada = in[5];
  p.g1 = in[6]; p.g2 = in[7]; p.w_in = in[8]; p.hy_conv_w = in[9]; p.hy_conv_b = in[10];
  p.f_w1 = in[11]; p.f_b1 = in[12]; p.f_freq = in[13]; p.f_w2 = in[14]; p.f_b2 = in[15]; p.f_w3 = in[16];
  p.hy_bias = in[17]; p.ssd_conv_w = in[18]; p.ssd_conv_b = in[19]; p.a_log = in[20]; p.dt_bias = in[21];
  p.ssd_d = in[22]; p.ssd_norm_g = in[23]; p.w_out = in[24]; p.w_group = in[25]; p.b_group = in[26];
  p.w_expert = in[27]; p.b_expert = in[28]; p.w1 = in[29]; p.w3 = in[30]; p.w2 = in[31]; p.g_final = in[32];
  p.out = (float*)d_out;

  char* ws = (char*)d_ws;
  size_t off = 0;
  auto take = [&](size_t bytes) { char* r = ws + off; off += (bytes + 255) & ~(size_t)255; return r; };
  p.MOD = (float*)take((size_t)9 * 6144 * 4);
  p.CNT = (int*)take(NE * 4);
  p.GATE = (float*)take((size_t)T * 2 * 4);
  p.LIST = (int*)take((size_t)NE * T * 4);
  p.DT = (float*)take((size_t)TT * 16 * 4);
  p.FILT = (float*)take((size_t)L * 2048 * 4);
  p.WinT = (bf16_t*)take((size_t)DP * D * 2);
  p.WoutT = (bf16_t*)take((size_t)D * D * 2);
  char* rPX = take((size_t)TT * DP * 2);
  char* rXBC = take((size_t)TT * DXBC * 2);
  char* rZ1 = take((size_t)T * DH * 4);
  char* rYF = take((size_t)T * DS * 4);
  char* rYB = take((size_t)T * DS * 4);
  char* rYM = take((size_t)T * D * 2);
  p.PXb = (bf16_t*)rPX; p.XBCb = (bf16_t*)rXBC; p.Z1 = (float*)rZ1; p.YF = (float*)rYF; p.YB = (float*)rYB; p.YMIXb = (bf16_t*)rYM;
  p.XNb = (bf16_t*)rZ1;
  p.X1 = (float*)rPX;
  p.H2 = (float*)rXBC;
  p.HB = (float*)rYF;
  p.YB2b = (bf16_t*)rXBC;
  if (off > ws_size) { fprintf(stderr, "workspace too small: need %zu have %zu\n", off, ws_size); return; }

  static int grid_blocks = 0;
  if (!grid_blocks) {
    int dev = 0, cus = 0, per_cu = 0;
    (void)hipGetDevice(&dev);
    (void)hipDeviceGetAttribute(&cus, hipDeviceAttributeMultiprocessorCount, dev);
    (void)hipFuncSetAttribute((const void*)mega, hipFuncAttributeMaxDynamicSharedMemorySize, LDS_BYTES);
    (void)hipOccupancyMaxActiveBlocksPerMultiprocessor(&per_cu, mega, NTHR, LDS_BYTES);
    if (per_cu < 1) { fprintf(stderr, "occupancy query returned %d\n", per_cu); per_cu = 1; }
    grid_blocks = cus;
  }
#ifndef ONE_LAUNCH
  for (int ph = 0; ph < NPHASE; ++ph) {
    p.lo = ph; p.hi = ph + 1;
    hipLaunchKernelGGL(mega, dim3(grid_blocks), dim3(NTHR), LDS_BYTES, stream, p);
  }
#else
  p.lo = 0; p.hi = NPHASE;
  void* args[] = {&p};
  hipError_t e = hipLaunchCooperativeKernel((void*)mega, dim3(grid_blocks), dim3(NTHR), args, LDS_BYTES, stream);
  if (e != hipSuccess) fprintf(stderr, "cooperative launch failed: %s (grid %d)\n", hipGetErrorString(e), grid_blocks);
#endif
}
```

```cpp
#define ONE_LAUNCH 1
#include <hip/hip_runtime.h>
#include <hip/hip_cooperative_groups.h>
#include <cstdio>
#include <cstdint>
namespace cg = cooperative_groups;

constexpr int D = 1024, NB = 8, L = 2048, LC = 256;
constexpr int T = NB * L;
constexpr int TC = NB * LC;
constexpr int TT = T + TC;
constexpr int DH = 512, HYC = 1536, DS = 512, DXBC = 1024, DIN = 3088, DP = 3072;
constexpr int COL_Z = 1536, COL_XBC = 2048, COL_DT = 3072;
constexpr int NE = 64, DE = 512;
constexpr float EPS = 1e-6f;
constexpr int NTHR = 512;
constexpr int LDS_BYTES = 132 * 1024;

typedef unsigned short bf16_t;

struct Params {
  const float *x, *c, *ctx, *c_ctx, *w_ada, *b_ada, *g1, *g2, *w_in, *hy_conv_w, *hy_conv_b;
  const float *f_w1, *f_b1, *f_freq, *f_w2, *f_b2, *f_w3, *hy_bias;
  const float *ssd_conv_w, *ssd_conv_b, *a_log, *dt_bias, *ssd_d, *ssd_norm_g, *w_out;
  const float *w_group, *b_group, *w_expert, *b_expert, *w1, *w3, *w2, *g_final;
  float* out;
  float *MOD, *FILT, *Z1, *YF, *YB, *DT, *X1, *GATE;
  bf16_t *XNb, *WinT, *WoutT, *PXb, *XBCb, *YMIXb, *YB2b, *Wup, *Wdn, *H2b, *HBb;
  int *CNT, *LIST;
  int lo, hi;
};

__device__ __forceinline__ float silu_f(float v) { return v / (1.f + __expf(-v)); }
__device__ __forceinline__ float softplus_f(float v) { return v > 20.f ? v : log1pf(expf(v)); }
__device__ __forceinline__ float bf2f(bf16_t v) { return __uint_as_float(((unsigned)v) << 16); }
__device__ __forceinline__ unsigned cvt_pk_bf16(float lo, float hi) {
  unsigned r;
  asm volatile("v_cvt_pk_bf16_f32 %0, %1, %2" : "=v"(r) : "v"(lo), "v"(hi));
  return r;
}
__device__ __forceinline__ bf16_t f2bf(float f) { return (bf16_t)(cvt_pk_bf16(f, 0.f) & 0xffffu); }
__device__ __forceinline__ float wave_sum(float v) {
#pragma unroll
  for (int o = 32; o > 0; o >>= 1) v += __shfl_xor(v, o);
  return v;
}

namespace pg8 {
#define PG8_LAS __attribute__((address_space(3)))
typedef short bf16x8 __attribute__((ext_vector_type(8)));
typedef float f32x4 __attribute__((ext_vector_type(4)));
typedef unsigned u32x4 __attribute__((ext_vector_type(4)));
typedef unsigned u32x2 __attribute__((ext_vector_type(2)));
constexpr int BM = 256, BK = 64, HALF = 128, HTB = HALF * BK * 2, STAGE_BYTES = 8 * HTB, NXCD = 8, WGM = 8;

__host__ __device__ __forceinline__ int lds_byte(int r, int c) {
  const int st = (r >> 4) * 2 + (c >> 5), rr = r & 15, cc = c & 31, ob = rr * 64 + cc * 2;
  return st * 1024 + (ob ^ (((ob >> 9) & 1) << 5));
}
__host__ __device__ __forceinline__ void stage_rc(int b, int& R, int& C) {
  const int st = b / 1024, sb = b % 1024, swz = sb ^ (((sb >> 9) & 1) << 5);
  R = (st >> 1) * 16 + swz / 64; C = (st & 1) * 32 + (swz % 64) / 2;
}
__host__ __device__ __forceinline__ int perm32(int rho) { const int n = rho >> 4, i = rho & 15; return 8 * (i >> 2) + 4 * n + (i & 3); }

struct Unit { int pm, pn, e, mu, nv, cnt, seg; };

__device__ __forceinline__ bool static_next(int nM, int nN, int G, int c, int i, int& pm, int& pn) {
  const int nwg = nM * nN;
  const long Lx = (long)i * G + c; if (Lx >= nwg) return false;
  int wgid = (int)Lx;
  { const int q = nwg / NXCD, r = nwg % NXCD, xcd = wgid % NXCD, off = wgid / NXCD; wgid = (xcd < r ? xcd * (q + 1) : r * (q + 1) + (xcd - r) * q) + off; }
  const int nig = WGM * nN, gid = wgid / nig, fm = gid * WGM, gsz = (nM - fm) < WGM ? (nM - fm) : WGM;
  pm = fm + ((wgid % nig) % gsz); pn = (wgid % nig) / gsz; return true;
}

struct DenseOrder {
  const bf16_t* A; const bf16_t* Bt; int nM, nN, K, G, c;
  __device__ __forceinline__ bool next(int i, Unit& u) const {
    if (!static_next(nM, nN, G, c, i, u.pm, u.pn)) return false;
    u.e = 0; u.mu = 0; u.nv = 256; u.cnt = 256; u.seg = 0; return true;
  }
  __device__ __forceinline__ const char* a_base() const { return (const char*)A; }
  __device__ __forceinline__ const char* b_ptr(const Unit& u) const { return (const char*)Bt + (size_t)u.pn * 256 * K * 2; }
  __device__ __forceinline__ void a_offs(const Unit& u, const int (&R)[2], const int (&C)[2], unsigned (&ao)[2][2]) const {
#pragma unroll
    for (int h = 0; h < 2; ++h)
#pragma unroll
      for (int i = 0; i < 2; ++i) ao[h][i] = (unsigned)((u.pm * 256 + h * 128 + R[i]) * K + C[i]) * 2u;
  }
};

struct MoeOrder {
  const int* tab; const bf16_t* A; const bf16_t* Bt; const int* list; int NTn, K, G, c; bool gather;
  __device__ __forceinline__ bool next(int i, Unit& u) const {
    const int Lx = i * G + c;
    if (Lx >= tab[64] * NTn) return false;
    const int mg = Lx / NTn; u.pn = Lx - mg * NTn;
    int e = 0;
    while (tab[e + 1] <= mg) ++e;
    u.e = e; u.mu = mg - tab[e]; u.cnt = tab[130 + e]; u.seg = tab[65 + e];
    const int rem = u.cnt - u.mu * 256; u.nv = rem < 256 ? rem : 256; u.pm = 0; return true;
  }
  __device__ __forceinline__ const char* a_base() const { return (const char*)A; }
  __device__ __forceinline__ const char* b_ptr(const Unit& u) const { return (const char*)Bt + ((size_t)u.e * NTn + u.pn) * 256 * K * 2; }
  __device__ __forceinline__ void a_offs(const Unit& u, const int (&R)[2], const int (&C)[2], unsigned (&ao)[2][2]) const {
#pragma unroll
    for (int h = 0; h < 2; ++h)
#pragma unroll
      for (int i = 0; i < 2; ++i) {
        int idx = u.mu * 256 + h * 128 + R[i];
        int row;
        if (gather) { if (idx > u.cnt - 1) idx = u.cnt - 1; row = list[u.e * T + idx] >> 1; }
        else row = u.seg + idx;
        ao[h][i] = (unsigned)(row * K + C[i]) * 2u;
      }
  }
};

struct EpiBf16 {
  static constexpr bool PERM = true;
  bf16_t* O; int ldc;
  __device__ __forceinline__ void operator()(const f32x4 (&acc)[2][2][4][2], const Unit& u, int wr, int wc, int fr, int fq) const {
    const int row0 = u.pm * BM + wr * 64 + fr;
    const int col0 = u.pn * BM + wc * 32 + 8 * fq;
#pragma unroll
    for (int ai = 0; ai < 2; ++ai)
#pragma unroll
      for (int m = 0; m < 4; ++m) {
        bf16_t* rowp = O + (size_t)(row0 + ai * HALF + m * 16) * ldc + col0;
#pragma unroll
        for (int bj = 0; bj < 2; ++bj) {
          f32x4 v0 = acc[ai][bj][m][0], v1 = acc[ai][bj][m][1];
          u32x4 w; w.x = cvt_pk_bf16(v0[0], v0[1]); w.y = cvt_pk_bf16(v0[2], v0[3]); w.z = cvt_pk_bf16(v1[0], v1[1]); w.w = cvt_pk_bf16(v1[2], v1[3]);
          *(u32x4*)(rowp + bj * HALF) = w;
        }
      }
  }
};

struct EpiX1 {
  static constexpr bool PERM = false;
  const float* x; const float* mod; float* X1;
  __device__ __forceinline__ void operator()(const f32x4 (&acc)[2][2][4][2], const Unit& u, int wr, int wc, int fr, int fq) const {
    const int row0 = u.pm * BM + wr * 64 + fr, col0 = u.pn * BM + wc * 32 + 4 * fq;
    const float* ga = mod + ((u.pm * BM) / L) * 6144 + 2048 + col0;
    f32x4 gv[2][2];
#pragma unroll
    for (int bj = 0; bj < 2; ++bj)
#pragma unroll
      for (int n = 0; n < 2; ++n) gv[bj][n] = *(const f32x4*)(ga + bj * HALF + n * 16);
#pragma unroll
    for (int ai = 0; ai < 2; ++ai)
#pragma unroll
      for (int m = 0; m < 4; ++m) {
        const size_t off = (size_t)(row0 + ai * HALF + m * 16) * D + col0;
#pragma unroll
        for (int bj = 0; bj < 2; ++bj)
#pragma unroll
          for (int n = 0; n < 2; ++n) {
            const f32x4 xv = *(const f32x4*)(x + off + bj * HALF + n * 16);
            *(f32x4*)(X1 + off + bj * HALF + n * 16) = xv + gv[bj][n] * acc[ai][bj][m][n];
          }
      }
  }
};

struct EpiSwiGLU {
  static constexpr bool PERM = true;
  bf16_t* HBb;
  __device__ __forceinline__ void operator()(const f32x4 (&acc)[2][2][4][2], const Unit& u, int wr, int wc, int fr, int fq) const {
    const int col0 = u.pn * 128 + wc * 32 + 8 * fq;
#pragma unroll
    for (int ai = 0; ai < 2; ++ai)
#pragma unroll
      for (int m = 0; m < 4; ++m) {
        const int slot = u.mu * 256 + ai * HALF + wr * 64 + m * 16 + fr;
        if (slot < u.cnt) {
          float h[8];
#pragma unroll
          for (int n = 0; n < 2; ++n)
#pragma unroll
            for (int j = 0; j < 4; ++j) { const float a = acc[ai][0][m][n][j]; h[n * 4 + j] = a / (1.f + __expf(-a)) * acc[ai][1][m][n][j]; }
          u32x4 w; w.x = cvt_pk_bf16(h[0], h[1]); w.y = cvt_pk_bf16(h[2], h[3]); w.z = cvt_pk_bf16(h[4], h[5]); w.w = cvt_pk_bf16(h[6], h[7]);
          *(u32x4*)(HBb + (size_t)(u.seg + slot) * DE + col0) = w;
        }
      }
  }
};

struct EpiDown {
  static constexpr bool PERM = true;
  bf16_t* YB2b; const int* list; const float* gate;
  __device__ __forceinline__ void operator()(const f32x4 (&acc)[2][2][4][2], const Unit& u, int wr, int wc, int fr, int fq) const {
    const int col0 = u.pn * 256 + wc * 32 + 8 * fq;
#pragma unroll
    for (int ai = 0; ai < 2; ++ai)
#pragma unroll
      for (int m = 0; m < 4; ++m) {
        const int slot = u.mu * 256 + ai * HALF + wr * 64 + m * 16 + fr;
        if (slot < u.cnt) {
          const int pair = list[u.e * T + slot];
          const float gt = gate[pair];
          bf16_t* rowp = YB2b + (size_t)pair * D + col0;
#pragma unroll
          for (int bj = 0; bj < 2; ++bj) {
            f32x4 v0 = acc[ai][bj][m][0] * gt, v1 = acc[ai][bj][m][1] * gt;
            u32x4 w; w.x = cvt_pk_bf16(v0[0], v0[1]); w.y = cvt_pk_bf16(v0[2], v0[3]); w.z = cvt_pk_bf16(v1[0], v1[1]); w.w = cvt_pk_bf16(v1[2], v1[3]);
            *(u32x4*)(rowp + bj * HALF) = w;
          }
        }
      }
  }
};

template <class Epi, class Sched>
__device__ __forceinline__ void gemm_phase(PG8_LAS unsigned char* lds, const int K, const Sched& S, const Epi& E) {
  const int tid = threadIdx.x, wid = __builtin_amdgcn_readfirstlane(tid >> 6), lane = tid & 63, wr = wid >> 2, wc = wid & 3, fr = lane & 15, fq = lane >> 4;
  const int nt = K / BK;
  int Rr[2], Cc[2];
  unsigned voffB[2];
#pragma unroll
  for (int i = 0; i < 2; ++i) {
    stage_rc(tid * 16 + i * 8192, Rr[i], Cc[i]);
    const int Rb = Epi::PERM ? ((Rr[i] & ~31) + perm32(Rr[i] & 31)) : Rr[i];
    voffB[i] = (unsigned)(Rb * K + Cc[i]) * 2u;
  }
  const size_t kstep = (size_t)(BK * 2);
  const size_t hstep = (size_t)HALF * K * 2;
  const unsigned ldsw = (unsigned)wid * 1024u;
  const int aoff = lds_byte(wr * 64 + fr, fq * 8), boff = lds_byte(wc * 32 + fr, fq * 8);
#define PG8_SA(b, h) (((b) * 2 + (h)) * HTB)
#define PG8_SB(b, h) ((4 + (b) * 2 + (h)) * HTB)
#define PG8_STAGE(bufoff, gbase, voff) do { _Pragma("unroll") for (int _i = 0; _i < 2; ++_i) \
    __builtin_amdgcn_global_load_lds((const unsigned*)((const char*)(gbase) + (voff)[_i]), (PG8_LAS unsigned*)(lds + (bufoff) + ldsw + _i * 8192), 16, 0, 0); } while (0)
#define PG8_LDA(dst, b, h) do { _Pragma("unroll") for (int m = 0; m < 4; ++m) _Pragma("unroll") for (int k = 0; k < 2; ++k) dst[m][k] = *(const PG8_LAS bf16x8*)(lds + PG8_SA(b, h) + aoff + m * 2048 + k * 1024); } while (0)
#define PG8_LDB(dst, b, h) do { _Pragma("unroll") for (int n = 0; n < 2; ++n) _Pragma("unroll") for (int k = 0; k < 2; ++k) dst[n][k] = *(const PG8_LAS bf16x8*)(lds + PG8_SB(b, h) + boff + n * 2048 + k * 1024); } while (0)
#define PG8_MMA(ai, bj, At, Bt) do { __builtin_amdgcn_s_setprio(1); _Pragma("unroll") for (int m = 0; m < 4; ++m) _Pragma("unroll") for (int n = 0; n < 2; ++n) _Pragma("unroll") for (int k = 0; k < 2; ++k) \
    acc[ai][bj][m][n] = __builtin_amdgcn_mfma_f32_16x16x32_bf16(Bt[n][k], At[m][k], acc[ai][bj][m][n], 0, 0, 0); __builtin_amdgcn_s_setprio(0); } while (0)
#define PG8_WAIT_V(n) asm volatile("s_waitcnt vmcnt(" #n ")" ::: "memory")
#define PG8_WAIT_L(n) asm volatile("s_waitcnt lgkmcnt(" #n ")" ::: "memory")
#define PG8_BAR __builtin_amdgcn_s_barrier()
#define PG8_SCHED __builtin_amdgcn_sched_barrier(0)
  Unit cur, nxt; int ui = 0;
  if (!S.next(0, cur)) return;
  f32x4 acc[2][2][4][2];
#pragma unroll
  for (int a = 0; a < 2; ++a)
#pragma unroll
    for (int b = 0; b < 2; ++b)
#pragma unroll
      for (int m = 0; m < 4; ++m)
#pragma unroll
        for (int n = 0; n < 2; ++n) acc[a][b][m][n] = (f32x4){0.f, 0.f, 0.f, 0.f};
  bf16x8 At[4][2], B0[2][2], B1[2][2];
  unsigned cao[2][2], nao[2][2];
  S.a_offs(cur, Rr, Cc, cao);
  const char* const aB = S.a_base();
  const char* cB = S.b_ptr(cur);
  PG8_STAGE(PG8_SB(0, 0), cB, voffB); PG8_STAGE(PG8_SA(0, 0), aB, cao[0]); PG8_STAGE(PG8_SB(0, 1), cB + hstep, voffB); PG8_STAGE(PG8_SA(0, 1), aB, cao[1]);
  if (wr == 1) PG8_BAR;
  PG8_WAIT_V(4); PG8_BAR;
  PG8_STAGE(PG8_SB(1, 0), cB + kstep, voffB); PG8_STAGE(PG8_SA(1, 0), aB + kstep, cao[0]); PG8_STAGE(PG8_SB(1, 1), cB + hstep + kstep, voffB);
  PG8_WAIT_V(6); PG8_BAR;
  for (;;) {
    const bool has_next = S.next(ui + 1, nxt);
    const char* nB = cB;
    if (has_next) { S.a_offs(nxt, Rr, Cc, nao); nB = S.b_ptr(nxt); }
    else {
#pragma unroll
      for (int h = 0; h < 2; ++h)
#pragma unroll
        for (int i = 0; i < 2; ++i) nao[h][i] = cao[h][i];
    }
    const bool full = cur.nv > 128;
    for (int t = 0; t < nt; t += 2) {
      const bool last = (t == nt - 2);
      const char* a1 = aB + (size_t)(t + 1) * kstep;
      const char* a2 = last ? aB : aB + (size_t)(t + 2) * kstep; const char* b2 = last ? nB : cB + (size_t)(t + 2) * kstep;
      const char* a3 = a2 + kstep; const char* b3 = b2 + kstep;
      unsigned so[2][2];
#pragma unroll
      for (int h = 0; h < 2; ++h)
#pragma unroll
        for (int i = 0; i < 2; ++i) so[h][i] = last ? nao[h][i] : cao[h][i];
      PG8_LDB(B0, 0, 0); PG8_SCHED; PG8_LDA(At, 0, 0); PG8_STAGE(PG8_SA(1, 1), a1, cao[1]);
      PG8_WAIT_L(8); PG8_BAR; PG8_WAIT_L(0); PG8_MMA(0, 0, At, B0); PG8_BAR; PG8_SCHED;
      PG8_LDB(B1, 0, 1); PG8_STAGE(PG8_SB(0, 0), b2, voffB);
      PG8_BAR; PG8_WAIT_L(0); PG8_MMA(0, 1, At, B1); PG8_BAR;
      PG8_LDA(At, 0, 1); PG8_STAGE(PG8_SA(0, 0), a2, so[0]);
      PG8_BAR; PG8_WAIT_L(0); if (full) PG8_MMA(1, 0, At, B0); PG8_BAR; PG8_SCHED;
      PG8_STAGE(PG8_SB(0, 1), b2 + hstep, voffB);
      PG8_WAIT_V(6); PG8_BAR; if (full) PG8_MMA(1, 1, At, B1); PG8_BAR;
      PG8_LDB(B0, 1, 0); PG8_SCHED; PG8_LDA(At, 1, 0); PG8_STAGE(PG8_SA(0, 1), a2, so[1]);
      PG8_WAIT_L(8); PG8_BAR; PG8_WAIT_L(0); PG8_MMA(0, 0, At, B0); PG8_BAR; PG8_SCHED;
      PG8_LDB(B1, 1, 1); PG8_STAGE(PG8_SB(1, 0), b3, voffB);
      PG8_BAR; PG8_WAIT_L(0); PG8_MMA(0, 1, At, B1); PG8_BAR;
      PG8_LDA(At, 1, 1); PG8_STAGE(PG8_SA(1, 0), a3, so[0]);
      PG8_BAR; PG8_WAIT_L(0); if (full) PG8_MMA(1, 0, At, B0); PG8_BAR; PG8_SCHED;
      PG8_STAGE(PG8_SB(1, 1), b3 + hstep, voffB);
      PG8_WAIT_V(6); PG8_BAR; if (full) PG8_MMA(1, 1, At, B1); PG8_BAR;
    }
    E(acc, cur, wr, wc, fr, fq);
    if (!has_next) break;
#pragma unroll
    for (int a = 0; a < 2; ++a)
#pragma unroll
      for (int b = 0; b < 2; ++b)
#pragma unroll
        for (int m = 0; m < 4; ++m)
#pragma unroll
          for (int n = 0; n < 2; ++n) acc[a][b][m][n] = (f32x4){0.f, 0.f, 0.f, 0.f};
    cur = nxt; cB = nB; ++ui;
#pragma unroll
    for (int h = 0; h < 2; ++h)
#pragma unroll
      for (int i = 0; i < 2; ++i) cao[h][i] = nao[h][i];
  }
  PG8_WAIT_V(0);
  if (wr == 0) PG8_BAR;
  PG8_BAR;
#undef PG8_SA
#undef PG8_SB
#undef PG8_STAGE
#undef PG8_LDA
#undef PG8_LDB
#undef PG8_MMA
#undef PG8_WAIT_V
#undef PG8_WAIT_L
#undef PG8_BAR
#undef PG8_SCHED
}
}

__device__ void ph_adaln(const Params& p) {
  const int tid = threadIdx.x;
  if (blockIdx.x == 0 && tid < NE) p.CNT[tid] = 0;
  for (int idx = blockIdx.x * NTHR + tid; idx < 9 * 6144; idx += gridDim.x * NTHR) {
    int r = idx / 6144, j = idx - r * 6144;
    const float* cv = (r < 8) ? (p.c + r * D) : p.c_ctx;
    float acc = 0.f;
    for (int k = 0; k < D; ++k) acc += silu_f(cv[k]) * p.w_ada[(size_t)k * 6144 + j];
    p.MOD[idx] = acc + p.b_ada[j];
  }
}

__device__ void ph_filters(const Params& p, float* sm) {
  const int tid = threadIdx.x;
  float* feats = sm;
  float* h1 = sm + 32;
  float* h2 = sm + 96;
  for (int t = blockIdx.x; t < L; t += gridDim.x) {
    const float tn = (float)t / (float)(L - 1);
    if (tid < 17) {
      float f;
      if (tid == 0) f = tn;
      else {
        int i = (tid - 1) & 7;
        double band = 1e-4 + (double)i * ((7.0 - 1e-4) / 7.0);
        float bandf = (float)band;
        float ang = (float)(2.0 * 3.14159265358979323846 / (double)L) * (float)t * bandf;
        f = (tid <= 8) ? cosf(ang) : -sinf(ang);
      }
      feats[tid] = f;
    }
    __syncthreads();
    if (tid < 64) {
      float a = p.f_b1[tid];
      for (int i = 0; i < 17; ++i) a += feats[i] * p.f_w1[i * 64 + tid];
      h1[tid] = sinf(p.f_freq[tid] * a);
    }
    __syncthreads();
    if (tid < 64) {
      float a = p.f_b2[tid];
      for (int i = 0; i < 64; ++i) a += h1[i] * p.f_w2[i * 64 + tid];
      h2[tid] = sinf(p.f_freq[tid] * a);
    }
    __syncthreads();
    for (int col = tid; col < 2048; col += NTHR) {
      float a = 0.f;
      for (int i = 0; i < 64; ++i) a += h2[i] * p.f_w3[i * 2048 + col];
      int cch = col & 511;
      const float d0 = -4.605170185988091f / 1.5f, d1 = -4.605170185988091f / 0.3f;
      float delta = fabsf(d0 + (float)cch * ((d1 - d0) / 511.f));
      p.FILT[(size_t)t * 2048 + col] = a * expf(-tn * delta);
    }
    __syncthreads();
  }
}

__device__ __forceinline__ void cvt_tile(const float* src, int ld, int k0, int n0, bf16_t* dst, int ldd, int drow0, float* sm) {
  const int tid = threadIdx.x;
  float* ts = sm;
  for (int e = tid; e < 1024; e += NTHR) {
    int k = e >> 4, n4 = (e & 15) * 4;
    float4 v = *(const float4*)(src + (size_t)(k0 + k) * ld + n0 + n4);
    ts[k * 65 + n4 + 0] = v.x; ts[k * 65 + n4 + 1] = v.y; ts[k * 65 + n4 + 2] = v.z; ts[k * 65 + n4 + 3] = v.w;
  }
  __syncthreads();
  {
    int n = tid >> 3, kq = (tid & 7) * 8;
    uint4 w;
    w.x = cvt_pk_bf16(ts[(kq + 0) * 65 + n], ts[(kq + 1) * 65 + n]);
    w.y = cvt_pk_bf16(ts[(kq + 2) * 65 + n], ts[(kq + 3) * 65 + n]);
    w.z = cvt_pk_bf16(ts[(kq + 4) * 65 + n], ts[(kq + 5) * 65 + n]);
    w.w = cvt_pk_bf16(ts[(kq + 6) * 65 + n], ts[(kq + 7) * 65 + n]);
    *(uint4*)(dst + (size_t)(drow0 + n) * ldd + k0 + kq) = w;
  }
  __syncthreads();
}

__device__ void ph_wcvt(const Params& p, float* sm) {
  for (int it = blockIdx.x; it < 768 + 256 + 16384 + 8192; it += gridDim.x) {
    if (it < 768) { int kt = it / 48, nt = it - kt * 48; cvt_tile(p.w_in, DIN, kt * 64, nt * 64, p.WinT, D, nt * 64, sm); }
    else if (it < 1024) { int i = it - 768; int kt = i >> 4, nt = i & 15; cvt_tile(p.w_out, D, kt * 64, nt * 64, p.WoutT, D, nt * 64, sm); }
    else if (it < 1024 + 16384) {
      int i = it - 1024; int e = i >> 8, r = i & 255; int which = r >> 7, r2 = r & 127; int kt = r2 >> 3, ct = r2 & 7;
      const float* src = (which ? p.w3 : p.w1) + (size_t)e * D * DE;
      int col0 = ct * 64;
      int drow0 = (col0 >> 7) * 256 + which * 128 + (col0 & 127);
      cvt_tile(src, DE, kt * 64, col0, p.Wup + (size_t)e * 1024 * 1024, D, drow0, sm);
    } else {
      int i = it - 1024 - 16384; int e = i >> 7, r = i & 127; int kt = r >> 4, nt = r & 15;
      cvt_tile(p.w2 + (size_t)e * DE * D, D, kt * 64, nt * 64, p.Wdn + (size_t)e * 1024 * 512, DE, nt * 64, sm);
    }
  }
}

__device__ void ph_norm1(const Params& p, float* sm) {
  const int tid = threadIdx.x, wid = tid >> 6, lane = tid & 63;
  float* wdt = sm;
  float* xs = sm + 16448 + wid * 1056;
  for (int e = tid; e < 4096; e += NTHR) {
    int k = e >> 2, q = e & 3;
    float4 v = *(const float4*)(p.w_in + (size_t)k * DIN + COL_DT + q * 4);
    *(float4*)(wdt + k * 16 + (k >> 8) * 16 + q * 4) = v;
  }
  __syncthreads();
  for (int row = blockIdx.x * 8 + wid; row < TT; row += gridDim.x * 8) {
    const float* src = (row < T) ? (p.x + (size_t)row * D) : (p.ctx + (size_t)(row - T) * D);
    const int mr = (row < T) ? (row / L) : 8;
    const float* sh = p.MOD + mr * 6144;
    const float* sc = sh + 1024;
    float4 v[4];
    float ss = 0.f;
#pragma unroll
    for (int i = 0; i < 4; ++i) {
      v[i] = *(const float4*)(src + i * 256 + lane * 4);
      ss += v[i].x * v[i].x + v[i].y * v[i].y + v[i].z * v[i].z + v[i].w * v[i].w;
    }
    ss = wave_sum(ss);
    const float rstd = rsqrtf(ss * (1.f / D) + EPS);
#pragma unroll
    for (int i = 0; i < 4; ++i) {
      const int col = i * 256 + lane * 4;
      float4 g = *(const float4*)(p.g1 + col);
      float4 s4 = *(const float4*)(sc + col);
      float4 h4 = *(const float4*)(sh + col);
      float4 o;
      o.x = v[i].x * rstd * g.x * (1.f + s4.x) + h4.x;
      o.y = v[i].y * rstd * g.y * (1.f + s4.y) + h4.y;
      o.z = v[i].z * rstd * g.z * (1.f + s4.z) + h4.z;
      o.w = v[i].w * rstd * g.w * (1.f + s4.w) + h4.w;
      uint2 w; w.x = cvt_pk_bf16(o.x, o.y); w.y = cvt_pk_bf16(o.z, o.w);
      *(uint2*)(p.XNb + (size_t)row * D + col) = w;
      *(float4*)(xs + col + i * 8) = o;
    }
    {
      const int j = lane & 15, ks = lane >> 4;
      const float* xp = xs + ks * 256 + ks * 8;
      const float* wp = wdt + (ks * 256) * 16 + ks * 16 + j;
      float a = 0.f;
#pragma unroll 8
      for (int k = 0; k < 256; ++k) a += xp[k] * wp[k * 16];
      a += __shfl_xor(a, 16);
      a += __shfl_xor(a, 32);
      if (lane < 16) p.DT[(size_t)row * 16 + j] = softplus_f(a + p.dt_bias[j]);
    }
  }
}

__device__ __forceinline__ float hy_u(const Params& p, int row, int col) {
  const int i = row & 63;
  const bf16_t* px = p.PXb + (size_t)row * DP + col;
  float v = p.hy_conv_b[col] + p.hy_conv_w[HYC + col] * bf2f(px[0]);
  if (i > 0) v += p.hy_conv_w[col] * bf2f(px[-DP]);
  if (i < 63) v += p.hy_conv_w[2 * HYC + col] * bf2f(px[DP]);
  return v;
}

__device__ void hyena_item(const Params& p, int item, int o, float* sm) {
  const int tid = threadIdx.x;
  const int tt = item & 31, ct = (item >> 5) & 7, b = item >> 8;
  const int t0 = tt * 64, c0 = ct * 64;
  const int c = tid & 63, tg = tid >> 6;
  float* zs = sm;
  float* fs = sm + 4096;
  float acc[8];
#pragma unroll
  for (int i = 0; i < 8; ++i) acc[i] = 0.f;
  for (int s0 = 0; s0 < L; s0 += 64) {
    for (int e = tid; e < 4096; e += NTHR) {
      int sj = e >> 6, cc = e & 63;
      int row = b * L + s0 + sj;
      zs[e] = (o == 0) ? hy_u(p, row, c0 + cc) : p.Z1[(size_t)row * DH + c0 + cc];
    }
    for (int e = tid; e < 127 * 64; e += NTHR) {
      int di = e >> 6, cc = e & 63;
      int d = t0 - s0 - 63 + di;
      float f;
      if (d >= 0) f = p.FILT[(size_t)d * 2048 + o * 1024 + c0 + cc];
      else f = p.FILT[(size_t)(-d) * 2048 + o * 1024 + 512 + c0 + cc];
      fs[e] = f;
    }
    __syncthreads();
#pragma unroll 4
    for (int sj = 0; sj < 64; ++sj) {
      float zv = zs[sj * 64 + c];
      const float* fp = fs + (tg * 8 - sj + 63) * 64 + c;
#pragma unroll
      for (int i = 0; i < 8; ++i) acc[i] += fp[i * 64] * zv;
    }
    __syncthreads();
  }
#pragma unroll
  for (int i = 0; i < 8; ++i) {
    int t = t0 + tg * 8 + i;
    int row = b * L + t;
    float zt = (o == 0) ? hy_u(p, row, c0 + c) : p.Z1[(size_t)row * DH + c0 + c];
    float conv = acc[i] + zt * p.hy_bias[o * 512 + c0 + c];
    float gate = hy_u(p, row, (o + 1) * 512 + c0 + c);
    float outv = gate * conv;
    if (o == 0) p.Z1[(size_t)row * DH + c0 + c] = outv;
    else p.YMIXb[(size_t)row * D + c0 + c] = f2bf(outv);
  }
}

__device__ void ph_ssd_prep(const Params& p) {
  const int tid = threadIdx.x;
  for (int row = blockIdx.x; row < TT; row += gridDim.x) {
    bool has_prev, has_next;
    if (row < T) { int i = row & 63; has_prev = i > 0; has_next = i < 63; }
    else { int i = (row - T) & (LC - 1); has_prev = i > 0; has_next = i < LC - 1; }
    const bf16_t* px = p.PXb + (size_t)row * DP + COL_XBC;
    for (int ch = tid; ch < DXBC; ch += NTHR) {
      float v = p.ssd_conv_b[ch] + p.ssd_conv_w[DXBC + ch] * bf2f(px[ch]);
      if (has_prev) v += p.ssd_conv_w[ch] * bf2f(px[ch - DP]);
      if (has_next) v += p.ssd_conv_w[2 * DXBC + ch] * bf2f(px[ch + DP]);
      p.XBCb[(size_t)row * DXBC + ch] = f2bf(silu_f(v));
    }
  }
}

__device__ void ssd_scan_item(const Params& p, int item) {
  const int tid = threadIdx.x;
  const int dir = item & 1, h = (item >> 1) & 7, b = item >> 4;
  const int g = h >> 2;
  const int pch = tid >> 3, q = tid & 7;
  const float A = expf(p.a_log[dir * 8 + h]);
  float* Y = dir ? p.YB : p.YF;
  float st[16];
#pragma unroll
  for (int j = 0; j < 16; ++j) st[j] = 0.f;
  const int nsteps = LC + L;
  for (int s = 0; s < nsteps; ++s) {
    int row; bool latent;
    if (s < LC) { int t = dir ? (LC - 1 - s) : s; row = T + b * LC + t; latent = false; }
    else { int t = dir ? (L - 1 - (s - LC)) : (s - LC); row = b * L + t; latent = true; }
    const bf16_t* xb = p.XBCb + (size_t)row * DXBC;
    float dtv = p.DT[(size_t)row * 16 + dir * 8 + h];
    float dec = expf(-A * dtv);
    float xv = bf2f(xb[h * 64 + pch]) * dtv;
    const uint4* Bp = (const uint4*)(xb + 512 + g * 128 + q * 16);
    const uint4* Cp = (const uint4*)(xb + 768 + g * 128 + q * 16);
    float y = 0.f;
#pragma unroll
    for (int j8 = 0; j8 < 2; ++j8) {
      uint4 bv = Bp[j8], cv = Cp[j8];
      unsigned bw[4] = {bv.x, bv.y, bv.z, bv.w};
      unsigned cw[4] = {cv.x, cv.y, cv.z, cv.w};
#pragma unroll
      for (int u = 0; u < 4; ++u) {
        float b0 = __uint_as_float(bw[u] << 16), b1 = __uint_as_float(bw[u] & 0xffff0000u);
        float c0 = __uint_as_float(cw[u] << 16), c1 = __uint_as_float(cw[u] & 0xffff0000u);
        st[j8 * 8 + u * 2 + 0] = dec * st[j8 * 8 + u * 2 + 0] + b0 * xv; y += c0 * st[j8 * 8 + u * 2 + 0];
        st[j8 * 8 + u * 2 + 1] = dec * st[j8 * 8 + u * 2 + 1] + b1 * xv; y += c1 * st[j8 * 8 + u * 2 + 1];
      }
    }
    if (latent) {
      y += __shfl_xor(y, 1);
      y += __shfl_xor(y, 2);
      y += __shfl_xor(y, 4);
      if (q == 0) Y[(size_t)row * DS + h * 64 + pch] = y;
    }
  }
}

__device__ void ph_ssd_finish(const Params& p, float* sm) {
  const int tid = threadIdx.x, wid = tid >> 6;
  for (int row = blockIdx.x; row < T; row += gridDim.x) {
    const int ch = tid;
    float xs = bf2f(p.XBCb[(size_t)row * DXBC + ch]);
    float y = p.YF[(size_t)row * DS + ch] + p.YB[(size_t)row * DS + ch] + p.ssd_d[ch >> 6] * xs;
    float z = bf2f(p.PXb[(size_t)row * DP + COL_Z + ch]);
    float yv = y * silu_f(z);
    float s = wave_sum(yv * yv);
    __syncthreads();
    if ((tid & 63) == 0) sm[wid] = s;
    __syncthreads();
    const int hb = (wid >> 2) * 4;
    float tot = sm[hb] + sm[hb + 1] + sm[hb + 2] + sm[hb + 3];
    float r = rsqrtf(tot * (1.f / 256.f) + EPS);
    p.YMIXb[(size_t)row * D + 512 + ch] = f2bf(yv * r * p.ssd_norm_g[ch]);
  }
}

__device__ void ph_router(const Params& p, float* sm) {
  const int tid = threadIdx.x, wid = tid >> 6, lane = tid & 63;
  float* hs = sm + wid * 1200;
  float* lg = hs + 1024;
  for (int row = blockIdx.x * 8 + wid; row < T; row += gridDim.x * 8) {
    const float* src = p.X1 + (size_t)row * D;
    const float* sh = p.MOD + (row / L) * 6144 + 3072;
    const float* sc = sh + 1024;
    float4 v[4];
    float ss = 0.f;
#pragma unroll
    for (int i = 0; i < 4; ++i) {
      v[i] = *(const float4*)(src + i * 256 + lane * 4);
      ss += v[i].x * v[i].x + v[i].y * v[i].y + v[i].z * v[i].z + v[i].w * v[i].w;
    }
    ss = wave_sum(ss);
    const float rstd = rsqrtf(ss * (1.f / D) + EPS);
#pragma unroll
    for (int i = 0; i < 4; ++i) {
      const int col = i * 256 + lane * 4;
      float4 g = *(const float4*)(p.g2 + col);
      float4 s4 = *(const float4*)(sc + col);
      float4 h4 = *(const float4*)(sh + col);
      float4 o;
      o.x = v[i].x * rstd * g.x * (1.f + s4.x) + h4.x;
      o.y = v[i].y * rstd * g.y * (1.f + s4.y) + h4.y;
      o.z = v[i].z * rstd * g.z * (1.f + s4.z) + h4.z;
      o.w = v[i].w * rstd * g.w * (1.f + s4.w) + h4.w;
      uint2 wq; wq.x = cvt_pk_bf16(o.x, o.y); wq.y = cvt_pk_bf16(o.z, o.w);
      *(uint2*)(p.H2b + (size_t)row * D + col) = wq;
      *(float4*)(hs + col) = o;
    }
    {
      float a = p.b_expert[lane];
      const float* wp = p.w_expert + lane;
#pragma unroll 8
      for (int k = 0; k < D; ++k) a += hs[k] * wp[k * 64];
      lg[lane] = a;
      const int j = lane & 7, ks = lane >> 3;
      float gsum = 0.f;
      const float* gp = p.w_group + (ks * 128) * 8 + j;
      const float* hp = hs + ks * 128;
#pragma unroll 8
      for (int k = 0; k < 128; ++k) gsum += hp[k] * gp[k * 8];
      gsum += __shfl_xor(gsum, 8);
      gsum += __shfl_xor(gsum, 16);
      gsum += __shfl_xor(gsum, 32);
      if (lane < 8) lg[64 + lane] = gsum + p.b_group[lane];
    }
    if (lane == 0) {
      int gs = 0; float gm = lg[64];
      for (int j = 1; j < 8; ++j) if (lg[64 + j] > gm) { gm = lg[64 + j]; gs = j; }
      float den = 0.f;
      for (int j = 0; j < 8; ++j) den += expf(lg[64 + j] - gm);
      float pg = 1.f / den;
      const float* el = lg + gs * 8;
      int i0 = 0; float l0 = el[0];
      for (int j = 1; j < 8; ++j) if (el[j] > l0) { l0 = el[j]; i0 = j; }
      int i1 = -1; float l1 = -3.0e38f;
      for (int j = 0; j < 8; ++j) if (j != i0 && el[j] > l1) { l1 = el[j]; i1 = j; }
      float e1 = expf(l1 - l0);
      float w0 = 1.f / (1.f + e1), w1 = e1 / (1.f + e1);
      p.GATE[row * 2 + 0] = w0 * pg;
      p.GATE[row * 2 + 1] = w1 * pg;
      int ea = gs * 8 + i0, eb = gs * 8 + i1;
      int sa = atomicAdd(&p.CNT[ea], 1);
      p.LIST[ea * T + sa] = row * 2 + 0;
      int sb = atomicAdd(&p.CNT[eb], 1);
      p.LIST[eb * T + sb] = row * 2 + 1;
    }
  }
}

__device__ __forceinline__ void moe_table(const Params& p, int* tab) {
  if (threadIdx.x == 0) {
    int a = 0, sg = 0;
    for (int e = 0; e < NE; ++e) {
      int cn = p.CNT[e];
      tab[e] = a; tab[65 + e] = sg; tab[130 + e] = cn;
      a += (cn + 255) >> 8; sg += ((cn + 127) >> 7) << 7;
    }
    tab[NE] = a; tab[65 + NE] = sg;
  }
  __syncthreads();
}

__device__ void ph_final(const Params& p) {
  const int tid = threadIdx.x, wid = tid >> 6, lane = tid & 63;
  for (int row = blockIdx.x * 8 + wid; row < T; row += gridDim.x * 8) {
    const float* ga2 = p.MOD + (row / L) * 6144 + 5120;
    float4 v[4];
    float ss = 0.f;
#pragma unroll
    for (int i = 0; i < 4; ++i) {
      const int col = i * 256 + lane * 4;
      float4 xv = *(const float4*)(p.X1 + (size_t)row * D + col);
      uint2 a = *(const uint2*)(p.YB2b + (size_t)(row * 2) * D + col);
      uint2 b = *(const uint2*)(p.YB2b + (size_t)(row * 2 + 1) * D + col);
      float4 ga = *(const float4*)(ga2 + col);
      v[i].x = xv.x + ga.x * (__uint_as_float(a.x << 16) + __uint_as_float(b.x << 16));
      v[i].y = xv.y + ga.y * (__uint_as_float(a.x & 0xffff0000u) + __uint_as_float(b.x & 0xffff0000u));
      v[i].z = xv.z + ga.z * (__uint_as_float(a.y << 16) + __uint_as_float(b.y << 16));
      v[i].w = xv.w + ga.w * (__uint_as_float(a.y & 0xffff0000u) + __uint_as_float(b.y & 0xffff0000u));
      ss += v[i].x * v[i].x + v[i].y * v[i].y + v[i].z * v[i].z + v[i].w * v[i].w;
    }
    ss = wave_sum(ss);
    const float rstd = rsqrtf(ss * (1.f / D) + EPS);
#pragma unroll
    for (int i = 0; i < 4; ++i) {
      const int col = i * 256 + lane * 4;
      float4 gf = *(const float4*)(p.g_final + col);
      float4 o;
      o.x = v[i].x * rstd * gf.x; o.y = v[i].y * rstd * gf.y; o.z = v[i].z * rstd * gf.z; o.w = v[i].w * rstd * gf.w;
      *(float4*)(p.out + (size_t)row * D + col) = o;
    }
  }
}

constexpr int NPHASE = 11;

__global__ void __launch_bounds__(NTHR, 2) mega(Params p) {
  extern __shared__ __attribute__((aligned(16))) unsigned char lds_raw[];
  float* sm = (float*)lds_raw;
  PG8_LAS unsigned char* lds = (PG8_LAS unsigned char*)lds_raw;
  cg::grid_group grid = cg::this_grid();
  const int lo = p.lo, hi = p.hi;
#define IN(k) (lo <= (k) && (k) < hi)
#define SYNC(k) do { if (IN(k) && IN((k) + 1)) grid.sync(); } while (0)
#ifndef SKIP_OTHER
  if (IN(0)) { ph_adaln(p); ph_filters(p, sm); ph_wcvt(p, sm); }
  SYNC(0);
  if (IN(1)) ph_norm1(p, sm);
  SYNC(1);
#endif
#ifndef SKIP_GEMM
  if (IN(2)) {
    pg8::DenseOrder S{p.XNb, p.WinT, TT / 256, DP / 256, D, (int)gridDim.x, (int)blockIdx.x};
    pg8::EpiBf16 E{p.PXb, DP};
    pg8::gemm_phase<pg8::EpiBf16, pg8::DenseOrder>(lds, D, S, E);
  }
  SYNC(2);
#endif
#ifndef SKIP_OTHER
  if (IN(3)) {
    ph_ssd_prep(p);
    for (int it = blockIdx.x; it < 2048; it += gridDim.x) hyena_item(p, it, 0, sm);
  }
  SYNC(3);
  if (IN(4)) {
    for (int it = blockIdx.x; it < 128 + 2048; it += gridDim.x) {
      if (it < 128) ssd_scan_item(p, it); else hyena_item(p, it - 128, 1, sm);
    }
  }
  SYNC(4);
  if (IN(5)) ph_ssd_finish(p, sm);
  SYNC(5);
#endif
#ifndef SKIP_GEMM
  if (IN(6)) {
    pg8::DenseOrder S{p.YMIXb, p.WoutT, T / 256, D / 256, D, (int)gridDim.x, (int)blockIdx.x};
    pg8::EpiX1 E{p.x, p.MOD, p.X1};
    pg8::gemm_phase<pg8::EpiX1, pg8::DenseOrder>(lds, D, S, E);
  }
  SYNC(6);
#endif
#ifndef SKIP_OTHER
  if (IN(7)) ph_router(p, sm);
  SYNC(7);
#endif
#ifndef SKIP_GEMM
  if (IN(8)) {
    int* tab = (int*)(lds_raw + pg8::STAGE_BYTES);
    moe_table(p, tab);
    pg8::MoeOrder S{tab, p.H2b, p.Wup, p.LIST, 4, D, (int)gridDim.x, (int)blockIdx.x, true};
    pg8::EpiSwiGLU E{p.HBb};
    pg8::gemm_phase<pg8::EpiSwiGLU, pg8::MoeOrder>(lds, D, S, E);
  }
  SYNC(8);
  if (IN(9)) {
    int* tab = (int*)(lds_raw + pg8::STAGE_BYTES);
    moe_table(p, tab);
    pg8::MoeOrder S{tab, p.HBb, p.Wdn, p.LIST, 4, DE, (int)gridDim.x, (int)blockIdx.x, false};
    pg8::EpiDown E{p.YB2b, p.LIST, p.GATE};
    pg8::gemm_phase<pg8::EpiDown, pg8::MoeOrder>(lds, DE, S, E);
  }
  SYNC(9);
#endif
#ifndef SKIP_OTHER
  if (IN(10)) ph_final(p);
#endif
#undef IN
#undef SYNC
}

extern "C" void kernel_launch(void* const* d_in, const int* in_sizes, int n_in, void* d_out, int out_size,
                              void* d_ws, size_t ws_size, hipStream_t stream) {
  Params p{};
  const float* const* in = (const float* const*)d_in;
  p.x = in[0]; p.c = in[1]; p.ctx = in[2]; p.c_ctx = in[3]; p.w_ada = in[4]; p.b_ada = in[5];
  p.g1 = in[6]; p.g2 = in[7]; p.w_in = in[8]; p.hy_conv_w = in[9]; p.hy_conv_b = in[10];
  p.f_w1 = in[11]; p.f_b1 = in[12]; p.f_freq = in[13]; p.f_w2 = in[14]; p.f_b2 = in[15]; p.f_w3 = in[16];
  p.hy_bias = in[17]; p.ssd_conv_w = in[18]; p.ssd_conv_b = in[19]; p.a_log = in[20]; p.dt_bias = in[21];
  p.ssd_d = in[22]; p.ssd_norm_g = in[23]; p.w_out = in[24]; p.w_group = in[25]; p.b_group = in[26];
  p.w_expert = in[27]; p.b_expert = in[28]; p.w1 = in[29]; p.w3 = in[30]; p.w2 = in[31]; p.g_final = in[32];
  p.out = (float*)d_out;

  char* ws = (char*)d_ws;
  size_t off = 0;
  auto take = [&](size_t bytes) { char* r = ws + off; off += (bytes + 255) & ~(size_t)255; return r; };
  p.MOD = (float*)take((size_t)9 * 6144 * 4);
  p.CNT = (int*)take(NE * 4);
  p.GATE = (float*)take((size_t)T * 2 * 4);
  p.LIST = (int*)take((size_t)NE * T * 4);
  p.DT = (float*)take((size_t)TT * 16 * 4);
  p.FILT = (float*)take((size_t)L * 2048 * 4);
  p.WinT = (bf16_t*)take((size_t)DP * D * 2);
  p.WoutT = (bf16_t*)take((size_t)D * D * 2);
  p.Wup = (bf16_t*)take((size_t)NE * 1024 * 1024 * 2);
  p.Wdn = (bf16_t*)take((size_t)NE * 1024 * 512 * 2);
  char* rPX = take((size_t)TT * DP * 2);
  char* rXBC = take((size_t)TT * DXBC * 2);
  char* rZ1 = take((size_t)T * DH * 4);
  char* rYF = take((size_t)T * DS * 4);
  char* rYB = take((size_t)T * DS * 4);
  char* rYM = take((size_t)T * D * 2);
  p.PXb = (bf16_t*)rPX; p.XBCb = (bf16_t*)rXBC; p.Z1 = (float*)rZ1; p.YF = (float*)rYF; p.YB = (float*)rYB; p.YMIXb = (bf16_t*)rYM;
  p.XNb = (bf16_t*)rZ1;
  p.X1 = (float*)rPX;
  p.H2b = (bf16_t*)rYM;
  p.HBb = (bf16_t*)rYF;
  p.YB2b = (bf16_t*)rXBC;
  if (off > ws_size) { fprintf(stderr, "workspace too small: need %zu have %zu\n", off, ws_size); return; }

  static int grid_blocks = 0;
  if (!grid_blocks) {
    int dev = 0, cus = 0, per_cu = 0;
    (void)hipGetDevice(&dev);
    (void)hipDeviceGetAttribute(&cus, hipDeviceAttributeMultiprocessorCount, dev);
    (void)hipFuncSetAttribute((const void*)mega, hipFuncAttributeMaxDynamicSharedMemorySize, LDS_BYTES);
    (void)hipOccupancyMaxActiveBlocksPerMultiprocessor(&per_cu, mega, NTHR, LDS_BYTES);
    if (per_cu < 1) { fprintf(stderr, "occupancy query returned %d\n", per_cu); per_cu = 1; }
    grid_blocks = cus;
  }
#ifndef ONE_LAUNCH
  for (int ph = 0; ph < NPHASE; ++ph) {
    p.lo = ph; p.hi = ph + 1;
    hipLaunchKernelGGL(mega, dim3(grid_blocks), dim3(NTHR), LDS_BYTES, stream, p);
  }
#else
  p.lo = 0; p.hi = NPHASE;
  void* args[] = {&p};
  hipError_t e = hipLaunchCooperativeKernel((void*)mega, dim3(grid_blocks), dim3(NTHR), args, LDS_BYTES, stream);
  if (e != hipSuccess) fprintf(stderr, "cooperative launch failed: %s (grid %d)\n", hipGetErrorString(e), grid_blocks);
#endif
}
```

```cpp
#define ONE_LAUNCH 1
#include <hip/hip_runtime.h>
#include <hip/hip_cooperative_groups.h>
#include <cstdio>
#include <cstdint>
namespace cg = cooperative_groups;

constexpr int D = 1024, NB = 8, L = 2048, LC = 256;
constexpr int T = NB * L;
constexpr int TC = NB * LC;
constexpr int TT = T + TC;
constexpr int DH = 512, HYC = 1536, DS = 512, DXBC = 1024, DIN = 3088, DP = 3072;
constexpr int COL_Z = 1536, COL_XBC = 2048, COL_DT = 3072;
constexpr int NE = 64, DE = 512;
constexpr float EPS = 1e-6f;
constexpr int NTHR = 512;
constexpr int LDS_BYTES = 132 * 1024;
constexpr int FLEN = 4232, HX0 = 2112, FCLEN = 4240, ZSTRB = 4240;

typedef unsigned short bf16_t;

struct Params {
  const float *x, *c, *ctx, *c_ctx, *w_ada, *b_ada, *g1, *g2, *w_in, *hy_conv_w, *hy_conv_b;
  const float *f_w1, *f_b1, *f_freq, *f_w2, *f_b2, *f_w3, *hy_bias;
  const float *ssd_conv_w, *ssd_conv_b, *a_log, *dt_bias, *ssd_d, *ssd_norm_g, *w_out;
  const float *w_group, *b_group, *w_expert, *b_expert, *w1, *w3, *w2, *g_final;
  float* out;
  float *MOD, *YF, *YB, *DT, *X1, *GATE;
  bf16_t *FILTt, *Ut, *XNb, *WinT, *WoutT, *PXb, *XBCb, *YMIXb, *YB2b, *Wup, *Wdn, *H2b, *HBb;
  int *CNT, *LIST;
  int lo, hi;
};

__device__ __forceinline__ float silu_f(float v) { return v / (1.f + __expf(-v)); }
__device__ __forceinline__ float softplus_f(float v) { return v > 20.f ? v : log1pf(expf(v)); }
__device__ __forceinline__ float bf2f(bf16_t v) { return __uint_as_float(((unsigned)v) << 16); }
__device__ __forceinline__ unsigned cvt_pk_bf16(float lo, float hi) {
  unsigned r;
  asm volatile("v_cvt_pk_bf16_f32 %0, %1, %2" : "=v"(r) : "v"(lo), "v"(hi));
  return r;
}
__device__ __forceinline__ bf16_t f2bf(float f) { return (bf16_t)(cvt_pk_bf16(f, 0.f) & 0xffffu); }
__device__ __forceinline__ float wave_sum(float v) {
#pragma unroll
  for (int o = 32; o > 0; o >>= 1) v += __shfl_xor(v, o);
  return v;
}

namespace pg8 {
#define PG8_LAS __attribute__((address_space(3)))
typedef short bf16x8 __attribute__((ext_vector_type(8)));
typedef float f32x4 __attribute__((ext_vector_type(4)));
typedef unsigned u32x4 __attribute__((ext_vector_type(4)));
typedef unsigned u32x2 __attribute__((ext_vector_type(2)));
constexpr int BM = 256, BK = 64, HALF = 128, HTB = HALF * BK * 2, STAGE_BYTES = 8 * HTB, NXCD = 8, WGM = 8;

__host__ __device__ __forceinline__ int lds_byte(int r, int c) {
  const int st = (r >> 4) * 2 + (c >> 5), rr = r & 15, cc = c & 31, ob = rr * 64 + cc * 2;
  return st * 1024 + (ob ^ (((ob >> 9) & 1) << 5));
}
__host__ __device__ __forceinline__ void stage_rc(int b, int& R, int& C) {
  const int st = b / 1024, sb = b % 1024, swz = sb ^ (((sb >> 9) & 1) << 5);
  R = (st >> 1) * 16 + swz / 64; C = (st & 1) * 32 + (swz % 64) / 2;
}
__host__ __device__ __forceinline__ int perm32(int rho) { const int n = rho >> 4, i = rho & 15; return 8 * (i >> 2) + 4 * n + (i & 3); }

struct Unit { int pm, pn, e, mu, nv, cnt, seg; };

__device__ __forceinline__ bool static_next(int nM, int nN, int G, int c, int i, int& pm, int& pn) {
  const int nwg = nM * nN;
  const long Lx = (long)i * G + c; if (Lx >= nwg) return false;
  int wgid = (int)Lx;
  { const int q = nwg / NXCD, r = nwg % NXCD, xcd = wgid % NXCD, off = wgid / NXCD; wgid = (xcd < r ? xcd * (q + 1) : r * (q + 1) + (xcd - r) * q) + off; }
  const int nig = WGM * nN, gid = wgid / nig, fm = gid * WGM, gsz = (nM - fm) < WGM ? (nM - fm) : WGM;
  pm = fm + ((wgid % nig) % gsz); pn = (wgid % nig) / gsz; return true;
}

struct DenseOrder {
  const bf16_t* A; const bf16_t* Bt; int nM, nN, K, G, c;
  __device__ __forceinline__ bool next(int i, Unit& u) const {
    if (!static_next(nM, nN, G, c, i, u.pm, u.pn)) return false;
    u.e = 0; u.mu = 0; u.nv = 256; u.cnt = 256; u.seg = 0; return true;
  }
  __device__ __forceinline__ const char* a_base() const { return (const char*)A; }
  __device__ __forceinline__ const char* b_ptr(const Unit& u) const { return (const char*)Bt + (size_t)u.pn * 256 * K * 2; }
  __device__ __forceinline__ void a_offs(const Unit& u, const int (&R)[2], const int (&C)[2], unsigned (&ao)[2][2]) const {
#pragma unroll
    for (int h = 0; h < 2; ++h)
#pragma unroll
      for (int i = 0; i < 2; ++i) ao[h][i] = (unsigned)((u.pm * 256 + h * 128 + R[i]) * K + C[i]) * 2u;
  }
};

struct MoeOrder {
  const int* tab; const bf16_t* A; const bf16_t* Bt; const int* list; int NTn, K, G, c; bool gather;
  __device__ __forceinline__ bool next(int i, Unit& u) const {
    const int Lx = i * G + c;
    if (Lx >= tab[64] * NTn) return false;
    const int mg = Lx / NTn; u.pn = Lx - mg * NTn;
    int e = 0;
    while (tab[e + 1] <= mg) ++e;
    u.e = e; u.mu = mg - tab[e]; u.cnt = tab[130 + e]; u.seg = tab[65 + e];
    const int rem = u.cnt - u.mu * 256; u.nv = rem < 256 ? rem : 256; u.pm = 0; return true;
  }
  __device__ __forceinline__ const char* a_base() const { return (const char*)A; }
  __device__ __forceinline__ const char* b_ptr(const Unit& u) const { return (const char*)Bt + ((size_t)u.e * NTn + u.pn) * 256 * K * 2; }
  __device__ __forceinline__ void a_offs(const Unit& u, const int (&R)[2], const int (&C)[2], unsigned (&ao)[2][2]) const {
#pragma unroll
    for (int h = 0; h < 2; ++h)
#pragma unroll
      for (int i = 0; i < 2; ++i) {
        int idx = u.mu * 256 + h * 128 + R[i];
        int row;
        if (gather) { if (idx > u.cnt - 1) idx = u.cnt - 1; row = list[u.e * T + idx] >> 1; }
        else row = u.seg + idx;
        ao[h][i] = (unsigned)(row * K + C[i]) * 2u;
      }
  }
};

struct EpiBf16 {
  static constexpr bool PERM = true;
  bf16_t* O; int ldc;
  __device__ __forceinline__ void operator()(const f32x4 (&acc)[2][2][4][2], const Unit& u, int wr, int wc, int fr, int fq) const {
    const int row0 = u.pm * BM + wr * 64 + fr;
    const int col0 = u.pn * BM + wc * 32 + 8 * fq;
#pragma unroll
    for (int ai = 0; ai < 2; ++ai)
#pragma unroll
      for (int m = 0; m < 4; ++m) {
        bf16_t* rowp = O + (size_t)(row0 + ai * HALF + m * 16) * ldc + col0;
#pragma unroll
        for (int bj = 0; bj < 2; ++bj) {
          f32x4 v0 = acc[ai][bj][m][0], v1 = acc[ai][bj][m][1];
          u32x4 w; w.x = cvt_pk_bf16(v0[0], v0[1]); w.y = cvt_pk_bf16(v0[2], v0[3]); w.z = cvt_pk_bf16(v1[0], v1[1]); w.w = cvt_pk_bf16(v1[2], v1[3]);
          *(u32x4*)(rowp + bj * HALF) = w;
        }
      }
  }
};

struct EpiX1 {
  static constexpr bool PERM = false;
  const float* x; const float* mod; float* X1;
  __device__ __forceinline__ void operator()(const f32x4 (&acc)[2][2][4][2], const Unit& u, int wr, int wc, int fr, int fq) const {
    const int row0 = u.pm * BM + wr * 64 + fr, col0 = u.pn * BM + wc * 32 + 4 * fq;
    const float* ga = mod + ((u.pm * BM) / L) * 6144 + 2048 + col0;
    f32x4 gv[2][2];
#pragma unroll
    for (int bj = 0; bj < 2; ++bj)
#pragma unroll
      for (int n = 0; n < 2; ++n) gv[bj][n] = *(const f32x4*)(ga + bj * HALF + n * 16);
#pragma unroll
    for (int ai = 0; ai < 2; ++ai)
#pragma unroll
      for (int m = 0; m < 4; ++m) {
        const size_t off = (size_t)(row0 + ai * HALF + m * 16) * D + col0;
#pragma unroll
        for (int bj = 0; bj < 2; ++bj)
#pragma unroll
          for (int n = 0; n < 2; ++n) {
            const f32x4 xv = *(const f32x4*)(x + off + bj * HALF + n * 16);
            *(f32x4*)(X1 + off + bj * HALF + n * 16) = xv + gv[bj][n] * acc[ai][bj][m][n];
          }
      }
  }
};

struct EpiSwiGLU {
  static constexpr bool PERM = true;
  bf16_t* HBb;
  __device__ __forceinline__ void operator()(const f32x4 (&acc)[2][2][4][2], const Unit& u, int wr, int wc, int fr, int fq) const {
    const int col0 = u.pn * 128 + wc * 32 + 8 * fq;
#pragma unroll
    for (int ai = 0; ai < 2; ++ai)
#pragma unroll
      for (int m = 0; m < 4; ++m) {
        const int slot = u.mu * 256 + ai * HALF + wr * 64 + m * 16 + fr;
        if (slot < u.cnt) {
          float h[8];
#pragma unroll
          for (int n = 0; n < 2; ++n)
#pragma unroll
            for (int j = 0; j < 4; ++j) { const float a = acc[ai][0][m][n][j]; h[n * 4 + j] = a / (1.f + __expf(-a)) * acc[ai][1][m][n][j]; }
          u32x4 w; w.x = cvt_pk_bf16(h[0], h[1]); w.y = cvt_pk_bf16(h[2], h[3]); w.z = cvt_pk_bf16(h[4], h[5]); w.w = cvt_pk_bf16(h[6], h[7]);
          *(u32x4*)(HBb + (size_t)(u.seg + slot) * DE + col0) = w;
        }
      }
  }
};

struct EpiDown {
  static constexpr bool PERM = true;
  bf16_t* YB2b; const int* list; const float* gate;
  __device__ __forceinline__ void operator()(const f32x4 (&acc)[2][2][4][2], const Unit& u, int wr, int wc, int fr, int fq) const {
    const int col0 = u.pn * 256 + wc * 32 + 8 * fq;
#pragma unroll
    for (int ai = 0; ai < 2; ++ai)
#pragma unroll
      for (int m = 0; m < 4; ++m) {
        const int slot = u.mu * 256 + ai * HALF + wr * 64 + m * 16 + fr;
        if (slot < u.cnt) {
          const int pair = list[u.e * T + slot];
          const float gt = gate[pair];
          bf16_t* rowp = YB2b + (size_t)pair * D + col0;
#pragma unroll
          for (int bj = 0; bj < 2; ++bj) {
            f32x4 v0 = acc[ai][bj][m][0] * gt, v1 = acc[ai][bj][m][1] * gt;
            u32x4 w; w.x = cvt_pk_bf16(v0[0], v0[1]); w.y = cvt_pk_bf16(v0[2], v0[3]); w.z = cvt_pk_bf16(v1[0], v1[1]); w.w = cvt_pk_bf16(v1[2], v1[3]);
            *(u32x4*)(rowp + bj * HALF) = w;
          }
        }
      }
  }
};

template <class Epi, class Sched>
__device__ __forceinline__ void gemm_phase(PG8_LAS unsigned char* lds, const int K, const Sched& S, const Epi& E) {
  const int tid = threadIdx.x, wid = __builtin_amdgcn_readfirstlane(tid >> 6), lane = tid & 63, wr = wid >> 2, wc = wid & 3, fr = lane & 15, fq = lane >> 4;
  const int nt = K / BK;
  int Rr[2], Cc[2];
  unsigned voffB[2];
#pragma unroll
  for (int i = 0; i < 2; ++i) {
    stage_rc(tid * 16 + i * 8192, Rr[i], Cc[i]);
    const int Rb = Epi::PERM ? ((Rr[i] & ~31) + perm32(Rr[i] & 31)) : Rr[i];
    voffB[i] = (unsigned)(Rb * K + Cc[i]) * 2u;
  }
  const size_t kstep = (size_t)(BK * 2);
  const size_t hstep = (size_t)HALF * K * 2;
  const unsigned ldsw = (unsigned)wid * 1024u;
  const int aoff = lds_byte(wr * 64 + fr, fq * 8), boff = lds_byte(wc * 32 + fr, fq * 8);
#define PG8_SA(b, h) (((b) * 2 + (h)) * HTB)
#define PG8_SB(b, h) ((4 + (b) * 2 + (h)) * HTB)
#define PG8_STAGE(bufoff, gbase, voff) do { _Pragma("unroll") for (int _i = 0; _i < 2; ++_i) \
    __builtin_amdgcn_global_load_lds((const unsigned*)((const char*)(gbase) + (voff)[_i]), (PG8_LAS unsigned*)(lds + (bufoff) + ldsw + _i * 8192), 16, 0, 0); } while (0)
#define PG8_LDA(dst, b, h) do { _Pragma("unroll") for (int m = 0; m < 4; ++m) _Pragma("unroll") for (int k = 0; k < 2; ++k) dst[m][k] = *(const PG8_LAS bf16x8*)(lds + PG8_SA(b, h) + aoff + m * 2048 + k * 1024); } while (0)
#define PG8_LDB(dst, b, h) do { _Pragma("unroll") for (int n = 0; n < 2; ++n) _Pragma("unroll") for (int k = 0; k < 2; ++k) dst[n][k] = *(const PG8_LAS bf16x8*)(lds + PG8_SB(b, h) + boff + n * 2048 + k * 1024); } while (0)
#define PG8_MMA(ai, bj, At, Bt) do { __builtin_amdgcn_s_setprio(1); _Pragma("unroll") for (int m = 0; m < 4; ++m) _Pragma("unroll") for (int n = 0; n < 2; ++n) _Pragma("unroll") for (int k = 0; k < 2; ++k) \
    acc[ai][bj][m][n] = __builtin_amdgcn_mfma_f32_16x16x32_bf16(Bt[n][k], At[m][k], acc[ai][bj][m][n], 0, 0, 0); __builtin_amdgcn_s_setprio(0); } while (0)
#define PG8_WAIT_V(n) asm volatile("s_waitcnt vmcnt(" #n ")" ::: "memory")
#define PG8_WAIT_L(n) asm volatile("s_waitcnt lgkmcnt(" #n ")" ::: "memory")
#define PG8_BAR __builtin_amdgcn_s_barrier()
#define PG8_SCHED __builtin_amdgcn_sched_barrier(0)
  Unit cur, nxt; int ui = 0;
  if (!S.next(0, cur)) return;
  f32x4 acc[2][2][4][2];
#pragma unroll
  for (int a = 0; a < 2; ++a)
#pragma unroll
    for (int b = 0; b < 2; ++b)
#pragma unroll
      for (int m = 0; m < 4; ++m)
#pragma unroll
        for (int n = 0; n < 2; ++n) acc[a][b][m][n] = (f32x4){0.f, 0.f, 0.f, 0.f};
  bf16x8 At[4][2], B0[2][2], B1[2][2];
  unsigned cao[2][2], nao[2][2];
  S.a_offs(cur, Rr, Cc, cao);
  const char* const aB = S.a_base();
  const char* cB = S.b_ptr(cur);
  PG8_STAGE(PG8_SB(0, 0), cB, voffB); PG8_STAGE(PG8_SA(0, 0), aB, cao[0]); PG8_STAGE(PG8_SB(0, 1), cB + hstep, voffB); PG8_STAGE(PG8_SA(0, 1), aB, cao[1]);
  if (wr == 1) PG8_BAR;
  PG8_WAIT_V(4); PG8_BAR;
  PG8_STAGE(PG8_SB(1, 0), cB + kstep, voffB); PG8_STAGE(PG8_SA(1, 0), aB + kstep, cao[0]); PG8_STAGE(PG8_SB(1, 1), cB + hstep + kstep, voffB);
  PG8_WAIT_V(6); PG8_BAR;
  for (;;) {
    const bool has_next = S.next(ui + 1, nxt);
    const char* nB = cB;
    if (has_next) { S.a_offs(nxt, Rr, Cc, nao); nB = S.b_ptr(nxt); }
    else {
#pragma unroll
      for (int h = 0; h < 2; ++h)
#pragma unroll
        for (int i = 0; i < 2; ++i) nao[h][i] = cao[h][i];
    }
    const bool full = cur.nv > 128;
    for (int t = 0; t < nt; t += 2) {
      const bool last = (t == nt - 2);
      const char* a1 = aB + (size_t)(t + 1) * kstep;
      const char* a2 = last ? aB : aB + (size_t)(t + 2) * kstep; const char* b2 = last ? nB : cB + (size_t)(t + 2) * kstep;
      const char* a3 = a2 + kstep; const char* b3 = b2 + kstep;
      unsigned so[2][2];
#pragma unroll
      for (int h = 0; h < 2; ++h)
#pragma unroll
        for (int i = 0; i < 2; ++i) so[h][i] = last ? nao[h][i] : cao[h][i];
      PG8_LDB(B0, 0, 0); PG8_SCHED; PG8_LDA(At, 0, 0); PG8_STAGE(PG8_SA(1, 1), a1, cao[1]);
      PG8_WAIT_L(8); PG8_BAR; PG8_WAIT_L(0); PG8_MMA(0, 0, At, B0); PG8_BAR; PG8_SCHED;
      PG8_LDB(B1, 0, 1); PG8_STAGE(PG8_SB(0, 0), b2, voffB);
      PG8_BAR; PG8_WAIT_L(0); PG8_MMA(0, 1, At, B1); PG8_BAR;
      PG8_LDA(At, 0, 1); PG8_STAGE(PG8_SA(0, 0), a2, so[0]);
      PG8_BAR; PG8_WAIT_L(0); if (full) PG8_MMA(1, 0, At, B0); PG8_BAR; PG8_SCHED;
      PG8_STAGE(PG8_SB(0, 1), b2 + hstep, voffB);
      PG8_WAIT_V(6); PG8_BAR; if (full) PG8_MMA(1, 1, At, B1); PG8_BAR;
      PG8_LDB(B0, 1, 0); PG8_SCHED; PG8_LDA(At, 1, 0); PG8_STAGE(PG8_SA(0, 1), a2, so[1]);
      PG8_WAIT_L(8); PG8_BAR; PG8_WAIT_L(0); PG8_MMA(0, 0, At, B0); PG8_BAR; PG8_SCHED;
      PG8_LDB(B1, 1, 1); PG8_STAGE(PG8_SB(1, 0), b3, voffB);
      PG8_BAR; PG8_WAIT_L(0); PG8_MMA(0, 1, At, B1); PG8_BAR;
      PG8_LDA(At, 1, 1); PG8_STAGE(PG8_SA(1, 0), a3, so[0]);
      PG8_BAR; PG8_WAIT_L(0); if (full) PG8_MMA(1, 0, At, B0); PG8_BAR; PG8_SCHED;
      PG8_STAGE(PG8_SB(1, 1), b3 + hstep, voffB);
      PG8_WAIT_V(6); PG8_BAR; if (full) PG8_MMA(1, 1, At, B1); PG8_BAR;
    }
    E(acc, cur, wr, wc, fr, fq);
    if (!has_next) break;
#pragma unroll
    for (int a = 0; a < 2; ++a)
#pragma unroll
      for (int b = 0; b < 2; ++b)
#pragma unroll
        for (int m = 0; m < 4; ++m)
#pragma unroll
          for (int n = 0; n < 2; ++n) acc[a][b][m][n] = (f32x4){0.f, 0.f, 0.f, 0.f};
    cur = nxt; cB = nB; ++ui;
#pragma unroll
    for (int h = 0; h < 2; ++h)
#pragma unroll
      for (int i = 0; i < 2; ++i) cao[h][i] = nao[h][i];
  }
  PG8_WAIT_V(0);
  if (wr == 0) PG8_BAR;
  PG8_BAR;
#undef PG8_SA
#undef PG8_SB
#undef PG8_STAGE
#undef PG8_LDA
#undef PG8_LDB
#undef PG8_MMA
#undef PG8_WAIT_V
#undef PG8_WAIT_L
#undef PG8_BAR
#undef PG8_SCHED
}
}

__device__ void ph_adaln(const Params& p) {
  const int tid = threadIdx.x;
  if (blockIdx.x == 0 && tid < NE) p.CNT[tid] = 0;
  for (int idx = blockIdx.x * NTHR + tid; idx < 9 * 6144; idx += gridDim.x * NTHR) {
    int r = idx / 6144, j = idx - r * 6144;
    const float* cv = (r < 8) ? (p.c + r * D) : p.c_ctx;
    float acc = 0.f;
    for (int k = 0; k < D; ++k) acc += silu_f(cv[k]) * p.w_ada[(size_t)k * 6144 + j];
    p.MOD[idx] = acc + p.b_ada[j];
  }
}

__device__ void ph_filters(const Params& p, float* sm) {
  const int tid = threadIdx.x, wid = tid >> 6, lane = tid & 63;
  float* feats = sm;
  float* h1 = sm + 64 * 20;
  float* h2 = h1 + 64 * 64;
  bf16_t* tile = (bf16_t*)(h2 + 64 * 64);
  for (int e = blockIdx.x * NTHR + tid; e < 1024 * 137; e += gridDim.x * NTHR) {
    int rowi = e / 137, k = e - rowi * 137;
    int x = (k < 65) ? k : (4160 + (k - 65));
    p.FILTt[(size_t)rowi * FLEN + x] = 0;
  }
  for (int item = blockIdx.x; item < 256; item += gridDim.x) {
    const int tt = item >> 3, ct = item & 7;
    for (int e = tid; e < 64 * 17; e += NTHR) {
      int tp = e / 17, i = e - tp * 17;
      int t = tt * 64 + tp;
      float f;
      if (i == 0) f = (float)t / (float)(L - 1);
      else {
        int bi = (i - 1) & 7;
        float bandf = (float)(1e-4 + (double)bi * ((7.0 - 1e-4) / 7.0));
        float ang = (float)(2.0 * 3.14159265358979323846 / (double)L) * (float)t * bandf;
        f = (i <= 8) ? cosf(ang) : -sinf(ang);
      }
      feats[tp * 20 + i] = f;
    }
    __syncthreads();
    for (int e = tid; e < 4096; e += NTHR) {
      int tp = e >> 6, j = e & 63;
      float a = p.f_b1[j];
      for (int i = 0; i < 17; ++i) a += feats[tp * 20 + i] * p.f_w1[i * 64 + j];
      h1[e] = sinf(p.f_freq[j] * a);
    }
    __syncthreads();
    for (int e = tid; e < 4096; e += NTHR) {
      int tp = e >> 6, j = e & 63;
      float a = p.f_b2[j];
      for (int i = 0; i < 64; ++i) a += h1[tp * 64 + i] * p.f_w2[i * 64 + j];
      h2[e] = sinf(p.f_freq[j] * a);
    }
    __syncthreads();
    {
      const int col = tid & 255, half = tid >> 8;
      const int gcol = ct * 256 + col;
      float acc[32];
#pragma unroll
      for (int k = 0; k < 32; ++k) acc[k] = 0.f;
      for (int i = 0; i < 64; ++i) {
        float w = p.f_w3[i * 2048 + gcol];
#pragma unroll
        for (int k = 0; k < 32; ++k) acc[k] += h2[(half * 32 + k) * 64 + i] * w;
      }
      const int cch = gcol & 511;
      const float d0 = -4.605170185988091f / 1.5f, d1 = -4.605170185988091f / 0.3f;
      const float delta = fabsf(d0 + (float)cch * ((d1 - d0) / 511.f));
#pragma unroll
      for (int k = 0; k < 32; ++k) {
        int t = tt * 64 + half * 32 + k;
        float tn = (float)t / (float)(L - 1);
        tile[col * 66 + half * 32 + k] = f2bf(acc[k] * expf(-tn * delta));
      }
    }
    __syncthreads();
    for (int cl = wid * 32; cl < wid * 32 + 32; ++cl) {
      const int gcol = ct * 256 + cl;
      const int o = gcol >> 10, dir = (gcol >> 9) & 1, cch = gcol & 511;
      const int t = tt * 64 + lane;
      const int x = dir ? (HX0 + t) : (HX0 - t);
      if (!(dir && t == 0)) p.FILTt[(size_t)(o * 512 + cch) * FLEN + x] = tile[cl * 66 + lane];
    }
    __syncthreads();
  }
}

__device__ __forceinline__ void cvt_tile(const float* src, int ld, int k0, int n0, bf16_t* dst, int ldd, int drow0, float* sm) {
  const int tid = threadIdx.x;
  float* ts = sm;
  for (int e = tid; e < 1024; e += NTHR) {
    int k = e >> 4, n4 = (e & 15) * 4;
    float4 v = *(const float4*)(src + (size_t)(k0 + k) * ld + n0 + n4);
    ts[k * 65 + n4 + 0] = v.x; ts[k * 65 + n4 + 1] = v.y; ts[k * 65 + n4 + 2] = v.z; ts[k * 65 + n4 + 3] = v.w;
  }
  __syncthreads();
  {
    int n = tid >> 3, kq = (tid & 7) * 8;
    uint4 w;
    w.x = cvt_pk_bf16(ts[(kq + 0) * 65 + n], ts[(kq + 1) * 65 + n]);
    w.y = cvt_pk_bf16(ts[(kq + 2) * 65 + n], ts[(kq + 3) * 65 + n]);
    w.z = cvt_pk_bf16(ts[(kq + 4) * 65 + n], ts[(kq + 5) * 65 + n]);
    w.w = cvt_pk_bf16(ts[(kq + 6) * 65 + n], ts[(kq + 7) * 65 + n]);
    *(uint4*)(dst + (size_t)(drow0 + n) * ldd + k0 + kq) = w;
  }
  __syncthreads();
}

__device__ void ph_wcvt(const Params& p, float* sm) {
  for (int it = blockIdx.x; it < 768 + 256 + 16384 + 8192; it += gridDim.x) {
    if (it < 768) { int kt = it / 48, nt = it - kt * 48; cvt_tile(p.w_in, DIN, kt * 64, nt * 64, p.WinT, D, nt * 64, sm); }
    else if (it < 1024) { int i = it - 768; int kt = i >> 4, nt = i & 15; cvt_tile(p.w_out, D, kt * 64, nt * 64, p.WoutT, D, nt * 64, sm); }
    else if (it < 1024 + 16384) {
      int i = it - 1024; int e = i >> 8, r = i & 255; int which = r >> 7, r2 = r & 127; int kt = r2 >> 3, ct = r2 & 7;
      const float* src = (which ? p.w3 : p.w1) + (size_t)e * D * DE;
      int col0 = ct * 64;
      int drow0 = (col0 >> 7) * 256 + which * 128 + (col0 & 127);
      cvt_tile(src, DE, kt * 64, col0, p.Wup + (size_t)e * 1024 * 1024, D, drow0, sm);
    } else {
      int i = it - 1024 - 16384; int e = i >> 7, r = i & 127; int kt = r >> 4, nt = r & 15;
      cvt_tile(p.w2 + (size_t)e * DE * D, D, kt * 64, nt * 64, p.Wdn + (size_t)e * 1024 * 512, DE, nt * 64, sm);
    }
  }
}

__device__ void ph_norm1(const Params& p, float* sm) {
  const int tid = threadIdx.x, wid = tid >> 6, lane = tid & 63;
  float* wdt = sm;
  float* xs = sm + 16448 + wid * 1056;
  for (int e = tid; e < 4096; e += NTHR) {
    int k = e >> 2, q = e & 3;
    float4 v = *(const float4*)(p.w_in + (size_t)k * DIN + COL_DT + q * 4);
    *(float4*)(wdt + k * 16 + (k >> 8) * 16 + q * 4) = v;
  }
  __syncthreads();
  for (int row = blockIdx.x * 8 + wid; row < TT; row += gridDim.x * 8) {
    const float* src = (row < T) ? (p.x + (size_t)row * D) : (p.ctx + (size_t)(row - T) * D);
    const int mr = (row < T) ? (row / L) : 8;
    const float* sh = p.MOD + mr * 6144;
    const float* sc = sh + 1024;
    float4 v[4];
    float ss = 0.f;
#pragma unroll
    for (int i = 0; i < 4; ++i) {
      v[i] = *(const float4*)(src + i * 256 + lane * 4);
      ss += v[i].x * v[i].x + v[i].y * v[i].y + v[i].z * v[i].z + v[i].w * v[i].w;
    }
    ss = wave_sum(ss);
    const float rstd = rsqrtf(ss * (1.f / D) + EPS);
#pragma unroll
    for (int i = 0; i < 4; ++i) {
      const int col = i * 256 + lane * 4;
      float4 g = *(const float4*)(p.g1 + col);
      float4 s4 = *(const float4*)(sc + col);
      float4 h4 = *(const float4*)(sh + col);
      float4 o;
      o.x = v[i].x * rstd * g.x * (1.f + s4.x) + h4.x;
      o.y = v[i].y * rstd * g.y * (1.f + s4.y) + h4.y;
      o.z = v[i].z * rstd * g.z * (1.f + s4.z) + h4.z;
      o.w = v[i].w * rstd * g.w * (1.f + s4.w) + h4.w;
      uint2 w; w.x = cvt_pk_bf16(o.x, o.y); w.y = cvt_pk_bf16(o.z, o.w);
      *(uint2*)(p.XNb + (size_t)row * D + col) = w;
      *(float4*)(xs + col + i * 8) = o;
    }
    {
      const int j = lane & 15, ks = lane >> 4;
      const float* xp = xs + ks * 256 + ks * 8;
      const float* wp = wdt + (ks * 256) * 16 + ks * 16 + j;
      float a = 0.f;
#pragma unroll 8
      for (int k = 0; k < 256; ++k) a += xp[k] * wp[k * 16];
      a += __shfl_xor(a, 16);
      a += __shfl_xor(a, 32);
      if (lane < 16) p.DT[(size_t)row * 16 + j] = softplus_f(a + p.dt_bias[j]);
    }
  }
}

__device__ void ph_hy_convT(const Params& p, float* sm) {
  const int tid = threadIdx.x;
  float* tile = sm;
  for (int item = blockIdx.x; item < 256 * 24; item += gridDim.x) {
    const int gr = item / 24, ct = item - gr * 24;
    const int row0 = gr * 64;
    {
      const int t = tid >> 3, c8 = (tid & 7) * 8;
      uint4 v = *(const uint4*)(p.PXb + (size_t)(row0 + t) * DP + ct * 64 + c8);
      unsigned w[4] = {v.x, v.y, v.z, v.w};
#pragma unroll
      for (int k = 0; k < 4; ++k) {
        tile[t * 65 + c8 + 2 * k] = __uint_as_float(w[k] << 16);
        tile[t * 65 + c8 + 2 * k + 1] = __uint_as_float(w[k] & 0xffff0000u);
      }
    }
    __syncthreads();
    {
      const int cc = tid >> 3, t8 = (tid & 7) * 8;
      const int col = ct * 64 + cc;
      const float w0 = p.hy_conv_w[col], w1 = p.hy_conv_w[HYC + col], w2 = p.hy_conv_w[2 * HYC + col], bb = p.hy_conv_b[col];
      float o[8];
#pragma unroll
      for (int k = 0; k < 8; ++k) {
        const int t = t8 + k;
        float v = bb + w1 * tile[t * 65 + cc];
        if (t > 0) v += w0 * tile[(t - 1) * 65 + cc];
        if (t < 63) v += w2 * tile[(t + 1) * 65 + cc];
        o[k] = v;
      }
      uint4 w; w.x = cvt_pk_bf16(o[0], o[1]); w.y = cvt_pk_bf16(o[2], o[3]); w.z = cvt_pk_bf16(o[4], o[5]); w.w = cvt_pk_bf16(o[6], o[7]);
      *(uint4*)(p.Ut + (size_t)col * T + row0 + t8) = w;
    }
    __syncthreads();
  }
}

__device__ void ph_hy_backT(const Params& p, float* sm) {
  const int tid = threadIdx.x;
  bf16_t* tile = (bf16_t*)sm;
  for (int item = blockIdx.x; item < 256 * 8; item += gridDim.x) {
    const int gr = item >> 3, ct = item & 7;
    const int row0 = gr * 64;
    {
      const int cc = tid >> 3, r8 = (tid & 7) * 8;
      uint4 v = *(const uint4*)(p.Ut + (size_t)(ct * 64 + cc) * T + row0 + r8);
      unsigned w[4] = {v.x, v.y, v.z, v.w};
#pragma unroll
      for (int k = 0; k < 4; ++k) {
        tile[cc * 66 + r8 + 2 * k] = (bf16_t)(w[k] & 0xffffu);
        tile[cc * 66 + r8 + 2 * k + 1] = (bf16_t)(w[k] >> 16);
      }
    }
    __syncthreads();
    {
      const int r = tid >> 3, c8 = (tid & 7) * 8;
      unsigned w[4];
#pragma unroll
      for (int k = 0; k < 4; ++k) w[k] = (unsigned)tile[(c8 + 2 * k) * 66 + r] | ((unsigned)tile[(c8 + 2 * k + 1) * 66 + r] << 16);
      uint4 o; o.x = w[0]; o.y = w[1]; o.z = w[2]; o.w = w[3];
      *(uint4*)(p.YMIXb + (size_t)(row0 + r) * D + ct * 64 + c8) = o;
    }
    __syncthreads();
  }
}

typedef short hbf16x8 __attribute__((ext_vector_type(8)));
typedef float hf32x4 __attribute__((ext_vector_type(4)));

constexpr int HY_FC = 0, HY_ZT0 = 4 * FCLEN * 2, HY_ZT1 = HY_ZT0 + 8 * ZSTRB;

__device__ __forceinline__ void hy_build_filter(const Params& p, int o, int c, unsigned char* lds) {
  const int tid = threadIdx.x;
  const bf16_t* gsrc = p.FILTt + (size_t)(o * 512 + c) * FLEN;
  for (int e = tid; e < 530; e += NTHR) {
    uint4 v = make_uint4(0u, 0u, 0u, 0u);
    if (e < 529) v = *(const uint4*)(gsrc + e * 8);
    *(uint4*)(lds + HY_FC + e * 16) = v;
  }
  __syncthreads();
  for (int g = tid; g < 3 * 530; g += NTHR) {
    const int r = 1 + g / 530, ch = g % 530;
    uint4 lo = make_uint4(0u, 0u, 0u, 0u);
    if (ch > 0) lo = *(const uint4*)(lds + HY_FC + (ch - 1) * 16);
    uint4 hi = *(const uint4*)(lds + HY_FC + ch * 16);
    unsigned W[8] = {lo.x, lo.y, lo.z, lo.w, hi.x, hi.y, hi.z, hi.w};
    uint4 ov;
    if (r == 1) {
      ov.x = __builtin_amdgcn_alignbyte(W[4], W[3], 2); ov.y = __builtin_amdgcn_alignbyte(W[5], W[4], 2);
      ov.z = __builtin_amdgcn_alignbyte(W[6], W[5], 2); ov.w = __builtin_amdgcn_alignbyte(W[7], W[6], 2);
    } else if (r == 2) {
      ov.x = W[3]; ov.y = W[4]; ov.z = W[5]; ov.w = W[6];
    } else {
      ov.x = __builtin_amdgcn_alignbyte(W[3], W[2], 2); ov.y = __builtin_amdgcn_alignbyte(W[4], W[3], 2);
      ov.z = __builtin_amdgcn_alignbyte(W[5], W[4], 2); ov.w = __builtin_amdgcn_alignbyte(W[6], W[5], 2);
    }
    *(uint4*)(lds + HY_FC + r * (FCLEN * 2) + ch * 16) = ov;
  }
  __syncthreads();
}

__device__ __forceinline__ void hy_order(const Params& p, int o, int c, unsigned char* lds) {
  const int tid = threadIdx.x, wid = __builtin_amdgcn_readfirstlane(tid >> 6), lane = tid & 63;
  const int g0 = wid * 4;
  const int n16 = lane & 15, h = lane >> 4, bb = n16 & 7, pp = n16 >> 3;
  const unsigned char* Zin = lds + (o ? HY_ZT1 : HY_ZT0);
  const bf16_t* gate = p.Ut + (size_t)((o + 1) * 512 + c) * T + bb * L;
  uint2 xg[4][2];
#pragma unroll
  for (int i = 0; i < 4; ++i)
#pragma unroll
    for (int u = 0; u < 2; ++u) xg[i][u] = *(const uint2*)(gate + 32 * (2 * (g0 + i) + pp) + 16 * u + 4 * h);
  const float bias = p.hy_bias[o * 512 + c];
  hf32x4 acc[4][2];
#pragma unroll
  for (int i = 0; i < 4; ++i)
#pragma unroll
    for (int u = 0; u < 2; ++u) acc[i][u] = (hf32x4){0.f, 0.f, 0.f, 0.f};
  const int ai = lane & 15, ar = ai & 3, aq = ai >> 2;
  const unsigned char* laneA = lds + HY_FC + ar * (FCLEN * 2) + 2 * (HX0 - 4 * aq + 8 * h);
  const unsigned char* laneB = Zin + bb * ZSTRB + 64 + 64 * pp + 16 * h;
#define HY_LDA(dst, Dd) do { const uint2 _lo = *(const uint2*)(laneA - 32 * (Dd)); const uint2 _hi = *(const uint2*)(laneA - 32 * (Dd) + 8); \
    union { uint4 u4; hbf16x8 v; } _cv; _cv.u4 = make_uint4(_lo.x, _lo.y, _hi.x, _hi.y); dst = _cv.v; } while (0)
#define HY_LDB(dst, Qq) do { dst = *(const hbf16x8*)(laneB + 64 * (Qq)); } while (0)
#pragma unroll 1
  for (int pass = 0; pass < 2; ++pass) {
    const int Es = 2 * g0 - 63 + pass;
    hbf16x8 R[4];
    HY_LDB(R[1], 2 * (g0 + 1) - Es); HY_LDB(R[2], 2 * (g0 + 2) - Es); HY_LDB(R[3], 2 * (g0 + 3) - Es);
#pragma unroll 1
    for (int n4 = 0; n4 < 9; ++n4) {
#pragma unroll
      for (int j = 0; j < 4; ++j) {
        const int n = n4 * 4 + j;
        const int E = Es + 2 * n;
        HY_LDB(R[(4 - j) & 3], 2 * (g0 - n) - Es);
        hbf16x8 A0, A1;
        HY_LDA(A0, 2 * E); HY_LDA(A1, 2 * E + 1);
#pragma unroll
        for (int i = 0; i < 4; ++i) {
          const int Q = 2 * (g0 + i - n) - Es;
          if (Q >= -1 && Q <= 63) {
            acc[i][0] = __builtin_amdgcn_mfma_f32_16x16x32_bf16(A0, R[(i - j) & 3], acc[i][0], 0, 0, 0);
            acc[i][1] = __builtin_amdgcn_mfma_f32_16x16x32_bf16(A1, R[(i - j) & 3], acc[i][1], 0, 0, 0);
          }
        }
      }
    }
  }
#undef HY_LDA
#undef HY_LDB
#pragma unroll
  for (int i = 0; i < 4; ++i)
#pragma unroll
    for (int u = 0; u < 2; ++u) {
      const int t0 = 32 * (2 * (g0 + i) + pp) + 16 * u + 4 * h;
      const uint2 zv = *(const uint2*)(Zin + bb * ZSTRB + 64 + 2 * t0);
      const float z0 = __uint_as_float(zv.x << 16), z1 = __uint_as_float(zv.x & 0xffff0000u), z2 = __uint_as_float(zv.y << 16), z3 = __uint_as_float(zv.y & 0xffff0000u);
      const float x0 = __uint_as_float(xg[i][u].x << 16), x1 = __uint_as_float(xg[i][u].x & 0xffff0000u), x2 = __uint_as_float(xg[i][u].y << 16), x3 = __uint_as_float(xg[i][u].y & 0xffff0000u);
      const float r0 = x0 * (acc[i][u][0] + z0 * bias), r1 = x1 * (acc[i][u][1] + z1 * bias), r2 = x2 * (acc[i][u][2] + z2 * bias), r3 = x3 * (acc[i][u][3] + z3 * bias);
      uint2 w; w.x = cvt_pk_bf16(r0, r1); w.y = cvt_pk_bf16(r2, r3);
      if (o == 0) *(uint2*)(lds + HY_ZT1 + bb * ZSTRB + 64 + 2 * t0) = w;
      else *(uint2*)(p.Ut + (size_t)c * T + bb * L + t0) = w;
    }
}

__device__ void hyena_unit(const Params& p, int c, unsigned char* lds) {
  const int tid = threadIdx.x;
  if (tid < 144) {
    const int buf = tid / 72, rem = tid % 72, b = rem / 9, k = rem % 9;
    const int off = (k < 4) ? (k * 16) : (4160 + (k - 4) * 16);
    *(uint4*)(lds + (buf ? HY_ZT1 : HY_ZT0) + b * ZSTRB + off) = make_uint4(0u, 0u, 0u, 0u);
  }
  for (int e = tid; e < 2048; e += NTHR) {
    const int b = e >> 8, ch = e & 255;
    *(uint4*)(lds + HY_ZT0 + b * ZSTRB + 64 + ch * 16) = *(const uint4*)(p.Ut + (size_t)c * T + b * L + ch * 8);
  }
#pragma unroll 1
  for (int o = 0; o < 2; ++o) {
    hy_build_filter(p, o, c, lds);
    hy_order(p, o, c, lds);
    __syncthreads();
  }
}

__device__ void ph_ssd_prep(const Params& p) {
  const int tid = threadIdx.x;
  for (int row = blockIdx.x; row < TT; row += gridDim.x) {
    bool has_prev, has_next;
    if (row < T) { int i = row & 63; has_prev = i > 0; has_next = i < 63; }
    else { int i = (row - T) & (LC - 1); has_prev = i > 0; has_next = i < LC - 1; }
    const bf16_t* px = p.PXb + (size_t)row * DP + COL_XBC;
    for (int ch = tid; ch < DXBC; ch += NTHR) {
      float v = p.ssd_conv_b[ch] + p.ssd_conv_w[DXBC + ch] * bf2f(px[ch]);
      if (has_prev) v += p.ssd_conv_w[ch] * bf2f(px[ch - DP]);
      if (has_next) v += p.ssd_conv_w[2 * DXBC + ch] * bf2f(px[ch + DP]);
      p.XBCb[(size_t)row * DXBC + ch] = f2bf(silu_f(v));
    }
  }
}

__device__ void ssd_scan_item(const Params& p, int item) {
  const int tid = threadIdx.x;
  const int dir = item & 1, h = (item >> 1) & 7, b = item >> 4;
  const int g = h >> 2;
  const int pch = tid >> 3, q = tid & 7;
  const float A = expf(p.a_log[dir * 8 + h]);
  float* Y = dir ? p.YB : p.YF;
  float st[16];
#pragma unroll
  for (int j = 0; j < 16; ++j) st[j] = 0.f;
  const int nsteps = LC + L;
  for (int s = 0; s < nsteps; ++s) {
    int row; bool latent;
    if (s < LC) { int t = dir ? (LC - 1 - s) : s; row = T + b * LC + t; latent = false; }
    else { int t = dir ? (L - 1 - (s - LC)) : (s - LC); row = b * L + t; latent = true; }
    const bf16_t* xb = p.XBCb + (size_t)row * DXBC;
    float dtv = p.DT[(size_t)row * 16 + dir * 8 + h];
    float dec = expf(-A * dtv);
    float xv = bf2f(xb[h * 64 + pch]) * dtv;
    const uint4* Bp = (const uint4*)(xb + 512 + g * 128 + q * 16);
    const uint4* Cp = (const uint4*)(xb + 768 + g * 128 + q * 16);
    float y = 0.f;
#pragma unroll
    for (int j8 = 0; j8 < 2; ++j8) {
      uint4 bv = Bp[j8], cv = Cp[j8];
      unsigned bw[4] = {bv.x, bv.y, bv.z, bv.w};
      unsigned cw[4] = {cv.x, cv.y, cv.z, cv.w};
#pragma unroll
      for (int u = 0; u < 4; ++u) {
        float b0 = __uint_as_float(bw[u] << 16), b1 = __uint_as_float(bw[u] & 0xffff0000u);
        float c0 = __uint_as_float(cw[u] << 16), c1 = __uint_as_float(cw[u] & 0xffff0000u);
        st[j8 * 8 + u * 2 + 0] = dec * st[j8 * 8 + u * 2 + 0] + b0 * xv; y += c0 * st[j8 * 8 + u * 2 + 0];
        st[j8 * 8 + u * 2 + 1] = dec * st[j8 * 8 + u * 2 + 1] + b1 * xv; y += c1 * st[j8 * 8 + u * 2 + 1];
      }
    }
    if (latent) {
      y += __shfl_xor(y, 1);
      y += __shfl_xor(y, 2);
      y += __shfl_xor(y, 4);
      if (q == 0) Y[(size_t)row * DS + h * 64 + pch] = y;
    }
  }
}

__device__ void ph_ssd_finish(const Params& p, float* sm) {
  const int tid = threadIdx.x, wid = tid >> 6;
  for (int row = blockIdx.x; row < T; row += gridDim.x) {
    const int ch = tid;
    float xs = bf2f(p.XBCb[(size_t)row * DXBC + ch]);
    float y = p.YF[(size_t)row * DS + ch] + p.YB[(size_t)row * DS + ch] + p.ssd_d[ch >> 6] * xs;
    float z = bf2f(p.PXb[(size_t)row * DP + COL_Z + ch]);
    float yv = y * silu_f(z);
    float s = wave_sum(yv * yv);
    __syncthreads();
    if ((tid & 63) == 0) sm[wid] = s;
    __syncthreads();
    const int hb = (wid >> 2) * 4;
    float tot = sm[hb] + sm[hb + 1] + sm[hb + 2] + sm[hb + 3];
    float r = rsqrtf(tot * (1.f / 256.f) + EPS);
    p.YMIXb[(size_t)row * D + 512 + ch] = f2bf(yv * r * p.ssd_norm_g[ch]);
  }
}

__device__ void ph_router(const Params& p, float* sm) {
  const int tid = threadIdx.x, wid = tid >> 6, lane = tid & 63;
  float* hs = sm + wid * 1200;
  float* lg = hs + 1024;
  for (int row = blockIdx.x * 8 + wid; row < T; row += gridDim.x * 8) {
    const float* src = p.X1 + (size_t)row * D;
    const float* sh = p.MOD + (row / L) * 6144 + 3072;
    const float* sc = sh + 1024;
    float4 v[4];
    float ss = 0.f;
#pragma unroll
    for (int i = 0; i < 4; ++i) {
      v[i] = *(const float4*)(src + i * 256 + lane * 4);
      ss += v[i].x * v[i].x + v[i].y * v[i].y + v[i].z * v[i].z + v[i].w * v[i].w;
    }
    ss = wave_sum(ss);
    const float rstd = rsqrtf(ss * (1.f / D) + EPS);
#pragma unroll
    for (int i = 0; i < 4; ++i) {
      const int col = i * 256 + lane * 4;
      float4 g = *(const float4*)(p.g2 + col);
      float4 s4 = *(const float4*)(sc + col);
      float4 h4 = *(const float4*)(sh + col);
      float4 o;
      o.x = v[i].x * rstd * g.x * (1.f + s4.x) + h4.x;
      o.y = v[i].y * rstd * g.y * (1.f + s4.y) + h4.y;
      o.z = v[i].z * rstd * g.z * (1.f + s4.z) + h4.z;
      o.w = v[i].w * rstd * g.w * (1.f + s4.w) + h4.w;
      uint2 wq; wq.x = cvt_pk_bf16(o.x, o.y); wq.y = cvt_pk_bf16(o.z, o.w);
      *(uint2*)(p.H2b + (size_t)row * D + col) = wq;
      *(float4*)(hs + col) = o;
    }
    {
      float a = p.b_expert[lane];
      const float* wp = p.w_expert + lane;
#pragma unroll 8
      for (int k = 0; k < D; ++k) a += hs[k] * wp[k * 64];
      lg[lane] = a;
      const int j = lane & 7, ks = lane >> 3;
      float gsum = 0.f;
      const float* gp = p.w_group + (ks * 128) * 8 + j;
      const float* hp = hs + ks * 128;
#pragma unroll 8
      for (int k = 0; k < 128; ++k) gsum += hp[k] * gp[k * 8];
      gsum += __shfl_xor(gsum, 8);
      gsum += __shfl_xor(gsum, 16);
      gsum += __shfl_xor(gsum, 32);
      if (lane < 8) lg[64 + lane] = gsum + p.b_group[lane];
    }
    if (lane == 0) {
      int gs = 0; float gm = lg[64];
      for (int j = 1; j < 8; ++j) if (lg[64 + j] > gm) { gm = lg[64 + j]; gs = j; }
      float den = 0.f;
      for (int j = 0; j < 8; ++j) den += expf(lg[64 + j] - gm);
      float pg = 1.f / den;
      const float* el = lg + gs * 8;
      int i0 = 0; float l0 = el[0];
      for (int j = 1; j < 8; ++j) if (el[j] > l0) { l0 = el[j]; i0 = j; }
      int i1 = -1; float l1 = -3.0e38f;
      for (int j = 0; j < 8; ++j) if (j != i0 && el[j] > l1) { l1 = el[j]; i1 = j; }
      float e1 = expf(l1 - l0);
      float w0 = 1.f / (1.f + e1), w1 = e1 / (1.f + e1);
      p.GATE[row * 2 + 0] = w0 * pg;
      p.GATE[row * 2 + 1] = w1 * pg;
      int ea = gs * 8 + i0, eb = gs * 8 + i1;
      int sa = atomicAdd(&p.CNT[ea], 1);
      p.LIST[ea * T + sa] = row * 2 + 0;
      int sb = atomicAdd(&p.CNT[eb], 1);
      p.LIST[eb * T + sb] = row * 2 + 1;
    }
  }
}

__device__ __forceinline__ void moe_table(const Params& p, int* tab) {
  if (threadIdx.x == 0) {
    int a = 0, sg = 0;
    for (int e = 0; e < NE; ++e) {
      int cn = p.CNT[e];
      tab[e] = a; tab[65 + e] = sg; tab[130 + e] = cn;
      a += (cn + 255) >> 8; sg += ((cn + 127) >> 7) << 7;
    }
    tab[NE] = a; tab[65 + NE] = sg;
  }
  __syncthreads();
}

__device__ void ph_final(const Params& p) {
  const int tid = threadIdx.x, wid = tid >> 6, lane = tid & 63;
  for (int row = blockIdx.x * 8 + wid; row < T; row += gridDim.x * 8) {
    const float* ga2 = p.MOD + (row / L) * 6144 + 5120;
    float4 v[4];
    float ss = 0.f;
#pragma unroll
    for (int i = 0; i < 4; ++i) {
      const int col = i * 256 + lane * 4;
      float4 xv = *(const float4*)(p.X1 + (size_t)row * D + col);
      uint2 a = *(const uint2*)(p.YB2b + (size_t)(row * 2) * D + col);
      uint2 b = *(const uint2*)(p.YB2b + (size_t)(row * 2 + 1) * D + col);
      float4 ga = *(const float4*)(ga2 + col);
      v[i].x = xv.x + ga.x * (__uint_as_float(a.x << 16) + __uint_as_float(b.x << 16));
      v[i].y = xv.y + ga.y * (__uint_as_float(a.x & 0xffff0000u) + __uint_as_float(b.x & 0xffff0000u));
      v[i].z = xv.z + ga.z * (__uint_as_float(a.y << 16) + __uint_as_float(b.y << 16));
      v[i].w = xv.w + ga.w * (__uint_as_float(a.y & 0xffff0000u) + __uint_as_float(b.y & 0xffff0000u));
      ss += v[i].x * v[i].x + v[i].y * v[i].y + v[i].z * v[i].z + v[i].w * v[i].w;
    }
    ss = wave_sum(ss);
    const float rstd = rsqrtf(ss * (1.f / D) + EPS);
#pragma unroll
    for (int i = 0; i < 4; ++i) {
      const int col = i * 256 + lane * 4;
      float4 gf = *(const float4*)(p.g_final + col);
      float4 o;
      o.x = v[i].x * rstd * gf.x; o.y = v[i].y * rstd * gf.y; o.z = v[i].z * rstd * gf.z; o.w = v[i].w * rstd * gf.w;
      *(float4*)(p.out + (size_t)row * D + col) = o;
    }
  }
}

constexpr int NPHASE = 11;

__global__ void __launch_bounds__(NTHR, 2) mega(Params p) {
  extern __shared__ __attribute__((aligned(16))) unsigned char lds_raw[];
  float* sm = (float*)lds_raw;
  PG8_LAS unsigned char* lds = (PG8_LAS unsigned char*)lds_raw;
  cg::grid_group grid = cg::this_grid();
  const int lo = p.lo, hi = p.hi;
#define IN(k) (lo <= (k) && (k) < hi)
#define SYNC(k) do { if (IN(k) && IN((k) + 1)) grid.sync(); } while (0)
#ifndef SKIP_OTHER
  if (IN(0)) { ph_adaln(p); ph_filters(p, sm); ph_wcvt(p, sm); }
  SYNC(0);
  if (IN(1)) ph_norm1(p, sm);
  SYNC(1);
#endif
#ifndef SKIP_GEMM
  if (IN(2)) {
    pg8::DenseOrder S{p.XNb, p.WinT, TT / 256, DP / 256, D, (int)gridDim.x, (int)blockIdx.x};
    pg8::EpiBf16 E{p.PXb, DP};
    pg8::gemm_phase<pg8::EpiBf16, pg8::DenseOrder>(lds, D, S, E);
  }
  SYNC(2);
#endif
#ifndef SKIP_OTHER
  if (IN(3)) {
    ph_ssd_prep(p);
    ph_hy_convT(p, sm);
  }
  SYNC(3);
  if (IN(4)) {
    for (int it = blockIdx.x; it < 128 + 512; it += gridDim.x) {
      if (it < 128) ssd_scan_item(p, it); else hyena_unit(p, it - 128, lds_raw);
    }
  }
  SYNC(4);
  if (IN(5)) { ph_ssd_finish(p, sm); ph_hy_backT(p, sm); }
  SYNC(5);
#endif
#ifndef SKIP_GEMM
  if (IN(6)) {
    pg8::DenseOrder S{p.YMIXb, p.WoutT, T / 256, D / 256, D, (int)gridDim.x, (int)blockIdx.x};
    pg8::EpiX1 E{p.x, p.MOD, p.X1};
    pg8::gemm_phase<pg8::EpiX1, pg8::DenseOrder>(lds, D, S, E);
  }
  SYNC(6);
#endif
#ifndef SKIP_OTHER
  if (IN(7)) ph_router(p, sm);
  SYNC(7);
#endif
#ifndef SKIP_GEMM
  if (IN(8)) {
    int* tab = (int*)(lds_raw + pg8::STAGE_BYTES);
    moe_table(p, tab);
    pg8::MoeOrder S{tab, p.H2b, p.Wup, p.LIST, 4, D, (int)gridDim.x, (int)blockIdx.x, true};
    pg8::EpiSwiGLU E{p.HBb};
    pg8::gemm_phase<pg8::EpiSwiGLU, pg8::MoeOrder>(lds, D, S, E);
  }
  SYNC(8);
  if (IN(9)) {
    int* tab = (int*)(lds_raw + pg8::STAGE_BYTES);
    moe_table(p, tab);
    pg8::MoeOrder S{tab, p.HBb, p.Wdn, p.LIST, 4, DE, (int)gridDim.x, (int)blockIdx.x, false};
    pg8::EpiDown E{p.YB2b, p.LIST, p.GATE};
    pg8::gemm_phase<pg8::EpiDown, pg8::MoeOrder>(lds, DE, S, E);
  }
  SYNC(9);
#endif
#ifndef SKIP_OTHER
  if (IN(10)) ph_final(p);
#endif
#undef IN
#undef SYNC
}

extern "C" void kernel_launch(void* const* d_in, const int* in_sizes, int n_in, void* d_out, int out_size,
                              void* d_ws, size_t ws_size, hipStream_t stream) {
  Params p{};
  const float* const* in = (const float* const*)d_in;
  p.x = in[0]; p.c = in[1]; p.ctx = in[2]; p.c_ctx = in[3]; p.w_ada = in[4]; p.b_ada = in[5];
  p.g1 = in[6]; p.g2 = in[7]; p.w_in = in[8]; p.hy_conv_w = in[9]; p.hy_conv_b = in[10];
  p.f_w1 = in[11]; p.f_b1 = in[12]; p.f_freq = in[13]; p.f_w2 = in[14]; p.f_b2 = in[15]; p.f_w3 = in[16];
  p.hy_bias = in[17]; p.ssd_conv_w = in[18]; p.ssd_conv_b = in[19]; p.a_log = in[20]; p.dt_bias = in[21];
  p.ssd_d = in[22]; p.ssd_norm_g = in[23]; p.w_out = in[24]; p.w_group = in[25]; p.b_group = in[26];
  p.w_expert = in[27]; p.b_expert = in[28]; p.w1 = in[29]; p.w3 = in[30]; p.w2 = in[31]; p.g_final = in[32];
  p.out = (float*)d_out;

  char* ws = (char*)d_ws;
  size_t off = 0;
  auto take = [&](size_t bytes) { char* r = ws + off; off += (bytes + 255) & ~(size_t)255; return r; };
  p.MOD = (float*)take((size_t)9 * 6144 * 4);
  p.CNT = (int*)take(NE * 4);
  p.GATE = (float*)take((size_t)T * 2 * 4);
  p.LIST = (int*)take((size_t)NE * T * 4);
  p.DT = (float*)take((size_t)TT * 16 * 4);
  p.FILTt = (bf16_t*)take((size_t)1024 * FLEN * 2);
  p.WinT = (bf16_t*)take((size_t)DP * D * 2);
  p.WoutT = (bf16_t*)take((size_t)D * D * 2);
  p.Wup = (bf16_t*)take((size_t)NE * 1024 * 1024 * 2);
  p.Wdn = (bf16_t*)take((size_t)NE * 1024 * 512 * 2);
  char* rPX = take((size_t)TT * DP * 2);
  char* rXBC = take((size_t)TT * DXBC * 2);
  char* rZ1 = take((size_t)HYC * T * 2);
  char* rYF = take((size_t)T * DS * 4);
  char* rYB = take((size_t)T * DS * 4);
  char* rYM = take((size_t)T * D * 2);
  p.PXb = (bf16_t*)rPX; p.XBCb = (bf16_t*)rXBC; p.Ut = (bf16_t*)rZ1; p.YF = (float*)rYF; p.YB = (float*)rYB; p.YMIXb = (bf16_t*)rYM;
  p.XNb = (bf16_t*)rZ1;
  p.X1 = (float*)rPX;
  p.H2b = (bf16_t*)rYM;
  p.HBb = (bf16_t*)rYF;
  p.YB2b = (bf16_t*)rXBC;
  if (off > ws_size) { fprintf(stderr, "workspace too small: need %zu have %zu\n", off, ws_size); return; }

  static int grid_blocks = 0;
  if (!grid_blocks) {
    int dev = 0, cus = 0, per_cu = 0;
    (void)hipGetDevice(&dev);
    (void)hipDeviceGetAttribute(&cus, hipDeviceAttributeMultiprocessorCount, dev);
    (void)hipFuncSetAttribute((const void*)mega, hipFuncAttributeMaxDynamicSharedMemorySize, LDS_BYTES);
    (void)hipOccupancyMaxActiveBlocksPerMultiprocessor(&per_cu, mega, NTHR, LDS_BYTES);
    if (per_cu < 1) { fprintf(stderr, "occupancy query returned %d\n", per_cu); per_cu = 1; }
    grid_blocks = cus;
  }
#ifndef ONE_LAUNCH
  for (int ph = 0; ph < NPHASE; ++ph) {
    p.lo = ph; p.hi = ph + 1;
    hipLaunchKernelGGL(mega, dim3(grid_blocks), dim3(NTHR), LDS_BYTES, stream, p);
  }
#else
  p.lo = 0; p.hi = NPHASE;
  void* args[] = {&p};
  hipError_t e = hipLaunchCooperativeKernel((void*)mega, dim3(grid_blocks), dim3(NTHR), args, LDS_BYTES, stream);
  if (e != hipSuccess) fprintf(stderr, "cooperative launch failed: %s (grid %d)\n", hipGetErrorString(e), grid_blocks);
#endif
}
```

```cpp
#define ONE_LAUNCH 1
#include <hip/hip_runtime.h>
#include <hip/hip_cooperative_groups.h>
#include <cstdio>
#include <cstdint>
namespace cg = cooperative_groups;

constexpr int D = 1024, NB = 8, L = 2048, LC = 256;
constexpr int T = NB * L;
constexpr int TC = NB * LC;
constexpr int TT = T + TC;
constexpr int DH = 512, HYC = 1536, DS = 512, DXBC = 1024, DIN = 3088, DP = 3072;
constexpr int COL_Z = 1536, COL_XBC = 2048, COL_DT = 3072;
constexpr int NE = 64, DE = 512;
constexpr float EPS = 1e-6f;
constexpr int NTHR = 512;
constexpr int LDS_BYTES = 132 * 1024;
constexpr int FLEN = 4232, HX0 = 2112, FCLEN = 4240, ZSTRB = 4240;

typedef unsigned short bf16_t;

struct Params {
  const float *x, *c, *ctx, *c_ctx, *w_ada, *b_ada, *g1, *g2, *w_in, *hy_conv_w, *hy_conv_b;
  const float *f_w1, *f_b1, *f_freq, *f_w2, *f_b2, *f_w3, *hy_bias;
  const float *ssd_conv_w, *ssd_conv_b, *a_log, *dt_bias, *ssd_d, *ssd_norm_g, *w_out;
  const float *w_group, *b_group, *w_expert, *b_expert, *w1, *w3, *w2, *g_final;
  float* out;
  float *MOD, *DT, *X1, *GATE, *ACUM, *CDEC;
  bf16_t *FILTt, *Ut, *Yt, *HIN, *XNb, *WinT, *WoutT, *PXb, *SST, *YMIXb, *YB2b, *Wup, *Wdn, *H2b, *HBb;
  int *CNT, *LIST;
  unsigned* BAR;
  int lo, hi;
};

__device__ __forceinline__ float silu_f(float v) { return v / (1.f + __expf(-v)); }
__device__ __forceinline__ float softplus_f(float v) { return v > 20.f ? v : log1pf(expf(v)); }
__device__ __forceinline__ float bf2f(bf16_t v) { return __uint_as_float(((unsigned)v) << 16); }
__device__ __forceinline__ unsigned cvt_pk_bf16(float lo, float hi) {
  unsigned r;
  asm volatile("v_cvt_pk_bf16_f32 %0, %1, %2" : "=v"(r) : "v"(lo), "v"(hi));
  return r;
}
__device__ __forceinline__ bf16_t f2bf(float f) { return (bf16_t)(cvt_pk_bf16(f, 0.f) & 0xffffu); }
__device__ __forceinline__ float wave_sum(float v) {
#pragma unroll
  for (int o = 32; o > 0; o >>= 1) v += __shfl_xor(v, o);
  return v;
}


#define XB_TMO      128
#define XB_XCNT(j)  (256  + 64 * (j))
#define XB_XSUB(j)  (1280 + 64 * (j))
#define XB_XGEN(j)  (2304 + 64 * (j))
#define XB_TOP      3328
#define XB_TOPGEN   3392
#define XCD_BAR_WORDS 3456
#define XB_SPIN_CAP (1u << 18)
#define LAS __attribute__((address_space(3)))
__device__ __forceinline__ unsigned xb_ld(unsigned* p) { return __hip_atomic_load(p, __ATOMIC_RELAXED, __HIP_MEMORY_SCOPE_AGENT); }
__device__ __forceinline__ unsigned xb_add(unsigned* p, unsigned v) { return __hip_atomic_fetch_add(p, v, __ATOMIC_RELAXED, __HIP_MEMORY_SCOPE_AGENT); }
__device__ __forceinline__ unsigned xb_xcc_id() { return (unsigned)__builtin_amdgcn_s_getreg((3 << 11) | 20) & 0xFu; }
#define XB_SPIN(cond, bar) do { unsigned _sp = 0; while (cond) { __builtin_amdgcn_s_sleep(1); \
    if ((++_sp & 255u) == 0u) { if (xb_ld(&(bar)[XB_TMO])) break; if (_sp > XB_SPIN_CAP) { atomicAdd(&(bar)[XB_TMO], 1u); break; } } } } while (0)
struct XcdBarrier { unsigned* bar; unsigned x; volatile LAS unsigned* st; };
__device__ __forceinline__ XcdBarrier xcd_barrier_post(unsigned* bar, volatile LAS unsigned* st) {
  XcdBarrier b; b.bar = bar; b.x = xb_xcc_id(); b.st = st;
  if (threadIdx.x == 0) (void)xb_add(&bar[XB_XCNT(b.x)], 1u);
  return b;
}
__device__ __forceinline__ void xcd_barrier_complete(unsigned* bar, unsigned x, unsigned& nloc, unsigned& nx) {
  const unsigned G = gridDim.x * gridDim.y * gridDim.z;
  unsigned sum, cnt, mine, sp = 0u;
  for (;;) {
    sum = 0u; cnt = 0u; mine = 0u;
#pragma unroll
    for (unsigned j = 0; j < 16; ++j) { const unsigned c = xb_ld(&bar[XB_XCNT(j)]); sum += c; cnt += (c > 0u) ? 1u : 0u; mine = (j == x) ? c : mine; }
    if (sum == G) break;
    __builtin_amdgcn_s_sleep(1);
    if ((++sp & 255u) == 0u) { if (xb_ld(&bar[XB_TMO])) break; if (sp > XB_SPIN_CAP) { atomicAdd(&bar[XB_TMO], 1u); break; } }
  }
  nloc = mine > 0u ? mine : 1u; nx = cnt > 0u ? cnt : 1u;
}
__device__ __forceinline__ void xcd_barrier(const XcdBarrier& b) {
  asm volatile("s_waitcnt vmcnt(0)" ::: "memory");
  __syncthreads();
  if (threadIdx.x == 0) {
    unsigned* bar = b.bar;
    __builtin_amdgcn_s_waitcnt(0);
    unsigned nloc = b.st[0], nx = b.st[1];
    if (nloc == 0u) { xcd_barrier_complete(bar, b.x, nloc, nx); b.st[0] = nloc; b.st[1] = nx; }
    const unsigned old = xb_add(&bar[XB_XSUB(b.x)], 1u);
    const unsigned gen = old / nloc;
    if (old + 1u == (gen + 1u) * nloc) {
      __builtin_amdgcn_fence(__ATOMIC_RELEASE, "agent");
      asm volatile("s_waitcnt vmcnt(0)" ::: "memory");
      const unsigned og = xb_add(&bar[XB_TOP], 1u);
      const unsigned tg = og / nx;
      if (og + 1u == (tg + 1u) * nx) xb_add(&bar[XB_TOPGEN], 1u);
      else XB_SPIN(xb_ld(&bar[XB_TOPGEN]) == tg, bar);
      __builtin_amdgcn_fence(__ATOMIC_ACQUIRE, "agent");
      xb_add(&bar[XB_XGEN(b.x)], 1u);
      asm volatile("s_waitcnt vmcnt(0)" ::: "memory");
    } else {
      XB_SPIN(xb_ld(&bar[XB_XGEN(b.x)]) == gen, bar);
      __builtin_amdgcn_fence(__ATOMIC_ACQUIRE, "agent");
      asm volatile("s_waitcnt vmcnt(0)" ::: "memory");
    }
  }
  __syncthreads();
}

namespace pg8 {
#define PG8_LAS __attribute__((address_space(3)))
typedef short bf16x8 __attribute__((ext_vector_type(8)));
typedef float f32x4 __attribute__((ext_vector_type(4)));
typedef unsigned u32x4 __attribute__((ext_vector_type(4)));
typedef unsigned u32x2 __attribute__((ext_vector_type(2)));
constexpr int BM = 256, BK = 64, HALF = 128, HTB = HALF * BK * 2, STAGE_BYTES = 8 * HTB, NXCD = 8, WGM = 8;

__host__ __device__ __forceinline__ int lds_byte(int r, int c) {
  const int st = (r >> 4) * 2 + (c >> 5), rr = r & 15, cc = c & 31, ob = rr * 64 + cc * 2;
  return st * 1024 + (ob ^ (((ob >> 9) & 1) << 5));
}
__host__ __device__ __forceinline__ void stage_rc(int b, int& R, int& C) {
  const int st = b / 1024, sb = b % 1024, swz = sb ^ (((sb >> 9) & 1) << 5);
  R = (st >> 1) * 16 + swz / 64; C = (st & 1) * 32 + (swz % 64) / 2;
}
__host__ __device__ __forceinline__ int perm32(int rho) { const int n = rho >> 4, i = rho & 15; return 8 * (i >> 2) + 4 * n + (i & 3); }

struct Unit { int pm, pn, e, mu, nv, cnt, seg; };

__device__ __forceinline__ bool static_next(int nM, int nN, int G, int c, int i, int& pm, int& pn) {
  const int nwg = nM * nN;
  const long Lx = (long)i * G + c; if (Lx >= nwg) return false;
  int wgid = (int)Lx;
  { const int q = nwg / NXCD, r = nwg % NXCD, xcd = wgid % NXCD, off = wgid / NXCD; wgid = (xcd < r ? xcd * (q + 1) : r * (q + 1) + (xcd - r) * q) + off; }
  const int nig = WGM * nN, gid = wgid / nig, fm = gid * WGM, gsz = (nM - fm) < WGM ? (nM - fm) : WGM;
  pm = fm + ((wgid % nig) % gsz); pn = (wgid % nig) / gsz; return true;
}

struct DenseOrder {
  const bf16_t* A; const bf16_t* Bt; int nM, nN, K, G, c;
  __device__ __forceinline__ bool next(int i, Unit& u) const {
    if (!static_next(nM, nN, G, c, i, u.pm, u.pn)) return false;
    u.e = 0; u.mu = 0; u.nv = 256; u.cnt = 256; u.seg = 0; return true;
  }
  __device__ __forceinline__ const char* a_base() const { return (const char*)A; }
  __device__ __forceinline__ const char* b_ptr(const Unit& u) const { return (const char*)Bt + (size_t)u.pn * 256 * K * 2; }
  __device__ __forceinline__ void a_offs(const Unit& u, const int (&R)[2], const int (&C)[2], unsigned (&ao)[2][2]) const {
#pragma unroll
    for (int h = 0; h < 2; ++h)
#pragma unroll
      for (int i = 0; i < 2; ++i) ao[h][i] = (unsigned)((u.pm * 256 + h * 128 + R[i]) * K + C[i]) * 2u;
  }
};

struct MoeOrder {
  const int* tab; const bf16_t* A; const bf16_t* Bt; const int* list; int NTn, K, G, c; bool gather;
  __device__ __forceinline__ bool next(int i, Unit& u) const {
    const int Lx = i * G + c;
    if (Lx >= tab[64] * NTn) return false;
    const int mg = Lx / NTn; u.pn = Lx - mg * NTn;
    int e = 0;
    while (tab[e + 1] <= mg) ++e;
    u.e = e; u.mu = mg - tab[e]; u.cnt = tab[130 + e]; u.seg = tab[65 + e];
    const int rem = u.cnt - u.mu * 256; u.nv = rem < 256 ? rem : 256; u.pm = 0; return true;
  }
  __device__ __forceinline__ const char* a_base() const { return (const char*)A; }
  __device__ __forceinline__ const char* b_ptr(const Unit& u) const { return (const char*)Bt + ((size_t)u.e * NTn + u.pn) * 256 * K * 2; }
  __device__ __forceinline__ void a_offs(const Unit& u, const int (&R)[2], const int (&C)[2], unsigned (&ao)[2][2]) const {
#pragma unroll
    for (int h = 0; h < 2; ++h)
#pragma unroll
      for (int i = 0; i < 2; ++i) {
        int idx = u.mu * 256 + h * 128 + R[i];
        int row;
        if (gather) { if (idx > u.cnt - 1) idx = u.cnt - 1; row = list[u.e * T + idx] >> 1; }
        else row = u.seg + idx;
        ao[h][i] = (unsigned)(row * K + C[i]) * 2u;
      }
  }
};

struct EpiBf16 {
  static constexpr bool PERM = true;
  bf16_t* O; int ldc;
  __device__ __forceinline__ void operator()(const f32x4 (&acc)[2][2][4][2], const Unit& u, int wr, int wc, int fr, int fq) const {
    const int row0 = u.pm * BM + wr * 64 + fr;
    const int col0 = u.pn * BM + wc * 32 + 8 * fq;
#pragma unroll
    for (int ai = 0; ai < 2; ++ai)
#pragma unroll
      for (int m = 0; m < 4; ++m) {
        bf16_t* rowp = O + (size_t)(row0 + ai * HALF + m * 16) * ldc + col0;
#pragma unroll
        for (int bj = 0; bj < 2; ++bj) {
          f32x4 v0 = acc[ai][bj][m][0], v1 = acc[ai][bj][m][1];
          u32x4 w; w.x = cvt_pk_bf16(v0[0], v0[1]); w.y = cvt_pk_bf16(v0[2], v0[3]); w.z = cvt_pk_bf16(v1[0], v1[1]); w.w = cvt_pk_bf16(v1[2], v1[3]);
          *(u32x4*)(rowp + bj * HALF) = w;
        }
      }
  }
};

struct EpiX1 {
  static constexpr bool PERM = false;
  const float* x; const float* mod; float* X1;
  __device__ __forceinline__ void operator()(const f32x4 (&acc)[2][2][4][2], const Unit& u, int wr, int wc, int fr, int fq) const {
    const int row0 = u.pm * BM + wr * 64 + fr, col0 = u.pn * BM + wc * 32 + 4 * fq;
    const float* ga = mod + ((u.pm * BM) / L) * 6144 + 2048 + col0;
    f32x4 gv[2][2];
#pragma unroll
    for (int bj = 0; bj < 2; ++bj)
#pragma unroll
      for (int n = 0; n < 2; ++n) gv[bj][n] = *(const f32x4*)(ga + bj * HALF + n * 16);
#pragma unroll
    for (int ai = 0; ai < 2; ++ai)
#pragma unroll
      for (int m = 0; m < 4; ++m) {
        const size_t off = (size_t)(row0 + ai * HALF + m * 16) * D + col0;
#pragma unroll
        for (int bj = 0; bj < 2; ++bj)
#pragma unroll
          for (int n = 0; n < 2; ++n) {
            const f32x4 xv = *(const f32x4*)(x + off + bj * HALF + n * 16);
            *(f32x4*)(X1 + off + bj * HALF + n * 16) = xv + gv[bj][n] * acc[ai][bj][m][n];
          }
      }
  }
};

struct EpiSwiGLU {
  static constexpr bool PERM = true;
  bf16_t* HBb;
  __device__ __forceinline__ void operator()(const f32x4 (&acc)[2][2][4][2], const Unit& u, int wr, int wc, int fr, int fq) const {
    const int col0 = u.pn * 128 + wc * 32 + 8 * fq;
#pragma unroll
    for (int ai = 0; ai < 2; ++ai)
#pragma unroll
      for (int m = 0; m < 4; ++m) {
        const int slot = u.mu * 256 + ai * HALF + wr * 64 + m * 16 + fr;
        if (slot < u.cnt) {
          float h[8];
#pragma unroll
          for (int n = 0; n < 2; ++n)
#pragma unroll
            for (int j = 0; j < 4; ++j) { const float a = acc[ai][0][m][n][j]; h[n * 4 + j] = a / (1.f + __expf(-a)) * acc[ai][1][m][n][j]; }
          u32x4 w; w.x = cvt_pk_bf16(h[0], h[1]); w.y = cvt_pk_bf16(h[2], h[3]); w.z = cvt_pk_bf16(h[4], h[5]); w.w = cvt_pk_bf16(h[6], h[7]);
          *(u32x4*)(HBb + (size_t)(u.seg + slot) * DE + col0) = w;
        }
      }
  }
};

struct EpiDown {
  static constexpr bool PERM = true;
  bf16_t* YB2b; const int* list; const float* gate;
  __device__ __forceinline__ void operator()(const f32x4 (&acc)[2][2][4][2], const Unit& u, int wr, int wc, int fr, int fq) const {
    const int col0 = u.pn * 256 + wc * 32 + 8 * fq;
#pragma unroll
    for (int ai = 0; ai < 2; ++ai)
#pragma unroll
      for (int m = 0; m < 4; ++m) {
        const int slot = u.mu * 256 + ai * HALF + wr * 64 + m * 16 + fr;
        if (slot < u.cnt) {
          const int pair = list[u.e * T + slot];
          const float gt = gate[pair];
          bf16_t* rowp = YB2b + (size_t)pair * D + col0;
#pragma unroll
          for (int bj = 0; bj < 2; ++bj) {
            f32x4 v0 = acc[ai][bj][m][0] * gt, v1 = acc[ai][bj][m][1] * gt;
            u32x4 w; w.x = cvt_pk_bf16(v0[0], v0[1]); w.y = cvt_pk_bf16(v0[2], v0[3]); w.z = cvt_pk_bf16(v1[0], v1[1]); w.w = cvt_pk_bf16(v1[2], v1[3]);
            *(u32x4*)(rowp + bj * HALF) = w;
          }
        }
      }
  }
};

template <class Epi, class Sched>
__device__ __forceinline__ void gemm_phase(PG8_LAS unsigned char* lds, const int K, const Sched& S, const Epi& E) {
  const int tid = threadIdx.x, wid = __builtin_amdgcn_readfirstlane(tid >> 6), lane = tid & 63, wr = wid >> 2, wc = wid & 3, fr = lane & 15, fq = lane >> 4;
  const int nt = K / BK;
  int Rr[2], Cc[2];
  unsigned voffB[2];
#pragma unroll
  for (int i = 0; i < 2; ++i) {
    stage_rc(tid * 16 + i * 8192, Rr[i], Cc[i]);
    const int Rb = Epi::PERM ? ((Rr[i] & ~31) + perm32(Rr[i] & 31)) : Rr[i];
    voffB[i] = (unsigned)(Rb * K + Cc[i]) * 2u;
  }
  const size_t kstep = (size_t)(BK * 2);
  const size_t hstep = (size_t)HALF * K * 2;
  const unsigned ldsw = (unsigned)wid * 1024u;
  const int aoff = lds_byte(wr * 64 + fr, fq * 8), boff = lds_byte(wc * 32 + fr, fq * 8);
#define PG8_SA(b, h) (((b) * 2 + (h)) * HTB)
#define PG8_SB(b, h) ((4 + (b) * 2 + (h)) * HTB)
#define PG8_STAGE(bufoff, gbase, voff) do { _Pragma("unroll") for (int _i = 0; _i < 2; ++_i) \
    __builtin_amdgcn_global_load_lds((const unsigned*)((const char*)(gbase) + (voff)[_i]), (PG8_LAS unsigned*)(lds + (bufoff) + ldsw + _i * 8192), 16, 0, 0); } while (0)
#define PG8_LDA(dst, b, h) do { _Pragma("unroll") for (int m = 0; m < 4; ++m) _Pragma("unroll") for (int k = 0; k < 2; ++k) dst[m][k] = *(const PG8_LAS bf16x8*)(lds + PG8_SA(b, h) + aoff + m * 2048 + k * 1024); } while (0)
#define PG8_LDB(dst, b, h) do { _Pragma("unroll") for (int n = 0; n < 2; ++n) _Pragma("unroll") for (int k = 0; k < 2; ++k) dst[n][k] = *(const PG8_LAS bf16x8*)(lds + PG8_SB(b, h) + boff + n * 2048 + k * 1024); } while (0)
#define PG8_MMA(ai, bj, At, Bt) do { __builtin_amdgcn_s_setprio(1); _Pragma("unroll") for (int m = 0; m < 4; ++m) _Pragma("unroll") for (int n = 0; n < 2; ++n) _Pragma("unroll") for (int k = 0; k < 2; ++k) \
    acc[ai][bj][m][n] = __builtin_amdgcn_mfma_f32_16x16x32_bf16(Bt[n][k], At[m][k], acc[ai][bj][m][n], 0, 0, 0); __builtin_amdgcn_s_setprio(0); } while (0)
#define PG8_WAIT_V(n) asm volatile("s_waitcnt vmcnt(" #n ")" ::: "memory")
#define PG8_WAIT_L(n) asm volatile("s_waitcnt lgkmcnt(" #n ")" ::: "memory")
#define PG8_BAR __builtin_amdgcn_s_barrier()
#define PG8_SCHED __builtin_amdgcn_sched_barrier(0)
  Unit cur, nxt; int ui = 0;
  if (!S.next(0, cur)) return;
  f32x4 acc[2][2][4][2];
#pragma unroll
  for (int a = 0; a < 2; ++a)
#pragma unroll
    for (int b = 0; b < 2; ++b)
#pragma unroll
      for (int m = 0; m < 4; ++m)
#pragma unroll
        for (int n = 0; n < 2; ++n) acc[a][b][m][n] = (f32x4){0.f, 0.f, 0.f, 0.f};
  bf16x8 At[4][2], B0[2][2], B1[2][2];
  unsigned cao[2][2], nao[2][2];
  S.a_offs(cur, Rr, Cc, cao);
  const char* const aB = S.a_base();
  const char* cB = S.b_ptr(cur);
  PG8_STAGE(PG8_SB(0, 0), cB, voffB); PG8_STAGE(PG8_SA(0, 0), aB, cao[0]); PG8_STAGE(PG8_SB(0, 1), cB + hstep, voffB); PG8_STAGE(PG8_SA(0, 1), aB, cao[1]);
  if (wr == 1) PG8_BAR;
  PG8_WAIT_V(4); PG8_BAR;
  PG8_STAGE(PG8_SB(1, 0), cB + kstep, voffB); PG8_STAGE(PG8_SA(1, 0), aB + kstep, cao[0]); PG8_STAGE(PG8_SB(1, 1), cB + hstep + kstep, voffB);
  PG8_WAIT_V(6); PG8_BAR;
  for (;;) {
    const bool has_next = S.next(ui + 1, nxt);
    const char* nB = cB;
    if (has_next) { S.a_offs(nxt, Rr, Cc, nao); nB = S.b_ptr(nxt); }
    else {
#pragma unroll
      for (int h = 0; h < 2; ++h)
#pragma unroll
        for (int i = 0; i < 2; ++i) nao[h][i] = cao[h][i];
    }
    const bool full = cur.nv > 128;
    for (int t = 0; t < nt; t += 2) {
      const bool last = (t == nt - 2);
      const char* a1 = aB + (size_t)(t + 1) * kstep;
      const char* a2 = last ? aB : aB + (size_t)(t + 2) * kstep; const char* b2 = last ? nB : cB + (size_t)(t + 2) * kstep;
      const char* a3 = a2 + kstep; const char* b3 = b2 + kstep;
      unsigned so[2][2];
#pragma unroll
      for (int h = 0; h < 2; ++h)
#pragma unroll
        for (int i = 0; i < 2; ++i) so[h][i] = last ? nao[h][i] : cao[h][i];
      PG8_LDB(B0, 0, 0); PG8_SCHED; PG8_LDA(At, 0, 0); PG8_STAGE(PG8_SA(1, 1), a1, cao[1]);
      PG8_WAIT_L(8); PG8_BAR; PG8_WAIT_L(0); PG8_MMA(0, 0, At, B0); PG8_BAR; PG8_SCHED;
      PG8_LDB(B1, 0, 1); PG8_STAGE(PG8_SB(0, 0), b2, voffB);
      PG8_BAR; PG8_WAIT_L(0); PG8_MMA(0, 1, At, B1); PG8_BAR;
      PG8_LDA(At, 0, 1); PG8_STAGE(PG8_SA(0, 0), a2, so[0]);
      PG8_BAR; PG8_WAIT_L(0); if (full) PG8_MMA(1, 0, At, B0); PG8_BAR; PG8_SCHED;
      PG8_STAGE(PG8_SB(0, 1), b2 + hstep, voffB);
      PG8_WAIT_V(6); PG8_BAR; if (full) PG8_MMA(1, 1, At, B1); PG8_BAR;
      PG8_LDB(B0, 1, 0); PG8_SCHED; PG8_LDA(At, 1, 0); PG8_STAGE(PG8_SA(0, 1), a2, so[1]);
      PG8_WAIT_L(8); PG8_BAR; PG8_WAIT_L(0); PG8_MMA(0, 0, At, B0); PG8_BAR; PG8_SCHED;
      PG8_LDB(B1, 1, 1); PG8_STAGE(PG8_SB(1, 0), b3, voffB);
      PG8_BAR; PG8_WAIT_L(0); PG8_MMA(0, 1, At, B1); PG8_BAR;
      PG8_LDA(At, 1, 1); PG8_STAGE(PG8_SA(1, 0), a3, so[0]);
      PG8_BAR; PG8_WAIT_L(0); if (full) PG8_MMA(1, 0, At, B0); PG8_BAR; PG8_SCHED;
      PG8_STAGE(PG8_SB(1, 1), b3 + hstep, voffB);
      PG8_WAIT_V(6); PG8_BAR; if (full) PG8_MMA(1, 1, At, B1); PG8_BAR;
    }
    E(acc, cur, wr, wc, fr, fq);
    if (!has_next) break;
#pragma unroll
    for (int a = 0; a < 2; ++a)
#pragma unroll
      for (int b = 0; b < 2; ++b)
#pragma unroll
        for (int m = 0; m < 4; ++m)
#pragma unroll
          for (int n = 0; n < 2; ++n) acc[a][b][m][n] = (f32x4){0.f, 0.f, 0.f, 0.f};
    cur = nxt; cB = nB; ++ui;
#pragma unroll
    for (int h = 0; h < 2; ++h)
#pragma unroll
      for (int i = 0; i < 2; ++i) cao[h][i] = nao[h][i];
  }
  PG8_WAIT_V(0);
  if (wr == 0) PG8_BAR;
  PG8_BAR;
#undef PG8_SA
#undef PG8_SB
#undef PG8_STAGE
#undef PG8_LDA
#undef PG8_LDB
#undef PG8_MMA
#undef PG8_WAIT_V
#undef PG8_WAIT_L
#undef PG8_BAR
#undef PG8_SCHED
}
}

__device__ void ph_adaln(const Params& p) {
  const int tid = threadIdx.x;
  if (blockIdx.x == 0 && tid < NE) p.CNT[tid] = 0;
  for (int idx = blockIdx.x * NTHR + tid; idx < 9 * 6144; idx += gridDim.x * NTHR) {
    int r = idx / 6144, j = idx - r * 6144;
    const float* cv = (r < 8) ? (p.c + r * D) : p.c_ctx;
    float acc = 0.f;
    for (int k = 0; k < D; ++k) acc += silu_f(cv[k]) * p.w_ada[(size_t)k * 6144 + j];
    p.MOD[idx] = acc + p.b_ada[j];
  }
}

__device__ void ph_filters(const Params& p, float* sm) {
  const int tid = threadIdx.x, wid = tid >> 6, lane = tid & 63;
  float* feats = sm;
  float* h1 = sm + 64 * 20;
  float* h2 = h1 + 64 * 64;
  bf16_t* tile = (bf16_t*)(h2 + 64 * 64);
  for (int e = blockIdx.x * NTHR + tid; e < 1024 * 137; e += gridDim.x * NTHR) {
    int rowi = e / 137, k = e - rowi * 137;
    int x = (k < 65) ? k : (4160 + (k - 65));
    p.FILTt[(size_t)rowi * FLEN + x] = 0;
  }
  for (int item = blockIdx.x; item < 256; item += gridDim.x) {
    const int tt = item >> 3, ct = item & 7;
    for (int e = tid; e < 64 * 17; e += NTHR) {
      int tp = e / 17, i = e - tp * 17;
      int t = tt * 64 + tp;
      float f;
      if (i == 0) f = (float)t / (float)(L - 1);
      else {
        int bi = (i - 1) & 7;
        float bandf = (float)(1e-4 + (double)bi * ((7.0 - 1e-4) / 7.0));
        float ang = (float)(2.0 * 3.14159265358979323846 / (double)L) * (float)t * bandf;
        f = (i <= 8) ? cosf(ang) : -sinf(ang);
      }
      feats[tp * 20 + i] = f;
    }
    __syncthreads();
    for (int e = tid; e < 4096; e += NTHR) {
      int tp = e >> 6, j = e & 63;
      float a = p.f_b1[j];
      for (int i = 0; i < 17; ++i) a += feats[tp * 20 + i] * p.f_w1[i * 64 + j];
      h1[e] = sinf(p.f_freq[j] * a);
    }
    __syncthreads();
    for (int e = tid; e < 4096; e += NTHR) {
      int tp = e >> 6, j = e & 63;
      float a = p.f_b2[j];
      for (int i = 0; i < 64; ++i) a += h1[tp * 64 + i] * p.f_w2[i * 64 + j];
      h2[e] = sinf(p.f_freq[j] * a);
    }
    __syncthreads();
    {
      const int col = tid & 255, half = tid >> 8;
      const int gcol = ct * 256 + col;
      float acc[32];
#pragma unroll
      for (int k = 0; k < 32; ++k) acc[k] = 0.f;
      for (int i = 0; i < 64; ++i) {
        float w = p.f_w3[i * 2048 + gcol];
#pragma unroll
        for (int k = 0; k < 32; ++k) acc[k] += h2[(half * 32 + k) * 64 + i] * w;
      }
      const int cch = gcol & 511;
      const float d0 = -4.605170185988091f / 1.5f, d1 = -4.605170185988091f / 0.3f;
      const float delta = fabsf(d0 + (float)cch * ((d1 - d0) / 511.f));
#pragma unroll
      for (int k = 0; k < 32; ++k) {
        int t = tt * 64 + half * 32 + k;
        float tn = (float)t / (float)(L - 1);
        tile[col * 66 + half * 32 + k] = f2bf(acc[k] * expf(-tn * delta));
      }
    }
    __syncthreads();
    for (int cl = wid * 32; cl < wid * 32 + 32; ++cl) {
      const int gcol = ct * 256 + cl;
      const int o = gcol >> 10, dir = (gcol >> 9) & 1, cch = gcol & 511;
      const int t = tt * 64 + lane;
      const int x = dir ? (HX0 + t) : (HX0 - t);
      if (!(dir && t == 0)) p.FILTt[(size_t)(o * 512 + cch) * FLEN + x] = tile[cl * 66 + lane];
    }
    __syncthreads();
  }
}

__device__ __forceinline__ void cvt_tile(const float* src, int ld, int k0, int n0, bf16_t* dst, int ldd, int drow0, float* sm) {
  const int tid = threadIdx.x;
  float* ts = sm;
  for (int e = tid; e < 1024; e += NTHR) {
    int k = e >> 4, n4 = (e & 15) * 4;
    float4 v = *(const float4*)(src + (size_t)(k0 + k) * ld + n0 + n4);
    ts[k * 65 + n4 + 0] = v.x; ts[k * 65 + n4 + 1] = v.y; ts[k * 65 + n4 + 2] = v.z; ts[k * 65 + n4 + 3] = v.w;
  }
  __syncthreads();
  {
    int n = tid >> 3, kq = (tid & 7) * 8;
    uint4 w;
    w.x = cvt_pk_bf16(ts[(kq + 0) * 65 + n], ts[(kq + 1) * 65 + n]);
    w.y = cvt_pk_bf16(ts[(kq + 2) * 65 + n], ts[(kq + 3) * 65 + n]);
    w.z = cvt_pk_bf16(ts[(kq + 4) * 65 + n], ts[(kq + 5) * 65 + n]);
    w.w = cvt_pk_bf16(ts[(kq + 6) * 65 + n], ts[(kq + 7) * 65 + n]);
    *(uint4*)(dst + (size_t)(drow0 + n) * ldd + k0 + kq) = w;
  }
  __syncthreads();
}

__device__ void ph_wcvt(const Params& p, float* sm) {
  for (int it = blockIdx.x; it < 768 + 256 + 16384 + 8192; it += gridDim.x) {
    if (it < 768) { int kt = it / 48, nt = it - kt * 48; cvt_tile(p.w_in, DIN, kt * 64, nt * 64, p.WinT, D, nt * 64, sm); }
    else if (it < 1024) { int i = it - 768; int kt = i >> 4, nt = i & 15; cvt_tile(p.w_out, D, kt * 64, nt * 64, p.WoutT, D, nt * 64, sm); }
    else if (it < 1024 + 16384) {
      int i = it - 1024; int e = i >> 8, r = i & 255; int which = r >> 7, r2 = r & 127; int kt = r2 >> 3, ct = r2 & 7;
      const float* src = (which ? p.w3 : p.w1) + (size_t)e * D * DE;
      int col0 = ct * 64;
      int drow0 = (col0 >> 7) * 256 + which * 128 + (col0 & 127);
      cvt_tile(src, DE, kt * 64, col0, p.Wup + (size_t)e * 1024 * 1024, D, drow0, sm);
    } else {
      int i = it - 1024 - 16384; int e = i >> 7, r = i & 127; int kt = r >> 4, nt = r & 15;
      cvt_tile(p.w2 + (size_t)e * DE * D, D, kt * 64, nt * 64, p.Wdn + (size_t)e * 1024 * 512, DE, nt * 64, sm);
    }
  }
}

__device__ void ph_norm1(const Params& p, float* sm) {
  const int tid = threadIdx.x, wid = tid >> 6, lane = tid & 63;
  float* wdt = sm;
  float* xs = sm + 16448 + wid * 1056;
  for (int e = tid; e < 4096; e += NTHR) {
    int k = e >> 2, q = e & 3;
    float4 v = *(const float4*)(p.w_in + (size_t)k * DIN + COL_DT + q * 4);
    *(float4*)(wdt + k * 16 + (k >> 8) * 16 + q * 4) = v;
  }
  __syncthreads();
  for (int row = blockIdx.x * 8 + wid; row < TT; row += gridDim.x * 8) {
    const float* src = (row < T) ? (p.x + (size_t)row * D) : (p.ctx + (size_t)(row - T) * D);
    const int mr = (row < T) ? (row / L) : 8;
    const float* sh = p.MOD + mr * 6144;
    const float* sc = sh + 1024;
    float4 v[4];
    float ss = 0.f;
#pragma unroll
    for (int i = 0; i < 4; ++i) {
      v[i] = *(const float4*)(src + i * 256 + lane * 4);
      ss += v[i].x * v[i].x + v[i].y * v[i].y + v[i].z * v[i].z + v[i].w * v[i].w;
    }
    ss = wave_sum(ss);
    const float rstd = rsqrtf(ss * (1.f / D) + EPS);
#pragma unroll
    for (int i = 0; i < 4; ++i) {
      const int col = i * 256 + lane * 4;
      float4 g = *(const float4*)(p.g1 + col);
      float4 s4 = *(const float4*)(sc + col);
      float4 h4 = *(const float4*)(sh + col);
      float4 o;
      o.x = v[i].x * rstd * g.x * (1.f + s4.x) + h4.x;
      o.y = v[i].y * rstd * g.y * (1.f + s4.y) + h4.y;
      o.z = v[i].z * rstd * g.z * (1.f + s4.z) + h4.z;
      o.w = v[i].w * rstd * g.w * (1.f + s4.w) + h4.w;
      uint2 w; w.x = cvt_pk_bf16(o.x, o.y); w.y = cvt_pk_bf16(o.z, o.w);
      *(uint2*)(p.XNb + (size_t)row * D + col) = w;
      *(float4*)(xs + col + i * 8) = o;
    }
    {
      const int j = lane & 15, ks = lane >> 4;
      const float* xp = xs + ks * 256 + ks * 8;
      const float* wp = wdt + (ks * 256) * 16 + ks * 16 + j;
      float a = 0.f;
#pragma unroll 8
      for (int k = 0; k < 256; ++k) a += xp[k] * wp[k * 16];
      a += __shfl_xor(a, 16);
      a += __shfl_xor(a, 32);
      if (lane < 16) p.DT[(size_t)row * 16 + j] = softplus_f(a + p.dt_bias[j]);
    }
  }
}

__device__ void ph_hy_convT(const Params& p, float* sm) {
  const int tid = threadIdx.x;
  float* tile = sm;
  for (int item = blockIdx.x; item < 256 * 24; item += gridDim.x) {
    const int gr = item / 24, ct = item - gr * 24;
    const int row0 = gr * 64;
    {
      const int t = tid >> 3, c8 = (tid & 7) * 8;
      uint4 v = *(const uint4*)(p.PXb + (size_t)(row0 + t) * DP + ct * 64 + c8);
      unsigned w[4] = {v.x, v.y, v.z, v.w};
#pragma unroll
      for (int k = 0; k < 4; ++k) {
        tile[t * 65 + c8 + 2 * k] = __uint_as_float(w[k] << 16);
        tile[t * 65 + c8 + 2 * k + 1] = __uint_as_float(w[k] & 0xffff0000u);
      }
    }
    __syncthreads();
    {
      const int cc = tid >> 3, t8 = (tid & 7) * 8;
      const int col = ct * 64 + cc;
      const float w0 = p.hy_conv_w[col], w1 = p.hy_conv_w[HYC + col], w2 = p.hy_conv_w[2 * HYC + col], bb = p.hy_conv_b[col];
      float o[8];
#pragma unroll
      for (int k = 0; k < 8; ++k) {
        const int t = t8 + k;
        float v = bb + w1 * tile[t * 65 + cc];
        if (t > 0) v += w0 * tile[(t - 1) * 65 + cc];
        if (t < 63) v += w2 * tile[(t + 1) * 65 + cc];
        o[k] = v;
      }
      uint4 w; w.x = cvt_pk_bf16(o[0], o[1]); w.y = cvt_pk_bf16(o[2], o[3]); w.z = cvt_pk_bf16(o[4], o[5]); w.w = cvt_pk_bf16(o[6], o[7]);
      *(uint4*)(p.Ut + (size_t)col * T + row0 + t8) = w;
    }
    __syncthreads();
  }
}

__device__ void ph_hy_backT(const Params& p, float* sm) {
  const int tid = threadIdx.x;
  bf16_t* tile = (bf16_t*)sm;
  for (int item = blockIdx.x; item < 256 * 8; item += gridDim.x) {
    const int gr = item >> 3, ct = item & 7;
    const int row0 = gr * 64;
    {
      const int cc = tid >> 3, r8 = (tid & 7) * 8;
      uint4 v = *(const uint4*)(p.Yt + (size_t)(ct * 64 + cc) * T + row0 + r8);
      unsigned w[4] = {v.x, v.y, v.z, v.w};
#pragma unroll
      for (int k = 0; k < 4; ++k) {
        tile[cc * 66 + r8 + 2 * k] = (bf16_t)(w[k] & 0xffffu);
        tile[cc * 66 + r8 + 2 * k + 1] = (bf16_t)(w[k] >> 16);
      }
    }
    __syncthreads();
    {
      const int r = tid >> 3, c8 = (tid & 7) * 8;
      unsigned w[4];
#pragma unroll
      for (int k = 0; k < 4; ++k) w[k] = (unsigned)tile[(c8 + 2 * k) * 66 + r] | ((unsigned)tile[(c8 + 2 * k + 1) * 66 + r] << 16);
      uint4 o; o.x = w[0]; o.y = w[1]; o.z = w[2]; o.w = w[3];
      *(uint4*)(p.YMIXb + (size_t)(row0 + r) * D + ct * 64 + c8) = o;
    }
    __syncthreads();
  }
}

typedef short hbf16x8 __attribute__((ext_vector_type(8)));
typedef float hf32x4 __attribute__((ext_vector_type(4)));

constexpr int HY_FC = 0, HY_ZT0 = 4 * FCLEN * 2, HY_ZT1 = HY_ZT0 + 8 * ZSTRB;

__device__ __forceinline__ void hy_build_filter(const Params& p, int o, int c, unsigned char* lds) {
  const int tid = threadIdx.x;
  const bf16_t* gsrc = p.FILTt + (size_t)(o * 512 + c) * FLEN;
  for (int e = tid; e < 530; e += NTHR) {
    uint4 v = make_uint4(0u, 0u, 0u, 0u);
    if (e < 529) v = *(const uint4*)(gsrc + e * 8);
    *(uint4*)(lds + HY_FC + e * 16) = v;
  }
  __syncthreads();
  for (int g = tid; g < 3 * 530; g += NTHR) {
    const int r = 1 + g / 530, ch = g % 530;
    uint4 lo = make_uint4(0u, 0u, 0u, 0u);
    if (ch > 0) lo = *(const uint4*)(lds + HY_FC + (ch - 1) * 16);
    uint4 hi = *(const uint4*)(lds + HY_FC + ch * 16);
    unsigned W[8] = {lo.x, lo.y, lo.z, lo.w, hi.x, hi.y, hi.z, hi.w};
    uint4 ov;
    if (r == 1) {
      ov.x = __builtin_amdgcn_alignbyte(W[4], W[3], 2); ov.y = __builtin_amdgcn_alignbyte(W[5], W[4], 2);
      ov.z = __builtin_amdgcn_alignbyte(W[6], W[5], 2); ov.w = __builtin_amdgcn_alignbyte(W[7], W[6], 2);
    } else if (r == 2) {
      ov.x = W[3]; ov.y = W[4]; ov.z = W[5]; ov.w = W[6];
    } else {
      ov.x = __builtin_amdgcn_alignbyte(W[3], W[2], 2); ov.y = __builtin_amdgcn_alignbyte(W[4], W[3], 2);
      ov.z = __builtin_amdgcn_alignbyte(W[5], W[4], 2); ov.w = __builtin_amdgcn_alignbyte(W[6], W[5], 2);
    }
    *(uint4*)(lds + HY_FC + r * (FCLEN * 2) + ch * 16) = ov;
  }
  __syncthreads();
}

__device__ __forceinline__ void hy_order(const Params& p, int o, int c, unsigned char* lds) {
  const int tid = threadIdx.x, wid = __builtin_amdgcn_readfirstlane(tid >> 6), lane = tid & 63;
  const int g0 = wid * 4;
  const int n16 = lane & 15, h = lane >> 4, bb = n16 & 7, pp = n16 >> 3;
  const unsigned char* Zin = lds + (o ? HY_ZT1 : HY_ZT0);
  const bf16_t* gate = p.Ut + (size_t)((o + 1) * 512 + c) * T + bb * L;
  uint2 xg[4][2];
#pragma unroll
  for (int i = 0; i < 4; ++i)
#pragma unroll
    for (int u = 0; u < 2; ++u) xg[i][u] = *(const uint2*)(gate + 32 * (2 * (g0 + i) + pp) + 16 * u + 4 * h);
  const float bias = p.hy_bias[o * 512 + c];
  hf32x4 acc[4][2];
#pragma unroll
  for (int i = 0; i < 4; ++i)
#pragma unroll
    for (int u = 0; u < 2; ++u) acc[i][u] = (hf32x4){0.f, 0.f, 0.f, 0.f};
  const int ai = lane & 15, ar = ai & 3, aq = ai >> 2;
  const unsigned char* laneA = lds + HY_FC + ar * (FCLEN * 2) + 2 * (HX0 - 4 * aq + 8 * h);
  const unsigned char* laneB = Zin + bb * ZSTRB + 64 + 64 * pp + 16 * h;
#define HY_LDA(dst, Dd) do { const uint2 _lo = *(const uint2*)(laneA - 32 * (Dd)); const uint2 _hi = *(const uint2*)(laneA - 32 * (Dd) + 8); \
    union { uint4 u4; hbf16x8 v; } _cv; _cv.u4 = make_uint4(_lo.x, _lo.y, _hi.x, _hi.y); dst = _cv.v; } while (0)
#define HY_LDB(dst, Qq) do { dst = *(const hbf16x8*)(laneB + 64 * (Qq)); } while (0)
#pragma unroll 1
  for (int pass = 0; pass < 2; ++pass) {
    const int Es = 2 * g0 - 63 + pass;
    hbf16x8 R[4];
    HY_LDB(R[1], 2 * (g0 + 1) - Es); HY_LDB(R[2], 2 * (g0 + 2) - Es); HY_LDB(R[3], 2 * (g0 + 3) - Es);
#pragma unroll 1
    for (int n4 = 0; n4 < 9; ++n4) {
#pragma unroll
      for (int j = 0; j < 4; ++j) {
        const int n = n4 * 4 + j;
        const int E = Es + 2 * n;
        HY_LDB(R[(4 - j) & 3], 2 * (g0 - n) - Es);
        hbf16x8 A0, A1;
        HY_LDA(A0, 2 * E); HY_LDA(A1, 2 * E + 1);
#pragma unroll
        for (int i = 0; i < 4; ++i) {
          const int Q = 2 * (g0 + i - n) - Es;
          if (Q >= -1 && Q <= 63) {
            acc[i][0] = __builtin_amdgcn_mfma_f32_16x16x32_bf16(A0, R[(i - j) & 3], acc[i][0], 0, 0, 0);
            acc[i][1] = __builtin_amdgcn_mfma_f32_16x16x32_bf16(A1, R[(i - j) & 3], acc[i][1], 0, 0, 0);
          }
        }
      }
    }
  }
#undef HY_LDA
#undef HY_LDB
#pragma unroll
  for (int i = 0; i < 4; ++i)
#pragma unroll
    for (int u = 0; u < 2; ++u) {
      const int t0 = 32 * (2 * (g0 + i) + pp) + 16 * u + 4 * h;
      const uint2 zv = *(const uint2*)(Zin + bb * ZSTRB + 64 + 2 * t0);
      const float z0 = __uint_as_float(zv.x << 16), z1 = __uint_as_float(zv.x & 0xffff0000u), z2 = __uint_as_float(zv.y << 16), z3 = __uint_as_float(zv.y & 0xffff0000u);
      const float x0 = __uint_as_float(xg[i][u].x << 16), x1 = __uint_as_float(xg[i][u].x & 0xffff0000u), x2 = __uint_as_float(xg[i][u].y << 16), x3 = __uint_as_float(xg[i][u].y & 0xffff0000u);
      const float r0 = x0 * (acc[i][u][0] + z0 * bias), r1 = x1 * (acc[i][u][1] + z1 * bias), r2 = x2 * (acc[i][u][2] + z2 * bias), r3 = x3 * (acc[i][u][3] + z3 * bias);
      uint2 w; w.x = cvt_pk_bf16(r0, r1); w.y = cvt_pk_bf16(r2, r3);
      if (o == 0) *(uint2*)(lds + HY_ZT1 + bb * ZSTRB + 64 + 2 * t0) = w;
      else *(uint2*)(p.Yt + (size_t)c * T + bb * L + t0) = w;
    }
}

__device__ void hyena_unit(const Params& p, int c, unsigned char* lds) {
  const int tid = threadIdx.x;
  if (tid < 144) {
    const int buf = tid / 72, rem = tid % 72, b = rem / 9, k = rem % 9;
    const int off = (k < 4) ? (k * 16) : (4160 + (k - 4) * 16);
    *(uint4*)(lds + (buf ? HY_ZT1 : HY_ZT0) + b * ZSTRB + off) = make_uint4(0u, 0u, 0u, 0u);
  }
  for (int e = tid; e < 2048; e += NTHR) {
    const int b = e >> 8, ch = e & 255;
    *(uint4*)(lds + HY_ZT0 + b * ZSTRB + 64 + ch * 16) = *(const uint4*)(p.Ut + (size_t)c * T + b * L + ch * 8);
  }
#pragma unroll 1
  for (int o = 0; o < 2; ++o) {
    hy_build_filter(p, o, c, lds);
    hy_order(p, o, c, lds);
    __syncthreads();
  }
}

constexpr int SROW = 272;

__device__ __forceinline__ void ssd_stage_nat(const Params& p, int row0, int pxcol0, int cvcol0, unsigned char* dst) {
  for (int e = threadIdx.x; e < 2048; e += NTHR) {
    const int l = e >> 4, cg = e & 15;
    const int row = row0 + l, li = row & 63;
    const bf16_t* src = p.PXb + (size_t)row * DP + pxcol0 + cg * 8;
    const uint4 zero4 = make_uint4(0u, 0u, 0u, 0u);
    const uint4 cur = *(const uint4*)src;
    const uint4 prv = (li > 0) ? *(const uint4*)(src - DP) : zero4;
    const uint4 nxt = (li < 63) ? *(const uint4*)(src + DP) : zero4;
    const float* cw = p.ssd_conv_w + cvcol0 + cg * 8;
    const float* cb = p.ssd_conv_b + cvcol0 + cg * 8;
    const unsigned pc[4] = {prv.x, prv.y, prv.z, prv.w}, cc[4] = {cur.x, cur.y, cur.z, cur.w}, nc[4] = {nxt.x, nxt.y, nxt.z, nxt.w};
    float o[8];
#pragma unroll
    for (int k = 0; k < 4; ++k) {
      const float p0 = __uint_as_float(pc[k] << 16), p1 = __uint_as_float(pc[k] & 0xffff0000u);
      const float c0 = __uint_as_float(cc[k] << 16), c1 = __uint_as_float(cc[k] & 0xffff0000u);
      const float n0 = __uint_as_float(nc[k] << 16), n1 = __uint_as_float(nc[k] & 0xffff0000u);
      const float v0 = cb[2 * k] + cw[2 * k] * p0 + cw[DXBC + 2 * k] * c0 + cw[2 * DXBC + 2 * k] * n0;
      const float v1 = cb[2 * k + 1] + cw[2 * k + 1] * p1 + cw[DXBC + 2 * k + 1] * c1 + cw[2 * DXBC + 2 * k + 1] * n1;
      o[2 * k] = silu_f(v0); o[2 * k + 1] = silu_f(v1);
    }
    uint4 w; w.x = cvt_pk_bf16(o[0], o[1]); w.y = cvt_pk_bf16(o[2], o[3]); w.z = cvt_pk_bf16(o[4], o[5]); w.w = cvt_pk_bf16(o[6], o[7]);
    *(uint4*)(dst + l * SROW + cg * 16) = w;
  }
}

__device__ __forceinline__ void ssd_stage_tr(const Params& p, int row0, bool is_ctx, int pxcol0, int cvcol0, int ncols, unsigned char* dst) {
  for (int e = threadIdx.x; e < ncols * 16; e += NTHR) {
    const int col = e & (ncols - 1), l8 = e / ncols;
    const int rowf = row0 + l8 * 8;
    bool has_prev, has_next;
    if (is_ctx) { const int tc = (rowf - T) & (LC - 1); has_prev = tc > 0; has_next = tc + 7 < LC - 1; }
    else { const int li = rowf & 63; has_prev = li > 0; has_next = li + 7 < 63; }
    const bf16_t* src = p.PXb + (size_t)rowf * DP + pxcol0 + col;
    float x[10];
    x[0] = (cvcol0 >= 0 && has_prev) ? bf2f(src[-DP]) : 0.f;
#pragma unroll
    for (int k = 0; k < 8; ++k) x[k + 1] = bf2f(src[(size_t)k * DP]);
    x[9] = (cvcol0 >= 0 && has_next) ? bf2f(src[(size_t)8 * DP]) : 0.f;
    float o[8];
    if (cvcol0 >= 0) {
      const float w0 = p.ssd_conv_w[cvcol0 + col], w1 = p.ssd_conv_w[DXBC + cvcol0 + col], w2 = p.ssd_conv_w[2 * DXBC + cvcol0 + col], bb = p.ssd_conv_b[cvcol0 + col];
#pragma unroll
      for (int k = 0; k < 8; ++k) o[k] = silu_f(bb + w0 * x[k] + w1 * x[k + 1] + w2 * x[k + 2]);
    } else {
#pragma unroll
      for (int k = 0; k < 8; ++k) o[k] = x[k + 1];
    }
    uint4 w; w.x = cvt_pk_bf16(o[0], o[1]); w.y = cvt_pk_bf16(o[2], o[3]); w.z = cvt_pk_bf16(o[4], o[5]); w.w = cvt_pk_bf16(o[6], o[7]);
    *(uint4*)(dst + col * SROW + l8 * 16) = w;
  }
}

__device__ void ssd_states_unit(const Params& p, int unit, unsigned char* lds) {
  const int tid = threadIdx.x, wid = __builtin_amdgcn_readfirstlane(tid >> 6), lane = tid & 63;
  const int g = unit & 1, bc = unit >> 1, cidx = bc % 18, b = bc / 18;
  const bool is_ctx = cidx < 2;
  const int row0 = is_ctx ? (T + b * LC + cidx * 128) : (b * L + (cidx - 2) * 128);
  unsigned char* XT = lds;
  unsigned char* BT = lds + 69632;
  unsigned char* XD = lds + 104448;
  float* WG = (float*)(lds + 121856);
  ssd_stage_tr(p, row0, is_ctx, COL_XBC + g * 256, g * 256, 256, XT);
  ssd_stage_tr(p, row0, is_ctx, COL_XBC + 512 + g * 128, 512 + g * 128, 128, BT);
  {
    const int dir = wid >> 2, hh = wid & 3, h = g * 4 + hh;
    const float A = expf(p.a_log[dir * 8 + h]);
    const int l0 = 2 * lane, l1 = l0 + 1;
    const float dt0 = p.DT[(size_t)(row0 + l0) * 16 + dir * 8 + h], dt1 = p.DT[(size_t)(row0 + l1) * 16 + dir * 8 + h];
    const float a0 = -A * dt0, a1 = -A * dt1, pair = a0 + a1;
    float incl = pair;
#pragma unroll
    for (int o = 1; o < 64; o <<= 1) { float t = __shfl_up(incl, o); if (lane >= o) incl += t; }
    const float excl = incl - pair;
    const float total = __shfl(incl, 63);
    float w0, w1, c0, c1;
    if (dir == 0) { c0 = excl + a0; c1 = excl + pair; w0 = dt0 * expf(total - c0); w1 = dt1 * expf(total - c1); }
    else { const float pe0 = excl, pe1 = excl + a0; w0 = dt0 * expf(pe0); w1 = dt1 * expf(pe1); c0 = total - pe0; c1 = total - pe1; }
    WG[wid * 128 + l0] = w0; WG[wid * 128 + l1] = w1;
    if (!is_ctx) { p.ACUM[(size_t)(row0 + l0) * 16 + dir * 8 + h] = c0; p.ACUM[(size_t)(row0 + l1) * 16 + dir * 8 + h] = c1; }
    if (lane == 0) {
      const int k = dir ? (is_ctx ? (1 - cidx) : (19 - cidx)) : cidx;
      p.CDEC[((b * 2 + dir) * 8 + h) * 18 + k] = expf(total);
    }
  }
  __syncthreads();
  const int fr = lane & 15, fq = lane >> 4;
#pragma unroll 1
  for (int it = 0; it < 8; ++it) {
    const int dir = it >> 2, hh = it & 3, h = g * 4 + hh;
    for (int e = tid; e < 1024; e += NTHR) {
      const int pr = e >> 4, ch = e & 15;
      const uint4 v = *(const uint4*)(XT + (hh * 64 + pr) * SROW + ch * 16);
      const float4 wa = *(const float4*)(WG + it * 128 + ch * 8), wb = *(const float4*)(WG + it * 128 + ch * 8 + 4);
      uint4 w;
      w.x = cvt_pk_bf16(__uint_as_float(v.x << 16) * wa.x, __uint_as_float(v.x & 0xffff0000u) * wa.y);
      w.y = cvt_pk_bf16(__uint_as_float(v.y << 16) * wa.z, __uint_as_float(v.y & 0xffff0000u) * wa.w);
      w.z = cvt_pk_bf16(__uint_as_float(v.z << 16) * wb.x, __uint_as_float(v.z & 0xffff0000u) * wb.y);
      w.w = cvt_pk_bf16(__uint_as_float(v.w << 16) * wb.z, __uint_as_float(v.w & 0xffff0000u) * wb.w);
      *(uint4*)(XD + pr * SROW + ch * 16) = w;
    }
    __syncthreads();
    hf32x4 acc[4];
#pragma unroll
    for (int pt = 0; pt < 4; ++pt) acc[pt] = (hf32x4){0.f, 0.f, 0.f, 0.f};
#pragma unroll
    for (int kk = 0; kk < 4; ++kk) {
      const hbf16x8 Bf = *(const hbf16x8*)(BT + (16 * wid + fr) * SROW + 2 * (32 * kk + 8 * fq));
#pragma unroll
      for (int pt = 0; pt < 4; ++pt) {
        const hbf16x8 Af = *(const hbf16x8*)(XD + (16 * pt + fr) * SROW + 2 * (32 * kk + 8 * fq));
        acc[pt] = __builtin_amdgcn_mfma_f32_16x16x32_bf16(Af, Bf, acc[pt], 0, 0, 0);
      }
    }
    const int k = dir ? (is_ctx ? (1 - cidx) : (19 - cidx)) : cidx;
    bf16_t* slot = p.SST + ((size_t)(((b * 2 + dir) * 8 + h) * 18 + k)) * 8192;
#pragma unroll
    for (int pt = 0; pt < 4; ++pt)
#pragma unroll
      for (int r = 0; r < 4; ++r) slot[(16 * pt + 4 * fq + r) * 128 + 16 * wid + fr] = f2bf(acc[pt][r]);
    __syncthreads();
  }
}

__device__ void ssd_scan_unit(const Params& p, int unit) {
  const int tid = threadIdx.x;
  const int half = unit & 1, seq = unit >> 1;
  const int pr = half * 32 + (tid >> 4), n8 = (tid & 15) * 8;
  const bf16_t* base = p.SST + (size_t)seq * 18 * 8192 + pr * 128 + n8;
  uint4 sv[18];
#pragma unroll
  for (int k = 0; k < 18; ++k) sv[k] = *(const uint4*)(base + (size_t)k * 8192);
  float hst[8];
#pragma unroll
  for (int j = 0; j < 8; ++j) hst[j] = 0.f;
#pragma unroll
  for (int k = 0; k < 18; ++k) {
    const float dec = p.CDEC[seq * 18 + k];
    if (k >= 2) {
      uint4 w; w.x = cvt_pk_bf16(hst[0], hst[1]); w.y = cvt_pk_bf16(hst[2], hst[3]); w.z = cvt_pk_bf16(hst[4], hst[5]); w.w = cvt_pk_bf16(hst[6], hst[7]);
      *(uint4*)(p.HIN + ((size_t)seq * 16 + (k - 2)) * 8192 + pr * 128 + n8) = w;
    }
    const unsigned sw[4] = {sv[k].x, sv[k].y, sv[k].z, sv[k].w};
#pragma unroll
    for (int u = 0; u < 4; ++u) {
      hst[2 * u] = dec * hst[2 * u] + __uint_as_float(sw[u] << 16);
      hst[2 * u + 1] = dec * hst[2 * u + 1] + __uint_as_float(sw[u] & 0xffff0000u);
    }
  }
}

__device__ void ssd_out_unit(const Params& p, int unit, unsigned char* lds) {
  const int tid = threadIdx.x, wid = __builtin_amdgcn_readfirstlane(tid >> 6), lane = tid & 63;
  const int fr = lane & 15, fq = lane >> 4;
  const int g = unit & 1, bc = unit >> 1, c = bc & 15, b = bc >> 4;
  const int row0 = b * L + c * 128;
  unsigned char* CS = lds;
  unsigned char* ML = lds + 34816;
  unsigned char* XT = lds + 69632;
  unsigned char* ZT = lds + 87040;
  unsigned char* HS = lds + 104448;
  float* CUM = (float*)(lds + 121856);
  float* DTL = (float*)(lds + 125952);
  ssd_stage_nat(p, row0, COL_XBC + 768 + g * 128, 768 + g * 128, CS);
  ssd_stage_nat(p, row0, COL_XBC + 512 + g * 128, 512 + g * 128, ML);
  for (int e = tid; e < 1024; e += NTHR) {
    const int it = e >> 7, l = e & 127, dir = it >> 2, hh = it & 3;
    CUM[e] = p.ACUM[(size_t)(row0 + l) * 16 + dir * 8 + g * 4 + hh];
    DTL[e] = p.DT[(size_t)(row0 + l) * 16 + dir * 8 + g * 4 + hh];
  }
  __syncthreads();
  hf32x4 cbt[8];
#pragma unroll
  for (int lt = 0; lt < 8; ++lt) cbt[lt] = (hf32x4){0.f, 0.f, 0.f, 0.f};
#pragma unroll
  for (int kk = 0; kk < 4; ++kk) {
    const hbf16x8 Af = *(const hbf16x8*)(ML + (16 * wid + fr) * SROW + 2 * (32 * kk + 8 * fq));
#pragma unroll
    for (int lt = 0; lt < 8; ++lt) {
      const hbf16x8 Bf = *(const hbf16x8*)(CS + (16 * lt + fr) * SROW + 2 * (32 * kk + 8 * fq));
      cbt[lt] = __builtin_amdgcn_mfma_f32_16x16x32_bf16(Af, Bf, cbt[lt], 0, 0, 0);
    }
  }
  __syncthreads();
  hf32x4 y[4][4];
#pragma unroll
  for (int hh = 0; hh < 4; ++hh)
#pragma unroll
    for (int pt = 0; pt < 4; ++pt) y[hh][pt] = (hf32x4){0.f, 0.f, 0.f, 0.f};
  const int sb = 16 * wid + 4 * fq;
#pragma unroll 1
  for (int hh = 0; hh < 4; ++hh) {
    const int h = g * 4 + hh;
    hf32x4 yc[4];
#pragma unroll
    for (int pt = 0; pt < 4; ++pt) yc[pt] = (hf32x4){0.f, 0.f, 0.f, 0.f};
    ssd_stage_tr(p, row0, false, COL_XBC + g * 256 + hh * 64, g * 256 + hh * 64, 64, XT);
    ssd_stage_tr(p, row0, false, COL_Z + g * 256 + hh * 64, -1, 64, ZT);
#pragma unroll 1
    for (int dir = 0; dir < 2; ++dir) {
      const int it = dir * 4 + hh;
      const int k = dir ? (17 - c) : (c + 2);
      const bf16_t* slot = p.HIN + ((size_t)(((b * 2 + dir) * 8 + h) * 16 + (k - 2))) * 8192;
      for (int e = tid; e < 1024; e += NTHR) {
        const int pr = e >> 4, ch = e & 15;
        *(uint4*)(HS + pr * SROW + ch * 16) = *(const uint4*)(slot + pr * 128 + ch * 8);
      }
      {
        const float* cu = CUM + it * 128; const float* dl = DTL + it * 128;
        float cs[4], ds[4];
#pragma unroll
        for (int r = 0; r < 4; ++r) { cs[r] = cu[sb + r]; ds[r] = dl[sb + r]; }
#pragma unroll
        for (int lt = 0; lt < 8; ++lt) {
          const int l = 16 * lt + fr;
          const float cl = cu[l];
          float m[4];
#pragma unroll
          for (int r = 0; r < 4; ++r) {
            const int sidx = sb + r;
            const bool ok = dir ? (sidx >= l) : (sidx <= l);
            m[r] = ok ? cbt[lt][r] * __expf(cl - cs[r]) * ds[r] : 0.f;
          }
          uint2 w; w.x = cvt_pk_bf16(m[0], m[1]); w.y = cvt_pk_bf16(m[2], m[3]);
          *(uint2*)(ML + l * SROW + 2 * sb) = w;
        }
      }
      __syncthreads();
      hf32x4 ad[4], ao[4];
#pragma unroll
      for (int pt = 0; pt < 4; ++pt) { ad[pt] = (hf32x4){0.f, 0.f, 0.f, 0.f}; ao[pt] = (hf32x4){0.f, 0.f, 0.f, 0.f}; }
#pragma unroll
      for (int kk = 0; kk < 4; ++kk) {
        const hbf16x8 Am = *(const hbf16x8*)(ML + (16 * wid + fr) * SROW + 2 * (32 * kk + 8 * fq));
        const hbf16x8 Ac = *(const hbf16x8*)(CS + (16 * wid + fr) * SROW + 2 * (32 * kk + 8 * fq));
#pragma unroll
        for (int pt = 0; pt < 4; ++pt) {
          const hbf16x8 Bx = *(const hbf16x8*)(XT + (16 * pt + fr) * SROW + 2 * (32 * kk + 8 * fq));
          const hbf16x8 Bh = *(const hbf16x8*)(HS + (16 * pt + fr) * SROW + 2 * (32 * kk + 8 * fq));
          ad[pt] = __builtin_amdgcn_mfma_f32_16x16x32_bf16(Am, Bx, ad[pt], 0, 0, 0);
          ao[pt] = __builtin_amdgcn_mfma_f32_16x16x32_bf16(Ac, Bh, ao[pt], 0, 0, 0);
        }
      }
      {
        const float* cu = CUM + it * 128;
        float ex[4];
#pragma unroll
        for (int r = 0; r < 4; ++r) ex[r] = __expf(cu[sb + r]);
#pragma unroll
        for (int pt = 0; pt < 4; ++pt)
#pragma unroll
          for (int r = 0; r < 4; ++r) yc[pt][r] += ad[pt][r] + ex[r] * ao[pt][r];
      }
      __syncthreads();
    }
    {
      const float dsk = p.ssd_d[h];
#pragma unroll
      for (int pt = 0; pt < 4; ++pt) {
        const uint2 xv = *(const uint2*)(XT + (16 * pt + fr) * SROW + 2 * sb);
        const uint2 zv = *(const uint2*)(ZT + (16 * pt + fr) * SROW + 2 * sb);
        const float xs4[4] = {__uint_as_float(xv.x << 16), __uint_as_float(xv.x & 0xffff0000u), __uint_as_float(xv.y << 16), __uint_as_float(xv.y & 0xffff0000u)};
        const float zs4[4] = {__uint_as_float(zv.x << 16), __uint_as_float(zv.x & 0xffff0000u), __uint_as_float(zv.y << 16), __uint_as_float(zv.y & 0xffff0000u)};
#pragma unroll
        for (int r = 0; r < 4; ++r) yc[pt][r] = (yc[pt][r] + dsk * xs4[r]) * silu_f(zs4[r]);
      }
    }
    if (hh == 0) {
#pragma unroll
      for (int pt = 0; pt < 4; ++pt) y[0][pt] = yc[pt];
    } else if (hh == 1) {
#pragma unroll
      for (int pt = 0; pt < 4; ++pt) y[1][pt] = yc[pt];
    } else if (hh == 2) {
#pragma unroll
      for (int pt = 0; pt < 4; ++pt) y[2][pt] = yc[pt];
    } else {
#pragma unroll
      for (int pt = 0; pt < 4; ++pt) y[3][pt] = yc[pt];
    }
    __syncthreads();
  }
  float rinv[4];
#pragma unroll
  for (int r = 0; r < 4; ++r) {
    float ss = 0.f;
#pragma unroll
    for (int hh = 0; hh < 4; ++hh)
#pragma unroll
      for (int pt = 0; pt < 4; ++pt) ss += y[hh][pt][r] * y[hh][pt][r];
    ss += __shfl_xor(ss, 1); ss += __shfl_xor(ss, 2); ss += __shfl_xor(ss, 4); ss += __shfl_xor(ss, 8);
    rinv[r] = rsqrtf(ss * (1.f / 256.f) + EPS);
  }
#pragma unroll
  for (int hh = 0; hh < 4; ++hh)
#pragma unroll
    for (int pt = 0; pt < 4; ++pt) {
      const int ch = g * 256 + hh * 64 + 16 * pt + fr;
      const float ng = p.ssd_norm_g[ch];
#pragma unroll
      for (int r = 0; r < 4; ++r) p.YMIXb[(size_t)(row0 + sb + r) * D + 512 + ch] = f2bf(y[hh][pt][r] * rinv[r] * ng);
    }
}

__device__ void ph_router(const Params& p, float* sm) {
  const int tid = threadIdx.x, wid = tid >> 6, lane = tid & 63;
  float* hs = sm + wid * 1200;
  float* lg = hs + 1024;
  for (int row = blockIdx.x * 8 + wid; row < T; row += gridDim.x * 8) {
    const float* src = p.X1 + (size_t)row * D;
    const float* sh = p.MOD + (row / L) * 6144 + 3072;
    const float* sc = sh + 1024;
    float4 v[4];
    float ss = 0.f;
#pragma unroll
    for (int i = 0; i < 4; ++i) {
      v[i] = *(const float4*)(src + i * 256 + lane * 4);
      ss += v[i].x * v[i].x + v[i].y * v[i].y + v[i].z * v[i].z + v[i].w * v[i].w;
    }
    ss = wave_sum(ss);
    const float rstd = rsqrtf(ss * (1.f / D) + EPS);
#pragma unroll
    for (int i = 0; i < 4; ++i) {
      const int col = i * 256 + lane * 4;
      float4 g = *(const float4*)(p.g2 + col);
      float4 s4 = *(const float4*)(sc + col);
      float4 h4 = *(const float4*)(sh + col);
      float4 o;
      o.x = v[i].x * rstd * g.x * (1.f + s4.x) + h4.x;
      o.y = v[i].y * rstd * g.y * (1.f + s4.y) + h4.y;
      o.z = v[i].z * rstd * g.z * (1.f + s4.z) + h4.z;
      o.w = v[i].w * rstd * g.w * (1.f + s4.w) + h4.w;
      uint2 wq; wq.x = cvt_pk_bf16(o.x, o.y); wq.y = cvt_pk_bf16(o.z, o.w);
      *(uint2*)(p.H2b + (size_t)row * D + col) = wq;
      *(float4*)(hs + col) = o;
    }
    {
      float a = p.b_expert[lane];
      const float* wp = p.w_expert + lane;
#pragma unroll 8
      for (int k = 0; k < D; ++k) a += hs[k] * wp[k * 64];
      lg[lane] = a;
      const int j = lane & 7, ks = lane >> 3;
      float gsum = 0.f;
      const float* gp = p.w_group + (ks * 128) * 8 + j;
      const float* hp = hs + ks * 128;
#pragma unroll 8
      for (int k = 0; k < 128; ++k) gsum += hp[k] * gp[k * 8];
      gsum += __shfl_xor(gsum, 8);
      gsum += __shfl_xor(gsum, 16);
      gsum += __shfl_xor(gsum, 32);
      if (lane < 8) lg[64 + lane] = gsum + p.b_group[lane];
    }
    if (lane == 0) {
      int gs = 0; float gm = lg[64];
      for (int j = 1; j < 8; ++j) if (lg[64 + j] > gm) { gm = lg[64 + j]; gs = j; }
      float den = 0.f;
      for (int j = 0; j < 8; ++j) den += expf(lg[64 + j] - gm);
      float pg = 1.f / den;
      const float* el = lg + gs * 8;
      int i0 = 0; float l0 = el[0];
      for (int j = 1; j < 8; ++j) if (el[j] > l0) { l0 = el[j]; i0 = j; }
      int i1 = -1; float l1 = -3.0e38f;
      for (int j = 0; j < 8; ++j) if (j != i0 && el[j] > l1) { l1 = el[j]; i1 = j; }
      float e1 = expf(l1 - l0);
      float w0 = 1.f / (1.f + e1), w1 = e1 / (1.f + e1);
      p.GATE[row * 2 + 0] = w0 * pg;
      p.GATE[row * 2 + 1] = w1 * pg;
      int ea = gs * 8 + i0, eb = gs * 8 + i1;
      int sa = atomicAdd(&p.CNT[ea], 1);
      p.LIST[ea * T + sa] = row * 2 + 0;
      int sb = atomicAdd(&p.CNT[eb], 1);
      p.LIST[eb * T + sb] = row * 2 + 1;
    }
  }
}

__device__ __forceinline__ void moe_table(const Params& p, int* tab) {
  if (threadIdx.x == 0) {
    int a = 0, sg = 0;
    for (int e = 0; e < NE; ++e) {
      int cn = p.CNT[e];
      tab[e] = a; tab[65 + e] = sg; tab[130 + e] = cn;
      a += (cn + 255) >> 8; sg += ((cn + 127) >> 7) << 7;
    }
    tab[NE] = a; tab[65 + NE] = sg;
  }
  __syncthreads();
}

__device__ void ph_final(const Params& p) {
  const int tid = threadIdx.x, wid = tid >> 6, lane = tid & 63;
  for (int row = blockIdx.x * 8 + wid; row < T; row += gridDim.x * 8) {
    const float* ga2 = p.MOD + (row / L) * 6144 + 5120;
    float4 v[4];
    float ss = 0.f;
#pragma unroll
    for (int i = 0; i < 4; ++i) {
      const int col = i * 256 + lane * 4;
      float4 xv = *(const float4*)(p.X1 + (size_t)row * D + col);
      uint2 a = *(const uint2*)(p.YB2b + (size_t)(row * 2) * D + col);
      uint2 b = *(const uint2*)(p.YB2b + (size_t)(row * 2 + 1) * D + col);
      float4 ga = *(const float4*)(ga2 + col);
      v[i].x = xv.x + ga.x * (__uint_as_float(a.x << 16) + __uint_as_float(b.x << 16));
      v[i].y = xv.y + ga.y * (__uint_as_float(a.x & 0xffff0000u) + __uint_as_float(b.x & 0xffff0000u));
      v[i].z = xv.z + ga.z * (__uint_as_float(a.y << 16) + __uint_as_float(b.y << 16));
      v[i].w = xv.w + ga.w * (__uint_as_float(a.y & 0xffff0000u) + __uint_as_float(b.y & 0xffff0000u));
      ss += v[i].x * v[i].x + v[i].y * v[i].y + v[i].z * v[i].z + v[i].w * v[i].w;
    }
    ss = wave_sum(ss);
    const float rstd = rsqrtf(ss * (1.f / D) + EPS);
#pragma unroll
    for (int i = 0; i < 4; ++i) {
      const int col = i * 256 + lane * 4;
      float4 gf = *(const float4*)(p.g_final + col);
      float4 o;
      o.x = v[i].x * rstd * gf.x; o.y = v[i].y * rstd * gf.y; o.z = v[i].z * rstd * gf.z; o.w = v[i].w * rstd * gf.w;
      *(float4*)(p.out + (size_t)row * D + col) = o;
    }
  }
}

constexpr int NPHASE = 11;

__global__ void __launch_bounds__(NTHR, 2) mega(Params p) {
  extern __shared__ __attribute__((aligned(16))) unsigned char lds_raw[];
  float* sm = (float*)lds_raw;
  PG8_LAS unsigned char* lds = (PG8_LAS unsigned char*)lds_raw;
  const int lo = p.lo, hi = p.hi;
  volatile LAS unsigned* xbst = (volatile LAS unsigned*)(lds + pg8::STAGE_BYTES + 2048);
  if (threadIdx.x < 4) xbst[threadIdx.x] = 0u;
  __syncthreads();
  XcdBarrier xbar; xbar.bar = p.BAR; xbar.x = 0; xbar.st = xbst;
  if (hi - lo > 1) xbar = xcd_barrier_post(p.BAR, xbst);
#define IN(k) (lo <= (k) && (k) < hi)
#define SYNC(k) do { if (IN(k) && IN((k) + 1)) xcd_barrier(xbar); } while (0)
#ifndef SKIP_OTHER
  if (IN(0)) { ph_adaln(p); ph_filters(p, sm); ph_wcvt(p, sm); }
  SYNC(0);
  if (IN(1)) ph_norm1(p, sm);
  SYNC(1);
#endif
#ifndef SKIP_GEMM
  if (IN(2)) {
    pg8::DenseOrder S{p.XNb, p.WinT, TT / 256, DP / 256, D, (int)gridDim.x, (int)blockIdx.x};
    pg8::EpiBf16 E{p.PXb, DP};
    pg8::gemm_phase<pg8::EpiBf16, pg8::DenseOrder>(lds, D, S, E);
  }
  SYNC(2);
#endif
#ifndef SKIP_OTHER
  if (IN(3)) {
    ph_hy_convT(p, sm);
    for (int it = blockIdx.x; it < 288; it += gridDim.x) ssd_states_unit(p, it, lds_raw);
  }
  SYNC(3);
  if (IN(4)) {
    for (int it = blockIdx.x; it < 256; it += gridDim.x) ssd_scan_unit(p, it);
    for (int it = blockIdx.x; it < 512; it += gridDim.x) hyena_unit(p, it, lds_raw);
  }
  SYNC(4);
  if (IN(5)) {
    for (int it = blockIdx.x; it < 256; it += gridDim.x) { ssd_out_unit(p, it, lds_raw); __syncthreads(); }
    ph_hy_backT(p, sm);
  }
  SYNC(5);
#endif
#ifndef SKIP_GEMM
  if (IN(6)) {
    pg8::DenseOrder S{p.YMIXb, p.WoutT, T / 256, D / 256, D, (int)gridDim.x, (int)blockIdx.x};
    pg8::EpiX1 E{p.x, p.MOD, p.X1};
    pg8::gemm_phase<pg8::EpiX1, pg8::DenseOrder>(lds, D, S, E);
  }
  SYNC(6);
#endif
#ifndef SKIP_OTHER
  if (IN(7)) ph_router(p, sm);
  SYNC(7);
#endif
#ifndef SKIP_GEMM
  if (IN(8)) {
    int* tab = (int*)(lds_raw + pg8::STAGE_BYTES);
    moe_table(p, tab);
    pg8::MoeOrder S{tab, p.H2b, p.Wup, p.LIST, 4, D, (int)gridDim.x, (int)blockIdx.x, true};
    pg8::EpiSwiGLU E{p.HBb};
    pg8::gemm_phase<pg8::EpiSwiGLU, pg8::MoeOrder>(lds, D, S, E);
  }
  SYNC(8);
  if (IN(9)) {
    int* tab = (int*)(lds_raw + pg8::STAGE_BYTES);
    moe_table(p, tab);
    pg8::MoeOrder S{tab, p.HBb, p.Wdn, p.LIST, 4, DE, (int)gridDim.x, (int)blockIdx.x, false};
    pg8::EpiDown E{p.YB2b, p.LIST, p.GATE};
    pg8::gemm_phase<pg8::EpiDown, pg8::MoeOrder>(lds, DE, S, E);
  }
  SYNC(9);
#endif
#ifndef SKIP_OTHER
  if (IN(10)) ph_final(p);
#endif
#undef IN
#undef SYNC
}

extern "C" void kernel_launch(void* const* d_in, const int* in_sizes, int n_in, void* d_out, int out_size,
                              void* d_ws, size_t ws_size, hipStream_t stream) {
  Params p{};
  const float* const* in = (const float* const*)d_in;
  p.x = in[0]; p.c = in[1]; p.ctx = in[2]; p.c_ctx = in[3]; p.w_ada = in[4]; p.b_ada = in[5];
  p.g1 = in[6]; p.g2 = in[7]; p.w_in = in[8]; p.hy_conv_w = in[9]; p.hy_conv_b = in[10];
  p.f_w1 = in[11]; p.f_b1 = in[12]; p.f_freq = in[13]; p.f_w2 = in[14]; p.f_b2 = in[15]; p.f_w3 = in[16];
  p.hy_bias = in[17]; p.ssd_conv_w = in[18]; p.ssd_conv_b = in[19]; p.a_log = in[20]; p.dt_bias = in[21];
  p.ssd_d = in[22]; p.ssd_norm_g = in[23]; p.w_out = in[24]; p.w_group = in[25]; p.b_group = in[26];
  p.w_expert = in[27]; p.b_expert = in[28]; p.w1 = in[29]; p.w3 = in[30]; p.w2 = in[31]; p.g_final = in[32];
  p.out = (float*)d_out;

  char* ws = (char*)d_ws;
  size_t off = 0;
  auto take = [&](size_t bytes) { char* r = ws + off; off += (bytes + 255) & ~(size_t)255; return r; };
  p.BAR = (unsigned*)take((size_t)XCD_BAR_WORDS * 4);
  p.MOD = (float*)take((size_t)9 * 6144 * 4);
  p.CNT = (int*)take(NE * 4);
  p.GATE = (float*)take((size_t)T * 2 * 4);
  p.LIST = (int*)take((size_t)NE * T * 4);
  p.DT = (float*)take((size_t)TT * 16 * 4);
  p.ACUM = (float*)take((size_t)T * 16 * 4);
  p.CDEC = (float*)take((size_t)128 * 18 * 4);
  p.FILTt = (bf16_t*)take((size_t)1024 * FLEN * 2);
  p.WinT = (bf16_t*)take((size_t)DP * D * 2);
  p.WoutT = (bf16_t*)take((size_t)D * D * 2);
  p.Wup = (bf16_t*)take((size_t)NE * 1024 * 1024 * 2);
  p.Wdn = (bf16_t*)take((size_t)NE * 1024 * 512 * 2);
  char* rPX = take((size_t)TT * DP * 2);
  char* rXBC = take((size_t)128 * 18 * 8192 * 2);
  char* rZ1 = take((size_t)HYC * T * 2);
  char* rYF = take((size_t)T * DS * 4);
  char* rYB = take((size_t)T * DS * 4);
  char* rYM = take((size_t)T * D * 2);
  p.PXb = (bf16_t*)rPX; p.SST = (bf16_t*)rXBC; p.Ut = (bf16_t*)rZ1; p.YMIXb = (bf16_t*)rYM;
  p.HIN = (bf16_t*)rYF;
  p.Yt = (bf16_t*)rYB;
  p.XNb = (bf16_t*)rZ1;
  p.X1 = (float*)rPX;
  p.H2b = (bf16_t*)rYM;
  p.HBb = (bf16_t*)rYF;
  p.YB2b = (bf16_t*)rXBC;
  if (off > ws_size) { fprintf(stderr, "workspace too small: need %zu have %zu\n", off, ws_size); return; }

  static int grid_blocks = 0;
  if (!grid_blocks) {
    int dev = 0, cus = 0, per_cu = 0;
    (void)hipGetDevice(&dev);
    (void)hipDeviceGetAttribute(&cus, hipDeviceAttributeMultiprocessorCount, dev);
    (void)hipFuncSetAttribute((const void*)mega, hipFuncAttributeMaxDynamicSharedMemorySize, LDS_BYTES);
    (void)hipOccupancyMaxActiveBlocksPerMultiprocessor(&per_cu, mega, NTHR, LDS_BYTES);
    if (per_cu < 1) { fprintf(stderr, "occupancy query returned %d\n", per_cu); per_cu = 1; }
    grid_blocks = cus;
  }
#ifndef ONE_LAUNCH
  for (int ph = 0; ph < NPHASE; ++ph) {
    p.lo = ph; p.hi = ph + 1;
    hipLaunchKernelGGL(mega, dim3(grid_blocks), dim3(NTHR), LDS_BYTES, stream, p);
  }
#else
  p.lo = 0; p.hi = NPHASE;
  (void)hipMemsetAsync(p.BAR, 0, (size_t)XCD_BAR_WORDS * 4, stream);
  void* args[] = {&p};
  hipError_t e = hipLaunchCooperativeKernel((void*)mega, dim3(grid_blocks), dim3(NTHR), args, LDS_BYTES, stream);
  if (e != hipSuccess) fprintf(stderr, "cooperative launch failed: %s (grid %d)\n", hipGetErrorString(e), grid_blocks);
#endif
}
```

```cpp
#define ONE_LAUNCH 1
#include <hip/hip_runtime.h>
#include <hip/hip_cooperative_groups.h>
#include <cstdio>
#include <cstdint>
namespace cg = cooperative_groups;

constexpr int D = 1024, NB = 8, L = 2048, LC = 256;
constexpr int T = NB * L;
constexpr int TC = NB * LC;
constexpr int TT = T + TC;
constexpr int DH = 512, HYC = 1536, DS = 512, DXBC = 1024, DIN = 3088, DP = 3072;
constexpr int COL_Z = 1536, COL_XBC = 2048, COL_DT = 3072;
constexpr int NE = 64, DE = 512;
constexpr float EPS = 1e-6f;
constexpr int NTHR = 512;
constexpr int LDS_BYTES = 132 * 1024;
constexpr int FLEN = 4232, HX0 = 2112, FCLEN = 4240, ZSTRB = 4240;

typedef unsigned short bf16_t;

struct Params {
  const float *x, *c, *ctx, *c_ctx, *w_ada, *b_ada, *g1, *g2, *w_in, *hy_conv_w, *hy_conv_b;
  const float *f_w1, *f_b1, *f_freq, *f_w2, *f_b2, *f_w3, *hy_bias;
  const float *ssd_conv_w, *ssd_conv_b, *a_log, *dt_bias, *ssd_d, *ssd_norm_g, *w_out;
  const float *w_group, *b_group, *w_expert, *b_expert, *w1, *w3, *w2, *g_final;
  float* out;
  float *MOD, *DT, *X1, *GATE, *ACUM, *CDEC;
  bf16_t *FILTt, *Ut, *Yt, *HIN, *XNb, *WinT, *WoutT, *PXb, *SST, *YMIXb, *YB2b, *Wup, *Wdn, *H2b, *HBb;
  int *CNT, *LIST;
  unsigned* BAR;
  int lo, hi;
};

__device__ __forceinline__ float silu_f(float v) { return v / (1.f + __expf(-v)); }
__device__ __forceinline__ float softplus_f(float v) { return v > 20.f ? v : log1pf(expf(v)); }
__device__ __forceinline__ float bf2f(bf16_t v) { return __uint_as_float(((unsigned)v) << 16); }
__device__ __forceinline__ unsigned cvt_pk_bf16(float lo, float hi) {
  typedef __bf16 bf2_t __attribute__((ext_vector_type(2)));
  typedef float f2_t __attribute__((ext_vector_type(2)));
  const f2_t v = {lo, hi};
  const bf2_t r = __builtin_convertvector(v, bf2_t);
  return __builtin_bit_cast(unsigned, r);
}
__device__ __forceinline__ bf16_t f2bf(float f) { return (bf16_t)(cvt_pk_bf16(f, 0.f) & 0xffffu); }
__device__ __forceinline__ void st_agent64(void* p, unsigned lo, unsigned hi) {
  __hip_atomic_store((unsigned long long*)p, ((unsigned long long)hi << 32) | lo, __ATOMIC_RELAXED, __HIP_MEMORY_SCOPE_AGENT);
}
__device__ __forceinline__ uint2 ld_agent64(const void* p) {
  const unsigned long long v = __hip_atomic_load((const unsigned long long*)p, __ATOMIC_RELAXED, __HIP_MEMORY_SCOPE_AGENT);
  return make_uint2((unsigned)v, (unsigned)(v >> 32));
}
__device__ __forceinline__ void st_agent32(float* p, float v) { __hip_atomic_store(p, v, __ATOMIC_RELAXED, __HIP_MEMORY_SCOPE_AGENT); }
__device__ __forceinline__ float ld_agent32(const float* p) { return __hip_atomic_load(p, __ATOMIC_RELAXED, __HIP_MEMORY_SCOPE_AGENT); }
__device__ __forceinline__ float wave_sum(float v) {
#pragma unroll
  for (int o = 32; o > 0; o >>= 1) v += __shfl_xor(v, o);
  return v;
}


#define XB_TMO      128
#define XB_XCNT(j)  (256  + 64 * (j))
#define XB_XSUB(j)  (1280 + 64 * (j))
#define XB_XGEN(j)  (2304 + 64 * (j))
#define XB_TOP      3328
#define XB_TOPGEN   3392
#define XCD_BAR_WORDS 3456
#define XB_SPIN_CAP (1u << 18)
#define LAS __attribute__((address_space(3)))
__device__ __forceinline__ unsigned xb_ld(unsigned* p) { return __hip_atomic_load(p, __ATOMIC_RELAXED, __HIP_MEMORY_SCOPE_AGENT); }
__device__ __forceinline__ unsigned xb_add(unsigned* p, unsigned v) { return __hip_atomic_fetch_add(p, v, __ATOMIC_RELAXED, __HIP_MEMORY_SCOPE_AGENT); }
__device__ __forceinline__ unsigned xb_xcc_id() { return (unsigned)__builtin_amdgcn_s_getreg((3 << 11) | 20) & 0xFu; }
#define XB_SPIN(cond, bar) do { unsigned _sp = 0; while (cond) { __builtin_amdgcn_s_sleep(1); \
    if ((++_sp & 255u) == 0u) { if (xb_ld(&(bar)[XB_TMO])) break; if (_sp > XB_SPIN_CAP) { atomicAdd(&(bar)[XB_TMO], 1u); break; } } } } while (0)
struct XcdBarrier { unsigned* bar; unsigned x; volatile LAS unsigned* st; };
__device__ __forceinline__ XcdBarrier xcd_barrier_post(unsigned* bar, volatile LAS unsigned* st) {
  XcdBarrier b; b.bar = bar; b.x = xb_xcc_id(); b.st = st;
  if (threadIdx.x == 0) (void)xb_add(&bar[XB_XCNT(b.x)], 1u);
  return b;
}
__device__ __forceinline__ void xcd_barrier_complete(unsigned* bar, unsigned x, unsigned& nloc, unsigned& nx) {
  const unsigned G = gridDim.x * gridDim.y * gridDim.z;
  unsigned sum, cnt, mine, sp = 0u;
  for (;;) {
    sum = 0u; cnt = 0u; mine = 0u;
#pragma unroll
    for (unsigned j = 0; j < 16; ++j) { const unsigned c = xb_ld(&bar[XB_XCNT(j)]); sum += c; cnt += (c > 0u) ? 1u : 0u; mine = (j == x) ? c : mine; }
    if (sum == G) break;
    __builtin_amdgcn_s_sleep(1);
    if ((++sp & 255u) == 0u) { if (xb_ld(&bar[XB_TMO])) break; if (sp > XB_SPIN_CAP) { atomicAdd(&bar[XB_TMO], 1u); break; } }
  }
  nloc = mine > 0u ? mine : 1u; nx = cnt > 0u ? cnt : 1u;
}
__device__ __forceinline__ void xcd_barrier(const XcdBarrier& b) {
  asm volatile("s_waitcnt vmcnt(0)" ::: "memory");
  __syncthreads();
  if (threadIdx.x == 0) {
    unsigned* bar = b.bar;
    __builtin_amdgcn_s_waitcnt(0);
    unsigned nloc = b.st[0], nx = b.st[1];
    if (nloc == 0u) { xcd_barrier_complete(bar, b.x, nloc, nx); b.st[0] = nloc; b.st[1] = nx; }
    const unsigned old = xb_add(&bar[XB_XSUB(b.x)], 1u);
    const unsigned gen = old / nloc;
    if (old + 1u == (gen + 1u) * nloc) {
      __builtin_amdgcn_fence(__ATOMIC_RELEASE, "agent");
      asm volatile("s_waitcnt vmcnt(0)" ::: "memory");
      const unsigned og = xb_add(&bar[XB_TOP], 1u);
      const unsigned tg = og / nx;
      if (og + 1u == (tg + 1u) * nx) xb_add(&bar[XB_TOPGEN], 1u);
      else XB_SPIN(xb_ld(&bar[XB_TOPGEN]) == tg, bar);
      __builtin_amdgcn_fence(__ATOMIC_ACQUIRE, "agent");
      xb_add(&bar[XB_XGEN(b.x)], 1u);
      asm volatile("s_waitcnt vmcnt(0)" ::: "memory");
    } else {
      XB_SPIN(xb_ld(&bar[XB_XGEN(b.x)]) == gen, bar);
      __builtin_amdgcn_fence(__ATOMIC_ACQUIRE, "agent");
      asm volatile("s_waitcnt vmcnt(0)" ::: "memory");
    }
  }
  __syncthreads();
}

namespace pg8 {
#define PG8_LAS __attribute__((address_space(3)))
typedef short bf16x8 __attribute__((ext_vector_type(8)));
typedef float f32x4 __attribute__((ext_vector_type(4)));
typedef unsigned u32x4 __attribute__((ext_vector_type(4)));
typedef unsigned u32x2 __attribute__((ext_vector_type(2)));
constexpr int BM = 256, BK = 64, HALF = 128, HTB = HALF * BK * 2, STAGE_BYTES = 8 * HTB, NXCD = 8, WGM = 8;

__host__ __device__ __forceinline__ int lds_byte(int r, int c) {
  const int st = (r >> 4) * 2 + (c >> 5), rr = r & 15, cc = c & 31, ob = rr * 64 + cc * 2;
  return st * 1024 + (ob ^ (((ob >> 9) & 1) << 5));
}
__host__ __device__ __forceinline__ void stage_rc(int b, int& R, int& C) {
  const int st = b / 1024, sb = b % 1024, swz = sb ^ (((sb >> 9) & 1) << 5);
  R = (st >> 1) * 16 + swz / 64; C = (st & 1) * 32 + (swz % 64) / 2;
}
__host__ __device__ __forceinline__ int perm32(int rho) { const int n = rho >> 4, i = rho & 15; return 8 * (i >> 2) + 4 * n + (i & 3); }

struct Unit { int pm, pn, e, mu, nv, cnt, seg; };

__device__ __forceinline__ bool static_next(int nM, int nN, int G, int c, int i, int& pm, int& pn) {
  const int nwg = nM * nN;
  const long Lx = (long)i * G + c; if (Lx >= nwg) return false;
  int wgid = (int)Lx;
  { const int q = nwg / NXCD, r = nwg % NXCD, xcd = wgid % NXCD, off = wgid / NXCD; wgid = (xcd < r ? xcd * (q + 1) : r * (q + 1) + (xcd - r) * q) + off; }
  const int nig = WGM * nN, gid = wgid / nig, fm = gid * WGM, gsz = (nM - fm) < WGM ? (nM - fm) : WGM;
  pm = fm + ((wgid % nig) % gsz); pn = (wgid % nig) / gsz; return true;
}

struct DenseOrder {
  const bf16_t* A; const bf16_t* Bt; int nM, nN, K, G, c;
  __device__ __forceinline__ bool next(int i, Unit& u) const {
    if (!static_next(nM, nN, G, c, i, u.pm, u.pn)) return false;
    u.e = 0; u.mu = 0; u.nv = 256; u.cnt = 256; u.seg = 0; return true;
  }
  __device__ __forceinline__ const char* a_base() const { return (const char*)A; }
  __device__ __forceinline__ const char* b_ptr(const Unit& u) const { return (const char*)Bt + (size_t)u.pn * 256 * K * 2; }
  __device__ __forceinline__ void a_offs(const Unit& u, const int (&R)[2], const int (&C)[2], unsigned (&ao)[2][2]) const {
#pragma unroll
    for (int h = 0; h < 2; ++h)
#pragma unroll
      for (int i = 0; i < 2; ++i) ao[h][i] = (unsigned)((u.pm * 256 + h * 128 + R[i]) * K + C[i]) * 2u;
  }
};

struct MoeOrder {
  const int* tab; const bf16_t* A; const bf16_t* Bt; const int* list; int NTn, K, G, c; bool gather;
  __device__ __forceinline__ bool next(int i, Unit& u) const {
    const int Lx = i * G + c;
    if (Lx >= tab[64] * NTn) return false;
    const int mg = Lx / NTn; u.pn = Lx - mg * NTn;
    int e = 0;
    while (tab[e + 1] <= mg) ++e;
    u.e = e; u.mu = mg - tab[e]; u.cnt = tab[130 + e]; u.seg = tab[65 + e];
    const int rem = u.cnt - u.mu * 256; u.nv = rem < 256 ? rem : 256; u.pm = 0; return true;
  }
  __device__ __forceinline__ const char* a_base() const { return (const char*)A; }
  __device__ __forceinline__ const char* b_ptr(const Unit& u) const { return (const char*)Bt + ((size_t)u.e * NTn + u.pn) * 256 * K * 2; }
  __device__ __forceinline__ void a_offs(const Unit& u, const int (&R)[2], const int (&C)[2], unsigned (&ao)[2][2]) const {
#pragma unroll
    for (int h = 0; h < 2; ++h)
#pragma unroll
      for (int i = 0; i < 2; ++i) {
        int idx = u.mu * 256 + h * 128 + R[i];
        int row;
        if (gather) { if (idx > u.cnt - 1) idx = u.cnt - 1; row = list[u.e * T + idx] >> 1; }
        else row = u.seg + idx;
        ao[h][i] = (unsigned)(row * K + C[i]) * 2u;
      }
  }
};

struct EpiBf16 {
  static constexpr bool PERM = true;
  bf16_t* O; int ldc;
  __device__ __forceinline__ void operator()(const f32x4 (&acc)[2][2][4][2], const Unit& u, int wr, int wc, int fr, int fq) const {
    const int row0 = u.pm * BM + wr * 64 + fr;
    const int col0 = u.pn * BM + wc * 32 + 8 * fq;
#pragma unroll
    for (int ai = 0; ai < 2; ++ai)
#pragma unroll
      for (int m = 0; m < 4; ++m) {
        bf16_t* rowp = O + (size_t)(row0 + ai * HALF + m * 16) * ldc + col0;
#pragma unroll
        for (int bj = 0; bj < 2; ++bj) {
          f32x4 v0 = acc[ai][bj][m][0], v1 = acc[ai][bj][m][1];
          u32x4 w; w.x = cvt_pk_bf16(v0[0], v0[1]); w.y = cvt_pk_bf16(v0[2], v0[3]); w.z = cvt_pk_bf16(v1[0], v1[1]); w.w = cvt_pk_bf16(v1[2], v1[3]);
          *(u32x4*)(rowp + bj * HALF) = w;
        }
      }
  }
};

struct EpiX1 {
  static constexpr bool PERM = false;
  const float* x; const float* mod; float* X1;
  __device__ __forceinline__ void operator()(const f32x4 (&acc)[2][2][4][2], const Unit& u, int wr, int wc, int fr, int fq) const {
    const int row0 = u.pm * BM + wr * 64 + fr, col0 = u.pn * BM + wc * 32 + 4 * fq;
    const float* ga = mod + ((u.pm * BM) / L) * 6144 + 2048 + col0;
    f32x4 gv[2][2];
#pragma unroll
    for (int bj = 0; bj < 2; ++bj)
#pragma unroll
      for (int n = 0; n < 2; ++n) gv[bj][n] = *(const f32x4*)(ga + bj * HALF + n * 16);
#pragma unroll
    for (int ai = 0; ai < 2; ++ai)
#pragma unroll
      for (int m = 0; m < 4; ++m) {
        const size_t off = (size_t)(row0 + ai * HALF + m * 16) * D + col0;
#pragma unroll
        for (int bj = 0; bj < 2; ++bj)
#pragma unroll
          for (int n = 0; n < 2; ++n) {
            const f32x4 xv = *(const f32x4*)(x + off + bj * HALF + n * 16);
            *(f32x4*)(X1 + off + bj * HALF + n * 16) = xv + gv[bj][n] * acc[ai][bj][m][n];
          }
      }
  }
};

struct EpiSwiGLU {
  static constexpr bool PERM = true;
  bf16_t* HBb;
  __device__ __forceinline__ void operator()(const f32x4 (&acc)[2][2][4][2], const Unit& u, int wr, int wc, int fr, int fq) const {
    const int col0 = u.pn * 128 + wc * 32 + 8 * fq;
#pragma unroll
    for (int ai = 0; ai < 2; ++ai)
#pragma unroll
      for (int m = 0; m < 4; ++m) {
        const int slot = u.mu * 256 + ai * HALF + wr * 64 + m * 16 + fr;
        if (slot < u.cnt) {
          float h[8];
#pragma unroll
          for (int n = 0; n < 2; ++n)
#pragma unroll
            for (int j = 0; j < 4; ++j) { const float a = acc[ai][0][m][n][j]; h[n * 4 + j] = a / (1.f + __expf(-a)) * acc[ai][1][m][n][j]; }
          u32x4 w; w.x = cvt_pk_bf16(h[0], h[1]); w.y = cvt_pk_bf16(h[2], h[3]); w.z = cvt_pk_bf16(h[4], h[5]); w.w = cvt_pk_bf16(h[6], h[7]);
          *(u32x4*)(HBb + (size_t)(u.seg + slot) * DE + col0) = w;
        }
      }
  }
};

struct EpiDown {
  static constexpr bool PERM = true;
  bf16_t* YB2b; const int* list; const float* gate;
  __device__ __forceinline__ void operator()(const f32x4 (&acc)[2][2][4][2], const Unit& u, int wr, int wc, int fr, int fq) const {
    const int col0 = u.pn * 256 + wc * 32 + 8 * fq;
#pragma unroll
    for (int ai = 0; ai < 2; ++ai)
#pragma unroll
      for (int m = 0; m < 4; ++m) {
        const int slot = u.mu * 256 + ai * HALF + wr * 64 + m * 16 + fr;
        if (slot < u.cnt) {
          const int pair = list[u.e * T + slot];
          const float gt = gate[pair];
          bf16_t* rowp = YB2b + (size_t)pair * D + col0;
#pragma unroll
          for (int bj = 0; bj < 2; ++bj) {
            f32x4 v0 = acc[ai][bj][m][0] * gt, v1 = acc[ai][bj][m][1] * gt;
            u32x4 w; w.x = cvt_pk_bf16(v0[0], v0[1]); w.y = cvt_pk_bf16(v0[2], v0[3]); w.z = cvt_pk_bf16(v1[0], v1[1]); w.w = cvt_pk_bf16(v1[2], v1[3]);
            *(u32x4*)(rowp + bj * HALF) = w;
          }
        }
      }
  }
};

template <class Epi, class Sched>
__device__ __forceinline__ void gemm_phase(PG8_LAS unsigned char* lds, const int K, const Sched& S, const Epi& E) {
  const int tid = threadIdx.x, wid = __builtin_amdgcn_readfirstlane(tid >> 6), lane = tid & 63, wr = wid >> 2, wc = wid & 3, fr = lane & 15, fq = lane >> 4;
  const int nt = K / BK;
  int Rr[2], Cc[2];
  unsigned voffB[2];
#pragma unroll
  for (int i = 0; i < 2; ++i) {
    stage_rc(tid * 16 + i * 8192, Rr[i], Cc[i]);
    const int Rb = Epi::PERM ? ((Rr[i] & ~31) + perm32(Rr[i] & 31)) : Rr[i];
    voffB[i] = (unsigned)(Rb * K + Cc[i]) * 2u;
  }
  const size_t kstep = (size_t)(BK * 2);
  const size_t hstep = (size_t)HALF * K * 2;
  const unsigned ldsw = (unsigned)wid * 1024u;
  const int aoff = lds_byte(wr * 64 + fr, fq * 8), boff = lds_byte(wc * 32 + fr, fq * 8);
#define PG8_SA(b, h) (((b) * 2 + (h)) * HTB)
#define PG8_SB(b, h) ((4 + (b) * 2 + (h)) * HTB)
#define PG8_STAGE(bufoff, gbase, voff) do { _Pragma("unroll") for (int _i = 0; _i < 2; ++_i) \
    __builtin_amdgcn_global_load_lds((const unsigned*)((const char*)(gbase) + (voff)[_i]), (PG8_LAS unsigned*)(lds + (bufoff) + ldsw + _i * 8192), 16, 0, 0); } while (0)
#define PG8_LDA(dst, b, h) do { _Pragma("unroll") for (int m = 0; m < 4; ++m) _Pragma("unroll") for (int k = 0; k < 2; ++k) dst[m][k] = *(const PG8_LAS bf16x8*)(lds + PG8_SA(b, h) + aoff + m * 2048 + k * 1024); } while (0)
#define PG8_LDB(dst, b, h) do { _Pragma("unroll") for (int n = 0; n < 2; ++n) _Pragma("unroll") for (int k = 0; k < 2; ++k) dst[n][k] = *(const PG8_LAS bf16x8*)(lds + PG8_SB(b, h) + boff + n * 2048 + k * 1024); } while (0)
#define PG8_MMA(ai, bj, At, Bt) do { __builtin_amdgcn_s_setprio(1); _Pragma("unroll") for (int m = 0; m < 4; ++m) _Pragma("unroll") for (int n = 0; n < 2; ++n) _Pragma("unroll") for (int k = 0; k < 2; ++k) \
    acc[ai][bj][m][n] = __builtin_amdgcn_mfma_f32_16x16x32_bf16(Bt[n][k], At[m][k], acc[ai][bj][m][n], 0, 0, 0); __builtin_amdgcn_s_setprio(0); } while (0)
#define PG8_WAIT_V(n) asm volatile("s_waitcnt vmcnt(" #n ")" ::: "memory")
#define PG8_WAIT_L(n) asm volatile("s_waitcnt lgkmcnt(" #n ")" ::: "memory")
#define PG8_BAR __builtin_amdgcn_s_barrier()
#define PG8_SCHED __builtin_amdgcn_sched_barrier(0)
  Unit cur, nxt; int ui = 0;
  if (!S.next(0, cur)) return;
  f32x4 acc[2][2][4][2];
#pragma unroll
  for (int a = 0; a < 2; ++a)
#pragma unroll
    for (int b = 0; b < 2; ++b)
#pragma unroll
      for (int m = 0; m < 4; ++m)
#pragma unroll
        for (int n = 0; n < 2; ++n) acc[a][b][m][n] = (f32x4){0.f, 0.f, 0.f, 0.f};
  bf16x8 At[4][2], B0[2][2], B1[2][2];
  unsigned cao[2][2], nao[2][2];
  S.a_offs(cur, Rr, Cc, cao);
  const char* const aB = S.a_base();
  const char* cB = S.b_ptr(cur);
  PG8_STAGE(PG8_SB(0, 0), cB, voffB); PG8_STAGE(PG8_SA(0, 0), aB, cao[0]); PG8_STAGE(PG8_SB(0, 1), cB + hstep, voffB); PG8_STAGE(PG8_SA(0, 1), aB, cao[1]);
  if (wr == 1) PG8_BAR;
  PG8_WAIT_V(4); PG8_BAR;
  PG8_STAGE(PG8_SB(1, 0), cB + kstep, voffB); PG8_STAGE(PG8_SA(1, 0), aB + kstep, cao[0]); PG8_STAGE(PG8_SB(1, 1), cB + hstep + kstep, voffB);
  PG8_WAIT_V(6); PG8_BAR;
  for (;;) {
    const bool has_next = S.next(ui + 1, nxt);
    const char* nB = cB;
    if (has_next) { S.a_offs(nxt, Rr, Cc, nao); nB = S.b_ptr(nxt); }
    else {
#pragma unroll
      for (int h = 0; h < 2; ++h)
#pragma unroll
        for (int i = 0; i < 2; ++i) nao[h][i] = cao[h][i];
    }
    const bool full = cur.nv > 128;
    for (int t = 0; t < nt; t += 2) {
      const bool last = (t == nt - 2);
      const char* a1 = aB + (size_t)(t + 1) * kstep;
      const char* a2 = last ? aB : aB + (size_t)(t + 2) * kstep; const char* b2 = last ? nB : cB + (size_t)(t + 2) * kstep;
      const char* a3 = a2 + kstep; const char* b3 = b2 + kstep;
      unsigned so[2][2];
#pragma unroll
      for (int h = 0; h < 2; ++h)
#pragma unroll
        for (int i = 0; i < 2; ++i) so[h][i] = last ? nao[h][i] : cao[h][i];
      PG8_LDB(B0, 0, 0); PG8_SCHED; PG8_LDA(At, 0, 0); PG8_STAGE(PG8_SA(1, 1), a1, cao[1]);
      PG8_WAIT_L(8); PG8_BAR; PG8_WAIT_L(0); PG8_MMA(0, 0, At, B0); PG8_BAR; PG8_SCHED;
      PG8_LDB(B1, 0, 1); PG8_STAGE(PG8_SB(0, 0), b2, voffB);
      PG8_BAR; PG8_WAIT_L(0); PG8_MMA(0, 1, At, B1); PG8_BAR;
      PG8_LDA(At, 0, 1); PG8_STAGE(PG8_SA(0, 0), a2, so[0]);
      PG8_BAR; PG8_WAIT_L(0); if (full) PG8_MMA(1, 0, At, B0); PG8_BAR; PG8_SCHED;
      PG8_STAGE(PG8_SB(0, 1), b2 + hstep, voffB);
      PG8_WAIT_V(6); PG8_BAR; if (full) PG8_MMA(1, 1, At, B1); PG8_BAR;
      PG8_LDB(B0, 1, 0); PG8_SCHED; PG8_LDA(At, 1, 0); PG8_STAGE(PG8_SA(0, 1), a2, so[1]);
      PG8_WAIT_L(8); PG8_BAR; PG8_WAIT_L(0); PG8_MMA(0, 0, At, B0); PG8_BAR; PG8_SCHED;
      PG8_LDB(B1, 1, 1); PG8_STAGE(PG8_SB(1, 0), b3, voffB);
      PG8_BAR; PG8_WAIT_L(0); PG8_MMA(0, 1, At, B1); PG8_BAR;
      PG8_LDA(At, 1, 1); PG8_STAGE(PG8_SA(1, 0), a3, so[0]);
      PG8_BAR; PG8_WAIT_L(0); if (full) PG8_MMA(1, 0, At, B0); PG8_BAR; PG8_SCHED;
      PG8_STAGE(PG8_SB(1, 1), b3 + hstep, voffB);
      PG8_WAIT_V(6); PG8_BAR; if (full) PG8_MMA(1, 1, At, B1); PG8_BAR;
    }
    E(acc, cur, wr, wc, fr, fq);
    if (!has_next) break;
#pragma unroll
    for (int a = 0; a < 2; ++a)
#pragma unroll
      for (int b = 0; b < 2; ++b)
#pragma unroll
        for (int m = 0; m < 4; ++m)
#pragma unroll
          for (int n = 0; n < 2; ++n) acc[a][b][m][n] = (f32x4){0.f, 0.f, 0.f, 0.f};
    cur = nxt; cB = nB; ++ui;
#pragma unroll
    for (int h = 0; h < 2; ++h)
#pragma unroll
      for (int i = 0; i < 2; ++i) cao[h][i] = nao[h][i];
  }
  PG8_WAIT_V(0);
  if (wr == 0) PG8_BAR;
  PG8_BAR;
#undef PG8_SA
#undef PG8_SB
#undef PG8_STAGE
#undef PG8_LDA
#undef PG8_LDB
#undef PG8_MMA
#undef PG8_WAIT_V
#undef PG8_WAIT_L
#undef PG8_BAR
#undef PG8_SCHED
}
}

__device__ void ph_adaln(const Params& p) {
  const int tid = threadIdx.x;
  if (blockIdx.x == 0 && tid < NE) p.CNT[tid] = 0;
  for (int idx = blockIdx.x * NTHR + tid; idx < 9 * 6144; idx += gridDim.x * NTHR) {
    int r = idx / 6144, j = idx - r * 6144;
    const float* cv = (r < 8) ? (p.c + r * D) : p.c_ctx;
    float acc = 0.f;
    for (int k = 0; k < D; ++k) acc += silu_f(cv[k]) * p.w_ada[(size_t)k * 6144 + j];
    p.MOD[idx] = acc + p.b_ada[j];
  }
}

__device__ void ph_filters(const Params& p, float* sm) {
  const int tid = threadIdx.x, wid = tid >> 6, lane = tid & 63;
  float* feats = sm;
  float* h1 = sm + 64 * 20;
  float* h2 = h1 + 64 * 64;
  bf16_t* tile = (bf16_t*)(h2 + 64 * 64);
  for (int e = blockIdx.x * NTHR + tid; e < 1024 * 137; e += gridDim.x * NTHR) {
    int rowi = e / 137, k = e - rowi * 137;
    int x = (k < 65) ? k : (4160 + (k - 65));
    p.FILTt[(size_t)rowi * FLEN + x] = 0;
  }
  for (int item = blockIdx.x; item < 256; item += gridDim.x) {
    const int tt = item >> 3, ct = item & 7;
    for (int e = tid; e < 64 * 17; e += NTHR) {
      int tp = e / 17, i = e - tp * 17;
      int t = tt * 64 + tp;
      float f;
      if (i == 0) f = (float)t / (float)(L - 1);
      else {
        int bi = (i - 1) & 7;
        float bandf = (float)(1e-4 + (double)bi * ((7.0 - 1e-4) / 7.0));
        float ang = (float)(2.0 * 3.14159265358979323846 / (double)L) * (float)t * bandf;
        f = (i <= 8) ? cosf(ang) : -sinf(ang);
      }
      feats[tp * 20 + i] = f;
    }
    __syncthreads();
    for (int e = tid; e < 4096; e += NTHR) {
      int tp = e >> 6, j = e & 63;
      float a = p.f_b1[j];
      for (int i = 0; i < 17; ++i) a += feats[tp * 20 + i] * p.f_w1[i * 64 + j];
      h1[e] = sinf(p.f_freq[j] * a);
    }
    __syncthreads();
    for (int e = tid; e < 4096; e += NTHR) {
      int tp = e >> 6, j = e & 63;
      float a = p.f_b2[j];
      for (int i = 0; i < 64; ++i) a += h1[tp * 64 + i] * p.f_w2[i * 64 + j];
      h2[e] = sinf(p.f_freq[j] * a);
    }
    __syncthreads();
    {
      const int col = tid & 255, half = tid >> 8;
      const int gcol = ct * 256 + col;
      float acc[32];
#pragma unroll
      for (int k = 0; k < 32; ++k) acc[k] = 0.f;
      for (int i = 0; i < 64; ++i) {
        float w = p.f_w3[i * 2048 + gcol];
#pragma unroll
        for (int k = 0; k < 32; ++k) acc[k] += h2[(half * 32 + k) * 64 + i] * w;
      }
      const int cch = gcol & 511;
      const float d0 = -4.605170185988091f / 1.5f, d1 = -4.605170185988091f / 0.3f;
      const float delta = fabsf(d0 + (float)cch * ((d1 - d0) / 511.f));
#pragma unroll
      for (int k = 0; k < 32; ++k) {
        int t = tt * 64 + half * 32 + k;
        float tn = (float)t / (float)(L - 1);
        tile[col * 66 + half * 32 + k] = f2bf(acc[k] * expf(-tn * delta));
      }
    }
    __syncthreads();
    for (int cl = wid * 32; cl < wid * 32 + 32; ++cl) {
      const int gcol = ct * 256 + cl;
      const int o = gcol >> 10, dir = (gcol >> 9) & 1, cch = gcol & 511;
      const int t = tt * 64 + lane;
      const int x = dir ? (HX0 + t) : (HX0 - t);
      if (!(dir && t == 0)) p.FILTt[(size_t)(o * 512 + cch) * FLEN + x] = tile[cl * 66 + lane];
    }
    __syncthreads();
  }
}

__device__ __forceinline__ void cvt_tile(const float* src, int ld, int k0, int n0, bf16_t* dst, int ldd, int drow0, float* sm) {
  const int tid = threadIdx.x;
  float* ts = sm;
  for (int e = tid; e < 1024; e += NTHR) {
    int k = e >> 4, n4 = (e & 15) * 4;
    float4 v = *(const float4*)(src + (size_t)(k0 + k) * ld + n0 + n4);
    ts[k * 65 + n4 + 0] = v.x; ts[k * 65 + n4 + 1] = v.y; ts[k * 65 + n4 + 2] = v.z; ts[k * 65 + n4 + 3] = v.w;
  }
  __syncthreads();
  {
    int n = tid >> 3, kq = (tid & 7) * 8;
    uint4 w;
    w.x = cvt_pk_bf16(ts[(kq + 0) * 65 + n], ts[(kq + 1) * 65 + n]);
    w.y = cvt_pk_bf16(ts[(kq + 2) * 65 + n], ts[(kq + 3) * 65 + n]);
    w.z = cvt_pk_bf16(ts[(kq + 4) * 65 + n], ts[(kq + 5) * 65 + n]);
    w.w = cvt_pk_bf16(ts[(kq + 6) * 65 + n], ts[(kq + 7) * 65 + n]);
    *(uint4*)(dst + (size_t)(drow0 + n) * ldd + k0 + kq) = w;
  }
  __syncthreads();
}

__device__ void ph_wcvt(const Params& p, float* sm) {
  for (int it = blockIdx.x; it < 768 + 256 + 16384 + 8192; it += gridDim.x) {
    if (it < 768) { int kt = it / 48, nt = it - kt * 48; cvt_tile(p.w_in, DIN, kt * 64, nt * 64, p.WinT, D, nt * 64, sm); }
    else if (it < 1024) { int i = it - 768; int kt = i >> 4, nt = i & 15; cvt_tile(p.w_out, D, kt * 64, nt * 64, p.WoutT, D, nt * 64, sm); }
    else if (it < 1024 + 16384) {
      int i = it - 1024; int e = i >> 8, r = i & 255; int which = r >> 7, r2 = r & 127; int kt = r2 >> 3, ct = r2 & 7;
      const float* src = (which ? p.w3 : p.w1) + (size_t)e * D * DE;
      int col0 = ct * 64;
      int drow0 = (col0 >> 7) * 256 + which * 128 + (col0 & 127);
      cvt_tile(src, DE, kt * 64, col0, p.Wup + (size_t)e * 1024 * 1024, D, drow0, sm);
    } else {
      int i = it - 1024 - 16384; int e = i >> 7, r = i & 127; int kt = r >> 4, nt = r & 15;
      cvt_tile(p.w2 + (size_t)e * DE * D, D, kt * 64, nt * 64, p.Wdn + (size_t)e * 1024 * 512, DE, nt * 64, sm);
    }
  }
}

__device__ void ph_norm1(const Params& p, float* sm) {
  const int tid = threadIdx.x, wid = tid >> 6, lane = tid & 63;
  float* wdt = sm;
  float* xs = sm + 16448 + wid * 1056;
  for (int e = tid; e < 4096; e += NTHR) {
    int k = e >> 2, q = e & 3;
    float4 v = *(const float4*)(p.w_in + (size_t)k * DIN + COL_DT + q * 4);
    *(float4*)(wdt + k * 16 + (k >> 8) * 16 + q * 4) = v;
  }
  __syncthreads();
  for (int row = blockIdx.x * 8 + wid; row < TT; row += gridDim.x * 8) {
    const float* src = (row < T) ? (p.x + (size_t)row * D) : (p.ctx + (size_t)(row - T) * D);
    const int mr = (row < T) ? (row / L) : 8;
    const float* sh = p.MOD + mr * 6144;
    const float* sc = sh + 1024;
    float4 v[4];
    float ss = 0.f;
#pragma unroll
    for (int i = 0; i < 4; ++i) {
      v[i] = *(const float4*)(src + i * 256 + lane * 4);
      ss += v[i].x * v[i].x + v[i].y * v[i].y + v[i].z * v[i].z + v[i].w * v[i].w;
    }
    ss = wave_sum(ss);
    const float rstd = rsqrtf(ss * (1.f / D) + EPS);
#pragma unroll
    for (int i = 0; i < 4; ++i) {
      const int col = i * 256 + lane * 4;
      float4 g = *(const float4*)(p.g1 + col);
      float4 s4 = *(const float4*)(sc + col);
      float4 h4 = *(const float4*)(sh + col);
      float4 o;
      o.x = v[i].x * rstd * g.x * (1.f + s4.x) + h4.x;
      o.y = v[i].y * rstd * g.y * (1.f + s4.y) + h4.y;
      o.z = v[i].z * rstd * g.z * (1.f + s4.z) + h4.z;
      o.w = v[i].w * rstd * g.w * (1.f + s4.w) + h4.w;
      uint2 w; w.x = cvt_pk_bf16(o.x, o.y); w.y = cvt_pk_bf16(o.z, o.w);
      *(uint2*)(p.XNb + (size_t)row * D + col) = w;
      *(float4*)(xs + col + i * 8) = o;
    }
    {
      const int j = lane & 15, ks = lane >> 4;
      const float* xp = xs + ks * 256 + ks * 8;
      const float* wp = wdt + (ks * 256) * 16 + ks * 16 + j;
      float a = 0.f;
#pragma unroll 8
      for (int k = 0; k < 256; ++k) a += xp[k] * wp[k * 16];
      a += __shfl_xor(a, 16);
      a += __shfl_xor(a, 32);
      if (lane < 16) p.DT[(size_t)row * 16 + j] = softplus_f(a + p.dt_bias[j]);
    }
  }
}

__device__ void ph_hy_convT(const Params& p, float* sm) {
  const int tid = threadIdx.x;
  float* tile = sm;
  for (int item = blockIdx.x; item < 256 * 24; item += gridDim.x) {
    const int gr = item / 24, ct = item - gr * 24;
    const int row0 = gr * 64;
    {
      const int t = tid >> 3, c8 = (tid & 7) * 8;
      uint4 v = *(const uint4*)(p.PXb + (size_t)(row0 + t) * DP + ct * 64 + c8);
      unsigned w[4] = {v.x, v.y, v.z, v.w};
#pragma unroll
      for (int k = 0; k < 4; ++k) {
        tile[t * 65 + c8 + 2 * k] = __uint_as_float(w[k] << 16);
        tile[t * 65 + c8 + 2 * k + 1] = __uint_as_float(w[k] & 0xffff0000u);
      }
    }
    __syncthreads();
    {
      const int cc = tid >> 3, t8 = (tid & 7) * 8;
      const int col = ct * 64 + cc;
      const float w0 = p.hy_conv_w[col], w1 = p.hy_conv_w[HYC + col], w2 = p.hy_conv_w[2 * HYC + col], bb = p.hy_conv_b[col];
      float o[8];
#pragma unroll
      for (int k = 0; k < 8; ++k) {
        const int t = t8 + k;
        float v = bb + w1 * tile[t * 65 + cc];
        if (t > 0) v += w0 * tile[(t - 1) * 65 + cc];
        if (t < 63) v += w2 * tile[(t + 1) * 65 + cc];
        o[k] = v;
      }
      uint4 w; w.x = cvt_pk_bf16(o[0], o[1]); w.y = cvt_pk_bf16(o[2], o[3]); w.z = cvt_pk_bf16(o[4], o[5]); w.w = cvt_pk_bf16(o[6], o[7]);
      *(uint4*)(p.Ut + (size_t)col * T + row0 + t8) = w;
    }
    __syncthreads();
  }
}

__device__ void ph_hy_backT(const Params& p, float* sm) {
  const int tid = threadIdx.x;
  bf16_t* tile = (bf16_t*)sm;
  for (int item = blockIdx.x; item < 256 * 8; item += gridDim.x) {
    const int gr = item >> 3, ct = item & 7;
    const int row0 = gr * 64;
    {
      const int cc = tid >> 3, r8 = (tid & 7) * 8;
      uint4 v = *(const uint4*)(p.Yt + (size_t)(ct * 64 + cc) * T + row0 + r8);
      unsigned w[4] = {v.x, v.y, v.z, v.w};
#pragma unroll
      for (int k = 0; k < 4; ++k) {
        tile[cc * 66 + r8 + 2 * k] = (bf16_t)(w[k] & 0xffffu);
        tile[cc * 66 + r8 + 2 * k + 1] = (bf16_t)(w[k] >> 16);
      }
    }
    __syncthreads();
    {
      const int r = tid >> 3, c8 = (tid & 7) * 8;
      unsigned w[4];
#pragma unroll
      for (int k = 0; k < 4; ++k) w[k] = (unsigned)tile[(c8 + 2 * k) * 66 + r] | ((unsigned)tile[(c8 + 2 * k + 1) * 66 + r] << 16);
      uint4 o; o.x = w[0]; o.y = w[1]; o.z = w[2]; o.w = w[3];
      *(uint4*)(p.YMIXb + (size_t)(row0 + r) * D + ct * 64 + c8) = o;
    }
    __syncthreads();
  }
}

typedef short hbf16x8 __attribute__((ext_vector_type(8)));
typedef float hf32x4 __attribute__((ext_vector_type(4)));

constexpr int HY_FC = 0, HY_ZT0 = 4 * FCLEN * 2, HY_ZT1 = HY_ZT0 + 8 * ZSTRB;

__device__ __forceinline__ void hy_build_filter(const Params& p, int o, int c, unsigned char* lds) {
  const int tid = threadIdx.x;
  const bf16_t* gsrc = p.FILTt + (size_t)(o * 512 + c) * FLEN;
  for (int e = tid; e < 530; e += NTHR) {
    uint4 v = make_uint4(0u, 0u, 0u, 0u);
    if (e < 529) v = *(const uint4*)(gsrc + e * 8);
    *(uint4*)(lds + HY_FC + e * 16) = v;
  }
  __syncthreads();
  for (int g = tid; g < 3 * 530; g += NTHR) {
    const int r = 1 + g / 530, ch = g % 530;
    uint4 lo = make_uint4(0u, 0u, 0u, 0u);
    if (ch > 0) lo = *(const uint4*)(lds + HY_FC + (ch - 1) * 16);
    uint4 hi = *(const uint4*)(lds + HY_FC + ch * 16);
    unsigned W[8] = {lo.x, lo.y, lo.z, lo.w, hi.x, hi.y, hi.z, hi.w};
    uint4 ov;
    if (r == 1) {
      ov.x = __builtin_amdgcn_alignbyte(W[4], W[3], 2); ov.y = __builtin_amdgcn_alignbyte(W[5], W[4], 2);
      ov.z = __builtin_amdgcn_alignbyte(W[6], W[5], 2); ov.w = __builtin_amdgcn_alignbyte(W[7], W[6], 2);
    } else if (r == 2) {
      ov.x = W[3]; ov.y = W[4]; ov.z = W[5]; ov.w = W[6];
    } else {
      ov.x = __builtin_amdgcn_alignbyte(W[3], W[2], 2); ov.y = __builtin_amdgcn_alignbyte(W[4], W[3], 2);
      ov.z = __builtin_amdgcn_alignbyte(W[5], W[4], 2); ov.w = __builtin_amdgcn_alignbyte(W[6], W[5], 2);
    }
    *(uint4*)(lds + HY_FC + r * (FCLEN * 2) + ch * 16) = ov;
  }
  __syncthreads();
}

__device__ __forceinline__ void hy_order(const Params& p, int o, int c, unsigned char* lds) {
  const int tid = threadIdx.x, wid = __builtin_amdgcn_readfirstlane(tid >> 6), lane = tid & 63;
  const int g0 = wid * 4;
  const int n16 = lane & 15, h = lane >> 4, bb = n16 & 7, pp = n16 >> 3;
  const unsigned char* Zin = lds + (o ? HY_ZT1 : HY_ZT0);
  const bf16_t* gate = p.Ut + (size_t)((o + 1) * 512 + c) * T + bb * L;
  uint2 xg[4][2];
#pragma unroll
  for (int i = 0; i < 4; ++i)
#pragma unroll
    for (int u = 0; u < 2; ++u) xg[i][u] = *(const uint2*)(gate + 32 * (2 * (g0 + i) + pp) + 16 * u + 4 * h);
  const float bias = p.hy_bias[o * 512 + c];
  hf32x4 acc[4][2];
#pragma unroll
  for (int i = 0; i < 4; ++i)
#pragma unroll
    for (int u = 0; u < 2; ++u) acc[i][u] = (hf32x4){0.f, 0.f, 0.f, 0.f};
  const int ai = lane & 15, ar = ai & 3, aq = ai >> 2;
  const unsigned char* laneA = lds + HY_FC + ar * (FCLEN * 2) + 2 * (HX0 - 4 * aq + 8 * h);
  const unsigned char* laneB = Zin + bb * ZSTRB + 64 + 64 * pp + 16 * h;
#define HY_LDA(dst, Dd) do { const uint2 _lo = *(const uint2*)(laneA - 32 * (Dd)); const uint2 _hi = *(const uint2*)(laneA - 32 * (Dd) + 8); \
    union { uint4 u4; hbf16x8 v; } _cv; _cv.u4 = make_uint4(_lo.x, _lo.y, _hi.x, _hi.y); dst = _cv.v; } while (0)
#define HY_LDB(dst, Qq) do { dst = *(const hbf16x8*)(laneB + 64 * (Qq)); } while (0)
#pragma unroll 1
  for (int pass = 0; pass < 2; ++pass) {
    const int Es = 2 * g0 - 63 + pass;
    hbf16x8 R[4];
    HY_LDB(R[1], 2 * (g0 + 1) - Es); HY_LDB(R[2], 2 * (g0 + 2) - Es); HY_LDB(R[3], 2 * (g0 + 3) - Es);
#pragma unroll 1
    for (int n4 = 0; n4 < 9; ++n4) {
#pragma unroll
      for (int j = 0; j < 4; ++j) {
        const int n = n4 * 4 + j;
        const int E = Es + 2 * n;
        HY_LDB(R[(4 - j) & 3], 2 * (g0 - n) - Es);
        hbf16x8 A0, A1;
        HY_LDA(A0, 2 * E); HY_LDA(A1, 2 * E + 1);
#pragma unroll
        for (int i = 0; i < 4; ++i) {
          const int Q = 2 * (g0 + i - n) - Es;
          if (Q >= -1 && Q <= 63) {
            acc[i][0] = __builtin_amdgcn_mfma_f32_16x16x32_bf16(A0, R[(i - j) & 3], acc[i][0], 0, 0, 0);
            acc[i][1] = __builtin_amdgcn_mfma_f32_16x16x32_bf16(A1, R[(i - j) & 3], acc[i][1], 0, 0, 0);
          }
        }
      }
    }
  }
#undef HY_LDA
#undef HY_LDB
#pragma unroll
  for (int i = 0; i < 4; ++i)
#pragma unroll
    for (int u = 0; u < 2; ++u) {
      const int t0 = 32 * (2 * (g0 + i) + pp) + 16 * u + 4 * h;
      const uint2 zv = *(const uint2*)(Zin + bb * ZSTRB + 64 + 2 * t0);
      const float z0 = __uint_as_float(zv.x << 16), z1 = __uint_as_float(zv.x & 0xffff0000u), z2 = __uint_as_float(zv.y << 16), z3 = __uint_as_float(zv.y & 0xffff0000u);
      const float x0 = __uint_as_float(xg[i][u].x << 16), x1 = __uint_as_float(xg[i][u].x & 0xffff0000u), x2 = __uint_as_float(xg[i][u].y << 16), x3 = __uint_as_float(xg[i][u].y & 0xffff0000u);
      const float r0 = x0 * (acc[i][u][0] + z0 * bias), r1 = x1 * (acc[i][u][1] + z1 * bias), r2 = x2 * (acc[i][u][2] + z2 * bias), r3 = x3 * (acc[i][u][3] + z3 * bias);
      uint2 w; w.x = cvt_pk_bf16(r0, r1); w.y = cvt_pk_bf16(r2, r3);
      if (o == 0) *(uint2*)(lds + HY_ZT1 + bb * ZSTRB + 64 + 2 * t0) = w;
      else *(uint2*)(p.Yt + (size_t)c * T + bb * L + t0) = w;
    }
}

__device__ void hyena_unit(const Params& p, int c, unsigned char* lds) {
  const int tid = threadIdx.x;
  if (tid < 144) {
    const int buf = tid / 72, rem = tid % 72, b = rem / 9, k = rem % 9;
    const int off = (k < 4) ? (k * 16) : (4160 + (k - 4) * 16);
    *(uint4*)(lds + (buf ? HY_ZT1 : HY_ZT0) + b * ZSTRB + off) = make_uint4(0u, 0u, 0u, 0u);
  }
  for (int e = tid; e < 2048; e += NTHR) {
    const int b = e >> 8, ch = e & 255;
    *(uint4*)(lds + HY_ZT0 + b * ZSTRB + 64 + ch * 16) = *(const uint4*)(p.Ut + (size_t)c * T + b * L + ch * 8);
  }
#pragma unroll 1
  for (int o = 0; o < 2; ++o) {
    hy_build_filter(p, o, c, lds);
    hy_order(p, o, c, lds);
    __syncthreads();
  }
}

constexpr int SROW = 272;

__device__ __forceinline__ void ssd_stage_nat(const Params& p, int row0, int pxcol0, int cvcol0, unsigned char* dst) {
  for (int e = threadIdx.x; e < 2048; e += NTHR) {
    const int l = e >> 4, cg = e & 15;
    const int row = row0 + l, li = row & 63;
    const bf16_t* src = p.PXb + (size_t)row * DP + pxcol0 + cg * 8;
    const uint4 zero4 = make_uint4(0u, 0u, 0u, 0u);
    const uint4 cur = *(const uint4*)src;
    const uint4 prv = (li > 0) ? *(const uint4*)(src - DP) : zero4;
    const uint4 nxt = (li < 63) ? *(const uint4*)(src + DP) : zero4;
    const float* cw = p.ssd_conv_w + cvcol0 + cg * 8;
    const float* cb = p.ssd_conv_b + cvcol0 + cg * 8;
    const unsigned pc[4] = {prv.x, prv.y, prv.z, prv.w}, cc[4] = {cur.x, cur.y, cur.z, cur.w}, nc[4] = {nxt.x, nxt.y, nxt.z, nxt.w};
    float o[8];
#pragma unroll
    for (int k = 0; k < 4; ++k) {
      const float p0 = __uint_as_float(pc[k] << 16), p1 = __uint_as_float(pc[k] & 0xffff0000u);
      const float c0 = __uint_as_float(cc[k] << 16), c1 = __uint_as_float(cc[k] & 0xffff0000u);
      const float n0 = __uint_as_float(nc[k] << 16), n1 = __uint_as_float(nc[k] & 0xffff0000u);
      const float v0 = cb[2 * k] + cw[2 * k] * p0 + cw[DXBC + 2 * k] * c0 + cw[2 * DXBC + 2 * k] * n0;
      const float v1 = cb[2 * k + 1] + cw[2 * k + 1] * p1 + cw[DXBC + 2 * k + 1] * c1 + cw[2 * DXBC + 2 * k + 1] * n1;
      o[2 * k] = silu_f(v0); o[2 * k + 1] = silu_f(v1);
    }
    uint4 w; w.x = cvt_pk_bf16(o[0], o[1]); w.y = cvt_pk_bf16(o[2], o[3]); w.z = cvt_pk_bf16(o[4], o[5]); w.w = cvt_pk_bf16(o[6], o[7]);
    *(uint4*)(dst + l * SROW + cg * 16) = w;
  }
}

__device__ __forceinline__ void ssd_stage_tr(const Params& p, int row0, bool is_ctx, int pxcol0, int cvcol0, int ncols, unsigned char* dst) {
  for (int e = threadIdx.x; e < ncols * 16; e += NTHR) {
    const int col = e & (ncols - 1), l8 = e / ncols;
    const int rowf = row0 + l8 * 8;
    bool has_prev, has_next;
    if (is_ctx) { const int tc = (rowf - T) & (LC - 1); has_prev = tc > 0; has_next = tc + 7 < LC - 1; }
    else { const int li = rowf & 63; has_prev = li > 0; has_next = li + 7 < 63; }
    const bf16_t* src = p.PXb + (size_t)rowf * DP + pxcol0 + col;
    float x[10];
    x[0] = (cvcol0 >= 0 && has_prev) ? bf2f(src[-DP]) : 0.f;
#pragma unroll
    for (int k = 0; k < 8; ++k) x[k + 1] = bf2f(src[(size_t)k * DP]);
    x[9] = (cvcol0 >= 0 && has_next) ? bf2f(src[(size_t)8 * DP]) : 0.f;
    float o[8];
    if (cvcol0 >= 0) {
      const float w0 = p.ssd_conv_w[cvcol0 + col], w1 = p.ssd_conv_w[DXBC + cvcol0 + col], w2 = p.ssd_conv_w[2 * DXBC + cvcol0 + col], bb = p.ssd_conv_b[cvcol0 + col];
#pragma unroll
      for (int k = 0; k < 8; ++k) o[k] = silu_f(bb + w0 * x[k] + w1 * x[k + 1] + w2 * x[k + 2]);
    } else {
#pragma unroll
      for (int k = 0; k < 8; ++k) o[k] = x[k + 1];
    }
    uint4 w; w.x = cvt_pk_bf16(o[0], o[1]); w.y = cvt_pk_bf16(o[2], o[3]); w.z = cvt_pk_bf16(o[4], o[5]); w.w = cvt_pk_bf16(o[6], o[7]);
    *(uint4*)(dst + col * SROW + l8 * 16) = w;
  }
}

__device__ void ssd_states_unit(const Params& p, int unit, unsigned char* lds) {
  const int tid = threadIdx.x, wid = __builtin_amdgcn_readfirstlane(tid >> 6), lane = tid & 63;
  const int g = unit & 1, bc = unit >> 1, cidx = bc % 18, b = bc / 18;
  const bool is_ctx = cidx < 2;
  const int row0 = is_ctx ? (T + b * LC + cidx * 128) : (b * L + (cidx - 2) * 128);
  unsigned char* XT = lds;
  unsigned char* BT = lds + 69632;
  unsigned char* XD = lds + 104448;
  float* WG = (float*)(lds + 121856);
  ssd_stage_tr(p, row0, is_ctx, COL_XBC + g * 256, g * 256, 256, XT);
  ssd_stage_tr(p, row0, is_ctx, COL_XBC + 512 + g * 128, 512 + g * 128, 128, BT);
  {
    const int dir = wid >> 2, hh = wid & 3, h = g * 4 + hh;
    const float A = expf(p.a_log[dir * 8 + h]);
    const int l0 = 2 * lane, l1 = l0 + 1;
    const float dt0 = p.DT[(size_t)(row0 + l0) * 16 + dir * 8 + h], dt1 = p.DT[(size_t)(row0 + l1) * 16 + dir * 8 + h];
    const float a0 = -A * dt0, a1 = -A * dt1, pair = a0 + a1;
    float incl = pair;
#pragma unroll
    for (int o = 1; o < 64; o <<= 1) { float t = __shfl_up(incl, o); if (lane >= o) incl += t; }
    const float excl = incl - pair;
    const float total = __shfl(incl, 63);
    float w0, w1, c0, c1;
    if (dir == 0) { c0 = excl + a0; c1 = excl + pair; w0 = dt0 * expf(total - c0); w1 = dt1 * expf(total - c1); }
    else { const float pe0 = excl, pe1 = excl + a0; w0 = dt0 * expf(pe0); w1 = dt1 * expf(pe1); c0 = total - pe0; c1 = total - pe1; }
    WG[wid * 128 + l0] = w0; WG[wid * 128 + l1] = w1;
    if (!is_ctx) { float* ac = p.ACUM + (size_t)(b * 16 + dir * 8 + h) * L + (cidx - 2) * 128; *(float2*)(ac + l0) = make_float2(c0, c1); }
    if (lane == 0) {
      const int k = dir ? (is_ctx ? (1 - cidx) : (19 - cidx)) : cidx;
      p.CDEC[(size_t)(((b * 2 + dir) * 8 + h) * 18 + k) * 32] = expf(total);
    }
  }
  __syncthreads();
  const int fr = lane & 15, fq = lane >> 4;
#pragma unroll 1
  for (int it = 0; it < 8; ++it) {
    const int dir = it >> 2, hh = it & 3, h = g * 4 + hh;
    for (int e = tid; e < 1024; e += NTHR) {
      const int pr = e >> 4, ch = e & 15;
      const uint4 v = *(const uint4*)(XT + (hh * 64 + pr) * SROW + ch * 16);
      const float4 wa = *(const float4*)(WG + it * 128 + ch * 8), wb = *(const float4*)(WG + it * 128 + ch * 8 + 4);
      uint4 w;
      w.x = cvt_pk_bf16(__uint_as_float(v.x << 16) * wa.x, __uint_as_float(v.x & 0xffff0000u) * wa.y);
      w.y = cvt_pk_bf16(__uint_as_float(v.y << 16) * wa.z, __uint_as_float(v.y & 0xffff0000u) * wa.w);
      w.z = cvt_pk_bf16(__uint_as_float(v.z << 16) * wb.x, __uint_as_float(v.z & 0xffff0000u) * wb.y);
      w.w = cvt_pk_bf16(__uint_as_float(v.w << 16) * wb.z, __uint_as_float(v.w & 0xffff0000u) * wb.w);
      *(uint4*)(XD + pr * SROW + ch * 16) = w;
    }
    __syncthreads();
    hf32x4 acc[4];
#pragma unroll
    for (int pt = 0; pt < 4; ++pt) acc[pt] = (hf32x4){0.f, 0.f, 0.f, 0.f};
#pragma unroll
    for (int kk = 0; kk < 4; ++kk) {
      const hbf16x8 Bf = *(const hbf16x8*)(BT + (16 * wid + fr) * SROW + 2 * (32 * kk + 8 * fq));
#pragma unroll
      for (int pt = 0; pt < 4; ++pt) {
        const hbf16x8 Af = *(const hbf16x8*)(XD + (16 * pt + fr) * SROW + 2 * (32 * kk + 8 * fq));
        acc[pt] = __builtin_amdgcn_mfma_f32_16x16x32_bf16(Bf, Af, acc[pt], 0, 0, 0);
      }
    }
    const int k = dir ? (is_ctx ? (1 - cidx) : (19 - cidx)) : cidx;
    bf16_t* slot = p.SST + ((size_t)(((b * 2 + dir) * 8 + h) * 18 + k)) * 8192;
#pragma unroll
    for (int pt = 0; pt < 4; ++pt)
      *(uint2*)(slot + (16 * pt + fr) * 128 + 16 * wid + 4 * fq) = make_uint2(cvt_pk_bf16(acc[pt][0], acc[pt][1]), cvt_pk_bf16(acc[pt][2], acc[pt][3]));
    __syncthreads();
  }
}

__device__ void ssd_scan_unit(const Params& p, int unit) {
  const int tid = threadIdx.x;
  const int half = unit & 1, seq = unit >> 1;
  const int pr = half * 32 + (tid >> 4), n8 = (tid & 15) * 8;
  const bf16_t* base = p.SST + (size_t)seq * 18 * 8192 + pr * 128 + n8;
  uint4 sv[18];
#pragma unroll
  for (int k = 0; k < 18; ++k) sv[k] = *(const uint4*)(base + (size_t)k * 8192);
  float hst[8];
#pragma unroll
  for (int j = 0; j < 8; ++j) hst[j] = 0.f;
#pragma unroll
  for (int k = 0; k < 18; ++k) {
    const float dec = p.CDEC[(size_t)(seq * 18 + k) * 32];
    if (k >= 2) {
      uint4 w; w.x = cvt_pk_bf16(hst[0], hst[1]); w.y = cvt_pk_bf16(hst[2], hst[3]); w.z = cvt_pk_bf16(hst[4], hst[5]); w.w = cvt_pk_bf16(hst[6], hst[7]);
      *(uint4*)(p.HIN + ((size_t)seq * 16 + (k - 2)) * 8192 + pr * 128 + n8) = w;
    }
    const unsigned sw[4] = {sv[k].x, sv[k].y, sv[k].z, sv[k].w};
#pragma unroll
    for (int u = 0; u < 4; ++u) {
      hst[2 * u] = dec * hst[2 * u] + __uint_as_float(sw[u] << 16);
      hst[2 * u + 1] = dec * hst[2 * u + 1] + __uint_as_float(sw[u] & 0xffff0000u);
    }
  }
}

__device__ void ssd_out_unit(const Params& p, int unit, unsigned char* lds) {
  const int tid = threadIdx.x, wid = __builtin_amdgcn_readfirstlane(tid >> 6), lane = tid & 63;
  const int fr = lane & 15, fq = lane >> 4;
  const int g = unit & 1, bc = unit >> 1, c = bc & 15, b = bc >> 4;
  const int row0 = b * L + c * 128;
  unsigned char* CS = lds;
  unsigned char* ML = lds + 34816;
  unsigned char* XT = lds + 69632;
  unsigned char* ZT = lds + 87040;
  unsigned char* HS = lds + 104448;
  float* CUM = (float*)(lds + 121856);
  float* DTL = (float*)(lds + 125952);
  ssd_stage_nat(p, row0, COL_XBC + 768 + g * 128, 768 + g * 128, CS);
  ssd_stage_nat(p, row0, COL_XBC + 512 + g * 128, 512 + g * 128, ML);
  for (int e = tid; e < 1024; e += NTHR) {
    const int it = e >> 7, l = e & 127, dir = it >> 2, hh = it & 3;
    CUM[e] = p.ACUM[(size_t)(b * 16 + dir * 8 + g * 4 + hh) * L + c * 128 + l];
    DTL[e] = p.DT[(size_t)(row0 + l) * 16 + dir * 8 + g * 4 + hh];
  }
  __syncthreads();
  hf32x4 cbt[8];
#pragma unroll
  for (int lt = 0; lt < 8; ++lt) cbt[lt] = (hf32x4){0.f, 0.f, 0.f, 0.f};
#pragma unroll
  for (int kk = 0; kk < 4; ++kk) {
    const hbf16x8 Af = *(const hbf16x8*)(ML + (16 * wid + fr) * SROW + 2 * (32 * kk + 8 * fq));
#pragma unroll
    for (int lt = 0; lt < 8; ++lt) {
      const hbf16x8 Bf = *(const hbf16x8*)(CS + (16 * lt + fr) * SROW + 2 * (32 * kk + 8 * fq));
      cbt[lt] = __builtin_amdgcn_mfma_f32_16x16x32_bf16(Af, Bf, cbt[lt], 0, 0, 0);
    }
  }
  __syncthreads();
  hf32x4 y[4][4];
#pragma unroll
  for (int hh = 0; hh < 4; ++hh)
#pragma unroll
    for (int pt = 0; pt < 4; ++pt) y[hh][pt] = (hf32x4){0.f, 0.f, 0.f, 0.f};
  const int sb = 16 * wid + 4 * fq;
#pragma unroll 1
  for (int hh = 0; hh < 4; ++hh) {
    const int h = g * 4 + hh;
    hf32x4 yc[4];
#pragma unroll
    for (int pt = 0; pt < 4; ++pt) yc[pt] = (hf32x4){0.f, 0.f, 0.f, 0.f};
    ssd_stage_tr(p, row0, false, COL_XBC + g * 256 + hh * 64, g * 256 + hh * 64, 64, XT);
    ssd_stage_tr(p, row0, false, COL_Z + g * 256 + hh * 64, -1, 64, ZT);
#pragma unroll 1
    for (int dir = 0; dir < 2; ++dir) {
      const int it = dir * 4 + hh;
      const int k = dir ? (17 - c) : (c + 2);
      const bf16_t* slot = p.HIN + ((size_t)(((b * 2 + dir) * 8 + h) * 16 + (k - 2))) * 8192;
      for (int e = tid; e < 1024; e += NTHR) {
        const int pr = e >> 4, ch = e & 15;
        *(uint4*)(HS + pr * SROW + ch * 16) = *(const uint4*)(slot + pr * 128 + ch * 8);
      }
      {
        const float* cu = CUM + it * 128; const float* dl = DTL + it * 128;
        float cs[4], ds[4];
#pragma unroll
        for (int r = 0; r < 4; ++r) { cs[r] = cu[sb + r]; ds[r] = dl[sb + r]; }
#pragma unroll
        for (int lt = 0; lt < 8; ++lt) {
          const int l = 16 * lt + fr;
          const float cl = cu[l];
          float m[4];
#pragma unroll
          for (int r = 0; r < 4; ++r) {
            const int sidx = sb + r;
            const bool ok = dir ? (sidx >= l) : (sidx <= l);
            m[r] = ok ? cbt[lt][r] * __expf(cl - cs[r]) * ds[r] : 0.f;
          }
          uint2 w; w.x = cvt_pk_bf16(m[0], m[1]); w.y = cvt_pk_bf16(m[2], m[3]);
          *(uint2*)(ML + l * SROW + 2 * sb) = w;
        }
      }
      __syncthreads();
      hf32x4 ad[4], ao[4];
#pragma unroll
      for (int pt = 0; pt < 4; ++pt) { ad[pt] = (hf32x4){0.f, 0.f, 0.f, 0.f}; ao[pt] = (hf32x4){0.f, 0.f, 0.f, 0.f}; }
#pragma unroll
      for (int kk = 0; kk < 4; ++kk) {
        const hbf16x8 Am = *(const hbf16x8*)(ML + (16 * wid + fr) * SROW + 2 * (32 * kk + 8 * fq));
        const hbf16x8 Ac = *(const hbf16x8*)(CS + (16 * wid + fr) * SROW + 2 * (32 * kk + 8 * fq));
#pragma unroll
        for (int pt = 0; pt < 4; ++pt) {
          const hbf16x8 Bx = *(const hbf16x8*)(XT + (16 * pt + fr) * SROW + 2 * (32 * kk + 8 * fq));
          const hbf16x8 Bh = *(const hbf16x8*)(HS + (16 * pt + fr) * SROW + 2 * (32 * kk + 8 * fq));
          ad[pt] = __builtin_amdgcn_mfma_f32_16x16x32_bf16(Am, Bx, ad[pt], 0, 0, 0);
          ao[pt] = __builtin_amdgcn_mfma_f32_16x16x32_bf16(Ac, Bh, ao[pt], 0, 0, 0);
        }
      }
      {
        const float* cu = CUM + it * 128;
        float ex[4];
#pragma unroll
        for (int r = 0; r < 4; ++r) ex[r] = __expf(cu[sb + r]);
#pragma unroll
        for (int pt = 0; pt < 4; ++pt)
#pragma unroll
          for (int r = 0; r < 4; ++r) yc[pt][r] += ad[pt][r] + ex[r] * ao[pt][r];
      }
      __syncthreads();
    }
    {
      const float dsk = p.ssd_d[h];
#pragma unroll
      for (int pt = 0; pt < 4; ++pt) {
        const uint2 xv = *(const uint2*)(XT + (16 * pt + fr) * SROW + 2 * sb);
        const uint2 zv = *(const uint2*)(ZT + (16 * pt + fr) * SROW + 2 * sb);
        const float xs4[4] = {__uint_as_float(xv.x << 16), __uint_as_float(xv.x & 0xffff0000u), __uint_as_float(xv.y << 16), __uint_as_float(xv.y & 0xffff0000u)};
        const float zs4[4] = {__uint_as_float(zv.x << 16), __uint_as_float(zv.x & 0xffff0000u), __uint_as_float(zv.y << 16), __uint_as_float(zv.y & 0xffff0000u)};
#pragma unroll
        for (int r = 0; r < 4; ++r) yc[pt][r] = (yc[pt][r] + dsk * xs4[r]) * silu_f(zs4[r]);
      }
    }
    if (hh == 0) {
#pragma unroll
      for (int pt = 0; pt < 4; ++pt) y[0][pt] = yc[pt];
    } else if (hh == 1) {
#pragma unroll
      for (int pt = 0; pt < 4; ++pt) y[1][pt] = yc[pt];
    } else if (hh == 2) {
#pragma unroll
      for (int pt = 0; pt < 4; ++pt) y[2][pt] = yc[pt];
    } else {
#pragma unroll
      for (int pt = 0; pt < 4; ++pt) y[3][pt] = yc[pt];
    }
    __syncthreads();
  }
  float rinv[4];
#pragma unroll
  for (int r = 0; r < 4; ++r) {
    float ss = 0.f;
#pragma unroll
    for (int hh = 0; hh < 4; ++hh)
#pragma unroll
      for (int pt = 0; pt < 4; ++pt) ss += y[hh][pt][r] * y[hh][pt][r];
    ss += __shfl_xor(ss, 1); ss += __shfl_xor(ss, 2); ss += __shfl_xor(ss, 4); ss += __shfl_xor(ss, 8);
    rinv[r] = rsqrtf(ss * (1.f / 256.f) + EPS);
  }
#pragma unroll
  for (int hh = 0; hh < 4; ++hh)
#pragma unroll
    for (int pt = 0; pt < 4; ++pt) {
      const int ch = g * 256 + hh * 64 + 16 * pt + fr;
      const float ng = p.ssd_norm_g[ch];
#pragma unroll
      for (int r = 0; r < 4; ++r) p.YMIXb[(size_t)(row0 + sb + r) * D + 512 + ch] = f2bf(y[hh][pt][r] * rinv[r] * ng);
    }
}

__device__ void ph_router(const Params& p, float* sm) {
  const int tid = threadIdx.x, wid = tid >> 6, lane = tid & 63;
  float* hs = sm + wid * 1200;
  float* lg = hs + 1024;
  for (int row = blockIdx.x * 8 + wid; row < T; row += gridDim.x * 8) {
    const float* src = p.X1 + (size_t)row * D;
    const float* sh = p.MOD + (row / L) * 6144 + 3072;
    const float* sc = sh + 1024;
    float4 v[4];
    float ss = 0.f;
#pragma unroll
    for (int i = 0; i < 4; ++i) {
      v[i] = *(const float4*)(src + i * 256 + lane * 4);
      ss += v[i].x * v[i].x + v[i].y * v[i].y + v[i].z * v[i].z + v[i].w * v[i].w;
    }
    ss = wave_sum(ss);
    const float rstd = rsqrtf(ss * (1.f / D) + EPS);
#pragma unroll
    for (int i = 0; i < 4; ++i) {
      const int col = i * 256 + lane * 4;
      float4 g = *(const float4*)(p.g2 + col);
      float4 s4 = *(const float4*)(sc + col);
      float4 h4 = *(const float4*)(sh + col);
      float4 o;
      o.x = v[i].x * rstd * g.x * (1.f + s4.x) + h4.x;
      o.y = v[i].y * rstd * g.y * (1.f + s4.y) + h4.y;
      o.z = v[i].z * rstd * g.z * (1.f + s4.z) + h4.z;
      o.w = v[i].w * rstd * g.w * (1.f + s4.w) + h4.w;
      uint2 wq; wq.x = cvt_pk_bf16(o.x, o.y); wq.y = cvt_pk_bf16(o.z, o.w);
      *(uint2*)(p.H2b + (size_t)row * D + col) = wq;
      *(float4*)(hs + col) = o;
    }
    {
      float a = p.b_expert[lane];
      const float* wp = p.w_expert + lane;
#pragma unroll 8
      for (int k = 0; k < D; ++k) a += hs[k] * wp[k * 64];
      lg[lane] = a;
      const int j = lane & 7, ks = lane >> 3;
      float gsum = 0.f;
      const float* gp = p.w_group + (ks * 128) * 8 + j;
      const float* hp = hs + ks * 128;
#pragma unroll 8
      for (int k = 0; k < 128; ++k) gsum += hp[k] * gp[k * 8];
      gsum += __shfl_xor(gsum, 8);
      gsum += __shfl_xor(gsum, 16);
      gsum += __shfl_xor(gsum, 32);
      if (lane < 8) lg[64 + lane] = gsum + p.b_group[lane];
    }
    if (lane == 0) {
      int gs = 0; float gm = lg[64];
      for (int j = 1; j < 8; ++j) if (lg[64 + j] > gm) { gm = lg[64 + j]; gs = j; }
      float den = 0.f;
      for (int j = 0; j < 8; ++j) den += expf(lg[64 + j] - gm);
      float pg = 1.f / den;
      const float* el = lg + gs * 8;
      int i0 = 0; float l0 = el[0];
      for (int j = 1; j < 8; ++j) if (el[j] > l0) { l0 = el[j]; i0 = j; }
      int i1 = -1; float l1 = -3.0e38f;
      for (int j = 0; j < 8; ++j) if (j != i0 && el[j] > l1) { l1 = el[j]; i1 = j; }
      float e1 = expf(l1 - l0);
      float w0 = 1.f / (1.f + e1), w1 = e1 / (1.f + e1);
      p.GATE[row * 2 + 0] = w0 * pg;
      p.GATE[row * 2 + 1] = w1 * pg;
      int ea = gs * 8 + i0, eb = gs * 8 + i1;
      int sa = atomicAdd(&p.CNT[ea], 1);
      p.LIST[ea * T + sa] = row * 2 + 0;
      int sb = atomicAdd(&p.CNT[eb], 1);
      p.LIST[eb * T + sb] = row * 2 + 1;
    }
  }
}

__device__ __forceinline__ void moe_table(const Params& p, int* tab) {
  if (threadIdx.x == 0) {
    int a = 0, sg = 0;
    for (int e = 0; e < NE; ++e) {
      int cn = p.CNT[e];
      tab[e] = a; tab[65 + e] = sg; tab[130 + e] = cn;
      a += (cn + 255) >> 8; sg += ((cn + 127) >> 7) << 7;
    }
    tab[NE] = a; tab[65 + NE] = sg;
  }
  __syncthreads();
}

__device__ void ph_final(const Params& p) {
  const int tid = threadIdx.x, wid = tid >> 6, lane = tid & 63;
  for (int row = blockIdx.x * 8 + wid; row < T; row += gridDim.x * 8) {
    const float* ga2 = p.MOD + (row / L) * 6144 + 5120;
    float4 v[4];
    float ss = 0.f;
#pragma unroll
    for (int i = 0; i < 4; ++i) {
      const int col = i * 256 + lane * 4;
      float4 xv = *(const float4*)(p.X1 + (size_t)row * D + col);
      uint2 a = *(const uint2*)(p.YB2b + (size_t)(row * 2) * D + col);
      uint2 b = *(const uint2*)(p.YB2b + (size_t)(row * 2 + 1) * D + col);
      float4 ga = *(const float4*)(ga2 + col);
      v[i].x = xv.x + ga.x * (__uint_as_float(a.x << 16) + __uint_as_float(b.x << 16));
      v[i].y = xv.y + ga.y * (__uint_as_float(a.x & 0xffff0000u) + __uint_as_float(b.x & 0xffff0000u));
      v[i].z = xv.z + ga.z * (__uint_as_float(a.y << 16) + __uint_as_float(b.y << 16));
      v[i].w = xv.w + ga.w * (__uint_as_float(a.y & 0xffff0000u) + __uint_as_float(b.y & 0xffff0000u));
      ss += v[i].x * v[i].x + v[i].y * v[i].y + v[i].z * v[i].z + v[i].w * v[i].w;
    }
    ss = wave_sum(ss);
    const float rstd = rsqrtf(ss * (1.f / D) + EPS);
#pragma unroll
    for (int i = 0; i < 4; ++i) {
      const int col = i * 256 + lane * 4;
      float4 gf = *(const float4*)(p.g_final + col);
      float4 o;
      o.x = v[i].x * rstd * gf.x; o.y = v[i].y * rstd * gf.y; o.z = v[i].z * rstd * gf.z; o.w = v[i].w * rstd * gf.w;
      *(float4*)(p.out + (size_t)row * D + col) = o;
    }
  }
}

constexpr int NPHASE = 11;

__global__ void __launch_bounds__(NTHR, 2) mega(Params p) {
  extern __shared__ __attribute__((aligned(16))) unsigned char lds_raw[];
  float* sm = (float*)lds_raw;
  PG8_LAS unsigned char* lds = (PG8_LAS unsigned char*)lds_raw;
  const int lo = p.lo, hi = p.hi;
  volatile LAS unsigned* xbst = (volatile LAS unsigned*)(lds + pg8::STAGE_BYTES + 2048);
  if (threadIdx.x < 4) xbst[threadIdx.x] = 0u;
  __syncthreads();
  XcdBarrier xbar; xbar.bar = p.BAR; xbar.x = 0; xbar.st = xbst;
  if (hi - lo > 1) xbar = xcd_barrier_post(p.BAR, xbst);
#define IN(k) (lo <= (k) && (k) < hi)
#define SYNC(k) do { if (IN(k) && IN((k) + 1)) xcd_barrier(xbar); } while (0)
#ifndef DUPK
#define DUPK -1
#endif
#ifndef SKIP_OTHER
  if (IN(0)) { ph_adaln(p); ph_filters(p, sm); ph_wcvt(p, sm); }
#if DUPK == 0
  xcd_barrier(xbar);
  if (IN(0)) { ph_adaln(p); ph_filters(p, sm); ph_wcvt(p, sm); }
#endif
  SYNC(0);
  if (IN(1)) ph_norm1(p, sm);
#if DUPK == 1
  xcd_barrier(xbar);
  if (IN(1)) ph_norm1(p, sm);
#endif
  SYNC(1);
#endif
#ifndef SKIP_GEMM
  if (IN(2)) {
    pg8::DenseOrder S{p.XNb, p.WinT, TT / 256, DP / 256, D, (int)gridDim.x, (int)blockIdx.x};
    pg8::EpiBf16 E{p.PXb, DP};
    pg8::gemm_phase<pg8::EpiBf16, pg8::DenseOrder>(lds, D, S, E);
  }
#if DUPK == 2
  xcd_barrier(xbar);
  if (IN(2)) {
    pg8::DenseOrder S{p.XNb, p.WinT, TT / 256, DP / 256, D, (int)gridDim.x, (int)blockIdx.x};
    pg8::EpiBf16 E{p.PXb, DP};
    pg8::gemm_phase<pg8::EpiBf16, pg8::DenseOrder>(lds, D, S, E);
  }
#endif
  SYNC(2);
#endif
#ifndef SKIP_OTHER
  if (IN(3)) {
    ph_hy_convT(p, sm);
    for (int it = blockIdx.x; it < 288; it += gridDim.x) ssd_states_unit(p, it, lds_raw);
  }
#if DUPK == 3
  xcd_barrier(xbar);
  if (IN(3)) {
    ph_hy_convT(p, sm);
    for (int it = blockIdx.x; it < 288; it += gridDim.x) ssd_states_unit(p, it, lds_raw);
  }
#endif
  SYNC(3);
  if (IN(4)) {
    for (int it = blockIdx.x; it < 256; it += gridDim.x) ssd_scan_unit(p, it);
    for (int it = blockIdx.x; it < 512; it += gridDim.x) hyena_unit(p, it, lds_raw);
  }
#if DUPK == 4
  xcd_barrier(xbar);
  if (IN(4)) {
    for (int it = blockIdx.x; it < 256; it += gridDim.x) ssd_scan_unit(p, it);
    for (int it = blockIdx.x; it < 512; it += gridDim.x) hyena_unit(p, it, lds_raw);
  }
#endif
  SYNC(4);
  if (IN(5)) {
    for (int it = blockIdx.x; it < 256; it += gridDim.x) { ssd_out_unit(p, it, lds_raw); __syncthreads(); }
    ph_hy_backT(p, sm);
  }
#if DUPK == 5
  xcd_barrier(xbar);
  if (IN(5)) {
    for (int it = blockIdx.x; it < 256; it += gridDim.x) { ssd_out_unit(p, it, lds_raw); __syncthreads(); }
    ph_hy_backT(p, sm);
  }
#endif
  SYNC(5);
#endif
#ifndef SKIP_GEMM
  if (IN(6)) {
    pg8::DenseOrder S{p.YMIXb, p.WoutT, T / 256, D / 256, D, (int)gridDim.x, (int)blockIdx.x};
    pg8::EpiX1 E{p.x, p.MOD, p.X1};
    pg8::gemm_phase<pg8::EpiX1, pg8::DenseOrder>(lds, D, S, E);
  }
#if DUPK == 6
  xcd_barrier(xbar);
  if (IN(6)) {
    pg8::DenseOrder S{p.YMIXb, p.WoutT, T / 256, D / 256, D, (int)gridDim.x, (int)blockIdx.x};
    pg8::EpiX1 E{p.x, p.MOD, p.X1};
    pg8::gemm_phase<pg8::EpiX1, pg8::DenseOrder>(lds, D, S, E);
  }
#endif
  SYNC(6);
#endif
#ifndef SKIP_OTHER
  if (IN(7)) ph_router(p, sm);
#if DUPK == 7
  xcd_barrier(xbar);
  if (IN(7)) ph_router(p, sm);
#endif
  SYNC(7);
#endif
#ifndef SKIP_GEMM
  if (IN(8)) {
    int* tab = (int*)(lds_raw + pg8::STAGE_BYTES);
    moe_table(p, tab);
    pg8::MoeOrder S{tab, p.H2b, p.Wup, p.LIST, 4, D, (int)gridDim.x, (int)blockIdx.x, true};
    pg8::EpiSwiGLU E{p.HBb};
    pg8::gemm_phase<pg8::EpiSwiGLU, pg8::MoeOrder>(lds, D, S, E);
  }
#if DUPK == 8
  xcd_barrier(xbar);
  if (IN(8)) {
    int* tab = (int*)(lds_raw + pg8::STAGE_BYTES);
    moe_table(p, tab);
    pg8::MoeOrder S{tab, p.H2b, p.Wup, p.LIST, 4, D, (int)gridDim.x, (int)blockIdx.x, true};
    pg8::EpiSwiGLU E{p.HBb};
    pg8::gemm_phase<pg8::EpiSwiGLU, pg8::MoeOrder>(lds, D, S, E);
  }
#endif
  SYNC(8);
  if (IN(9)) {
    int* tab = (int*)(lds_raw + pg8::STAGE_BYTES);
    moe_table(p, tab);
    pg8::MoeOrder S{tab, p.HBb, p.Wdn, p.LIST, 4, DE, (int)gridDim.x, (int)blockIdx.x, false};
    pg8::EpiDown E{p.YB2b, p.LIST, p.GATE};
    pg8::gemm_phase<pg8::EpiDown, pg8::MoeOrder>(lds, DE, S, E);
  }
#if DUPK == 9
  xcd_barrier(xbar);
  if (IN(9)) {
    int* tab = (int*)(lds_raw + pg8::STAGE_BYTES);
    moe_table(p, tab);
    pg8::MoeOrder S{tab, p.HBb, p.Wdn, p.LIST, 4, DE, (int)gridDim.x, (int)blockIdx.x, false};
    pg8::EpiDown E{p.YB2b, p.LIST, p.GATE};
    pg8::gemm_phase<pg8::EpiDown, pg8::MoeOrder>(lds, DE, S, E);
  }
#endif
  SYNC(9);
#endif
#ifndef SKIP_OTHER
  if (IN(10)) ph_final(p);
#if DUPK == 10
  xcd_barrier(xbar);
  if (IN(10)) ph_final(p);
#endif
#endif
#undef IN
#undef SYNC
}

extern "C" void kernel_launch(void* const* d_in, const int* in_sizes, int n_in, void* d_out, int out_size,
                              void* d_ws, size_t ws_size, hipStream_t stream) {
  Params p{};
  const float* const* in = (const float* const*)d_in;
  p.x = in[0]; p.c = in[1]; p.ctx = in[2]; p.c_ctx = in[3]; p.w_ada = in[4]; p.b_ada = in[5];
  p.g1 = in[6]; p.g2 = in[7]; p.w_in = in[8]; p.hy_conv_w = in[9]; p.hy_conv_b = in[10];
  p.f_w1 = in[11]; p.f_b1 = in[12]; p.f_freq = in[13]; p.f_w2 = in[14]; p.f_b2 = in[15]; p.f_w3 = in[16];
  p.hy_bias = in[17]; p.ssd_conv_w = in[18]; p.ssd_conv_b = in[19]; p.a_log = in[20]; p.dt_bias = in[21];
  p.ssd_d = in[22]; p.ssd_norm_g = in[23]; p.w_out = in[24]; p.w_group = in[25]; p.b_group = in[26];
  p.w_expert = in[27]; p.b_expert = in[28]; p.w1 = in[29]; p.w3 = in[30]; p.w2 = in[31]; p.g_final = in[32];
  p.out = (float*)d_out;

  char* ws = (char*)d_ws;
  size_t off = 0;
  auto take = [&](size_t bytes) { char* r = ws + off; off += (bytes + 255) & ~(size_t)255; return r; };
  p.BAR = (unsigned*)take((size_t)XCD_BAR_WORDS * 4);
  p.MOD = (float*)take((size_t)9 * 6144 * 4);
  p.CNT = (int*)take(NE * 4);
  p.GATE = (float*)take((size_t)T * 2 * 4);
  p.LIST = (int*)take((size_t)NE * T * 4);
  p.DT = (float*)take((size_t)TT * 16 * 4);
  p.ACUM = (float*)take((size_t)T * 16 * 4);
  p.CDEC = (float*)take((size_t)128 * 18 * 32 * 4);
  p.FILTt = (bf16_t*)take((size_t)1024 * FLEN * 2);
  p.WinT = (bf16_t*)take((size_t)DP * D * 2);
  p.WoutT = (bf16_t*)take((size_t)D * D * 2);
  p.Wup = (bf16_t*)take((size_t)NE * 1024 * 1024 * 2);
  p.Wdn = (bf16_t*)take((size_t)NE * 1024 * 512 * 2);
  char* rPX = take((size_t)TT * DP * 2);
  char* rXBC = take((size_t)128 * 18 * 8192 * 2);
  char* rYF = take((size_t)T * DS * 4);
  char* rZ1 = take((size_t)HYC * T * 2);
  char* rYB = take((size_t)T * DS * 4);
  char* rYM = take((size_t)T * D * 2);
  p.PXb = (bf16_t*)rPX; p.SST = (bf16_t*)rXBC; p.Ut = (bf16_t*)rZ1; p.YMIXb = (bf16_t*)rYM;
  p.HIN = (bf16_t*)rYF;
  p.Yt = (bf16_t*)rYB;
  p.XNb = (bf16_t*)rZ1;
  p.X1 = (float*)rPX;
  p.H2b = (bf16_t*)rYM;
  p.HBb = (bf16_t*)(rPX + (size_t)T * D * 4);
  p.YB2b = (bf16_t*)rZ1;
  if (off > ws_size) { fprintf(stderr, "workspace too small: need %zu have %zu\n", off, ws_size); return; }

  static int grid_blocks = 0;
  if (!grid_blocks) {
    int dev = 0, cus = 0, per_cu = 0;
    (void)hipGetDevice(&dev);
    (void)hipDeviceGetAttribute(&cus, hipDeviceAttributeMultiprocessorCount, dev);
    (void)hipFuncSetAttribute((const void*)mega, hipFuncAttributeMaxDynamicSharedMemorySize, LDS_BYTES);
    (void)hipOccupancyMaxActiveBlocksPerMultiprocessor(&per_cu, mega, NTHR, LDS_BYTES);
    if (per_cu < 1) { fprintf(stderr, "occupancy query returned %d\n", per_cu); per_cu = 1; }
    grid_blocks = cus;
  }
#ifndef ONE_LAUNCH
  for (int ph = 0; ph < NPHASE; ++ph) {
    p.lo = ph; p.hi = ph + 1;
    hipLaunchKernelGGL(mega, dim3(grid_blocks), dim3(NTHR), LDS_BYTES, stream, p);
  }
#else
  p.lo = 0; p.hi = NPHASE;
  (void)hipMemsetAsync(p.BAR, 0, (size_t)XCD_BAR_WORDS * 4, stream);
  void* args[] = {&p};
  hipError_t e = hipLaunchCooperativeKernel((void*)mega, dim3(grid_blocks), dim3(NTHR), args, LDS_BYTES, stream);
  if (e != hipSuccess) fprintf(stderr, "cooperative launch failed: %s (grid %d)\n", hipGetErrorString(e), grid_blocks);
#endif
}
```

```cpp
#define ONE_LAUNCH 1
#include <hip/hip_runtime.h>
#include <hip/hip_cooperative_groups.h>
#include <cstdio>
#include <cstdint>
namespace cg = cooperative_groups;

constexpr int D = 1024, NB = 8, L = 2048, LC = 256;
constexpr int T = NB * L;
constexpr int TC = NB * LC;
constexpr int TT = T + TC;
constexpr int DH = 512, HYC = 1536, DS = 512, DXBC = 1024, DIN = 3088, DP = 3072;
constexpr int COL_Z = 1536, COL_XBC = 2048, COL_DT = 3072;
constexpr int NE = 64, DE = 512;
constexpr float EPS = 1e-6f;
constexpr int NTHR = 512;
constexpr int LDS_BYTES = 132 * 1024;
constexpr int FLEN = 4232, HX0 = 2112, FCLEN = 4240, ZSTRB = 4240;

typedef unsigned short bf16_t;

struct Params {
  const float *x, *c, *ctx, *c_ctx, *w_ada, *b_ada, *g1, *g2, *w_in, *hy_conv_w, *hy_conv_b;
  const float *f_w1, *f_b1, *f_freq, *f_w2, *f_b2, *f_w3, *hy_bias;
  const float *ssd_conv_w, *ssd_conv_b, *a_log, *dt_bias, *ssd_d, *ssd_norm_g, *w_out;
  const float *w_group, *b_group, *w_expert, *b_expert, *w1, *w3, *w2, *g_final;
  float* out;
  float *MOD, *DT, *X1, *GATE, *ACUM, *CDEC;
  bf16_t *WRhi, *WRlo, *FILTt, *Ut, *Yt, *HIN, *XNb, *WinT, *WoutT, *PXb, *SST, *YMIXb, *YB2b, *Wup, *Wdn, *H2b, *HBb;
  int *CNT, *LIST;
  unsigned* BAR;
  int lo, hi;
};

__device__ __forceinline__ float silu_f(float v) { return v / (1.f + __expf(-v)); }
__device__ __forceinline__ float softplus_f(float v) { return v > 20.f ? v : log1pf(expf(v)); }
__device__ __forceinline__ float bf2f(bf16_t v) { return __uint_as_float(((unsigned)v) << 16); }
__device__ __forceinline__ unsigned cvt_pk_bf16(float lo, float hi) {
  typedef __bf16 bf2_t __attribute__((ext_vector_type(2)));
  typedef float f2_t __attribute__((ext_vector_type(2)));
  const f2_t v = {lo, hi};
  const bf2_t r = __builtin_convertvector(v, bf2_t);
  return __builtin_bit_cast(unsigned, r);
}
__device__ __forceinline__ bf16_t f2bf(float f) { return (bf16_t)(cvt_pk_bf16(f, 0.f) & 0xffffu); }
__device__ __forceinline__ void st_agent64(void* p, unsigned lo, unsigned hi) {
  __hip_atomic_store((unsigned long long*)p, ((unsigned long long)hi << 32) | lo, __ATOMIC_RELAXED, __HIP_MEMORY_SCOPE_AGENT);
}
__device__ __forceinline__ uint2 ld_agent64(const void* p) {
  const unsigned long long v = __hip_atomic_load((const unsigned long long*)p, __ATOMIC_RELAXED, __HIP_MEMORY_SCOPE_AGENT);
  return make_uint2((unsigned)v, (unsigned)(v >> 32));
}
__device__ __forceinline__ void st_agent32(float* p, float v) { __hip_atomic_store(p, v, __ATOMIC_RELAXED, __HIP_MEMORY_SCOPE_AGENT); }
__device__ __forceinline__ float ld_agent32(const float* p) { return __hip_atomic_load(p, __ATOMIC_RELAXED, __HIP_MEMORY_SCOPE_AGENT); }
__device__ __forceinline__ float wave_sum(float v) {
#pragma unroll
  for (int o = 32; o > 0; o >>= 1) v += __shfl_xor(v, o);
  return v;
}


#define XB_TMO      128
#define XB_XCNT(j)  (256  + 64 * (j))
#define XB_XSUB(j)  (1280 + 64 * (j))
#define XB_XGEN(j)  (2304 + 64 * (j))
#define XB_TOP      3328
#define XB_TOPGEN   3392
#define XCD_BAR_WORDS 3456
#define XB_SPIN_CAP (1u << 18)
#define LAS __attribute__((address_space(3)))
__device__ __forceinline__ unsigned xb_ld(unsigned* p) { return __hip_atomic_load(p, __ATOMIC_RELAXED, __HIP_MEMORY_SCOPE_AGENT); }
__device__ __forceinline__ unsigned xb_add(unsigned* p, unsigned v) { return __hip_atomic_fetch_add(p, v, __ATOMIC_RELAXED, __HIP_MEMORY_SCOPE_AGENT); }
__device__ __forceinline__ unsigned xb_xcc_id() { return (unsigned)__builtin_amdgcn_s_getreg((3 << 11) | 20) & 0xFu; }
#define XB_SPIN(cond, bar) do { unsigned _sp = 0; while (cond) { __builtin_amdgcn_s_sleep(1); \
    if ((++_sp & 255u) == 0u) { if (xb_ld(&(bar)[XB_TMO])) break; if (_sp > XB_SPIN_CAP) { atomicAdd(&(bar)[XB_TMO], 1u); break; } } } } while (0)
struct XcdBarrier { unsigned* bar; unsigned x; volatile LAS unsigned* st; };
__device__ __forceinline__ XcdBarrier xcd_barrier_post(unsigned* bar, volatile LAS unsigned* st) {
  XcdBarrier b; b.bar = bar; b.x = xb_xcc_id(); b.st = st;
  if (threadIdx.x == 0) (void)xb_add(&bar[XB_XCNT(b.x)], 1u);
  return b;
}
__device__ __forceinline__ void xcd_barrier_complete(unsigned* bar, unsigned x, unsigned& nloc, unsigned& nx) {
  const unsigned G = gridDim.x * gridDim.y * gridDim.z;
  unsigned sum, cnt, mine, sp = 0u;
  for (;;) {
    sum = 0u; cnt = 0u; mine = 0u;
#pragma unroll
    for (unsigned j = 0; j < 16; ++j) { const unsigned c = xb_ld(&bar[XB_XCNT(j)]); sum += c; cnt += (c > 0u) ? 1u : 0u; mine = (j == x) ? c : mine; }
    if (sum == G) break;
    __builtin_amdgcn_s_sleep(1);
    if ((++sp & 255u) == 0u) { if (xb_ld(&bar[XB_TMO])) break; if (sp > XB_SPIN_CAP) { atomicAdd(&bar[XB_TMO], 1u); break; } }
  }
  nloc = mine > 0u ? mine : 1u; nx = cnt > 0u ? cnt : 1u;
}
__device__ __forceinline__ void xcd_barrier(const XcdBarrier& b) {
  asm volatile("s_waitcnt vmcnt(0)" ::: "memory");
  __syncthreads();
  if (threadIdx.x == 0) {
    unsigned* bar = b.bar;
    __builtin_amdgcn_s_waitcnt(0);
    unsigned nloc = b.st[0], nx = b.st[1];
    if (nloc == 0u) { xcd_barrier_complete(bar, b.x, nloc, nx); b.st[0] = nloc; b.st[1] = nx; }
    const unsigned old = xb_add(&bar[XB_XSUB(b.x)], 1u);
    const unsigned gen = old / nloc;
    if (old + 1u == (gen + 1u) * nloc) {
      __builtin_amdgcn_fence(__ATOMIC_RELEASE, "agent");
      asm volatile("s_waitcnt vmcnt(0)" ::: "memory");
      const unsigned og = xb_add(&bar[XB_TOP], 1u);
      const unsigned tg = og / nx;
      if (og + 1u == (tg + 1u) * nx) xb_add(&bar[XB_TOPGEN], 1u);
      else XB_SPIN(xb_ld(&bar[XB_TOPGEN]) == tg, bar);
      __builtin_amdgcn_fence(__ATOMIC_ACQUIRE, "agent");
      xb_add(&bar[XB_XGEN(b.x)], 1u);
      asm volatile("s_waitcnt vmcnt(0)" ::: "memory");
    } else {
      XB_SPIN(xb_ld(&bar[XB_XGEN(b.x)]) == gen, bar);
      __builtin_amdgcn_fence(__ATOMIC_ACQUIRE, "agent");
      asm volatile("s_waitcnt vmcnt(0)" ::: "memory");
    }
  }
  __syncthreads();
}

namespace pg8 {
#define PG8_LAS __attribute__((address_space(3)))
typedef short bf16x8 __attribute__((ext_vector_type(8)));
typedef float f32x4 __attribute__((ext_vector_type(4)));
typedef unsigned u32x4 __attribute__((ext_vector_type(4)));
typedef unsigned u32x2 __attribute__((ext_vector_type(2)));
constexpr int BM = 256, BK = 64, HALF = 128, HTB = HALF * BK * 2, STAGE_BYTES = 8 * HTB, NXCD = 8, WGM = 8;

__host__ __device__ __forceinline__ int lds_byte(int r, int c) {
  const int st = (r >> 4) * 2 + (c >> 5), rr = r & 15, cc = c & 31, ob = rr * 64 + cc * 2;
  return st * 1024 + (ob ^ (((ob >> 9) & 1) << 5));
}
__host__ __device__ __forceinline__ void stage_rc(int b, int& R, int& C) {
  const int st = b / 1024, sb = b % 1024, swz = sb ^ (((sb >> 9) & 1) << 5);
  R = (st >> 1) * 16 + swz / 64; C = (st & 1) * 32 + (swz % 64) / 2;
}
__host__ __device__ __forceinline__ int perm32(int rho) { const int n = rho >> 4, i = rho & 15; return 8 * (i >> 2) + 4 * n + (i & 3); }

struct Unit { int pm, pn, e, mu, nv, cnt, seg; };

__device__ __forceinline__ bool static_next(int nM, int nN, int G, int c, int i, int& pm, int& pn) {
  const int nwg = nM * nN;
  const long Lx = (long)i * G + c; if (Lx >= nwg) return false;
  int wgid = (int)Lx;
  { const int q = nwg / NXCD, r = nwg % NXCD, xcd = wgid % NXCD, off = wgid / NXCD; wgid = (xcd < r ? xcd * (q + 1) : r * (q + 1) + (xcd - r) * q) + off; }
  const int nig = WGM * nN, gid = wgid / nig, fm = gid * WGM, gsz = (nM - fm) < WGM ? (nM - fm) : WGM;
  pm = fm + ((wgid % nig) % gsz); pn = (wgid % nig) / gsz; return true;
}

struct DenseOrder {
  const bf16_t* A; const bf16_t* Bt; int nM, nN, K, G, c;
  __device__ __forceinline__ bool next(int i, Unit& u) const {
    if (!static_next(nM, nN, G, c, i, u.pm, u.pn)) return false;
    u.e = 0; u.mu = 0; u.nv = 256; u.cnt = 256; u.seg = 0; return true;
  }
  __device__ __forceinline__ const char* a_base() const { return (const char*)A; }
  __device__ __forceinline__ const char* b_ptr(const Unit& u) const { return (const char*)Bt + (size_t)u.pn * 256 * K * 2; }
  __device__ __forceinline__ void a_offs(const Unit& u, const int (&R)[2], const int (&C)[2], unsigned (&ao)[2][2]) const {
#pragma unroll
    for (int h = 0; h < 2; ++h)
#pragma unroll
      for (int i = 0; i < 2; ++i) ao[h][i] = (unsigned)((u.pm * 256 + h * 128 + R[i]) * K + C[i]) * 2u;
  }
};

struct MoeOrder {
  const int* tab; const bf16_t* A; const bf16_t* Bt; const int* list; int NTn, K, G, c; bool gather;
  __device__ __forceinline__ bool next(int i, Unit& u) const {
    const int Lx = i * G + c;
    if (Lx >= tab[64] * NTn) return false;
    const int mg = Lx / NTn; u.pn = Lx - mg * NTn;
    int e = 0;
    while (tab[e + 1] <= mg) ++e;
    u.e = e; u.mu = mg - tab[e]; u.cnt = tab[130 + e]; u.seg = tab[65 + e];
    const int rem = u.cnt - u.mu * 256; u.nv = rem < 256 ? rem : 256; u.pm = 0; return true;
  }
  __device__ __forceinline__ const char* a_base() const { return (const char*)A; }
  __device__ __forceinline__ const char* b_ptr(const Unit& u) const { return (const char*)Bt + ((size_t)u.e * NTn + u.pn) * 256 * K * 2; }
  __device__ __forceinline__ void a_offs(const Unit& u, const int (&R)[2], const int (&C)[2], unsigned (&ao)[2][2]) const {
#pragma unroll
    for (int h = 0; h < 2; ++h)
#pragma unroll
      for (int i = 0; i < 2; ++i) {
        int idx = u.mu * 256 + h * 128 + R[i];
        int row;
        if (gather) { if (idx > u.cnt - 1) idx = u.cnt - 1; row = list[u.e * T + idx] >> 1; }
        else row = u.seg + idx;
        ao[h][i] = (unsigned)(row * K + C[i]) * 2u;
      }
  }
};

struct EpiBf16 {
  static constexpr bool PERM = true;
  bf16_t* O; int ldc;
  __device__ __forceinline__ void operator()(const f32x4 (&acc)[2][2][4][2], const Unit& u, int wr, int wc, int fr, int fq) const {
    const int row0 = u.pm * BM + wr * 64 + fr;
    const int col0 = u.pn * BM + wc * 32 + 8 * fq;
#pragma unroll
    for (int ai = 0; ai < 2; ++ai)
#pragma unroll
      for (int m = 0; m < 4; ++m) {
        bf16_t* rowp = O + (size_t)(row0 + ai * HALF + m * 16) * ldc + col0;
#pragma unroll
        for (int bj = 0; bj < 2; ++bj) {
          f32x4 v0 = acc[ai][bj][m][0], v1 = acc[ai][bj][m][1];
          u32x4 w; w.x = cvt_pk_bf16(v0[0], v0[1]); w.y = cvt_pk_bf16(v0[2], v0[3]); w.z = cvt_pk_bf16(v1[0], v1[1]); w.w = cvt_pk_bf16(v1[2], v1[3]);
          *(u32x4*)(rowp + bj * HALF) = w;
        }
      }
  }
};

struct EpiX1 {
  static constexpr bool PERM = false;
  const float* x; const float* mod; float* X1;
  __device__ __forceinline__ void operator()(const f32x4 (&acc)[2][2][4][2], const Unit& u, int wr, int wc, int fr, int fq) const {
    const int row0 = u.pm * BM + wr * 64 + fr, col0 = u.pn * BM + wc * 32 + 4 * fq;
    const float* ga = mod + ((u.pm * BM) / L) * 6144 + 2048 + col0;
    f32x4 gv[2][2];
#pragma unroll
    for (int bj = 0; bj < 2; ++bj)
#pragma unroll
      for (int n = 0; n < 2; ++n) gv[bj][n] = *(const f32x4*)(ga + bj * HALF + n * 16);
#pragma unroll
    for (int ai = 0; ai < 2; ++ai)
#pragma unroll
      for (int m = 0; m < 4; ++m) {
        const size_t off = (size_t)(row0 + ai * HALF + m * 16) * D + col0;
#pragma unroll
        for (int bj = 0; bj < 2; ++bj)
#pragma unroll
          for (int n = 0; n < 2; ++n) {
            const f32x4 xv = *(const f32x4*)(x + off + bj * HALF + n * 16);
            *(f32x4*)(X1 + off + bj * HALF + n * 16) = xv + gv[bj][n] * acc[ai][bj][m][n];
          }
      }
  }
};

struct EpiSwiGLU {
  static constexpr bool PERM = true;
  bf16_t* HBb;
  __device__ __forceinline__ void operator()(const f32x4 (&acc)[2][2][4][2], const Unit& u, int wr, int wc, int fr, int fq) const {
    const int col0 = u.pn * 128 + wc * 32 + 8 * fq;
#pragma unroll
    for (int ai = 0; ai < 2; ++ai)
#pragma unroll
      for (int m = 0; m < 4; ++m) {
        const int slot = u.mu * 256 + ai * HALF + wr * 64 + m * 16 + fr;
        if (slot < u.cnt) {
          float h[8];
#pragma unroll
          for (int n = 0; n < 2; ++n)
#pragma unroll
            for (int j = 0; j < 4; ++j) { const float a = acc[ai][0][m][n][j]; h[n * 4 + j] = a / (1.f + __expf(-a)) * acc[ai][1][m][n][j]; }
          u32x4 w; w.x = cvt_pk_bf16(h[0], h[1]); w.y = cvt_pk_bf16(h[2], h[3]); w.z = cvt_pk_bf16(h[4], h[5]); w.w = cvt_pk_bf16(h[6], h[7]);
          *(u32x4*)(HBb + (size_t)(u.seg + slot) * DE + col0) = w;
        }
      }
  }
};

struct EpiDown {
  static constexpr bool PERM = true;
  bf16_t* YB2b; const int* list; const float* gate;
  __device__ __forceinline__ void operator()(const f32x4 (&acc)[2][2][4][2], const Unit& u, int wr, int wc, int fr, int fq) const {
    const int col0 = u.pn * 256 + wc * 32 + 8 * fq;
#pragma unroll
    for (int ai = 0; ai < 2; ++ai)
#pragma unroll
      for (int m = 0; m < 4; ++m) {
        const int slot = u.mu * 256 + ai * HALF + wr * 64 + m * 16 + fr;
        if (slot < u.cnt) {
          const int pair = list[u.e * T + slot];
          const float gt = gate[pair];
          bf16_t* rowp = YB2b + (size_t)pair * D + col0;
#pragma unroll
          for (int bj = 0; bj < 2; ++bj) {
            f32x4 v0 = acc[ai][bj][m][0] * gt, v1 = acc[ai][bj][m][1] * gt;
            u32x4 w; w.x = cvt_pk_bf16(v0[0], v0[1]); w.y = cvt_pk_bf16(v0[2], v0[3]); w.z = cvt_pk_bf16(v1[0], v1[1]); w.w = cvt_pk_bf16(v1[2], v1[3]);
            *(u32x4*)(rowp + bj * HALF) = w;
          }
        }
      }
  }
};

template <class Epi, class Sched>
__device__ __forceinline__ void gemm_phase(PG8_LAS unsigned char* lds, const int K, const Sched& S, const Epi& E) {
  const int tid = threadIdx.x, wid = __builtin_amdgcn_readfirstlane(tid >> 6), lane = tid & 63, wr = wid >> 2, wc = wid & 3, fr = lane & 15, fq = lane >> 4;
  const int nt = K / BK;
  int Rr[2], Cc[2];
  unsigned voffB[2];
#pragma unroll
  for (int i = 0; i < 2; ++i) {
    stage_rc(tid * 16 + i * 8192, Rr[i], Cc[i]);
    const int Rb = Epi::PERM ? ((Rr[i] & ~31) + perm32(Rr[i] & 31)) : Rr[i];
    voffB[i] = (unsigned)(Rb * K + Cc[i]) * 2u;
  }
  const size_t kstep = (size_t)(BK * 2);
  const size_t hstep = (size_t)HALF * K * 2;
  const unsigned ldsw = (unsigned)wid * 1024u;
  const int aoff = lds_byte(wr * 64 + fr, fq * 8), boff = lds_byte(wc * 32 + fr, fq * 8);
#define PG8_SA(b, h) (((b) * 2 + (h)) * HTB)
#define PG8_SB(b, h) ((4 + (b) * 2 + (h)) * HTB)
#define PG8_STAGE(bufoff, gbase, voff) do { _Pragma("unroll") for (int _i = 0; _i < 2; ++_i) \
    __builtin_amdgcn_global_load_lds((const unsigned*)((const char*)(gbase) + (voff)[_i]), (PG8_LAS unsigned*)(lds + (bufoff) + ldsw + _i * 8192), 16, 0, 0); } while (0)
#define PG8_LDA(dst, b, h) do { _Pragma("unroll") for (int m = 0; m < 4; ++m) _Pragma("unroll") for (int k = 0; k < 2; ++k) dst[m][k] = *(const PG8_LAS bf16x8*)(lds + PG8_SA(b, h) + aoff + m * 2048 + k * 1024); } while (0)
#define PG8_LDB(dst, b, h) do { _Pragma("unroll") for (int n = 0; n < 2; ++n) _Pragma("unroll") for (int k = 0; k < 2; ++k) dst[n][k] = *(const PG8_LAS bf16x8*)(lds + PG8_SB(b, h) + boff + n * 2048 + k * 1024); } while (0)
#define PG8_MMA(ai, bj, At, Bt) do { __builtin_amdgcn_s_setprio(1); _Pragma("unroll") for (int m = 0; m < 4; ++m) _Pragma("unroll") for (int n = 0; n < 2; ++n) _Pragma("unroll") for (int k = 0; k < 2; ++k) \
    acc[ai][bj][m][n] = __builtin_amdgcn_mfma_f32_16x16x32_bf16(Bt[n][k], At[m][k], acc[ai][bj][m][n], 0, 0, 0); __builtin_amdgcn_s_setprio(0); } while (0)
#define PG8_WAIT_V(n) asm volatile("s_waitcnt vmcnt(" #n ")" ::: "memory")
#define PG8_WAIT_L(n) asm volatile("s_waitcnt lgkmcnt(" #n ")" ::: "memory")
#define PG8_BAR __builtin_amdgcn_s_barrier()
#define PG8_SCHED __builtin_amdgcn_sched_barrier(0)
  Unit cur, nxt; int ui = 0;
  if (!S.next(0, cur)) return;
  f32x4 acc[2][2][4][2];
#pragma unroll
  for (int a = 0; a < 2; ++a)
#pragma unroll
    for (int b = 0; b < 2; ++b)
#pragma unroll
      for (int m = 0; m < 4; ++m)
#pragma unroll
        for (int n = 0; n < 2; ++n) acc[a][b][m][n] = (f32x4){0.f, 0.f, 0.f, 0.f};
  bf16x8 At[4][2], B0[2][2], B1[2][2];
  unsigned cao[2][2], nao[2][2];
  S.a_offs(cur, Rr, Cc, cao);
  const char* const aB = S.a_base();
  const char* cB = S.b_ptr(cur);
  PG8_STAGE(PG8_SB(0, 0), cB, voffB); PG8_STAGE(PG8_SA(0, 0), aB, cao[0]); PG8_STAGE(PG8_SB(0, 1), cB + hstep, voffB); PG8_STAGE(PG8_SA(0, 1), aB, cao[1]);
  if (wr == 1) PG8_BAR;
  PG8_WAIT_V(4); PG8_BAR;
  PG8_STAGE(PG8_SB(1, 0), cB + kstep, voffB); PG8_STAGE(PG8_SA(1, 0), aB + kstep, cao[0]); PG8_STAGE(PG8_SB(1, 1), cB + hstep + kstep, voffB);
  PG8_WAIT_V(6); PG8_BAR;
  for (;;) {
    const bool has_next = S.next(ui + 1, nxt);
    const char* nB = cB;
    if (has_next) { S.a_offs(nxt, Rr, Cc, nao); nB = S.b_ptr(nxt); }
    else {
#pragma unroll
      for (int h = 0; h < 2; ++h)
#pragma unroll
        for (int i = 0; i < 2; ++i) nao[h][i] = cao[h][i];
    }
    const bool full = cur.nv > 128;
    for (int t = 0; t < nt; t += 2) {
      const bool last = (t == nt - 2);
      const char* a1 = aB + (size_t)(t + 1) * kstep;
      const char* a2 = last ? aB : aB + (size_t)(t + 2) * kstep; const char* b2 = last ? nB : cB + (size_t)(t + 2) * kstep;
      const char* a3 = a2 + kstep; const char* b3 = b2 + kstep;
      unsigned so[2][2];
#pragma unroll
      for (int h = 0; h < 2; ++h)
#pragma unroll
        for (int i = 0; i < 2; ++i) so[h][i] = last ? nao[h][i] : cao[h][i];
      PG8_LDB(B0, 0, 0); PG8_SCHED; PG8_LDA(At, 0, 0); PG8_STAGE(PG8_SA(1, 1), a1, cao[1]);
      PG8_WAIT_L(8); PG8_BAR; PG8_WAIT_L(0); PG8_MMA(0, 0, At, B0); PG8_BAR; PG8_SCHED;
      PG8_LDB(B1, 0, 1); PG8_STAGE(PG8_SB(0, 0), b2, voffB);
      PG8_BAR; PG8_WAIT_L(0); PG8_MMA(0, 1, At, B1); PG8_BAR;
      PG8_LDA(At, 0, 1); PG8_STAGE(PG8_SA(0, 0), a2, so[0]);
      PG8_BAR; PG8_WAIT_L(0); if (full) PG8_MMA(1, 0, At, B0); PG8_BAR; PG8_SCHED;
      PG8_STAGE(PG8_SB(0, 1), b2 + hstep, voffB);
      PG8_WAIT_V(6); PG8_BAR; if (full) PG8_MMA(1, 1, At, B1); PG8_BAR;
      PG8_LDB(B0, 1, 0); PG8_SCHED; PG8_LDA(At, 1, 0); PG8_STAGE(PG8_SA(0, 1), a2, so[1]);
      PG8_WAIT_L(8); PG8_BAR; PG8_WAIT_L(0); PG8_MMA(0, 0, At, B0); PG8_BAR; PG8_SCHED;
      PG8_LDB(B1, 1, 1); PG8_STAGE(PG8_SB(1, 0), b3, voffB);
      PG8_BAR; PG8_WAIT_L(0); PG8_MMA(0, 1, At, B1); PG8_BAR;
      PG8_LDA(At, 1, 1); PG8_STAGE(PG8_SA(1, 0), a3, so[0]);
      PG8_BAR; PG8_WAIT_L(0); if (full) PG8_MMA(1, 0, At, B0); PG8_BAR; PG8_SCHED;
      PG8_STAGE(PG8_SB(1, 1), b3 + hstep, voffB);
      PG8_WAIT_V(6); PG8_BAR; if (full) PG8_MMA(1, 1, At, B1); PG8_BAR;
    }
    E(acc, cur, wr, wc, fr, fq);
    if (!has_next) break;
#pragma unroll
    for (int a = 0; a < 2; ++a)
#pragma unroll
      for (int b = 0; b < 2; ++b)
#pragma unroll
        for (int m = 0; m < 4; ++m)
#pragma unroll
          for (int n = 0; n < 2; ++n) acc[a][b][m][n] = (f32x4){0.f, 0.f, 0.f, 0.f};
    cur = nxt; cB = nB; ++ui;
#pragma unroll
    for (int h = 0; h < 2; ++h)
#pragma unroll
      for (int i = 0; i < 2; ++i) cao[h][i] = nao[h][i];
  }
  PG8_WAIT_V(0);
  if (wr == 0) PG8_BAR;
  PG8_BAR;
#undef PG8_SA
#undef PG8_SB
#undef PG8_STAGE
#undef PG8_LDA
#undef PG8_LDB
#undef PG8_MMA
#undef PG8_WAIT_V
#undef PG8_WAIT_L
#undef PG8_BAR
#undef PG8_SCHED
}
}

__device__ void ph_adaln(const Params& p, float* sm) {
  const int tid = threadIdx.x;
  if (blockIdx.x == 0 && tid < NE) p.CNT[tid] = 0;
  for (int e = blockIdx.x * NTHR + tid; e < 96 * 1024; e += gridDim.x * NTHR) {
    const int j = e >> 10, k = e & 1023;
    float w = 0.f;
    if (j < 64) w = p.w_expert[k * 64 + j]; else if (j < 72) w = p.w_group[k * 8 + (j - 64)];
    const unsigned hi = cvt_pk_bf16(w, 0.f) & 0xffffu;
    const float rem = w - __uint_as_float(hi << 16);
    p.WRhi[e] = (bf16_t)hi; p.WRlo[e] = (bf16_t)(cvt_pk_bf16(rem, 0.f) & 0xffffu);
  }
  float* sc = sm;
  float* red = sm + 9 * 1024;
  for (int e = tid; e < 9 * 1024; e += NTHR) {
    const int r = e >> 10, k = e & 1023;
    sc[e] = silu_f(r < 8 ? p.c[r * D + k] : p.c_ctx[k]);
  }
  __syncthreads();
  for (int item = blockIdx.x; item < 192; item += gridDim.x) {
    const int col0 = item * 32;
    const int kq = tid >> 3, c4 = (tid & 7) * 4;
    float acc[9][4];
#pragma unroll
    for (int r = 0; r < 9; ++r)
#pragma unroll
      for (int j = 0; j < 4; ++j) acc[r][j] = 0.f;
#pragma unroll 4
    for (int i = 0; i < 16; ++i) {
      const int k = kq + i * 64;
      const float4 w = *(const float4*)(p.w_ada + (size_t)k * 6144 + col0 + c4);
#pragma unroll
      for (int r = 0; r < 9; ++r) {
        const float sv = sc[r * 1024 + k];
        acc[r][0] += sv * w.x; acc[r][1] += sv * w.y; acc[r][2] += sv * w.z; acc[r][3] += sv * w.w;
      }
    }
#pragma unroll
    for (int r = 0; r < 9; ++r)
#pragma unroll
      for (int j = 0; j < 4; ++j) red[kq * 292 + r * 32 + c4 + j] = acc[r][j];
    __syncthreads();
    if (tid < 288) {
      float a = 0.f;
      for (int q = 0; q < 64; ++q) a += red[q * 292 + tid];
      const int r = tid >> 5, j = tid & 31;
      p.MOD[r * 6144 + col0 + j] = a + p.b_ada[col0 + j];
    }
    __syncthreads();
  }
}

__device__ void ph_filters(const Params& p, float* sm) {
  const int tid = threadIdx.x, wid = tid >> 6, lane = tid & 63;
  float* feats = sm;
  float* h1 = sm + 64 * 20;
  float* h2 = h1 + 64 * 64;
  bf16_t* tile = (bf16_t*)(h2 + 64 * 64);
  for (int e = blockIdx.x * NTHR + tid; e < 1024 * 137; e += gridDim.x * NTHR) {
    int rowi = e / 137, k = e - rowi * 137;
    int x = (k < 65) ? k : (4160 + (k - 65));
    p.FILTt[(size_t)rowi * FLEN + x] = 0;
  }
  for (int item = blockIdx.x; item < 256; item += gridDim.x) {
    const int tt = item >> 3, ct = item & 7;
    for (int e = tid; e < 64 * 17; e += NTHR) {
      int tp = e / 17, i = e - tp * 17;
      int t = tt * 64 + tp;
      float f;
      if (i == 0) f = (float)t / (float)(L - 1);
      else {
        int bi = (i - 1) & 7;
        float bandf = (float)(1e-4 + (double)bi * ((7.0 - 1e-4) / 7.0));
        float ang = (float)(2.0 * 3.14159265358979323846 / (double)L) * (float)t * bandf;
        f = (i <= 8) ? cosf(ang) : -sinf(ang);
      }
      feats[tp * 20 + i] = f;
    }
    __syncthreads();
    for (int e = tid; e < 4096; e += NTHR) {
      int tp = e >> 6, j = e & 63;
      float a = p.f_b1[j];
      for (int i = 0; i < 17; ++i) a += feats[tp * 20 + i] * p.f_w1[i * 64 + j];
      h1[e] = sinf(p.f_freq[j] * a);
    }
    __syncthreads();
    for (int e = tid; e < 4096; e += NTHR) {
      int tp = e >> 6, j = e & 63;
      float a = p.f_b2[j];
      for (int i = 0; i < 64; ++i) a += h1[tp * 64 + i] * p.f_w2[i * 64 + j];
      h2[e] = sinf(p.f_freq[j] * a);
    }
    __syncthreads();
    {
      const int col = tid & 255, half = tid >> 8;
      const int gcol = ct * 256 + col;
      float acc[32];
#pragma unroll
      for (int k = 0; k < 32; ++k) acc[k] = 0.f;
      for (int i = 0; i < 64; ++i) {
        float w = p.f_w3[i * 2048 + gcol];
#pragma unroll
        for (int k = 0; k < 32; ++k) acc[k] += h2[(half * 32 + k) * 64 + i] * w;
      }
      const int cch = gcol & 511;
      const float d0 = -4.605170185988091f / 1.5f, d1 = -4.605170185988091f / 0.3f;
      const float delta = fabsf(d0 + (float)cch * ((d1 - d0) / 511.f));
#pragma unroll
      for (int k = 0; k < 32; ++k) {
        int t = tt * 64 + half * 32 + k;
        float tn = (float)t / (float)(L - 1);
        tile[col * 66 + half * 32 + k] = f2bf(acc[k] * expf(-tn * delta));
      }
    }
    __syncthreads();
    for (int cl = wid * 32; cl < wid * 32 + 32; ++cl) {
      const int gcol = ct * 256 + cl;
      const int o = gcol >> 10, dir = (gcol >> 9) & 1, cch = gcol & 511;
      const int t = tt * 64 + lane;
      const int x = dir ? (HX0 + t) : (HX0 - t);
      if (!(dir && t == 0)) p.FILTt[(size_t)(o * 512 + cch) * FLEN + x] = tile[cl * 66 + lane];
    }
    __syncthreads();
  }
}

__device__ __forceinline__ void cvt_tile256(const float* src, int ld, int k0, int n0, bf16_t* dst, int ldd, int dmap0, int dmap1, int nsplit, float* sm) {
  const int tid = threadIdx.x;
  float* ts = sm;
  float4 v[8];
#pragma unroll
  for (int i = 0; i < 8; ++i) {
    const int e = tid + i * NTHR; const int k = e >> 6, n4 = (e & 63) * 4;
    v[i] = *(const float4*)(src + (size_t)(k0 + k) * ld + n0 + n4);
  }
#pragma unroll
  for (int i = 0; i < 8; ++i) {
    const int e = tid + i * NTHR; const int k = e >> 6, n4 = (e & 63) * 4;
    ts[k * 257 + n4 + 0] = v[i].x; ts[k * 257 + n4 + 1] = v[i].y; ts[k * 257 + n4 + 2] = v[i].z; ts[k * 257 + n4 + 3] = v[i].w;
  }
  __syncthreads();
#pragma unroll
  for (int i = 0; i < 4; ++i) {
    const int e = tid + i * NTHR; const int n = e >> 3, kq = (e & 7) * 8;
    uint4 w;
    w.x = cvt_pk_bf16(ts[(kq + 0) * 257 + n], ts[(kq + 1) * 257 + n]);
    w.y = cvt_pk_bf16(ts[(kq + 2) * 257 + n], ts[(kq + 3) * 257 + n]);
    w.z = cvt_pk_bf16(ts[(kq + 4) * 257 + n], ts[(kq + 5) * 257 + n]);
    w.w = cvt_pk_bf16(ts[(kq + 6) * 257 + n], ts[(kq + 7) * 257 + n]);
    const int drow = (n < nsplit) ? (dmap0 + n) : (dmap1 + (n - nsplit));
    *(uint4*)(dst + (size_t)drow * ldd + k0 + kq) = w;
  }
  __syncthreads();
}

__device__ void ph_wcvt(const Params& p, float* sm) {
  for (int it = blockIdx.x; it < 192 + 64 + 64 * 96; it += gridDim.x) {
    if (it < 192) { const int kt = it / 12, nt = it - kt * 12; cvt_tile256(p.w_in, DIN, kt * 64, nt * 256, p.WinT, D, nt * 256, 0, 256, sm); }
    else if (it < 256) { const int i = it - 192; const int kt = i >> 2, nt = i & 3; cvt_tile256(p.w_out, D, kt * 64, nt * 256, p.WoutT, D, nt * 256, 0, 256, sm); }
    else {
      const int i = it - 256; const int e = i / 96, r = i - e * 96;
      if (r < 64) {
        const int which = r >> 5, r2 = r & 31; const int kt = r2 >> 1, nt = r2 & 1;
        const float* src = (which ? p.w3 : p.w1) + (size_t)e * D * DE;
        const int c0 = nt * 256;
        cvt_tile256(src, DE, kt * 64, c0, p.Wup + (size_t)e * 1024 * 1024, D, (c0 >> 7) * 256 + which * 128, ((c0 >> 7) + 1) * 256 + which * 128, 128, sm);
      } else {
        const int r2 = r - 64; const int kt = r2 >> 2, nt = r2 & 3;
        cvt_tile256(p.w2 + (size_t)e * DE * D, D, kt * 64, nt * 256, p.Wdn + (size_t)e * 1024 * 512, DE, nt * 256, 0, 256, sm);
      }
    }
  }
}

__device__ void ph_norm1(const Params& p, float* sm) {
  const int tid = threadIdx.x, wid = tid >> 6, lane = tid & 63;
  float* wdt = sm;
  float* xs = sm + 16448 + wid * 1056;
  for (int e = tid; e < 4096; e += NTHR) {
    int k = e >> 2, q = e & 3;
    float4 v = *(const float4*)(p.w_in + (size_t)k * DIN + COL_DT + q * 4);
    *(float4*)(wdt + k * 16 + (k >> 8) * 16 + q * 4) = v;
  }
  __syncthreads();
  for (int row = blockIdx.x * 8 + wid; row < TT; row += gridDim.x * 8) {
    const float* src = (row < T) ? (p.x + (size_t)row * D) : (p.ctx + (size_t)(row - T) * D);
    const int mr = (row < T) ? (row / L) : 8;
    const float* sh = p.MOD + mr * 6144;
    const float* sc = sh + 1024;
    float4 v[4];
    float ss = 0.f;
#pragma unroll
    for (int i = 0; i < 4; ++i) {
      v[i] = *(const float4*)(src + i * 256 + lane * 4);
      ss += v[i].x * v[i].x + v[i].y * v[i].y + v[i].z * v[i].z + v[i].w * v[i].w;
    }
    ss = wave_sum(ss);
    const float rstd = rsqrtf(ss * (1.f / D) + EPS);
#pragma unroll
    for (int i = 0; i < 4; ++i) {
      const int col = i * 256 + lane * 4;
      float4 g = *(const float4*)(p.g1 + col);
      float4 s4 = *(const float4*)(sc + col);
      float4 h4 = *(const float4*)(sh + col);
      float4 o;
      o.x = v[i].x * rstd * g.x * (1.f + s4.x) + h4.x;
      o.y = v[i].y * rstd * g.y * (1.f + s4.y) + h4.y;
      o.z = v[i].z * rstd * g.z * (1.f + s4.z) + h4.z;
      o.w = v[i].w * rstd * g.w * (1.f + s4.w) + h4.w;
      uint2 w; w.x = cvt_pk_bf16(o.x, o.y); w.y = cvt_pk_bf16(o.z, o.w);
      *(uint2*)(p.XNb + (size_t)row * D + col) = w;
      *(float4*)(xs + col + i * 8) = o;
    }
    {
      const int j = lane & 15, ks = lane >> 4;
      const float* xp = xs + ks * 256 + ks * 8;
      const float* wp = wdt + (ks * 256) * 16 + ks * 16 + j;
      float a = 0.f;
#pragma unroll 8
      for (int k = 0; k < 256; ++k) a += xp[k] * wp[k * 16];
      a += __shfl_xor(a, 16);
      a += __shfl_xor(a, 32);
      if (lane < 16) p.DT[(size_t)row * 16 + j] = softplus_f(a + p.dt_bias[j]);
    }
  }
}

__device__ void ph_hy_convT(const Params& p, float* sm) {
  const int tid = threadIdx.x;
  float* tile = sm;
  for (int item = blockIdx.x; item < 256 * 24; item += gridDim.x) {
    const int gr = item / 24, ct = item - gr * 24;
    const int row0 = gr * 64;
    {
      const int t = tid >> 3, c8 = (tid & 7) * 8;
      uint4 v = *(const uint4*)(p.PXb + (size_t)(row0 + t) * DP + ct * 64 + c8);
      unsigned w[4] = {v.x, v.y, v.z, v.w};
#pragma unroll
      for (int k = 0; k < 4; ++k) {
        tile[t * 65 + c8 + 2 * k] = __uint_as_float(w[k] << 16);
        tile[t * 65 + c8 + 2 * k + 1] = __uint_as_float(w[k] & 0xffff0000u);
      }
    }
    __syncthreads();
    {
      const int cc = tid >> 3, t8 = (tid & 7) * 8;
      const int col = ct * 64 + cc;
      const float w0 = p.hy_conv_w[col], w1 = p.hy_conv_w[HYC + col], w2 = p.hy_conv_w[2 * HYC + col], bb = p.hy_conv_b[col];
      float o[8];
#pragma unroll
      for (int k = 0; k < 8; ++k) {
        const int t = t8 + k;
        float v = bb + w1 * tile[t * 65 + cc];
        if (t > 0) v += w0 * tile[(t - 1) * 65 + cc];
        if (t < 63) v += w2 * tile[(t + 1) * 65 + cc];
        o[k] = v;
      }
      uint4 w; w.x = cvt_pk_bf16(o[0], o[1]); w.y = cvt_pk_bf16(o[2], o[3]); w.z = cvt_pk_bf16(o[4], o[5]); w.w = cvt_pk_bf16(o[6], o[7]);
      *(uint4*)(p.Ut + (size_t)col * T + row0 + t8) = w;
    }
    __syncthreads();
  }
}

__device__ void ph_hy_backT(const Params& p, float* sm) {
  const int tid = threadIdx.x;
  bf16_t* tile = (bf16_t*)sm;
  for (int item = blockIdx.x; item < 256 * 8; item += gridDim.x) {
    const int gr = item >> 3, ct = item & 7;
    const int row0 = gr * 64;
    {
      const int cc = tid >> 3, r8 = (tid & 7) * 8;
      uint4 v = *(const uint4*)(p.Yt + (size_t)(ct * 64 + cc) * T + row0 + r8);
      unsigned w[4] = {v.x, v.y, v.z, v.w};
#pragma unroll
      for (int k = 0; k < 4; ++k) {
        tile[cc * 66 + r8 + 2 * k] = (bf16_t)(w[k] & 0xffffu);
        tile[cc * 66 + r8 + 2 * k + 1] = (bf16_t)(w[k] >> 16);
      }
    }
    __syncthreads();
    {
      const int r = tid >> 3, c8 = (tid & 7) * 8;
      unsigned w[4];
#pragma unroll
      for (int k = 0; k < 4; ++k) w[k] = (unsigned)tile[(c8 + 2 * k) * 66 + r] | ((unsigned)tile[(c8 + 2 * k + 1) * 66 + r] << 16);
      uint4 o; o.x = w[0]; o.y = w[1]; o.z = w[2]; o.w = w[3];
      *(uint4*)(p.YMIXb + (size_t)(row0 + r) * D + ct * 64 + c8) = o;
    }
    __syncthreads();
  }
}

typedef short hbf16x8 __attribute__((ext_vector_type(8)));
typedef float hf32x4 __attribute__((ext_vector_type(4)));

constexpr int HY_FC = 0, HY_ZT0 = 4 * FCLEN * 2, HY_ZT1 = HY_ZT0 + 8 * ZSTRB;

__device__ __forceinline__ void hy_build_filter(const Params& p, int o, int c, unsigned char* lds) {
  const int tid = threadIdx.x;
  const bf16_t* gsrc = p.FILTt + (size_t)(o * 512 + c) * FLEN;
  for (int e = tid; e < 530; e += NTHR) {
    uint4 v = make_uint4(0u, 0u, 0u, 0u);
    if (e < 529) v = *(const uint4*)(gsrc + e * 8);
    *(uint4*)(lds + HY_FC + e * 16) = v;
  }
  __syncthreads();
  for (int g = tid; g < 3 * 530; g += NTHR) {
    const int r = 1 + g / 530, ch = g % 530;
    uint4 lo = make_uint4(0u, 0u, 0u, 0u);
    if (ch > 0) lo = *(const uint4*)(lds + HY_FC + (ch - 1) * 16);
    uint4 hi = *(const uint4*)(lds + HY_FC + ch * 16);
    unsigned W[8] = {lo.x, lo.y, lo.z, lo.w, hi.x, hi.y, hi.z, hi.w};
    uint4 ov;
    if (r == 1) {
      ov.x = __builtin_amdgcn_alignbyte(W[4], W[3], 2); ov.y = __builtin_amdgcn_alignbyte(W[5], W[4], 2);
      ov.z = __builtin_amdgcn_alignbyte(W[6], W[5], 2); ov.w = __builtin_amdgcn_alignbyte(W[7], W[6], 2);
    } else if (r == 2) {
      ov.x = W[3]; ov.y = W[4]; ov.z = W[5]; ov.w = W[6];
    } else {
      ov.x = __builtin_amdgcn_alignbyte(W[3], W[2], 2); ov.y = __builtin_amdgcn_alignbyte(W[4], W[3], 2);
      ov.z = __builtin_amdgcn_alignbyte(W[5], W[4], 2); ov.w = __builtin_amdgcn_alignbyte(W[6], W[5], 2);
    }
    *(uint4*)(lds + HY_FC + r * (FCLEN * 2) + ch * 16) = ov;
  }
  __syncthreads();
}

__device__ __forceinline__ void hy_order(const Params& p, int o, int c, unsigned char* lds) {
  const int tid = threadIdx.x, wid = __builtin_amdgcn_readfirstlane(tid >> 6), lane = tid & 63;
  const int g0 = wid * 4;
  const int n16 = lane & 15, h = lane >> 4, bb = n16 & 7, pp = n16 >> 3;
  const unsigned char* Zin = lds + (o ? HY_ZT1 : HY_ZT0);
  const bf16_t* gate = p.Ut + (size_t)((o + 1) * 512 + c) * T + bb * L;
  uint2 xg[4][2];
#pragma unroll
  for (int i = 0; i < 4; ++i)
#pragma unroll
    for (int u = 0; u < 2; ++u) xg[i][u] = *(const uint2*)(gate + 32 * (2 * (g0 + i) + pp) + 16 * u + 4 * h);
  const float bias = p.hy_bias[o * 512 + c];
  hf32x4 acc[4][2];
#pragma unroll
  for (int i = 0; i < 4; ++i)
#pragma unroll
    for (int u = 0; u < 2; ++u) acc[i][u] = (hf32x4){0.f, 0.f, 0.f, 0.f};
  const int ai = lane & 15, ar = ai & 3, aq = ai >> 2;
  const unsigned char* laneA = lds + HY_FC + ar * (FCLEN * 2) + 2 * (HX0 - 4 * aq + 8 * h);
  const unsigned char* laneB = Zin + bb * ZSTRB + 64 + 64 * pp + 16 * h;
#define HY_LDA(dst, Dd) do { const uint2 _lo = *(const uint2*)(laneA - 32 * (Dd)); const uint2 _hi = *(const uint2*)(laneA - 32 * (Dd) + 8); \
    union { uint4 u4; hbf16x8 v; } _cv; _cv.u4 = make_uint4(_lo.x, _lo.y, _hi.x, _hi.y); dst = _cv.v; } while (0)
#define HY_LDB(dst, Qq) do { dst = *(const hbf16x8*)(laneB + 64 * (Qq)); } while (0)
#pragma unroll 1
  for (int pass = 0; pass < 2; ++pass) {
    const int Es = 2 * g0 - 63 + pass;
    hbf16x8 R[4];
    HY_LDB(R[1], 2 * (g0 + 1) - Es); HY_LDB(R[2], 2 * (g0 + 2) - Es); HY_LDB(R[3], 2 * (g0 + 3) - Es);
#pragma unroll 1
    for (int n4 = 0; n4 < 9; ++n4) {
#pragma unroll
      for (int j = 0; j < 4; ++j) {
        const int n = n4 * 4 + j;
        const int E = Es + 2 * n;
        HY_LDB(R[(4 - j) & 3], 2 * (g0 - n) - Es);
        hbf16x8 A0, A1;
        HY_LDA(A0, 2 * E); HY_LDA(A1, 2 * E + 1);
#pragma unroll
        for (int i = 0; i < 4; ++i) {
          const int Q = 2 * (g0 + i - n) - Es;
          if (Q >= -1 && Q <= 63) {
            acc[i][0] = __builtin_amdgcn_mfma_f32_16x16x32_bf16(A0, R[(i - j) & 3], acc[i][0], 0, 0, 0);
            acc[i][1] = __builtin_amdgcn_mfma_f32_16x16x32_bf16(A1, R[(i - j) & 3], acc[i][1], 0, 0, 0);
          }
        }
      }
    }
  }
#undef HY_LDA
#undef HY_LDB
#pragma unroll
  for (int i = 0; i < 4; ++i)
#pragma unroll
    for (int u = 0; u < 2; ++u) {
      const int t0 = 32 * (2 * (g0 + i) + pp) + 16 * u + 4 * h;
      const uint2 zv = *(const uint2*)(Zin + bb * ZSTRB + 64 + 2 * t0);
      const float z0 = __uint_as_float(zv.x << 16), z1 = __uint_as_float(zv.x & 0xffff0000u), z2 = __uint_as_float(zv.y << 16), z3 = __uint_as_float(zv.y & 0xffff0000u);
      const float x0 = __uint_as_float(xg[i][u].x << 16), x1 = __uint_as_float(xg[i][u].x & 0xffff0000u), x2 = __uint_as_float(xg[i][u].y << 16), x3 = __uint_as_float(xg[i][u].y & 0xffff0000u);
      const float r0 = x0 * (acc[i][u][0] + z0 * bias), r1 = x1 * (acc[i][u][1] + z1 * bias), r2 = x2 * (acc[i][u][2] + z2 * bias), r3 = x3 * (acc[i][u][3] + z3 * bias);
      uint2 w; w.x = cvt_pk_bf16(r0, r1); w.y = cvt_pk_bf16(r2, r3);
      if (o == 0) *(uint2*)(lds + HY_ZT1 + bb * ZSTRB + 64 + 2 * t0) = w;
      else *(uint2*)(p.Yt + (size_t)c * T + bb * L + t0) = w;
    }
}

__device__ void hyena_unit(const Params& p, int c, unsigned char* lds) {
  const int tid = threadIdx.x;
  if (tid < 144) {
    const int buf = tid / 72, rem = tid % 72, b = rem / 9, k = rem % 9;
    const int off = (k < 4) ? (k * 16) : (4160 + (k - 4) * 16);
    *(uint4*)(lds + (buf ? HY_ZT1 : HY_ZT0) + b * ZSTRB + off) = make_uint4(0u, 0u, 0u, 0u);
  }
  for (int e = tid; e < 2048; e += NTHR) {
    const int b = e >> 8, ch = e & 255;
    *(uint4*)(lds + HY_ZT0 + b * ZSTRB + 64 + ch * 16) = *(const uint4*)(p.Ut + (size_t)c * T + b * L + ch * 8);
  }
#pragma unroll 1
  for (int o = 0; o < 2; ++o) {
    hy_build_filter(p, o, c, lds);
    hy_order(p, o, c, lds);
    __syncthreads();
  }
}

constexpr int SROW = 272;

__device__ __forceinline__ void ssd_stage_nat(const Params& p, int row0, int pxcol0, int cvcol0, unsigned char* dst) {
  for (int e = threadIdx.x; e < 2048; e += NTHR) {
    const int l = e >> 4, cg = e & 15;
    const int row = row0 + l, li = row & 63;
    const bf16_t* src = p.PXb + (size_t)row * DP + pxcol0 + cg * 8;
    const uint4 zero4 = make_uint4(0u, 0u, 0u, 0u);
    const uint4 cur = *(const uint4*)src;
    const uint4 prv = (li > 0) ? *(const uint4*)(src - DP) : zero4;
    const uint4 nxt = (li < 63) ? *(const uint4*)(src + DP) : zero4;
    const float* cw = p.ssd_conv_w + cvcol0 + cg * 8;
    const float* cb = p.ssd_conv_b + cvcol0 + cg * 8;
    const unsigned pc[4] = {prv.x, prv.y, prv.z, prv.w}, cc[4] = {cur.x, cur.y, cur.z, cur.w}, nc[4] = {nxt.x, nxt.y, nxt.z, nxt.w};
    float o[8];
#pragma unroll
    for (int k = 0; k < 4; ++k) {
      const float p0 = __uint_as_float(pc[k] << 16), p1 = __uint_as_float(pc[k] & 0xffff0000u);
      const float c0 = __uint_as_float(cc[k] << 16), c1 = __uint_as_float(cc[k] & 0xffff0000u);
      const float n0 = __uint_as_float(nc[k] << 16), n1 = __uint_as_float(nc[k] & 0xffff0000u);
      const float v0 = cb[2 * k] + cw[2 * k] * p0 + cw[DXBC + 2 * k] * c0 + cw[2 * DXBC + 2 * k] * n0;
      const float v1 = cb[2 * k + 1] + cw[2 * k + 1] * p1 + cw[DXBC + 2 * k + 1] * c1 + cw[2 * DXBC + 2 * k + 1] * n1;
      o[2 * k] = silu_f(v0); o[2 * k + 1] = silu_f(v1);
    }
    uint4 w; w.x = cvt_pk_bf16(o[0], o[1]); w.y = cvt_pk_bf16(o[2], o[3]); w.z = cvt_pk_bf16(o[4], o[5]); w.w = cvt_pk_bf16(o[6], o[7]);
    *(uint4*)(dst + l * SROW + cg * 16) = w;
  }
}

__device__ __forceinline__ void ssd_stage_tr(const Params& p, int row0, bool is_ctx, int pxcol0, int cvcol0, int ncols, unsigned char* dst) {
  for (int e = threadIdx.x; e < ncols * 16; e += NTHR) {
    const int col = e & (ncols - 1), l8 = e / ncols;
    const int rowf = row0 + l8 * 8;
    bool has_prev, has_next;
    if (is_ctx) { const int tc = (rowf - T) & (LC - 1); has_prev = tc > 0; has_next = tc + 7 < LC - 1; }
    else { const int li = rowf & 63; has_prev = li > 0; has_next = li + 7 < 63; }
    const bf16_t* src = p.PXb + (size_t)rowf * DP + pxcol0 + col;
    float x[10];
    x[0] = (cvcol0 >= 0 && has_prev) ? bf2f(src[-DP]) : 0.f;
#pragma unroll
    for (int k = 0; k < 8; ++k) x[k + 1] = bf2f(src[(size_t)k * DP]);
    x[9] = (cvcol0 >= 0 && has_next) ? bf2f(src[(size_t)8 * DP]) : 0.f;
    float o[8];
    if (cvcol0 >= 0) {
      const float w0 = p.ssd_conv_w[cvcol0 + col], w1 = p.ssd_conv_w[DXBC + cvcol0 + col], w2 = p.ssd_conv_w[2 * DXBC + cvcol0 + col], bb = p.ssd_conv_b[cvcol0 + col];
#pragma unroll
      for (int k = 0; k < 8; ++k) o[k] = silu_f(bb + w0 * x[k] + w1 * x[k + 1] + w2 * x[k + 2]);
    } else {
#pragma unroll
      for (int k = 0; k < 8; ++k) o[k] = x[k + 1];
    }
    uint4 w; w.x = cvt_pk_bf16(o[0], o[1]); w.y = cvt_pk_bf16(o[2], o[3]); w.z = cvt_pk_bf16(o[4], o[5]); w.w = cvt_pk_bf16(o[6], o[7]);
    *(uint4*)(dst + col * SROW + l8 * 16) = w;
  }
}

__device__ void ssd_states_unit(const Params& p, int unit, unsigned char* lds) {
  const int tid = threadIdx.x, wid = __builtin_amdgcn_readfirstlane(tid >> 6), lane = tid & 63;
  const int g = unit & 1, bc = unit >> 1, cidx = bc % 18, b = bc / 18;
  const bool is_ctx = cidx < 2;
  const int row0 = is_ctx ? (T + b * LC + cidx * 128) : (b * L + (cidx - 2) * 128);
  unsigned char* XT = lds;
  unsigned char* BT = lds + 69632;
  unsigned char* XD = lds + 104448;
  float* WG = (float*)(lds + 121856);
  ssd_stage_tr(p, row0, is_ctx, COL_XBC + g * 256, g * 256, 256, XT);
  ssd_stage_tr(p, row0, is_ctx, COL_XBC + 512 + g * 128, 512 + g * 128, 128, BT);
  {
    const int dir = wid >> 2, hh = wid & 3, h = g * 4 + hh;
    const float A = expf(p.a_log[dir * 8 + h]);
    const int l0 = 2 * lane, l1 = l0 + 1;
    const float dt0 = p.DT[(size_t)(row0 + l0) * 16 + dir * 8 + h], dt1 = p.DT[(size_t)(row0 + l1) * 16 + dir * 8 + h];
    const float a0 = -A * dt0, a1 = -A * dt1, pair = a0 + a1;
    float incl = pair;
#pragma unroll
    for (int o = 1; o < 64; o <<= 1) { float t = __shfl_up(incl, o); if (lane >= o) incl += t; }
    const float excl = incl - pair;
    const float total = __shfl(incl, 63);
    float w0, w1, c0, c1;
    if (dir == 0) { c0 = excl + a0; c1 = excl + pair; w0 = dt0 * expf(total - c0); w1 = dt1 * expf(total - c1); }
    else { const float pe0 = excl, pe1 = excl + a0; w0 = dt0 * expf(pe0); w1 = dt1 * expf(pe1); c0 = total - pe0; c1 = total - pe1; }
    WG[wid * 128 + l0] = w0; WG[wid * 128 + l1] = w1;
    if (!is_ctx) { float* ac = p.ACUM + (size_t)(b * 16 + dir * 8 + h) * L + (cidx - 2) * 128; *(float2*)(ac + l0) = make_float2(c0, c1); }
    if (lane == 0) {
      const int k = dir ? (is_ctx ? (1 - cidx) : (19 - cidx)) : cidx;
      p.CDEC[(size_t)(((b * 2 + dir) * 8 + h) * 18 + k) * 32] = expf(total);
    }
  }
  __syncthreads();
  const int fr = lane & 15, fq = lane >> 4;
#pragma unroll 1
  for (int it = 0; it < 8; ++it) {
    const int dir = it >> 2, hh = it & 3, h = g * 4 + hh;
    for (int e = tid; e < 1024; e += NTHR) {
      const int pr = e >> 4, ch = e & 15;
      const uint4 v = *(const uint4*)(XT + (hh * 64 + pr) * SROW + ch * 16);
      const float4 wa = *(const float4*)(WG + it * 128 + ch * 8), wb = *(const float4*)(WG + it * 128 + ch * 8 + 4);
      uint4 w;
      w.x = cvt_pk_bf16(__uint_as_float(v.x << 16) * wa.x, __uint_as_float(v.x & 0xffff0000u) * wa.y);
      w.y = cvt_pk_bf16(__uint_as_float(v.y << 16) * wa.z, __uint_as_float(v.y & 0xffff0000u) * wa.w);
      w.z = cvt_pk_bf16(__uint_as_float(v.z << 16) * wb.x, __uint_as_float(v.z & 0xffff0000u) * wb.y);
      w.w = cvt_pk_bf16(__uint_as_float(v.w << 16) * wb.z, __uint_as_float(v.w & 0xffff0000u) * wb.w);
      *(uint4*)(XD + pr * SROW + ch * 16) = w;
    }
    __syncthreads();
    hf32x4 acc[4];
#pragma unroll
    for (int pt = 0; pt < 4; ++pt) acc[pt] = (hf32x4){0.f, 0.f, 0.f, 0.f};
#pragma unroll
    for (int kk = 0; kk < 4; ++kk) {
      const hbf16x8 Bf = *(const hbf16x8*)(BT + (16 * wid + fr) * SROW + 2 * (32 * kk + 8 * fq));
#pragma unroll
      for (int pt = 0; pt < 4; ++pt) {
        const hbf16x8 Af = *(const hbf16x8*)(XD + (16 * pt + fr) * SROW + 2 * (32 * kk + 8 * fq));
        acc[pt] = __builtin_amdgcn_mfma_f32_16x16x32_bf16(Bf, Af, acc[pt], 0, 0, 0);
      }
    }
    const int k = dir ? (is_ctx ? (1 - cidx) : (19 - cidx)) : cidx;
    bf16_t* slot = p.SST + ((size_t)(((b * 2 + dir) * 8 + h) * 18 + k)) * 8192;
#pragma unroll
    for (int pt = 0; pt < 4; ++pt)
      *(uint2*)(slot + (16 * pt + fr) * 128 + 16 * wid + 4 * fq) = make_uint2(cvt_pk_bf16(acc[pt][0], acc[pt][1]), cvt_pk_bf16(acc[pt][2], acc[pt][3]));
    __syncthreads();
  }
}

__device__ void ssd_scan_unit(const Params& p, int unit) {
  const int tid = threadIdx.x;
  const int half = unit & 1, seq = unit >> 1;
  const int pr = half * 32 + (tid >> 4), n8 = (tid & 15) * 8;
  const bf16_t* base = p.SST + (size_t)seq * 18 * 8192 + pr * 128 + n8;
  uint4 sv[18];
#pragma unroll
  for (int k = 0; k < 18; ++k) sv[k] = *(const uint4*)(base + (size_t)k * 8192);
  float hst[8];
#pragma unroll
  for (int j = 0; j < 8; ++j) hst[j] = 0.f;
#pragma unroll
  for (int k = 0; k < 18; ++k) {
    const float dec = p.CDEC[(size_t)(seq * 18 + k) * 32];
    if (k >= 2) {
      uint4 w; w.x = cvt_pk_bf16(hst[0], hst[1]); w.y = cvt_pk_bf16(hst[2], hst[3]); w.z = cvt_pk_bf16(hst[4], hst[5]); w.w = cvt_pk_bf16(hst[6], hst[7]);
      *(uint4*)(p.HIN + ((size_t)seq * 16 + (k - 2)) * 8192 + pr * 128 + n8) = w;
    }
    const unsigned sw[4] = {sv[k].x, sv[k].y, sv[k].z, sv[k].w};
#pragma unroll
    for (int u = 0; u < 4; ++u) {
      hst[2 * u] = dec * hst[2 * u] + __uint_as_float(sw[u] << 16);
      hst[2 * u + 1] = dec * hst[2 * u + 1] + __uint_as_float(sw[u] & 0xffff0000u);
    }
  }
}

__device__ void ssd_out_unit(const Params& p, int unit, unsigned char* lds) {
  const int tid = threadIdx.x, wid = __builtin_amdgcn_readfirstlane(tid >> 6), lane = tid & 63;
  const int fr = lane & 15, fq = lane >> 4;
  const int g = unit & 1, bc = unit >> 1, c = bc & 15, b = bc >> 4;
  const int row0 = b * L + c * 128;
  unsigned char* CS = lds;
  unsigned char* ML = lds + 34816;
  unsigned char* XT = lds + 69632;
  unsigned char* ZT = lds + 87040;
  unsigned char* HS = lds + 104448;
  float* CUM = (float*)(lds + 121856);
  float* DTL = (float*)(lds + 125952);
  ssd_stage_nat(p, row0, COL_XBC + 768 + g * 128, 768 + g * 128, CS);
  ssd_stage_nat(p, row0, COL_XBC + 512 + g * 128, 512 + g * 128, ML);
  for (int e = tid; e < 1024; e += NTHR) {
    const int it = e >> 7, l = e & 127, dir = it >> 2, hh = it & 3;
    CUM[e] = p.ACUM[(size_t)(b * 16 + dir * 8 + g * 4 + hh) * L + c * 128 + l];
    DTL[e] = p.DT[(size_t)(row0 + l) * 16 + dir * 8 + g * 4 + hh];
  }
  __syncthreads();
  hf32x4 cbt[8];
#pragma unroll
  for (int lt = 0; lt < 8; ++lt) cbt[lt] = (hf32x4){0.f, 0.f, 0.f, 0.f};
#pragma unroll
  for (int kk = 0; kk < 4; ++kk) {
    const hbf16x8 Af = *(const hbf16x8*)(ML + (16 * wid + fr) * SROW + 2 * (32 * kk + 8 * fq));
#pragma unroll
    for (int lt = 0; lt < 8; ++lt) {
      const hbf16x8 Bf = *(const hbf16x8*)(CS + (16 * lt + fr) * SROW + 2 * (32 * kk + 8 * fq));
      cbt[lt] = __builtin_amdgcn_mfma_f32_16x16x32_bf16(Af, Bf, cbt[lt], 0, 0, 0);
    }
  }
  __syncthreads();
  hf32x4 y[4][4];
#pragma unroll
  for (int hh = 0; hh < 4; ++hh)
#pragma unroll
    for (int pt = 0; pt < 4; ++pt) y[hh][pt] = (hf32x4){0.f, 0.f, 0.f, 0.f};
  const int sb = 16 * wid + 4 * fq;
#pragma unroll 1
  for (int hh = 0; hh < 4; ++hh) {
    const int h = g * 4 + hh;
    hf32x4 yc[4];
#pragma unroll
    for (int pt = 0; pt < 4; ++pt) yc[pt] = (hf32x4){0.f, 0.f, 0.f, 0.f};
    ssd_stage_tr(p, row0, false, COL_XBC + g * 256 + hh * 64, g * 256 + hh * 64, 64, XT);
    ssd_stage_tr(p, row0, false, COL_Z + g * 256 + hh * 64, -1, 64, ZT);
#pragma unroll 1
    for (int dir = 0; dir < 2; ++dir) {
      const int it = dir * 4 + hh;
      const int k = dir ? (17 - c) : (c + 2);
      const bf16_t* slot = p.HIN + ((size_t)(((b * 2 + dir) * 8 + h) * 16 + (k - 2))) * 8192;
      for (int e = tid; e < 1024; e += NTHR) {
        const int pr = e >> 4, ch = e & 15;
        *(uint4*)(HS + pr * SROW + ch * 16) = *(const uint4*)(slot + pr * 128 + ch * 8);
      }
      {
        const float* cu = CUM + it * 128; const float* dl = DTL + it * 128;
        float cs[4], ds[4];
#pragma unroll
        for (int r = 0; r < 4; ++r) { cs[r] = cu[sb + r]; ds[r] = dl[sb + r]; }
#pragma unroll
        for (int lt = 0; lt < 8; ++lt) {
          const int l = 16 * lt + fr;
          const float cl = cu[l];
          float m[4];
#pragma unroll
          for (int r = 0; r < 4; ++r) {
            const int sidx = sb + r;
            const bool ok = dir ? (sidx >= l) : (sidx <= l);
            m[r] = ok ? cbt[lt][r] * __expf(cl - cs[r]) * ds[r] : 0.f;
          }
          uint2 w; w.x = cvt_pk_bf16(m[0], m[1]); w.y = cvt_pk_bf16(m[2], m[3]);
          *(uint2*)(ML + l * SROW + 2 * sb) = w;
        }
      }
      __syncthreads();
      hf32x4 ad[4], ao[4];
#pragma unroll
      for (int pt = 0; pt < 4; ++pt) { ad[pt] = (hf32x4){0.f, 0.f, 0.f, 0.f}; ao[pt] = (hf32x4){0.f, 0.f, 0.f, 0.f}; }
#pragma unroll
      for (int kk = 0; kk < 4; ++kk) {
        const hbf16x8 Am = *(const hbf16x8*)(ML + (16 * wid + fr) * SROW + 2 * (32 * kk + 8 * fq));
        const hbf16x8 Ac = *(const hbf16x8*)(CS + (16 * wid + fr) * SROW + 2 * (32 * kk + 8 * fq));
#pragma unroll
        for (int pt = 0; pt < 4; ++pt) {
          const hbf16x8 Bx = *(const hbf16x8*)(XT + (16 * pt + fr) * SROW + 2 * (32 * kk + 8 * fq));
          const hbf16x8 Bh = *(const hbf16x8*)(HS + (16 * pt + fr) * SROW + 2 * (32 * kk + 8 * fq));
          ad[pt] = __builtin_amdgcn_mfma_f32_16x16x32_bf16(Am, Bx, ad[pt], 0, 0, 0);
          ao[pt] = __builtin_amdgcn_mfma_f32_16x16x32_bf16(Ac, Bh, ao[pt], 0, 0, 0);
        }
      }
      {
        const float* cu = CUM + it * 128;
        float ex[4];
#pragma unroll
        for (int r = 0; r < 4; ++r) ex[r] = __expf(cu[sb + r]);
#pragma unroll
        for (int pt = 0; pt < 4; ++pt)
#pragma unroll
          for (int r = 0; r < 4; ++r) yc[pt][r] += ad[pt][r] + ex[r] * ao[pt][r];
      }
      __syncthreads();
    }
    {
      const float dsk = p.ssd_d[h];
#pragma unroll
      for (int pt = 0; pt < 4; ++pt) {
        const uint2 xv = *(const uint2*)(XT + (16 * pt + fr) * SROW + 2 * sb);
        const uint2 zv = *(const uint2*)(ZT + (16 * pt + fr) * SROW + 2 * sb);
        const float xs4[4] = {__uint_as_float(xv.x << 16), __uint_as_float(xv.x & 0xffff0000u), __uint_as_float(xv.y << 16), __uint_as_float(xv.y & 0xffff0000u)};
        const float zs4[4] = {__uint_as_float(zv.x << 16), __uint_as_float(zv.x & 0xffff0000u), __uint_as_float(zv.y << 16), __uint_as_float(zv.y & 0xffff0000u)};
#pragma unroll
        for (int r = 0; r < 4; ++r) yc[pt][r] = (yc[pt][r] + dsk * xs4[r]) * silu_f(zs4[r]);
      }
    }
    if (hh == 0) {
#pragma unroll
      for (int pt = 0; pt < 4; ++pt) y[0][pt] = yc[pt];
    } else if (hh == 1) {
#pragma unroll
      for (int pt = 0; pt < 4; ++pt) y[1][pt] = yc[pt];
    } else if (hh == 2) {
#pragma unroll
      for (int pt = 0; pt < 4; ++pt) y[2][pt] = yc[pt];
    } else {
#pragma unroll
      for (int pt = 0; pt < 4; ++pt) y[3][pt] = yc[pt];
    }
    __syncthreads();
  }
  float rinv[4];
#pragma unroll
  for (int r = 0; r < 4; ++r) {
    float ss = 0.f;
#pragma unroll
    for (int hh = 0; hh < 4; ++hh)
#pragma unroll
      for (int pt = 0; pt < 4; ++pt) ss += y[hh][pt][r] * y[hh][pt][r];
    ss += __shfl_xor(ss, 1); ss += __shfl_xor(ss, 2); ss += __shfl_xor(ss, 4); ss += __shfl_xor(ss, 8);
    rinv[r] = rsqrtf(ss * (1.f / 256.f) + EPS);
  }
#pragma unroll
  for (int hh = 0; hh < 4; ++hh)
#pragma unroll
    for (int pt = 0; pt < 4; ++pt) {
      const int ch = g * 256 + hh * 64 + 16 * pt + fr;
      const float ng = p.ssd_norm_g[ch];
#pragma unroll
      for (int r = 0; r < 4; ++r) p.YMIXb[(size_t)(row0 + sb + r) * D + 512 + ch] = f2bf(y[hh][pt][r] * rinv[r] * ng);
    }
}

__device__ void ph_router(const Params& p, unsigned char* lds) {
  const int tid = threadIdx.x, wid = __builtin_amdgcn_readfirstlane(tid >> 6), lane = tid & 63;
  const int fr = lane & 15, fq = lane >> 4;
  constexpr int AROW = 528;
  unsigned char* AH = lds;
  unsigned char* AL = lds + 64 * AROW;
  float* RS = (float*)(lds + 2 * 64 * AROW);
  float* LOG = RS + 64;
  for (int tile = blockIdx.x; tile < T / 64; tile += gridDim.x) {
    const int row0 = tile * 64;
    const float* shp = p.MOD + (row0 / L) * 6144 + 3072;
    const float* scp = shp + 1024;
    for (int t8 = 0; t8 < 8; ++t8) {
      const int tok = wid * 8 + t8;
      const float* src = p.X1 + (size_t)(row0 + tok) * D;
      float ss = 0.f;
#pragma unroll
      for (int i = 0; i < 4; ++i) { const float4 v = *(const float4*)(src + i * 256 + lane * 4); ss += v.x * v.x + v.y * v.y + v.z * v.z + v.w * v.w; }
      ss = wave_sum(ss);
      if (lane == 0) RS[tok] = rsqrtf(ss * (1.f / D) + EPS);
    }
    __syncthreads();
    hf32x4 acc[3];
#pragma unroll
    for (int nt = 0; nt < 3; ++nt) acc[nt] = (hf32x4){0.f, 0.f, 0.f, 0.f};
    const int mt = wid & 3, nh = wid >> 2;
#pragma unroll 1
    for (int kc = 0; kc < 4; ++kc) {
#pragma unroll
      for (int i = 0; i < 8; ++i) {
        const int e = tid + i * NTHR; const int tok = e >> 6, k4 = (e & 63) * 4;
        const int kg = kc * 256 + k4;
        const float4 v = *(const float4*)(p.X1 + (size_t)(row0 + tok) * D + kg);
        const float4 g = *(const float4*)(p.g2 + kg);
        const float4 s4 = *(const float4*)(scp + kg);
        const float4 h4 = *(const float4*)(shp + kg);
        const float rstd = RS[tok];
        const float h0 = v.x * rstd * g.x * (1.f + s4.x) + h4.x, h1 = v.y * rstd * g.y * (1.f + s4.y) + h4.y;
        const float h2 = v.z * rstd * g.z * (1.f + s4.z) + h4.z, h3 = v.w * rstd * g.w * (1.f + s4.w) + h4.w;
        const unsigned hi01 = cvt_pk_bf16(h0, h1), hi23 = cvt_pk_bf16(h2, h3);
        const unsigned lo01 = cvt_pk_bf16(h0 - __uint_as_float(hi01 << 16), h1 - __uint_as_float(hi01 & 0xffff0000u));
        const unsigned lo23 = cvt_pk_bf16(h2 - __uint_as_float(hi23 << 16), h3 - __uint_as_float(hi23 & 0xffff0000u));
        *(uint2*)(AH + tok * AROW + k4 * 2) = make_uint2(hi01, hi23);
        *(uint2*)(AL + tok * AROW + k4 * 2) = make_uint2(lo01, lo23);
        *(uint2*)(p.H2b + (size_t)(row0 + tok) * D + kg) = make_uint2(hi01, hi23);
      }
      __syncthreads();
#pragma unroll 2
      for (int kk = 0; kk < 8; ++kk) {
        const hbf16x8 Ahi = *(const hbf16x8*)(AH + (16 * mt + fr) * AROW + 2 * (32 * kk + 8 * fq));
        const hbf16x8 Alo = *(const hbf16x8*)(AL + (16 * mt + fr) * AROW + 2 * (32 * kk + 8 * fq));
#pragma unroll
        for (int nt = 0; nt < 3; ++nt) {
          const size_t wo = (size_t)(16 * (nh * 3 + nt) + fr) * 1024 + kc * 256 + 32 * kk + 8 * fq;
          const hbf16x8 Bhi = *(const hbf16x8*)(p.WRhi + wo);
          const hbf16x8 Blo = *(const hbf16x8*)(p.WRlo + wo);
          acc[nt] = __builtin_amdgcn_mfma_f32_16x16x32_bf16(Ahi, Bhi, acc[nt], 0, 0, 0);
          acc[nt] = __builtin_amdgcn_mfma_f32_16x16x32_bf16(Ahi, Blo, acc[nt], 0, 0, 0);
          acc[nt] = __builtin_amdgcn_mfma_f32_16x16x32_bf16(Alo, Bhi, acc[nt], 0, 0, 0);
        }
      }
      __syncthreads();
    }
#pragma unroll
    for (int nt = 0; nt < 3; ++nt)
#pragma unroll
      for (int r = 0; r < 4; ++r) LOG[(16 * mt + 4 * fq + r) * 100 + 16 * (nh * 3 + nt) + fr] = acc[nt][r];
    __syncthreads();
    if (tid < 64) {
      const float* lg = LOG + tid * 100;
      const int row = row0 + tid;
      int gs = 0; float gm = lg[64] + p.b_group[0];
      float gl[8];
      gl[0] = gm;
#pragma unroll
      for (int j = 1; j < 8; ++j) { gl[j] = lg[64 + j] + p.b_group[j]; if (gl[j] > gm) { gm = gl[j]; gs = j; } }
      float den = 0.f;
#pragma unroll
      for (int j = 0; j < 8; ++j) den += expf(gl[j] - gm);
      const float pg = 1.f / den;
      float el[8];
#pragma unroll
      for (int j = 0; j < 8; ++j) el[j] = 0.f;
      for (int j = 0; j < 8; ++j) el[j] = lg[gs * 8 + j] + p.b_expert[gs * 8 + j];
      int i0 = 0; float l0 = el[0];
#pragma unroll
      for (int j = 1; j < 8; ++j) if (el[j] > l0) { l0 = el[j]; i0 = j; }
      int i1 = -1; float l1 = -3.0e38f;
#pragma unroll
      for (int j = 0; j < 8; ++j) if (j != i0 && el[j] > l1) { l1 = el[j]; i1 = j; }
      const float e1 = expf(l1 - l0);
      const float w0 = 1.f / (1.f + e1), w1 = e1 / (1.f + e1);
      p.GATE[row * 2 + 0] = w0 * pg;
      p.GATE[row * 2 + 1] = w1 * pg;
      const int ea = gs * 8 + i0, eb = gs * 8 + i1;
      const int sa = atomicAdd(&p.CNT[ea], 1);
      p.LIST[ea * T + sa] = row * 2 + 0;
      const int sb2 = atomicAdd(&p.CNT[eb], 1);
      p.LIST[eb * T + sb2] = row * 2 + 1;
    }
    __syncthreads();
  }
}

__device__ __forceinline__ void moe_table(const Params& p, int* tab) {
  if (threadIdx.x == 0) {
    int a = 0, sg = 0;
    for (int e = 0; e < NE; ++e) {
      int cn = p.CNT[e];
      tab[e] = a; tab[65 + e] = sg; tab[130 + e] = cn;
      a += (cn + 255) >> 8; sg += ((cn + 127) >> 7) << 7;
    }
    tab[NE] = a; tab[65 + NE] = sg;
  }
  __syncthreads();
}

__device__ void ph_final(const Params& p) {
  const int tid = threadIdx.x, wid = tid >> 6, lane = tid & 63;
  for (int row = blockIdx.x * 8 + wid; row < T; row += gridDim.x * 8) {
    const float* ga2 = p.MOD + (row / L) * 6144 + 5120;
    float4 v[4];
    float ss = 0.f;
#pragma unroll
    for (int i = 0; i < 4; ++i) {
      const int col = i * 256 + lane * 4;
      float4 xv = *(const float4*)(p.X1 + (size_t)row * D + col);
      uint2 a = *(const uint2*)(p.YB2b + (size_t)(row * 2) * D + col);
      uint2 b = *(const uint2*)(p.YB2b + (size_t)(row * 2 + 1) * D + col);
      float4 ga = *(const float4*)(ga2 + col);
      v[i].x = xv.x + ga.x * (__uint_as_float(a.x << 16) + __uint_as_float(b.x << 16));
      v[i].y = xv.y + ga.y * (__uint_as_float(a.x & 0xffff0000u) + __uint_as_float(b.x & 0xffff0000u));
      v[i].z = xv.z + ga.z * (__uint_as_float(a.y << 16) + __uint_as_float(b.y << 16));
      v[i].w = xv.w + ga.w * (__uint_as_float(a.y & 0xffff0000u) + __uint_as_float(b.y & 0xffff0000u));
      ss += v[i].x * v[i].x + v[i].y * v[i].y + v[i].z * v[i].z + v[i].w * v[i].w;
    }
    ss = wave_sum(ss);
    const float rstd = rsqrtf(ss * (1.f / D) + EPS);
#pragma unroll
    for (int i = 0; i < 4; ++i) {
      const int col = i * 256 + lane * 4;
      float4 gf = *(const float4*)(p.g_final + col);
      float4 o;
      o.x = v[i].x * rstd * gf.x; o.y = v[i].y * rstd * gf.y; o.z = v[i].z * rstd * gf.z; o.w = v[i].w * rstd * gf.w;
      *(float4*)(p.out + (size_t)row * D + col) = o;
    }
  }
}

constexpr int NPHASE = 11;

__global__ void __launch_bounds__(NTHR, 2) mega(Params p) {
  extern __shared__ __attribute__((aligned(16))) unsigned char lds_raw[];
  float* sm = (float*)lds_raw;
  PG8_LAS unsigned char* lds = (PG8_LAS unsigned char*)lds_raw;
  const int lo = p.lo, hi = p.hi;
  volatile LAS unsigned* xbst = (volatile LAS unsigned*)(lds + pg8::STAGE_BYTES + 2048);
  if (threadIdx.x < 4) xbst[threadIdx.x] = 0u;
  __syncthreads();
  XcdBarrier xbar; xbar.bar = p.BAR; xbar.x = 0; xbar.st = xbst;
  if (hi - lo > 1) xbar = xcd_barrier_post(p.BAR, xbst);
#define IN(k) (lo <= (k) && (k) < hi)
#define SYNC(k) do { if (IN(k) && IN((k) + 1)) xcd_barrier(xbar); } while (0)
#ifndef DUPK
#define DUPK -1
#endif
#ifndef SKIP_OTHER
  if (IN(0)) { ph_adaln(p, sm); ph_filters(p, sm); ph_wcvt(p, sm); }
#if DUPK == 0
  xcd_barrier(xbar);
  if (IN(0)) { ph_adaln(p, sm); ph_filters(p, sm); ph_wcvt(p, sm); }
#endif
  SYNC(0);
  if (IN(1)) ph_norm1(p, sm);
#if DUPK == 1
  xcd_barrier(xbar);
  if (IN(1)) ph_norm1(p, sm);
#endif
  SYNC(1);
#endif
#ifndef SKIP_GEMM
  if (IN(2)) {
    pg8::DenseOrder S{p.XNb, p.WinT, TT / 256, DP / 256, D, (int)gridDim.x, (int)blockIdx.x};
    pg8::EpiBf16 E{p.PXb, DP};
    pg8::gemm_phase<pg8::EpiBf16, pg8::DenseOrder>(lds, D, S, E);
  }
#if DUPK == 2
  xcd_barrier(xbar);
  if (IN(2)) {
    pg8::DenseOrder S{p.XNb, p.WinT, TT / 256, DP / 256, D, (int)gridDim.x, (int)blockIdx.x};
    pg8::EpiBf16 E{p.PXb, DP};
    pg8::gemm_phase<pg8::EpiBf16, pg8::DenseOrder>(lds, D, S, E);
  }
#endif
  SYNC(2);
#endif
#ifndef SKIP_OTHER
  if (IN(3)) {
    ph_hy_convT(p, sm);
    for (int it = blockIdx.x; it < 288; it += gridDim.x) ssd_states_unit(p, it, lds_raw);
  }
#if DUPK == 3
  xcd_barrier(xbar);
  if (IN(3)) {
    ph_hy_convT(p, sm);
    for (int it = blockIdx.x; it < 288; it += gridDim.x) ssd_states_unit(p, it, lds_raw);
  }
#endif
  SYNC(3);
  if (IN(4)) {
    for (int it = blockIdx.x; it < 256; it += gridDim.x) ssd_scan_unit(p, it);
    for (int it = blockIdx.x; it < 512; it += gridDim.x) hyena_unit(p, it, lds_raw);
  }
#if DUPK == 4
  xcd_barrier(xbar);
  if (IN(4)) {
    for (int it = blockIdx.x; it < 256; it += gridDim.x) ssd_scan_unit(p, it);
    for (int it = blockIdx.x; it < 512; it += gridDim.x) hyena_unit(p, it, lds_raw);
  }
#endif
  SYNC(4);
  if (IN(5)) {
    for (int it = blockIdx.x; it < 256; it += gridDim.x) { ssd_out_unit(p, it, lds_raw); __syncthreads(); }
    ph_hy_backT(p, sm);
  }
#if DUPK == 5
  xcd_barrier(xbar);
  if (IN(5)) {
    for (int it = blockIdx.x; it < 256; it += gridDim.x) { ssd_out_unit(p, it, lds_raw); __syncthreads(); }
    ph_hy_backT(p, sm);
  }
#endif
  SYNC(5);
#endif
#ifndef SKIP_GEMM
  if (IN(6)) {
    pg8::DenseOrder S{p.YMIXb, p.WoutT, T / 256, D / 256, D, (int)gridDim.x, (int)blockIdx.x};
    pg8::EpiX1 E{p.x, p.MOD, p.X1};
    pg8::gemm_phase<pg8::EpiX1, pg8::DenseOrder>(lds, D, S, E);
  }
#if DUPK == 6
  xcd_barrier(xbar);
  if (IN(6)) {
    pg8::DenseOrder S{p.YMIXb, p.WoutT, T / 256, D / 256, D, (int)gridDim.x, (int)blockIdx.x};
    pg8::EpiX1 E{p.x, p.MOD, p.X1};
    pg8::gemm_phase<pg8::EpiX1, pg8::DenseOrder>(lds, D, S, E);
  }
#endif
  SYNC(6);
#endif
#ifndef SKIP_OTHER
  if (IN(7)) ph_router(p, lds_raw);
#if DUPK == 7
  xcd_barrier(xbar);
  if (IN(7)) ph_router(p, lds_raw);
#endif
  SYNC(7);
#endif
#ifndef SKIP_GEMM
  if (IN(8)) {
    int* tab = (int*)(lds_raw + pg8::STAGE_BYTES);
    moe_table(p, tab);
    pg8::MoeOrder S{tab, p.H2b, p.Wup, p.LIST, 4, D, (int)gridDim.x, (int)blockIdx.x, true};
    pg8::EpiSwiGLU E{p.HBb};
    pg8::gemm_phase<pg8::EpiSwiGLU, pg8::MoeOrder>(lds, D, S, E);
  }
#if DUPK == 8
  xcd_barrier(xbar);
  if (IN(8)) {
    int* tab = (int*)(lds_raw + pg8::STAGE_BYTES);
    moe_table(p, tab);
    pg8::MoeOrder S{tab, p.H2b, p.Wup, p.LIST, 4, D, (int)gridDim.x, (int)blockIdx.x, true};
    pg8::EpiSwiGLU E{p.HBb};
    pg8::gemm_phase<pg8::EpiSwiGLU, pg8::MoeOrder>(lds, D, S, E);
  }
#endif
  SYNC(8);
  if (IN(9)) {
    int* tab = (int*)(lds_raw + pg8::STAGE_BYTES);
    moe_table(p, tab);
    pg8::MoeOrder S{tab, p.HBb, p.Wdn, p.LIST, 4, DE, (int)gridDim.x, (int)blockIdx.x, false};
    pg8::EpiDown E{p.YB2b, p.LIST, p.GATE};
    pg8::gemm_phase<pg8::EpiDown, pg8::MoeOrder>(lds, DE, S, E);
  }
#if DUPK == 9
  xcd_barrier(xbar);
  if (IN(9)) {
    int* tab = (int*)(lds_raw + pg8::STAGE_BYTES);
    moe_table(p, tab);
    pg8::MoeOrder S{tab, p.HBb, p.Wdn, p.LIST, 4, DE, (int)gridDim.x, (int)blockIdx.x, false};
    pg8::EpiDown E{p.YB2b, p.LIST, p.GATE};
    pg8::gemm_phase<pg8::EpiDown, pg8::MoeOrder>(lds, DE, S, E);
  }
#endif
  SYNC(9);
#endif
#ifndef SKIP_OTHER
  if (IN(10)) ph_final(p);
#if DUPK == 10
  xcd_barrier(xbar);
  if (IN(10)) ph_final(p);
#endif
#endif
#undef IN
#undef SYNC
}

extern "C" void kernel_launch(void* const* d_in, const int* in_sizes, int n_in, void* d_out, int out_size,
                              void* d_ws, size_t ws_size, hipStream_t stream) {
  Params p{};
  const float* const* in = (const float* const*)d_in;
  p.x = in[0]; p.c = in[1]; p.ctx = in[2]; p.c_ctx = in[3]; p.w_ada = in[4]; p.b_ada = in[5];
  p.g1 = in[6]; p.g2 = in[7]; p.w_in = in[8]; p.hy_conv_w = in[9]; p.hy_conv_b = in[10];
  p.f_w1 = in[11]; p.f_b1 = in[12]; p.f_freq = in[13]; p.f_w2 = in[14]; p.f_b2 = in[15]; p.f_w3 = in[16];
  p.hy_bias = in[17]; p.ssd_conv_w = in[18]; p.ssd_conv_b = in[19]; p.a_log = in[20]; p.dt_bias = in[21];
  p.ssd_d = in[22]; p.ssd_norm_g = in[23]; p.w_out = in[24]; p.w_group = in[25]; p.b_group = in[26];
  p.w_expert = in[27]; p.b_expert = in[28]; p.w1 = in[29]; p.w3 = in[30]; p.w2 = in[31]; p.g_final = in[32];
  p.out = (float*)d_out;

  char* ws = (char*)d_ws;
  size_t off = 0;
  auto take = [&](size_t bytes) { char* r = ws + off; off += (bytes + 255) & ~(size_t)255; return r; };
  p.BAR = (unsigned*)take((size_t)XCD_BAR_WORDS * 4);
  p.MOD = (float*)take((size_t)9 * 6144 * 4);
  p.CNT = (int*)take(NE * 4);
  p.GATE = (float*)take((size_t)T * 2 * 4);
  p.LIST = (int*)take((size_t)NE * T * 4);
  p.DT = (float*)take((size_t)TT * 16 * 4);
  p.ACUM = (float*)take((size_t)T * 16 * 4);
  p.CDEC = (float*)take((size_t)128 * 18 * 32 * 4);
  p.FILTt = (bf16_t*)take((size_t)1024 * FLEN * 2);
  p.WRhi = (bf16_t*)take((size_t)96 * 1024 * 2);
  p.WRlo = (bf16_t*)take((size_t)96 * 1024 * 2);
  p.WinT = (bf16_t*)take((size_t)DP * D * 2);
  p.WoutT = (bf16_t*)take((size_t)D * D * 2);
  p.Wup = (bf16_t*)take((size_t)NE * 1024 * 1024 * 2);
  p.Wdn = (bf16_t*)take((size_t)NE * 1024 * 512 * 2);
  char* rPX = take((size_t)TT * DP * 2);
  char* rXBC = take((size_t)128 * 18 * 8192 * 2);
  char* rYF = take((size_t)T * DS * 4);
  char* rZ1 = take((size_t)HYC * T * 2);
  char* rYB = take((size_t)T * DS * 4);
  char* rYM = take((size_t)T * D * 2);
  p.PXb = (bf16_t*)rPX; p.SST = (bf16_t*)rXBC; p.Ut = (bf16_t*)rZ1; p.YMIXb = (bf16_t*)rYM;
  p.HIN = (bf16_t*)rYF;
  p.Yt = (bf16_t*)rYB;
  p.XNb = (bf16_t*)rZ1;
  p.X1 = (float*)rPX;
  p.H2b = (bf16_t*)rYM;
  p.HBb = (bf16_t*)(rPX + (size_t)T * D * 4);
  p.YB2b = (bf16_t*)rZ1;
  if (off > ws_size) { fprintf(stderr, "workspace too small: need %zu have %zu\n", off, ws_size); return; }

  static int grid_blocks = 0;
  if (!grid_blocks) {
    int dev = 0, cus = 0, per_cu = 0;
    (void)hipGetDevice(&dev);
    (void)hipDeviceGetAttribute(&cus, hipDeviceAttributeMultiprocessorCount, dev);
    (void)hipFuncSetAttribute((const void*)mega, hipFuncAttributeMaxDynamicSharedMemorySize, LDS_BYTES);
    (void)hipOccupancyMaxActiveBlocksPerMultiprocessor(&per_cu, mega, NTHR, LDS_BYTES);
    if (per_cu < 1) { fprintf(stderr, "occupancy query returned %d\n", per_cu); per_cu = 1; }
    grid_blocks = cus;
  }
#ifndef ONE_LAUNCH
  for (int ph = 0; ph < NPHASE; ++ph) {
    p.lo = ph; p.hi = ph + 1;
    hipLaunchKernelGGL(mega, dim3(grid_blocks), dim3(NTHR), LDS_BYTES, stream, p);
  }
#else
  p.lo = 0; p.hi = NPHASE;
  (void)hipMemsetAsync(p.BAR, 0, (size_t)XCD_BAR_WORDS * 4, stream);
  void* args[] = {&p};
  hipError_t e = hipLaunchCooperativeKernel((void*)mega, dim3(grid_blocks), dim3(NTHR), args, LDS_BYTES, stream);
  if (e != hipSuccess) fprintf(stderr, "cooperative launch failed: %s (grid %d)\n", hipGetErrorString(e), grid_blocks);
#endif
}
```

```cpp
#define ONE_LAUNCH 1
#include <hip/hip_runtime.h>
#include <hip/hip_cooperative_groups.h>
#include <cstdio>
#include <cstdint>
namespace cg = cooperative_groups;

constexpr int D = 1024, NB = 8, L = 2048, LC = 256;
constexpr int T = NB * L;
constexpr int TC = NB * LC;
constexpr int TT = T + TC;
constexpr int DH = 512, HYC = 1536, DS = 512, DXBC = 1024, DIN = 3088, DP = 3072;
constexpr int COL_Z = 1536, COL_XBC = 2048, COL_DT = 3072;
constexpr int NE = 64, DE = 512;
constexpr float EPS = 1e-6f;
constexpr int NTHR = 512;
constexpr int LDS_BYTES = 132 * 1024;
constexpr int FLEN = 4232, HX0 = 2112, FCLEN = 4240, ZSTRB = 4240;

typedef unsigned short bf16_t;

struct Params {
  const float *x, *c, *ctx, *c_ctx, *w_ada, *b_ada, *g1, *g2, *w_in, *hy_conv_w, *hy_conv_b;
  const float *f_w1, *f_b1, *f_freq, *f_w2, *f_b2, *f_w3, *hy_bias;
  const float *ssd_conv_w, *ssd_conv_b, *a_log, *dt_bias, *ssd_d, *ssd_norm_g, *w_out;
  const float *w_group, *b_group, *w_expert, *b_expert, *w1, *w3, *w2, *g_final;
  float* out;
  float *MOD, *DT, *X1, *GATE, *ACUM, *CDEC, *SSQP;
  bf16_t *WRhi, *WRlo, *FILTt, *Ut, *Yt, *HIN, *XNb, *WinT, *WoutT, *PXb, *SST, *YMIXb, *YB2b, *Wup, *Wdn, *H2b, *HBb;
  int *CNT, *LIST;
  unsigned* BAR;
  int lo, hi;
};

__device__ __forceinline__ float silu_f(float v) { return v / (1.f + __expf(-v)); }
__device__ __forceinline__ float softplus_f(float v) { return v > 20.f ? v : log1pf(expf(v)); }
__device__ __forceinline__ float bf2f(bf16_t v) { return __uint_as_float(((unsigned)v) << 16); }
__device__ __forceinline__ unsigned cvt_pk_bf16(float lo, float hi) {
  typedef __bf16 bf2_t __attribute__((ext_vector_type(2)));
  typedef float f2_t __attribute__((ext_vector_type(2)));
  const f2_t v = {lo, hi};
  const bf2_t r = __builtin_convertvector(v, bf2_t);
  return __builtin_bit_cast(unsigned, r);
}
__device__ __forceinline__ bf16_t f2bf(float f) { return (bf16_t)(cvt_pk_bf16(f, 0.f) & 0xffffu); }
__device__ __forceinline__ void st_agent64(void* p, unsigned lo, unsigned hi) {
  __hip_atomic_store((unsigned long long*)p, ((unsigned long long)hi << 32) | lo, __ATOMIC_RELAXED, __HIP_MEMORY_SCOPE_AGENT);
}
__device__ __forceinline__ uint2 ld_agent64(const void* p) {
  const unsigned long long v = __hip_atomic_load((const unsigned long long*)p, __ATOMIC_RELAXED, __HIP_MEMORY_SCOPE_AGENT);
  return make_uint2((unsigned)v, (unsigned)(v >> 32));
}
__device__ __forceinline__ void st_agent32(float* p, float v) { __hip_atomic_store(p, v, __ATOMIC_RELAXED, __HIP_MEMORY_SCOPE_AGENT); }
__device__ __forceinline__ float ld_agent32(const float* p) { return __hip_atomic_load(p, __ATOMIC_RELAXED, __HIP_MEMORY_SCOPE_AGENT); }
__device__ __forceinline__ float wave_sum(float v) {
#pragma unroll
  for (int o = 32; o > 0; o >>= 1) v += __shfl_xor(v, o);
  return v;
}


#define XB_TMO      128
#define XB_XCNT(j)  (256  + 64 * (j))
#define XB_XSUB(j)  (1280 + 64 * (j))
#define XB_XGEN(j)  (2304 + 64 * (j))
#define XB_TOP      3328
#define XB_TOPGEN   3392
#define XCD_BAR_WORDS 3456
#define XB_SPIN_CAP (1u << 18)
#define LAS __attribute__((address_space(3)))
__device__ __forceinline__ unsigned xb_ld(unsigned* p) { return __hip_atomic_load(p, __ATOMIC_RELAXED, __HIP_MEMORY_SCOPE_AGENT); }
__device__ __forceinline__ unsigned xb_add(unsigned* p, unsigned v) { return __hip_atomic_fetch_add(p, v, __ATOMIC_RELAXED, __HIP_MEMORY_SCOPE_AGENT); }
__device__ __forceinline__ unsigned xb_xcc_id() { return (unsigned)__builtin_amdgcn_s_getreg((3 << 11) | 20) & 0xFu; }
#define XB_SPIN(cond, bar) do { unsigned _sp = 0; while (cond) { __builtin_amdgcn_s_sleep(1); \
    if ((++_sp & 255u) == 0u) { if (xb_ld(&(bar)[XB_TMO])) break; if (_sp > XB_SPIN_CAP) { atomicAdd(&(bar)[XB_TMO], 1u); break; } } } } while (0)
struct XcdBarrier { unsigned* bar; unsigned x; volatile LAS unsigned* st; };
__device__ __forceinline__ XcdBarrier xcd_barrier_post(unsigned* bar, volatile LAS unsigned* st) {
  XcdBarrier b; b.bar = bar; b.x = xb_xcc_id(); b.st = st;
  if (threadIdx.x == 0) (void)xb_add(&bar[XB_XCNT(b.x)], 1u);
  return b;
}
__device__ __forceinline__ void xcd_barrier_complete(unsigned* bar, unsigned x, unsigned& nloc, unsigned& nx) {
  const unsigned G = gridDim.x * gridDim.y * gridDim.z;
  unsigned sum, cnt, mine, sp = 0u;
  for (;;) {
    sum = 0u; cnt = 0u; mine = 0u;
#pragma unroll
    for (unsigned j = 0; j < 16; ++j) { const unsigned c = xb_ld(&bar[XB_XCNT(j)]); sum += c; cnt += (c > 0u) ? 1u : 0u; mine = (j == x) ? c : mine; }
    if (sum == G) break;
    __builtin_amdgcn_s_sleep(1);
    if ((++sp & 255u) == 0u) { if (xb_ld(&bar[XB_TMO])) break; if (sp > XB_SPIN_CAP) { atomicAdd(&bar[XB_TMO], 1u); break; } }
  }
  nloc = mine > 0u ? mine : 1u; nx = cnt > 0u ? cnt : 1u;
}
__device__ __forceinline__ void xcd_barrier(const XcdBarrier& b) {
  asm volatile("s_waitcnt vmcnt(0)" ::: "memory");
  __syncthreads();
  if (threadIdx.x == 0) {
    unsigned* bar = b.bar;
    __builtin_amdgcn_s_waitcnt(0);
    unsigned nloc = b.st[0], nx = b.st[1];
    if (nloc == 0u) { xcd_barrier_complete(bar, b.x, nloc, nx); b.st[0] = nloc; b.st[1] = nx; }
    const unsigned old = xb_add(&bar[XB_XSUB(b.x)], 1u);
    const unsigned gen = old / nloc;
    if (old + 1u == (gen + 1u) * nloc) {
      __builtin_amdgcn_fence(__ATOMIC_RELEASE, "agent");
      asm volatile("s_waitcnt vmcnt(0)" ::: "memory");
      const unsigned og = xb_add(&bar[XB_TOP], 1u);
      const unsigned tg = og / nx;
      if (og + 1u == (tg + 1u) * nx) xb_add(&bar[XB_TOPGEN], 1u);
      else XB_SPIN(xb_ld(&bar[XB_TOPGEN]) == tg, bar);
      __builtin_amdgcn_fence(__ATOMIC_ACQUIRE, "agent");
      xb_add(&bar[XB_XGEN(b.x)], 1u);
      asm volatile("s_waitcnt vmcnt(0)" ::: "memory");
    } else {
      XB_SPIN(xb_ld(&bar[XB_XGEN(b.x)]) == gen, bar);
      __builtin_amdgcn_fence(__ATOMIC_ACQUIRE, "agent");
      asm volatile("s_waitcnt vmcnt(0)" ::: "memory");
    }
  }
  __syncthreads();
}

namespace pg8 {
#define PG8_LAS __attribute__((address_space(3)))
typedef short bf16x8 __attribute__((ext_vector_type(8)));
typedef float f32x4 __attribute__((ext_vector_type(4)));
typedef unsigned u32x4 __attribute__((ext_vector_type(4)));
typedef unsigned u32x2 __attribute__((ext_vector_type(2)));
constexpr int BM = 256, BK = 64, HALF = 128, HTB = HALF * BK * 2, STAGE_BYTES = 8 * HTB, NXCD = 8, WGM = 8;

__host__ __device__ __forceinline__ int lds_byte(int r, int c) {
  const int st = (r >> 4) * 2 + (c >> 5), rr = r & 15, cc = c & 31, ob = rr * 64 + cc * 2;
  return st * 1024 + (ob ^ (((ob >> 9) & 1) << 5));
}
__host__ __device__ __forceinline__ void stage_rc(int b, int& R, int& C) {
  const int st = b / 1024, sb = b % 1024, swz = sb ^ (((sb >> 9) & 1) << 5);
  R = (st >> 1) * 16 + swz / 64; C = (st & 1) * 32 + (swz % 64) / 2;
}
__host__ __device__ __forceinline__ int perm32(int rho) { const int n = rho >> 4, i = rho & 15; return 8 * (i >> 2) + 4 * n + (i & 3); }

struct Unit { int pm, pn, e, mu, nv, cnt, seg; };

__device__ __forceinline__ bool static_next(int nM, int nN, int G, int c, int i, int& pm, int& pn) {
  const int nwg = nM * nN;
  const long Lx = (long)i * G + c; if (Lx >= nwg) return false;
  int wgid = (int)Lx;
  { const int q = nwg / NXCD, r = nwg % NXCD, xcd = wgid % NXCD, off = wgid / NXCD; wgid = (xcd < r ? xcd * (q + 1) : r * (q + 1) + (xcd - r) * q) + off; }
  const int nig = WGM * nN, gid = wgid / nig, fm = gid * WGM, gsz = (nM - fm) < WGM ? (nM - fm) : WGM;
  pm = fm + ((wgid % nig) % gsz); pn = (wgid % nig) / gsz; return true;
}

struct DenseOrder {
  const bf16_t* A; const bf16_t* Bt; int nM, nN, K, G, c;
  __device__ __forceinline__ bool next(int i, Unit& u) const {
    if (!static_next(nM, nN, G, c, i, u.pm, u.pn)) return false;
    u.e = 0; u.mu = 0; u.nv = 256; u.cnt = 256; u.seg = 0; return true;
  }
  __device__ __forceinline__ const char* a_base() const { return (const char*)A; }
  __device__ __forceinline__ const char* b_ptr(const Unit& u) const { return (const char*)Bt + (size_t)u.pn * 256 * K * 2; }
  __device__ __forceinline__ void a_offs(const Unit& u, const int (&R)[2], const int (&C)[2], unsigned (&ao)[2][2]) const {
#pragma unroll
    for (int h = 0; h < 2; ++h)
#pragma unroll
      for (int i = 0; i < 2; ++i) ao[h][i] = (unsigned)((u.pm * 256 + h * 128 + R[i]) * K + C[i]) * 2u;
  }
};

struct MoeOrder {
  const int* tab; const bf16_t* A; const bf16_t* Bt; const int* list; int NTn, K, G, c; bool gather;
  __device__ __forceinline__ bool next(int i, Unit& u) const {
    const int Lx = i * G + c;
    if (Lx >= tab[64] * NTn) return false;
    const int mg = Lx / NTn; u.pn = Lx - mg * NTn;
    int e = 0;
    while (tab[e + 1] <= mg) ++e;
    u.e = e; u.mu = mg - tab[e]; u.cnt = tab[130 + e]; u.seg = tab[65 + e];
    const int rem = u.cnt - u.mu * 256; u.nv = rem < 256 ? rem : 256; u.pm = 0; return true;
  }
  __device__ __forceinline__ const char* a_base() const { return (const char*)A; }
  __device__ __forceinline__ const char* b_ptr(const Unit& u) const { return (const char*)Bt + ((size_t)u.e * NTn + u.pn) * 256 * K * 2; }
  __device__ __forceinline__ void a_offs(const Unit& u, const int (&R)[2], const int (&C)[2], unsigned (&ao)[2][2]) const {
#pragma unroll
    for (int h = 0; h < 2; ++h)
#pragma unroll
      for (int i = 0; i < 2; ++i) {
        int idx = u.mu * 256 + h * 128 + R[i];
        int row;
        if (gather) { if (idx > u.cnt - 1) idx = u.cnt - 1; row = list[u.e * T + idx] >> 1; }
        else row = u.seg + idx;
        ao[h][i] = (unsigned)(row * K + C[i]) * 2u;
      }
  }
};

struct EpiBf16 {
  static constexpr bool PERM = true;
  bf16_t* O; int ldc; float* DT; const float* dt_bias;
  __device__ __forceinline__ void operator()(const f32x4 (&acc)[2][2][4][2], const Unit& u, int wr, int wc, int fr, int fq) const {
    const int row0 = u.pm * BM + wr * 64 + fr;
    if (u.pn == 12) {
      if (wc == 0 && fq < 2) {
        const f32x4 b0 = *(const f32x4*)(dt_bias + 8 * fq), b1 = *(const f32x4*)(dt_bias + 8 * fq + 4);
#pragma unroll
        for (int ai = 0; ai < 2; ++ai)
#pragma unroll
          for (int m = 0; m < 4; ++m) {
            float* dp = DT + (size_t)(row0 + ai * HALF + m * 16) * 16 + 8 * fq;
            *(f32x4*)dp = acc[ai][0][m][0] + b0; *(f32x4*)(dp + 4) = acc[ai][0][m][1] + b1;
          }
      }
      return;
    }
    const int col0 = u.pn * BM + wc * 32 + 8 * fq;
#pragma unroll
    for (int ai = 0; ai < 2; ++ai)
#pragma unroll
      for (int m = 0; m < 4; ++m) {
        bf16_t* rowp = O + (size_t)(row0 + ai * HALF + m * 16) * ldc + col0;
#pragma unroll
        for (int bj = 0; bj < 2; ++bj) {
          f32x4 v0 = acc[ai][bj][m][0], v1 = acc[ai][bj][m][1];
          u32x4 w; w.x = cvt_pk_bf16(v0[0], v0[1]); w.y = cvt_pk_bf16(v0[2], v0[3]); w.z = cvt_pk_bf16(v1[0], v1[1]); w.w = cvt_pk_bf16(v1[2], v1[3]);
          *(u32x4*)(rowp + bj * HALF) = w;
        }
      }
  }
};

struct EpiX1 {
  static constexpr bool PERM = false;
  const float* x; const float* mod; float* X1; float* SSQP;
  __device__ __forceinline__ void operator()(const f32x4 (&acc)[2][2][4][2], const Unit& u, int wr, int wc, int fr, int fq) const {
    const int row0 = u.pm * BM + wr * 64 + fr, col0 = u.pn * BM + wc * 32 + 4 * fq;
    const float* ga = mod + ((u.pm * BM) / L) * 6144 + 2048 + col0;
    f32x4 gv[2][2];
#pragma unroll
    for (int bj = 0; bj < 2; ++bj)
#pragma unroll
      for (int n = 0; n < 2; ++n) gv[bj][n] = *(const f32x4*)(ga + bj * HALF + n * 16);
#pragma unroll
    for (int ai = 0; ai < 2; ++ai)
#pragma unroll
      for (int m = 0; m < 4; ++m) {
        const size_t off = (size_t)(row0 + ai * HALF + m * 16) * D + col0;
        float ssq = 0.f;
#pragma unroll
        for (int bj = 0; bj < 2; ++bj)
#pragma unroll
          for (int n = 0; n < 2; ++n) {
            const f32x4 xv = *(const f32x4*)(x + off + bj * HALF + n * 16);
            const f32x4 o = xv + gv[bj][n] * acc[ai][bj][m][n];
            *(f32x4*)(X1 + off + bj * HALF + n * 16) = o;
            ssq += (o[0] * o[0] + o[1] * o[1]) + (o[2] * o[2] + o[3] * o[3]);
          }
        ssq += __shfl_xor(ssq, 16); ssq += __shfl_xor(ssq, 32);
        if (fq == 0) SSQP[(size_t)(row0 + ai * HALF + m * 16) * 16 + u.pn * 4 + wc] = ssq;
      }
  }
};

struct EpiSwiGLU {
  static constexpr bool PERM = true;
  bf16_t* HBb;
  __device__ __forceinline__ void operator()(const f32x4 (&acc)[2][2][4][2], const Unit& u, int wr, int wc, int fr, int fq) const {
    const int col0 = u.pn * 128 + wc * 32 + 8 * fq;
#pragma unroll
    for (int ai = 0; ai < 2; ++ai)
#pragma unroll
      for (int m = 0; m < 4; ++m) {
        const int slot = u.mu * 256 + ai * HALF + wr * 64 + m * 16 + fr;
        if (slot < u.cnt) {
          float h[8];
#pragma unroll
          for (int n = 0; n < 2; ++n)
#pragma unroll
            for (int j = 0; j < 4; ++j) { const float a = acc[ai][0][m][n][j]; h[n * 4 + j] = a / (1.f + __expf(-a)) * acc[ai][1][m][n][j]; }
          u32x4 w; w.x = cvt_pk_bf16(h[0], h[1]); w.y = cvt_pk_bf16(h[2], h[3]); w.z = cvt_pk_bf16(h[4], h[5]); w.w = cvt_pk_bf16(h[6], h[7]);
          *(u32x4*)(HBb + (size_t)(u.seg + slot) * DE + col0) = w;
        }
      }
  }
};

struct EpiDown {
  static constexpr bool PERM = true;
  bf16_t* YB2b; const int* list; const float* gate;
  __device__ __forceinline__ void operator()(const f32x4 (&acc)[2][2][4][2], const Unit& u, int wr, int wc, int fr, int fq) const {
    const int col0 = u.pn * 256 + wc * 32 + 8 * fq;
#pragma unroll
    for (int ai = 0; ai < 2; ++ai)
#pragma unroll
      for (int m = 0; m < 4; ++m) {
        const int slot = u.mu * 256 + ai * HALF + wr * 64 + m * 16 + fr;
        if (slot < u.cnt) {
          const int pair = list[u.e * T + slot];
          const float gt = gate[pair];
          bf16_t* rowp = YB2b + (size_t)pair * D + col0;
#pragma unroll
          for (int bj = 0; bj < 2; ++bj) {
            f32x4 v0 = acc[ai][bj][m][0] * gt, v1 = acc[ai][bj][m][1] * gt;
            u32x4 w; w.x = cvt_pk_bf16(v0[0], v0[1]); w.y = cvt_pk_bf16(v0[2], v0[3]); w.z = cvt_pk_bf16(v1[0], v1[1]); w.w = cvt_pk_bf16(v1[2], v1[3]);
            *(u32x4*)(rowp + bj * HALF) = w;
          }
        }
      }
  }
};

template <class Epi, class Sched>
__device__ __forceinline__ void gemm_phase(PG8_LAS unsigned char* lds, const int K, const Sched& S, const Epi& E) {
  const int tid = threadIdx.x, wid = __builtin_amdgcn_readfirstlane(tid >> 6), lane = tid & 63, wr = wid >> 2, wc = wid & 3, fr = lane & 15, fq = lane >> 4;
  const int nt = K / BK;
  int Rr[2], Cc[2];
  unsigned voffB[2];
#pragma unroll
  for (int i = 0; i < 2; ++i) {
    stage_rc(tid * 16 + i * 8192, Rr[i], Cc[i]);
    const int Rb = Epi::PERM ? ((Rr[i] & ~31) + perm32(Rr[i] & 31)) : Rr[i];
    voffB[i] = (unsigned)(Rb * K + Cc[i]) * 2u;
  }
  const size_t kstep = (size_t)(BK * 2);
  const size_t hstep = (size_t)HALF * K * 2;
  const unsigned ldsw = (unsigned)wid * 1024u;
  const int aoff = lds_byte(wr * 64 + fr, fq * 8), boff = lds_byte(wc * 32 + fr, fq * 8);
#define PG8_SA(b, h) (((b) * 2 + (h)) * HTB)
#define PG8_SB(b, h) ((4 + (b) * 2 + (h)) * HTB)
#define PG8_STAGE(bufoff, gbase, voff) do { _Pragma("unroll") for (int _i = 0; _i < 2; ++_i) \
    __builtin_amdgcn_global_load_lds((const unsigned*)((const char*)(gbase) + (voff)[_i]), (PG8_LAS unsigned*)(lds + (bufoff) + ldsw + _i * 8192), 16, 0, 0); } while (0)
#define PG8_LDA(dst, b, h) do { _Pragma("unroll") for (int m = 0; m < 4; ++m) _Pragma("unroll") for (int k = 0; k < 2; ++k) dst[m][k] = *(const PG8_LAS bf16x8*)(lds + PG8_SA(b, h) + aoff + m * 2048 + k * 1024); } while (0)
#define PG8_LDB(dst, b, h) do { _Pragma("unroll") for (int n = 0; n < 2; ++n) _Pragma("unroll") for (int k = 0; k < 2; ++k) dst[n][k] = *(const PG8_LAS bf16x8*)(lds + PG8_SB(b, h) + boff + n * 2048 + k * 1024); } while (0)
#define PG8_MMA(ai, bj, At, Bt) do { __builtin_amdgcn_s_setprio(1); _Pragma("unroll") for (int m = 0; m < 4; ++m) _Pragma("unroll") for (int n = 0; n < 2; ++n) _Pragma("unroll") for (int k = 0; k < 2; ++k) \
    acc[ai][bj][m][n] = __builtin_amdgcn_mfma_f32_16x16x32_bf16(Bt[n][k], At[m][k], acc[ai][bj][m][n], 0, 0, 0); __builtin_amdgcn_s_setprio(0); } while (0)
#define PG8_WAIT_V(n) asm volatile("s_waitcnt vmcnt(" #n ")" ::: "memory")
#define PG8_WAIT_L(n) asm volatile("s_waitcnt lgkmcnt(" #n ")" ::: "memory")
#define PG8_BAR __builtin_amdgcn_s_barrier()
#define PG8_SCHED __builtin_amdgcn_sched_barrier(0)
  Unit cur, nxt; int ui = 0;
  if (!S.next(0, cur)) return;
  f32x4 acc[2][2][4][2];
#pragma unroll
  for (int a = 0; a < 2; ++a)
#pragma unroll
    for (int b = 0; b < 2; ++b)
#pragma unroll
      for (int m = 0; m < 4; ++m)
#pragma unroll
        for (int n = 0; n < 2; ++n) acc[a][b][m][n] = (f32x4){0.f, 0.f, 0.f, 0.f};
  bf16x8 At[4][2], B0[2][2], B1[2][2];
  unsigned cao[2][2], nao[2][2];
  S.a_offs(cur, Rr, Cc, cao);
  const char* const aB = S.a_base();
  const char* cB = S.b_ptr(cur);
  PG8_STAGE(PG8_SB(0, 0), cB, voffB); PG8_STAGE(PG8_SA(0, 0), aB, cao[0]); PG8_STAGE(PG8_SB(0, 1), cB + hstep, voffB); PG8_STAGE(PG8_SA(0, 1), aB, cao[1]);
  if (wr == 1) PG8_BAR;
  PG8_WAIT_V(4); PG8_BAR;
  PG8_STAGE(PG8_SB(1, 0), cB + kstep, voffB); PG8_STAGE(PG8_SA(1, 0), aB + kstep, cao[0]); PG8_STAGE(PG8_SB(1, 1), cB + hstep + kstep, voffB);
  PG8_WAIT_V(6); PG8_BAR;
  for (;;) {
    const bool has_next = S.next(ui + 1, nxt);
    const char* nB = cB;
    if (has_next) { S.a_offs(nxt, Rr, Cc, nao); nB = S.b_ptr(nxt); }
    else {
#pragma unroll
      for (int h = 0; h < 2; ++h)
#pragma unroll
        for (int i = 0; i < 2; ++i) nao[h][i] = cao[h][i];
    }
    const bool full = cur.nv > 128;
    for (int t = 0; t < nt; t += 2) {
      const bool last = (t == nt - 2);
      const char* a1 = aB + (size_t)(t + 1) * kstep;
      const char* a2 = last ? aB : aB + (size_t)(t + 2) * kstep; const char* b2 = last ? nB : cB + (size_t)(t + 2) * kstep;
      const char* a3 = a2 + kstep; const char* b3 = b2 + kstep;
      unsigned so[2][2];
#pragma unroll
      for (int h = 0; h < 2; ++h)
#pragma unroll
        for (int i = 0; i < 2; ++i) so[h][i] = last ? nao[h][i] : cao[h][i];
      PG8_LDB(B0, 0, 0); PG8_SCHED; PG8_LDA(At, 0, 0); PG8_STAGE(PG8_SA(1, 1), a1, cao[1]);
      PG8_WAIT_L(8); PG8_BAR; PG8_WAIT_L(0); PG8_MMA(0, 0, At, B0); PG8_BAR; PG8_SCHED;
      PG8_LDB(B1, 0, 1); PG8_STAGE(PG8_SB(0, 0), b2, voffB);
      PG8_BAR; PG8_WAIT_L(0); PG8_MMA(0, 1, At, B1); PG8_BAR;
      PG8_LDA(At, 0, 1); PG8_STAGE(PG8_SA(0, 0), a2, so[0]);
      PG8_BAR; PG8_WAIT_L(0); if (full) PG8_MMA(1, 0, At, B0); PG8_BAR; PG8_SCHED;
      PG8_STAGE(PG8_SB(0, 1), b2 + hstep, voffB);
      PG8_WAIT_V(6); PG8_BAR; if (full) PG8_MMA(1, 1, At, B1); PG8_BAR;
      PG8_LDB(B0, 1, 0); PG8_SCHED; PG8_LDA(At, 1, 0); PG8_STAGE(PG8_SA(0, 1), a2, so[1]);
      PG8_WAIT_L(8); PG8_BAR; PG8_WAIT_L(0); PG8_MMA(0, 0, At, B0); PG8_BAR; PG8_SCHED;
      PG8_LDB(B1, 1, 1); PG8_STAGE(PG8_SB(1, 0), b3, voffB);
      PG8_BAR; PG8_WAIT_L(0); PG8_MMA(0, 1, At, B1); PG8_BAR;
      PG8_LDA(At, 1, 1); PG8_STAGE(PG8_SA(1, 0), a3, so[0]);
      PG8_BAR; PG8_WAIT_L(0); if (full) PG8_MMA(1, 0, At, B0); PG8_BAR; PG8_SCHED;
      PG8_STAGE(PG8_SB(1, 1), b3 + hstep, voffB);
      PG8_WAIT_V(6); PG8_BAR; if (full) PG8_MMA(1, 1, At, B1); PG8_BAR;
    }
    E(acc, cur, wr, wc, fr, fq);
    if (!has_next) break;
#pragma unroll
    for (int a = 0; a < 2; ++a)
#pragma unroll
      for (int b = 0; b < 2; ++b)
#pragma unroll
        for (int m = 0; m < 4; ++m)
#pragma unroll
          for (int n = 0; n < 2; ++n) acc[a][b][m][n] = (f32x4){0.f, 0.f, 0.f, 0.f};
    cur = nxt; cB = nB; ++ui;
#pragma unroll
    for (int h = 0; h < 2; ++h)
#pragma unroll
      for (int i = 0; i < 2; ++i) cao[h][i] = nao[h][i];
  }
  PG8_WAIT_V(0);
  if (wr == 0) PG8_BAR;
  PG8_BAR;
#undef PG8_SA
#undef PG8_SB
#undef PG8_STAGE
#undef PG8_LDA
#undef PG8_LDB
#undef PG8_MMA
#undef PG8_WAIT_V
#undef PG8_WAIT_L
#undef PG8_BAR
#undef PG8_SCHED
}
}

__device__ void ph_adaln(const Params& p, float* sm) {
  const int tid = threadIdx.x;
  if (blockIdx.x == 0 && tid < NE) p.CNT[tid] = 0;
  for (int e = blockIdx.x * NTHR + tid; e < 96 * 1024; e += gridDim.x * NTHR) {
    const int j = e >> 10, k = e & 1023;
    float w = 0.f;
    if (j < 64) w = p.w_expert[k * 64 + j]; else if (j < 72) w = p.w_group[k * 8 + (j - 64)];
    const unsigned hi = cvt_pk_bf16(w, 0.f) & 0xffffu;
    const float rem = w - __uint_as_float(hi << 16);
    p.WRhi[e] = (bf16_t)hi; p.WRlo[e] = (bf16_t)(cvt_pk_bf16(rem, 0.f) & 0xffffu);
  }
  float* sc = sm;
  float* red = sm + 9 * 1024;
  for (int e = tid; e < 9 * 1024; e += NTHR) {
    const int r = e >> 10, k = e & 1023;
    sc[e] = silu_f(r < 8 ? p.c[r * D + k] : p.c_ctx[k]);
  }
  __syncthreads();
  for (int item = blockIdx.x; item < 192; item += gridDim.x) {
    const int col0 = item * 32;
    const int kq = tid >> 3, c4 = (tid & 7) * 4;
    float acc[9][4];
#pragma unroll
    for (int r = 0; r < 9; ++r)
#pragma unroll
      for (int j = 0; j < 4; ++j) acc[r][j] = 0.f;
#pragma unroll 4
    for (int i = 0; i < 16; ++i) {
      const int k = kq + i * 64;
      const float4 w = *(const float4*)(p.w_ada + (size_t)k * 6144 + col0 + c4);
#pragma unroll
      for (int r = 0; r < 9; ++r) {
        const float sv = sc[r * 1024 + k];
        acc[r][0] += sv * w.x; acc[r][1] += sv * w.y; acc[r][2] += sv * w.z; acc[r][3] += sv * w.w;
      }
    }
#pragma unroll
    for (int r = 0; r < 9; ++r)
#pragma unroll
      for (int j = 0; j < 4; ++j) red[kq * 292 + r * 32 + c4 + j] = acc[r][j];
    __syncthreads();
    if (tid < 288) {
      float a = 0.f;
      for (int q = 0; q < 64; ++q) a += red[q * 292 + tid];
      const int r = tid >> 5, j = tid & 31;
      p.MOD[r * 6144 + col0 + j] = a + p.b_ada[col0 + j];
    }
    __syncthreads();
  }
}

__device__ void ph_filters(const Params& p, float* sm) {
  const int tid = threadIdx.x, wid = tid >> 6, lane = tid & 63;
  float* feats = sm;
  float* h1 = sm + 64 * 20;
  float* h2 = h1 + 64 * 64;
  bf16_t* tile = (bf16_t*)(h2 + 64 * 64);
  for (int e = blockIdx.x * NTHR + tid; e < 1024 * 137; e += gridDim.x * NTHR) {
    int rowi = e / 137, k = e - rowi * 137;
    int x = (k < 65) ? k : (4160 + (k - 65));
    p.FILTt[(size_t)rowi * FLEN + x] = 0;
  }
  for (int item = blockIdx.x; item < 256; item += gridDim.x) {
    const int tt = item >> 3, ct = item & 7;
    for (int e = tid; e < 64 * 17; e += NTHR) {
      int tp = e / 17, i = e - tp * 17;
      int t = tt * 64 + tp;
      float f;
      if (i == 0) f = (float)t / (float)(L - 1);
      else {
        int bi = (i - 1) & 7;
        float bandf = (float)(1e-4 + (double)bi * ((7.0 - 1e-4) / 7.0));
        float ang = (float)(2.0 * 3.14159265358979323846 / (double)L) * (float)t * bandf;
        f = (i <= 8) ? cosf(ang) : -sinf(ang);
      }
      feats[tp * 20 + i] = f;
    }
    __syncthreads();
    for (int e = tid; e < 4096; e += NTHR) {
      int tp = e >> 6, j = e & 63;
      float a = p.f_b1[j];
      for (int i = 0; i < 17; ++i) a += feats[tp * 20 + i] * p.f_w1[i * 64 + j];
      h1[e] = sinf(p.f_freq[j] * a);
    }
    __syncthreads();
    for (int e = tid; e < 4096; e += NTHR) {
      int tp = e >> 6, j = e & 63;
      float a = p.f_b2[j];
      for (int i = 0; i < 64; ++i) a += h1[tp * 64 + i] * p.f_w2[i * 64 + j];
      h2[e] = sinf(p.f_freq[j] * a);
    }
    __syncthreads();
    {
      const int col = tid & 255, half = tid >> 8;
      const int gcol = ct * 256 + col;
      float acc[32];
#pragma unroll
      for (int k = 0; k < 32; ++k) acc[k] = 0.f;
      for (int i = 0; i < 64; ++i) {
        float w = p.f_w3[i * 2048 + gcol];
#pragma unroll
        for (int k = 0; k < 32; ++k) acc[k] += h2[(half * 32 + k) * 64 + i] * w;
      }
      const int cch = gcol & 511;
      const float d0 = -4.605170185988091f / 1.5f, d1 = -4.605170185988091f / 0.3f;
      const float delta = fabsf(d0 + (float)cch * ((d1 - d0) / 511.f));
#pragma unroll
      for (int k = 0; k < 32; ++k) {
        int t = tt * 64 + half * 32 + k;
        float tn = (float)t / (float)(L - 1);
        tile[col * 66 + half * 32 + k] = f2bf(acc[k] * expf(-tn * delta));
      }
    }
    __syncthreads();
    for (int cl = wid * 32; cl < wid * 32 + 32; ++cl) {
      const int gcol = ct * 256 + cl;
      const int o = gcol >> 10, dir = (gcol >> 9) & 1, cch = gcol & 511;
      const int t = tt * 64 + lane;
      const int x = dir ? (HX0 + t) : (HX0 - t);
      if (!(dir && t == 0)) p.FILTt[(size_t)(o * 512 + cch) * FLEN + x] = tile[cl * 66 + lane];
    }
    __syncthreads();
  }
}

__device__ __forceinline__ void cvt_tile256(const float* src, int ld, int k0, int n0, bf16_t* dst, int ldd, int dmap0, int dmap1, int nsplit, float* sm) {
  const int tid = threadIdx.x;
  float* ts = sm;
  float4 v[8];
#pragma unroll
  for (int i = 0; i < 8; ++i) {
    const int e = tid + i * NTHR; const int k = e >> 6, n4 = (e & 63) * 4;
    v[i] = *(const float4*)(src + (size_t)(k0 + k) * ld + n0 + n4);
  }
#pragma unroll
  for (int i = 0; i < 8; ++i) {
    const int e = tid + i * NTHR; const int k = e >> 6, n4 = (e & 63) * 4;
    ts[k * 257 + n4 + 0] = v[i].x; ts[k * 257 + n4 + 1] = v[i].y; ts[k * 257 + n4 + 2] = v[i].z; ts[k * 257 + n4 + 3] = v[i].w;
  }
  __syncthreads();
#pragma unroll
  for (int i = 0; i < 4; ++i) {
    const int e = tid + i * NTHR; const int n = e >> 3, kq = (e & 7) * 8;
    uint4 w;
    w.x = cvt_pk_bf16(ts[(kq + 0) * 257 + n], ts[(kq + 1) * 257 + n]);
    w.y = cvt_pk_bf16(ts[(kq + 2) * 257 + n], ts[(kq + 3) * 257 + n]);
    w.z = cvt_pk_bf16(ts[(kq + 4) * 257 + n], ts[(kq + 5) * 257 + n]);
    w.w = cvt_pk_bf16(ts[(kq + 6) * 257 + n], ts[(kq + 7) * 257 + n]);
    const int drow = (n < nsplit) ? (dmap0 + n) : (dmap1 + (n - nsplit));
    *(uint4*)(dst + (size_t)drow * ldd + k0 + kq) = w;
  }
  __syncthreads();
}

__device__ void ph_wcvt(const Params& p, float* sm) {
  for (int e = blockIdx.x * NTHR + threadIdx.x; e < 16 * 1024; e += gridDim.x * NTHR) {
    const int j = e >> 10, k = e & 1023;
    p.WinT[(size_t)(DP + j) * D + k] = f2bf(p.w_in[(size_t)k * DIN + COL_DT + j]);
  }
  for (int it = blockIdx.x; it < 192 + 64 + 64 * 96; it += gridDim.x) {
    if (it < 192) { const int kt = it / 12, nt = it - kt * 12; cvt_tile256(p.w_in, DIN, kt * 64, nt * 256, p.WinT, D, nt * 256, 0, 256, sm); }
    else if (it < 256) { const int i = it - 192; const int kt = i >> 2, nt = i & 3; cvt_tile256(p.w_out, D, kt * 64, nt * 256, p.WoutT, D, nt * 256, 0, 256, sm); }
    else {
      const int i = it - 256; const int e = i / 96, r = i - e * 96;
      if (r < 64) {
        const int which = r >> 5, r2 = r & 31; const int kt = r2 >> 1, nt = r2 & 1;
        const float* src = (which ? p.w3 : p.w1) + (size_t)e * D * DE;
        const int c0 = nt * 256;
        cvt_tile256(src, DE, kt * 64, c0, p.Wup + (size_t)e * 1024 * 1024, D, (c0 >> 7) * 256 + which * 128, ((c0 >> 7) + 1) * 256 + which * 128, 128, sm);
      } else {
        const int r2 = r - 64; const int kt = r2 >> 2, nt = r2 & 3;
        cvt_tile256(p.w2 + (size_t)e * DE * D, D, kt * 64, nt * 256, p.Wdn + (size_t)e * 1024 * 512, DE, nt * 256, 0, 256, sm);
      }
    }
  }
}

__device__ void ph_norm1(const Params& p) {
  const int tid = threadIdx.x, wid = tid >> 6, lane = tid & 63;
  for (int row = blockIdx.x * 8 + wid; row < TT; row += gridDim.x * 8) {
    const float* src = (row < T) ? (p.x + (size_t)row * D) : (p.ctx + (size_t)(row - T) * D);
    const int mr = (row < T) ? (row / L) : 8;
    const float* sh = p.MOD + mr * 6144;
    const float* sc = sh + 1024;
    float4 v[4];
    float ss = 0.f;
#pragma unroll
    for (int i = 0; i < 4; ++i) {
      v[i] = *(const float4*)(src + i * 256 + lane * 4);
      ss += v[i].x * v[i].x + v[i].y * v[i].y + v[i].z * v[i].z + v[i].w * v[i].w;
    }
    ss = wave_sum(ss);
    const float rstd = rsqrtf(ss * (1.f / D) + EPS);
#pragma unroll
    for (int i = 0; i < 4; ++i) {
      const int col = i * 256 + lane * 4;
      float4 g = *(const float4*)(p.g1 + col);
      float4 s4 = *(const float4*)(sc + col);
      float4 h4 = *(const float4*)(sh + col);
      float4 o;
      o.x = v[i].x * rstd * g.x * (1.f + s4.x) + h4.x;
      o.y = v[i].y * rstd * g.y * (1.f + s4.y) + h4.y;
      o.z = v[i].z * rstd * g.z * (1.f + s4.z) + h4.z;
      o.w = v[i].w * rstd * g.w * (1.f + s4.w) + h4.w;
      uint2 w; w.x = cvt_pk_bf16(o.x, o.y); w.y = cvt_pk_bf16(o.z, o.w);
      *(uint2*)(p.XNb + (size_t)row * D + col) = w;
    }
  }
}

__device__ void ph_hy_convT(const Params& p, float* sm) {
  const int tid = threadIdx.x;
  float* tile = sm;
  for (int item = blockIdx.x; item < 256 * 24; item += gridDim.x) {
    const int gr = item / 24, ct = item - gr * 24;
    const int row0 = gr * 64;
    {
      const int t = tid >> 3, c8 = (tid & 7) * 8;
      uint4 v = *(const uint4*)(p.PXb + (size_t)(row0 + t) * DP + ct * 64 + c8);
      unsigned w[4] = {v.x, v.y, v.z, v.w};
#pragma unroll
      for (int k = 0; k < 4; ++k) {
        tile[t * 65 + c8 + 2 * k] = __uint_as_float(w[k] << 16);
        tile[t * 65 + c8 + 2 * k + 1] = __uint_as_float(w[k] & 0xffff0000u);
      }
    }
    __syncthreads();
    {
      const int cc = tid >> 3, t8 = (tid & 7) * 8;
      const int col = ct * 64 + cc;
      const float w0 = p.hy_conv_w[col], w1 = p.hy_conv_w[HYC + col], w2 = p.hy_conv_w[2 * HYC + col], bb = p.hy_conv_b[col];
      float o[8];
#pragma unroll
      for (int k = 0; k < 8; ++k) {
        const int t = t8 + k;
        float v = bb + w1 * tile[t * 65 + cc];
        if (t > 0) v += w0 * tile[(t - 1) * 65 + cc];
        if (t < 63) v += w2 * tile[(t + 1) * 65 + cc];
        o[k] = v;
      }
      uint4 w; w.x = cvt_pk_bf16(o[0], o[1]); w.y = cvt_pk_bf16(o[2], o[3]); w.z = cvt_pk_bf16(o[4], o[5]); w.w = cvt_pk_bf16(o[6], o[7]);
      *(uint4*)(p.Ut + (size_t)col * T + row0 + t8) = w;
    }
    __syncthreads();
  }
}

__device__ void ph_hy_backT(const Params& p, float* sm) {
  const int tid = threadIdx.x;
  bf16_t* tile = (bf16_t*)sm;
  for (int item = blockIdx.x; item < 256 * 8; item += gridDim.x) {
    const int gr = item >> 3, ct = item & 7;
    const int row0 = gr * 64;
    {
      const int cc = tid >> 3, r8 = (tid & 7) * 8;
      uint4 v = *(const uint4*)(p.Yt + (size_t)(ct * 64 + cc) * T + row0 + r8);
      unsigned w[4] = {v.x, v.y, v.z, v.w};
#pragma unroll
      for (int k = 0; k < 4; ++k) {
        tile[cc * 66 + r8 + 2 * k] = (bf16_t)(w[k] & 0xffffu);
        tile[cc * 66 + r8 + 2 * k + 1] = (bf16_t)(w[k] >> 16);
      }
    }
    __syncthreads();
    {
      const int r = tid >> 3, c8 = (tid & 7) * 8;
      unsigned w[4];
#pragma unroll
      for (int k = 0; k < 4; ++k) w[k] = (unsigned)tile[(c8 + 2 * k) * 66 + r] | ((unsigned)tile[(c8 + 2 * k + 1) * 66 + r] << 16);
      uint4 o; o.x = w[0]; o.y = w[1]; o.z = w[2]; o.w = w[3];
      *(uint4*)(p.YMIXb + (size_t)(row0 + r) * D + ct * 64 + c8) = o;
    }
    __syncthreads();
  }
}

typedef short hbf16x8 __attribute__((ext_vector_type(8)));
typedef float hf32x4 __attribute__((ext_vector_type(4)));

constexpr int HY_FC = 0, HY_ZT0 = 4 * FCLEN * 2, HY_ZT1 = HY_ZT0 + 8 * ZSTRB;

__device__ __forceinline__ void hy_build_filter(const Params& p, int o, int c, unsigned char* lds) {
  const int tid = threadIdx.x;
  const bf16_t* gsrc = p.FILTt + (size_t)(o * 512 + c) * FLEN;
  for (int e = tid; e < 530; e += NTHR) {
    uint4 v = make_uint4(0u, 0u, 0u, 0u);
    if (e < 529) v = *(const uint4*)(gsrc + e * 8);
    *(uint4*)(lds + HY_FC + e * 16) = v;
  }
  __syncthreads();
  for (int g = tid; g < 3 * 530; g += NTHR) {
    const int r = 1 + g / 530, ch = g % 530;
    uint4 lo = make_uint4(0u, 0u, 0u, 0u);
    if (ch > 0) lo = *(const uint4*)(lds + HY_FC + (ch - 1) * 16);
    uint4 hi = *(const uint4*)(lds + HY_FC + ch * 16);
    unsigned W[8] = {lo.x, lo.y, lo.z, lo.w, hi.x, hi.y, hi.z, hi.w};
    uint4 ov;
    if (r == 1) {
      ov.x = __builtin_amdgcn_alignbyte(W[4], W[3], 2); ov.y = __builtin_amdgcn_alignbyte(W[5], W[4], 2);
      ov.z = __builtin_amdgcn_alignbyte(W[6], W[5], 2); ov.w = __builtin_amdgcn_alignbyte(W[7], W[6], 2);
    } else if (r == 2) {
      ov.x = W[3]; ov.y = W[4]; ov.z = W[5]; ov.w = W[6];
    } else {
      ov.x = __builtin_amdgcn_alignbyte(W[3], W[2], 2); ov.y = __builtin_amdgcn_alignbyte(W[4], W[3], 2);
      ov.z = __builtin_amdgcn_alignbyte(W[5], W[4], 2); ov.w = __builtin_amdgcn_alignbyte(W[6], W[5], 2);
    }
    *(uint4*)(lds + HY_FC + r * (FCLEN * 2) + ch * 16) = ov;
  }
  __syncthreads();
}

__device__ __forceinline__ void hy_order(const Params& p, int o, int c, unsigned char* lds) {
  const int tid = threadIdx.x, wid = __builtin_amdgcn_readfirstlane(tid >> 6), lane = tid & 63;
  const int g0 = wid * 4;
  const int n16 = lane & 15, h = lane >> 4, bb = n16 & 7, pp = n16 >> 3;
  const unsigned char* Zin = lds + (o ? HY_ZT1 : HY_ZT0);
  const bf16_t* gate = p.Ut + (size_t)((o + 1) * 512 + c) * T + bb * L;
  uint2 xg[4][2];
#pragma unroll
  for (int i = 0; i < 4; ++i)
#pragma unroll
    for (int u = 0; u < 2; ++u) xg[i][u] = *(const uint2*)(gate + 32 * (2 * (g0 + i) + pp) + 16 * u + 4 * h);
  const float bias = p.hy_bias[o * 512 + c];
  hf32x4 acc[4][2];
#pragma unroll
  for (int i = 0; i < 4; ++i)
#pragma unroll
    for (int u = 0; u < 2; ++u) acc[i][u] = (hf32x4){0.f, 0.f, 0.f, 0.f};
  const int ai = lane & 15, ar = ai & 3, aq = ai >> 2;
  const unsigned char* laneA = lds + HY_FC + ar * (FCLEN * 2) + 2 * (HX0 - 4 * aq + 8 * h);
  const unsigned char* laneB = Zin + bb * ZSTRB + 64 + 64 * pp + 16 * h;
#define HY_LDA(dst, Dd) do { const uint2 _lo = *(const uint2*)(laneA - 32 * (Dd)); const uint2 _hi = *(const uint2*)(laneA - 32 * (Dd) + 8); \
    union { uint4 u4; hbf16x8 v; } _cv; _cv.u4 = make_uint4(_lo.x, _lo.y, _hi.x, _hi.y); dst = _cv.v; } while (0)
#define HY_LDB(dst, Qq) do { dst = *(const hbf16x8*)(laneB + 64 * (Qq)); } while (0)
#pragma unroll 1
  for (int pass = 0; pass < 2; ++pass) {
    const int Es = 2 * g0 - 63 + pass;
    hbf16x8 R[4];
    HY_LDB(R[1], 2 * (g0 + 1) - Es); HY_LDB(R[2], 2 * (g0 + 2) - Es); HY_LDB(R[3], 2 * (g0 + 3) - Es);
#pragma unroll 1
    for (int n4 = 0; n4 < 9; ++n4) {
#pragma unroll
      for (int j = 0; j < 4; ++j) {
        const int n = n4 * 4 + j;
        const int E = Es + 2 * n;
        HY_LDB(R[(4 - j) & 3], 2 * (g0 - n) - Es);
        hbf16x8 A0, A1;
        HY_LDA(A0, 2 * E); HY_LDA(A1, 2 * E + 1);
#pragma unroll
        for (int i = 0; i < 4; ++i) {
          const int Q = 2 * (g0 + i - n) - Es;
          if (Q >= -1 && Q <= 63) {
            acc[i][0] = __builtin_amdgcn_mfma_f32_16x16x32_bf16(A0, R[(i - j) & 3], acc[i][0], 0, 0, 0);
            acc[i][1] = __builtin_amdgcn_mfma_f32_16x16x32_bf16(A1, R[(i - j) & 3], acc[i][1], 0, 0, 0);
          }
        }
      }
    }
  }
#undef HY_LDA
#undef HY_LDB
#pragma unroll
  for (int i = 0; i < 4; ++i)
#pragma unroll
    for (int u = 0; u < 2; ++u) {
      const int t0 = 32 * (2 * (g0 + i) + pp) + 16 * u + 4 * h;
      const uint2 zv = *(const uint2*)(Zin + bb * ZSTRB + 64 + 2 * t0);
      const float z0 = __uint_as_float(zv.x << 16), z1 = __uint_as_float(zv.x & 0xffff0000u), z2 = __uint_as_float(zv.y << 16), z3 = __uint_as_float(zv.y & 0xffff0000u);
      const float x0 = __uint_as_float(xg[i][u].x << 16), x1 = __uint_as_float(xg[i][u].x & 0xffff0000u), x2 = __uint_as_float(xg[i][u].y << 16), x3 = __uint_as_float(xg[i][u].y & 0xffff0000u);
      const float r0 = x0 * (acc[i][u][0] + z0 * bias), r1 = x1 * (acc[i][u][1] + z1 * bias), r2 = x2 * (acc[i][u][2] + z2 * bias), r3 = x3 * (acc[i][u][3] + z3 * bias);
      uint2 w; w.x = cvt_pk_bf16(r0, r1); w.y = cvt_pk_bf16(r2, r3);
      if (o == 0) *(uint2*)(lds + HY_ZT1 + bb * ZSTRB + 64 + 2 * t0) = w;
      else *(uint2*)(p.Yt + (size_t)c * T + bb * L + t0) = w;
    }
}

__device__ void hyena_unit(const Params& p, int c, unsigned char* lds) {
  const int tid = threadIdx.x;
  if (tid < 144) {
    const int buf = tid / 72, rem = tid % 72, b = rem / 9, k = rem % 9;
    const int off = (k < 4) ? (k * 16) : (4160 + (k - 4) * 16);
    *(uint4*)(lds + (buf ? HY_ZT1 : HY_ZT0) + b * ZSTRB + off) = make_uint4(0u, 0u, 0u, 0u);
  }
  for (int e = tid; e < 2048; e += NTHR) {
    const int b = e >> 8, ch = e & 255;
    *(uint4*)(lds + HY_ZT0 + b * ZSTRB + 64 + ch * 16) = *(const uint4*)(p.Ut + (size_t)c * T + b * L + ch * 8);
  }
#pragma unroll 1
  for (int o = 0; o < 2; ++o) {
    hy_build_filter(p, o, c, lds);
    hy_order(p, o, c, lds);
    __syncthreads();
  }
}

constexpr int SROW = 272;

__device__ __forceinline__ void ssd_stage_nat(const Params& p, int row0, int pxcol0, int cvcol0, unsigned char* dst) {
  for (int e = threadIdx.x; e < 2048; e += NTHR) {
    const int l = e >> 4, cg = e & 15;
    const int row = row0 + l, li = row & 63;
    const bf16_t* src = p.PXb + (size_t)row * DP + pxcol0 + cg * 8;
    const uint4 zero4 = make_uint4(0u, 0u, 0u, 0u);
    const uint4 cur = *(const uint4*)src;
    const uint4 prv = (li > 0) ? *(const uint4*)(src - DP) : zero4;
    const uint4 nxt = (li < 63) ? *(const uint4*)(src + DP) : zero4;
    const float* cw = p.ssd_conv_w + cvcol0 + cg * 8;
    const float* cb = p.ssd_conv_b + cvcol0 + cg * 8;
    const unsigned pc[4] = {prv.x, prv.y, prv.z, prv.w}, cc[4] = {cur.x, cur.y, cur.z, cur.w}, nc[4] = {nxt.x, nxt.y, nxt.z, nxt.w};
    float o[8];
#pragma unroll
    for (int k = 0; k < 4; ++k) {
      const float p0 = __uint_as_float(pc[k] << 16), p1 = __uint_as_float(pc[k] & 0xffff0000u);
      const float c0 = __uint_as_float(cc[k] << 16), c1 = __uint_as_float(cc[k] & 0xffff0000u);
      const float n0 = __uint_as_float(nc[k] << 16), n1 = __uint_as_float(nc[k] & 0xffff0000u);
      const float v0 = cb[2 * k] + cw[2 * k] * p0 + cw[DXBC + 2 * k] * c0 + cw[2 * DXBC + 2 * k] * n0;
      const float v1 = cb[2 * k + 1] + cw[2 * k + 1] * p1 + cw[DXBC + 2 * k + 1] * c1 + cw[2 * DXBC + 2 * k + 1] * n1;
      o[2 * k] = silu_f(v0); o[2 * k + 1] = silu_f(v1);
    }
    uint4 w; w.x = cvt_pk_bf16(o[0], o[1]); w.y = cvt_pk_bf16(o[2], o[3]); w.z = cvt_pk_bf16(o[4], o[5]); w.w = cvt_pk_bf16(o[6], o[7]);
    *(uint4*)(dst + l * SROW + cg * 16) = w;
  }
}

__device__ __forceinline__ void ssd_stage_tr(const Params& p, int row0, bool is_ctx, int pxcol0, int cvcol0, int ncols, unsigned char* dst) {
  for (int e = threadIdx.x; e < ncols * 16; e += NTHR) {
    const int col = e & (ncols - 1), l8 = e / ncols;
    const int rowf = row0 + l8 * 8;
    bool has_prev, has_next;
    if (is_ctx) { const int tc = (rowf - T) & (LC - 1); has_prev = tc > 0; has_next = tc + 7 < LC - 1; }
    else { const int li = rowf & 63; has_prev = li > 0; has_next = li + 7 < 63; }
    const bf16_t* src = p.PXb + (size_t)rowf * DP + pxcol0 + col;
    float x[10];
    x[0] = (cvcol0 >= 0 && has_prev) ? bf2f(src[-DP]) : 0.f;
#pragma unroll
    for (int k = 0; k < 8; ++k) x[k + 1] = bf2f(src[(size_t)k * DP]);
    x[9] = (cvcol0 >= 0 && has_next) ? bf2f(src[(size_t)8 * DP]) : 0.f;
    float o[8];
    if (cvcol0 >= 0) {
      const float w0 = p.ssd_conv_w[cvcol0 + col], w1 = p.ssd_conv_w[DXBC + cvcol0 + col], w2 = p.ssd_conv_w[2 * DXBC + cvcol0 + col], bb = p.ssd_conv_b[cvcol0 + col];
#pragma unroll
      for (int k = 0; k < 8; ++k) o[k] = silu_f(bb + w0 * x[k] + w1 * x[k + 1] + w2 * x[k + 2]);
    } else {
#pragma unroll
      for (int k = 0; k < 8; ++k) o[k] = x[k + 1];
    }
    uint4 w; w.x = cvt_pk_bf16(o[0], o[1]); w.y = cvt_pk_bf16(o[2], o[3]); w.z = cvt_pk_bf16(o[4], o[5]); w.w = cvt_pk_bf16(o[6], o[7]);
    *(uint4*)(dst + col * SROW + l8 * 16) = w;
  }
}

__device__ void ssd_states_unit(const Params& p, int unit, unsigned char* lds) {
  const int tid = threadIdx.x, wid = __builtin_amdgcn_readfirstlane(tid >> 6), lane = tid & 63;
  const int g = unit & 1, bc = unit >> 1, cidx = bc % 18, b = bc / 18;
  const bool is_ctx = cidx < 2;
  const int row0 = is_ctx ? (T + b * LC + cidx * 128) : (b * L + (cidx - 2) * 128);
  unsigned char* XT = lds;
  unsigned char* BT = lds + 69632;
  unsigned char* XD = lds + 104448;
  float* WG = (float*)(lds + 121856);
  ssd_stage_tr(p, row0, is_ctx, COL_XBC + g * 256, g * 256, 256, XT);
  ssd_stage_tr(p, row0, is_ctx, COL_XBC + 512 + g * 128, 512 + g * 128, 128, BT);
  {
    const int dir = wid >> 2, hh = wid & 3, h = g * 4 + hh;
    const float A = expf(p.a_log[dir * 8 + h]);
    const int l0 = 2 * lane, l1 = l0 + 1;
    const float dt0 = softplus_f(p.DT[(size_t)(row0 + l0) * 16 + dir * 8 + h]), dt1 = softplus_f(p.DT[(size_t)(row0 + l1) * 16 + dir * 8 + h]);
    const float a0 = -A * dt0, a1 = -A * dt1, pair = a0 + a1;
    float incl = pair;
#pragma unroll
    for (int o = 1; o < 64; o <<= 1) { float t = __shfl_up(incl, o); if (lane >= o) incl += t; }
    const float excl = incl - pair;
    const float total = __shfl(incl, 63);
    float w0, w1, c0, c1;
    if (dir == 0) { c0 = excl + a0; c1 = excl + pair; w0 = dt0 * expf(total - c0); w1 = dt1 * expf(total - c1); }
    else { const float pe0 = excl, pe1 = excl + a0; w0 = dt0 * expf(pe0); w1 = dt1 * expf(pe1); c0 = total - pe0; c1 = total - pe1; }
    WG[wid * 128 + l0] = w0; WG[wid * 128 + l1] = w1;
    if (!is_ctx) { float* ac = p.ACUM + (size_t)(b * 16 + dir * 8 + h) * L + (cidx - 2) * 128; *(float2*)(ac + l0) = make_float2(c0, c1); }
    if (lane == 0) {
      const int k = dir ? (is_ctx ? (1 - cidx) : (19 - cidx)) : cidx;
      p.CDEC[(size_t)(((b * 2 + dir) * 8 + h) * 18 + k) * 32] = expf(total);
    }
  }
  __syncthreads();
  const int fr = lane & 15, fq = lane >> 4;
#pragma unroll 1
  for (int it = 0; it < 8; ++it) {
    const int dir = it >> 2, hh = it & 3, h = g * 4 + hh;
    for (int e = tid; e < 1024; e += NTHR) {
      const int pr = e >> 4, ch = e & 15;
      const uint4 v = *(const uint4*)(XT + (hh * 64 + pr) * SROW + ch * 16);
      const float4 wa = *(const float4*)(WG + it * 128 + ch * 8), wb = *(const float4*)(WG + it * 128 + ch * 8 + 4);
      uint4 w;
      w.x = cvt_pk_bf16(__uint_as_float(v.x << 16) * wa.x, __uint_as_float(v.x & 0xffff0000u) * wa.y);
      w.y = cvt_pk_bf16(__uint_as_float(v.y << 16) * wa.z, __uint_as_float(v.y & 0xffff0000u) * wa.w);
      w.z = cvt_pk_bf16(__uint_as_float(v.z << 16) * wb.x, __uint_as_float(v.z & 0xffff0000u) * wb.y);
      w.w = cvt_pk_bf16(__uint_as_float(v.w << 16) * wb.z, __uint_as_float(v.w & 0xffff0000u) * wb.w);
      *(uint4*)(XD + pr * SROW + ch * 16) = w;
    }
    __syncthreads();
    hf32x4 acc[4];
#pragma unroll
    for (int pt = 0; pt < 4; ++pt) acc[pt] = (hf32x4){0.f, 0.f, 0.f, 0.f};
#pragma unroll
    for (int kk = 0; kk < 4; ++kk) {
      const hbf16x8 Bf = *(const hbf16x8*)(BT + (16 * wid + fr) * SROW + 2 * (32 * kk + 8 * fq));
#pragma unroll
      for (int pt = 0; pt < 4; ++pt) {
        const hbf16x8 Af = *(const hbf16x8*)(XD + (16 * pt + fr) * SROW + 2 * (32 * kk + 8 * fq));
        acc[pt] = __builtin_amdgcn_mfma_f32_16x16x32_bf16(Bf, Af, acc[pt], 0, 0, 0);
      }
    }
    const int k = dir ? (is_ctx ? (1 - cidx) : (19 - cidx)) : cidx;
    bf16_t* slot = p.SST + ((size_t)(((b * 2 + dir) * 8 + h) * 18 + k)) * 8192;
#pragma unroll
    for (int pt = 0; pt < 4; ++pt)
      *(uint2*)(slot + (16 * pt + fr) * 128 + 16 * wid + 4 * fq) = make_uint2(cvt_pk_bf16(acc[pt][0], acc[pt][1]), cvt_pk_bf16(acc[pt][2], acc[pt][3]));
    __syncthreads();
  }
}

__device__ void ssd_scan_unit(const Params& p, int unit) {
  const int tid = threadIdx.x;
  const int half = unit & 1, seq = unit >> 1;
  const int pr = half * 32 + (tid >> 4), n8 = (tid & 15) * 8;
  const bf16_t* base = p.SST + (size_t)seq * 18 * 8192 + pr * 128 + n8;
  uint4 sv[18];
#pragma unroll
  for (int k = 0; k < 18; ++k) sv[k] = *(const uint4*)(base + (size_t)k * 8192);
  float hst[8];
#pragma unroll
  for (int j = 0; j < 8; ++j) hst[j] = 0.f;
#pragma unroll
  for (int k = 0; k < 18; ++k) {
    const float dec = p.CDEC[(size_t)(seq * 18 + k) * 32];
    if (k >= 2) {
      uint4 w; w.x = cvt_pk_bf16(hst[0], hst[1]); w.y = cvt_pk_bf16(hst[2], hst[3]); w.z = cvt_pk_bf16(hst[4], hst[5]); w.w = cvt_pk_bf16(hst[6], hst[7]);
      *(uint4*)(p.HIN + ((size_t)seq * 16 + (k - 2)) * 8192 + pr * 128 + n8) = w;
    }
    const unsigned sw[4] = {sv[k].x, sv[k].y, sv[k].z, sv[k].w};
#pragma unroll
    for (int u = 0; u < 4; ++u) {
      hst[2 * u] = dec * hst[2 * u] + __uint_as_float(sw[u] << 16);
      hst[2 * u + 1] = dec * hst[2 * u + 1] + __uint_as_float(sw[u] & 0xffff0000u);
    }
  }
}

__device__ void ssd_out_unit(const Params& p, int unit, unsigned char* lds) {
  const int tid = threadIdx.x, wid = __builtin_amdgcn_readfirstlane(tid >> 6), lane = tid & 63;
  const int fr = lane & 15, fq = lane >> 4;
  const int g = unit & 1, bc = unit >> 1, c = bc & 15, b = bc >> 4;
  const int row0 = b * L + c * 128;
  unsigned char* CS = lds;
  unsigned char* ML = lds + 34816;
  unsigned char* XT = lds + 69632;
  unsigned char* ZT = lds + 87040;
  unsigned char* HS = lds + 104448;
  float* CUM = (float*)(lds + 121856);
  float* DTL = (float*)(lds + 125952);
  ssd_stage_nat(p, row0, COL_XBC + 768 + g * 128, 768 + g * 128, CS);
  ssd_stage_nat(p, row0, COL_XBC + 512 + g * 128, 512 + g * 128, ML);
  for (int e = tid; e < 1024; e += NTHR) {
    const int it = e >> 7, l = e & 127, dir = it >> 2, hh = it & 3;
    CUM[e] = p.ACUM[(size_t)(b * 16 + dir * 8 + g * 4 + hh) * L + c * 128 + l];
    DTL[e] = softplus_f(p.DT[(size_t)(row0 + l) * 16 + dir * 8 + g * 4 + hh]);
  }
  __syncthreads();
  hf32x4 cbt[8];
#pragma unroll
  for (int lt = 0; lt < 8; ++lt) cbt[lt] = (hf32x4){0.f, 0.f, 0.f, 0.f};
#pragma unroll
  for (int kk = 0; kk < 4; ++kk) {
    const hbf16x8 Af = *(const hbf16x8*)(ML + (16 * wid + fr) * SROW + 2 * (32 * kk + 8 * fq));
#pragma unroll
    for (int lt = 0; lt < 8; ++lt) {
      const hbf16x8 Bf = *(const hbf16x8*)(CS + (16 * lt + fr) * SROW + 2 * (32 * kk + 8 * fq));
      cbt[lt] = __builtin_amdgcn_mfma_f32_16x16x32_bf16(Af, Bf, cbt[lt], 0, 0, 0);
    }
  }
  __syncthreads();
  hf32x4 y[4][4];
#pragma unroll
  for (int hh = 0; hh < 4; ++hh)
#pragma unroll
    for (int pt = 0; pt < 4; ++pt) y[hh][pt] = (hf32x4){0.f, 0.f, 0.f, 0.f};
  const int sb = 16 * wid + 4 * fq;
#pragma unroll 1
  for (int hh = 0; hh < 4; ++hh) {
    const int h = g * 4 + hh;
    hf32x4 yc[4];
#pragma unroll
    for (int pt = 0; pt < 4; ++pt) yc[pt] = (hf32x4){0.f, 0.f, 0.f, 0.f};
    ssd_stage_tr(p, row0, false, COL_XBC + g * 256 + hh * 64, g * 256 + hh * 64, 64, XT);
    ssd_stage_tr(p, row0, false, COL_Z + g * 256 + hh * 64, -1, 64, ZT);
#pragma unroll 1
    for (int dir = 0; dir < 2; ++dir) {
      const int it = dir * 4 + hh;
      const int k = dir ? (17 - c) : (c + 2);
      const bf16_t* slot = p.HIN + ((size_t)(((b * 2 + dir) * 8 + h) * 16 + (k - 2))) * 8192;
      for (int e = tid; e < 1024; e += NTHR) {
        const int pr = e >> 4, ch = e & 15;
        *(uint4*)(HS + pr * SROW + ch * 16) = *(const uint4*)(slot + pr * 128 + ch * 8);
      }
      {
        const float* cu = CUM + it * 128; const float* dl = DTL + it * 128;
        float cs[4], ds[4];
#pragma unroll
        for (int r = 0; r < 4; ++r) { cs[r] = cu[sb + r]; ds[r] = dl[sb + r]; }
#pragma unroll
        for (int lt = 0; lt < 8; ++lt) {
          const int l = 16 * lt + fr;
          const float cl = cu[l];
          float m[4];
#pragma unroll
          for (int r = 0; r < 4; ++r) {
            const int sidx = sb + r;
            const bool ok = dir ? (sidx >= l) : (sidx <= l);
            m[r] = ok ? cbt[lt][r] * __expf(cl - cs[r]) * ds[r] : 0.f;
          }
          uint2 w; w.x = cvt_pk_bf16(m[0], m[1]); w.y = cvt_pk_bf16(m[2], m[3]);
          *(uint2*)(ML + l * SROW + 2 * sb) = w;
        }
      }
      __syncthreads();
      hf32x4 ad[4], ao[4];
#pragma unroll
      for (int pt = 0; pt < 4; ++pt) { ad[pt] = (hf32x4){0.f, 0.f, 0.f, 0.f}; ao[pt] = (hf32x4){0.f, 0.f, 0.f, 0.f}; }
#pragma unroll
      for (int kk = 0; kk < 4; ++kk) {
        const hbf16x8 Am = *(const hbf16x8*)(ML + (16 * wid + fr) * SROW + 2 * (32 * kk + 8 * fq));
        const hbf16x8 Ac = *(const hbf16x8*)(CS + (16 * wid + fr) * SROW + 2 * (32 * kk + 8 * fq));
#pragma unroll
        for (int pt = 0; pt < 4; ++pt) {
          const hbf16x8 Bx = *(const hbf16x8*)(XT + (16 * pt + fr) * SROW + 2 * (32 * kk + 8 * fq));
          const hbf16x8 Bh = *(const hbf16x8*)(HS + (16 * pt + fr) * SROW + 2 * (32 * kk + 8 * fq));
          ad[pt] = __builtin_amdgcn_mfma_f32_16x16x32_bf16(Am, Bx, ad[pt], 0, 0, 0);
          ao[pt] = __builtin_amdgcn_mfma_f32_16x16x32_bf16(Ac, Bh, ao[pt], 0, 0, 0);
        }
      }
      {
        const float* cu = CUM + it * 128;
        float ex[4];
#pragma unroll
        for (int r = 0; r < 4; ++r) ex[r] = __expf(cu[sb + r]);
#pragma unroll
        for (int pt = 0; pt < 4; ++pt)
#pragma unroll
          for (int r = 0; r < 4; ++r) yc[pt][r] += ad[pt][r] + ex[r] * ao[pt][r];
      }
      __syncthreads();
    }
    {
      const float dsk = p.ssd_d[h];
#pragma unroll
      for (int pt = 0; pt < 4; ++pt) {
        const uint2 xv = *(const uint2*)(XT + (16 * pt + fr) * SROW + 2 * sb);
        const uint2 zv = *(const uint2*)(ZT + (16 * pt + fr) * SROW + 2 * sb);
        const float xs4[4] = {__uint_as_float(xv.x << 16), __uint_as_float(xv.x & 0xffff0000u), __uint_as_float(xv.y << 16), __uint_as_float(xv.y & 0xffff0000u)};
        const float zs4[4] = {__uint_as_float(zv.x << 16), __uint_as_float(zv.x & 0xffff0000u), __uint_as_float(zv.y << 16), __uint_as_float(zv.y & 0xffff0000u)};
#pragma unroll
        for (int r = 0; r < 4; ++r) yc[pt][r] = (yc[pt][r] + dsk * xs4[r]) * silu_f(zs4[r]);
      }
    }
    if (hh == 0) {
#pragma unroll
      for (int pt = 0; pt < 4; ++pt) y[0][pt] = yc[pt];
    } else if (hh == 1) {
#pragma unroll
      for (int pt = 0; pt < 4; ++pt) y[1][pt] = yc[pt];
    } else if (hh == 2) {
#pragma unroll
      for (int pt = 0; pt < 4; ++pt) y[2][pt] = yc[pt];
    } else {
#pragma unroll
      for (int pt = 0; pt < 4; ++pt) y[3][pt] = yc[pt];
    }
    __syncthreads();
  }
  float rinv[4];
#pragma unroll
  for (int r = 0; r < 4; ++r) {
    float ss = 0.f;
#pragma unroll
    for (int hh = 0; hh < 4; ++hh)
#pragma unroll
      for (int pt = 0; pt < 4; ++pt) ss += y[hh][pt][r] * y[hh][pt][r];
    ss += __shfl_xor(ss, 1); ss += __shfl_xor(ss, 2); ss += __shfl_xor(ss, 4); ss += __shfl_xor(ss, 8);
    rinv[r] = rsqrtf(ss * (1.f / 256.f) + EPS);
  }
#pragma unroll
  for (int hh = 0; hh < 4; ++hh)
#pragma unroll
    for (int pt = 0; pt < 4; ++pt) {
      const int ch = g * 256 + hh * 64 + 16 * pt + fr;
      const float ng = p.ssd_norm_g[ch];
#pragma unroll
      for (int r = 0; r < 4; ++r) p.YMIXb[(size_t)(row0 + sb + r) * D + 512 + ch] = f2bf(y[hh][pt][r] * rinv[r] * ng);
    }
}

__device__ void ph_router(const Params& p, unsigned char* lds) {
  const int tid = threadIdx.x, wid = __builtin_amdgcn_readfirstlane(tid >> 6), lane = tid & 63;
  const int fr = lane & 15, fq = lane >> 4;
  constexpr int AROW = 272;
  unsigned char* AH = lds;
  unsigned char* AL = lds + 64 * AROW;
  unsigned char* WH = lds + 128 * AROW;
  unsigned char* WL = lds + 224 * AROW;
  float* RS = (float*)(lds + 320 * AROW);
  float* LOG = RS + 64;
  float* GM = LOG + 6400;
  float* SH = GM + 1024;
  for (int tile = blockIdx.x; tile < T / 64; tile += gridDim.x) {
    const int row0 = tile * 64;
    const float* shp = p.MOD + (row0 / L) * 6144 + 3072;
    const float* scp = shp + 1024;
    if (tid < 64) {
      const float4* sp = (const float4*)(p.SSQP + (size_t)(row0 + tid) * 16);
      const float4 a0 = sp[0], a1 = sp[1], a2 = sp[2], a3 = sp[3];
      const float ss = ((a0.x + a0.y) + (a0.z + a0.w)) + ((a1.x + a1.y) + (a1.z + a1.w)) + ((a2.x + a2.y) + (a2.z + a2.w)) + ((a3.x + a3.y) + (a3.z + a3.w));
      RS[tid] = rsqrtf(ss * (1.f / D) + EPS);
    }
    for (int e = tid; e < 256; e += NTHR) {
      const float4 g = *(const float4*)(p.g2 + e * 4), s4 = *(const float4*)(scp + e * 4), h4 = *(const float4*)(shp + e * 4);
      *(float4*)(GM + e * 4) = make_float4(g.x * (1.f + s4.x), g.y * (1.f + s4.y), g.z * (1.f + s4.z), g.w * (1.f + s4.w));
      *(float4*)(SH + e * 4) = h4;
    }
    float4 xv[4];
#pragma unroll
    for (int i = 0; i < 4; ++i) { const int e = tid + i * NTHR; xv[i] = *(const float4*)(p.X1 + (size_t)(row0 + (e >> 5)) * D + (e & 31) * 4); }
    __syncthreads();
    hf32x4 acc[3];
#pragma unroll
    for (int nt = 0; nt < 3; ++nt) acc[nt] = (hf32x4){0.f, 0.f, 0.f, 0.f};
    const int mt = wid & 3, nh = wid >> 2;
#pragma unroll 1
    for (int kc = 0; kc < 8; ++kc) {
#pragma unroll
      for (int i = 0; i < 4; ++i) {
        const int e = tid + i * NTHR; const int tok = e >> 5, k4 = (e & 31) * 4;
        const int kg = kc * 128 + k4;
        const float4 v = xv[i];
        const float4 g = *(const float4*)(GM + kg);
        const float4 h4 = *(const float4*)(SH + kg);
        const float rstd = RS[tok];
        const float h0 = v.x * rstd * g.x + h4.x, h1 = v.y * rstd * g.y + h4.y;
        const float h2 = v.z * rstd * g.z + h4.z, h3 = v.w * rstd * g.w + h4.w;
        const unsigned hi01 = cvt_pk_bf16(h0, h1), hi23 = cvt_pk_bf16(h2, h3);
        const unsigned lo01 = cvt_pk_bf16(h0 - __uint_as_float(hi01 << 16), h1 - __uint_as_float(hi01 & 0xffff0000u));
        const unsigned lo23 = cvt_pk_bf16(h2 - __uint_as_float(hi23 << 16), h3 - __uint_as_float(hi23 & 0xffff0000u));
        *(uint2*)(AH + tok * AROW + k4 * 2) = make_uint2(hi01, hi23);
        *(uint2*)(AL + tok * AROW + k4 * 2) = make_uint2(lo01, lo23);
        *(uint2*)(p.H2b + (size_t)(row0 + tok) * D + kg) = make_uint2(hi01, hi23);
      }
#pragma unroll
      for (int i = 0; i < 3; ++i) {
        const int e = tid + i * NTHR; const int j = e >> 4, ch = e & 15;
        *(uint4*)(WH + j * AROW + ch * 16) = *(const uint4*)(p.WRhi + (size_t)j * 1024 + kc * 128 + ch * 8);
        *(uint4*)(WL + j * AROW + ch * 16) = *(const uint4*)(p.WRlo + (size_t)j * 1024 + kc * 128 + ch * 8);
      }
      if (kc + 1 < 8) {
#pragma unroll
        for (int i = 0; i < 4; ++i) { const int e = tid + i * NTHR; xv[i] = *(const float4*)(p.X1 + (size_t)(row0 + (e >> 5)) * D + (kc + 1) * 128 + (e & 31) * 4); }
      }
      __syncthreads();
#pragma unroll
      for (int kk = 0; kk < 4; ++kk) {
        const hbf16x8 Ahi = *(const hbf16x8*)(AH + (16 * mt + fr) * AROW + 2 * (32 * kk + 8 * fq));
        const hbf16x8 Alo = *(const hbf16x8*)(AL + (16 * mt + fr) * AROW + 2 * (32 * kk + 8 * fq));
#pragma unroll
        for (int nt = 0; nt < 3; ++nt) {
          const int wo = (16 * (nh * 3 + nt) + fr) * AROW + 2 * (32 * kk + 8 * fq);
          const hbf16x8 Bhi = *(const hbf16x8*)(WH + wo);
          const hbf16x8 Blo = *(const hbf16x8*)(WL + wo);
          acc[nt] = __builtin_amdgcn_mfma_f32_16x16x32_bf16(Ahi, Bhi, acc[nt], 0, 0, 0);
          acc[nt] = __builtin_amdgcn_mfma_f32_16x16x32_bf16(Ahi, Blo, acc[nt], 0, 0, 0);
          acc[nt] = __builtin_amdgcn_mfma_f32_16x16x32_bf16(Alo, Bhi, acc[nt], 0, 0, 0);
        }
      }
      __syncthreads();
    }
#pragma unroll
    for (int nt = 0; nt < 3; ++nt)
#pragma unroll
      for (int r = 0; r < 4; ++r) LOG[(16 * mt + 4 * fq + r) * 100 + 16 * (nh * 3 + nt) + fr] = acc[nt][r];
    __syncthreads();
    if (tid < 64) {
      const float* lg = LOG + tid * 100;
      const int row = row0 + tid;
      int gs = 0; float gm = lg[64] + p.b_group[0];
      float gl[8];
      gl[0] = gm;
#pragma unroll
      for (int j = 1; j < 8; ++j) { gl[j] = lg[64 + j] + p.b_group[j]; if (gl[j] > gm) { gm = gl[j]; gs = j; } }
      float den = 0.f;
#pragma unroll
      for (int j = 0; j < 8; ++j) den += expf(gl[j] - gm);
      const float pg = 1.f / den;
      float el[8];
#pragma unroll
      for (int j = 0; j < 8; ++j) el[j] = 0.f;
      for (int j = 0; j < 8; ++j) el[j] = lg[gs * 8 + j] + p.b_expert[gs * 8 + j];
      int i0 = 0; float l0 = el[0];
#pragma unroll
      for (int j = 1; j < 8; ++j) if (el[j] > l0) { l0 = el[j]; i0 = j; }
      int i1 = -1; float l1 = -3.0e38f;
#pragma unroll
      for (int j = 0; j < 8; ++j) if (j != i0 && el[j] > l1) { l1 = el[j]; i1 = j; }
      const float e1 = expf(l1 - l0);
      const float w0 = 1.f / (1.f + e1), w1 = e1 / (1.f + e1);
      p.GATE[row * 2 + 0] = w0 * pg;
      p.GATE[row * 2 + 1] = w1 * pg;
      const int ea = gs * 8 + i0, eb = gs * 8 + i1;
      const int sa = atomicAdd(&p.CNT[ea], 1);
      p.LIST[ea * T + sa] = row * 2 + 0;
      const int sb2 = atomicAdd(&p.CNT[eb], 1);
      p.LIST[eb * T + sb2] = row * 2 + 1;
    }
    __syncthreads();
  }
}

__device__ __forceinline__ void moe_table(const Params& p, int* tab) {
  if (threadIdx.x == 0) {
    int a = 0, sg = 0;
    for (int e = 0; e < NE; ++e) {
      int cn = p.CNT[e];
      tab[e] = a; tab[65 + e] = sg; tab[130 + e] = cn;
      a += (cn + 255) >> 8; sg += ((cn + 127) >> 7) << 7;
    }
    tab[NE] = a; tab[65 + NE] = sg;
  }
  __syncthreads();
}

__device__ void ph_final(const Params& p) {
  const int tid = threadIdx.x, wid = tid >> 6, lane = tid & 63;
  for (int row = blockIdx.x * 8 + wid; row < T; row += gridDim.x * 8) {
    const float* ga2 = p.MOD + (row / L) * 6144 + 5120;
    float4 v[4];
    float ss = 0.f;
#pragma unroll
    for (int i = 0; i < 4; ++i) {
      const int col = i * 256 + lane * 4;
      float4 xv = *(const float4*)(p.X1 + (size_t)row * D + col);
      uint2 a = *(const uint2*)(p.YB2b + (size_t)(row * 2) * D + col);
      uint2 b = *(const uint2*)(p.YB2b + (size_t)(row * 2 + 1) * D + col);
      float4 ga = *(const float4*)(ga2 + col);
      v[i].x = xv.x + ga.x * (__uint_as_float(a.x << 16) + __uint_as_float(b.x << 16));
      v[i].y = xv.y + ga.y * (__uint_as_float(a.x & 0xffff0000u) + __uint_as_float(b.x & 0xffff0000u));
      v[i].z = xv.z + ga.z * (__uint_as_float(a.y << 16) + __uint_as_float(b.y << 16));
      v[i].w = xv.w + ga.w * (__uint_as_float(a.y & 0xffff0000u) + __uint_as_float(b.y & 0xffff0000u));
      ss += v[i].x * v[i].x + v[i].y * v[i].y + v[i].z * v[i].z + v[i].w * v[i].w;
    }
    ss = wave_sum(ss);
    const float rstd = rsqrtf(ss * (1.f / D) + EPS);
#pragma unroll
    for (int i = 0; i < 4; ++i) {
      const int col = i * 256 + lane * 4;
      float4 gf = *(const float4*)(p.g_final + col);
      float4 o;
      o.x = v[i].x * rstd * gf.x; o.y = v[i].y * rstd * gf.y; o.z = v[i].z * rstd * gf.z; o.w = v[i].w * rstd * gf.w;
      *(float4*)(p.out + (size_t)row * D + col) = o;
    }
  }
}

constexpr int NPHASE = 11;

__global__ void __launch_bounds__(NTHR, 2) mega(Params p) {
  extern __shared__ __attribute__((aligned(16))) unsigned char lds_raw[];
  float* sm = (float*)lds_raw;
  PG8_LAS unsigned char* lds = (PG8_LAS unsigned char*)lds_raw;
  const int lo = p.lo, hi = p.hi;
  volatile LAS unsigned* xbst = (volatile LAS unsigned*)(lds + pg8::STAGE_BYTES + 2048);
  if (threadIdx.x < 4) xbst[threadIdx.x] = 0u;
  __syncthreads();
  XcdBarrier xbar; xbar.bar = p.BAR; xbar.x = 0; xbar.st = xbst;
  if (hi - lo > 1) xbar = xcd_barrier_post(p.BAR, xbst);
#define IN(k) (lo <= (k) && (k) < hi)
#define SYNC(k) do { if (IN(k) && IN((k) + 1)) xcd_barrier(xbar); } while (0)
#ifndef DUPK
#define DUPK -1
#endif
#ifndef SKIP_OTHER
  if (IN(0)) { ph_adaln(p, sm); ph_filters(p, sm); ph_wcvt(p, sm); }
#if DUPK == 0
  xcd_barrier(xbar);
  if (IN(0)) { ph_adaln(p, sm); ph_filters(p, sm); ph_wcvt(p, sm); }
#endif
  SYNC(0);
  if (IN(1)) ph_norm1(p);
#if DUPK == 1
  xcd_barrier(xbar);
  if (IN(1)) ph_norm1(p);
#endif
  SYNC(1);
#endif
#ifndef SKIP_GEMM
  if (IN(2)) {
    pg8::DenseOrder S{p.XNb, p.WinT, TT / 256, DP / 256 + 1, D, (int)gridDim.x, (int)blockIdx.x};
    pg8::EpiBf16 E{p.PXb, DP, p.DT, p.dt_bias};
    pg8::gemm_phase<pg8::EpiBf16, pg8::DenseOrder>(lds, D, S, E);
  }
#if DUPK == 2
  xcd_barrier(xbar);
  if (IN(2)) {
    pg8::DenseOrder S{p.XNb, p.WinT, TT / 256, DP / 256 + 1, D, (int)gridDim.x, (int)blockIdx.x};
    pg8::EpiBf16 E{p.PXb, DP, p.DT, p.dt_bias};
    pg8::gemm_phase<pg8::EpiBf16, pg8::DenseOrder>(lds, D, S, E);
  }
#endif
  SYNC(2);
#endif
#ifndef SKIP_OTHER
  if (IN(3)) {
    ph_hy_convT(p, sm);
    for (int it = blockIdx.x; it < 288; it += gridDim.x) ssd_states_unit(p, it, lds_raw);
  }
#if DUPK == 3
  xcd_barrier(xbar);
  if (IN(3)) {
    ph_hy_convT(p, sm);
    for (int it = blockIdx.x; it < 288; it += gridDim.x) ssd_states_unit(p, it, lds_raw);
  }
#endif
  SYNC(3);
  if (IN(4)) {
    for (int it = blockIdx.x; it < 256; it += gridDim.x) ssd_scan_unit(p, it);
    for (int it = blockIdx.x; it < 512; it += gridDim.x) hyena_unit(p, it, lds_raw);
  }
#if DUPK == 4
  xcd_barrier(xbar);
  if (IN(4)) {
    for (int it = blockIdx.x; it < 256; it += gridDim.x) ssd_scan_unit(p, it);
    for (int it = blockIdx.x; it < 512; it += gridDim.x) hyena_unit(p, it, lds_raw);
  }
#endif
  SYNC(4);
  if (IN(5)) {
    for (int it = blockIdx.x; it < 256; it += gridDim.x) { ssd_out_unit(p, it, lds_raw); __syncthreads(); }
    ph_hy_backT(p, sm);
  }
#if DUPK == 5
  xcd_barrier(xbar);
  if (IN(5)) {
    for (int it = blockIdx.x; it < 256; it += gridDim.x) { ssd_out_unit(p, it, lds_raw); __syncthreads(); }
    ph_hy_backT(p, sm);
  }
#endif
  SYNC(5);
#endif
#ifndef SKIP_GEMM
  if (IN(6)) {
    pg8::DenseOrder S{p.YMIXb, p.WoutT, T / 256, D / 256, D, (int)gridDim.x, (int)blockIdx.x};
    pg8::EpiX1 E{p.x, p.MOD, p.X1, p.SSQP};
    pg8::gemm_phase<pg8::EpiX1, pg8::DenseOrder>(lds, D, S, E);
  }
#if DUPK == 6
  xcd_barrier(xbar);
  if (IN(6)) {
    pg8::DenseOrder S{p.YMIXb, p.WoutT, T / 256, D / 256, D, (int)gridDim.x, (int)blockIdx.x};
    pg8::EpiX1 E{p.x, p.MOD, p.X1, p.SSQP};
    pg8::gemm_phase<pg8::EpiX1, pg8::DenseOrder>(lds, D, S, E);
  }
#endif
  SYNC(6);
#endif
#ifndef SKIP_OTHER
  if (IN(7)) ph_router(p, lds_raw);
#if DUPK == 7
  xcd_barrier(xbar);
  if (IN(7)) ph_router(p, lds_raw);
#endif
  SYNC(7);
#endif
#ifndef SKIP_GEMM
  if (IN(8)) {
    int* tab = (int*)(lds_raw + pg8::STAGE_BYTES);
    moe_table(p, tab);
    pg8::MoeOrder S{tab, p.H2b, p.Wup, p.LIST, 4, D, (int)gridDim.x, (int)blockIdx.x, true};
    pg8::EpiSwiGLU E{p.HBb};
    pg8::gemm_phase<pg8::EpiSwiGLU, pg8::MoeOrder>(lds, D, S, E);
  }
#if DUPK == 8
  xcd_barrier(xbar);
  if (IN(8)) {
    int* tab = (int*)(lds_raw + pg8::STAGE_BYTES);
    moe_table(p, tab);
    pg8::MoeOrder S{tab, p.H2b, p.Wup, p.LIST, 4, D, (int)gridDim.x, (int)blockIdx.x, true};
    pg8::EpiSwiGLU E{p.HBb};
    pg8::gemm_phase<pg8::EpiSwiGLU, pg8::MoeOrder>(lds, D, S, E);
  }
#endif
  SYNC(8);
  if (IN(9)) {
    int* tab = (int*)(lds_raw + pg8::STAGE_BYTES);
    moe_table(p, tab);
    pg8::MoeOrder S{tab, p.HBb, p.Wdn, p.LIST, 4, DE, (int)gridDim.x, (int)blockIdx.x, false};
    pg8::EpiDown E{p.YB2b, p.LIST, p.GATE};
    pg8::gemm_phase<pg8::EpiDown, pg8::MoeOrder>(lds, DE, S, E);
  }
#if DUPK == 9
  xcd_barrier(xbar);
  if (IN(9)) {
    int* tab = (int*)(lds_raw + pg8::STAGE_BYTES);
    moe_table(p, tab);
    pg8::MoeOrder S{tab, p.HBb, p.Wdn, p.LIST, 4, DE, (int)gridDim.x, (int)blockIdx.x, false};
    pg8::EpiDown E{p.YB2b, p.LIST, p.GATE};
    pg8::gemm_phase<pg8::EpiDown, pg8::MoeOrder>(lds, DE, S, E);
  }
#endif
  SYNC(9);
#endif
#ifndef SKIP_OTHER
  if (IN(10)) ph_final(p);
#if DUPK == 10
  xcd_barrier(xbar);
  if (IN(10)) ph_final(p);
#endif
#endif
#undef IN
#undef SYNC
}

extern "C" void kernel_launch(void* const* d_in, const int* in_sizes, int n_in, void* d_out, int out_size,
                              void* d_ws, size_t ws_size, hipStream_t stream) {
  Params p{};
  const float* const* in = (const float* const*)d_in;
  p.x = in[0]; p.c = in[1]; p.ctx = in[2]; p.c_ctx = in[3]; p.w_ada = in[4]; p.b_ada = in[5];
  p.g1 = in[6]; p.g2 = in[7]; p.w_in = in[8]; p.hy_conv_w = in[9]; p.hy_conv_b = in[10];
  p.f_w1 = in[11]; p.f_b1 = in[12]; p.f_freq = in[13]; p.f_w2 = in[14]; p.f_b2 = in[15]; p.f_w3 = in[16];
  p.hy_bias = in[17]; p.ssd_conv_w = in[18]; p.ssd_conv_b = in[19]; p.a_log = in[20]; p.dt_bias = in[21];
  p.ssd_d = in[22]; p.ssd_norm_g = in[23]; p.w_out = in[24]; p.w_group = in[25]; p.b_group = in[26];
  p.w_expert = in[27]; p.b_expert = in[28]; p.w1 = in[29]; p.w3 = in[30]; p.w2 = in[31]; p.g_final = in[32];
  p.out = (float*)d_out;

  char* ws = (char*)d_ws;
  size_t off = 0;
  auto take = [&](size_t bytes) { char* r = ws + off; off += (bytes + 255) & ~(size_t)255; return r; };
  p.BAR = (unsigned*)take((size_t)XCD_BAR_WORDS * 4);
  p.MOD = (float*)take((size_t)9 * 6144 * 4);
  p.CNT = (int*)take(NE * 4);
  p.GATE = (float*)take((size_t)T * 2 * 4);
  p.LIST = (int*)take((size_t)NE * T * 4);
  p.DT = (float*)take((size_t)TT * 16 * 4);
  p.ACUM = (float*)take((size_t)T * 16 * 4);
  p.SSQP = (float*)take((size_t)T * 16 * 4);
  p.CDEC = (float*)take((size_t)128 * 18 * 32 * 4);
  p.FILTt = (bf16_t*)take((size_t)1024 * FLEN * 2);
  p.WRhi = (bf16_t*)take((size_t)96 * 1024 * 2);
  p.WRlo = (bf16_t*)take((size_t)96 * 1024 * 2);
  p.WinT = (bf16_t*)take((size_t)(DP + 256) * D * 2);
  p.WoutT = (bf16_t*)take((size_t)D * D * 2);
  p.Wup = (bf16_t*)take((size_t)NE * 1024 * 1024 * 2);
  p.Wdn = (bf16_t*)take((size_t)NE * 1024 * 512 * 2);
  char* rPX = take((size_t)TT * DP * 2);
  char* rXBC = take((size_t)128 * 18 * 8192 * 2);
  char* rYF = take((size_t)T * DS * 4);
  char* rZ1 = take((size_t)HYC * T * 2);
  char* rYB = take((size_t)T * DS * 4);
  char* rYM = take((size_t)T * D * 2);
  p.PXb = (bf16_t*)rPX; p.SST = (bf16_t*)rXBC; p.Ut = (bf16_t*)rZ1; p.YMIXb = (bf16_t*)rYM;
  p.HIN = (bf16_t*)rYF;
  p.Yt = (bf16_t*)rYB;
  p.XNb = (bf16_t*)rZ1;
  p.X1 = (float*)rPX;
  p.H2b = (bf16_t*)rYM;
  p.HBb = (bf16_t*)(rPX + (size_t)T * D * 4);
  p.YB2b = (bf16_t*)rZ1;
  if (off > ws_size) { fprintf(stderr, "workspace too small: need %zu have %zu\n", off, ws_size); return; }

  static int grid_blocks = 0;
  if (!grid_blocks) {
    int dev = 0, cus = 0, per_cu = 0;
    (void)hipGetDevice(&dev);
    (void)hipDeviceGetAttribute(&cus, hipDeviceAttributeMultiprocessorCount, dev);
    (void)hipFuncSetAttribute((const void*)mega, hipFuncAttributeMaxDynamicSharedMemorySize, LDS_BYTES);
    (void)hipOccupancyMaxActiveBlocksPerMultiprocessor(&per_cu, mega, NTHR, LDS_BYTES);
    if (per_cu < 1) { fprintf(stderr, "occupancy query returned %d\n", per_cu); per_cu = 1; }
    grid_blocks = cus;
  }
#ifndef ONE_LAUNCH
  for (int ph = 0; ph < NPHASE; ++ph) {
    p.lo = ph; p.hi = ph + 1;
    hipLaunchKernelGGL(mega, dim3(grid_blocks), dim3(NTHR), LDS_BYTES, stream, p);
  }
#else
  p.lo = 0; p.hi = NPHASE;
  (void)hipMemsetAsync(p.BAR, 0, (size_t)XCD_BAR_WORDS * 4, stream);
  void* args[] = {&p};
  hipError_t e = hipLaunchCooperativeKernel((void*)mega, dim3(grid_blocks), dim3(NTHR), args, LDS_BYTES, stream);
  if (e != hipSuccess) fprintf(stderr, "cooperative launch failed: %s (grid %d)\n", hipGetErrorString(e), grid_blocks);
#endif
}
```

```cpp
#define ONE_LAUNCH 1
#include <hip/hip_runtime.h>
#include <hip/hip_cooperative_groups.h>
#include <cstdio>
#include <cstdint>
namespace cg = cooperative_groups;

constexpr int D = 1024, NB = 8, L = 2048, LC = 256;
constexpr int T = NB * L;
constexpr int TC = NB * LC;
constexpr int TT = T + TC;
constexpr int DH = 512, HYC = 1536, DS = 512, DXBC = 1024, DIN = 3088, DP = 3072;
constexpr int COL_Z = 1536, COL_XBC = 2048, COL_DT = 3072;
constexpr int NE = 64, DE = 512;
constexpr float EPS = 1e-6f;
constexpr int NTHR = 512;
constexpr int LDS_BYTES = 132 * 1024;
constexpr int FLEN = 4232, HX0 = 2112, FCLEN = 4240, ZSTRB = 4240;

typedef unsigned short bf16_t;

struct Params {
  const float *x, *c, *ctx, *c_ctx, *w_ada, *b_ada, *g1, *g2, *w_in, *hy_conv_w, *hy_conv_b;
  const float *f_w1, *f_b1, *f_freq, *f_w2, *f_b2, *f_w3, *hy_bias;
  const float *ssd_conv_w, *ssd_conv_b, *a_log, *dt_bias, *ssd_d, *ssd_norm_g, *w_out;
  const float *w_group, *b_group, *w_expert, *b_expert, *w1, *w3, *w2, *g_final;
  float* out;
  float *MOD, *DT, *X1, *GATE, *ACUM, *CDEC, *SSQP;
  bf16_t *WRhi, *WRlo, *FILTt, *Ut, *Yt, *HIN, *XNb, *WinT, *WoutT, *PXb, *SST, *YMIXb, *YB2b, *Wup, *Wdn, *H2b, *HBb;
  int *CNT, *LIST;
  unsigned* BAR;
  int lo, hi;
};

__device__ __forceinline__ float silu_f(float v) { return v / (1.f + __expf(-v)); }
__device__ __forceinline__ float softplus_f(float v) { return v > 20.f ? v : log1pf(expf(v)); }
__device__ __forceinline__ float bf2f(bf16_t v) { return __uint_as_float(((unsigned)v) << 16); }
__device__ __forceinline__ unsigned cvt_pk_bf16(float lo, float hi) {
  typedef __bf16 bf2_t __attribute__((ext_vector_type(2)));
  typedef float f2_t __attribute__((ext_vector_type(2)));
  const f2_t v = {lo, hi};
  const bf2_t r = __builtin_convertvector(v, bf2_t);
  return __builtin_bit_cast(unsigned, r);
}
__device__ __forceinline__ bf16_t f2bf(float f) { return (bf16_t)(cvt_pk_bf16(f, 0.f) & 0xffffu); }
__device__ __forceinline__ void st_agent64(void* p, unsigned lo, unsigned hi) {
  __hip_atomic_store((unsigned long long*)p, ((unsigned long long)hi << 32) | lo, __ATOMIC_RELAXED, __HIP_MEMORY_SCOPE_AGENT);
}
__device__ __forceinline__ uint2 ld_agent64(const void* p) {
  const unsigned long long v = __hip_atomic_load((const unsigned long long*)p, __ATOMIC_RELAXED, __HIP_MEMORY_SCOPE_AGENT);
  return make_uint2((unsigned)v, (unsigned)(v >> 32));
}
__device__ __forceinline__ void st_agent32(float* p, float v) { __hip_atomic_store(p, v, __ATOMIC_RELAXED, __HIP_MEMORY_SCOPE_AGENT); }
__device__ __forceinline__ float ld_agent32(const float* p) { return __hip_atomic_load(p, __ATOMIC_RELAXED, __HIP_MEMORY_SCOPE_AGENT); }
__device__ __forceinline__ float wave_sum(float v) {
#pragma unroll
  for (int o = 32; o > 0; o >>= 1) v += __shfl_xor(v, o);
  return v;
}


#define XB_TMO      128
#define XB_XCNT(j)  (256  + 64 * (j))
#define XB_XSUB(j)  (1280 + 64 * (j))
#define XB_XGEN(j)  (2304 + 64 * (j))
#define XB_TOP      3328
#define XB_TOPGEN   3392
#define XCD_BAR_WORDS 3456
#define XB_SPIN_CAP (1u << 18)
#define LAS __attribute__((address_space(3)))
__device__ __forceinline__ unsigned xb_ld(unsigned* p) { return __hip_atomic_load(p, __ATOMIC_RELAXED, __HIP_MEMORY_SCOPE_AGENT); }
__device__ __forceinline__ unsigned xb_add(unsigned* p, unsigned v) { return __hip_atomic_fetch_add(p, v, __ATOMIC_RELAXED, __HIP_MEMORY_SCOPE_AGENT); }
__device__ __forceinline__ unsigned xb_xcc_id() { return (unsigned)__builtin_amdgcn_s_getreg((3 << 11) | 20) & 0xFu; }
#define XB_SPIN(cond, bar) do { unsigned _sp = 0; while (cond) { __builtin_amdgcn_s_sleep(1); \
    if ((++_sp & 255u) == 0u) { if (xb_ld(&(bar)[XB_TMO])) break; if (_sp > XB_SPIN_CAP) { atomicAdd(&(bar)[XB_TMO], 1u); break; } } } } while (0)
struct XcdBarrier { unsigned* bar; unsigned x; volatile LAS unsigned* st; };
__device__ __forceinline__ XcdBarrier xcd_barrier_post(unsigned* bar, volatile LAS unsigned* st) {
  XcdBarrier b; b.bar = bar; b.x = xb_xcc_id(); b.st = st;
  if (threadIdx.x == 0) (void)xb_add(&bar[XB_XCNT(b.x)], 1u);
  return b;
}
__device__ __forceinline__ void xcd_barrier_complete(unsigned* bar, unsigned x, unsigned& nloc, unsigned& nx) {
  const unsigned G = gridDim.x * gridDim.y * gridDim.z;
  unsigned sum, cnt, mine, sp = 0u;
  for (;;) {
    sum = 0u; cnt = 0u; mine = 0u;
#pragma unroll
    for (unsigned j = 0; j < 16; ++j) { const unsigned c = xb_ld(&bar[XB_XCNT(j)]); sum += c; cnt += (c > 0u) ? 1u : 0u; mine = (j == x) ? c : mine; }
    if (sum == G) break;
    __builtin_amdgcn_s_sleep(1);
    if ((++sp & 255u) == 0u) { if (xb_ld(&bar[XB_TMO])) break; if (sp > XB_SPIN_CAP) { atomicAdd(&bar[XB_TMO], 1u); break; } }
  }
  nloc = mine > 0u ? mine : 1u; nx = cnt > 0u ? cnt : 1u;
}
__device__ __forceinline__ void xcd_barrier(const XcdBarrier& b) {
  asm volatile("s_waitcnt vmcnt(0)" ::: "memory");
  __syncthreads();
  if (threadIdx.x == 0) {
    unsigned* bar = b.bar;
    __builtin_amdgcn_s_waitcnt(0);
    unsigned nloc = b.st[0], nx = b.st[1];
    if (nloc == 0u) { xcd_barrier_complete(bar, b.x, nloc, nx); b.st[0] = nloc; b.st[1] = nx; }
    const unsigned old = xb_add(&bar[XB_XSUB(b.x)], 1u);
    const unsigned gen = old / nloc;
    if (old + 1u == (gen + 1u) * nloc) {
      __builtin_amdgcn_fence(__ATOMIC_RELEASE, "agent");
      asm volatile("s_waitcnt vmcnt(0)" ::: "memory");
      const unsigned og = xb_add(&bar[XB_TOP], 1u);
      const unsigned tg = og / nx;
      if (og + 1u == (tg + 1u) * nx) xb_add(&bar[XB_TOPGEN], 1u);
      else XB_SPIN(xb_ld(&bar[XB_TOPGEN]) == tg, bar);
      __builtin_amdgcn_fence(__ATOMIC_ACQUIRE, "agent");
      xb_add(&bar[XB_XGEN(b.x)], 1u);
      asm volatile("s_waitcnt vmcnt(0)" ::: "memory");
    } else {
      XB_SPIN(xb_ld(&bar[XB_XGEN(b.x)]) == gen, bar);
      __builtin_amdgcn_fence(__ATOMIC_ACQUIRE, "agent");
      asm volatile("s_waitcnt vmcnt(0)" ::: "memory");
    }
  }
  __syncthreads();
}

namespace pg8 {
#define PG8_LAS __attribute__((address_space(3)))
typedef short bf16x8 __attribute__((ext_vector_type(8)));
typedef float f32x4 __attribute__((ext_vector_type(4)));
typedef unsigned u32x4 __attribute__((ext_vector_type(4)));
typedef unsigned u32x2 __attribute__((ext_vector_type(2)));
constexpr int BM = 256, BK = 64, HALF = 128, HTB = HALF * BK * 2, STAGE_BYTES = 8 * HTB, NXCD = 8, WGM = 8;

__host__ __device__ __forceinline__ int lds_byte(int r, int c) {
  const int st = (r >> 4) * 2 + (c >> 5), rr = r & 15, cc = c & 31, ob = rr * 64 + cc * 2;
  return st * 1024 + (ob ^ (((ob >> 9) & 1) << 5));
}
__host__ __device__ __forceinline__ void stage_rc(int b, int& R, int& C) {
  const int st = b / 1024, sb = b % 1024, swz = sb ^ (((sb >> 9) & 1) << 5);
  R = (st >> 1) * 16 + swz / 64; C = (st & 1) * 32 + (swz % 64) / 2;
}
__host__ __device__ __forceinline__ int perm32(int rho) { const int n = rho >> 4, i = rho & 15; return 8 * (i >> 2) + 4 * n + (i & 3); }

struct Unit { int pm, pn, e, mu, nv, cnt, seg; };

__device__ __forceinline__ bool static_next(int nM, int nN, int G, int c, int i, int& pm, int& pn) {
  const int nwg = nM * nN;
  const long Lx = (long)i * G + c; if (Lx >= nwg) return false;
  int wgid = (int)Lx;
  { const int q = nwg / NXCD, r = nwg % NXCD, xcd = wgid % NXCD, off = wgid / NXCD; wgid = (xcd < r ? xcd * (q + 1) : r * (q + 1) + (xcd - r) * q) + off; }
  const int nig = WGM * nN, gid = wgid / nig, fm = gid * WGM, gsz = (nM - fm) < WGM ? (nM - fm) : WGM;
  pm = fm + ((wgid % nig) % gsz); pn = (wgid % nig) / gsz; return true;
}

struct DenseOrder {
  const bf16_t* A; const bf16_t* Bt; int nM, nN, K, G, c;
  __device__ __forceinline__ bool next(int i, Unit& u) const {
    if (!static_next(nM, nN, G, c, i, u.pm, u.pn)) return false;
    u.e = 0; u.mu = 0; u.nv = 256; u.cnt = 256; u.seg = 0; return true;
  }
  __device__ __forceinline__ const char* a_base() const { return (const char*)A; }
  __device__ __forceinline__ const char* b_ptr(const Unit& u) const { return (const char*)Bt + (size_t)u.pn * 256 * K * 2; }
  __device__ __forceinline__ void a_offs(const Unit& u, const int (&R)[2], const int (&C)[2], unsigned (&ao)[2][2]) const {
#pragma unroll
    for (int h = 0; h < 2; ++h)
#pragma unroll
      for (int i = 0; i < 2; ++i) ao[h][i] = (unsigned)((u.pm * 256 + h * 128 + R[i]) * K + C[i]) * 2u;
  }
};

struct MoeOrder {
  const int* tab; const bf16_t* A; const bf16_t* Bt; const int* list; int NTn, K, G, c; bool gather;
  __device__ __forceinline__ bool next(int i, Unit& u) const {
    const int Lx = i * G + c;
    if (Lx >= tab[64] * NTn) return false;
    const int mg = Lx / NTn; u.pn = Lx - mg * NTn;
    int e = 0;
    while (tab[e + 1] <= mg) ++e;
    u.e = e; u.mu = mg - tab[e]; u.cnt = tab[130 + e]; u.seg = tab[65 + e];
    const int rem = u.cnt - u.mu * 256; u.nv = rem < 256 ? rem : 256; u.pm = 0; return true;
  }
  __device__ __forceinline__ const char* a_base() const { return (const char*)A; }
  __device__ __forceinline__ const char* b_ptr(const Unit& u) const { return (const char*)Bt + ((size_t)u.e * NTn + u.pn) * 256 * K * 2; }
  __device__ __forceinline__ void a_offs(const Unit& u, const int (&R)[2], const int (&C)[2], unsigned (&ao)[2][2]) const {
#pragma unroll
    for (int h = 0; h < 2; ++h)
#pragma unroll
      for (int i = 0; i < 2; ++i) {
        int idx = u.mu * 256 + h * 128 + R[i];
        int row;
        if (gather) { if (idx > u.cnt - 1) idx = u.cnt - 1; row = list[u.e * T + idx] >> 1; }
        else row = u.seg + idx;
        ao[h][i] = (unsigned)(row * K + C[i]) * 2u;
      }
  }
};

struct EpiBf16 {
  static constexpr bool PERM = true;
  bf16_t* O; int ldc; float* DT; const float* dt_bias;
  __device__ __forceinline__ void operator()(const f32x4 (&acc)[2][2][4][2], const Unit& u, int wr, int wc, int fr, int fq) const {
    const int row0 = u.pm * BM + wr * 64 + fr;
    if (u.pn == 12) {
      if (wc == 0 && fq < 2) {
        const f32x4 b0 = *(const f32x4*)(dt_bias + 8 * fq), b1 = *(const f32x4*)(dt_bias + 8 * fq + 4);
#pragma unroll
        for (int ai = 0; ai < 2; ++ai)
#pragma unroll
          for (int m = 0; m < 4; ++m) {
            float* dp = DT + (size_t)(row0 + ai * HALF + m * 16) * 16 + 8 * fq;
            *(f32x4*)dp = acc[ai][0][m][0] + b0; *(f32x4*)(dp + 4) = acc[ai][0][m][1] + b1;
          }
      }
      return;
    }
    const int col0 = u.pn * BM + wc * 32 + 8 * fq;
#pragma unroll
    for (int ai = 0; ai < 2; ++ai)
#pragma unroll
      for (int m = 0; m < 4; ++m) {
        bf16_t* rowp = O + (size_t)(row0 + ai * HALF + m * 16) * ldc + col0;
#pragma unroll
        for (int bj = 0; bj < 2; ++bj) {
          f32x4 v0 = acc[ai][bj][m][0], v1 = acc[ai][bj][m][1];
          u32x4 w; w.x = cvt_pk_bf16(v0[0], v0[1]); w.y = cvt_pk_bf16(v0[2], v0[3]); w.z = cvt_pk_bf16(v1[0], v1[1]); w.w = cvt_pk_bf16(v1[2], v1[3]);
          *(u32x4*)(rowp + bj * HALF) = w;
        }
      }
  }
};

struct EpiX1 {
  static constexpr bool PERM = false;
  const float* x; const float* mod; float* X1; float* SSQP;
  __device__ __forceinline__ void operator()(const f32x4 (&acc)[2][2][4][2], const Unit& u, int wr, int wc, int fr, int fq) const {
    const int row0 = u.pm * BM + wr * 64 + fr, col0 = u.pn * BM + wc * 32 + 4 * fq;
    const float* ga = mod + ((u.pm * BM) / L) * 6144 + 2048 + col0;
    f32x4 gv[2][2];
#pragma unroll
    for (int bj = 0; bj < 2; ++bj)
#pragma unroll
      for (int n = 0; n < 2; ++n) gv[bj][n] = *(const f32x4*)(ga + bj * HALF + n * 16);
#pragma unroll
    for (int ai = 0; ai < 2; ++ai)
#pragma unroll
      for (int m = 0; m < 4; ++m) {
        const size_t off = (size_t)(row0 + ai * HALF + m * 16) * D + col0;
        float ssq = 0.f;
#pragma unroll
        for (int bj = 0; bj < 2; ++bj)
#pragma unroll
          for (int n = 0; n < 2; ++n) {
            const f32x4 xv = *(const f32x4*)(x + off + bj * HALF + n * 16);
            const f32x4 o = xv + gv[bj][n] * acc[ai][bj][m][n];
            *(f32x4*)(X1 + off + bj * HALF + n * 16) = o;
            ssq += (o[0] * o[0] + o[1] * o[1]) + (o[2] * o[2] + o[3] * o[3]);
          }
        ssq += __shfl_xor(ssq, 16); ssq += __shfl_xor(ssq, 32);
        if (fq == 0) SSQP[(size_t)(row0 + ai * HALF + m * 16) * 16 + u.pn * 4 + wc] = ssq;
      }
  }
};

struct EpiSwiGLU {
  static constexpr bool PERM = true;
  bf16_t* HBb;
  __device__ __forceinline__ void operator()(const f32x4 (&acc)[2][2][4][2], const Unit& u, int wr, int wc, int fr, int fq) const {
    const int col0 = u.pn * 128 + wc * 32 + 8 * fq;
#pragma unroll
    for (int ai = 0; ai < 2; ++ai)
#pragma unroll
      for (int m = 0; m < 4; ++m) {
        const int slot = u.mu * 256 + ai * HALF + wr * 64 + m * 16 + fr;
        if (slot < u.cnt) {
          float h[8];
#pragma unroll
          for (int n = 0; n < 2; ++n)
#pragma unroll
            for (int j = 0; j < 4; ++j) { const float a = acc[ai][0][m][n][j]; h[n * 4 + j] = a / (1.f + __expf(-a)) * acc[ai][1][m][n][j]; }
          u32x4 w; w.x = cvt_pk_bf16(h[0], h[1]); w.y = cvt_pk_bf16(h[2], h[3]); w.z = cvt_pk_bf16(h[4], h[5]); w.w = cvt_pk_bf16(h[6], h[7]);
          *(u32x4*)(HBb + (size_t)(u.seg + slot) * DE + col0) = w;
        }
      }
  }
};

struct EpiDown {
  static constexpr bool PERM = true;
  bf16_t* YB2b; const int* list; const float* gate;
  __device__ __forceinline__ void operator()(const f32x4 (&acc)[2][2][4][2], const Unit& u, int wr, int wc, int fr, int fq) const {
    const int col0 = u.pn * 256 + wc * 32 + 8 * fq;
#pragma unroll
    for (int ai = 0; ai < 2; ++ai)
#pragma unroll
      for (int m = 0; m < 4; ++m) {
        const int slot = u.mu * 256 + ai * HALF + wr * 64 + m * 16 + fr;
        if (slot < u.cnt) {
          const int pair = list[u.e * T + slot];
          const float gt = gate[pair];
          bf16_t* rowp = YB2b + (size_t)pair * D + col0;
#pragma unroll
          for (int bj = 0; bj < 2; ++bj) {
            f32x4 v0 = acc[ai][bj][m][0] * gt, v1 = acc[ai][bj][m][1] * gt;
            u32x4 w; w.x = cvt_pk_bf16(v0[0], v0[1]); w.y = cvt_pk_bf16(v0[2], v0[3]); w.z = cvt_pk_bf16(v1[0], v1[1]); w.w = cvt_pk_bf16(v1[2], v1[3]);
            *(u32x4*)(rowp + bj * HALF) = w;
          }
        }
      }
  }
};

template <class Epi, class Sched>
__device__ __forceinline__ void gemm_phase(PG8_LAS unsigned char* lds, const int K, const Sched& S, const Epi& E) {
  const int tid = threadIdx.x, wid = __builtin_amdgcn_readfirstlane(tid >> 6), lane = tid & 63, wr = wid >> 2, wc = wid & 3, fr = lane & 15, fq = lane >> 4;
  const int nt = K / BK;
  int Rr[2], Cc[2];
  unsigned voffB[2];
#pragma unroll
  for (int i = 0; i < 2; ++i) {
    stage_rc(tid * 16 + i * 8192, Rr[i], Cc[i]);
    const int Rb = Epi::PERM ? ((Rr[i] & ~31) + perm32(Rr[i] & 31)) : Rr[i];
    voffB[i] = (unsigned)(Rb * K + Cc[i]) * 2u;
  }
  const size_t kstep = (size_t)(BK * 2);
  const size_t hstep = (size_t)HALF * K * 2;
  const unsigned ldsw = (unsigned)wid * 1024u;
  const int aoff = lds_byte(wr * 64 + fr, fq * 8), boff = lds_byte(wc * 32 + fr, fq * 8);
#define PG8_SA(b, h) (((b) * 2 + (h)) * HTB)
#define PG8_SB(b, h) ((4 + (b) * 2 + (h)) * HTB)
#define PG8_STAGE(bufoff, gbase, voff) do { _Pragma("unroll") for (int _i = 0; _i < 2; ++_i) \
    __builtin_amdgcn_global_load_lds((const unsigned*)((const char*)(gbase) + (voff)[_i]), (PG8_LAS unsigned*)(lds + (bufoff) + ldsw + _i * 8192), 16, 0, 0); } while (0)
#define PG8_LDA(dst, b, h) do { _Pragma("unroll") for (int m = 0; m < 4; ++m) _Pragma("unroll") for (int k = 0; k < 2; ++k) dst[m][k] = *(const PG8_LAS bf16x8*)(lds + PG8_SA(b, h) + aoff + m * 2048 + k * 1024); } while (0)
#define PG8_LDB(dst, b, h) do { _Pragma("unroll") for (int n = 0; n < 2; ++n) _Pragma("unroll") for (int k = 0; k < 2; ++k) dst[n][k] = *(const PG8_LAS bf16x8*)(lds + PG8_SB(b, h) + boff + n * 2048 + k * 1024); } while (0)
#define PG8_MMA(ai, bj, At, Bt) do { __builtin_amdgcn_s_setprio(1); _Pragma("unroll") for (int m = 0; m < 4; ++m) _Pragma("unroll") for (int n = 0; n < 2; ++n) _Pragma("unroll") for (int k = 0; k < 2; ++k) \
    acc[ai][bj][m][n] = __builtin_amdgcn_mfma_f32_16x16x32_bf16(Bt[n][k], At[m][k], acc[ai][bj][m][n], 0, 0, 0); __builtin_amdgcn_s_setprio(0); } while (0)
#define PG8_WAIT_V(n) asm volatile("s_waitcnt vmcnt(" #n ")" ::: "memory")
#define PG8_WAIT_L(n) asm volatile("s_waitcnt lgkmcnt(" #n ")" ::: "memory")
#define PG8_BAR __builtin_amdgcn_s_barrier()
#define PG8_SCHED __builtin_amdgcn_sched_barrier(0)
  Unit cur, nxt; int ui = 0;
  if (!S.next(0, cur)) return;
  f32x4 acc[2][2][4][2];
#pragma unroll
  for (int a = 0; a < 2; ++a)
#pragma unroll
    for (int b = 0; b < 2; ++b)
#pragma unroll
      for (int m = 0; m < 4; ++m)
#pragma unroll
        for (int n = 0; n < 2; ++n) acc[a][b][m][n] = (f32x4){0.f, 0.f, 0.f, 0.f};
  bf16x8 At[4][2], B0[2][2], B1[2][2];
  unsigned cao[2][2], nao[2][2];
  S.a_offs(cur, Rr, Cc, cao);
  const char* const aB = S.a_base();
  const char* cB = S.b_ptr(cur);
  PG8_STAGE(PG8_SB(0, 0), cB, voffB); PG8_STAGE(PG8_SA(0, 0), aB, cao[0]); PG8_STAGE(PG8_SB(0, 1), cB + hstep, voffB); PG8_STAGE(PG8_SA(0, 1), aB, cao[1]);
  if (wr == 1) PG8_BAR;
  PG8_WAIT_V(4); PG8_BAR;
  PG8_STAGE(PG8_SB(1, 0), cB + kstep, voffB); PG8_STAGE(PG8_SA(1, 0), aB + kstep, cao[0]); PG8_STAGE(PG8_SB(1, 1), cB + hstep + kstep, voffB);
  PG8_WAIT_V(6); PG8_BAR;
  for (;;) {
    const bool has_next = S.next(ui + 1, nxt);
    const char* nB = cB;
    if (has_next) { S.a_offs(nxt, Rr, Cc, nao); nB = S.b_ptr(nxt); }
    else {
#pragma unroll
      for (int h = 0; h < 2; ++h)
#pragma unroll
        for (int i = 0; i < 2; ++i) nao[h][i] = cao[h][i];
    }
    const bool full = cur.nv > 128;
    for (int t = 0; t < nt; t += 2) {
      const bool last = (t == nt - 2);
      const char* a1 = aB + (size_t)(t + 1) * kstep;
      const char* a2 = last ? aB : aB + (size_t)(t + 2) * kstep; const char* b2 = last ? nB : cB + (size_t)(t + 2) * kstep;
      const char* a3 = a2 + kstep; const char* b3 = b2 + kstep;
      unsigned so[2][2];
#pragma unroll
      for (int h = 0; h < 2; ++h)
#pragma unroll
        for (int i = 0; i < 2; ++i) so[h][i] = last ? nao[h][i] : cao[h][i];
      PG8_LDB(B0, 0, 0); PG8_SCHED; PG8_LDA(At, 0, 0); PG8_STAGE(PG8_SA(1, 1), a1, cao[1]);
      PG8_WAIT_L(8); PG8_BAR; PG8_WAIT_L(0); PG8_MMA(0, 0, At, B0); PG8_BAR; PG8_SCHED;
      PG8_LDB(B1, 0, 1); PG8_STAGE(PG8_SB(0, 0), b2, voffB);
      PG8_BAR; PG8_WAIT_L(0); PG8_MMA(0, 1, At, B1); PG8_BAR;
      PG8_LDA(At, 0, 1); PG8_STAGE(PG8_SA(0, 0), a2, so[0]);
      PG8_BAR; PG8_WAIT_L(0); if (full) PG8_MMA(1, 0, At, B0); PG8_BAR; PG8_SCHED;
      PG8_STAGE(PG8_SB(0, 1), b2 + hstep, voffB);
      PG8_WAIT_V(6); PG8_BAR; if (full) PG8_MMA(1, 1, At, B1); PG8_BAR;
      PG8_LDB(B0, 1, 0); PG8_SCHED; PG8_LDA(At, 1, 0); PG8_STAGE(PG8_SA(0, 1), a2, so[1]);
      PG8_WAIT_L(8); PG8_BAR; PG8_WAIT_L(0); PG8_MMA(0, 0, At, B0); PG8_BAR; PG8_SCHED;
      PG8_LDB(B1, 1, 1); PG8_STAGE(PG8_SB(1, 0), b3, voffB);
      PG8_BAR; PG8_WAIT_L(0); PG8_MMA(0, 1, At, B1); PG8_BAR;
      PG8_LDA(At, 1, 1); PG8_STAGE(PG8_SA(1, 0), a3, so[0]);
      PG8_BAR; PG8_WAIT_L(0); if (full) PG8_MMA(1, 0, At, B0); PG8_BAR; PG8_SCHED;
      PG8_STAGE(PG8_SB(1, 1), b3 + hstep, voffB);
      PG8_WAIT_V(6); PG8_BAR; if (full) PG8_MMA(1, 1, At, B1); PG8_BAR;
    }
    E(acc, cur, wr, wc, fr, fq);
    if (!has_next) break;
#pragma unroll
    for (int a = 0; a < 2; ++a)
#pragma unroll
      for (int b = 0; b < 2; ++b)
#pragma unroll
        for (int m = 0; m < 4; ++m)
#pragma unroll
          for (int n = 0; n < 2; ++n) acc[a][b][m][n] = (f32x4){0.f, 0.f, 0.f, 0.f};
    cur = nxt; cB = nB; ++ui;
#pragma unroll
    for (int h = 0; h < 2; ++h)
#pragma unroll
      for (int i = 0; i < 2; ++i) cao[h][i] = nao[h][i];
  }
  PG8_WAIT_V(0);
  if (wr == 0) PG8_BAR;
  PG8_BAR;
#undef PG8_SA
#undef PG8_SB
#undef PG8_STAGE
#undef PG8_LDA
#undef PG8_LDB
#undef PG8_MMA
#undef PG8_WAIT_V
#undef PG8_WAIT_L
#undef PG8_BAR
#undef PG8_SCHED
}
}

__device__ void ph_adaln(const Params& p, float* sm) {
  const int tid = threadIdx.x;
  if (blockIdx.x == 0 && tid < NE) p.CNT[tid] = 0;
  for (int e = blockIdx.x * NTHR + tid; e < 96 * 1024; e += gridDim.x * NTHR) {
    const int j = e >> 10, k = e & 1023;
    float w = 0.f;
    if (j < 64) w = p.w_expert[k * 64 + j]; else if (j < 72) w = p.w_group[k * 8 + (j - 64)];
    const unsigned hi = cvt_pk_bf16(w, 0.f) & 0xffffu;
    const float rem = w - __uint_as_float(hi << 16);
    p.WRhi[e] = (bf16_t)hi; p.WRlo[e] = (bf16_t)(cvt_pk_bf16(rem, 0.f) & 0xffffu);
  }
  float* sc = sm;
  float* red = sm + 9 * 1024;
  for (int e = tid; e < 9 * 1024; e += NTHR) {
    const int r = e >> 10, k = e & 1023;
    sc[e] = silu_f(r < 8 ? p.c[r * D + k] : p.c_ctx[k]);
  }
  __syncthreads();
  for (int item = blockIdx.x; item < 192; item += gridDim.x) {
    const int col0 = item * 32;
    const int kq = tid >> 3, c4 = (tid & 7) * 4;
    float acc[9][4];
#pragma unroll
    for (int r = 0; r < 9; ++r)
#pragma unroll
      for (int j = 0; j < 4; ++j) acc[r][j] = 0.f;
#pragma unroll 4
    for (int i = 0; i < 16; ++i) {
      const int k = kq + i * 64;
      const float4 w = *(const float4*)(p.w_ada + (size_t)k * 6144 + col0 + c4);
#pragma unroll
      for (int r = 0; r < 9; ++r) {
        const float sv = sc[r * 1024 + k];
        acc[r][0] += sv * w.x; acc[r][1] += sv * w.y; acc[r][2] += sv * w.z; acc[r][3] += sv * w.w;
      }
    }
#pragma unroll
    for (int r = 0; r < 9; ++r)
#pragma unroll
      for (int j = 0; j < 4; ++j) red[kq * 292 + r * 32 + c4 + j] = acc[r][j];
    __syncthreads();
    if (tid < 288) {
      float a = 0.f;
      for (int q = 0; q < 64; ++q) a += red[q * 292 + tid];
      const int r = tid >> 5, j = tid & 31;
      p.MOD[r * 6144 + col0 + j] = a + p.b_ada[col0 + j];
    }
    __syncthreads();
  }
}

__device__ void ph_filters(const Params& p, float* sm) {
  const int tid = threadIdx.x, wid = tid >> 6, lane = tid & 63;
  float* feats = sm;
  float* h1 = sm + 64 * 20;
  float* h2 = h1 + 64 * 64;
  bf16_t* tile = (bf16_t*)(h2 + 64 * 64);
  for (int e = blockIdx.x * NTHR + tid; e < 1024 * 137; e += gridDim.x * NTHR) {
    int rowi = e / 137, k = e - rowi * 137;
    int x = (k < 65) ? k : (4160 + (k - 65));
    p.FILTt[(size_t)rowi * FLEN + x] = 0;
  }
  for (int item = blockIdx.x; item < 256; item += gridDim.x) {
    const int tt = item >> 3, ct = item & 7;
    for (int e = tid; e < 64 * 17; e += NTHR) {
      int tp = e / 17, i = e - tp * 17;
      int t = tt * 64 + tp;
      float f;
      if (i == 0) f = (float)t / (float)(L - 1);
      else {
        int bi = (i - 1) & 7;
        float bandf = (float)(1e-4 + (double)bi * ((7.0 - 1e-4) / 7.0));
        float ang = (float)(2.0 * 3.14159265358979323846 / (double)L) * (float)t * bandf;
        f = (i <= 8) ? cosf(ang) : -sinf(ang);
      }
      feats[tp * 20 + i] = f;
    }
    __syncthreads();
    for (int e = tid; e < 4096; e += NTHR) {
      int tp = e >> 6, j = e & 63;
      float a = p.f_b1[j];
      for (int i = 0; i < 17; ++i) a += feats[tp * 20 + i] * p.f_w1[i * 64 + j];
      h1[e] = sinf(p.f_freq[j] * a);
    }
    __syncthreads();
    for (int e = tid; e < 4096; e += NTHR) {
      int tp = e >> 6, j = e & 63;
      float a = p.f_b2[j];
      for (int i = 0; i < 64; ++i) a += h1[tp * 64 + i] * p.f_w2[i * 64 + j];
      h2[e] = sinf(p.f_freq[j] * a);
    }
    __syncthreads();
    {
      const int col = tid & 255, half = tid >> 8;
      const int gcol = ct * 256 + col;
      float acc[32];
#pragma unroll
      for (int k = 0; k < 32; ++k) acc[k] = 0.f;
      for (int i = 0; i < 64; ++i) {
        float w = p.f_w3[i * 2048 + gcol];
#pragma unroll
        for (int k = 0; k < 32; ++k) acc[k] += h2[(half * 32 + k) * 64 + i] * w;
      }
      const int cch = gcol & 511;
      const float d0 = -4.605170185988091f / 1.5f, d1 = -4.605170185988091f / 0.3f;
      const float delta = fabsf(d0 + (float)cch * ((d1 - d0) / 511.f));
#pragma unroll
      for (int k = 0; k < 32; ++k) {
        int t = tt * 64 + half * 32 + k;
        float tn = (float)t / (float)(L - 1);
        tile[col * 66 + half * 32 + k] = f2bf(acc[k] * expf(-tn * delta));
      }
    }
    __syncthreads();
    for (int cl = wid * 32; cl < wid * 32 + 32; ++cl) {
      const int gcol = ct * 256 + cl;
      const int o = gcol >> 10, dir = (gcol >> 9) & 1, cch = gcol & 511;
      const int t = tt * 64 + lane;
      const int x = dir ? (HX0 + t) : (HX0 - t);
      if (!(dir && t == 0)) p.FILTt[(size_t)(o * 512 + cch) * FLEN + x] = tile[cl * 66 + lane];
    }
    __syncthreads();
  }
}

__device__ __forceinline__ void cvt_tile256(const float* src, int ld, int k0, int n0, bf16_t* dst, int ldd, int dmap0, int dmap1, int nsplit, float* sm) {
  const int tid = threadIdx.x;
  float* ts = sm;
  float4 v[8];
#pragma unroll
  for (int i = 0; i < 8; ++i) {
    const int e = tid + i * NTHR; const int k = e >> 6, n4 = (e & 63) * 4;
    v[i] = *(const float4*)(src + (size_t)(k0 + k) * ld + n0 + n4);
  }
#pragma unroll
  for (int i = 0; i < 8; ++i) {
    const int e = tid + i * NTHR; const int k = e >> 6, n4 = (e & 63) * 4;
    ts[k * 257 + n4 + 0] = v[i].x; ts[k * 257 + n4 + 1] = v[i].y; ts[k * 257 + n4 + 2] = v[i].z; ts[k * 257 + n4 + 3] = v[i].w;
  }
  __syncthreads();
#pragma unroll
  for (int i = 0; i < 4; ++i) {
    const int e = tid + i * NTHR; const int n = e >> 3, kq = (e & 7) * 8;
    uint4 w;
    w.x = cvt_pk_bf16(ts[(kq + 0) * 257 + n], ts[(kq + 1) * 257 + n]);
    w.y = cvt_pk_bf16(ts[(kq + 2) * 257 + n], ts[(kq + 3) * 257 + n]);
    w.z = cvt_pk_bf16(ts[(kq + 4) * 257 + n], ts[(kq + 5) * 257 + n]);
    w.w = cvt_pk_bf16(ts[(kq + 6) * 257 + n], ts[(kq + 7) * 257 + n]);
    const int drow = (n < nsplit) ? (dmap0 + n) : (dmap1 + (n - nsplit));
    *(uint4*)(dst + (size_t)drow * ldd + k0 + kq) = w;
  }
  __syncthreads();
}

__device__ void ph_wcvt(const Params& p, float* sm) {
  for (int e = blockIdx.x * NTHR + threadIdx.x; e < 16 * 1024; e += gridDim.x * NTHR) {
    const int j = e >> 10, k = e & 1023;
    p.WinT[(size_t)(DP + j) * D + k] = f2bf(p.w_in[(size_t)k * DIN + COL_DT + j]);
  }
  for (int it = blockIdx.x; it < 192 + 64 + 64 * 96; it += gridDim.x) {
    if (it < 192) { const int kt = it / 12, nt = it - kt * 12; cvt_tile256(p.w_in, DIN, kt * 64, nt * 256, p.WinT, D, nt * 256, 0, 256, sm); }
    else if (it < 256) { const int i = it - 192; const int kt = i >> 2, nt = i & 3; cvt_tile256(p.w_out, D, kt * 64, nt * 256, p.WoutT, D, nt * 256, 0, 256, sm); }
    else {
      const int i = it - 256; const int e = i / 96, r = i - e * 96;
      if (r < 64) {
        const int which = r >> 5, r2 = r & 31; const int kt = r2 >> 1, nt = r2 & 1;
        const float* src = (which ? p.w3 : p.w1) + (size_t)e * D * DE;
        const int c0 = nt * 256;
        cvt_tile256(src, DE, kt * 64, c0, p.Wup + (size_t)e * 1024 * 1024, D, (c0 >> 7) * 256 + which * 128, ((c0 >> 7) + 1) * 256 + which * 128, 128, sm);
      } else {
        const int r2 = r - 64; const int kt = r2 >> 2, nt = r2 & 3;
        cvt_tile256(p.w2 + (size_t)e * DE * D, D, kt * 64, nt * 256, p.Wdn + (size_t)e * 1024 * 512, DE, nt * 256, 0, 256, sm);
      }
    }
  }
}

__device__ void ph_norm1(const Params& p) {
  const int tid = threadIdx.x, wid = tid >> 6, lane = tid & 63;
  for (int row = blockIdx.x * 8 + wid; row < TT; row += gridDim.x * 8) {
    const float* src = (row < T) ? (p.x + (size_t)row * D) : (p.ctx + (size_t)(row - T) * D);
    const int mr = (row < T) ? (row / L) : 8;
    const float* sh = p.MOD + mr * 6144;
    const float* sc = sh + 1024;
    float4 v[4];
    float ss = 0.f;
#pragma unroll
    for (int i = 0; i < 4; ++i) {
      v[i] = *(const float4*)(src + i * 256 + lane * 4);
      ss += v[i].x * v[i].x + v[i].y * v[i].y + v[i].z * v[i].z + v[i].w * v[i].w;
    }
    ss = wave_sum(ss);
    const float rstd = rsqrtf(ss * (1.f / D) + EPS);
#pragma unroll
    for (int i = 0; i < 4; ++i) {
      const int col = i * 256 + lane * 4;
      float4 g = *(const float4*)(p.g1 + col);
      float4 s4 = *(const float4*)(sc + col);
      float4 h4 = *(const float4*)(sh + col);
      float4 o;
      o.x = v[i].x * rstd * g.x * (1.f + s4.x) + h4.x;
      o.y = v[i].y * rstd * g.y * (1.f + s4.y) + h4.y;
      o.z = v[i].z * rstd * g.z * (1.f + s4.z) + h4.z;
      o.w = v[i].w * rstd * g.w * (1.f + s4.w) + h4.w;
      uint2 w; w.x = cvt_pk_bf16(o.x, o.y); w.y = cvt_pk_bf16(o.z, o.w);
      *(uint2*)(p.XNb + (size_t)row * D + col) = w;
    }
  }
}

__device__ void ph_hy_convT(const Params& p, float* sm) {
  const int tid = threadIdx.x;
  float* tile = sm;
  const int bid = blockIdx.x;
  int it0, it1;
  if (gridDim.x == 256) { if (bid < 32) { it0 = bid * 3; it1 = it0 + 3; } else { it0 = 96 + (bid - 32) * 27; it1 = it0 + 27; } }
  else { const int per = (256 * 24 + gridDim.x - 1) / gridDim.x; it0 = bid * per; it1 = it0 + per; if (it1 > 256 * 24) it1 = 256 * 24; }
  for (int item = it0; item < it1; ++item) {
    const int gr = item / 24, ct = item - gr * 24;
    const int row0 = gr * 64;
    {
      const int t = tid >> 3, c8 = (tid & 7) * 8;
      uint4 v = *(const uint4*)(p.PXb + (size_t)(row0 + t) * DP + ct * 64 + c8);
      unsigned w[4] = {v.x, v.y, v.z, v.w};
#pragma unroll
      for (int k = 0; k < 4; ++k) {
        tile[t * 65 + c8 + 2 * k] = __uint_as_float(w[k] << 16);
        tile[t * 65 + c8 + 2 * k + 1] = __uint_as_float(w[k] & 0xffff0000u);
      }
    }
    __syncthreads();
    {
      const int cc = tid >> 3, t8 = (tid & 7) * 8;
      const int col = ct * 64 + cc;
      const float w0 = p.hy_conv_w[col], w1 = p.hy_conv_w[HYC + col], w2 = p.hy_conv_w[2 * HYC + col], bb = p.hy_conv_b[col];
      float o[8];
#pragma unroll
      for (int k = 0; k < 8; ++k) {
        const int t = t8 + k;
        float v = bb + w1 * tile[t * 65 + cc];
        if (t > 0) v += w0 * tile[(t - 1) * 65 + cc];
        if (t < 63) v += w2 * tile[(t + 1) * 65 + cc];
        o[k] = v;
      }
      uint4 w; w.x = cvt_pk_bf16(o[0], o[1]); w.y = cvt_pk_bf16(o[2], o[3]); w.z = cvt_pk_bf16(o[4], o[5]); w.w = cvt_pk_bf16(o[6], o[7]);
      *(uint4*)(p.Ut + (size_t)col * T + row0 + t8) = w;
    }
    __syncthreads();
  }
}

__device__ void ph_hy_backT(const Params& p, float* sm) {
  const int tid = threadIdx.x;
  bf16_t* tile = (bf16_t*)sm;
  for (int item = blockIdx.x; item < 256 * 8; item += gridDim.x) {
    const int gr = item >> 3, ct = item & 7;
    const int row0 = gr * 64;
    {
      const int cc = tid >> 3, r8 = (tid & 7) * 8;
      uint4 v = *(const uint4*)(p.Yt + (size_t)(ct * 64 + cc) * T + row0 + r8);
      unsigned w[4] = {v.x, v.y, v.z, v.w};
#pragma unroll
      for (int k = 0; k < 4; ++k) {
        tile[cc * 66 + r8 + 2 * k] = (bf16_t)(w[k] & 0xffffu);
        tile[cc * 66 + r8 + 2 * k + 1] = (bf16_t)(w[k] >> 16);
      }
    }
    __syncthreads();
    {
      const int r = tid >> 3, c8 = (tid & 7) * 8;
      unsigned w[4];
#pragma unroll
      for (int k = 0; k < 4; ++k) w[k] = (unsigned)tile[(c8 + 2 * k) * 66 + r] | ((unsigned)tile[(c8 + 2 * k + 1) * 66 + r] << 16);
      uint4 o; o.x = w[0]; o.y = w[1]; o.z = w[2]; o.w = w[3];
      *(uint4*)(p.YMIXb + (size_t)(row0 + r) * D + ct * 64 + c8) = o;
    }
    __syncthreads();
  }
}

typedef short hbf16x8 __attribute__((ext_vector_type(8)));
typedef float hf32x4 __attribute__((ext_vector_type(4)));

constexpr int HY_FC = 0, HY_ZT0 = 4 * FCLEN * 2, HY_ZT1 = HY_ZT0 + 8 * ZSTRB;

__device__ __forceinline__ void hy_build_filter(const Params& p, int o, int c, unsigned char* lds) {
  const int tid = threadIdx.x;
  const bf16_t* gsrc = p.FILTt + (size_t)(o * 512 + c) * FLEN;
  for (int e = tid; e < 530; e += NTHR) {
    uint4 v = make_uint4(0u, 0u, 0u, 0u);
    if (e < 529) v = *(const uint4*)(gsrc + e * 8);
    *(uint4*)(lds + HY_FC + e * 16) = v;
  }
  __syncthreads();
  for (int g = tid; g < 3 * 530; g += NTHR) {
    const int r = 1 + g / 530, ch = g % 530;
    uint4 lo = make_uint4(0u, 0u, 0u, 0u);
    if (ch > 0) lo = *(const uint4*)(lds + HY_FC + (ch - 1) * 16);
    uint4 hi = *(const uint4*)(lds + HY_FC + ch * 16);
    unsigned W[8] = {lo.x, lo.y, lo.z, lo.w, hi.x, hi.y, hi.z, hi.w};
    uint4 ov;
    if (r == 1) {
      ov.x = __builtin_amdgcn_alignbyte(W[4], W[3], 2); ov.y = __builtin_amdgcn_alignbyte(W[5], W[4], 2);
      ov.z = __builtin_amdgcn_alignbyte(W[6], W[5], 2); ov.w = __builtin_amdgcn_alignbyte(W[7], W[6], 2);
    } else if (r == 2) {
      ov.x = W[3]; ov.y = W[4]; ov.z = W[5]; ov.w = W[6];
    } else {
      ov.x = __builtin_amdgcn_alignbyte(W[3], W[2], 2); ov.y = __builtin_amdgcn_alignbyte(W[4], W[3], 2);
      ov.z = __builtin_amdgcn_alignbyte(W[5], W[4], 2); ov.w = __builtin_amdgcn_alignbyte(W[6], W[5], 2);
    }
    *(uint4*)(lds + HY_FC + r * (FCLEN * 2) + ch * 16) = ov;
  }
  __syncthreads();
}

__device__ __forceinline__ void hy_order(const Params& p, int o, int c, unsigned char* lds) {
  const int tid = threadIdx.x, wid = __builtin_amdgcn_readfirstlane(tid >> 6), lane = tid & 63;
  const int g0 = wid * 4;
  const int n16 = lane & 15, h = lane >> 4, bb = n16 & 7, pp = n16 >> 3;
  const unsigned char* Zin = lds + (o ? HY_ZT1 : HY_ZT0);
  const bf16_t* gate = p.Ut + (size_t)((o + 1) * 512 + c) * T + bb * L;
  uint2 xg[4][2];
#pragma unroll
  for (int i = 0; i < 4; ++i)
#pragma unroll
    for (int u = 0; u < 2; ++u) xg[i][u] = *(const uint2*)(gate + 32 * (2 * (g0 + i) + pp) + 16 * u + 4 * h);
  const float bias = p.hy_bias[o * 512 + c];
  hf32x4 acc[4][2];
#pragma unroll
  for (int i = 0; i < 4; ++i)
#pragma unroll
    for (int u = 0; u < 2; ++u) acc[i][u] = (hf32x4){0.f, 0.f, 0.f, 0.f};
  const int ai = lane & 15, ar = ai & 3, aq = ai >> 2;
  const unsigned char* laneA = lds + HY_FC + ar * (FCLEN * 2) + 2 * (HX0 - 4 * aq + 8 * h);
  const unsigned char* laneB = Zin + bb * ZSTRB + 64 + 64 * pp + 16 * h;
#define HY_LDA(dst, Dd) do { const uint2 _lo = *(const uint2*)(laneA - 32 * (Dd)); const uint2 _hi = *(const uint2*)(laneA - 32 * (Dd) + 8); \
    union { uint4 u4; hbf16x8 v; } _cv; _cv.u4 = make_uint4(_lo.x, _lo.y, _hi.x, _hi.y); dst = _cv.v; } while (0)
#define HY_LDB(dst, Qq) do { dst = *(const hbf16x8*)(laneB + 64 * (Qq)); } while (0)
#pragma unroll 1
  for (int pass = 0; pass < 2; ++pass) {
    const int Es = 2 * g0 - 63 + pass;
    hbf16x8 R[4];
    HY_LDB(R[1], 2 * (g0 + 1) - Es); HY_LDB(R[2], 2 * (g0 + 2) - Es); HY_LDB(R[3], 2 * (g0 + 3) - Es);
#pragma unroll 1
    for (int n4 = 0; n4 < 9; ++n4) {
#pragma unroll
      for (int j = 0; j < 4; ++j) {
        const int n = n4 * 4 + j;
        const int E = Es + 2 * n;
        HY_LDB(R[(4 - j) & 3], 2 * (g0 - n) - Es);
        hbf16x8 A0, A1;
        HY_LDA(A0, 2 * E); HY_LDA(A1, 2 * E + 1);
#pragma unroll
        for (int i = 0; i < 4; ++i) {
          const int Q = 2 * (g0 + i - n) - Es;
          if (Q >= -1 && Q <= 63) {
            acc[i][0] = __builtin_amdgcn_mfma_f32_16x16x32_bf16(A0, R[(i - j) & 3], acc[i][0], 0, 0, 0);
            acc[i][1] = __builtin_amdgcn_mfma_f32_16x16x32_bf16(A1, R[(i - j) & 3], acc[i][1], 0, 0, 0);
          }
        }
      }
    }
  }
#undef HY_LDA
#undef HY_LDB
#pragma unroll
  for (int i = 0; i < 4; ++i)
#pragma unroll
    for (int u = 0; u < 2; ++u) {
      const int t0 = 32 * (2 * (g0 + i) + pp) + 16 * u + 4 * h;
      const uint2 zv = *(const uint2*)(Zin + bb * ZSTRB + 64 + 2 * t0);
      const float z0 = __uint_as_float(zv.x << 16), z1 = __uint_as_float(zv.x & 0xffff0000u), z2 = __uint_as_float(zv.y << 16), z3 = __uint_as_float(zv.y & 0xffff0000u);
      const float x0 = __uint_as_float(xg[i][u].x << 16), x1 = __uint_as_float(xg[i][u].x & 0xffff0000u), x2 = __uint_as_float(xg[i][u].y << 16), x3 = __uint_as_float(xg[i][u].y & 0xffff0000u);
      const float r0 = x0 * (acc[i][u][0] + z0 * bias), r1 = x1 * (acc[i][u][1] + z1 * bias), r2 = x2 * (acc[i][u][2] + z2 * bias), r3 = x3 * (acc[i][u][3] + z3 * bias);
      uint2 w; w.x = cvt_pk_bf16(r0, r1); w.y = cvt_pk_bf16(r2, r3);
      if (o == 0) *(uint2*)(lds + HY_ZT1 + bb * ZSTRB + 64 + 2 * t0) = w;
      else *(uint2*)(p.Yt + (size_t)c * T + bb * L + t0) = w;
    }
}

__device__ void hyena_unit(const Params& p, int c, unsigned char* lds) {
  const int tid = threadIdx.x;
  if (tid < 144) {
    const int buf = tid / 72, rem = tid % 72, b = rem / 9, k = rem % 9;
    const int off = (k < 4) ? (k * 16) : (4160 + (k - 4) * 16);
    *(uint4*)(lds + (buf ? HY_ZT1 : HY_ZT0) + b * ZSTRB + off) = make_uint4(0u, 0u, 0u, 0u);
  }
  for (int e = tid; e < 2048; e += NTHR) {
    const int b = e >> 8, ch = e & 255;
    *(uint4*)(lds + HY_ZT0 + b * ZSTRB + 64 + ch * 16) = *(const uint4*)(p.Ut + (size_t)c * T + b * L + ch * 8);
  }
#pragma unroll 1
  for (int o = 0; o < 2; ++o) {
    hy_build_filter(p, o, c, lds);
    hy_order(p, o, c, lds);
    __syncthreads();
  }
}

constexpr int SROW = 272;

__device__ __forceinline__ void ssd_stage_nat(const Params& p, int row0, int pxcol0, int cvcol0, unsigned char* dst) {
  for (int e = threadIdx.x; e < 2048; e += NTHR) {
    const int l = e >> 4, cg = e & 15;
    const int row = row0 + l, li = row & 63;
    const bf16_t* src = p.PXb + (size_t)row * DP + pxcol0 + cg * 8;
    const uint4 zero4 = make_uint4(0u, 0u, 0u, 0u);
    const uint4 cur = *(const uint4*)src;
    const uint4 prv = (li > 0) ? *(const uint4*)(src - DP) : zero4;
    const uint4 nxt = (li < 63) ? *(const uint4*)(src + DP) : zero4;
    const float* cw = p.ssd_conv_w + cvcol0 + cg * 8;
    const float* cb = p.ssd_conv_b + cvcol0 + cg * 8;
    const unsigned pc[4] = {prv.x, prv.y, prv.z, prv.w}, cc[4] = {cur.x, cur.y, cur.z, cur.w}, nc[4] = {nxt.x, nxt.y, nxt.z, nxt.w};
    float o[8];
#pragma unroll
    for (int k = 0; k < 4; ++k) {
      const float p0 = __uint_as_float(pc[k] << 16), p1 = __uint_as_float(pc[k] & 0xffff0000u);
      const float c0 = __uint_as_float(cc[k] << 16), c1 = __uint_as_float(cc[k] & 0xffff0000u);
      const float n0 = __uint_as_float(nc[k] << 16), n1 = __uint_as_float(nc[k] & 0xffff0000u);
      const float v0 = cb[2 * k] + cw[2 * k] * p0 + cw[DXBC + 2 * k] * c0 + cw[2 * DXBC + 2 * k] * n0;
      const float v1 = cb[2 * k + 1] + cw[2 * k + 1] * p1 + cw[DXBC + 2 * k + 1] * c1 + cw[2 * DXBC + 2 * k + 1] * n1;
      o[2 * k] = silu_f(v0); o[2 * k + 1] = silu_f(v1);
    }
    uint4 w; w.x = cvt_pk_bf16(o[0], o[1]); w.y = cvt_pk_bf16(o[2], o[3]); w.z = cvt_pk_bf16(o[4], o[5]); w.w = cvt_pk_bf16(o[6], o[7]);
    *(uint4*)(dst + l * SROW + cg * 16) = w;
  }
}

__device__ __forceinline__ void ssd_stage_tr(const Params& p, int row0, bool is_ctx, int pxcol0, int cvcol0, int ncols, unsigned char* dst) {
  const int ncg = ncols >> 2;
  for (int e = threadIdx.x; e < ncg * 16; e += NTHR) {
    const int cg = e % ncg, l8 = e / ncg;
    const int rowf = row0 + l8 * 8;
    bool has_prev, has_next;
    if (is_ctx) { const int tc = (rowf - T) & (LC - 1); has_prev = tc > 0; has_next = tc + 7 < LC - 1; }
    else { const int li = rowf & 63; has_prev = li > 0; has_next = li + 7 < 63; }
    const bf16_t* src = p.PXb + (size_t)rowf * DP + pxcol0 + cg * 4;
    const uint2 z2 = make_uint2(0u, 0u);
    uint2 raw[10];
    raw[0] = *(const uint2*)((cvcol0 >= 0 && has_prev) ? (src - DP) : src);
    if (!(cvcol0 >= 0 && has_prev)) raw[0] = z2;
#pragma unroll
    for (int k = 0; k < 8; ++k) raw[k + 1] = *(const uint2*)(src + (size_t)k * DP);
    raw[9] = *(const uint2*)((cvcol0 >= 0 && has_next) ? (src + (size_t)8 * DP) : src);
    if (!(cvcol0 >= 0 && has_next)) raw[9] = z2;
    unsigned outw[4][4];
    if (cvcol0 >= 0) {
      const float* cw = p.ssd_conv_w + cvcol0 + cg * 4; const float* cb = p.ssd_conv_b + cvcol0 + cg * 4;
      const float4 a0 = *(const float4*)cw, b0 = *(const float4*)(cw + DXBC), c0 = *(const float4*)(cw + 2 * DXBC), d0 = *(const float4*)cb;
      const float w0[4] = {a0.x, a0.y, a0.z, a0.w}, w1[4] = {b0.x, b0.y, b0.z, b0.w}, w2[4] = {c0.x, c0.y, c0.z, c0.w}, bb[4] = {d0.x, d0.y, d0.z, d0.w};
#pragma unroll
      for (int kp = 0; kp < 4; ++kp) {
#pragma unroll
        for (int c = 0; c < 4; ++c) {
          const unsigned q0 = (c >> 1) ? raw[2 * kp].y : raw[2 * kp].x, q1 = (c >> 1) ? raw[2 * kp + 1].y : raw[2 * kp + 1].x;
          const unsigned q2 = (c >> 1) ? raw[2 * kp + 2].y : raw[2 * kp + 2].x, q3 = (c >> 1) ? raw[2 * kp + 3].y : raw[2 * kp + 3].x;
          float x0, x1, x2, x3;
          if (c & 1) { x0 = __uint_as_float(q0 & 0xffff0000u); x1 = __uint_as_float(q1 & 0xffff0000u); x2 = __uint_as_float(q2 & 0xffff0000u); x3 = __uint_as_float(q3 & 0xffff0000u); }
          else { x0 = __uint_as_float(q0 << 16); x1 = __uint_as_float(q1 << 16); x2 = __uint_as_float(q2 << 16); x3 = __uint_as_float(q3 << 16); }
          const float oa = silu_f(bb[c] + w0[c] * x0 + w1[c] * x1 + w2[c] * x2);
          const float ob = silu_f(bb[c] + w0[c] * x1 + w1[c] * x2 + w2[c] * x3);
          outw[c][kp] = cvt_pk_bf16(oa, ob);
        }
      }
    } else {
#pragma unroll
      for (int kp = 0; kp < 4; ++kp) {
#pragma unroll
        for (int c = 0; c < 4; ++c) {
          const unsigned q1 = (c >> 1) ? raw[2 * kp + 1].y : raw[2 * kp + 1].x, q2 = (c >> 1) ? raw[2 * kp + 2].y : raw[2 * kp + 2].x;
          outw[c][kp] = (c & 1) ? ((q1 >> 16) | (q2 & 0xffff0000u)) : ((q1 & 0xffffu) | (q2 << 16));
        }
      }
    }
#pragma unroll
    for (int c = 0; c < 4; ++c)
      *(uint4*)(dst + (cg * 4 + c) * SROW + l8 * 16) = make_uint4(outw[c][0], outw[c][1], outw[c][2], outw[c][3]);
  }
}

__device__ __forceinline__ void ssd_stage_tr_s(const Params& p, int row0, bool is_ctx, int pxcol0, int cvcol0, int ncols, unsigned char* dst) {
  for (int e = threadIdx.x; e < ncols * 16; e += NTHR) {
    const int col = e & (ncols - 1), l8 = e / ncols;
    const int rowf = row0 + l8 * 8;
    bool has_prev, has_next;
    if (is_ctx) { const int tc = (rowf - T) & (LC - 1); has_prev = tc > 0; has_next = tc + 7 < LC - 1; }
    else { const int li = rowf & 63; has_prev = li > 0; has_next = li + 7 < 63; }
    const bf16_t* src = p.PXb + (size_t)rowf * DP + pxcol0 + col;
    float x[10];
    x[0] = (cvcol0 >= 0 && has_prev) ? bf2f(src[-DP]) : 0.f;
#pragma unroll
    for (int k = 0; k < 8; ++k) x[k + 1] = bf2f(src[(size_t)k * DP]);
    x[9] = (cvcol0 >= 0 && has_next) ? bf2f(src[(size_t)8 * DP]) : 0.f;
    float o[8];
    if (cvcol0 >= 0) {
      const float w0 = p.ssd_conv_w[cvcol0 + col], w1 = p.ssd_conv_w[DXBC + cvcol0 + col], w2 = p.ssd_conv_w[2 * DXBC + cvcol0 + col], bb = p.ssd_conv_b[cvcol0 + col];
#pragma unroll
      for (int k = 0; k < 8; ++k) o[k] = silu_f(bb + w0 * x[k] + w1 * x[k + 1] + w2 * x[k + 2]);
    } else {
#pragma unroll
      for (int k = 0; k < 8; ++k) o[k] = x[k + 1];
    }
    uint4 w; w.x = cvt_pk_bf16(o[0], o[1]); w.y = cvt_pk_bf16(o[2], o[3]); w.z = cvt_pk_bf16(o[4], o[5]); w.w = cvt_pk_bf16(o[6], o[7]);
    *(uint4*)(dst + col * SROW + l8 * 16) = w;
  }
}

__device__ void ssd_states_unit(const Params& p, int unit, unsigned char* lds) {
  const int tid = threadIdx.x, wid = __builtin_amdgcn_readfirstlane(tid >> 6), lane = tid & 63;
  const int g = unit & 1, bc = unit >> 1, cidx = bc % 18, b = bc / 18;
  const bool is_ctx = cidx < 2;
  const int row0 = is_ctx ? (T + b * LC + cidx * 128) : (b * L + (cidx - 2) * 128);
  unsigned char* XT = lds;
  unsigned char* BT = lds + 69632;
  unsigned char* XD = lds + 104448;
  float* WG = (float*)(lds + 121856);
  ssd_stage_tr(p, row0, is_ctx, COL_XBC + g * 256, g * 256, 256, XT);
  ssd_stage_tr(p, row0, is_ctx, COL_XBC + 512 + g * 128, 512 + g * 128, 128, BT);
  {
    const int dir = wid >> 2, hh = wid & 3, h = g * 4 + hh;
    const float A = expf(p.a_log[dir * 8 + h]);
    const int l0 = 2 * lane, l1 = l0 + 1;
    const float dt0 = softplus_f(p.DT[(size_t)(row0 + l0) * 16 + dir * 8 + h]), dt1 = softplus_f(p.DT[(size_t)(row0 + l1) * 16 + dir * 8 + h]);
    const float a0 = -A * dt0, a1 = -A * dt1, pair = a0 + a1;
    float incl = pair;
#pragma unroll
    for (int o = 1; o < 64; o <<= 1) { float t = __shfl_up(incl, o); if (lane >= o) incl += t; }
    const float excl = incl - pair;
    const float total = __shfl(incl, 63);
    float w0, w1, c0, c1;
    if (dir == 0) { c0 = excl + a0; c1 = excl + pair; w0 = dt0 * expf(total - c0); w1 = dt1 * expf(total - c1); }
    else { const float pe0 = excl, pe1 = excl + a0; w0 = dt0 * expf(pe0); w1 = dt1 * expf(pe1); c0 = total - pe0; c1 = total - pe1; }
    WG[wid * 128 + l0] = w0; WG[wid * 128 + l1] = w1;
    if (!is_ctx) { float* ac = p.ACUM + (size_t)(b * 16 + dir * 8 + h) * L + (cidx - 2) * 128; *(float2*)(ac + l0) = make_float2(c0, c1); }
    if (lane == 0) {
      const int k = dir ? (is_ctx ? (1 - cidx) : (19 - cidx)) : cidx;
      p.CDEC[(size_t)(((b * 2 + dir) * 8 + h) * 18 + k) * 32] = expf(total);
    }
  }
  __syncthreads();
  const int fr = lane & 15, fq = lane >> 4;
#pragma unroll 1
  for (int it = 0; it < 8; ++it) {
    const int dir = it >> 2, hh = it & 3, h = g * 4 + hh;
    for (int e = tid; e < 1024; e += NTHR) {
      const int pr = e >> 4, ch = e & 15;
      const uint4 v = *(const uint4*)(XT + (hh * 64 + pr) * SROW + ch * 16);
      const float4 wa = *(const float4*)(WG + it * 128 + ch * 8), wb = *(const float4*)(WG + it * 128 + ch * 8 + 4);
      uint4 w;
      w.x = cvt_pk_bf16(__uint_as_float(v.x << 16) * wa.x, __uint_as_float(v.x & 0xffff0000u) * wa.y);
      w.y = cvt_pk_bf16(__uint_as_float(v.y << 16) * wa.z, __uint_as_float(v.y & 0xffff0000u) * wa.w);
      w.z = cvt_pk_bf16(__uint_as_float(v.z << 16) * wb.x, __uint_as_float(v.z & 0xffff0000u) * wb.y);
      w.w = cvt_pk_bf16(__uint_as_float(v.w << 16) * wb.z, __uint_as_float(v.w & 0xffff0000u) * wb.w);
      *(uint4*)(XD + pr * SROW + ch * 16) = w;
    }
    __syncthreads();
    hf32x4 acc[4];
#pragma unroll
    for (int pt = 0; pt < 4; ++pt) acc[pt] = (hf32x4){0.f, 0.f, 0.f, 0.f};
#pragma unroll
    for (int kk = 0; kk < 4; ++kk) {
      const hbf16x8 Bf = *(const hbf16x8*)(BT + (16 * wid + fr) * SROW + 2 * (32 * kk + 8 * fq));
#pragma unroll
      for (int pt = 0; pt < 4; ++pt) {
        const hbf16x8 Af = *(const hbf16x8*)(XD + (16 * pt + fr) * SROW + 2 * (32 * kk + 8 * fq));
        acc[pt] = __builtin_amdgcn_mfma_f32_16x16x32_bf16(Bf, Af, acc[pt], 0, 0, 0);
      }
    }
    const int k = dir ? (is_ctx ? (1 - cidx) : (19 - cidx)) : cidx;
    bf16_t* slot = p.SST + ((size_t)(((b * 2 + dir) * 8 + h) * 18 + k)) * 8192;
#pragma unroll
    for (int pt = 0; pt < 4; ++pt)
      *(uint2*)(slot + (16 * pt + fr) * 128 + 16 * wid + 4 * fq) = make_uint2(cvt_pk_bf16(acc[pt][0], acc[pt][1]), cvt_pk_bf16(acc[pt][2], acc[pt][3]));
    __syncthreads();
  }
}

__device__ void ssd_scan_unit(const Params& p, int unit) {
  const int tid = threadIdx.x;
  const int half = unit & 1, seq = unit >> 1;
  const int pr = half * 32 + (tid >> 4), n8 = (tid & 15) * 8;
  const bf16_t* base = p.SST + (size_t)seq * 18 * 8192 + pr * 128 + n8;
  uint4 sv[18];
#pragma unroll
  for (int k = 0; k < 18; ++k) sv[k] = *(const uint4*)(base + (size_t)k * 8192);
  float hst[8];
#pragma unroll
  for (int j = 0; j < 8; ++j) hst[j] = 0.f;
#pragma unroll
  for (int k = 0; k < 18; ++k) {
    const float dec = p.CDEC[(size_t)(seq * 18 + k) * 32];
    if (k >= 2) {
      uint4 w; w.x = cvt_pk_bf16(hst[0], hst[1]); w.y = cvt_pk_bf16(hst[2], hst[3]); w.z = cvt_pk_bf16(hst[4], hst[5]); w.w = cvt_pk_bf16(hst[6], hst[7]);
      *(uint4*)(p.HIN + ((size_t)seq * 16 + (k - 2)) * 8192 + pr * 128 + n8) = w;
    }
    const unsigned sw[4] = {sv[k].x, sv[k].y, sv[k].z, sv[k].w};
#pragma unroll
    for (int u = 0; u < 4; ++u) {
      hst[2 * u] = dec * hst[2 * u] + __uint_as_float(sw[u] << 16);
      hst[2 * u + 1] = dec * hst[2 * u + 1] + __uint_as_float(sw[u] & 0xffff0000u);
    }
  }
}

__device__ void ssd_out_unit(const Params& p, int unit, unsigned char* lds) {
  const int tid = threadIdx.x, wid = __builtin_amdgcn_readfirstlane(tid >> 6), lane = tid & 63;
  const int fr = lane & 15, fq = lane >> 4;
  const int g = unit & 1, bc = unit >> 1, c = bc & 15, b = bc >> 4;
  const int row0 = b * L + c * 128;
  unsigned char* CS = lds;
  unsigned char* ML = lds + 34816;
  unsigned char* XT = lds + 69632;
  unsigned char* ZT = lds + 87040;
  unsigned char* HS = lds + 104448;
  float* CUM = (float*)(lds + 121856);
  float* DTL = (float*)(lds + 125952);
  ssd_stage_nat(p, row0, COL_XBC + 768 + g * 128, 768 + g * 128, CS);
  ssd_stage_nat(p, row0, COL_XBC + 512 + g * 128, 512 + g * 128, ML);
  for (int e = tid; e < 1024; e += NTHR) {
    const int it = e >> 7, l = e & 127, dir = it >> 2, hh = it & 3;
    CUM[e] = p.ACUM[(size_t)(b * 16 + dir * 8 + g * 4 + hh) * L + c * 128 + l];
    DTL[e] = softplus_f(p.DT[(size_t)(row0 + l) * 16 + dir * 8 + g * 4 + hh]);
  }
  __syncthreads();
  hf32x4 cbt[8];
#pragma unroll
  for (int lt = 0; lt < 8; ++lt) cbt[lt] = (hf32x4){0.f, 0.f, 0.f, 0.f};
#pragma unroll
  for (int kk = 0; kk < 4; ++kk) {
    const hbf16x8 Af = *(const hbf16x8*)(ML + (16 * wid + fr) * SROW + 2 * (32 * kk + 8 * fq));
#pragma unroll
    for (int lt = 0; lt < 8; ++lt) {
      const hbf16x8 Bf = *(const hbf16x8*)(CS + (16 * lt + fr) * SROW + 2 * (32 * kk + 8 * fq));
      cbt[lt] = __builtin_amdgcn_mfma_f32_16x16x32_bf16(Af, Bf, cbt[lt], 0, 0, 0);
    }
  }
  __syncthreads();
  hf32x4 y[4][4];
#pragma unroll
  for (int hh = 0; hh < 4; ++hh)
#pragma unroll
    for (int pt = 0; pt < 4; ++pt) y[hh][pt] = (hf32x4){0.f, 0.f, 0.f, 0.f};
  const int sb = 16 * wid + 4 * fq;
#pragma unroll 1
  for (int hh = 0; hh < 4; ++hh) {
    const int h = g * 4 + hh;
    hf32x4 yc[4];
#pragma unroll
    for (int pt = 0; pt < 4; ++pt) yc[pt] = (hf32x4){0.f, 0.f, 0.f, 0.f};
    ssd_stage_tr_s(p, row0, false, COL_XBC + g * 256 + hh * 64, g * 256 + hh * 64, 64, XT);
    ssd_stage_tr_s(p, row0, false, COL_Z + g * 256 + hh * 64, -1, 64, ZT);
#pragma unroll 1
    for (int dir = 0; dir < 2; ++dir) {
      const int it = dir * 4 + hh;
      const int k = dir ? (17 - c) : (c + 2);
      const bf16_t* slot = p.HIN + ((size_t)(((b * 2 + dir) * 8 + h) * 16 + (k - 2))) * 8192;
      for (int e = tid; e < 1024; e += NTHR) {
        const int pr = e >> 4, ch = e & 15;
        *(uint4*)(HS + pr * SROW + ch * 16) = *(const uint4*)(slot + pr * 128 + ch * 8);
      }
      {
        const float* cu = CUM + it * 128; const float* dl = DTL + it * 128;
        float cs[4], ds[4];
#pragma unroll
        for (int r = 0; r < 4; ++r) { cs[r] = cu[sb + r]; ds[r] = dl[sb + r]; }
#pragma unroll
        for (int lt = 0; lt < 8; ++lt) {
          const int l = 16 * lt + fr;
          const float cl = cu[l];
          float m[4];
#pragma unroll
          for (int r = 0; r < 4; ++r) {
            const int sidx = sb + r;
            const bool ok = dir ? (sidx >= l) : (sidx <= l);
            m[r] = ok ? cbt[lt][r] * __expf(cl - cs[r]) * ds[r] : 0.f;
          }
          uint2 w; w.x = cvt_pk_bf16(m[0], m[1]); w.y = cvt_pk_bf16(m[2], m[3]);
          *(uint2*)(ML + l * SROW + 2 * sb) = w;
        }
      }
      __syncthreads();
      hf32x4 ad[4], ao[4];
#pragma unroll
      for (int pt = 0; pt < 4; ++pt) { ad[pt] = (hf32x4){0.f, 0.f, 0.f, 0.f}; ao[pt] = (hf32x4){0.f, 0.f, 0.f, 0.f}; }
#pragma unroll
      for (int kk = 0; kk < 4; ++kk) {
        const hbf16x8 Am = *(const hbf16x8*)(ML + (16 * wid + fr) * SROW + 2 * (32 * kk + 8 * fq));
        const hbf16x8 Ac = *(const hbf16x8*)(CS + (16 * wid + fr) * SROW + 2 * (32 * kk + 8 * fq));
#pragma unroll
        for (int pt = 0; pt < 4; ++pt) {
          const hbf16x8 Bx = *(const hbf16x8*)(XT + (16 * pt + fr) * SROW + 2 * (32 * kk + 8 * fq));
          const hbf16x8 Bh = *(const hbf16x8*)(HS + (16 * pt + fr) * SROW + 2 * (32 * kk + 8 * fq));
          ad[pt] = __builtin_amdgcn_mfma_f32_16x16x32_bf16(Am, Bx, ad[pt], 0, 0, 0);
          ao[pt] = __builtin_amdgcn_mfma_f32_16x16x32_bf16(Ac, Bh, ao[pt], 0, 0, 0);
        }
      }
      {
        const float* cu = CUM + it * 128;
        float ex[4];
#pragma unroll
        for (int r = 0; r < 4; ++r) ex[r] = __expf(cu[sb + r]);
#pragma unroll
        for (int pt = 0; pt < 4; ++pt)
#pragma unroll
          for (int r = 0; r < 4; ++r) yc[pt][r] += ad[pt][r] + ex[r] * ao[pt][r];
      }
      __syncthreads();
    }
    {
      const float dsk = p.ssd_d[h];
#pragma unroll
      for (int pt = 0; pt < 4; ++pt) {
        const uint2 xv = *(const uint2*)(XT + (16 * pt + fr) * SROW + 2 * sb);
        const uint2 zv = *(const uint2*)(ZT + (16 * pt + fr) * SROW + 2 * sb);
        const float xs4[4] = {__uint_as_float(xv.x << 16), __uint_as_float(xv.x & 0xffff0000u), __uint_as_float(xv.y << 16), __uint_as_float(xv.y & 0xffff0000u)};
        const float zs4[4] = {__uint_as_float(zv.x << 16), __uint_as_float(zv.x & 0xffff0000u), __uint_as_float(zv.y << 16), __uint_as_float(zv.y & 0xffff0000u)};
#pragma unroll
        for (int r = 0; r < 4; ++r) yc[pt][r] = (yc[pt][r] + dsk * xs4[r]) * silu_f(zs4[r]);
      }
    }
    if (hh == 0) {
#pragma unroll
      for (int pt = 0; pt < 4; ++pt) y[0][pt] = yc[pt];
    } else if (hh == 1) {
#pragma unroll
      for (int pt = 0; pt < 4; ++pt) y[1][pt] = yc[pt];
    } else if (hh == 2) {
#pragma unroll
      for (int pt = 0; pt < 4; ++pt) y[2][pt] = yc[pt];
    } else {
#pragma unroll
      for (int pt = 0; pt < 4; ++pt) y[3][pt] = yc[pt];
    }
    __syncthreads();
  }
  float rinv[4];
#pragma unroll
  for (int r = 0; r < 4; ++r) {
    float ss = 0.f;
#pragma unroll
    for (int hh = 0; hh < 4; ++hh)
#pragma unroll
      for (int pt = 0; pt < 4; ++pt) ss += y[hh][pt][r] * y[hh][pt][r];
    ss += __shfl_xor(ss, 1); ss += __shfl_xor(ss, 2); ss += __shfl_xor(ss, 4); ss += __shfl_xor(ss, 8);
    rinv[r] = rsqrtf(ss * (1.f / 256.f) + EPS);
  }
  {
    bf16_t* OT = (bf16_t*)lds;
#pragma unroll
    for (int hh = 0; hh < 4; ++hh)
#pragma unroll
      for (int pt = 0; pt < 4; ++pt) {
        const int chl = hh * 64 + 16 * pt + fr;
        const float ng = p.ssd_norm_g[g * 256 + chl];
#pragma unroll
        for (int r = 0; r < 4; ++r) OT[(sb + r) * 264 + chl] = f2bf(y[hh][pt][r] * rinv[r] * ng);
      }
    __syncthreads();
    for (int e = tid; e < 128 * 32; e += NTHR) {
      const int l = e >> 5, ch8 = (e & 31) * 8;
      *(uint4*)(p.YMIXb + (size_t)(row0 + l) * D + 512 + g * 256 + ch8) = *(const uint4*)(OT + l * 264 + ch8);
    }
  }
}

__device__ void ph_router(const Params& p, unsigned char* lds) {
  const int tid = threadIdx.x, wid = __builtin_amdgcn_readfirstlane(tid >> 6), lane = tid & 63;
  const int fr = lane & 15, fq = lane >> 4;
  constexpr int AROW = 272;
  unsigned char* AH = lds;
  unsigned char* AL = lds + 64 * AROW;
  unsigned char* WH = lds + 128 * AROW;
  unsigned char* WL = lds + 224 * AROW;
  float* RS = (float*)(lds + 320 * AROW);
  float* LOG = RS + 64;
  float* GM = LOG + 6400;
  float* SH = GM + 1024;
  for (int tile = blockIdx.x; tile < T / 64; tile += gridDim.x) {
    const int row0 = tile * 64;
    const float* shp = p.MOD + (row0 / L) * 6144 + 3072;
    const float* scp = shp + 1024;
    if (tid < 64) {
      const float4* sp = (const float4*)(p.SSQP + (size_t)(row0 + tid) * 16);
      const float4 a0 = sp[0], a1 = sp[1], a2 = sp[2], a3 = sp[3];
      const float ss = ((a0.x + a0.y) + (a0.z + a0.w)) + ((a1.x + a1.y) + (a1.z + a1.w)) + ((a2.x + a2.y) + (a2.z + a2.w)) + ((a3.x + a3.y) + (a3.z + a3.w));
      RS[tid] = rsqrtf(ss * (1.f / D) + EPS);
    }
    for (int e = tid; e < 256; e += NTHR) {
      const float4 g = *(const float4*)(p.g2 + e * 4), s4 = *(const float4*)(scp + e * 4), h4 = *(const float4*)(shp + e * 4);
      *(float4*)(GM + e * 4) = make_float4(g.x * (1.f + s4.x), g.y * (1.f + s4.y), g.z * (1.f + s4.z), g.w * (1.f + s4.w));
      *(float4*)(SH + e * 4) = h4;
    }
    float4 xv[4];
#pragma unroll
    for (int i = 0; i < 4; ++i) { const int e = tid + i * NTHR; xv[i] = *(const float4*)(p.X1 + (size_t)(row0 + (e >> 5)) * D + (e & 31) * 4); }
    __syncthreads();
    hf32x4 acc[3];
#pragma unroll
    for (int nt = 0; nt < 3; ++nt) acc[nt] = (hf32x4){0.f, 0.f, 0.f, 0.f};
    const int mt = wid & 3, nh = wid >> 2;
#pragma unroll 1
    for (int kc = 0; kc < 8; ++kc) {
#pragma unroll
      for (int i = 0; i < 4; ++i) {
        const int e = tid + i * NTHR; const int tok = e >> 5, k4 = (e & 31) * 4;
        const int kg = kc * 128 + k4;
        const float4 v = xv[i];
        const float4 g = *(const float4*)(GM + kg);
        const float4 h4 = *(const float4*)(SH + kg);
        const float rstd = RS[tok];
        const float h0 = v.x * rstd * g.x + h4.x, h1 = v.y * rstd * g.y + h4.y;
        const float h2 = v.z * rstd * g.z + h4.z, h3 = v.w * rstd * g.w + h4.w;
        const unsigned hi01 = cvt_pk_bf16(h0, h1), hi23 = cvt_pk_bf16(h2, h3);
        const unsigned lo01 = cvt_pk_bf16(h0 - __uint_as_float(hi01 << 16), h1 - __uint_as_float(hi01 & 0xffff0000u));
        const unsigned lo23 = cvt_pk_bf16(h2 - __uint_as_float(hi23 << 16), h3 - __uint_as_float(hi23 & 0xffff0000u));
        *(uint2*)(AH + tok * AROW + k4 * 2) = make_uint2(hi01, hi23);
        *(uint2*)(AL + tok * AROW + k4 * 2) = make_uint2(lo01, lo23);
        *(uint2*)(p.H2b + (size_t)(row0 + tok) * D + kg) = make_uint2(hi01, hi23);
      }
#pragma unroll
      for (int i = 0; i < 3; ++i) {
        const int e = tid + i * NTHR; const int j = e >> 4, ch = e & 15;
        *(uint4*)(WH + j * AROW + ch * 16) = *(const uint4*)(p.WRhi + (size_t)j * 1024 + kc * 128 + ch * 8);
        *(uint4*)(WL + j * AROW + ch * 16) = *(const uint4*)(p.WRlo + (size_t)j * 1024 + kc * 128 + ch * 8);
      }
      if (kc + 1 < 8) {
#pragma unroll
        for (int i = 0; i < 4; ++i) { const int e = tid + i * NTHR; xv[i] = *(const float4*)(p.X1 + (size_t)(row0 + (e >> 5)) * D + (kc + 1) * 128 + (e & 31) * 4); }
      }
      __syncthreads();
#pragma unroll
      for (int kk = 0; kk < 4; ++kk) {
        const hbf16x8 Ahi = *(const hbf16x8*)(AH + (16 * mt + fr) * AROW + 2 * (32 * kk + 8 * fq));
        const hbf16x8 Alo = *(const hbf16x8*)(AL + (16 * mt + fr) * AROW + 2 * (32 * kk + 8 * fq));
#pragma unroll
        for (int nt = 0; nt < 3; ++nt) {
          const int wo = (16 * (nh * 3 + nt) + fr) * AROW + 2 * (32 * kk + 8 * fq);
          const hbf16x8 Bhi = *(const hbf16x8*)(WH + wo);
          const hbf16x8 Blo = *(const hbf16x8*)(WL + wo);
          acc[nt] = __builtin_amdgcn_mfma_f32_16x16x32_bf16(Ahi, Bhi, acc[nt], 0, 0, 0);
          acc[nt] = __builtin_amdgcn_mfma_f32_16x16x32_bf16(Ahi, Blo, acc[nt], 0, 0, 0);
          acc[nt] = __builtin_amdgcn_mfma_f32_16x16x32_bf16(Alo, Bhi, acc[nt], 0, 0, 0);
        }
      }
      __syncthreads();
    }
#pragma unroll
    for (int nt = 0; nt < 3; ++nt)
#pragma unroll
      for (int r = 0; r < 4; ++r) LOG[(16 * mt + 4 * fq + r) * 100 + 16 * (nh * 3 + nt) + fr] = acc[nt][r];
    __syncthreads();
    if (tid < 64) {
      const float* lg = LOG + tid * 100;
      const int row = row0 + tid;
      int gs = 0; float gm = lg[64] + p.b_group[0];
      float gl[8];
      gl[0] = gm;
#pragma unroll
      for (int j = 1; j < 8; ++j) { gl[j] = lg[64 + j] + p.b_group[j]; if (gl[j] > gm) { gm = gl[j]; gs = j; } }
      float den = 0.f;
#pragma unroll
      for (int j = 0; j < 8; ++j) den += expf(gl[j] - gm);
      const float pg = 1.f / den;
      float el[8];
#pragma unroll
      for (int j = 0; j < 8; ++j) el[j] = 0.f;
      for (int j = 0; j < 8; ++j) el[j] = lg[gs * 8 + j] + p.b_expert[gs * 8 + j];
      int i0 = 0; float l0 = el[0];
#pragma unroll
      for (int j = 1; j < 8; ++j) if (el[j] > l0) { l0 = el[j]; i0 = j; }
      int i1 = -1; float l1 = -3.0e38f;
#pragma unroll
      for (int j = 0; j < 8; ++j) if (j != i0 && el[j] > l1) { l1 = el[j]; i1 = j; }
      const float e1 = expf(l1 - l0);
      const float w0 = 1.f / (1.f + e1), w1 = e1 / (1.f + e1);
      p.GATE[row * 2 + 0] = w0 * pg;
      p.GATE[row * 2 + 1] = w1 * pg;
      const int ea = gs * 8 + i0, eb = gs * 8 + i1;
      const int sa = atomicAdd(&p.CNT[ea], 1);
      p.LIST[ea * T + sa] = row * 2 + 0;
      const int sb2 = atomicAdd(&p.CNT[eb], 1);
      p.LIST[eb * T + sb2] = row * 2 + 1;
    }
    __syncthreads();
  }
}

__device__ __forceinline__ void moe_table(const Params& p, int* tab) {
  if (threadIdx.x == 0) {
    int a = 0, sg = 0;
    for (int e = 0; e < NE; ++e) {
      int cn = p.CNT[e];
      tab[e] = a; tab[65 + e] = sg; tab[130 + e] = cn;
      a += (cn + 255) >> 8; sg += ((cn + 127) >> 7) << 7;
    }
    tab[NE] = a; tab[65 + NE] = sg;
  }
  __syncthreads();
}

__device__ void ph_final(const Params& p) {
  const int tid = threadIdx.x, wid = tid >> 6, lane = tid & 63;
  for (int row = blockIdx.x * 8 + wid; row < T; row += gridDim.x * 8) {
    const float* ga2 = p.MOD + (row / L) * 6144 + 5120;
    float4 v[4];
    float ss = 0.f;
#pragma unroll
    for (int i = 0; i < 4; ++i) {
      const int col = i * 256 + lane * 4;
      float4 xv = *(const float4*)(p.X1 + (size_t)row * D + col);
      uint2 a = *(const uint2*)(p.YB2b + (size_t)(row * 2) * D + col);
      uint2 b = *(const uint2*)(p.YB2b + (size_t)(row * 2 + 1) * D + col);
      float4 ga = *(const float4*)(ga2 + col);
      v[i].x = xv.x + ga.x * (__uint_as_float(a.x << 16) + __uint_as_float(b.x << 16));
      v[i].y = xv.y + ga.y * (__uint_as_float(a.x & 0xffff0000u) + __uint_as_float(b.x & 0xffff0000u));
      v[i].z = xv.z + ga.z * (__uint_as_float(a.y << 16) + __uint_as_float(b.y << 16));
      v[i].w = xv.w + ga.w * (__uint_as_float(a.y & 0xffff0000u) + __uint_as_float(b.y & 0xffff0000u));
      ss += v[i].x * v[i].x + v[i].y * v[i].y + v[i].z * v[i].z + v[i].w * v[i].w;
    }
    ss = wave_sum(ss);
    const float rstd = rsqrtf(ss * (1.f / D) + EPS);
#pragma unroll
    for (int i = 0; i < 4; ++i) {
      const int col = i * 256 + lane * 4;
      float4 gf = *(const float4*)(p.g_final + col);
      float4 o;
      o.x = v[i].x * rstd * gf.x; o.y = v[i].y * rstd * gf.y; o.z = v[i].z * rstd * gf.z; o.w = v[i].w * rstd * gf.w;
      *(float4*)(p.out + (size_t)row * D + col) = o;
    }
  }
}

constexpr int NPHASE = 11;

__global__ void __launch_bounds__(NTHR, 2) mega(Params p) {
  extern __shared__ __attribute__((aligned(16))) unsigned char lds_raw[];
  float* sm = (float*)lds_raw;
  PG8_LAS unsigned char* lds = (PG8_LAS unsigned char*)lds_raw;
  const int lo = p.lo, hi = p.hi;
  volatile LAS unsigned* xbst = (volatile LAS unsigned*)(lds + pg8::STAGE_BYTES + 2048);
  if (threadIdx.x < 4) xbst[threadIdx.x] = 0u;
  __syncthreads();
  XcdBarrier xbar; xbar.bar = p.BAR; xbar.x = 0; xbar.st = xbst;
  if (hi - lo > 1) xbar = xcd_barrier_post(p.BAR, xbst);
#define IN(k) (lo <= (k) && (k) < hi)
#define SYNC(k) do { if (IN(k) && IN((k) + 1)) xcd_barrier(xbar); } while (0)
#ifndef DUPK
#define DUPK -1
#endif
#ifndef SKIP_OTHER
  if (IN(0)) { ph_adaln(p, sm); ph_filters(p, sm); ph_wcvt(p, sm); }
#if DUPK == 0
  xcd_barrier(xbar);
  if (IN(0)) { ph_adaln(p, sm); ph_filters(p, sm); ph_wcvt(p, sm); }
#endif
  SYNC(0);
  if (IN(1)) ph_norm1(p);
#if DUPK == 1
  xcd_barrier(xbar);
  if (IN(1)) ph_norm1(p);
#endif
  SYNC(1);
#endif
#ifndef SKIP_GEMM
  if (IN(2)) {
    pg8::DenseOrder S{p.XNb, p.WinT, TT / 256, DP / 256 + 1, D, (int)gridDim.x, (int)blockIdx.x};
    pg8::EpiBf16 E{p.PXb, DP, p.DT, p.dt_bias};
    pg8::gemm_phase<pg8::EpiBf16, pg8::DenseOrder>(lds, D, S, E);
  }
#if DUPK == 2
  xcd_barrier(xbar);
  if (IN(2)) {
    pg8::DenseOrder S{p.XNb, p.WinT, TT / 256, DP / 256 + 1, D, (int)gridDim.x, (int)blockIdx.x};
    pg8::EpiBf16 E{p.PXb, DP, p.DT, p.dt_bias};
    pg8::gemm_phase<pg8::EpiBf16, pg8::DenseOrder>(lds, D, S, E);
  }
#endif
  SYNC(2);
#endif
#ifndef SKIP_OTHER
  if (IN(3)) {
    ph_hy_convT(p, sm);
    for (int it = blockIdx.x; it < 288; it += gridDim.x) ssd_states_unit(p, it, lds_raw);
  }
#if DUPK == 3
  xcd_barrier(xbar);
  if (IN(3)) {
    ph_hy_convT(p, sm);
    for (int it = blockIdx.x; it < 288; it += gridDim.x) ssd_states_unit(p, it, lds_raw);
  }
#endif
  SYNC(3);
  if (IN(4)) {
    for (int it = blockIdx.x; it < 256; it += gridDim.x) ssd_scan_unit(p, it);
    for (int it = blockIdx.x; it < 512; it += gridDim.x) hyena_unit(p, it, lds_raw);
  }
#if DUPK == 4
  xcd_barrier(xbar);
  if (IN(4)) {
    for (int it = blockIdx.x; it < 256; it += gridDim.x) ssd_scan_unit(p, it);
    for (int it = blockIdx.x; it < 512; it += gridDim.x) hyena_unit(p, it, lds_raw);
  }
#endif
  SYNC(4);
  if (IN(5)) {
    for (int it = blockIdx.x; it < 256; it += gridDim.x) { ssd_out_unit(p, it, lds_raw); __syncthreads(); }
    ph_hy_backT(p, sm);
  }
#if DUPK == 5
  xcd_barrier(xbar);
  if (IN(5)) {
    for (int it = blockIdx.x; it < 256; it += gridDim.x) { ssd_out_unit(p, it, lds_raw); __syncthreads(); }
    ph_hy_backT(p, sm);
  }
#endif
  SYNC(5);
#endif
#ifndef SKIP_GEMM
  if (IN(6)) {
    pg8::DenseOrder S{p.YMIXb, p.WoutT, T / 256, D / 256, D, (int)gridDim.x, (int)blockIdx.x};
    pg8::EpiX1 E{p.x, p.MOD, p.X1, p.SSQP};
    pg8::gemm_phase<pg8::EpiX1, pg8::DenseOrder>(lds, D, S, E);
  }
#if DUPK == 6
  xcd_barrier(xbar);
  if (IN(6)) {
    pg8::DenseOrder S{p.YMIXb, p.WoutT, T / 256, D / 256, D, (int)gridDim.x, (int)blockIdx.x};
    pg8::EpiX1 E{p.x, p.MOD, p.X1, p.SSQP};
    pg8::gemm_phase<pg8::EpiX1, pg8::DenseOrder>(lds, D, S, E);
  }
#endif
  SYNC(6);
#endif
#ifndef SKIP_OTHER
  if (IN(7)) ph_router(p, lds_raw);
#if DUPK == 7
  xcd_barrier(xbar);
  if (IN(7)) ph_router(p, lds_raw);
#endif
  SYNC(7);
#endif
#ifndef SKIP_GEMM
  if (IN(8)) {
    int* tab = (int*)(lds_raw + pg8::STAGE_BYTES);
    moe_table(p, tab);
    pg8::MoeOrder S{tab, p.H2b, p.Wup, p.LIST, 4, D, (int)gridDim.x, (int)blockIdx.x, true};
    pg8::EpiSwiGLU E{p.HBb};
    pg8::gemm_phase<pg8::EpiSwiGLU, pg8::MoeOrder>(lds, D, S, E);
  }
#if DUPK == 8
  xcd_barrier(xbar);
  if (IN(8)) {
    int* tab = (int*)(lds_raw + pg8::STAGE_BYTES);
    moe_table(p, tab);
    pg8::MoeOrder S{tab, p.H2b, p.Wup, p.LIST, 4, D, (int)gridDim.x, (int)blockIdx.x, true};
    pg8::EpiSwiGLU E{p.HBb};
    pg8::gemm_phase<pg8::EpiSwiGLU, pg8::MoeOrder>(lds, D, S, E);
  }
#endif
  SYNC(8);
  if (IN(9)) {
    int* tab = (int*)(lds_raw + pg8::STAGE_BYTES);
    moe_table(p, tab);
    pg8::MoeOrder S{tab, p.HBb, p.Wdn, p.LIST, 4, DE, (int)gridDim.x, (int)blockIdx.x, false};
    pg8::EpiDown E{p.YB2b, p.LIST, p.GATE};
    pg8::gemm_phase<pg8::EpiDown, pg8::MoeOrder>(lds, DE, S, E);
  }
#if DUPK == 9
  xcd_barrier(xbar);
  if (IN(9)) {
    int* tab = (int*)(lds_raw + pg8::STAGE_BYTES);
    moe_table(p, tab);
    pg8::MoeOrder S{tab, p.HBb, p.Wdn, p.LIST, 4, DE, (int)gridDim.x, (int)blockIdx.x, false};
    pg8::EpiDown E{p.YB2b, p.LIST, p.GATE};
    pg8::gemm_phase<pg8::EpiDown, pg8::MoeOrder>(lds, DE, S, E);
  }
#endif
  SYNC(9);
#endif
#ifndef SKIP_OTHER
  if (IN(10)) ph_final(p);
#if DUPK == 10
  xcd_barrier(xbar);
  if (IN(10)) ph_final(p);
#endif
#endif
#undef IN
#undef SYNC
}

extern "C" void kernel_launch(void* const* d_in, const int* in_sizes, int n_in, void* d_out, int out_size,
                              void* d_ws, size_t ws_size, hipStream_t stream) {
  Params p{};
  const float* const* in = (const float* const*)d_in;
  p.x = in[0]; p.c = in[1]; p.ctx = in[2]; p.c_ctx = in[3]; p.w_ada = in[4]; p.b_ada = in[5];
  p.g1 = in[6]; p.g2 = in[7]; p.w_in = in[8]; p.hy_conv_w = in[9]; p.hy_conv_b = in[10];
  p.f_w1 = in[11]; p.f_b1 = in[12]; p.f_freq = in[13]; p.f_w2 = in[14]; p.f_b2 = in[15]; p.f_w3 = in[16];
  p.hy_bias = in[17]; p.ssd_conv_w = in[18]; p.ssd_conv_b = in[19]; p.a_log = in[20]; p.dt_bias = in[21];
  p.ssd_d = in[22]; p.ssd_norm_g = in[23]; p.w_out = in[24]; p.w_group = in[25]; p.b_group = in[26];
  p.w_expert = in[27]; p.b_expert = in[28]; p.w1 = in[29]; p.w3 = in[30]; p.w2 = in[31]; p.g_final = in[32];
  p.out = (float*)d_out;

  char* ws = (char*)d_ws;
  size_t off = 0;
  auto take = [&](size_t bytes) { char* r = ws + off; off += (bytes + 255) & ~(size_t)255; return r; };
  p.BAR = (unsigned*)take((size_t)XCD_BAR_WORDS * 4);
  p.MOD = (float*)take((size_t)9 * 6144 * 4);
  p.CNT = (int*)take(NE * 4);
  p.GATE = (float*)take((size_t)T * 2 * 4);
  p.LIST = (int*)take((size_t)NE * T * 4);
  p.DT = (float*)take((size_t)TT * 16 * 4);
  p.ACUM = (float*)take((size_t)T * 16 * 4);
  p.SSQP = (float*)take((size_t)T * 16 * 4);
  p.CDEC = (float*)take((size_t)128 * 18 * 32 * 4);
  p.FILTt = (bf16_t*)take((size_t)1024 * FLEN * 2);
  p.WRhi = (bf16_t*)take((size_t)96 * 1024 * 2);
  p.WRlo = (bf16_t*)take((size_t)96 * 1024 * 2);
  p.WinT = (bf16_t*)take((size_t)(DP + 256) * D * 2);
  p.WoutT = (bf16_t*)take((size_t)D * D * 2);
  p.Wup = (bf16_t*)take((size_t)NE * 1024 * 1024 * 2);
  p.Wdn = (bf16_t*)take((size_t)NE * 1024 * 512 * 2);
  char* rPX = take((size_t)TT * DP * 2);
  char* rXBC = take((size_t)128 * 18 * 8192 * 2);
  char* rYF = take((size_t)T * DS * 4);
  char* rZ1 = take((size_t)HYC * T * 2);
  char* rYB = take((size_t)T * DS * 4);
  char* rYM = take((size_t)T * D * 2);
  p.PXb = (bf16_t*)rPX; p.SST = (bf16_t*)rXBC; p.Ut = (bf16_t*)rZ1; p.YMIXb = (bf16_t*)rYM;
  p.HIN = (bf16_t*)rYF;
  p.Yt = (bf16_t*)rYB;
  p.XNb = (bf16_t*)rZ1;
  p.X1 = (float*)rPX;
  p.H2b = (bf16_t*)rYM;
  p.HBb = (bf16_t*)(rPX + (size_t)T * D * 4);
  p.YB2b = (bf16_t*)rZ1;
  if (off > ws_size) { fprintf(stderr, "workspace too small: need %zu have %zu\n", off, ws_size); return; }

  static int grid_blocks = 0;
  if (!grid_blocks) {
    int dev = 0, cus = 0, per_cu = 0;
    (void)hipGetDevice(&dev);
    (void)hipDeviceGetAttribute(&cus, hipDeviceAttributeMultiprocessorCount, dev);
    (void)hipFuncSetAttribute((const void*)mega, hipFuncAttributeMaxDynamicSharedMemorySize, LDS_BYTES);
    (void)hipOccupancyMaxActiveBlocksPerMultiprocessor(&per_cu, mega, NTHR, LDS_BYTES);
    if (per_cu < 1) { fprintf(stderr, "occupancy query returned %d\n", per_cu); per_cu = 1; }
    grid_blocks = cus;
  }
#ifndef ONE_LAUNCH
  for (int ph = 0; ph < NPHASE; ++ph) {
    p.lo = ph; p.hi = ph + 1;
    hipLaunchKernelGGL(mega, dim3(grid_blocks), dim3(NTHR), LDS_BYTES, stream, p);
  }
#else
  p.lo = 0; p.hi = NPHASE;
  (void)hipMemsetAsync(p.BAR, 0, (size_t)XCD_BAR_WORDS * 4, stream);
  void* args[] = {&p};
  hipError_t e = hipLaunchCooperativeKernel((void*)mega, dim3(grid_blocks), dim3(NTHR), args, LDS_BYTES, stream);
  if (e != hipSuccess) fprintf(stderr, "cooperative launch failed: %s (grid %d)\n", hipGetErrorString(e), grid_blocks);
#endif
}
```

```cpp
#define ONE_LAUNCH 1
#include <hip/hip_runtime.h>
#include <hip/hip_cooperative_groups.h>
#include <cstdio>
#include <cstdint>
namespace cg = cooperative_groups;

constexpr int D = 1024, NB = 8, L = 2048, LC = 256;
constexpr int T = NB * L;
constexpr int TC = NB * LC;
constexpr int TT = T + TC;
constexpr int DH = 512, HYC = 1536, DS = 512, DXBC = 1024, DIN = 3088, DP = 3072;
constexpr int COL_Z = 1536, COL_XBC = 2048, COL_DT = 3072;
constexpr int NE = 64, DE = 512;
constexpr float EPS = 1e-6f;
constexpr int NTHR = 512;
constexpr int LDS_BYTES = 132 * 1024;
constexpr int FLEN = 4232, HX0 = 2112, FCLEN = 4240, ZSTRB = 4240;

typedef unsigned short bf16_t;

struct Params {
  const float *x, *c, *ctx, *c_ctx, *w_ada, *b_ada, *g1, *g2, *w_in, *hy_conv_w, *hy_conv_b;
  const float *f_w1, *f_b1, *f_freq, *f_w2, *f_b2, *f_w3, *hy_bias;
  const float *ssd_conv_w, *ssd_conv_b, *a_log, *dt_bias, *ssd_d, *ssd_norm_g, *w_out;
  const float *w_group, *b_group, *w_expert, *b_expert, *w1, *w3, *w2, *g_final;
  float* out;
  float *MOD, *DT, *X1, *GATE, *ACUM, *CDEC, *SSQP;
  bf16_t *WRhi, *WRlo, *FILTt, *Ut, *Yt, *HIN, *XNb, *WinT, *WoutT, *PXb, *SST, *YMIXb, *YB2b, *H2b, *HBb;
  int *CNT, *LIST;
  unsigned* BAR;
  int lo, hi;
};

__device__ __forceinline__ float silu_f(float v) { return v / (1.f + __expf(-v)); }
__device__ __forceinline__ float softplus_f(float v) { return v > 20.f ? v : log1pf(expf(v)); }
__device__ __forceinline__ float bf2f(bf16_t v) { return __uint_as_float(((unsigned)v) << 16); }
__device__ __forceinline__ unsigned cvt_pk_bf16(float lo, float hi) {
  typedef __bf16 bf2_t __attribute__((ext_vector_type(2)));
  typedef float f2_t __attribute__((ext_vector_type(2)));
  const f2_t v = {lo, hi};
  const bf2_t r = __builtin_convertvector(v, bf2_t);
  return __builtin_bit_cast(unsigned, r);
}
__device__ __forceinline__ bf16_t f2bf(float f) { return (bf16_t)(cvt_pk_bf16(f, 0.f) & 0xffffu); }
__device__ __forceinline__ void st_agent64(void* p, unsigned lo, unsigned hi) {
  __hip_atomic_store((unsigned long long*)p, ((unsigned long long)hi << 32) | lo, __ATOMIC_RELAXED, __HIP_MEMORY_SCOPE_AGENT);
}
__device__ __forceinline__ uint2 ld_agent64(const void* p) {
  const unsigned long long v = __hip_atomic_load((const unsigned long long*)p, __ATOMIC_RELAXED, __HIP_MEMORY_SCOPE_AGENT);
  return make_uint2((unsigned)v, (unsigned)(v >> 32));
}
__device__ __forceinline__ void st_agent32(float* p, float v) { __hip_atomic_store(p, v, __ATOMIC_RELAXED, __HIP_MEMORY_SCOPE_AGENT); }
__device__ __forceinline__ float ld_agent32(const float* p) { return __hip_atomic_load(p, __ATOMIC_RELAXED, __HIP_MEMORY_SCOPE_AGENT); }
__device__ __forceinline__ float wave_sum(float v) {
#pragma unroll
  for (int o = 32; o > 0; o >>= 1) v += __shfl_xor(v, o);
  return v;
}


#define XB_TMO      128
#define XB_XCNT(j)  (256  + 64 * (j))
#define XB_XSUB(j)  (1280 + 64 * (j))
#define XB_XGEN(j)  (2304 + 64 * (j))
#define XB_TOP      3328
#define XB_TOPGEN   3392
#define XCD_BAR_WORDS 3456
#define XB_SPIN_CAP (1u << 18)
#define LAS __attribute__((address_space(3)))
__device__ __forceinline__ unsigned xb_ld(unsigned* p) { return __hip_atomic_load(p, __ATOMIC_RELAXED, __HIP_MEMORY_SCOPE_AGENT); }
__device__ __forceinline__ unsigned xb_add(unsigned* p, unsigned v) { return __hip_atomic_fetch_add(p, v, __ATOMIC_RELAXED, __HIP_MEMORY_SCOPE_AGENT); }
__device__ __forceinline__ unsigned xb_xcc_id() { return (unsigned)__builtin_amdgcn_s_getreg((3 << 11) | 20) & 0xFu; }
#define XB_SPIN(cond, bar) do { unsigned _sp = 0; while (cond) { __builtin_amdgcn_s_sleep(1); \
    if ((++_sp & 255u) == 0u) { if (xb_ld(&(bar)[XB_TMO])) break; if (_sp > XB_SPIN_CAP) { atomicAdd(&(bar)[XB_TMO], 1u); break; } } } } while (0)
struct XcdBarrier { unsigned* bar; unsigned x; volatile LAS unsigned* st; };
__device__ __forceinline__ XcdBarrier xcd_barrier_post(unsigned* bar, volatile LAS unsigned* st) {
  XcdBarrier b; b.bar = bar; b.x = xb_xcc_id(); b.st = st;
  if (threadIdx.x == 0) (void)xb_add(&bar[XB_XCNT(b.x)], 1u);
  return b;
}
__device__ __forceinline__ void xcd_barrier_complete(unsigned* bar, unsigned x, unsigned& nloc, unsigned& nx) {
  const unsigned G = gridDim.x * gridDim.y * gridDim.z;
  unsigned sum, cnt, mine, sp = 0u;
  for (;;) {
    sum = 0u; cnt = 0u; mine = 0u;
#pragma unroll
    for (unsigned j = 0; j < 16; ++j) { const unsigned c = xb_ld(&bar[XB_XCNT(j)]); sum += c; cnt += (c > 0u) ? 1u : 0u; mine = (j == x) ? c : mine; }
    if (sum == G) break;
    __builtin_amdgcn_s_sleep(1);
    if ((++sp & 255u) == 0u) { if (xb_ld(&bar[XB_TMO])) break; if (sp > XB_SPIN_CAP) { atomicAdd(&bar[XB_TMO], 1u); break; } }
  }
  nloc = mine > 0u ? mine : 1u; nx = cnt > 0u ? cnt : 1u;
}
__device__ __forceinline__ void xcd_barrier(const XcdBarrier& b) {
  asm volatile("s_waitcnt vmcnt(0)" ::: "memory");
  __syncthreads();
  if (threadIdx.x == 0) {
    unsigned* bar = b.bar;
    __builtin_amdgcn_s_waitcnt(0);
    unsigned nloc = b.st[0], nx = b.st[1];
    if (nloc == 0u) { xcd_barrier_complete(bar, b.x, nloc, nx); b.st[0] = nloc; b.st[1] = nx; }
    const unsigned old = xb_add(&bar[XB_XSUB(b.x)], 1u);
    const unsigned gen = old / nloc;
    if (old + 1u == (gen + 1u) * nloc) {
      __builtin_amdgcn_fence(__ATOMIC_RELEASE, "agent");
      asm volatile("s_waitcnt vmcnt(0)" ::: "memory");
      const unsigned og = xb_add(&bar[XB_TOP], 1u);
      const unsigned tg = og / nx;
      if (og + 1u == (tg + 1u) * nx) xb_add(&bar[XB_TOPGEN], 1u);
      else XB_SPIN(xb_ld(&bar[XB_TOPGEN]) == tg, bar);
      __builtin_amdgcn_fence(__ATOMIC_ACQUIRE, "agent");
      xb_add(&bar[XB_XGEN(b.x)], 1u);
      asm volatile("s_waitcnt vmcnt(0)" ::: "memory");
    } else {
      XB_SPIN(xb_ld(&bar[XB_XGEN(b.x)]) == gen, bar);
      __builtin_amdgcn_fence(__ATOMIC_ACQUIRE, "agent");
      asm volatile("s_waitcnt vmcnt(0)" ::: "memory");
    }
  }
  __syncthreads();
}

namespace pg8 {
#define PG8_LAS __attribute__((address_space(3)))
typedef short bf16x8 __attribute__((ext_vector_type(8)));
typedef float f32x4 __attribute__((ext_vector_type(4)));
typedef unsigned u32x4 __attribute__((ext_vector_type(4)));
typedef unsigned u32x2 __attribute__((ext_vector_type(2)));
constexpr int BM = 256, BK = 64, HALF = 128, HTB = HALF * BK * 2, STAGE_BYTES = 8 * HTB, NXCD = 8, WGM = 8;

__host__ __device__ __forceinline__ int lds_byte(int r, int c) {
  const int st = (r >> 4) * 2 + (c >> 5), rr = r & 15, cc = c & 31, ob = rr * 64 + cc * 2;
  return st * 1024 + (ob ^ (((ob >> 9) & 1) << 5));
}
__host__ __device__ __forceinline__ void stage_rc(int b, int& R, int& C) {
  const int st = b / 1024, sb = b % 1024, swz = sb ^ (((sb >> 9) & 1) << 5);
  R = (st >> 1) * 16 + swz / 64; C = (st & 1) * 32 + (swz % 64) / 2;
}
__host__ __device__ __forceinline__ int perm32(int rho) { const int n = rho >> 4, i = rho & 15; return 8 * (i >> 2) + 4 * n + (i & 3); }

struct Unit { int pm, pn, e, mu, nv, cnt, seg; };

__device__ __forceinline__ bool static_next(int nM, int nN, int G, int c, int i, int& pm, int& pn) {
  const int nwg = nM * nN;
  const long Lx = (long)i * G + c; if (Lx >= nwg) return false;
  int wgid = (int)Lx;
  { const int q = nwg / NXCD, r = nwg % NXCD, xcd = wgid % NXCD, off = wgid / NXCD; wgid = (xcd < r ? xcd * (q + 1) : r * (q + 1) + (xcd - r) * q) + off; }
  const int nig = WGM * nN, gid = wgid / nig, fm = gid * WGM, gsz = (nM - fm) < WGM ? (nM - fm) : WGM;
  pm = fm + ((wgid % nig) % gsz); pn = (wgid % nig) / gsz; return true;
}

struct DenseOrder {
  const bf16_t* A; const bf16_t* Bt; int nM, nN, K, G, c;
  __device__ __forceinline__ bool next(int i, Unit& u) const {
    if (!static_next(nM, nN, G, c, i, u.pm, u.pn)) return false;
    u.e = 0; u.mu = 0; u.nv = 256; u.cnt = 256; u.seg = 0; return true;
  }
  __device__ __forceinline__ const char* a_base() const { return (const char*)A; }
  __device__ __forceinline__ const char* b_ptr(const Unit& u) const { return (const char*)Bt + (size_t)u.pn * 256 * K * 2; }
  __device__ __forceinline__ void a_offs(const Unit& u, const int (&R)[2], const int (&C)[2], unsigned (&ao)[2][2]) const {
#pragma unroll
    for (int h = 0; h < 2; ++h)
#pragma unroll
      for (int i = 0; i < 2; ++i) ao[h][i] = (unsigned)((u.pm * 256 + h * 128 + R[i]) * K + C[i]) * 2u;
  }
};

struct MoeOrder {
  const int* tab; const bf16_t* A; const bf16_t* Bt; const int* list; int NTn, K, G, c; bool gather;
  __device__ __forceinline__ bool next(int i, Unit& u) const {
    const int Lx = i * G + c;
    if (Lx >= tab[64] * NTn) return false;
    const int mg = Lx / NTn; u.pn = Lx - mg * NTn;
    int e = 0;
    while (tab[e + 1] <= mg) ++e;
    u.e = e; u.mu = mg - tab[e]; u.cnt = tab[130 + e]; u.seg = tab[65 + e];
    const int rem = u.cnt - u.mu * 256; u.nv = rem < 256 ? rem : 256; u.pm = 0; return true;
  }
  __device__ __forceinline__ const char* a_base() const { return (const char*)A; }
  __device__ __forceinline__ const char* b_ptr(const Unit& u) const { return (const char*)Bt + ((size_t)u.e * NTn + u.pn) * 256 * K * 2; }
  __device__ __forceinline__ void a_offs(const Unit& u, const int (&R)[2], const int (&C)[2], unsigned (&ao)[2][2]) const {
#pragma unroll
    for (int h = 0; h < 2; ++h)
#pragma unroll
      for (int i = 0; i < 2; ++i) {
        int idx = u.mu * 256 + h * 128 + R[i];
        int row;
        if (gather) { if (idx > u.cnt - 1) idx = u.cnt - 1; row = list[u.e * T + idx] >> 1; }
        else row = u.seg + idx;
        ao[h][i] = (unsigned)(row * K + C[i]) * 2u;
      }
  }
};

struct EpiBf16 {
  static constexpr bool PERM = true;
  bf16_t* O; int ldc; float* DT; const float* dt_bias;
  __device__ __forceinline__ void operator()(const f32x4 (&acc)[2][2][4][2], const Unit& u, int wr, int wc, int fr, int fq) const {
    const int row0 = u.pm * BM + wr * 64 + fr;
    if (u.pn == 12) {
      if (wc == 0 && fq < 2) {
        const f32x4 b0 = *(const f32x4*)(dt_bias + 8 * fq), b1 = *(const f32x4*)(dt_bias + 8 * fq + 4);
#pragma unroll
        for (int ai = 0; ai < 2; ++ai)
#pragma unroll
          for (int m = 0; m < 4; ++m) {
            float* dp = DT + (size_t)(row0 + ai * HALF + m * 16) * 16 + 8 * fq;
            *(f32x4*)dp = acc[ai][0][m][0] + b0; *(f32x4*)(dp + 4) = acc[ai][0][m][1] + b1;
          }
      }
      return;
    }
    const int col0 = u.pn * BM + wc * 32 + 8 * fq;
#pragma unroll
    for (int ai = 0; ai < 2; ++ai)
#pragma unroll
      for (int m = 0; m < 4; ++m) {
        bf16_t* rowp = O + (size_t)(row0 + ai * HALF + m * 16) * ldc + col0;
#pragma unroll
        for (int bj = 0; bj < 2; ++bj) {
          f32x4 v0 = acc[ai][bj][m][0], v1 = acc[ai][bj][m][1];
          u32x4 w; w.x = cvt_pk_bf16(v0[0], v0[1]); w.y = cvt_pk_bf16(v0[2], v0[3]); w.z = cvt_pk_bf16(v1[0], v1[1]); w.w = cvt_pk_bf16(v1[2], v1[3]);
          *(u32x4*)(rowp + bj * HALF) = w;
        }
      }
  }
};

struct EpiX1 {
  static constexpr bool PERM = false;
  const float* x; const float* mod; float* X1; float* SSQP;
  __device__ __forceinline__ void operator()(const f32x4 (&acc)[2][2][4][2], const Unit& u, int wr, int wc, int fr, int fq) const {
    const int row0 = u.pm * BM + wr * 64 + fr, col0 = u.pn * BM + wc * 32 + 4 * fq;
    const float* ga = mod + ((u.pm * BM) / L) * 6144 + 2048 + col0;
    f32x4 gv[2][2];
#pragma unroll
    for (int bj = 0; bj < 2; ++bj)
#pragma unroll
      for (int n = 0; n < 2; ++n) gv[bj][n] = *(const f32x4*)(ga + bj * HALF + n * 16);
#pragma unroll
    for (int ai = 0; ai < 2; ++ai)
#pragma unroll
      for (int m = 0; m < 4; ++m) {
        const size_t off = (size_t)(row0 + ai * HALF + m * 16) * D + col0;
        float ssq = 0.f;
#pragma unroll
        for (int bj = 0; bj < 2; ++bj)
#pragma unroll
          for (int n = 0; n < 2; ++n) {
            const f32x4 xv = *(const f32x4*)(x + off + bj * HALF + n * 16);
            const f32x4 o = xv + gv[bj][n] * acc[ai][bj][m][n];
            *(f32x4*)(X1 + off + bj * HALF + n * 16) = o;
            ssq += (o[0] * o[0] + o[1] * o[1]) + (o[2] * o[2] + o[3] * o[3]);
          }
        ssq += __shfl_xor(ssq, 16); ssq += __shfl_xor(ssq, 32);
        if (fq == 0) SSQP[(size_t)(row0 + ai * HALF + m * 16) * 16 + u.pn * 4 + wc] = ssq;
      }
  }
};

struct EpiSwiGLU {
  static constexpr bool PERM = true;
  bf16_t* HBb;
  __device__ __forceinline__ void operator()(const f32x4 (&acc)[2][2][4][2], const Unit& u, int wr, int wc, int fr, int fq) const {
    const int col0 = u.pn * 128 + wc * 32 + 8 * fq;
#pragma unroll
    for (int ai = 0; ai < 2; ++ai)
#pragma unroll
      for (int m = 0; m < 4; ++m) {
        const int slot = u.mu * 256 + ai * HALF + wr * 64 + m * 16 + fr;
        if (slot < u.cnt) {
          float h[8];
#pragma unroll
          for (int n = 0; n < 2; ++n)
#pragma unroll
            for (int j = 0; j < 4; ++j) { const float a = acc[ai][0][m][n][j]; h[n * 4 + j] = a / (1.f + __expf(-a)) * acc[ai][1][m][n][j]; }
          u32x4 w; w.x = cvt_pk_bf16(h[0], h[1]); w.y = cvt_pk_bf16(h[2], h[3]); w.z = cvt_pk_bf16(h[4], h[5]); w.w = cvt_pk_bf16(h[6], h[7]);
          *(u32x4*)(HBb + (size_t)(u.seg + slot) * DE + col0) = w;
        }
      }
  }
};

struct EpiDown {
  static constexpr bool PERM = true;
  bf16_t* YB2b; const int* list; const float* gate;
  __device__ __forceinline__ void operator()(const f32x4 (&acc)[2][2][4][2], const Unit& u, int wr, int wc, int fr, int fq) const {
    const int col0 = u.pn * 256 + wc * 32 + 8 * fq;
#pragma unroll
    for (int ai = 0; ai < 2; ++ai)
#pragma unroll
      for (int m = 0; m < 4; ++m) {
        const int slot = u.mu * 256 + ai * HALF + wr * 64 + m * 16 + fr;
        if (slot < u.cnt) {
          const int pair = list[u.e * T + slot];
          const float gt = gate[pair];
          bf16_t* rowp = YB2b + (size_t)pair * D + col0;
#pragma unroll
          for (int bj = 0; bj < 2; ++bj) {
            f32x4 v0 = acc[ai][bj][m][0] * gt, v1 = acc[ai][bj][m][1] * gt;
            u32x4 w; w.x = cvt_pk_bf16(v0[0], v0[1]); w.y = cvt_pk_bf16(v0[2], v0[3]); w.z = cvt_pk_bf16(v1[0], v1[1]); w.w = cvt_pk_bf16(v1[2], v1[3]);
            *(u32x4*)(rowp + bj * HALF) = w;
          }
        }
      }
  }
};

template <class Epi, class Sched>
__device__ __forceinline__ void gemm_phase(PG8_LAS unsigned char* lds, const int K, const Sched& S, const Epi& E) {
  const int tid = threadIdx.x, wid = __builtin_amdgcn_readfirstlane(tid >> 6), lane = tid & 63, wr = wid >> 2, wc = wid & 3, fr = lane & 15, fq = lane >> 4;
  const int nt = K / BK;
  int Rr[2], Cc[2];
  unsigned voffB[2];
#pragma unroll
  for (int i = 0; i < 2; ++i) {
    stage_rc(tid * 16 + i * 8192, Rr[i], Cc[i]);
    const int Rb = Epi::PERM ? ((Rr[i] & ~31) + perm32(Rr[i] & 31)) : Rr[i];
    voffB[i] = (unsigned)(Rb * K + Cc[i]) * 2u;
  }
  const size_t kstep = (size_t)(BK * 2);
  const size_t hstep = (size_t)HALF * K * 2;
  const unsigned ldsw = (unsigned)wid * 1024u;
  const int aoff = lds_byte(wr * 64 + fr, fq * 8), boff = lds_byte(wc * 32 + fr, fq * 8);
#define PG8_SA(b, h) (((b) * 2 + (h)) * HTB)
#define PG8_SB(b, h) ((4 + (b) * 2 + (h)) * HTB)
#define PG8_STAGE(bufoff, gbase, voff) do { _Pragma("unroll") for (int _i = 0; _i < 2; ++_i) \
    __builtin_amdgcn_global_load_lds((const unsigned*)((const char*)(gbase) + (voff)[_i]), (PG8_LAS unsigned*)(lds + (bufoff) + ldsw + _i * 8192), 16, 0, 0); } while (0)
#define PG8_LDA(dst, b, h) do { _Pragma("unroll") for (int m = 0; m < 4; ++m) _Pragma("unroll") for (int k = 0; k < 2; ++k) dst[m][k] = *(const PG8_LAS bf16x8*)(lds + PG8_SA(b, h) + aoff + m * 2048 + k * 1024); } while (0)
#define PG8_LDB(dst, b, h) do { _Pragma("unroll") for (int n = 0; n < 2; ++n) _Pragma("unroll") for (int k = 0; k < 2; ++k) dst[n][k] = *(const PG8_LAS bf16x8*)(lds + PG8_SB(b, h) + boff + n * 2048 + k * 1024); } while (0)
#define PG8_MMA(ai, bj, At, Bt) do { __builtin_amdgcn_s_setprio(1); _Pragma("unroll") for (int m = 0; m < 4; ++m) _Pragma("unroll") for (int n = 0; n < 2; ++n) _Pragma("unroll") for (int k = 0; k < 2; ++k) \
    acc[ai][bj][m][n] = __builtin_amdgcn_mfma_f32_16x16x32_bf16(Bt[n][k], At[m][k], acc[ai][bj][m][n], 0, 0, 0); __builtin_amdgcn_s_setprio(0); } while (0)
#define PG8_WAIT_V(n) asm volatile("s_waitcnt vmcnt(" #n ")" ::: "memory")
#define PG8_WAIT_L(n) asm volatile("s_waitcnt lgkmcnt(" #n ")" ::: "memory")
#define PG8_BAR __builtin_amdgcn_s_barrier()
#define PG8_SCHED __builtin_amdgcn_sched_barrier(0)
  Unit cur, nxt; int ui = 0;
  if (!S.next(0, cur)) return;
  f32x4 acc[2][2][4][2];
#pragma unroll
  for (int a = 0; a < 2; ++a)
#pragma unroll
    for (int b = 0; b < 2; ++b)
#pragma unroll
      for (int m = 0; m < 4; ++m)
#pragma unroll
        for (int n = 0; n < 2; ++n) acc[a][b][m][n] = (f32x4){0.f, 0.f, 0.f, 0.f};
  bf16x8 At[4][2], B0[2][2], B1[2][2];
  unsigned cao[2][2], nao[2][2];
  S.a_offs(cur, Rr, Cc, cao);
  const char* const aB = S.a_base();
  const char* cB = S.b_ptr(cur);
  PG8_STAGE(PG8_SB(0, 0), cB, voffB); PG8_STAGE(PG8_SA(0, 0), aB, cao[0]); PG8_STAGE(PG8_SB(0, 1), cB + hstep, voffB); PG8_STAGE(PG8_SA(0, 1), aB, cao[1]);
  if (wr == 1) PG8_BAR;
  PG8_WAIT_V(4); PG8_BAR;
  PG8_STAGE(PG8_SB(1, 0), cB + kstep, voffB); PG8_STAGE(PG8_SA(1, 0), aB + kstep, cao[0]); PG8_STAGE(PG8_SB(1, 1), cB + hstep + kstep, voffB);
  PG8_WAIT_V(6); PG8_BAR;
  for (;;) {
    const bool has_next = S.next(ui + 1, nxt);
    const char* nB = cB;
    if (has_next) { S.a_offs(nxt, Rr, Cc, nao); nB = S.b_ptr(nxt); }
    else {
#pragma unroll
      for (int h = 0; h < 2; ++h)
#pragma unroll
        for (int i = 0; i < 2; ++i) nao[h][i] = cao[h][i];
    }
    const bool full = cur.nv > 128;
    for (int t = 0; t < nt; t += 2) {
      const bool last = (t == nt - 2);
      const char* a1 = aB + (size_t)(t + 1) * kstep;
      const char* a2 = last ? aB : aB + (size_t)(t + 2) * kstep; const char* b2 = last ? nB : cB + (size_t)(t + 2) * kstep;
      const char* a3 = a2 + kstep; const char* b3 = b2 + kstep;
      unsigned so[2][2];
#pragma unroll
      for (int h = 0; h < 2; ++h)
#pragma unroll
        for (int i = 0; i < 2; ++i) so[h][i] = last ? nao[h][i] : cao[h][i];
      PG8_LDB(B0, 0, 0); PG8_SCHED; PG8_LDA(At, 0, 0); PG8_STAGE(PG8_SA(1, 1), a1, cao[1]);
      PG8_WAIT_L(8); PG8_BAR; PG8_WAIT_L(0); PG8_MMA(0, 0, At, B0); PG8_BAR; PG8_SCHED;
      PG8_LDB(B1, 0, 1); PG8_STAGE(PG8_SB(0, 0), b2, voffB);
      PG8_BAR; PG8_WAIT_L(0); PG8_MMA(0, 1, At, B1); PG8_BAR;
      PG8_LDA(At, 0, 1); PG8_STAGE(PG8_SA(0, 0), a2, so[0]);
      PG8_BAR; PG8_WAIT_L(0); if (full) PG8_MMA(1, 0, At, B0); PG8_BAR; PG8_SCHED;
      PG8_STAGE(PG8_SB(0, 1), b2 + hstep, voffB);
      PG8_WAIT_V(6); PG8_BAR; if (full) PG8_MMA(1, 1, At, B1); PG8_BAR;
      PG8_LDB(B0, 1, 0); PG8_SCHED; PG8_LDA(At, 1, 0); PG8_STAGE(PG8_SA(0, 1), a2, so[1]);
      PG8_WAIT_L(8); PG8_BAR; PG8_WAIT_L(0); PG8_MMA(0, 0, At, B0); PG8_BAR; PG8_SCHED;
      PG8_LDB(B1, 1, 1); PG8_STAGE(PG8_SB(1, 0), b3, voffB);
      PG8_BAR; PG8_WAIT_L(0); PG8_MMA(0, 1, At, B1); PG8_BAR;
      PG8_LDA(At, 1, 1); PG8_STAGE(PG8_SA(1, 0), a3, so[0]);
      PG8_BAR; PG8_WAIT_L(0); if (full) PG8_MMA(1, 0, At, B0); PG8_BAR; PG8_SCHED;
      PG8_STAGE(PG8_SB(1, 1), b3 + hstep, voffB);
      PG8_WAIT_V(6); PG8_BAR; if (full) PG8_MMA(1, 1, At, B1); PG8_BAR;
    }
    E(acc, cur, wr, wc, fr, fq);
    if (!has_next) break;
#pragma unroll
    for (int a = 0; a < 2; ++a)
#pragma unroll
      for (int b = 0; b < 2; ++b)
#pragma unroll
        for (int m = 0; m < 4; ++m)
#pragma unroll
          for (int n = 0; n < 2; ++n) acc[a][b][m][n] = (f32x4){0.f, 0.f, 0.f, 0.f};
    cur = nxt; cB = nB; ++ui;
#pragma unroll
    for (int h = 0; h < 2; ++h)
#pragma unroll
      for (int i = 0; i < 2; ++i) cao[h][i] = nao[h][i];
  }
  PG8_WAIT_V(0);
  if (wr == 0) PG8_BAR;
  PG8_BAR;
#undef PG8_SA
#undef PG8_SB
#undef PG8_STAGE
#undef PG8_LDA
#undef PG8_LDB
#undef PG8_MMA
#undef PG8_WAIT_V
#undef PG8_WAIT_L
#undef PG8_BAR
#undef PG8_SCHED
}
}

__device__ void ph_adaln(const Params& p, float* sm) {
  const int tid = threadIdx.x;
  if (blockIdx.x == 0 && tid < NE) p.CNT[tid] = 0;
  for (int e = blockIdx.x * NTHR + tid; e < 96 * 1024; e += gridDim.x * NTHR) {
    const int j = e >> 10, k = e & 1023;
    float w = 0.f;
    if (j < 64) w = p.w_expert[k * 64 + j]; else if (j < 72) w = p.w_group[k * 8 + (j - 64)];
    const unsigned hi = cvt_pk_bf16(w, 0.f) & 0xffffu;
    const float rem = w - __uint_as_float(hi << 16);
    p.WRhi[e] = (bf16_t)hi; p.WRlo[e] = (bf16_t)(cvt_pk_bf16(rem, 0.f) & 0xffffu);
  }
  float* sc = sm;
  float* red = sm + 9 * 1024;
  for (int e = tid; e < 9 * 1024; e += NTHR) {
    const int r = e >> 10, k = e & 1023;
    sc[e] = silu_f(r < 8 ? p.c[r * D + k] : p.c_ctx[k]);
  }
  __syncthreads();
  for (int item = blockIdx.x; item < 192; item += gridDim.x) {
    const int col0 = item * 32;
    const int kq = tid >> 3, c4 = (tid & 7) * 4;
    float acc[9][4];
#pragma unroll
    for (int r = 0; r < 9; ++r)
#pragma unroll
      for (int j = 0; j < 4; ++j) acc[r][j] = 0.f;
#pragma unroll 4
    for (int i = 0; i < 16; ++i) {
      const int k = kq + i * 64;
      const float4 w = *(const float4*)(p.w_ada + (size_t)k * 6144 + col0 + c4);
#pragma unroll
      for (int r = 0; r < 9; ++r) {
        const float sv = sc[r * 1024 + k];
        acc[r][0] += sv * w.x; acc[r][1] += sv * w.y; acc[r][2] += sv * w.z; acc[r][3] += sv * w.w;
      }
    }
#pragma unroll
    for (int r = 0; r < 9; ++r)
#pragma unroll
      for (int j = 0; j < 4; ++j) red[kq * 292 + r * 32 + c4 + j] = acc[r][j];
    __syncthreads();
    if (tid < 288) {
      float a = 0.f;
      for (int q = 0; q < 64; ++q) a += red[q * 292 + tid];
      const int r = tid >> 5, j = tid & 31;
      p.MOD[r * 6144 + col0 + j] = a + p.b_ada[col0 + j];
    }
    __syncthreads();
  }
}

__device__ void ph_filters(const Params& p, float* sm) {
  const int tid = threadIdx.x, wid = tid >> 6, lane = tid & 63;
  float* feats = sm;
  float* h1 = sm + 64 * 20;
  float* h2 = h1 + 64 * 64;
  bf16_t* tile = (bf16_t*)(h2 + 64 * 64);
  for (int e = blockIdx.x * NTHR + tid; e < 1024 * 137; e += gridDim.x * NTHR) {
    int rowi = e / 137, k = e - rowi * 137;
    int x = (k < 65) ? k : (4160 + (k - 65));
    p.FILTt[(size_t)rowi * FLEN + x] = 0;
  }
  for (int item = blockIdx.x; item < 256; item += gridDim.x) {
    const int tt = item >> 3, ct = item & 7;
    for (int e = tid; e < 64 * 17; e += NTHR) {
      int tp = e / 17, i = e - tp * 17;
      int t = tt * 64 + tp;
      float f;
      if (i == 0) f = (float)t / (float)(L - 1);
      else {
        int bi = (i - 1) & 7;
        float bandf = (float)(1e-4 + (double)bi * ((7.0 - 1e-4) / 7.0));
        float ang = (float)(2.0 * 3.14159265358979323846 / (double)L) * (float)t * bandf;
        f = (i <= 8) ? cosf(ang) : -sinf(ang);
      }
      feats[tp * 20 + i] = f;
    }
    __syncthreads();
    for (int e = tid; e < 4096; e += NTHR) {
      int tp = e >> 6, j = e & 63;
      float a = p.f_b1[j];
      for (int i = 0; i < 17; ++i) a += feats[tp * 20 + i] * p.f_w1[i * 64 + j];
      h1[e] = sinf(p.f_freq[j] * a);
    }
    __syncthreads();
    for (int e = tid; e < 4096; e += NTHR) {
      int tp = e >> 6, j = e & 63;
      float a = p.f_b2[j];
      for (int i = 0; i < 64; ++i) a += h1[tp * 64 + i] * p.f_w2[i * 64 + j];
      h2[e] = sinf(p.f_freq[j] * a);
    }
    __syncthreads();
    {
      const int col = tid & 255, half = tid >> 8;
      const int gcol = ct * 256 + col;
      float acc[32];
#pragma unroll
      for (int k = 0; k < 32; ++k) acc[k] = 0.f;
      for (int i = 0; i < 64; ++i) {
        float w = p.f_w3[i * 2048 + gcol];
#pragma unroll
        for (int k = 0; k < 32; ++k) acc[k] += h2[(half * 32 + k) * 64 + i] * w;
      }
      const int cch = gcol & 511;
      const float d0 = -4.605170185988091f / 1.5f, d1 = -4.605170185988091f / 0.3f;
      const float delta = fabsf(d0 + (float)cch * ((d1 - d0) / 511.f));
#pragma unroll
      for (int k = 0; k < 32; ++k) {
        int t = tt * 64 + half * 32 + k;
        float tn = (float)t / (float)(L - 1);
        tile[col * 66 + half * 32 + k] = f2bf(acc[k] * expf(-tn * delta));
      }
    }
    __syncthreads();
    for (int cl = wid * 32; cl < wid * 32 + 32; ++cl) {
      const int gcol = ct * 256 + cl;
      const int o = gcol >> 10, dir = (gcol >> 9) & 1, cch = gcol & 511;
      const int t = tt * 64 + lane;
      const int x = dir ? (HX0 + t) : (HX0 - t);
      if (!(dir && t == 0)) p.FILTt[(size_t)(o * 512 + cch) * FLEN + x] = tile[cl * 66 + lane];
    }
    __syncthreads();
  }
}

__device__ __forceinline__ void cvt_tile256(const float* src, int ld, int k0, int n0, bf16_t* dst, int ldd, int dmap0, int dmap1, int nsplit, float* sm) {
  const int tid = threadIdx.x;
  float* ts = sm;
  float4 v[8];
#pragma unroll
  for (int i = 0; i < 8; ++i) {
    const int e = tid + i * NTHR; const int k = e >> 6, n4 = (e & 63) * 4;
    v[i] = *(const float4*)(src + (size_t)(k0 + k) * ld + n0 + n4);
  }
#pragma unroll
  for (int i = 0; i < 8; ++i) {
    const int e = tid + i * NTHR; const int k = e >> 6, n4 = (e & 63) * 4;
    ts[k * 257 + n4 + 0] = v[i].x; ts[k * 257 + n4 + 1] = v[i].y; ts[k * 257 + n4 + 2] = v[i].z; ts[k * 257 + n4 + 3] = v[i].w;
  }
  __syncthreads();
#pragma unroll
  for (int i = 0; i < 4; ++i) {
    const int e = tid + i * NTHR; const int n = e >> 3, kq = (e & 7) * 8;
    uint4 w;
    w.x = cvt_pk_bf16(ts[(kq + 0) * 257 + n], ts[(kq + 1) * 257 + n]);
    w.y = cvt_pk_bf16(ts[(kq + 2) * 257 + n], ts[(kq + 3) * 257 + n]);
    w.z = cvt_pk_bf16(ts[(kq + 4) * 257 + n], ts[(kq + 5) * 257 + n]);
    w.w = cvt_pk_bf16(ts[(kq + 6) * 257 + n], ts[(kq + 7) * 257 + n]);
    const int drow = (n < nsplit) ? (dmap0 + n) : (dmap1 + (n - nsplit));
    *(uint4*)(dst + (size_t)drow * ldd + k0 + kq) = w;
  }
  __syncthreads();
}

__device__ void ph_wcvt(const Params& p, float* sm) {
  for (int e = blockIdx.x * NTHR + threadIdx.x; e < 16 * 1024; e += gridDim.x * NTHR) {
    const int j = e >> 10, k = e & 1023;
    p.WinT[(size_t)(DP + j) * D + k] = f2bf(p.w_in[(size_t)k * DIN + COL_DT + j]);
  }
  for (int it = blockIdx.x; it < 192 + 64; it += gridDim.x) {
    if (it < 192) { const int kt = it / 12, nt = it - kt * 12; cvt_tile256(p.w_in, DIN, kt * 64, nt * 256, p.WinT, D, nt * 256, 0, 256, sm); }
    else if (it < 256) { const int i = it - 192; const int kt = i >> 2, nt = i & 3; cvt_tile256(p.w_out, D, kt * 64, nt * 256, p.WoutT, D, nt * 256, 0, 256, sm); }
  }
}

__device__ void ph_norm1(const Params& p) {
  const int tid = threadIdx.x, wid = tid >> 6, lane = tid & 63;
  for (int row = blockIdx.x * 8 + wid; row < TT; row += gridDim.x * 8) {
    const float* src = (row < T) ? (p.x + (size_t)row * D) : (p.ctx + (size_t)(row - T) * D);
    const int mr = (row < T) ? (row / L) : 8;
    const float* sh = p.MOD + mr * 6144;
    const float* sc = sh + 1024;
    float4 v[4];
    float ss = 0.f;
#pragma unroll
    for (int i = 0; i < 4; ++i) {
      v[i] = *(const float4*)(src + i * 256 + lane * 4);
      ss += v[i].x * v[i].x + v[i].y * v[i].y + v[i].z * v[i].z + v[i].w * v[i].w;
    }
    ss = wave_sum(ss);
    const float rstd = rsqrtf(ss * (1.f / D) + EPS);
#pragma unroll
    for (int i = 0; i < 4; ++i) {
      const int col = i * 256 + lane * 4;
      float4 g = *(const float4*)(p.g1 + col);
      float4 s4 = *(const float4*)(sc + col);
      float4 h4 = *(const float4*)(sh + col);
      float4 o;
      o.x = v[i].x * rstd * g.x * (1.f + s4.x) + h4.x;
      o.y = v[i].y * rstd * g.y * (1.f + s4.y) + h4.y;
      o.z = v[i].z * rstd * g.z * (1.f + s4.z) + h4.z;
      o.w = v[i].w * rstd * g.w * (1.f + s4.w) + h4.w;
      uint2 w; w.x = cvt_pk_bf16(o.x, o.y); w.y = cvt_pk_bf16(o.z, o.w);
      *(uint2*)(p.XNb + (size_t)row * D + col) = w;
    }
  }
}

__device__ void ph_hy_convT(const Params& p, float* sm) {
  const int tid = threadIdx.x;
  float* tile = sm;
  const int bid = blockIdx.x;
  int it0, it1;
  if (gridDim.x == 256) { if (bid < 32) { it0 = bid * 3; it1 = it0 + 3; } else { it0 = 96 + (bid - 32) * 27; it1 = it0 + 27; } }
  else { const int per = (256 * 24 + gridDim.x - 1) / gridDim.x; it0 = bid * per; it1 = it0 + per; if (it1 > 256 * 24) it1 = 256 * 24; }
  for (int item = it0; item < it1; ++item) {
    const int gr = item / 24, ct = item - gr * 24;
    const int row0 = gr * 64;
    {
      const int t = tid >> 3, c8 = (tid & 7) * 8;
      uint4 v = *(const uint4*)(p.PXb + (size_t)(row0 + t) * DP + ct * 64 + c8);
      unsigned w[4] = {v.x, v.y, v.z, v.w};
#pragma unroll
      for (int k = 0; k < 4; ++k) {
        tile[t * 65 + c8 + 2 * k] = __uint_as_float(w[k] << 16);
        tile[t * 65 + c8 + 2 * k + 1] = __uint_as_float(w[k] & 0xffff0000u);
      }
    }
    __syncthreads();
    {
      const int cc = tid >> 3, t8 = (tid & 7) * 8;
      const int col = ct * 64 + cc;
      const float w0 = p.hy_conv_w[col], w1 = p.hy_conv_w[HYC + col], w2 = p.hy_conv_w[2 * HYC + col], bb = p.hy_conv_b[col];
      float o[8];
#pragma unroll
      for (int k = 0; k < 8; ++k) {
        const int t = t8 + k;
        float v = bb + w1 * tile[t * 65 + cc];
        if (t > 0) v += w0 * tile[(t - 1) * 65 + cc];
        if (t < 63) v += w2 * tile[(t + 1) * 65 + cc];
        o[k] = v;
      }
      uint4 w; w.x = cvt_pk_bf16(o[0], o[1]); w.y = cvt_pk_bf16(o[2], o[3]); w.z = cvt_pk_bf16(o[4], o[5]); w.w = cvt_pk_bf16(o[6], o[7]);
      *(uint4*)(p.Ut + (size_t)col * T + row0 + t8) = w;
    }
    __syncthreads();
  }
}

__device__ void ph_hy_backT(const Params& p, float* sm) {
  const int tid = threadIdx.x;
  bf16_t* tile = (bf16_t*)sm;
  for (int item = blockIdx.x; item < 256 * 8; item += gridDim.x) {
    const int gr = item >> 3, ct = item & 7;
    const int row0 = gr * 64;
    {
      const int cc = tid >> 3, r8 = (tid & 7) * 8;
      uint4 v = *(const uint4*)(p.Yt + (size_t)(ct * 64 + cc) * T + row0 + r8);
      unsigned w[4] = {v.x, v.y, v.z, v.w};
#pragma unroll
      for (int k = 0; k < 4; ++k) {
        tile[cc * 66 + r8 + 2 * k] = (bf16_t)(w[k] & 0xffffu);
        tile[cc * 66 + r8 + 2 * k + 1] = (bf16_t)(w[k] >> 16);
      }
    }
    __syncthreads();
    {
      const int r = tid >> 3, c8 = (tid & 7) * 8;
      unsigned w[4];
#pragma unroll
      for (int k = 0; k < 4; ++k) w[k] = (unsigned)tile[(c8 + 2 * k) * 66 + r] | ((unsigned)tile[(c8 + 2 * k + 1) * 66 + r] << 16);
      uint4 o; o.x = w[0]; o.y = w[1]; o.z = w[2]; o.w = w[3];
      *(uint4*)(p.YMIXb + (size_t)(row0 + r) * D + ct * 64 + c8) = o;
    }
    __syncthreads();
  }
}

typedef short hbf16x8 __attribute__((ext_vector_type(8)));
typedef float hf32x4 __attribute__((ext_vector_type(4)));

constexpr int HY_FC = 0, HY_ZT0 = 4 * FCLEN * 2, HY_ZT1 = HY_ZT0 + 8 * ZSTRB;

__device__ __forceinline__ void hy_build_filter(const Params& p, int o, int c, unsigned char* lds) {
  const int tid = threadIdx.x;
  const bf16_t* gsrc = p.FILTt + (size_t)(o * 512 + c) * FLEN;
  for (int e = tid; e < 530; e += NTHR) {
    uint4 v = make_uint4(0u, 0u, 0u, 0u);
    if (e < 529) v = *(const uint4*)(gsrc + e * 8);
    *(uint4*)(lds + HY_FC + e * 16) = v;
  }
  __syncthreads();
  for (int g = tid; g < 3 * 530; g += NTHR) {
    const int r = 1 + g / 530, ch = g % 530;
    uint4 lo = make_uint4(0u, 0u, 0u, 0u);
    if (ch > 0) lo = *(const uint4*)(lds + HY_FC + (ch - 1) * 16);
    uint4 hi = *(const uint4*)(lds + HY_FC + ch * 16);
    unsigned W[8] = {lo.x, lo.y, lo.z, lo.w, hi.x, hi.y, hi.z, hi.w};
    uint4 ov;
    if (r == 1) {
      ov.x = __builtin_amdgcn_alignbyte(W[4], W[3], 2); ov.y = __builtin_amdgcn_alignbyte(W[5], W[4], 2);
      ov.z = __builtin_amdgcn_alignbyte(W[6], W[5], 2); ov.w = __builtin_amdgcn_alignbyte(W[7], W[6], 2);
    } else if (r == 2) {
      ov.x = W[3]; ov.y = W[4]; ov.z = W[5]; ov.w = W[6];
    } else {
      ov.x = __builtin_amdgcn_alignbyte(W[3], W[2], 2); ov.y = __builtin_amdgcn_alignbyte(W[4], W[3], 2);
      ov.z = __builtin_amdgcn_alignbyte(W[5], W[4], 2); ov.w = __builtin_amdgcn_alignbyte(W[6], W[5], 2);
    }
    *(uint4*)(lds + HY_FC + r * (FCLEN * 2) + ch * 16) = ov;
  }
  __syncthreads();
}

__device__ __forceinline__ void hy_order(const Params& p, int o, int c, unsigned char* lds) {
  const int tid = threadIdx.x, wid = __builtin_amdgcn_readfirstlane(tid >> 6), lane = tid & 63;
  const int g0 = wid * 4;
  const int n16 = lane & 15, h = lane >> 4, bb = n16 & 7, pp = n16 >> 3;
  const unsigned char* Zin = lds + (o ? HY_ZT1 : HY_ZT0);
  const bf16_t* gate = p.Ut + (size_t)((o + 1) * 512 + c) * T + bb * L;
  uint2 xg[4][2];
#pragma unroll
  for (int i = 0; i < 4; ++i)
#pragma unroll
    for (int u = 0; u < 2; ++u) xg[i][u] = *(const uint2*)(gate + 32 * (2 * (g0 + i) + pp) + 16 * u + 4 * h);
  const float bias = p.hy_bias[o * 512 + c];
  hf32x4 acc[4][2];
#pragma unroll
  for (int i = 0; i < 4; ++i)
#pragma unroll
    for (int u = 0; u < 2; ++u) acc[i][u] = (hf32x4){0.f, 0.f, 0.f, 0.f};
  const int ai = lane & 15, ar = ai & 3, aq = ai >> 2;
  const unsigned char* laneA = lds + HY_FC + ar * (FCLEN * 2) + 2 * (HX0 - 4 * aq + 8 * h);
  const unsigned char* laneB = Zin + bb * ZSTRB + 64 + 64 * pp + 16 * h;
#define HY_LDA(dst, Dd) do { const uint2 _lo = *(const uint2*)(laneA - 32 * (Dd)); const uint2 _hi = *(const uint2*)(laneA - 32 * (Dd) + 8); \
    union { uint4 u4; hbf16x8 v; } _cv; _cv.u4 = make_uint4(_lo.x, _lo.y, _hi.x, _hi.y); dst = _cv.v; } while (0)
#define HY_LDB(dst, Qq) do { dst = *(const hbf16x8*)(laneB + 64 * (Qq)); } while (0)
#pragma unroll 1
  for (int pass = 0; pass < 2; ++pass) {
    const int Es = 2 * g0 - 63 + pass;
    hbf16x8 R[4];
    HY_LDB(R[1], 2 * (g0 + 1) - Es); HY_LDB(R[2], 2 * (g0 + 2) - Es); HY_LDB(R[3], 2 * (g0 + 3) - Es);
#pragma unroll 1
    for (int n4 = 0; n4 < 9; ++n4) {
#pragma unroll
      for (int j = 0; j < 4; ++j) {
        const int n = n4 * 4 + j;
        const int E = Es + 2 * n;
        HY_LDB(R[(4 - j) & 3], 2 * (g0 - n) - Es);
        hbf16x8 A0, A1;
        HY_LDA(A0, 2 * E); HY_LDA(A1, 2 * E + 1);
#pragma unroll
        for (int i = 0; i < 4; ++i) {
          const int Q = 2 * (g0 + i - n) - Es;
          if (Q >= -1 && Q <= 63) {
            acc[i][0] = __builtin_amdgcn_mfma_f32_16x16x32_bf16(A0, R[(i - j) & 3], acc[i][0], 0, 0, 0);
            acc[i][1] = __builtin_amdgcn_mfma_f32_16x16x32_bf16(A1, R[(i - j) & 3], acc[i][1], 0, 0, 0);
          }
        }
      }
    }
  }
#undef HY_LDA
#undef HY_LDB
#pragma unroll
  for (int i = 0; i < 4; ++i)
#pragma unroll
    for (int u = 0; u < 2; ++u) {
      const int t0 = 32 * (2 * (g0 + i) + pp) + 16 * u + 4 * h;
      const uint2 zv = *(const uint2*)(Zin + bb * ZSTRB + 64 + 2 * t0);
      const float z0 = __uint_as_float(zv.x << 16), z1 = __uint_as_float(zv.x & 0xffff0000u), z2 = __uint_as_float(zv.y << 16), z3 = __uint_as_float(zv.y & 0xffff0000u);
      const float x0 = __uint_as_float(xg[i][u].x << 16), x1 = __uint_as_float(xg[i][u].x & 0xffff0000u), x2 = __uint_as_float(xg[i][u].y << 16), x3 = __uint_as_float(xg[i][u].y & 0xffff0000u);
      const float r0 = x0 * (acc[i][u][0] + z0 * bias), r1 = x1 * (acc[i][u][1] + z1 * bias), r2 = x2 * (acc[i][u][2] + z2 * bias), r3 = x3 * (acc[i][u][3] + z3 * bias);
      uint2 w; w.x = cvt_pk_bf16(r0, r1); w.y = cvt_pk_bf16(r2, r3);
      if (o == 0) *(uint2*)(lds + HY_ZT1 + bb * ZSTRB + 64 + 2 * t0) = w;
      else *(uint2*)(p.Yt + (size_t)c * T + bb * L + t0) = w;
    }
}

__device__ void hyena_unit(const Params& p, int c, unsigned char* lds) {
  const int tid = threadIdx.x;
  if (tid < 144) {
    const int buf = tid / 72, rem = tid % 72, b = rem / 9, k = rem % 9;
    const int off = (k < 4) ? (k * 16) : (4160 + (k - 4) * 16);
    *(uint4*)(lds + (buf ? HY_ZT1 : HY_ZT0) + b * ZSTRB + off) = make_uint4(0u, 0u, 0u, 0u);
  }
  for (int e = tid; e < 2048; e += NTHR) {
    const int b = e >> 8, ch = e & 255;
    *(uint4*)(lds + HY_ZT0 + b * ZSTRB + 64 + ch * 16) = *(const uint4*)(p.Ut + (size_t)c * T + b * L + ch * 8);
  }
#pragma unroll 1
  for (int o = 0; o < 2; ++o) {
    hy_build_filter(p, o, c, lds);
    hy_order(p, o, c, lds);
    __syncthreads();
  }
}

constexpr int SROW = 272;

__device__ __forceinline__ void ssd_stage_nat(const Params& p, int row0, int pxcol0, int cvcol0, unsigned char* dst) {
  for (int e = threadIdx.x; e < 2048; e += NTHR) {
    const int l = e >> 4, cg = e & 15;
    const int row = row0 + l, li = row & 63;
    const bf16_t* src = p.PXb + (size_t)row * DP + pxcol0 + cg * 8;
    const uint4 zero4 = make_uint4(0u, 0u, 0u, 0u);
    const uint4 cur = *(const uint4*)src;
    const uint4 prv = (li > 0) ? *(const uint4*)(src - DP) : zero4;
    const uint4 nxt = (li < 63) ? *(const uint4*)(src + DP) : zero4;
    const float* cw = p.ssd_conv_w + cvcol0 + cg * 8;
    const float* cb = p.ssd_conv_b + cvcol0 + cg * 8;
    const unsigned pc[4] = {prv.x, prv.y, prv.z, prv.w}, cc[4] = {cur.x, cur.y, cur.z, cur.w}, nc[4] = {nxt.x, nxt.y, nxt.z, nxt.w};
    float o[8];
#pragma unroll
    for (int k = 0; k < 4; ++k) {
      const float p0 = __uint_as_float(pc[k] << 16), p1 = __uint_as_float(pc[k] & 0xffff0000u);
      const float c0 = __uint_as_float(cc[k] << 16), c1 = __uint_as_float(cc[k] & 0xffff0000u);
      const float n0 = __uint_as_float(nc[k] << 16), n1 = __uint_as_float(nc[k] & 0xffff0000u);
      const float v0 = cb[2 * k] + cw[2 * k] * p0 + cw[DXBC + 2 * k] * c0 + cw[2 * DXBC + 2 * k] * n0;
      const float v1 = cb[2 * k + 1] + cw[2 * k + 1] * p1 + cw[DXBC + 2 * k + 1] * c1 + cw[2 * DXBC + 2 * k + 1] * n1;
      o[2 * k] = silu_f(v0); o[2 * k + 1] = silu_f(v1);
    }
    uint4 w; w.x = cvt_pk_bf16(o[0], o[1]); w.y = cvt_pk_bf16(o[2], o[3]); w.z = cvt_pk_bf16(o[4], o[5]); w.w = cvt_pk_bf16(o[6], o[7]);
    *(uint4*)(dst + l * SROW + cg * 16) = w;
  }
}

__device__ __forceinline__ void ssd_stage_tr(const Params& p, int row0, bool is_ctx, int pxcol0, int cvcol0, int ncols, unsigned char* dst) {
  const int ncg = ncols >> 2;
  for (int e = threadIdx.x; e < ncg * 16; e += NTHR) {
    const int cg = e % ncg, l8 = e / ncg;
    const int rowf = row0 + l8 * 8;
    bool has_prev, has_next;
    if (is_ctx) { const int tc = (rowf - T) & (LC - 1); has_prev = tc > 0; has_next = tc + 7 < LC - 1; }
    else { const int li = rowf & 63; has_prev = li > 0; has_next = li + 7 < 63; }
    const bf16_t* src = p.PXb + (size_t)rowf * DP + pxcol0 + cg * 4;
    const uint2 z2 = make_uint2(0u, 0u);
    uint2 raw[10];
    raw[0] = *(const uint2*)((cvcol0 >= 0 && has_prev) ? (src - DP) : src);
    if (!(cvcol0 >= 0 && has_prev)) raw[0] = z2;
#pragma unroll
    for (int k = 0; k < 8; ++k) raw[k + 1] = *(const uint2*)(src + (size_t)k * DP);
    raw[9] = *(const uint2*)((cvcol0 >= 0 && has_next) ? (src + (size_t)8 * DP) : src);
    if (!(cvcol0 >= 0 && has_next)) raw[9] = z2;
    unsigned outw[4][4];
    if (cvcol0 >= 0) {
      const float* cw = p.ssd_conv_w + cvcol0 + cg * 4; const float* cb = p.ssd_conv_b + cvcol0 + cg * 4;
      const float4 a0 = *(const float4*)cw, b0 = *(const float4*)(cw + DXBC), c0 = *(const float4*)(cw + 2 * DXBC), d0 = *(const float4*)cb;
      const float w0[4] = {a0.x, a0.y, a0.z, a0.w}, w1[4] = {b0.x, b0.y, b0.z, b0.w}, w2[4] = {c0.x, c0.y, c0.z, c0.w}, bb[4] = {d0.x, d0.y, d0.z, d0.w};
#pragma unroll
      for (int kp = 0; kp < 4; ++kp) {
#pragma unroll
        for (int c = 0; c < 4; ++c) {
          const unsigned q0 = (c >> 1) ? raw[2 * kp].y : raw[2 * kp].x, q1 = (c >> 1) ? raw[2 * kp + 1].y : raw[2 * kp + 1].x;
          const unsigned q2 = (c >> 1) ? raw[2 * kp + 2].y : raw[2 * kp + 2].x, q3 = (c >> 1) ? raw[2 * kp + 3].y : raw[2 * kp + 3].x;
          float x0, x1, x2, x3;
          if (c & 1) { x0 = __uint_as_float(q0 & 0xffff0000u); x1 = __uint_as_float(q1 & 0xffff0000u); x2 = __uint_as_float(q2 & 0xffff0000u); x3 = __uint_as_float(q3 & 0xffff0000u); }
          else { x0 = __uint_as_float(q0 << 16); x1 = __uint_as_float(q1 << 16); x2 = __uint_as_float(q2 << 16); x3 = __uint_as_float(q3 << 16); }
          const float oa = silu_f(bb[c] + w0[c] * x0 + w1[c] * x1 + w2[c] * x2);
          const float ob = silu_f(bb[c] + w0[c] * x1 + w1[c] * x2 + w2[c] * x3);
          outw[c][kp] = cvt_pk_bf16(oa, ob);
        }
      }
    } else {
#pragma unroll
      for (int kp = 0; kp < 4; ++kp) {
#pragma unroll
        for (int c = 0; c < 4; ++c) {
          const unsigned q1 = (c >> 1) ? raw[2 * kp + 1].y : raw[2 * kp + 1].x, q2 = (c >> 1) ? raw[2 * kp + 2].y : raw[2 * kp + 2].x;
          outw[c][kp] = (c & 1) ? ((q1 >> 16) | (q2 & 0xffff0000u)) : ((q1 & 0xffffu) | (q2 << 16));
        }
      }
    }
#pragma unroll
    for (int c = 0; c < 4; ++c)
      *(uint4*)(dst + (cg * 4 + c) * SROW + l8 * 16) = make_uint4(outw[c][0], outw[c][1], outw[c][2], outw[c][3]);
  }
}

__device__ __forceinline__ void ssd_stage_tr_s(const Params& p, int row0, bool is_ctx, int pxcol0, int cvcol0, int ncols, unsigned char* dst) {
  for (int e = threadIdx.x; e < ncols * 16; e += NTHR) {
    const int col = e & (ncols - 1), l8 = e / ncols;
    const int rowf = row0 + l8 * 8;
    bool has_prev, has_next;
    if (is_ctx) { const int tc = (rowf - T) & (LC - 1); has_prev = tc > 0; has_next = tc + 7 < LC - 1; }
    else { const int li = rowf & 63; has_prev = li > 0; has_next = li + 7 < 63; }
    const bf16_t* src = p.PXb + (size_t)rowf * DP + pxcol0 + col;
    float x[10];
    x[0] = (cvcol0 >= 0 && has_prev) ? bf2f(src[-DP]) : 0.f;
#pragma unroll
    for (int k = 0; k < 8; ++k) x[k + 1] = bf2f(src[(size_t)k * DP]);
    x[9] = (cvcol0 >= 0 && has_next) ? bf2f(src[(size_t)8 * DP]) : 0.f;
    float o[8];
    if (cvcol0 >= 0) {
      const float w0 = p.ssd_conv_w[cvcol0 + col], w1 = p.ssd_conv_w[DXBC + cvcol0 + col], w2 = p.ssd_conv_w[2 * DXBC + cvcol0 + col], bb = p.ssd_conv_b[cvcol0 + col];
#pragma unroll
      for (int k = 0; k < 8; ++k) o[k] = silu_f(bb + w0 * x[k] + w1 * x[k + 1] + w2 * x[k + 2]);
    } else {
#pragma unroll
      for (int k = 0; k < 8; ++k) o[k] = x[k + 1];
    }
    uint4 w; w.x = cvt_pk_bf16(o[0], o[1]); w.y = cvt_pk_bf16(o[2], o[3]); w.z = cvt_pk_bf16(o[4], o[5]); w.w = cvt_pk_bf16(o[6], o[7]);
    *(uint4*)(dst + col * SROW + l8 * 16) = w;
  }
}

__device__ void ssd_states_unit(const Params& p, int unit, unsigned char* lds) {
  const int tid = threadIdx.x, wid = __builtin_amdgcn_readfirstlane(tid >> 6), lane = tid & 63;
  const int g = unit & 1, bc = unit >> 1, cidx = bc % 18, b = bc / 18;
  const bool is_ctx = cidx < 2;
  const int row0 = is_ctx ? (T + b * LC + cidx * 128) : (b * L + (cidx - 2) * 128);
  unsigned char* XT = lds;
  unsigned char* BT = lds + 69632;
  unsigned char* XD = lds + 104448;
  float* WG = (float*)(lds + 121856);
  ssd_stage_tr(p, row0, is_ctx, COL_XBC + g * 256, g * 256, 256, XT);
  ssd_stage_tr(p, row0, is_ctx, COL_XBC + 512 + g * 128, 512 + g * 128, 128, BT);
  {
    const int dir = wid >> 2, hh = wid & 3, h = g * 4 + hh;
    const float A = expf(p.a_log[dir * 8 + h]);
    const int l0 = 2 * lane, l1 = l0 + 1;
    const float dt0 = softplus_f(p.DT[(size_t)(row0 + l0) * 16 + dir * 8 + h]), dt1 = softplus_f(p.DT[(size_t)(row0 + l1) * 16 + dir * 8 + h]);
    const float a0 = -A * dt0, a1 = -A * dt1, pair = a0 + a1;
    float incl = pair;
#pragma unroll
    for (int o = 1; o < 64; o <<= 1) { float t = __shfl_up(incl, o); if (lane >= o) incl += t; }
    const float excl = incl - pair;
    const float total = __shfl(incl, 63);
    float w0, w1, c0, c1;
    if (dir == 0) { c0 = excl + a0; c1 = excl + pair; w0 = dt0 * expf(total - c0); w1 = dt1 * expf(total - c1); }
    else { const float pe0 = excl, pe1 = excl + a0; w0 = dt0 * expf(pe0); w1 = dt1 * expf(pe1); c0 = total - pe0; c1 = total - pe1; }
    WG[wid * 128 + l0] = w0; WG[wid * 128 + l1] = w1;
    if (!is_ctx) { float* ac = p.ACUM + (size_t)(b * 16 + dir * 8 + h) * L + (cidx - 2) * 128; *(float2*)(ac + l0) = make_float2(c0, c1); }
    if (lane == 0) {
      const int k = dir ? (is_ctx ? (1 - cidx) : (19 - cidx)) : cidx;
      p.CDEC[(size_t)(((b * 2 + dir) * 8 + h) * 18 + k) * 32] = expf(total);
    }
  }
  __syncthreads();
  const int fr = lane & 15, fq = lane >> 4;
#pragma unroll 1
  for (int it = 0; it < 8; ++it) {
    const int dir = it >> 2, hh = it & 3, h = g * 4 + hh;
    for (int e = tid; e < 1024; e += NTHR) {
      const int pr = e >> 4, ch = e & 15;
      const uint4 v = *(const uint4*)(XT + (hh * 64 + pr) * SROW + ch * 16);
      const float4 wa = *(const float4*)(WG + it * 128 + ch * 8), wb = *(const float4*)(WG + it * 128 + ch * 8 + 4);
      uint4 w;
      w.x = cvt_pk_bf16(__uint_as_float(v.x << 16) * wa.x, __uint_as_float(v.x & 0xffff0000u) * wa.y);
      w.y = cvt_pk_bf16(__uint_as_float(v.y << 16) * wa.z, __uint_as_float(v.y & 0xffff0000u) * wa.w);
      w.z = cvt_pk_bf16(__uint_as_float(v.z << 16) * wb.x, __uint_as_float(v.z & 0xffff0000u) * wb.y);
      w.w = cvt_pk_bf16(__uint_as_float(v.w << 16) * wb.z, __uint_as_float(v.w & 0xffff0000u) * wb.w);
      *(uint4*)(XD + pr * SROW + ch * 16) = w;
    }
    __syncthreads();
    hf32x4 acc[4];
#pragma unroll
    for (int pt = 0; pt < 4; ++pt) acc[pt] = (hf32x4){0.f, 0.f, 0.f, 0.f};
#pragma unroll
    for (int kk = 0; kk < 4; ++kk) {
      const hbf16x8 Bf = *(const hbf16x8*)(BT + (16 * wid + fr) * SROW + 2 * (32 * kk + 8 * fq));
#pragma unroll
      for (int pt = 0; pt < 4; ++pt) {
        const hbf16x8 Af = *(const hbf16x8*)(XD + (16 * pt + fr) * SROW + 2 * (32 * kk + 8 * fq));
        acc[pt] = __builtin_amdgcn_mfma_f32_16x16x32_bf16(Bf, Af, acc[pt], 0, 0, 0);
      }
    }
    const int k = dir ? (is_ctx ? (1 - cidx) : (19 - cidx)) : cidx;
    bf16_t* slot = p.SST + ((size_t)(((b * 2 + dir) * 8 + h) * 18 + k)) * 8192;
#pragma unroll
    for (int pt = 0; pt < 4; ++pt)
      *(uint2*)(slot + (16 * pt + fr) * 128 + 16 * wid + 4 * fq) = make_uint2(cvt_pk_bf16(acc[pt][0], acc[pt][1]), cvt_pk_bf16(acc[pt][2], acc[pt][3]));
    __syncthreads();
  }
}

__device__ void ssd_scan_unit(const Params& p, int unit) {
  const int tid = threadIdx.x;
  const int half = unit & 1, seq = unit >> 1;
  const int pr = half * 32 + (tid >> 4), n8 = (tid & 15) * 8;
  const bf16_t* base = p.SST + (size_t)seq * 18 * 8192 + pr * 128 + n8;
  uint4 sv[18];
#pragma unroll
  for (int k = 0; k < 18; ++k) sv[k] = *(const uint4*)(base + (size_t)k * 8192);
  float hst[8];
#pragma unroll
  for (int j = 0; j < 8; ++j) hst[j] = 0.f;
#pragma unroll
  for (int k = 0; k < 18; ++k) {
    const float dec = p.CDEC[(size_t)(seq * 18 + k) * 32];
    if (k >= 2) {
      uint4 w; w.x = cvt_pk_bf16(hst[0], hst[1]); w.y = cvt_pk_bf16(hst[2], hst[3]); w.z = cvt_pk_bf16(hst[4], hst[5]); w.w = cvt_pk_bf16(hst[6], hst[7]);
      *(uint4*)(p.HIN + ((size_t)seq * 16 + (k - 2)) * 8192 + pr * 128 + n8) = w;
    }
    const unsigned sw[4] = {sv[k].x, sv[k].y, sv[k].z, sv[k].w};
#pragma unroll
    for (int u = 0; u < 4; ++u) {
      hst[2 * u] = dec * hst[2 * u] + __uint_as_float(sw[u] << 16);
      hst[2 * u + 1] = dec * hst[2 * u + 1] + __uint_as_float(sw[u] & 0xffff0000u);
    }
  }
}

__device__ void ssd_out_unit(const Params& p, int unit, unsigned char* lds) {
  const int tid = threadIdx.x, wid = __builtin_amdgcn_readfirstlane(tid >> 6), lane = tid & 63;
  const int fr = lane & 15, fq = lane >> 4;
  const int g = unit & 1, bc = unit >> 1, c = bc & 15, b = bc >> 4;
  const int row0 = b * L + c * 128;
  unsigned char* CS = lds;
  unsigned char* ML = lds + 34816;
  unsigned char* XT = lds + 69632;
  unsigned char* ZT = lds + 87040;
  unsigned char* HS = lds + 104448;
  float* CUM = (float*)(lds + 121856);
  float* DTL = (float*)(lds + 125952);
  ssd_stage_nat(p, row0, COL_XBC + 768 + g * 128, 768 + g * 128, CS);
  ssd_stage_nat(p, row0, COL_XBC + 512 + g * 128, 512 + g * 128, ML);
  for (int e = tid; e < 1024; e += NTHR) {
    const int it = e >> 7, l = e & 127, dir = it >> 2, hh = it & 3;
    CUM[e] = p.ACUM[(size_t)(b * 16 + dir * 8 + g * 4 + hh) * L + c * 128 + l];
    DTL[e] = softplus_f(p.DT[(size_t)(row0 + l) * 16 + dir * 8 + g * 4 + hh]);
  }
  __syncthreads();
  hf32x4 cbt[8];
#pragma unroll
  for (int lt = 0; lt < 8; ++lt) cbt[lt] = (hf32x4){0.f, 0.f, 0.f, 0.f};
#pragma unroll
  for (int kk = 0; kk < 4; ++kk) {
    const hbf16x8 Af = *(const hbf16x8*)(ML + (16 * wid + fr) * SROW + 2 * (32 * kk + 8 * fq));
#pragma unroll
    for (int lt = 0; lt < 8; ++lt) {
      const hbf16x8 Bf = *(const hbf16x8*)(CS + (16 * lt + fr) * SROW + 2 * (32 * kk + 8 * fq));
      cbt[lt] = __builtin_amdgcn_mfma_f32_16x16x32_bf16(Af, Bf, cbt[lt], 0, 0, 0);
    }
  }
  __syncthreads();
  hf32x4 y[4][4];
#pragma unroll
  for (int hh = 0; hh < 4; ++hh)
#pragma unroll
    for (int pt = 0; pt < 4; ++pt) y[hh][pt] = (hf32x4){0.f, 0.f, 0.f, 0.f};
  const int sb = 16 * wid + 4 * fq;
#pragma unroll 1
  for (int hh = 0; hh < 4; ++hh) {
    const int h = g * 4 + hh;
    hf32x4 yc[4];
#pragma unroll
    for (int pt = 0; pt < 4; ++pt) yc[pt] = (hf32x4){0.f, 0.f, 0.f, 0.f};
    ssd_stage_tr_s(p, row0, false, COL_XBC + g * 256 + hh * 64, g * 256 + hh * 64, 64, XT);
    ssd_stage_tr_s(p, row0, false, COL_Z + g * 256 + hh * 64, -1, 64, ZT);
#pragma unroll 1
    for (int dir = 0; dir < 2; ++dir) {
      const int it = dir * 4 + hh;
      const int k = dir ? (17 - c) : (c + 2);
      const bf16_t* slot = p.HIN + ((size_t)(((b * 2 + dir) * 8 + h) * 16 + (k - 2))) * 8192;
      for (int e = tid; e < 1024; e += NTHR) {
        const int pr = e >> 4, ch = e & 15;
        *(uint4*)(HS + pr * SROW + ch * 16) = *(const uint4*)(slot + pr * 128 + ch * 8);
      }
      {
        const float* cu = CUM + it * 128; const float* dl = DTL + it * 128;
        float cs[4], ds[4];
#pragma unroll
        for (int r = 0; r < 4; ++r) { cs[r] = cu[sb + r]; ds[r] = dl[sb + r]; }
#pragma unroll
        for (int lt = 0; lt < 8; ++lt) {
          const int l = 16 * lt + fr;
          const float cl = cu[l];
          float m[4];
#pragma unroll
          for (int r = 0; r < 4; ++r) {
            const int sidx = sb + r;
            const bool ok = dir ? (sidx >= l) : (sidx <= l);
            m[r] = ok ? cbt[lt][r] * __expf(cl - cs[r]) * ds[r] : 0.f;
          }
          uint2 w; w.x = cvt_pk_bf16(m[0], m[1]); w.y = cvt_pk_bf16(m[2], m[3]);
          *(uint2*)(ML + l * SROW + 2 * sb) = w;
        }
      }
      __syncthreads();
      hf32x4 ad[4], ao[4];
#pragma unroll
      for (int pt = 0; pt < 4; ++pt) { ad[pt] = (hf32x4){0.f, 0.f, 0.f, 0.f}; ao[pt] = (hf32x4){0.f, 0.f, 0.f, 0.f}; }
#pragma unroll
      for (int kk = 0; kk < 4; ++kk) {
        const hbf16x8 Am = *(const hbf16x8*)(ML + (16 * wid + fr) * SROW + 2 * (32 * kk + 8 * fq));
        const hbf16x8 Ac = *(const hbf16x8*)(CS + (16 * wid + fr) * SROW + 2 * (32 * kk + 8 * fq));
#pragma unroll
        for (int pt = 0; pt < 4; ++pt) {
          const hbf16x8 Bx = *(const hbf16x8*)(XT + (16 * pt + fr) * SROW + 2 * (32 * kk + 8 * fq));
          const hbf16x8 Bh = *(const hbf16x8*)(HS + (16 * pt + fr) * SROW + 2 * (32 * kk + 8 * fq));
          ad[pt] = __builtin_amdgcn_mfma_f32_16x16x32_bf16(Am, Bx, ad[pt], 0, 0, 0);
          ao[pt] = __builtin_amdgcn_mfma_f32_16x16x32_bf16(Ac, Bh, ao[pt], 0, 0, 0);
        }
      }
      {
        const float* cu = CUM + it * 128;
        float ex[4];
#pragma unroll
        for (int r = 0; r < 4; ++r) ex[r] = __expf(cu[sb + r]);
#pragma unroll
        for (int pt = 0; pt < 4; ++pt)
#pragma unroll
          for (int r = 0; r < 4; ++r) yc[pt][r] += ad[pt][r] + ex[r] * ao[pt][r];
      }
      __syncthreads();
    }
    {
      const float dsk = p.ssd_d[h];
#pragma unroll
      for (int pt = 0; pt < 4; ++pt) {
        const uint2 xv = *(const uint2*)(XT + (16 * pt + fr) * SROW + 2 * sb);
        const uint2 zv = *(const uint2*)(ZT + (16 * pt + fr) * SROW + 2 * sb);
        const float xs4[4] = {__uint_as_float(xv.x << 16), __uint_as_float(xv.x & 0xffff0000u), __uint_as_float(xv.y << 16), __uint_as_float(xv.y & 0xffff0000u)};
        const float zs4[4] = {__uint_as_float(zv.x << 16), __uint_as_float(zv.x & 0xffff0000u), __uint_as_float(zv.y << 16), __uint_as_float(zv.y & 0xffff0000u)};
#pragma unroll
        for (int r = 0; r < 4; ++r) yc[pt][r] = (yc[pt][r] + dsk * xs4[r]) * silu_f(zs4[r]);
      }
    }
    if (hh == 0) {
#pragma unroll
      for (int pt = 0; pt < 4; ++pt) y[0][pt] = yc[pt];
    } else if (hh == 1) {
#pragma unroll
      for (int pt = 0; pt < 4; ++pt) y[1][pt] = yc[pt];
    } else if (hh == 2) {
#pragma unroll
      for (int pt = 0; pt < 4; ++pt) y[2][pt] = yc[pt];
    } else {
#pragma unroll
      for (int pt = 0; pt < 4; ++pt) y[3][pt] = yc[pt];
    }
    __syncthreads();
  }
  float rinv[4];
#pragma unroll
  for (int r = 0; r < 4; ++r) {
    float ss = 0.f;
#pragma unroll
    for (int hh = 0; hh < 4; ++hh)
#pragma unroll
      for (int pt = 0; pt < 4; ++pt) ss += y[hh][pt][r] * y[hh][pt][r];
    ss += __shfl_xor(ss, 1); ss += __shfl_xor(ss, 2); ss += __shfl_xor(ss, 4); ss += __shfl_xor(ss, 8);
    rinv[r] = rsqrtf(ss * (1.f / 256.f) + EPS);
  }
  {
    bf16_t* OT = (bf16_t*)lds;
#pragma unroll
    for (int hh = 0; hh < 4; ++hh)
#pragma unroll
      for (int pt = 0; pt < 4; ++pt) {
        const int chl = hh * 64 + 16 * pt + fr;
        const float ng = p.ssd_norm_g[g * 256 + chl];
#pragma unroll
        for (int r = 0; r < 4; ++r) OT[(sb + r) * 264 + chl] = f2bf(y[hh][pt][r] * rinv[r] * ng);
      }
    __syncthreads();
    for (int e = tid; e < 128 * 32; e += NTHR) {
      const int l = e >> 5, ch8 = (e & 31) * 8;
      *(uint4*)(p.YMIXb + (size_t)(row0 + l) * D + 512 + g * 256 + ch8) = *(const uint4*)(OT + l * 264 + ch8);
    }
  }
}

__device__ void ph_router(const Params& p, unsigned char* lds) {
  const int tid = threadIdx.x, wid = __builtin_amdgcn_readfirstlane(tid >> 6), lane = tid & 63;
  const int fr = lane & 15, fq = lane >> 4;
  constexpr int AROW = 272;
  unsigned char* AH = lds;
  unsigned char* AL = lds + 64 * AROW;
  unsigned char* WH = lds + 128 * AROW;
  unsigned char* WL = lds + 224 * AROW;
  float* RS = (float*)(lds + 320 * AROW);
  float* LOG = RS + 64;
  float* GM = LOG + 6400;
  float* SH = GM + 1024;
  for (int tile = blockIdx.x; tile < T / 64; tile += gridDim.x) {
    const int row0 = tile * 64;
    const float* shp = p.MOD + (row0 / L) * 6144 + 3072;
    const float* scp = shp + 1024;
    if (tid < 64) {
      const float4* sp = (const float4*)(p.SSQP + (size_t)(row0 + tid) * 16);
      const float4 a0 = sp[0], a1 = sp[1], a2 = sp[2], a3 = sp[3];
      const float ss = ((a0.x + a0.y) + (a0.z + a0.w)) + ((a1.x + a1.y) + (a1.z + a1.w)) + ((a2.x + a2.y) + (a2.z + a2.w)) + ((a3.x + a3.y) + (a3.z + a3.w));
      RS[tid] = rsqrtf(ss * (1.f / D) + EPS);
    }
    for (int e = tid; e < 256; e += NTHR) {
      const float4 g = *(const float4*)(p.g2 + e * 4), s4 = *(const float4*)(scp + e * 4), h4 = *(const float4*)(shp + e * 4);
      *(float4*)(GM + e * 4) = make_float4(g.x * (1.f + s4.x), g.y * (1.f + s4.y), g.z * (1.f + s4.z), g.w * (1.f + s4.w));
      *(float4*)(SH + e * 4) = h4;
    }
    float4 xv[4];
#pragma unroll
    for (int i = 0; i < 4; ++i) { const int e = tid + i * NTHR; xv[i] = *(const float4*)(p.X1 + (size_t)(row0 + (e >> 5)) * D + (e & 31) * 4); }
    __syncthreads();
    hf32x4 acc[3];
#pragma unroll
    for (int nt = 0; nt < 3; ++nt) acc[nt] = (hf32x4){0.f, 0.f, 0.f, 0.f};
    const int mt = wid & 3, nh = wid >> 2;
#pragma unroll 1
    for (int kc = 0; kc < 8; ++kc) {
#pragma unroll
      for (int i = 0; i < 4; ++i) {
        const int e = tid + i * NTHR; const int tok = e >> 5, k4 = (e & 31) * 4;
        const int kg = kc * 128 + k4;
        const float4 v = xv[i];
        const float4 g = *(const float4*)(GM + kg);
        const float4 h4 = *(const float4*)(SH + kg);
        const float rstd = RS[tok];
        const float h0 = v.x * rstd * g.x + h4.x, h1 = v.y * rstd * g.y + h4.y;
        const float h2 = v.z * rstd * g.z + h4.z, h3 = v.w * rstd * g.w + h4.w;
        const unsigned hi01 = cvt_pk_bf16(h0, h1), hi23 = cvt_pk_bf16(h2, h3);
        const unsigned lo01 = cvt_pk_bf16(h0 - __uint_as_float(hi01 << 16), h1 - __uint_as_float(hi01 & 0xffff0000u));
        const unsigned lo23 = cvt_pk_bf16(h2 - __uint_as_float(hi23 << 16), h3 - __uint_as_float(hi23 & 0xffff0000u));
        *(uint2*)(AH + tok * AROW + k4 * 2) = make_uint2(hi01, hi23);
        *(uint2*)(AL + tok * AROW + k4 * 2) = make_uint2(lo01, lo23);
        *(uint2*)(p.H2b + (size_t)(row0 + tok) * D + kg) = make_uint2(hi01, hi23);
      }
#pragma unroll
      for (int i = 0; i < 3; ++i) {
        const int e = tid + i * NTHR; const int j = e >> 4, ch = e & 15;
        *(uint4*)(WH + j * AROW + ch * 16) = *(const uint4*)(p.WRhi + (size_t)j * 1024 + kc * 128 + ch * 8);
        *(uint4*)(WL + j * AROW + ch * 16) = *(const uint4*)(p.WRlo + (size_t)j * 1024 + kc * 128 + ch * 8);
      }
      if (kc + 1 < 8) {
#pragma unroll
        for (int i = 0; i < 4; ++i) { const int e = tid + i * NTHR; xv[i] = *(const float4*)(p.X1 + (size_t)(row0 + (e >> 5)) * D + (kc + 1) * 128 + (e & 31) * 4); }
      }
      __syncthreads();
#pragma unroll
      for (int kk = 0; kk < 4; ++kk) {
        const hbf16x8 Ahi = *(const hbf16x8*)(AH + (16 * mt + fr) * AROW + 2 * (32 * kk + 8 * fq));
        const hbf16x8 Alo = *(const hbf16x8*)(AL + (16 * mt + fr) * AROW + 2 * (32 * kk + 8 * fq));
#pragma unroll
        for (int nt = 0; nt < 3; ++nt) {
          const int wo = (16 * (nh * 3 + nt) + fr) * AROW + 2 * (32 * kk + 8 * fq);
          const hbf16x8 Bhi = *(const hbf16x8*)(WH + wo);
          const hbf16x8 Blo = *(const hbf16x8*)(WL + wo);
          acc[nt] = __builtin_amdgcn_mfma_f32_16x16x32_bf16(Ahi, Bhi, acc[nt], 0, 0, 0);
          acc[nt] = __builtin_amdgcn_mfma_f32_16x16x32_bf16(Ahi, Blo, acc[nt], 0, 0, 0);
          acc[nt] = __builtin_amdgcn_mfma_f32_16x16x32_bf16(Alo, Bhi, acc[nt], 0, 0, 0);
        }
      }
      __syncthreads();
    }
#pragma unroll
    for (int nt = 0; nt < 3; ++nt)
#pragma unroll
      for (int r = 0; r < 4; ++r) LOG[(16 * mt + 4 * fq + r) * 100 + 16 * (nh * 3 + nt) + fr] = acc[nt][r];
    __syncthreads();
    if (tid < 64) {
      const float* lg = LOG + tid * 100;
      const int row = row0 + tid;
      int gs = 0; float gm = lg[64] + p.b_group[0];
      float gl[8];
      gl[0] = gm;
#pragma unroll
      for (int j = 1; j < 8; ++j) { gl[j] = lg[64 + j] + p.b_group[j]; if (gl[j] > gm) { gm = gl[j]; gs = j; } }
      float den = 0.f;
#pragma unroll
      for (int j = 0; j < 8; ++j) den += expf(gl[j] - gm);
      const float pg = 1.f / den;
      float el[8];
#pragma unroll
      for (int j = 0; j < 8; ++j) el[j] = 0.f;
      for (int j = 0; j < 8; ++j) el[j] = lg[gs * 8 + j] + p.b_expert[gs * 8 + j];
      int i0 = 0; float l0 = el[0];
#pragma unroll
      for (int j = 1; j < 8; ++j) if (el[j] > l0) { l0 = el[j]; i0 = j; }
      int i1 = -1; float l1 = -3.0e38f;
#pragma unroll
      for (int j = 0; j < 8; ++j) if (j != i0 && el[j] > l1) { l1 = el[j]; i1 = j; }
      const float e1 = expf(l1 - l0);
      const float w0 = 1.f / (1.f + e1), w1 = e1 / (1.f + e1);
      p.GATE[row * 2 + 0] = w0 * pg;
      p.GATE[row * 2 + 1] = w1 * pg;
      const int ea = gs * 8 + i0, eb = gs * 8 + i1;
      const int sa = atomicAdd(&p.CNT[ea], 1);
      p.LIST[ea * T + sa] = row * 2 + 0;
      const int sb2 = atomicAdd(&p.CNT[eb], 1);
      p.LIST[eb * T + sb2] = row * 2 + 1;
    }
    __syncthreads();
  }
}

__device__ __forceinline__ void moe_table(const Params& p, int* tab) {
  if (threadIdx.x == 0) {
    int a = 0, sg = 0;
    for (int e = 0; e < NE; ++e) {
      int cn = p.CNT[e];
      tab[e] = a; tab[65 + e] = sg; tab[130 + e] = cn;
      a += (cn + 255) >> 8; sg += ((cn + 127) >> 7) << 7;
    }
    tab[NE] = a; tab[65 + NE] = sg;
  }
  __syncthreads();
}

template <bool UP>
__device__ void moe_gemm_phase(const Params& p, unsigned char* lds, PG8_LAS unsigned char* ldsl, const int* tab) {
  constexpr int K = UP ? 1024 : 512;
  constexpr int NKT = K / 64;
  constexpr int LDB = UP ? 512 : 1024;
  const int tid = threadIdx.x, wid = __builtin_amdgcn_readfirstlane(tid >> 6), lane = tid & 63, fr = lane & 15, fq = lane >> 4;
  const int wm = wid >> 1, wn = wid & 1;
  constexpr int AOFF0 = 0, AOFF1 = 32768, BOFF0 = 65536, BOFF1 = 65536 + 128 * 144;
  const int total = tab[64] * 8;
  for (int ui = blockIdx.x; ui < total; ui += gridDim.x) {
   {
    int e = 0;
    while (tab[e + 1] * 8 <= ui) ++e;
    const int local = ui - tab[e] * 8;
    const int mu = local >> 3, nt = local & 7;
    const int cnt = tab[130 + e], seg = tab[65 + e];
    const int rem = cnt - mu * 256;
    const bool full = rem > 128;
    const bool active = full || wm < 2;
    unsigned aoffs[4];
#pragma unroll
    for (int i = 0; i < 4; ++i) {
      const int row = (tid >> 3) + 64 * i;
      int idx = mu * 256 + row;
      unsigned rowb;
      if (UP) { if (idx > cnt - 1) idx = cnt - 1; rowb = (unsigned)(p.LIST[e * T + idx] >> 1) * (unsigned)(K * 2); }
      else rowb = (unsigned)(seg + idx) * (unsigned)(K * 2);
      aoffs[i] = rowb + (unsigned)(((tid & 7) ^ (row & 7)) * 16);
    }
    const char* Abase = UP ? (const char*)p.H2b : (const char*)p.HBb;
    const float* bsrc;
    if (UP) bsrc = ((lane < 32) ? p.w1 : p.w3) + (size_t)e * 1024 * 512 + nt * 64 + 2 * (lane & 31) + (size_t)(8 * wid) * LDB;
    else bsrc = p.w2 + (size_t)e * 512 * 1024 + nt * 128 + 2 * lane + (size_t)(8 * wid) * LDB;
    hf32x4 acc[4][4];
#pragma unroll
    for (int m = 0; m < 4; ++m)
#pragma unroll
      for (int j = 0; j < 4; ++j) acc[m][j] = (hf32x4){0.f, 0.f, 0.f, 0.f};
    uint4 P0a0, P0a1, P0a2, P0a3, P1a0, P1a1, P1a2, P1a3;
    float2 P0b0, P0b1, P0b2, P0b3, P0b4, P0b5, P0b6, P0b7, P1b0, P1b1, P1b2, P1b3, P1b4, P1b5, P1b6, P1b7;
    const int srow = tid >> 3, spc = tid & 7;
#define MG_LOAD(kt, S) do { \
      S##a0 = *(const uint4*)(Abase + aoffs[0] + (kt) * 128); S##a1 = *(const uint4*)(Abase + aoffs[1] + (kt) * 128); \
      S##a2 = *(const uint4*)(Abase + aoffs[2] + (kt) * 128); S##a3 = *(const uint4*)(Abase + aoffs[3] + (kt) * 128); \
      S##b0 = *(const float2*)(bsrc + (size_t)((kt) * 64 + 0) * LDB); S##b1 = *(const float2*)(bsrc + (size_t)((kt) * 64 + 1) * LDB); \
      S##b2 = *(const float2*)(bsrc + (size_t)((kt) * 64 + 2) * LDB); S##b3 = *(const float2*)(bsrc + (size_t)((kt) * 64 + 3) * LDB); \
      S##b4 = *(const float2*)(bsrc + (size_t)((kt) * 64 + 4) * LDB); S##b5 = *(const float2*)(bsrc + (size_t)((kt) * 64 + 5) * LDB); \
      S##b6 = *(const float2*)(bsrc + (size_t)((kt) * 64 + 6) * LDB); S##b7 = *(const float2*)(bsrc + (size_t)((kt) * 64 + 7) * LDB); } while (0)
#define MG_WRITE(aoff, boff, S) do { \
      *(uint4*)(lds + (aoff) + (srow) * 128 + spc * 16) = S##a0; *(uint4*)(lds + (aoff) + (srow + 64) * 128 + spc * 16) = S##a1; \
      if (full) { *(uint4*)(lds + (aoff) + (srow + 128) * 128 + spc * 16) = S##a2; *(uint4*)(lds + (aoff) + (srow + 192) * 128 + spc * 16) = S##a3; } \
      *(uint4*)(lds + (boff) + (2 * lane) * 144 + 16 * wid) = make_uint4(cvt_pk_bf16(S##b0.x, S##b1.x), cvt_pk_bf16(S##b2.x, S##b3.x), cvt_pk_bf16(S##b4.x, S##b5.x), cvt_pk_bf16(S##b6.x, S##b7.x)); \
      *(uint4*)(lds + (boff) + (2 * lane + 1) * 144 + 16 * wid) = make_uint4(cvt_pk_bf16(S##b0.y, S##b1.y), cvt_pk_bf16(S##b2.y, S##b3.y), cvt_pk_bf16(S##b4.y, S##b5.y), cvt_pk_bf16(S##b6.y, S##b7.y)); } while (0)
#define MG_MMA(aoff, boff) do { if (active) { \
      _Pragma("unroll") for (int kk = 0; kk < 2; ++kk) { \
        hbf16x8 Af[4], Bf[4]; \
        _Pragma("unroll") for (int m = 0; m < 4; ++m) Af[m] = *(const hbf16x8*)(lds + (aoff) + (64 * wm + 16 * m + fr) * 128 + (((4 * kk + fq) ^ (fr & 7)) * 16)); \
        _Pragma("unroll") for (int j = 0; j < 4; ++j) { \
          const int nrow = UP ? ((j < 2) ? (32 * wn + 16 * j + fr) : (64 + 32 * wn + 16 * (j - 2) + fr)) : (64 * wn + 16 * j + fr); \
          Bf[j] = *(const hbf16x8*)(lds + (boff) + nrow * 144 + 2 * (32 * kk + 8 * fq)); } \
        _Pragma("unroll") for (int m = 0; m < 4; ++m) _Pragma("unroll") for (int j = 0; j < 4; ++j) \
          acc[m][j] = __builtin_amdgcn_mfma_f32_16x16x32_bf16(Bf[j], Af[m], acc[m][j], 0, 0, 0); } } } while (0)
    MG_LOAD(0, P0);
    MG_LOAD(1, P1);
    MG_WRITE(AOFF0, BOFF0, P0);
    __syncthreads();
#pragma unroll 1
    for (int kt = 0; kt < NKT; kt += 2) {
      if (kt + 2 < NKT) MG_LOAD(kt + 2, P0);
      MG_MMA(AOFF0, BOFF0);
      MG_WRITE(AOFF1, BOFF1, P1);
      __syncthreads();
      if (kt + 3 < NKT) MG_LOAD(kt + 3, P1);
      MG_MMA(AOFF1, BOFF1);
      if (kt + 2 < NKT) MG_WRITE(AOFF0, BOFF0, P0);
      __syncthreads();
    }
#undef MG_LOAD
#undef MG_WRITE
#undef MG_MMA
    if (active) {
#pragma unroll
      for (int m = 0; m < 4; ++m) {
        const int slot = mu * 256 + 64 * wm + 16 * m + fr;
        if (slot < cnt) {
          if (UP) {
            bf16_t* hp = p.HBb + (size_t)(seg + slot) * DE + nt * 64 + 32 * wn + 4 * fq;
#pragma unroll
            for (int j = 0; j < 2; ++j) {
              float h[4];
#pragma unroll
              for (int r = 0; r < 4; ++r) { const float a = acc[m][j][r]; h[r] = a / (1.f + __expf(-a)) * acc[m][j + 2][r]; }
              *(uint2*)(hp + 16 * j) = make_uint2(cvt_pk_bf16(h[0], h[1]), cvt_pk_bf16(h[2], h[3]));
            }
          } else {
            const int pair = p.LIST[e * T + slot];
            const float gt = p.GATE[pair];
            bf16_t* yp = p.YB2b + (size_t)pair * D + nt * 128 + 64 * wn + 4 * fq;
#pragma unroll
            for (int j = 0; j < 4; ++j)
              *(uint2*)(yp + 16 * j) = make_uint2(cvt_pk_bf16(gt * acc[m][j][0], gt * acc[m][j][1]), cvt_pk_bf16(gt * acc[m][j][2], gt * acc[m][j][3]));
          }
        }
      }
    }
   }
  }
}

__device__ void ph_final(const Params& p) {
  const int tid = threadIdx.x, wid = tid >> 6, lane = tid & 63;
  for (int row = blockIdx.x * 8 + wid; row < T; row += gridDim.x * 8) {
    const float* ga2 = p.MOD + (row / L) * 6144 + 5120;
    float4 v[4];
    float ss = 0.f;
#pragma unroll
    for (int i = 0; i < 4; ++i) {
      const int col = i * 256 + lane * 4;
      float4 xv = *(const float4*)(p.X1 + (size_t)row * D + col);
      uint2 a = *(const uint2*)(p.YB2b + (size_t)(row * 2) * D + col);
      uint2 b = *(const uint2*)(p.YB2b + (size_t)(row * 2 + 1) * D + col);
      float4 ga = *(const float4*)(ga2 + col);
      v[i].x = xv.x + ga.x * (__uint_as_float(a.x << 16) + __uint_as_float(b.x << 16));
      v[i].y = xv.y + ga.y * (__uint_as_float(a.x & 0xffff0000u) + __uint_as_float(b.x & 0xffff0000u));
      v[i].z = xv.z + ga.z * (__uint_as_float(a.y << 16) + __uint_as_float(b.y << 16));
      v[i].w = xv.w + ga.w * (__uint_as_float(a.y & 0xffff0000u) + __uint_as_float(b.y & 0xffff0000u));
      ss += v[i].x * v[i].x + v[i].y * v[i].y + v[i].z * v[i].z + v[i].w * v[i].w;
    }
    ss = wave_sum(ss);
    const float rstd = rsqrtf(ss * (1.f / D) + EPS);
#pragma unroll
    for (int i = 0; i < 4; ++i) {
      const int col = i * 256 + lane * 4;
      float4 gf = *(const float4*)(p.g_final + col);
      float4 o;
      o.x = v[i].x * rstd * gf.x; o.y = v[i].y * rstd * gf.y; o.z = v[i].z * rstd * gf.z; o.w = v[i].w * rstd * gf.w;
      *(float4*)(p.out + (size_t)row * D + col) = o;
    }
  }
}

constexpr int NPHASE = 11;

__global__ void __launch_bounds__(NTHR, 2) mega(Params p) {
  extern __shared__ __attribute__((aligned(16))) unsigned char lds_raw[];
  float* sm = (float*)lds_raw;
  PG8_LAS unsigned char* lds = (PG8_LAS unsigned char*)lds_raw;
  const int lo = p.lo, hi = p.hi;
  volatile LAS unsigned* xbst = (volatile LAS unsigned*)(lds + pg8::STAGE_BYTES + 2048);
  if (threadIdx.x < 4) xbst[threadIdx.x] = 0u;
  __syncthreads();
  XcdBarrier xbar; xbar.bar = p.BAR; xbar.x = 0; xbar.st = xbst;
  if (hi - lo > 1) xbar = xcd_barrier_post(p.BAR, xbst);
#define IN(k) (lo <= (k) && (k) < hi)
#define SYNC(k) do { if (IN(k) && IN((k) + 1)) xcd_barrier(xbar); } while (0)
#ifndef DUPK
#define DUPK -1
#endif
#ifndef SKIP_OTHER
  if (IN(0)) { ph_adaln(p, sm); ph_filters(p, sm); ph_wcvt(p, sm); }
#if DUPK == 0
  xcd_barrier(xbar);
  if (IN(0)) { ph_adaln(p, sm); ph_filters(p, sm); ph_wcvt(p, sm); }
#endif
  SYNC(0);
  if (IN(1)) ph_norm1(p);
#if DUPK == 1
  xcd_barrier(xbar);
  if (IN(1)) ph_norm1(p);
#endif
  SYNC(1);
#endif
#ifndef SKIP_GEMM
  if (IN(2)) {
    pg8::DenseOrder S{p.XNb, p.WinT, TT / 256, DP / 256 + 1, D, (int)gridDim.x, (int)blockIdx.x};
    pg8::EpiBf16 E{p.PXb, DP, p.DT, p.dt_bias};
    pg8::gemm_phase<pg8::EpiBf16, pg8::DenseOrder>(lds, D, S, E);
  }
#if DUPK == 2
  xcd_barrier(xbar);
  if (IN(2)) {
    pg8::DenseOrder S{p.XNb, p.WinT, TT / 256, DP / 256 + 1, D, (int)gridDim.x, (int)blockIdx.x};
    pg8::EpiBf16 E{p.PXb, DP, p.DT, p.dt_bias};
    pg8::gemm_phase<pg8::EpiBf16, pg8::DenseOrder>(lds, D, S, E);
  }
#endif
  SYNC(2);
#endif
#ifndef SKIP_OTHER
  if (IN(3)) {
    ph_hy_convT(p, sm);
    for (int it = blockIdx.x; it < 288; it += gridDim.x) ssd_states_unit(p, it, lds_raw);
  }
#if DUPK == 3
  xcd_barrier(xbar);
  if (IN(3)) {
    ph_hy_convT(p, sm);
    for (int it = blockIdx.x; it < 288; it += gridDim.x) ssd_states_unit(p, it, lds_raw);
  }
#endif
  SYNC(3);
  if (IN(4)) {
    for (int it = blockIdx.x; it < 256; it += gridDim.x) ssd_scan_unit(p, it);
    for (int it = blockIdx.x; it < 512; it += gridDim.x) hyena_unit(p, it, lds_raw);
  }
#if DUPK == 4
  xcd_barrier(xbar);
  if (IN(4)) {
    for (int it = blockIdx.x; it < 256; it += gridDim.x) ssd_scan_unit(p, it);
    for (int it = blockIdx.x; it < 512; it += gridDim.x) hyena_unit(p, it, lds_raw);
  }
#endif
  SYNC(4);
  if (IN(5)) {
    for (int it = blockIdx.x; it < 256; it += gridDim.x) { ssd_out_unit(p, it, lds_raw); __syncthreads(); }
    ph_hy_backT(p, sm);
  }
#if DUPK == 5
  xcd_barrier(xbar);
  if (IN(5)) {
    for (int it = blockIdx.x; it < 256; it += gridDim.x) { ssd_out_unit(p, it, lds_raw); __syncthreads(); }
    ph_hy_backT(p, sm);
  }
#endif
  SYNC(5);
#endif
#ifndef SKIP_GEMM
  if (IN(6)) {
    pg8::DenseOrder S{p.YMIXb, p.WoutT, T / 256, D / 256, D, (int)gridDim.x, (int)blockIdx.x};
    pg8::EpiX1 E{p.x, p.MOD, p.X1, p.SSQP};
    pg8::gemm_phase<pg8::EpiX1, pg8::DenseOrder>(lds, D, S, E);
  }
#if DUPK == 6
  xcd_barrier(xbar);
  if (IN(6)) {
    pg8::DenseOrder S{p.YMIXb, p.WoutT, T / 256, D / 256, D, (int)gridDim.x, (int)blockIdx.x};
    pg8::EpiX1 E{p.x, p.MOD, p.X1, p.SSQP};
    pg8::gemm_phase<pg8::EpiX1, pg8::DenseOrder>(lds, D, S, E);
  }
#endif
  SYNC(6);
#endif
#ifndef SKIP_OTHER
  if (IN(7)) ph_router(p, lds_raw);
#if DUPK == 7
  xcd_barrier(xbar);
  if (IN(7)) ph_router(p, lds_raw);
#endif
  SYNC(7);
#endif
#ifndef SKIP_GEMM
  if (IN(8)) {
    int* tab = (int*)(lds_raw + pg8::STAGE_BYTES);
    moe_table(p, tab);
    moe_gemm_phase<true>(p, lds_raw, lds, tab);
  }
#if DUPK == 8
  xcd_barrier(xbar);
  if (IN(8)) {
    int* tab = (int*)(lds_raw + pg8::STAGE_BYTES);
    moe_table(p, tab);
    moe_gemm_phase<true>(p, lds_raw, lds, tab);
  }
#endif
  SYNC(8);
  if (IN(9)) {
    int* tab = (int*)(lds_raw + pg8::STAGE_BYTES);
    moe_table(p, tab);
    moe_gemm_phase<false>(p, lds_raw, lds, tab);
  }
#if DUPK == 9
  xcd_barrier(xbar);
  if (IN(9)) {
    int* tab = (int*)(lds_raw + pg8::STAGE_BYTES);
    moe_table(p, tab);
    moe_gemm_phase<false>(p, lds_raw, lds, tab);
  }
#endif
  SYNC(9);
#endif
#ifndef SKIP_OTHER
  if (IN(10)) ph_final(p);
#if DUPK == 10
  xcd_barrier(xbar);
  if (IN(10)) ph_final(p);
#endif
#endif
#undef IN
#undef SYNC
}

extern "C" void kernel_launch(void* const* d_in, const int* in_sizes, int n_in, void* d_out, int out_size,
                              void* d_ws, size_t ws_size, hipStream_t stream) {
  Params p{};
  const float* const* in = (const float* const*)d_in;
  p.x = in[0]; p.c = in[1]; p.ctx = in[2]; p.c_ctx = in[3]; p.w_ada = in[4]; p.b_ada = in[5];
  p.g1 = in[6]; p.g2 = in[7]; p.w_in = in[8]; p.hy_conv_w = in[9]; p.hy_conv_b = in[10];
  p.f_w1 = in[11]; p.f_b1 = in[12]; p.f_freq = in[13]; p.f_w2 = in[14]; p.f_b2 = in[15]; p.f_w3 = in[16];
  p.hy_bias = in[17]; p.ssd_conv_w = in[18]; p.ssd_conv_b = in[19]; p.a_log = in[20]; p.dt_bias = in[21];
  p.ssd_d = in[22]; p.ssd_norm_g = in[23]; p.w_out = in[24]; p.w_group = in[25]; p.b_group = in[26];
  p.w_expert = in[27]; p.b_expert = in[28]; p.w1 = in[29]; p.w3 = in[30]; p.w2 = in[31]; p.g_final = in[32];
  p.out = (float*)d_out;

  char* ws = (char*)d_ws;
  size_t off = 0;
  auto take = [&](size_t bytes) { char* r = ws + off; off += (bytes + 255) & ~(size_t)255; return r; };
  p.BAR = (unsigned*)take((size_t)XCD_BAR_WORDS * 4);
  p.MOD = (float*)take((size_t)9 * 6144 * 4);
  p.CNT = (int*)take(NE * 4);
  p.GATE = (float*)take((size_t)T * 2 * 4);
  p.LIST = (int*)take((size_t)NE * T * 4);
  p.DT = (float*)take((size_t)TT * 16 * 4);
  p.ACUM = (float*)take((size_t)T * 16 * 4);
  p.SSQP = (float*)take((size_t)T * 16 * 4);
  p.CDEC = (float*)take((size_t)128 * 18 * 32 * 4);
  p.FILTt = (bf16_t*)take((size_t)1024 * FLEN * 2);
  p.WRhi = (bf16_t*)take((size_t)96 * 1024 * 2);
  p.WRlo = (bf16_t*)take((size_t)96 * 1024 * 2);
  p.WinT = (bf16_t*)take((size_t)(DP + 256) * D * 2);
  p.WoutT = (bf16_t*)take((size_t)D * D * 2);
  char* rPX = take((size_t)TT * DP * 2);
  char* rXBC = take((size_t)128 * 18 * 8192 * 2);
  char* rYF = take((size_t)T * DS * 4);
  char* rZ1 = take((size_t)HYC * T * 2);
  char* rYB = take((size_t)T * DS * 4);
  char* rYM = take((size_t)T * D * 2);
  p.PXb = (bf16_t*)rPX; p.SST = (bf16_t*)rXBC; p.Ut = (bf16_t*)rZ1; p.YMIXb = (bf16_t*)rYM;
  p.HIN = (bf16_t*)rYF;
  p.Yt = (bf16_t*)rYB;
  p.XNb = (bf16_t*)rZ1;
  p.X1 = (float*)rPX;
  p.H2b = (bf16_t*)rYM;
  p.HBb = (bf16_t*)(rPX + (size_t)T * D * 4);
  p.YB2b = (bf16_t*)rZ1;
  if (off > ws_size) { fprintf(stderr, "workspace too small: need %zu have %zu\n", off, ws_size); return; }

  static int grid_blocks = 0;
  if (!grid_blocks) {
    int dev = 0, cus = 0, per_cu = 0;
    (void)hipGetDevice(&dev);
    (void)hipDeviceGetAttribute(&cus, hipDeviceAttributeMultiprocessorCount, dev);
    (void)hipFuncSetAttribute((const void*)mega, hipFuncAttributeMaxDynamicSharedMemorySize, LDS_BYTES);
    (void)hipOccupancyMaxActiveBlocksPerMultiprocessor(&per_cu, mega, NTHR, LDS_BYTES);
    if (per_cu < 1) { fprintf(stderr, "occupancy query returned %d\n", per_cu); per_cu = 1; }
    grid_blocks = cus;
  }
#ifndef ONE_LAUNCH
  for (int ph = 0; ph < NPHASE; ++ph) {
    p.lo = ph; p.hi = ph + 1;
    hipLaunchKernelGGL(mega, dim3(grid_blocks), dim3(NTHR), LDS_BYTES, stream, p);
  }
#else
  p.lo = 0; p.hi = NPHASE;
  (void)hipMemsetAsync(p.BAR, 0, (size_t)XCD_BAR_WORDS * 4, stream);
  void* args[] = {&p};
  hipError_t e = hipLaunchCooperativeKernel((void*)mega, dim3(grid_blocks), dim3(NTHR), args, LDS_BYTES, stream);
  if (e != hipSuccess) fprintf(stderr, "cooperative launch failed: %s (grid %d)\n", hipGetErrorString(e), grid_blocks);
#endif
}
```

```cpp
#define ONE_LAUNCH 1
#include <hip/hip_runtime.h>
#include <hip/hip_cooperative_groups.h>
#include <cstdio>
#include <cstdint>
namespace cg = cooperative_groups;

constexpr int D = 1024, NB = 8, L = 2048, LC = 256;
constexpr int T = NB * L;
constexpr int TC = NB * LC;
constexpr int TT = T + TC;
constexpr int DH = 512, HYC = 1536, DS = 512, DXBC = 1024, DIN = 3088, DP = 3072;
constexpr int COL_Z = 1536, COL_XBC = 2048, COL_DT = 3072;
constexpr int NE = 64, DE = 512;
constexpr float EPS = 1e-6f;
constexpr int NTHR = 512;
constexpr int LDS_BYTES = 132 * 1024;
constexpr int FLEN = 4232, HX0 = 2112, FCLEN = 4240, ZSTRB = 4240;

typedef unsigned short bf16_t;

struct Params {
  const float *x, *c, *ctx, *c_ctx, *w_ada, *b_ada, *g1, *g2, *w_in, *hy_conv_w, *hy_conv_b;
  const float *f_w1, *f_b1, *f_freq, *f_w2, *f_b2, *f_w3, *hy_bias;
  const float *ssd_conv_w, *ssd_conv_b, *a_log, *dt_bias, *ssd_d, *ssd_norm_g, *w_out;
  const float *w_group, *b_group, *w_expert, *b_expert, *w1, *w3, *w2, *g_final;
  float* out;
  float *MOD, *DT, *X1, *GATE, *ACUM, *CDEC, *SSQP;
  bf16_t *WRhi, *WRlo, *FILTt, *Ut, *Yt, *HIN, *XNb, *WinT, *WoutT, *PXb, *SST, *YMIXb, *YB2b, *H2b, *HBb;
  int *CNT, *LIST;
  unsigned* BAR;
  int lo, hi;
};

__device__ __forceinline__ float silu_f(float v) { return v / (1.f + __expf(-v)); }
__device__ __forceinline__ float softplus_f(float v) { return v > 20.f ? v : log1pf(expf(v)); }
__device__ __forceinline__ float bf2f(bf16_t v) { return __uint_as_float(((unsigned)v) << 16); }
__device__ __forceinline__ unsigned cvt_pk_bf16(float lo, float hi) {
  typedef __bf16 bf2_t __attribute__((ext_vector_type(2)));
  typedef float f2_t __attribute__((ext_vector_type(2)));
  const f2_t v = {lo, hi};
  const bf2_t r = __builtin_convertvector(v, bf2_t);
  return __builtin_bit_cast(unsigned, r);
}
__device__ __forceinline__ bf16_t f2bf(float f) { return (bf16_t)(cvt_pk_bf16(f, 0.f) & 0xffffu); }
__device__ __forceinline__ void st_agent64(void* p, unsigned lo, unsigned hi) {
  __hip_atomic_store((unsigned long long*)p, ((unsigned long long)hi << 32) | lo, __ATOMIC_RELAXED, __HIP_MEMORY_SCOPE_AGENT);
}
__device__ __forceinline__ uint2 ld_agent64(const void* p) {
  const unsigned long long v = __hip_atomic_load((const unsigned long long*)p, __ATOMIC_RELAXED, __HIP_MEMORY_SCOPE_AGENT);
  return make_uint2((unsigned)v, (unsigned)(v >> 32));
}
__device__ __forceinline__ void st_agent32(float* p, float v) { __hip_atomic_store(p, v, __ATOMIC_RELAXED, __HIP_MEMORY_SCOPE_AGENT); }
__device__ __forceinline__ float ld_agent32(const float* p) { return __hip_atomic_load(p, __ATOMIC_RELAXED, __HIP_MEMORY_SCOPE_AGENT); }
__device__ __forceinline__ float wave_sum(float v) {
#pragma unroll
  for (int o = 32; o > 0; o >>= 1) v += __shfl_xor(v, o);
  return v;
}


#define XB_TMO      128
#define XB_XCNT(j)  (256  + 64 * (j))
#define XB_XSUB(j)  (1280 + 64 * (j))
#define XB_XGEN(j)  (2304 + 64 * (j))
#define XB_TOP      3328
#define XB_TOPGEN   3392
#define XCD_BAR_WORDS 3456
#define XB_SPIN_CAP (1u << 18)
#define LAS __attribute__((address_space(3)))
__device__ __forceinline__ unsigned xb_ld(unsigned* p) { return __hip_atomic_load(p, __ATOMIC_RELAXED, __HIP_MEMORY_SCOPE_AGENT); }
__device__ __forceinline__ unsigned xb_add(unsigned* p, unsigned v) { return __hip_atomic_fetch_add(p, v, __ATOMIC_RELAXED, __HIP_MEMORY_SCOPE_AGENT); }
__device__ __forceinline__ unsigned xb_xcc_id() { return (unsigned)__builtin_amdgcn_s_getreg((3 << 11) | 20) & 0xFu; }
#define XB_SPIN(cond, bar) do { unsigned _sp = 0; while (cond) { __builtin_amdgcn_s_sleep(1); \
    if ((++_sp & 255u) == 0u) { if (xb_ld(&(bar)[XB_TMO])) break; if (_sp > XB_SPIN_CAP) { atomicAdd(&(bar)[XB_TMO], 1u); break; } } } } while (0)
struct XcdBarrier { unsigned* bar; unsigned x; volatile LAS unsigned* st; };
__device__ __forceinline__ XcdBarrier xcd_barrier_post(unsigned* bar, volatile LAS unsigned* st) {
  XcdBarrier b; b.bar = bar; b.x = xb_xcc_id(); b.st = st;
  if (threadIdx.x == 0) (void)xb_add(&bar[XB_XCNT(b.x)], 1u);
  return b;
}
__device__ __forceinline__ void xcd_barrier_complete(unsigned* bar, unsigned x, unsigned& nloc, unsigned& nx) {
  const unsigned G = gridDim.x * gridDim.y * gridDim.z;
  unsigned sum, cnt, mine, sp = 0u;
  for (;;) {
    sum = 0u; cnt = 0u; mine = 0u;
#pragma unroll
    for (unsigned j = 0; j < 16; ++j) { const unsigned c = xb_ld(&bar[XB_XCNT(j)]); sum += c; cnt += (c > 0u) ? 1u : 0u; mine = (j == x) ? c : mine; }
    if (sum == G) break;
    __builtin_amdgcn_s_sleep(1);
    if ((++sp & 255u) == 0u) { if (xb_ld(&bar[XB_TMO])) break; if (sp > XB_SPIN_CAP) { atomicAdd(&bar[XB_TMO], 1u); break; } }
  }
  nloc = mine > 0u ? mine : 1u; nx = cnt > 0u ? cnt : 1u;
}
__device__ __forceinline__ void xcd_barrier(const XcdBarrier& b) {
  asm volatile("s_waitcnt vmcnt(0)" ::: "memory");
  __syncthreads();
  if (threadIdx.x == 0) {
    unsigned* bar = b.bar;
    __builtin_amdgcn_s_waitcnt(0);
    unsigned nloc = b.st[0], nx = b.st[1];
    if (nloc == 0u) { xcd_barrier_complete(bar, b.x, nloc, nx); b.st[0] = nloc; b.st[1] = nx; }
    const unsigned old = xb_add(&bar[XB_XSUB(b.x)], 1u);
    const unsigned gen = old / nloc;
    if (old + 1u == (gen + 1u) * nloc) {
      __builtin_amdgcn_fence(__ATOMIC_RELEASE, "agent");
      asm volatile("s_waitcnt vmcnt(0)" ::: "memory");
      const unsigned og = xb_add(&bar[XB_TOP], 1u);
      const unsigned tg = og / nx;
      if (og + 1u == (tg + 1u) * nx) xb_add(&bar[XB_TOPGEN], 1u);
      else XB_SPIN(xb_ld(&bar[XB_TOPGEN]) == tg, bar);
      __builtin_amdgcn_fence(__ATOMIC_ACQUIRE, "agent");
      xb_add(&bar[XB_XGEN(b.x)], 1u);
      asm volatile("s_waitcnt vmcnt(0)" ::: "memory");
    } else {
      XB_SPIN(xb_ld(&bar[XB_XGEN(b.x)]) == gen, bar);
      __builtin_amdgcn_fence(__ATOMIC_ACQUIRE, "agent");
      asm volatile("s_waitcnt vmcnt(0)" ::: "memory");
    }
  }
  __syncthreads();
}

namespace pg8 {
#define PG8_LAS __attribute__((address_space(3)))
typedef short bf16x8 __attribute__((ext_vector_type(8)));
typedef float f32x4 __attribute__((ext_vector_type(4)));
typedef unsigned u32x4 __attribute__((ext_vector_type(4)));
typedef unsigned u32x2 __attribute__((ext_vector_type(2)));
constexpr int BM = 256, BK = 64, HALF = 128, HTB = HALF * BK * 2, STAGE_BYTES = 8 * HTB, NXCD = 8, WGM = 8;

__host__ __device__ __forceinline__ int lds_byte(int r, int c) {
  const int st = (r >> 4) * 2 + (c >> 5), rr = r & 15, cc = c & 31, ob = rr * 64 + cc * 2;
  return st * 1024 + (ob ^ (((ob >> 9) & 1) << 5));
}
__host__ __device__ __forceinline__ void stage_rc(int b, int& R, int& C) {
  const int st = b / 1024, sb = b % 1024, swz = sb ^ (((sb >> 9) & 1) << 5);
  R = (st >> 1) * 16 + swz / 64; C = (st & 1) * 32 + (swz % 64) / 2;
}
__host__ __device__ __forceinline__ int perm32(int rho) { const int n = rho >> 4, i = rho & 15; return 8 * (i >> 2) + 4 * n + (i & 3); }

struct Unit { int pm, pn, e, mu, nv, cnt, seg; };

__device__ __forceinline__ bool static_next(int nM, int nN, int G, int c, int i, int& pm, int& pn) {
  const int nwg = nM * nN;
  const long Lx = (long)i * G + c; if (Lx >= nwg) return false;
  int wgid = (int)Lx;
  { const int q = nwg / NXCD, r = nwg % NXCD, xcd = wgid % NXCD, off = wgid / NXCD; wgid = (xcd < r ? xcd * (q + 1) : r * (q + 1) + (xcd - r) * q) + off; }
  const int nig = WGM * nN, gid = wgid / nig, fm = gid * WGM, gsz = (nM - fm) < WGM ? (nM - fm) : WGM;
  pm = fm + ((wgid % nig) % gsz); pn = (wgid % nig) / gsz; return true;
}

struct DenseOrder {
  const bf16_t* A; const bf16_t* Bt; int nM, nN, K, G, c;
  __device__ __forceinline__ bool next(int i, Unit& u) const {
    if (!static_next(nM, nN, G, c, i, u.pm, u.pn)) return false;
    u.e = 0; u.mu = 0; u.nv = 256; u.cnt = 256; u.seg = 0; return true;
  }
  __device__ __forceinline__ const char* a_base() const { return (const char*)A; }
  __device__ __forceinline__ const char* b_ptr(const Unit& u) const { return (const char*)Bt + (size_t)u.pn * 256 * K * 2; }
  __device__ __forceinline__ void a_offs(const Unit& u, const int (&R)[2], const int (&C)[2], unsigned (&ao)[2][2]) const {
#pragma unroll
    for (int h = 0; h < 2; ++h)
#pragma unroll
      for (int i = 0; i < 2; ++i) ao[h][i] = (unsigned)((u.pm * 256 + h * 128 + R[i]) * K + C[i]) * 2u;
  }
};

struct MoeOrder {
  const int* tab; const bf16_t* A; const bf16_t* Bt; const int* list; int NTn, K, G, c; bool gather;
  __device__ __forceinline__ bool next(int i, Unit& u) const {
    const int Lx = i * G + c;
    if (Lx >= tab[64] * NTn) return false;
    const int mg = Lx / NTn; u.pn = Lx - mg * NTn;
    int e = 0;
    while (tab[e + 1] <= mg) ++e;
    u.e = e; u.mu = mg - tab[e]; u.cnt = tab[130 + e]; u.seg = tab[65 + e];
    const int rem = u.cnt - u.mu * 256; u.nv = rem < 256 ? rem : 256; u.pm = 0; return true;
  }
  __device__ __forceinline__ const char* a_base() const { return (const char*)A; }
  __device__ __forceinline__ const char* b_ptr(const Unit& u) const { return (const char*)Bt + ((size_t)u.e * NTn + u.pn) * 256 * K * 2; }
  __device__ __forceinline__ void a_offs(const Unit& u, const int (&R)[2], const int (&C)[2], unsigned (&ao)[2][2]) const {
#pragma unroll
    for (int h = 0; h < 2; ++h)
#pragma unroll
      for (int i = 0; i < 2; ++i) {
        int idx = u.mu * 256 + h * 128 + R[i];
        int row;
        if (gather) { if (idx > u.cnt - 1) idx = u.cnt - 1; row = list[u.e * T + idx] >> 1; }
        else row = u.seg + idx;
        ao[h][i] = (unsigned)(row * K + C[i]) * 2u;
      }
  }
};

struct EpiBf16 {
  static constexpr bool PERM = true;
  bf16_t* O; int ldc; float* DT; const float* dt_bias;
  __device__ __forceinline__ void operator()(const f32x4 (&acc)[2][2][4][2], const Unit& u, int wr, int wc, int fr, int fq) const {
    const int row0 = u.pm * BM + wr * 64 + fr;
    if (u.pn == 12) {
      if (wc == 0 && fq < 2) {
        const f32x4 b0 = *(const f32x4*)(dt_bias + 8 * fq), b1 = *(const f32x4*)(dt_bias + 8 * fq + 4);
#pragma unroll
        for (int ai = 0; ai < 2; ++ai)
#pragma unroll
          for (int m = 0; m < 4; ++m) {
            float* dp = DT + (size_t)(row0 + ai * HALF + m * 16) * 16 + 8 * fq;
            *(f32x4*)dp = acc[ai][0][m][0] + b0; *(f32x4*)(dp + 4) = acc[ai][0][m][1] + b1;
          }
      }
      return;
    }
    const int col0 = u.pn * BM + wc * 32 + 8 * fq;
#pragma unroll
    for (int ai = 0; ai < 2; ++ai)
#pragma unroll
      for (int m = 0; m < 4; ++m) {
        bf16_t* rowp = O + (size_t)(row0 + ai * HALF + m * 16) * ldc + col0;
#pragma unroll
        for (int bj = 0; bj < 2; ++bj) {
          f32x4 v0 = acc[ai][bj][m][0], v1 = acc[ai][bj][m][1];
          u32x4 w; w.x = cvt_pk_bf16(v0[0], v0[1]); w.y = cvt_pk_bf16(v0[2], v0[3]); w.z = cvt_pk_bf16(v1[0], v1[1]); w.w = cvt_pk_bf16(v1[2], v1[3]);
          *(u32x4*)(rowp + bj * HALF) = w;
        }
      }
  }
};

struct EpiX1 {
  static constexpr bool PERM = false;
  const float* x; const float* mod; float* X1; float* SSQP;
  __device__ __forceinline__ void operator()(const f32x4 (&acc)[2][2][4][2], const Unit& u, int wr, int wc, int fr, int fq) const {
    const int row0 = u.pm * BM + wr * 64 + fr, col0 = u.pn * BM + wc * 32 + 4 * fq;
    const float* ga = mod + ((u.pm * BM) / L) * 6144 + 2048 + col0;
    f32x4 gv[2][2];
#pragma unroll
    for (int bj = 0; bj < 2; ++bj)
#pragma unroll
      for (int n = 0; n < 2; ++n) gv[bj][n] = *(const f32x4*)(ga + bj * HALF + n * 16);
#pragma unroll
    for (int ai = 0; ai < 2; ++ai)
#pragma unroll
      for (int m = 0; m < 4; ++m) {
        const size_t off = (size_t)(row0 + ai * HALF + m * 16) * D + col0;
        float ssq = 0.f;
#pragma unroll
        for (int bj = 0; bj < 2; ++bj)
#pragma unroll
          for (int n = 0; n < 2; ++n) {
            const f32x4 xv = *(const f32x4*)(x + off + bj * HALF + n * 16);
            const f32x4 o = xv + gv[bj][n] * acc[ai][bj][m][n];
            *(f32x4*)(X1 + off + bj * HALF + n * 16) = o;
            ssq += (o[0] * o[0] + o[1] * o[1]) + (o[2] * o[2] + o[3] * o[3]);
          }
        ssq += __shfl_xor(ssq, 16); ssq += __shfl_xor(ssq, 32);
        if (fq == 0) SSQP[(size_t)(row0 + ai * HALF + m * 16) * 16 + u.pn * 4 + wc] = ssq;
      }
  }
};

struct EpiSwiGLU {
  static constexpr bool PERM = true;
  bf16_t* HBb;
  __device__ __forceinline__ void operator()(const f32x4 (&acc)[2][2][4][2], const Unit& u, int wr, int wc, int fr, int fq) const {
    const int col0 = u.pn * 128 + wc * 32 + 8 * fq;
#pragma unroll
    for (int ai = 0; ai < 2; ++ai)
#pragma unroll
      for (int m = 0; m < 4; ++m) {
        const int slot = u.mu * 256 + ai * HALF + wr * 64 + m * 16 + fr;
        if (slot < u.cnt) {
          float h[8];
#pragma unroll
          for (int n = 0; n < 2; ++n)
#pragma unroll
            for (int j = 0; j < 4; ++j) { const float a = acc[ai][0][m][n][j]; h[n * 4 + j] = a / (1.f + __expf(-a)) * acc[ai][1][m][n][j]; }
          u32x4 w; w.x = cvt_pk_bf16(h[0], h[1]); w.y = cvt_pk_bf16(h[2], h[3]); w.z = cvt_pk_bf16(h[4], h[5]); w.w = cvt_pk_bf16(h[6], h[7]);
          *(u32x4*)(HBb + (size_t)(u.seg + slot) * DE + col0) = w;
        }
      }
  }
};

struct EpiDown {
  static constexpr bool PERM = true;
  bf16_t* YB2b; const int* list; const float* gate;
  __device__ __forceinline__ void operator()(const f32x4 (&acc)[2][2][4][2], const Unit& u, int wr, int wc, int fr, int fq) const {
    const int col0 = u.pn * 256 + wc * 32 + 8 * fq;
#pragma unroll
    for (int ai = 0; ai < 2; ++ai)
#pragma unroll
      for (int m = 0; m < 4; ++m) {
        const int slot = u.mu * 256 + ai * HALF + wr * 64 + m * 16 + fr;
        if (slot < u.cnt) {
          const int pair = list[u.e * T + slot];
          const float gt = gate[pair];
          bf16_t* rowp = YB2b + (size_t)pair * D + col0;
#pragma unroll
          for (int bj = 0; bj < 2; ++bj) {
            f32x4 v0 = acc[ai][bj][m][0] * gt, v1 = acc[ai][bj][m][1] * gt;
            u32x4 w; w.x = cvt_pk_bf16(v0[0], v0[1]); w.y = cvt_pk_bf16(v0[2], v0[3]); w.z = cvt_pk_bf16(v1[0], v1[1]); w.w = cvt_pk_bf16(v1[2], v1[3]);
            *(u32x4*)(rowp + bj * HALF) = w;
          }
        }
      }
  }
};

template <class Epi, class Sched>
__device__ __forceinline__ void gemm_phase(PG8_LAS unsigned char* lds, const int K, const Sched& S, const Epi& E) {
  const int tid = threadIdx.x, wid = __builtin_amdgcn_readfirstlane(tid >> 6), lane = tid & 63, wr = wid >> 2, wc = wid & 3, fr = lane & 15, fq = lane >> 4;
  const int nt = K / BK;
  int Rr[2], Cc[2];
  unsigned voffB[2];
#pragma unroll
  for (int i = 0; i < 2; ++i) {
    stage_rc(tid * 16 + i * 8192, Rr[i], Cc[i]);
    const int Rb = Epi::PERM ? ((Rr[i] & ~31) + perm32(Rr[i] & 31)) : Rr[i];
    voffB[i] = (unsigned)(Rb * K + Cc[i]) * 2u;
  }
  const size_t kstep = (size_t)(BK * 2);
  const size_t hstep = (size_t)HALF * K * 2;
  const unsigned ldsw = (unsigned)wid * 1024u;
  const int aoff = lds_byte(wr * 64 + fr, fq * 8), boff = lds_byte(wc * 32 + fr, fq * 8);
#define PG8_SA(b, h) (((b) * 2 + (h)) * HTB)
#define PG8_SB(b, h) ((4 + (b) * 2 + (h)) * HTB)
#define PG8_STAGE(bufoff, gbase, voff) do { _Pragma("unroll") for (int _i = 0; _i < 2; ++_i) \
    __builtin_amdgcn_global_load_lds((const unsigned*)((const char*)(gbase) + (voff)[_i]), (PG8_LAS unsigned*)(lds + (bufoff) + ldsw + _i * 8192), 16, 0, 0); } while (0)
#define PG8_LDA(dst, b, h) do { _Pragma("unroll") for (int m = 0; m < 4; ++m) _Pragma("unroll") for (int k = 0; k < 2; ++k) dst[m][k] = *(const PG8_LAS bf16x8*)(lds + PG8_SA(b, h) + aoff + m * 2048 + k * 1024); } while (0)
#define PG8_LDB(dst, b, h) do { _Pragma("unroll") for (int n = 0; n < 2; ++n) _Pragma("unroll") for (int k = 0; k < 2; ++k) dst[n][k] = *(const PG8_LAS bf16x8*)(lds + PG8_SB(b, h) + boff + n * 2048 + k * 1024); } while (0)
#define PG8_MMA(ai, bj, At, Bt) do { __builtin_amdgcn_s_setprio(1); _Pragma("unroll") for (int m = 0; m < 4; ++m) _Pragma("unroll") for (int n = 0; n < 2; ++n) _Pragma("unroll") for (int k = 0; k < 2; ++k) \
    acc[ai][bj][m][n] = __builtin_amdgcn_mfma_f32_16x16x32_bf16(Bt[n][k], At[m][k], acc[ai][bj][m][n], 0, 0, 0); __builtin_amdgcn_s_setprio(0); } while (0)
#define PG8_WAIT_V(n) asm volatile("s_waitcnt vmcnt(" #n ")" ::: "memory")
#define PG8_WAIT_L(n) asm volatile("s_waitcnt lgkmcnt(" #n ")" ::: "memory")
#define PG8_BAR __builtin_amdgcn_s_barrier()
#define PG8_SCHED __builtin_amdgcn_sched_barrier(0)
  Unit cur, nxt; int ui = 0;
  if (!S.next(0, cur)) return;
  f32x4 acc[2][2][4][2];
#pragma unroll
  for (int a = 0; a < 2; ++a)
#pragma unroll
    for (int b = 0; b < 2; ++b)
#pragma unroll
      for (int m = 0; m < 4; ++m)
#pragma unroll
        for (int n = 0; n < 2; ++n) acc[a][b][m][n] = (f32x4){0.f, 0.f, 0.f, 0.f};
  bf16x8 At[4][2], B0[2][2], B1[2][2];
  unsigned cao[2][2], nao[2][2];
  S.a_offs(cur, Rr, Cc, cao);
  const char* const aB = S.a_base();
  const char* cB = S.b_ptr(cur);
  PG8_STAGE(PG8_SB(0, 0), cB, voffB); PG8_STAGE(PG8_SA(0, 0), aB, cao[0]); PG8_STAGE(PG8_SB(0, 1), cB + hstep, voffB); PG8_STAGE(PG8_SA(0, 1), aB, cao[1]);
  if (wr == 1) PG8_BAR;
  PG8_WAIT_V(4); PG8_BAR;
  PG8_STAGE(PG8_SB(1, 0), cB + kstep, voffB); PG8_STAGE(PG8_SA(1, 0), aB + kstep, cao[0]); PG8_STAGE(PG8_SB(1, 1), cB + hstep + kstep, voffB);
  PG8_WAIT_V(6); PG8_BAR;
  for (;;) {
    const bool has_next = S.next(ui + 1, nxt);
    const char* nB = cB;
    if (has_next) { S.a_offs(nxt, Rr, Cc, nao); nB = S.b_ptr(nxt); }
    else {
#pragma unroll
      for (int h = 0; h < 2; ++h)
#pragma unroll
        for (int i = 0; i < 2; ++i) nao[h][i] = cao[h][i];
    }
    const bool full = cur.nv > 128;
    for (int t = 0; t < nt; t += 2) {
      const bool last = (t == nt - 2);
      const char* a1 = aB + (size_t)(t + 1) * kstep;
      const char* a2 = last ? aB : aB + (size_t)(t + 2) * kstep; const char* b2 = last ? nB : cB + (size_t)(t + 2) * kstep;
      const char* a3 = a2 + kstep; const char* b3 = b2 + kstep;
      unsigned so[2][2];
#pragma unroll
      for (int h = 0; h < 2; ++h)
#pragma unroll
        for (int i = 0; i < 2; ++i) so[h][i] = last ? nao[h][i] : cao[h][i];
      PG8_LDB(B0, 0, 0); PG8_SCHED; PG8_LDA(At, 0, 0); PG8_STAGE(PG8_SA(1, 1), a1, cao[1]);
      PG8_WAIT_L(8); PG8_BAR; PG8_WAIT_L(0); PG8_MMA(0, 0, At, B0); PG8_BAR; PG8_SCHED;
      PG8_LDB(B1, 0, 1); PG8_STAGE(PG8_SB(0, 0), b2, voffB);
      PG8_BAR; PG8_WAIT_L(0); PG8_MMA(0, 1, At, B1); PG8_BAR;
      PG8_LDA(At, 0, 1); PG8_STAGE(PG8_SA(0, 0), a2, so[0]);
      PG8_BAR; PG8_WAIT_L(0); if (full) PG8_MMA(1, 0, At, B0); PG8_BAR; PG8_SCHED;
      PG8_STAGE(PG8_SB(0, 1), b2 + hstep, voffB);
      PG8_WAIT_V(6); PG8_BAR; if (full) PG8_MMA(1, 1, At, B1); PG8_BAR;
      PG8_LDB(B0, 1, 0); PG8_SCHED; PG8_LDA(At, 1, 0); PG8_STAGE(PG8_SA(0, 1), a2, so[1]);
      PG8_WAIT_L(8); PG8_BAR; PG8_WAIT_L(0); PG8_MMA(0, 0, At, B0); PG8_BAR; PG8_SCHED;
      PG8_LDB(B1, 1, 1); PG8_STAGE(PG8_SB(1, 0), b3, voffB);
      PG8_BAR; PG8_WAIT_L(0); PG8_MMA(0, 1, At, B1); PG8_BAR;
      PG8_LDA(At, 1, 1); PG8_STAGE(PG8_SA(1, 0), a3, so[0]);
      PG8_BAR; PG8_WAIT_L(0); if (full) PG8_MMA(1, 0, At, B0); PG8_BAR; PG8_SCHED;
      PG8_STAGE(PG8_SB(1, 1), b3 + hstep, voffB);
      PG8_WAIT_V(6); PG8_BAR; if (full) PG8_MMA(1, 1, At, B1); PG8_BAR;
    }
    E(acc, cur, wr, wc, fr, fq);
    if (!has_next) break;
#pragma unroll
    for (int a = 0; a < 2; ++a)
#pragma unroll
      for (int b = 0; b < 2; ++b)
#pragma unroll
        for (int m = 0; m < 4; ++m)
#pragma unroll
          for (int n = 0; n < 2; ++n) acc[a][b][m][n] = (f32x4){0.f, 0.f, 0.f, 0.f};
    cur = nxt; cB = nB; ++ui;
#pragma unroll
    for (int h = 0; h < 2; ++h)
#pragma unroll
      for (int i = 0; i < 2; ++i) cao[h][i] = nao[h][i];
  }
  PG8_WAIT_V(0);
  if (wr == 0) PG8_BAR;
  PG8_BAR;
#undef PG8_SA
#undef PG8_SB
#undef PG8_STAGE
#undef PG8_LDA
#undef PG8_LDB
#undef PG8_MMA
#undef PG8_WAIT_V
#undef PG8_WAIT_L
#undef PG8_BAR
#undef PG8_SCHED
}
}

__device__ void ph_adaln(const Params& p, float* sm) {
  const int tid = threadIdx.x;
  if (blockIdx.x == 0 && tid < NE) p.CNT[tid] = 0;
  for (int e = blockIdx.x * NTHR + tid; e < 96 * 1024; e += gridDim.x * NTHR) {
    const int j = e >> 10, k = e & 1023;
    float w = 0.f;
    if (j < 64) w = p.w_expert[k * 64 + j]; else if (j < 72) w = p.w_group[k * 8 + (j - 64)];
    const unsigned hi = cvt_pk_bf16(w, 0.f) & 0xffffu;
    const float rem = w - __uint_as_float(hi << 16);
    p.WRhi[e] = (bf16_t)hi; p.WRlo[e] = (bf16_t)(cvt_pk_bf16(rem, 0.f) & 0xffffu);
  }
  float* sc = sm;
  float* red = sm + 9 * 1024;
  for (int e = tid; e < 9 * 1024; e += NTHR) {
    const int r = e >> 10, k = e & 1023;
    sc[e] = silu_f(r < 8 ? p.c[r * D + k] : p.c_ctx[k]);
  }
  __syncthreads();
  for (int item = blockIdx.x; item < 192; item += gridDim.x) {
    const int col0 = item * 32;
    const int kq = tid >> 3, c4 = (tid & 7) * 4;
    float acc[9][4];
#pragma unroll
    for (int r = 0; r < 9; ++r)
#pragma unroll
      for (int j = 0; j < 4; ++j) acc[r][j] = 0.f;
    float4 wv[16];
#pragma unroll
    for (int i = 0; i < 16; ++i) wv[i] = *(const float4*)(p.w_ada + (size_t)(kq + i * 64) * 6144 + col0 + c4);
#pragma unroll
    for (int i = 0; i < 16; ++i) {
      const int k = kq + i * 64;
      const float4 w = wv[i];
#pragma unroll
      for (int r = 0; r < 9; ++r) {
        const float sv = sc[r * 1024 + k];
        acc[r][0] += sv * w.x; acc[r][1] += sv * w.y; acc[r][2] += sv * w.z; acc[r][3] += sv * w.w;
      }
    }
#pragma unroll
    for (int r = 0; r < 9; ++r)
#pragma unroll
      for (int j = 0; j < 4; ++j) red[kq * 292 + r * 32 + c4 + j] = acc[r][j];
    __syncthreads();
    if (tid < 288) {
      float a = 0.f;
      for (int q = 0; q < 64; ++q) a += red[q * 292 + tid];
      const int r = tid >> 5, j = tid & 31;
      p.MOD[r * 6144 + col0 + j] = a + p.b_ada[col0 + j];
    }
    __syncthreads();
  }
}

__device__ void ph_filters(const Params& p, float* sm) {
  const int tid = threadIdx.x, wid = tid >> 6, lane = tid & 63;
  float* feats = sm;
  float* h1 = sm + 64 * 20;
  float* h2 = h1 + 64 * 64;
  float* w3s = h2 + 64 * 64;
  bf16_t* tile = (bf16_t*)w3s;
  float* w2s = w3s + 64 * 256;
  float* w1s = w2s + 4096;
  for (int e = tid; e < 4096; e += NTHR) w2s[e] = p.f_w2[e];
  for (int e = tid; e < 17 * 64; e += NTHR) w1s[e] = p.f_w1[e];
  __syncthreads();
  for (int e = blockIdx.x * NTHR + tid; e < 1024 * 137; e += gridDim.x * NTHR) {
    int rowi = e / 137, k = e - rowi * 137;
    int x = (k < 65) ? k : (4160 + (k - 65));
    p.FILTt[(size_t)rowi * FLEN + x] = 0;
  }
  for (int item = blockIdx.x; item < 256; item += gridDim.x) {
    const int tt = item >> 3, ct = item & 7;
    for (int e = tid; e < 64 * 17; e += NTHR) {
      int tp = e / 17, i = e - tp * 17;
      int t = tt * 64 + tp;
      float f;
      if (i == 0) f = (float)t / (float)(L - 1);
      else {
        int bi = (i - 1) & 7;
        float bandf = (float)(1e-4 + (double)bi * ((7.0 - 1e-4) / 7.0));
        float ang = (float)(2.0 * 3.14159265358979323846 / (double)L) * (float)t * bandf;
        f = (i <= 8) ? cosf(ang) : -sinf(ang);
      }
      feats[tp * 20 + i] = f;
    }
    __syncthreads();
    for (int e = tid; e < 4096; e += NTHR) {
      int tp = e >> 6, j = e & 63;
      float a = p.f_b1[j];
      for (int i = 0; i < 17; ++i) a += feats[tp * 20 + i] * w1s[i * 64 + j];
      h1[e] = __sinf(p.f_freq[j] * a);
    }
    __syncthreads();
    for (int e = tid; e < 4096; e += NTHR) {
      int tp = e >> 6, j = e & 63;
      float a = p.f_b2[j];
      for (int i = 0; i < 64; ++i) a += h1[tp * 64 + i] * w2s[i * 64 + j];
      h2[e] = __sinf(p.f_freq[j] * a);
    }
    __syncthreads();
    for (int e = tid; e < 4096; e += NTHR) {
      const int i = e >> 6, c4 = (e & 63) * 4;
      *(float4*)(w3s + i * 256 + c4) = *(const float4*)(p.f_w3 + i * 2048 + ct * 256 + c4);
    }
    __syncthreads();
    {
      const int cg = tid & 31, tg = tid >> 5;
      float acc[4][8];
#pragma unroll
      for (int a = 0; a < 4; ++a)
#pragma unroll
        for (int c = 0; c < 8; ++c) acc[a][c] = 0.f;
#pragma unroll 4
      for (int i = 0; i < 64; ++i) {
        const float4 w0 = *(const float4*)(w3s + i * 256 + cg * 8), w1 = *(const float4*)(w3s + i * 256 + cg * 8 + 4);
        const float wv[8] = {w0.x, w0.y, w0.z, w0.w, w1.x, w1.y, w1.z, w1.w};
#pragma unroll
        for (int a = 0; a < 4; ++a) {
          const float hv = h2[(tg * 4 + a) * 64 + i];
#pragma unroll
          for (int c = 0; c < 8; ++c) acc[a][c] += hv * wv[c];
        }
      }
      __syncthreads();
      const float d0 = -4.605170185988091f / 1.5f, d1 = -4.605170185988091f / 0.3f;
#pragma unroll
      for (int c = 0; c < 8; ++c) {
        const int col = cg * 8 + c;
        const int cch = (ct * 256 + col) & 511;
        const float delta = fabsf(d0 + (float)cch * ((d1 - d0) / 511.f));
#pragma unroll
        for (int a = 0; a < 4; ++a) {
          const int t = tt * 64 + tg * 4 + a;
          const float tn = (float)t / (float)(L - 1);
          tile[col * 66 + tg * 4 + a] = f2bf(acc[a][c] * __expf(-tn * delta));
        }
      }
    }
    __syncthreads();
    for (int cl = wid * 32; cl < wid * 32 + 32; ++cl) {
      const int gcol = ct * 256 + cl;
      const int o = gcol >> 10, dir = (gcol >> 9) & 1, cch = gcol & 511;
      const int t = tt * 64 + lane;
      const int x = dir ? (HX0 + t) : (HX0 - t);
      if (!(dir && t == 0)) p.FILTt[(size_t)(o * 512 + cch) * FLEN + x] = tile[cl * 66 + lane];
    }
    __syncthreads();
  }
}

__device__ __forceinline__ void cvt_tile256(const float* src, int ld, int k0, int n0, bf16_t* dst, int ldd, int dmap0, int dmap1, int nsplit, float* sm) {
  const int tid = threadIdx.x;
  float* ts = sm;
  float4 v[8];
#pragma unroll
  for (int i = 0; i < 8; ++i) {
    const int e = tid + i * NTHR; const int k = e >> 6, n4 = (e & 63) * 4;
    v[i] = *(const float4*)(src + (size_t)(k0 + k) * ld + n0 + n4);
  }
#pragma unroll
  for (int i = 0; i < 8; ++i) {
    const int e = tid + i * NTHR; const int k = e >> 6, n4 = (e & 63) * 4;
    ts[k * 257 + n4 + 0] = v[i].x; ts[k * 257 + n4 + 1] = v[i].y; ts[k * 257 + n4 + 2] = v[i].z; ts[k * 257 + n4 + 3] = v[i].w;
  }
  __syncthreads();
#pragma unroll
  for (int i = 0; i < 4; ++i) {
    const int e = tid + i * NTHR; const int n = e >> 3, kq = (e & 7) * 8;
    uint4 w;
    w.x = cvt_pk_bf16(ts[(kq + 0) * 257 + n], ts[(kq + 1) * 257 + n]);
    w.y = cvt_pk_bf16(ts[(kq + 2) * 257 + n], ts[(kq + 3) * 257 + n]);
    w.z = cvt_pk_bf16(ts[(kq + 4) * 257 + n], ts[(kq + 5) * 257 + n]);
    w.w = cvt_pk_bf16(ts[(kq + 6) * 257 + n], ts[(kq + 7) * 257 + n]);
    const int drow = (n < nsplit) ? (dmap0 + n) : (dmap1 + (n - nsplit));
    *(uint4*)(dst + (size_t)drow * ldd + k0 + kq) = w;
  }
  __syncthreads();
}

__device__ void ph_wcvt(const Params& p, float* sm) {
  for (int e = blockIdx.x * NTHR + threadIdx.x; e < 16 * 1024; e += gridDim.x * NTHR) {
    const int j = e >> 10, k = e & 1023;
    p.WinT[(size_t)(DP + j) * D + k] = f2bf(p.w_in[(size_t)k * DIN + COL_DT + j]);
  }
  for (int it = blockIdx.x; it < 192 + 64; it += gridDim.x) {
    if (it < 192) { const int kt = it / 12, nt = it - kt * 12; cvt_tile256(p.w_in, DIN, kt * 64, nt * 256, p.WinT, D, nt * 256, 0, 256, sm); }
    else if (it < 256) { const int i = it - 192; const int kt = i >> 2, nt = i & 3; cvt_tile256(p.w_out, D, kt * 64, nt * 256, p.WoutT, D, nt * 256, 0, 256, sm); }
  }
}

__device__ void ph_norm1(const Params& p) {
  const int tid = threadIdx.x, wid = tid >> 6, lane = tid & 63;
  for (int row = blockIdx.x * 8 + wid; row < TT; row += gridDim.x * 8) {
    const float* src = (row < T) ? (p.x + (size_t)row * D) : (p.ctx + (size_t)(row - T) * D);
    const int mr = (row < T) ? (row / L) : 8;
    const float* sh = p.MOD + mr * 6144;
    const float* sc = sh + 1024;
    float4 v[4];
    float ss = 0.f;
#pragma unroll
    for (int i = 0; i < 4; ++i) {
      v[i] = *(const float4*)(src + i * 256 + lane * 4);
      ss += v[i].x * v[i].x + v[i].y * v[i].y + v[i].z * v[i].z + v[i].w * v[i].w;
    }
    ss = wave_sum(ss);
    const float rstd = rsqrtf(ss * (1.f / D) + EPS);
#pragma unroll
    for (int i = 0; i < 4; ++i) {
      const int col = i * 256 + lane * 4;
      float4 g = *(const float4*)(p.g1 + col);
      float4 s4 = *(const float4*)(sc + col);
      float4 h4 = *(const float4*)(sh + col);
      float4 o;
      o.x = v[i].x * rstd * g.x * (1.f + s4.x) + h4.x;
      o.y = v[i].y * rstd * g.y * (1.f + s4.y) + h4.y;
      o.z = v[i].z * rstd * g.z * (1.f + s4.z) + h4.z;
      o.w = v[i].w * rstd * g.w * (1.f + s4.w) + h4.w;
      uint2 w; w.x = cvt_pk_bf16(o.x, o.y); w.y = cvt_pk_bf16(o.z, o.w);
      *(uint2*)(p.XNb + (size_t)row * D + col) = w;
    }
  }
}

__device__ void ph_hy_convT(const Params& p, float* sm) {
  const int tid = threadIdx.x;
  float* tile = sm;
  const int bid = blockIdx.x;
  int it0, it1;
  if (gridDim.x == 256) { if (bid < 32) { it0 = bid * 3; it1 = it0 + 3; } else { it0 = 96 + (bid - 32) * 27; it1 = it0 + 27; } }
  else { const int per = (256 * 24 + gridDim.x - 1) / gridDim.x; it0 = bid * per; it1 = it0 + per; if (it1 > 256 * 24) it1 = 256 * 24; }
  for (int item = it0; item < it1; ++item) {
    const int gr = item / 24, ct = item - gr * 24;
    const int row0 = gr * 64;
    {
      const int t = tid >> 3, c8 = (tid & 7) * 8;
      uint4 v = *(const uint4*)(p.PXb + (size_t)(row0 + t) * DP + ct * 64 + c8);
      unsigned w[4] = {v.x, v.y, v.z, v.w};
#pragma unroll
      for (int k = 0; k < 4; ++k) {
        tile[t * 65 + c8 + 2 * k] = __uint_as_float(w[k] << 16);
        tile[t * 65 + c8 + 2 * k + 1] = __uint_as_float(w[k] & 0xffff0000u);
      }
    }
    __syncthreads();
    {
      const int cc = tid >> 3, t8 = (tid & 7) * 8;
      const int col = ct * 64 + cc;
      const float w0 = p.hy_conv_w[col], w1 = p.hy_conv_w[HYC + col], w2 = p.hy_conv_w[2 * HYC + col], bb = p.hy_conv_b[col];
      float o[8];
#pragma unroll
      for (int k = 0; k < 8; ++k) {
        const int t = t8 + k;
        float v = bb + w1 * tile[t * 65 + cc];
        if (t > 0) v += w0 * tile[(t - 1) * 65 + cc];
        if (t < 63) v += w2 * tile[(t + 1) * 65 + cc];
        o[k] = v;
      }
      uint4 w; w.x = cvt_pk_bf16(o[0], o[1]); w.y = cvt_pk_bf16(o[2], o[3]); w.z = cvt_pk_bf16(o[4], o[5]); w.w = cvt_pk_bf16(o[6], o[7]);
      *(uint4*)(p.Ut + (size_t)col * T + row0 + t8) = w;
    }
    __syncthreads();
  }
}

__device__ void ph_hy_backT(const Params& p, float* sm) {
  const int tid = threadIdx.x;
  bf16_t* tile = (bf16_t*)sm;
  for (int item = blockIdx.x; item < 256 * 8; item += gridDim.x) {
    const int gr = item >> 3, ct = item & 7;
    const int row0 = gr * 64;
    {
      const int cc = tid >> 3, r8 = (tid & 7) * 8;
      uint4 v = *(const uint4*)(p.Yt + (size_t)(ct * 64 + cc) * T + row0 + r8);
      unsigned w[4] = {v.x, v.y, v.z, v.w};
#pragma unroll
      for (int k = 0; k < 4; ++k) {
        tile[cc * 66 + r8 + 2 * k] = (bf16_t)(w[k] & 0xffffu);
        tile[cc * 66 + r8 + 2 * k + 1] = (bf16_t)(w[k] >> 16);
      }
    }
    __syncthreads();
    {
      const int r = tid >> 3, c8 = (tid & 7) * 8;
      unsigned w[4];
#pragma unroll
      for (int k = 0; k < 4; ++k) w[k] = (unsigned)tile[(c8 + 2 * k) * 66 + r] | ((unsigned)tile[(c8 + 2 * k + 1) * 66 + r] << 16);
      uint4 o; o.x = w[0]; o.y = w[1]; o.z = w[2]; o.w = w[3];
      *(uint4*)(p.YMIXb + (size_t)(row0 + r) * D + ct * 64 + c8) = o;
    }
    __syncthreads();
  }
}

typedef short hbf16x8 __attribute__((ext_vector_type(8)));
typedef float hf32x4 __attribute__((ext_vector_type(4)));

constexpr int HY_FC = 0, HY_ZT0 = 4 * FCLEN * 2, HY_ZT1 = HY_ZT0 + 8 * ZSTRB;

__device__ __forceinline__ void hy_build_filter(const Params& p, int o, int c, unsigned char* lds) {
  const int tid = threadIdx.x;
  const bf16_t* gsrc = p.FILTt + (size_t)(o * 512 + c) * FLEN;
  for (int e = tid; e < 530; e += NTHR) {
    uint4 v = make_uint4(0u, 0u, 0u, 0u);
    if (e < 529) v = *(const uint4*)(gsrc + e * 8);
    *(uint4*)(lds + HY_FC + e * 16) = v;
  }
  __syncthreads();
  for (int g = tid; g < 3 * 530; g += NTHR) {
    const int r = 1 + g / 530, ch = g % 530;
    uint4 lo = make_uint4(0u, 0u, 0u, 0u);
    if (ch > 0) lo = *(const uint4*)(lds + HY_FC + (ch - 1) * 16);
    uint4 hi = *(const uint4*)(lds + HY_FC + ch * 16);
    unsigned W[8] = {lo.x, lo.y, lo.z, lo.w, hi.x, hi.y, hi.z, hi.w};
    uint4 ov;
    if (r == 1) {
      ov.x = __builtin_amdgcn_alignbyte(W[4], W[3], 2); ov.y = __builtin_amdgcn_alignbyte(W[5], W[4], 2);
      ov.z = __builtin_amdgcn_alignbyte(W[6], W[5], 2); ov.w = __builtin_amdgcn_alignbyte(W[7], W[6], 2);
    } else if (r == 2) {
      ov.x = W[3]; ov.y = W[4]; ov.z = W[5]; ov.w = W[6];
    } else {
      ov.x = __builtin_amdgcn_alignbyte(W[3], W[2], 2); ov.y = __builtin_amdgcn_alignbyte(W[4], W[3], 2);
      ov.z = __builtin_amdgcn_alignbyte(W[5], W[4], 2); ov.w = __builtin_amdgcn_alignbyte(W[6], W[5], 2);
    }
    *(uint4*)(lds + HY_FC + r * (FCLEN * 2) + ch * 16) = ov;
  }
  __syncthreads();
}

__device__ __forceinline__ void hy_order(const Params& p, int o, int c, unsigned char* lds) {
  const int tid = threadIdx.x, wid = __builtin_amdgcn_readfirstlane(tid >> 6), lane = tid & 63;
  const int g0 = wid * 4;
  const int n16 = lane & 15, h = lane >> 4, bb = n16 & 7, pp = n16 >> 3;
  const unsigned char* Zin = lds + (o ? HY_ZT1 : HY_ZT0);
  const bf16_t* gate = p.Ut + (size_t)((o + 1) * 512 + c) * T + bb * L;
  uint2 xg[4][2];
#pragma unroll
  for (int i = 0; i < 4; ++i)
#pragma unroll
    for (int u = 0; u < 2; ++u) xg[i][u] = *(const uint2*)(gate + 32 * (2 * (g0 + i) + pp) + 16 * u + 4 * h);
  const float bias = p.hy_bias[o * 512 + c];
  hf32x4 acc[4][2];
#pragma unroll
  for (int i = 0; i < 4; ++i)
#pragma unroll
    for (int u = 0; u < 2; ++u) acc[i][u] = (hf32x4){0.f, 0.f, 0.f, 0.f};
  const int ai = lane & 15, ar = ai & 3, aq = ai >> 2;
  const unsigned char* laneA = lds + HY_FC + ar * (FCLEN * 2) + 2 * (HX0 - 4 * aq + 8 * h);
  const unsigned char* laneB = Zin + bb * ZSTRB + 64 + 64 * pp + 16 * h;
#define HY_LDA(dst, Dd) do { const uint2 _lo = *(const uint2*)(laneA - 32 * (Dd)); const uint2 _hi = *(const uint2*)(laneA - 32 * (Dd) + 8); \
    union { uint4 u4; hbf16x8 v; } _cv; _cv.u4 = make_uint4(_lo.x, _lo.y, _hi.x, _hi.y); dst = _cv.v; } while (0)
#define HY_LDB(dst, Qq) do { dst = *(const hbf16x8*)(laneB + 64 * (Qq)); } while (0)
#pragma unroll 1
  for (int pass = 0; pass < 2; ++pass) {
    const int Es = 2 * g0 - 63 + pass;
    hbf16x8 R[4];
    HY_LDB(R[1], 2 * (g0 + 1) - Es); HY_LDB(R[2], 2 * (g0 + 2) - Es); HY_LDB(R[3], 2 * (g0 + 3) - Es);
#pragma unroll 1
    for (int n4 = 0; n4 < 9; ++n4) {
#pragma unroll
      for (int j = 0; j < 4; ++j) {
        const int n = n4 * 4 + j;
        const int E = Es + 2 * n;
        HY_LDB(R[(4 - j) & 3], 2 * (g0 - n) - Es);
        hbf16x8 A0, A1;
        HY_LDA(A0, 2 * E); HY_LDA(A1, 2 * E + 1);
#pragma unroll
        for (int i = 0; i < 4; ++i) {
          const int Q = 2 * (g0 + i - n) - Es;
          if (Q >= -1 && Q <= 63) {
            acc[i][0] = __builtin_amdgcn_mfma_f32_16x16x32_bf16(A0, R[(i - j) & 3], acc[i][0], 0, 0, 0);
            acc[i][1] = __builtin_amdgcn_mfma_f32_16x16x32_bf16(A1, R[(i - j) & 3], acc[i][1], 0, 0, 0);
          }
        }
      }
    }
  }
#undef HY_LDA
#undef HY_LDB
#pragma unroll
  for (int i = 0; i < 4; ++i)
#pragma unroll
    for (int u = 0; u < 2; ++u) {
      const int t0 = 32 * (2 * (g0 + i) + pp) + 16 * u + 4 * h;
      const uint2 zv = *(const uint2*)(Zin + bb * ZSTRB + 64 + 2 * t0);
      const float z0 = __uint_as_float(zv.x << 16), z1 = __uint_as_float(zv.x & 0xffff0000u), z2 = __uint_as_float(zv.y << 16), z3 = __uint_as_float(zv.y & 0xffff0000u);
      const float x0 = __uint_as_float(xg[i][u].x << 16), x1 = __uint_as_float(xg[i][u].x & 0xffff0000u), x2 = __uint_as_float(xg[i][u].y << 16), x3 = __uint_as_float(xg[i][u].y & 0xffff0000u);
      const float r0 = x0 * (acc[i][u][0] + z0 * bias), r1 = x1 * (acc[i][u][1] + z1 * bias), r2 = x2 * (acc[i][u][2] + z2 * bias), r3 = x3 * (acc[i][u][3] + z3 * bias);
      uint2 w; w.x = cvt_pk_bf16(r0, r1); w.y = cvt_pk_bf16(r2, r3);
      if (o == 0) *(uint2*)(lds + HY_ZT1 + bb * ZSTRB + 64 + 2 * t0) = w;
      else *(uint2*)(p.Yt + (size_t)c * T + bb * L + t0) = w;
    }
}

__device__ void hyena_unit(const Params& p, int c, unsigned char* lds) {
  const int tid = threadIdx.x;
  if (tid < 144) {
    const int buf = tid / 72, rem = tid % 72, b = rem / 9, k = rem % 9;
    const int off = (k < 4) ? (k * 16) : (4160 + (k - 4) * 16);
    *(uint4*)(lds + (buf ? HY_ZT1 : HY_ZT0) + b * ZSTRB + off) = make_uint4(0u, 0u, 0u, 0u);
  }
  for (int e = tid; e < 2048; e += NTHR) {
    const int b = e >> 8, ch = e & 255;
    *(uint4*)(lds + HY_ZT0 + b * ZSTRB + 64 + ch * 16) = *(const uint4*)(p.Ut + (size_t)c * T + b * L + ch * 8);
  }
#pragma unroll 1
  for (int o = 0; o < 2; ++o) {
    hy_build_filter(p, o, c, lds);
    hy_order(p, o, c, lds);
    __syncthreads();
  }
}

constexpr int SROW = 272;

__device__ __forceinline__ void ssd_stage_nat(const Params& p, int row0, int pxcol0, int cvcol0, unsigned char* dst) {
  for (int e = threadIdx.x; e < 2048; e += NTHR) {
    const int l = e >> 4, cg = e & 15;
    const int row = row0 + l, li = row & 63;
    const bf16_t* src = p.PXb + (size_t)row * DP + pxcol0 + cg * 8;
    const uint4 zero4 = make_uint4(0u, 0u, 0u, 0u);
    const uint4 cur = *(const uint4*)src;
    const uint4 prv = (li > 0) ? *(const uint4*)(src - DP) : zero4;
    const uint4 nxt = (li < 63) ? *(const uint4*)(src + DP) : zero4;
    const float* cw = p.ssd_conv_w + cvcol0 + cg * 8;
    const float* cb = p.ssd_conv_b + cvcol0 + cg * 8;
    const unsigned pc[4] = {prv.x, prv.y, prv.z, prv.w}, cc[4] = {cur.x, cur.y, cur.z, cur.w}, nc[4] = {nxt.x, nxt.y, nxt.z, nxt.w};
    float o[8];
#pragma unroll
    for (int k = 0; k < 4; ++k) {
      const float p0 = __uint_as_float(pc[k] << 16), p1 = __uint_as_float(pc[k] & 0xffff0000u);
      const float c0 = __uint_as_float(cc[k] << 16), c1 = __uint_as_float(cc[k] & 0xffff0000u);
      const float n0 = __uint_as_float(nc[k] << 16), n1 = __uint_as_float(nc[k] & 0xffff0000u);
      const float v0 = cb[2 * k] + cw[2 * k] * p0 + cw[DXBC + 2 * k] * c0 + cw[2 * DXBC + 2 * k] * n0;
      const float v1 = cb[2 * k + 1] + cw[2 * k + 1] * p1 + cw[DXBC + 2 * k + 1] * c1 + cw[2 * DXBC + 2 * k + 1] * n1;
      o[2 * k] = silu_f(v0); o[2 * k + 1] = silu_f(v1);
    }
    uint4 w; w.x = cvt_pk_bf16(o[0], o[1]); w.y = cvt_pk_bf16(o[2], o[3]); w.z = cvt_pk_bf16(o[4], o[5]); w.w = cvt_pk_bf16(o[6], o[7]);
    *(uint4*)(dst + l * SROW + cg * 16) = w;
  }
}

__device__ __forceinline__ void ssd_stage_tr(const Params& p, int row0, bool is_ctx, int pxcol0, int cvcol0, int ncols, unsigned char* dst) {
  const int ncg = ncols >> 2;
  for (int e = threadIdx.x; e < ncg * 16; e += NTHR) {
    const int cg = e % ncg, l8 = e / ncg;
    const int rowf = row0 + l8 * 8;
    bool has_prev, has_next;
    if (is_ctx) { const int tc = (rowf - T) & (LC - 1); has_prev = tc > 0; has_next = tc + 7 < LC - 1; }
    else { const int li = rowf & 63; has_prev = li > 0; has_next = li + 7 < 63; }
    const bf16_t* src = p.PXb + (size_t)rowf * DP + pxcol0 + cg * 4;
    const uint2 z2 = make_uint2(0u, 0u);
    uint2 raw[10];
    raw[0] = *(const uint2*)((cvcol0 >= 0 && has_prev) ? (src - DP) : src);
    if (!(cvcol0 >= 0 && has_prev)) raw[0] = z2;
#pragma unroll
    for (int k = 0; k < 8; ++k) raw[k + 1] = *(const uint2*)(src + (size_t)k * DP);
    raw[9] = *(const uint2*)((cvcol0 >= 0 && has_next) ? (src + (size_t)8 * DP) : src);
    if (!(cvcol0 >= 0 && has_next)) raw[9] = z2;
    unsigned outw[4][4];
    if (cvcol0 >= 0) {
      const float* cw = p.ssd_conv_w + cvcol0 + cg * 4; const float* cb = p.ssd_conv_b + cvcol0 + cg * 4;
      const float4 a0 = *(const float4*)cw, b0 = *(const float4*)(cw + DXBC), c0 = *(const float4*)(cw + 2 * DXBC), d0 = *(const float4*)cb;
      const float w0[4] = {a0.x, a0.y, a0.z, a0.w}, w1[4] = {b0.x, b0.y, b0.z, b0.w}, w2[4] = {c0.x, c0.y, c0.z, c0.w}, bb[4] = {d0.x, d0.y, d0.z, d0.w};
#pragma unroll
      for (int kp = 0; kp < 4; ++kp) {
#pragma unroll
        for (int c = 0; c < 4; ++c) {
          const unsigned q0 = (c >> 1) ? raw[2 * kp].y : raw[2 * kp].x, q1 = (c >> 1) ? raw[2 * kp + 1].y : raw[2 * kp + 1].x;
          const unsigned q2 = (c >> 1) ? raw[2 * kp + 2].y : raw[2 * kp + 2].x, q3 = (c >> 1) ? raw[2 * kp + 3].y : raw[2 * kp + 3].x;
          float x0, x1, x2, x3;
          if (c & 1) { x0 = __uint_as_float(q0 & 0xffff0000u); x1 = __uint_as_float(q1 & 0xffff0000u); x2 = __uint_as_float(q2 & 0xffff0000u); x3 = __uint_as_float(q3 & 0xffff0000u); }
          else { x0 = __uint_as_float(q0 << 16); x1 = __uint_as_float(q1 << 16); x2 = __uint_as_float(q2 << 16); x3 = __uint_as_float(q3 << 16); }
          const float oa = silu_f(bb[c] + w0[c] * x0 + w1[c] * x1 + w2[c] * x2);
          const float ob = silu_f(bb[c] + w0[c] * x1 + w1[c] * x2 + w2[c] * x3);
          outw[c][kp] = cvt_pk_bf16(oa, ob);
        }
      }
    } else {
#pragma unroll
      for (int kp = 0; kp < 4; ++kp) {
#pragma unroll
        for (int c = 0; c < 4; ++c) {
          const unsigned q1 = (c >> 1) ? raw[2 * kp + 1].y : raw[2 * kp + 1].x, q2 = (c >> 1) ? raw[2 * kp + 2].y : raw[2 * kp + 2].x;
          outw[c][kp] = (c & 1) ? ((q1 >> 16) | (q2 & 0xffff0000u)) : ((q1 & 0xffffu) | (q2 << 16));
        }
      }
    }
#pragma unroll
    for (int c = 0; c < 4; ++c)
      *(uint4*)(dst + (cg * 4 + c) * SROW + l8 * 16) = make_uint4(outw[c][0], outw[c][1], outw[c][2], outw[c][3]);
  }
}

__device__ __forceinline__ void ssd_stage_tr_s(const Params& p, int row0, bool is_ctx, int pxcol0, int cvcol0, int ncols, unsigned char* dst) {
  for (int e = threadIdx.x; e < ncols * 16; e += NTHR) {
    const int col = e & (ncols - 1), l8 = e / ncols;
    const int rowf = row0 + l8 * 8;
    bool has_prev, has_next;
    if (is_ctx) { const int tc = (rowf - T) & (LC - 1); has_prev = tc > 0; has_next = tc + 7 < LC - 1; }
    else { const int li = rowf & 63; has_prev = li > 0; has_next = li + 7 < 63; }
    const bf16_t* src = p.PXb + (size_t)rowf * DP + pxcol0 + col;
    float x[10];
    x[0] = (cvcol0 >= 0 && has_prev) ? bf2f(src[-DP]) : 0.f;
#pragma unroll
    for (int k = 0; k < 8; ++k) x[k + 1] = bf2f(src[(size_t)k * DP]);
    x[9] = (cvcol0 >= 0 && has_next) ? bf2f(src[(size_t)8 * DP]) : 0.f;
    float o[8];
    if (cvcol0 >= 0) {
      const float w0 = p.ssd_conv_w[cvcol0 + col], w1 = p.ssd_conv_w[DXBC + cvcol0 + col], w2 = p.ssd_conv_w[2 * DXBC + cvcol0 + col], bb = p.ssd_conv_b[cvcol0 + col];
#pragma unroll
      for (int k = 0; k < 8; ++k) o[k] = silu_f(bb + w0 * x[k] + w1 * x[k + 1] + w2 * x[k + 2]);
    } else {
#pragma unroll
      for (int k = 0; k < 8; ++k) o[k] = x[k + 1];
    }
    uint4 w; w.x = cvt_pk_bf16(o[0], o[1]); w.y = cvt_pk_bf16(o[2], o[3]); w.z = cvt_pk_bf16(o[4], o[5]); w.w = cvt_pk_bf16(o[6], o[7]);
    *(uint4*)(dst + col * SROW + l8 * 16) = w;
  }
}

__device__ void ssd_states_unit(const Params& p, int unit, unsigned char* lds) {
  const int tid = threadIdx.x, wid = __builtin_amdgcn_readfirstlane(tid >> 6), lane = tid & 63;
  const int g = unit & 1, bc = unit >> 1, cidx = bc % 18, b = bc / 18;
  const bool is_ctx = cidx < 2;
  const int row0 = is_ctx ? (T + b * LC + cidx * 128) : (b * L + (cidx - 2) * 128);
  unsigned char* XT = lds;
  unsigned char* BT = lds + 69632;
  unsigned char* XD = lds + 104448;
  float* WG = (float*)(lds + 121856);
  ssd_stage_tr(p, row0, is_ctx, COL_XBC + g * 256, g * 256, 256, XT);
  ssd_stage_tr(p, row0, is_ctx, COL_XBC + 512 + g * 128, 512 + g * 128, 128, BT);
  {
    const int dir = wid >> 2, hh = wid & 3, h = g * 4 + hh;
    const float A = expf(p.a_log[dir * 8 + h]);
    const int l0 = 2 * lane, l1 = l0 + 1;
    const float dt0 = softplus_f(p.DT[(size_t)(row0 + l0) * 16 + dir * 8 + h]), dt1 = softplus_f(p.DT[(size_t)(row0 + l1) * 16 + dir * 8 + h]);
    const float a0 = -A * dt0, a1 = -A * dt1, pair = a0 + a1;
    float incl = pair;
#pragma unroll
    for (int o = 1; o < 64; o <<= 1) { float t = __shfl_up(incl, o); if (lane >= o) incl += t; }
    const float excl = incl - pair;
    const float total = __shfl(incl, 63);
    float w0, w1, c0, c1;
    if (dir == 0) { c0 = excl + a0; c1 = excl + pair; w0 = dt0 * expf(total - c0); w1 = dt1 * expf(total - c1); }
    else { const float pe0 = excl, pe1 = excl + a0; w0 = dt0 * expf(pe0); w1 = dt1 * expf(pe1); c0 = total - pe0; c1 = total - pe1; }
    WG[wid * 128 + l0] = w0; WG[wid * 128 + l1] = w1;
    if (!is_ctx) { float* ac = p.ACUM + (size_t)(b * 16 + dir * 8 + h) * L + (cidx - 2) * 128; *(float2*)(ac + l0) = make_float2(c0, c1); }
    if (lane == 0) {
      const int k = dir ? (is_ctx ? (1 - cidx) : (19 - cidx)) : cidx;
      p.CDEC[(size_t)(((b * 2 + dir) * 8 + h) * 18 + k) * 32] = expf(total);
    }
  }
  __syncthreads();
  const int fr = lane & 15, fq = lane >> 4;
#pragma unroll 1
  for (int it = 0; it < 8; ++it) {
    const int dir = it >> 2, hh = it & 3, h = g * 4 + hh;
    for (int e = tid; e < 1024; e += NTHR) {
      const int pr = e >> 4, ch = e & 15;
      const uint4 v = *(const uint4*)(XT + (hh * 64 + pr) * SROW + ch * 16);
      const float4 wa = *(const float4*)(WG + it * 128 + ch * 8), wb = *(const float4*)(WG + it * 128 + ch * 8 + 4);
      uint4 w;
      w.x = cvt_pk_bf16(__uint_as_float(v.x << 16) * wa.x, __uint_as_float(v.x & 0xffff0000u) * wa.y);
      w.y = cvt_pk_bf16(__uint_as_float(v.y << 16) * wa.z, __uint_as_float(v.y & 0xffff0000u) * wa.w);
      w.z = cvt_pk_bf16(__uint_as_float(v.z << 16) * wb.x, __uint_as_float(v.z & 0xffff0000u) * wb.y);
      w.w = cvt_pk_bf16(__uint_as_float(v.w << 16) * wb.z, __uint_as_float(v.w & 0xffff0000u) * wb.w);
      *(uint4*)(XD + pr * SROW + ch * 16) = w;
    }
    __syncthreads();
    hf32x4 acc[4];
#pragma unroll
    for (int pt = 0; pt < 4; ++pt) acc[pt] = (hf32x4){0.f, 0.f, 0.f, 0.f};
#pragma unroll
    for (int kk = 0; kk < 4; ++kk) {
      const hbf16x8 Bf = *(const hbf16x8*)(BT + (16 * wid + fr) * SROW + 2 * (32 * kk + 8 * fq));
#pragma unroll
      for (int pt = 0; pt < 4; ++pt) {
        const hbf16x8 Af = *(const hbf16x8*)(XD + (16 * pt + fr) * SROW + 2 * (32 * kk + 8 * fq));
        acc[pt] = __builtin_amdgcn_mfma_f32_16x16x32_bf16(Bf, Af, acc[pt], 0, 0, 0);
      }
    }
    const int k = dir ? (is_ctx ? (1 - cidx) : (19 - cidx)) : cidx;
    bf16_t* slot = p.SST + ((size_t)(((b * 2 + dir) * 8 + h) * 18 + k)) * 8192;
#pragma unroll
    for (int pt = 0; pt < 4; ++pt)
      *(uint2*)(slot + (16 * pt + fr) * 128 + 16 * wid + 4 * fq) = make_uint2(cvt_pk_bf16(acc[pt][0], acc[pt][1]), cvt_pk_bf16(acc[pt][2], acc[pt][3]));
    __syncthreads();
  }
}

__device__ void ssd_scan_unit(const Params& p, int unit) {
  const int tid = threadIdx.x;
  const int half = unit & 1, seq = unit >> 1;
  const int pr = half * 32 + (tid >> 4), n8 = (tid & 15) * 8;
  const bf16_t* base = p.SST + (size_t)seq * 18 * 8192 + pr * 128 + n8;
  uint4 sv[18];
#pragma unroll
  for (int k = 0; k < 18; ++k) sv[k] = *(const uint4*)(base + (size_t)k * 8192);
  float hst[8];
#pragma unroll
  for (int j = 0; j < 8; ++j) hst[j] = 0.f;
#pragma unroll
  for (int k = 0; k < 18; ++k) {
    const float dec = p.CDEC[(size_t)(seq * 18 + k) * 32];
    if (k >= 2) {
      uint4 w; w.x = cvt_pk_bf16(hst[0], hst[1]); w.y = cvt_pk_bf16(hst[2], hst[3]); w.z = cvt_pk_bf16(hst[4], hst[5]); w.w = cvt_pk_bf16(hst[6], hst[7]);
      *(uint4*)(p.HIN + ((size_t)seq * 16 + (k - 2)) * 8192 + pr * 128 + n8) = w;
    }
    const unsigned sw[4] = {sv[k].x, sv[k].y, sv[k].z, sv[k].w};
#pragma unroll
    for (int u = 0; u < 4; ++u) {
      hst[2 * u] = dec * hst[2 * u] + __uint_as_float(sw[u] << 16);
      hst[2 * u + 1] = dec * hst[2 * u + 1] + __uint_as_float(sw[u] & 0xffff0000u);
    }
  }
}

__device__ void ssd_out_unit(const Params& p, int unit, unsigned char* lds) {
  const int tid = threadIdx.x, wid = __builtin_amdgcn_readfirstlane(tid >> 6), lane = tid & 63;
  const int fr = lane & 15, fq = lane >> 4;
  const int g = unit & 1, bc = unit >> 1, c = bc & 15, b = bc >> 4;
  const int row0 = b * L + c * 128;
  unsigned char* CS = lds;
  unsigned char* ML = lds + 34816;
  unsigned char* XT = lds + 69632;
  unsigned char* ZT = lds + 87040;
  unsigned char* HS = lds + 104448;
  float* CUM = (float*)(lds + 121856);
  float* DTL = (float*)(lds + 125952);
  ssd_stage_nat(p, row0, COL_XBC + 768 + g * 128, 768 + g * 128, CS);
  ssd_stage_nat(p, row0, COL_XBC + 512 + g * 128, 512 + g * 128, ML);
  for (int e = tid; e < 1024; e += NTHR) {
    const int it = e >> 7, l = e & 127, dir = it >> 2, hh = it & 3;
    CUM[e] = p.ACUM[(size_t)(b * 16 + dir * 8 + g * 4 + hh) * L + c * 128 + l];
    DTL[e] = softplus_f(p.DT[(size_t)(row0 + l) * 16 + dir * 8 + g * 4 + hh]);
  }
  __syncthreads();
  hf32x4 cbt[8];
#pragma unroll
  for (int lt = 0; lt < 8; ++lt) cbt[lt] = (hf32x4){0.f, 0.f, 0.f, 0.f};
#pragma unroll
  for (int kk = 0; kk < 4; ++kk) {
    const hbf16x8 Af = *(const hbf16x8*)(ML + (16 * wid + fr) * SROW + 2 * (32 * kk + 8 * fq));
#pragma unroll
    for (int lt = 0; lt < 8; ++lt) {
      const hbf16x8 Bf = *(const hbf16x8*)(CS + (16 * lt + fr) * SROW + 2 * (32 * kk + 8 * fq));
      cbt[lt] = __builtin_amdgcn_mfma_f32_16x16x32_bf16(Af, Bf, cbt[lt], 0, 0, 0);
    }
  }
  __syncthreads();
  hf32x4 y[4][4];
#pragma unroll
  for (int hh = 0; hh < 4; ++hh)
#pragma unroll
    for (int pt = 0; pt < 4; ++pt) y[hh][pt] = (hf32x4){0.f, 0.f, 0.f, 0.f};
  const int sb = 16 * wid + 4 * fq;
#pragma unroll 1
  for (int hh = 0; hh < 4; ++hh) {
    const int h = g * 4 + hh;
    hf32x4 yc[4];
#pragma unroll
    for (int pt = 0; pt < 4; ++pt) yc[pt] = (hf32x4){0.f, 0.f, 0.f, 0.f};
    ssd_stage_tr_s(p, row0, false, COL_XBC + g * 256 + hh * 64, g * 256 + hh * 64, 64, XT);
    ssd_stage_tr_s(p, row0, false, COL_Z + g * 256 + hh * 64, -1, 64, ZT);
#pragma unroll 1
    for (int dir = 0; dir < 2; ++dir) {
      const int it = dir * 4 + hh;
      const int k = dir ? (17 - c) : (c + 2);
      const bf16_t* slot = p.HIN + ((size_t)(((b * 2 + dir) * 8 + h) * 16 + (k - 2))) * 8192;
      for (int e = tid; e < 1024; e += NTHR) {
        const int pr = e >> 4, ch = e & 15;
        *(uint4*)(HS + pr * SROW + ch * 16) = *(const uint4*)(slot + pr * 128 + ch * 8);
      }
      {
        const float* cu = CUM + it * 128; const float* dl = DTL + it * 128;
        float cs[4], ds[4];
#pragma unroll
        for (int r = 0; r < 4; ++r) { cs[r] = cu[sb + r]; ds[r] = dl[sb + r]; }
#pragma unroll
        for (int lt = 0; lt < 8; ++lt) {
          const int l = 16 * lt + fr;
          const float cl = cu[l];
          float m[4];
#pragma unroll
          for (int r = 0; r < 4; ++r) {
            const int sidx = sb + r;
            const bool ok = dir ? (sidx >= l) : (sidx <= l);
            m[r] = ok ? cbt[lt][r] * __expf(cl - cs[r]) * ds[r] : 0.f;
          }
          uint2 w; w.x = cvt_pk_bf16(m[0], m[1]); w.y = cvt_pk_bf16(m[2], m[3]);
          *(uint2*)(ML + l * SROW + 2 * sb) = w;
        }
      }
      __syncthreads();
      hf32x4 ad[4], ao[4];
#pragma unroll
      for (int pt = 0; pt < 4; ++pt) { ad[pt] = (hf32x4){0.f, 0.f, 0.f, 0.f}; ao[pt] = (hf32x4){0.f, 0.f, 0.f, 0.f}; }
#pragma unroll
      for (int kk = 0; kk < 4; ++kk) {
        const hbf16x8 Am = *(const hbf16x8*)(ML + (16 * wid + fr) * SROW + 2 * (32 * kk + 8 * fq));
        const hbf16x8 Ac = *(const hbf16x8*)(CS + (16 * wid + fr) * SROW + 2 * (32 * kk + 8 * fq));
#pragma unroll
        for (int pt = 0; pt < 4; ++pt) {
          const hbf16x8 Bx = *(const hbf16x8*)(XT + (16 * pt + fr) * SROW + 2 * (32 * kk + 8 * fq));
          const hbf16x8 Bh = *(const hbf16x8*)(HS + (16 * pt + fr) * SROW + 2 * (32 * kk + 8 * fq));
          ad[pt] = __builtin_amdgcn_mfma_f32_16x16x32_bf16(Am, Bx, ad[pt], 0, 0, 0);
          ao[pt] = __builtin_amdgcn_mfma_f32_16x16x32_bf16(Ac, Bh, ao[pt], 0, 0, 0);
        }
      }
      {
        const float* cu = CUM + it * 128;
        float ex[4];
#pragma unroll
        for (int r = 0; r < 4; ++r) ex[r] = __expf(cu[sb + r]);
#pragma unroll
        for (int pt = 0; pt < 4; ++pt)
#pragma unroll
          for (int r = 0; r < 4; ++r) yc[pt][r] += ad[pt][r] + ex[r] * ao[pt][r];
      }
      __syncthreads();
    }
    {
      const float dsk = p.ssd_d[h];
#pragma unroll
      for (int pt = 0; pt < 4; ++pt) {
        const uint2 xv = *(const uint2*)(XT + (16 * pt + fr) * SROW + 2 * sb);
        const uint2 zv = *(const uint2*)(ZT + (16 * pt + fr) * SROW + 2 * sb);
        const float xs4[4] = {__uint_as_float(xv.x << 16), __uint_as_float(xv.x & 0xffff0000u), __uint_as_float(xv.y << 16), __uint_as_float(xv.y & 0xffff0000u)};
        const float zs4[4] = {__uint_as_float(zv.x << 16), __uint_as_float(zv.x & 0xffff0000u), __uint_as_float(zv.y << 16), __uint_as_float(zv.y & 0xffff0000u)};
#pragma unroll
        for (int r = 0; r < 4; ++r) yc[pt][r] = (yc[pt][r] + dsk * xs4[r]) * silu_f(zs4[r]);
      }
    }
    if (hh == 0) {
#pragma unroll
      for (int pt = 0; pt < 4; ++pt) y[0][pt] = yc[pt];
    } else if (hh == 1) {
#pragma unroll
      for (int pt = 0; pt < 4; ++pt) y[1][pt] = yc[pt];
    } else if (hh == 2) {
#pragma unroll
      for (int pt = 0; pt < 4; ++pt) y[2][pt] = yc[pt];
    } else {
#pragma unroll
      for (int pt = 0; pt < 4; ++pt) y[3][pt] = yc[pt];
    }
    __syncthreads();
  }
  float rinv[4];
#pragma unroll
  for (int r = 0; r < 4; ++r) {
    float ss = 0.f;
#pragma unroll
    for (int hh = 0; hh < 4; ++hh)
#pragma unroll
      for (int pt = 0; pt < 4; ++pt) ss += y[hh][pt][r] * y[hh][pt][r];
    ss += __shfl_xor(ss, 1); ss += __shfl_xor(ss, 2); ss += __shfl_xor(ss, 4); ss += __shfl_xor(ss, 8);
    rinv[r] = rsqrtf(ss * (1.f / 256.f) + EPS);
  }
  {
    bf16_t* OT = (bf16_t*)lds;
#pragma unroll
    for (int hh = 0; hh < 4; ++hh)
#pragma unroll
      for (int pt = 0; pt < 4; ++pt) {
        const int chl = hh * 64 + 16 * pt + fr;
        const float ng = p.ssd_norm_g[g * 256 + chl];
#pragma unroll
        for (int r = 0; r < 4; ++r) OT[(sb + r) * 264 + chl] = f2bf(y[hh][pt][r] * rinv[r] * ng);
      }
    __syncthreads();
    for (int e = tid; e < 128 * 32; e += NTHR) {
      const int l = e >> 5, ch8 = (e & 31) * 8;
      *(uint4*)(p.YMIXb + (size_t)(row0 + l) * D + 512 + g * 256 + ch8) = *(const uint4*)(OT + l * 264 + ch8);
    }
  }
}

__device__ void ph_router(const Params& p, unsigned char* lds) {
  const int tid = threadIdx.x, wid = __builtin_amdgcn_readfirstlane(tid >> 6), lane = tid & 63;
  const int fr = lane & 15, fq = lane >> 4;
  constexpr int AROW = 272;
  unsigned char* AH = lds;
  unsigned char* AL = lds + 64 * AROW;
  unsigned char* WH = lds + 128 * AROW;
  unsigned char* WL = lds + 224 * AROW;
  float* RS = (float*)(lds + 320 * AROW);
  float* LOG = RS + 64;
  float* GM = LOG + 6400;
  float* SH = GM + 1024;
  for (int tile = blockIdx.x; tile < T / 64; tile += gridDim.x) {
    const int row0 = tile * 64;
    const float* shp = p.MOD + (row0 / L) * 6144 + 3072;
    const float* scp = shp + 1024;
    if (tid < 64) {
      const float4* sp = (const float4*)(p.SSQP + (size_t)(row0 + tid) * 16);
      const float4 a0 = sp[0], a1 = sp[1], a2 = sp[2], a3 = sp[3];
      const float ss = ((a0.x + a0.y) + (a0.z + a0.w)) + ((a1.x + a1.y) + (a1.z + a1.w)) + ((a2.x + a2.y) + (a2.z + a2.w)) + ((a3.x + a3.y) + (a3.z + a3.w));
      RS[tid] = rsqrtf(ss * (1.f / D) + EPS);
    }
    for (int e = tid; e < 256; e += NTHR) {
      const float4 g = *(const float4*)(p.g2 + e * 4), s4 = *(const float4*)(scp + e * 4), h4 = *(const float4*)(shp + e * 4);
      *(float4*)(GM + e * 4) = make_float4(g.x * (1.f + s4.x), g.y * (1.f + s4.y), g.z * (1.f + s4.z), g.w * (1.f + s4.w));
      *(float4*)(SH + e * 4) = h4;
    }
    float4 xv[4];
#pragma unroll
    for (int i = 0; i < 4; ++i) { const int e = tid + i * NTHR; xv[i] = *(const float4*)(p.X1 + (size_t)(row0 + (e >> 5)) * D + (e & 31) * 4); }
    const int wj = tid >> 4, wch = tid & 15;
    uint4 wh0, wh1, wh2, wl0, wl1, wl2;
#define RT_LOADW(kn) do { \
      wh0 = *(const uint4*)(p.WRhi + (size_t)(wj) * 1024 + (kn) * 128 + wch * 8); wl0 = *(const uint4*)(p.WRlo + (size_t)(wj) * 1024 + (kn) * 128 + wch * 8); \
      wh1 = *(const uint4*)(p.WRhi + (size_t)(wj + 32) * 1024 + (kn) * 128 + wch * 8); wl1 = *(const uint4*)(p.WRlo + (size_t)(wj + 32) * 1024 + (kn) * 128 + wch * 8); \
      wh2 = *(const uint4*)(p.WRhi + (size_t)(wj + 64) * 1024 + (kn) * 128 + wch * 8); wl2 = *(const uint4*)(p.WRlo + (size_t)(wj + 64) * 1024 + (kn) * 128 + wch * 8); } while (0)
    RT_LOADW(0);
    __syncthreads();
    hf32x4 acc[3];
#pragma unroll
    for (int nt = 0; nt < 3; ++nt) acc[nt] = (hf32x4){0.f, 0.f, 0.f, 0.f};
    const int mt = wid & 3, nh = wid >> 2;
#pragma unroll 1
    for (int kc = 0; kc < 8; ++kc) {
#pragma unroll
      for (int i = 0; i < 4; ++i) {
        const int e = tid + i * NTHR; const int tok = e >> 5, k4 = (e & 31) * 4;
        const int kg = kc * 128 + k4;
        const float4 v = xv[i];
        const float4 g = *(const float4*)(GM + kg);
        const float4 h4 = *(const float4*)(SH + kg);
        const float rstd = RS[tok];
        const float h0 = v.x * rstd * g.x + h4.x, h1 = v.y * rstd * g.y + h4.y;
        const float h2 = v.z * rstd * g.z + h4.z, h3 = v.w * rstd * g.w + h4.w;
        const unsigned hi01 = cvt_pk_bf16(h0, h1), hi23 = cvt_pk_bf16(h2, h3);
        const unsigned lo01 = cvt_pk_bf16(h0 - __uint_as_float(hi01 << 16), h1 - __uint_as_float(hi01 & 0xffff0000u));
        const unsigned lo23 = cvt_pk_bf16(h2 - __uint_as_float(hi23 << 16), h3 - __uint_as_float(hi23 & 0xffff0000u));
        *(uint2*)(AH + tok * AROW + k4 * 2) = make_uint2(hi01, hi23);
        *(uint2*)(AL + tok * AROW + k4 * 2) = make_uint2(lo01, lo23);
        *(uint2*)(p.H2b + (size_t)(row0 + tok) * D + kg) = make_uint2(hi01, hi23);
      }
      *(uint4*)(WH + wj * AROW + wch * 16) = wh0; *(uint4*)(WL + wj * AROW + wch * 16) = wl0;
      *(uint4*)(WH + (wj + 32) * AROW + wch * 16) = wh1; *(uint4*)(WL + (wj + 32) * AROW + wch * 16) = wl1;
      *(uint4*)(WH + (wj + 64) * AROW + wch * 16) = wh2; *(uint4*)(WL + (wj + 64) * AROW + wch * 16) = wl2;
      {
        const int kn = (kc + 1 < 8) ? (kc + 1) : kc;
#pragma unroll
        for (int i = 0; i < 4; ++i) { const int e = tid + i * NTHR; xv[i] = *(const float4*)(p.X1 + (size_t)(row0 + (e >> 5)) * D + kn * 128 + (e & 31) * 4); }
        RT_LOADW(kn);
      }
      __syncthreads();
#pragma unroll
      for (int kk = 0; kk < 4; ++kk) {
        const hbf16x8 Ahi = *(const hbf16x8*)(AH + (16 * mt + fr) * AROW + 2 * (32 * kk + 8 * fq));
        const hbf16x8 Alo = *(const hbf16x8*)(AL + (16 * mt + fr) * AROW + 2 * (32 * kk + 8 * fq));
#pragma unroll
        for (int nt = 0; nt < 3; ++nt) {
          const int wo = (16 * (nh * 3 + nt) + fr) * AROW + 2 * (32 * kk + 8 * fq);
          const hbf16x8 Bhi = *(const hbf16x8*)(WH + wo);
          const hbf16x8 Blo = *(const hbf16x8*)(WL + wo);
          acc[nt] = __builtin_amdgcn_mfma_f32_16x16x32_bf16(Ahi, Bhi, acc[nt], 0, 0, 0);
          acc[nt] = __builtin_amdgcn_mfma_f32_16x16x32_bf16(Ahi, Blo, acc[nt], 0, 0, 0);
          acc[nt] = __builtin_amdgcn_mfma_f32_16x16x32_bf16(Alo, Bhi, acc[nt], 0, 0, 0);
        }
      }
      __syncthreads();
    }
#pragma unroll
    for (int nt = 0; nt < 3; ++nt)
#pragma unroll
      for (int r = 0; r < 4; ++r) LOG[(16 * mt + 4 * fq + r) * 100 + 16 * (nh * 3 + nt) + fr] = acc[nt][r];
    __syncthreads();
    if (tid < 64) {
      const float* lg = LOG + tid * 100;
      const int row = row0 + tid;
      int gs = 0; float gm = lg[64] + p.b_group[0];
      float gl[8];
      gl[0] = gm;
#pragma unroll
      for (int j = 1; j < 8; ++j) { gl[j] = lg[64 + j] + p.b_group[j]; if (gl[j] > gm) { gm = gl[j]; gs = j; } }
      float den = 0.f;
#pragma unroll
      for (int j = 0; j < 8; ++j) den += expf(gl[j] - gm);
      const float pg = 1.f / den;
      float el[8];
#pragma unroll
      for (int j = 0; j < 8; ++j) el[j] = 0.f;
      for (int j = 0; j < 8; ++j) el[j] = lg[gs * 8 + j] + p.b_expert[gs * 8 + j];
      int i0 = 0; float l0 = el[0];
#pragma unroll
      for (int j = 1; j < 8; ++j) if (el[j] > l0) { l0 = el[j]; i0 = j; }
      int i1 = -1; float l1 = -3.0e38f;
#pragma unroll
      for (int j = 0; j < 8; ++j) if (j != i0 && el[j] > l1) { l1 = el[j]; i1 = j; }
      const float e1 = expf(l1 - l0);
      const float w0 = 1.f / (1.f + e1), w1 = e1 / (1.f + e1);
      p.GATE[row * 2 + 0] = w0 * pg;
      p.GATE[row * 2 + 1] = w1 * pg;
      const int ea = gs * 8 + i0, eb = gs * 8 + i1;
      const int sa = atomicAdd(&p.CNT[ea], 1);
      p.LIST[ea * T + sa] = row * 2 + 0;
      const int sb2 = atomicAdd(&p.CNT[eb], 1);
      p.LIST[eb * T + sb2] = row * 2 + 1;
    }
    __syncthreads();
  }
}

__device__ __forceinline__ void moe_table(const Params& p, int* tab) {
  if (threadIdx.x == 0) {
    int a = 0, sg = 0;
    for (int e = 0; e < NE; ++e) {
      int cn = p.CNT[e];
      tab[e] = a; tab[65 + e] = sg; tab[130 + e] = cn;
      a += (cn + 255) >> 8; sg += ((cn + 127) >> 7) << 7;
    }
    tab[NE] = a; tab[65 + NE] = sg;
  }
  __syncthreads();
}

template <bool UP>
__device__ void moe_gemm_phase(const Params& p, unsigned char* lds, PG8_LAS unsigned char* ldsl, const int* tab) {
  constexpr int K = UP ? 1024 : 512;
  constexpr int NKT = K / 64;
  constexpr int LDB = UP ? 512 : 1024;
  const int tid = threadIdx.x, wid = __builtin_amdgcn_readfirstlane(tid >> 6), lane = tid & 63, fr = lane & 15, fq = lane >> 4;
  const int wm = wid >> 1, wn = wid & 1;
  constexpr int AOFF0 = 0, AOFF1 = 32768, BOFF0 = 65536, BOFF1 = 65536 + 128 * 144;
  const int total = tab[64] * 8;
  for (int ui = blockIdx.x; ui < total; ui += gridDim.x) {
   {
    int e = 0;
    while (tab[e + 1] * 8 <= ui) ++e;
    const int local = ui - tab[e] * 8;
    const int mu = local >> 3, nt = local & 7;
    const int cnt = tab[130 + e], seg = tab[65 + e];
    const int rem = cnt - mu * 256;
    const bool full = rem > 128;
    const bool active = full || wm < 2;
    unsigned aoffs[4];
#pragma unroll
    for (int i = 0; i < 4; ++i) {
      const int row = (tid >> 3) + 64 * i;
      int idx = mu * 256 + row;
      unsigned rowb;
      if (UP) { if (idx > cnt - 1) idx = cnt - 1; rowb = (unsigned)(p.LIST[e * T + idx] >> 1) * (unsigned)(K * 2); }
      else rowb = (unsigned)(seg + idx) * (unsigned)(K * 2);
      aoffs[i] = rowb + (unsigned)(((tid & 7) ^ (row & 7)) * 16);
    }
    const char* Abase = UP ? (const char*)p.H2b : (const char*)p.HBb;
    const float* bsrc;
    if (UP) bsrc = ((lane < 32) ? p.w1 : p.w3) + (size_t)e * 1024 * 512 + nt * 64 + 2 * (lane & 31) + (size_t)(8 * wid) * LDB;
    else bsrc = p.w2 + (size_t)e * 512 * 1024 + nt * 128 + 2 * lane + (size_t)(8 * wid) * LDB;
    hf32x4 acc[4][4];
#pragma unroll
    for (int m = 0; m < 4; ++m)
#pragma unroll
      for (int j = 0; j < 4; ++j) acc[m][j] = (hf32x4){0.f, 0.f, 0.f, 0.f};
    uint4 P0a0, P0a1, P0a2, P0a3, P1a0, P1a1, P1a2, P1a3;
    float2 P0b0, P0b1, P0b2, P0b3, P0b4, P0b5, P0b6, P0b7, P1b0, P1b1, P1b2, P1b3, P1b4, P1b5, P1b6, P1b7;
    const int srow = tid >> 3, spc = tid & 7;
#define MG_LOAD(kt, S) do { \
      S##a0 = *(const uint4*)(Abase + aoffs[0] + (kt) * 128); S##a1 = *(const uint4*)(Abase + aoffs[1] + (kt) * 128); \
      S##a2 = *(const uint4*)(Abase + aoffs[2] + (kt) * 128); S##a3 = *(const uint4*)(Abase + aoffs[3] + (kt) * 128); \
      S##b0 = *(const float2*)(bsrc + (size_t)((kt) * 64 + 0) * LDB); S##b1 = *(const float2*)(bsrc + (size_t)((kt) * 64 + 1) * LDB); \
      S##b2 = *(const float2*)(bsrc + (size_t)((kt) * 64 + 2) * LDB); S##b3 = *(const float2*)(bsrc + (size_t)((kt) * 64 + 3) * LDB); \
      S##b4 = *(const float2*)(bsrc + (size_t)((kt) * 64 + 4) * LDB); S##b5 = *(const float2*)(bsrc + (size_t)((kt) * 64 + 5) * LDB); \
      S##b6 = *(const float2*)(bsrc + (size_t)((kt) * 64 + 6) * LDB); S##b7 = *(const float2*)(bsrc + (size_t)((kt) * 64 + 7) * LDB); } while (0)
#define MG_WRITE(aoff, boff, S) do { \
      *(uint4*)(lds + (aoff) + (srow) * 128 + spc * 16) = S##a0; *(uint4*)(lds + (aoff) + (srow + 64) * 128 + spc * 16) = S##a1; \
      if (full) { *(uint4*)(lds + (aoff) + (srow + 128) * 128 + spc * 16) = S##a2; *(uint4*)(lds + (aoff) + (srow + 192) * 128 + spc * 16) = S##a3; } \
      *(uint4*)(lds + (boff) + (2 * lane) * 144 + 16 * wid) = make_uint4(cvt_pk_bf16(S##b0.x, S##b1.x), cvt_pk_bf16(S##b2.x, S##b3.x), cvt_pk_bf16(S##b4.x, S##b5.x), cvt_pk_bf16(S##b6.x, S##b7.x)); \
      *(uint4*)(lds + (boff) + (2 * lane + 1) * 144 + 16 * wid) = make_uint4(cvt_pk_bf16(S##b0.y, S##b1.y), cvt_pk_bf16(S##b2.y, S##b3.y), cvt_pk_bf16(S##b4.y, S##b5.y), cvt_pk_bf16(S##b6.y, S##b7.y)); } while (0)
#define MG_MMA(aoff, boff) do { if (active) { \
      _Pragma("unroll") for (int kk = 0; kk < 2; ++kk) { \
        hbf16x8 Af[4], Bf[4]; \
        _Pragma("unroll") for (int m = 0; m < 4; ++m) Af[m] = *(const hbf16x8*)(lds + (aoff) + (64 * wm + 16 * m + fr) * 128 + (((4 * kk + fq) ^ (fr & 7)) * 16)); \
        _Pragma("unroll") for (int j = 0; j < 4; ++j) { \
          const int nrow = UP ? ((j < 2) ? (32 * wn + 16 * j + fr) : (64 + 32 * wn + 16 * (j - 2) + fr)) : (64 * wn + 16 * j + fr); \
          Bf[j] = *(const hbf16x8*)(lds + (boff) + nrow * 144 + 2 * (32 * kk + 8 * fq)); } \
        _Pragma("unroll") for (int m = 0; m < 4; ++m) _Pragma("unroll") for (int j = 0; j < 4; ++j) \
          acc[m][j] = __builtin_amdgcn_mfma_f32_16x16x32_bf16(Bf[j], Af[m], acc[m][j], 0, 0, 0); } } } while (0)
    MG_LOAD(0, P0);
    MG_LOAD(1, P1);
    MG_WRITE(AOFF0, BOFF0, P0);
    __syncthreads();
#pragma unroll 1
    for (int kt = 0; kt < NKT; kt += 2) {
      if (kt + 2 < NKT) MG_LOAD(kt + 2, P0);
      MG_MMA(AOFF0, BOFF0);
      MG_WRITE(AOFF1, BOFF1, P1);
      __syncthreads();
      if (kt + 3 < NKT) MG_LOAD(kt + 3, P1);
      MG_MMA(AOFF1, BOFF1);
      if (kt + 2 < NKT) MG_WRITE(AOFF0, BOFF0, P0);
      __syncthreads();
    }
#undef MG_LOAD
#undef MG_WRITE
#undef MG_MMA
    if (active) {
#pragma unroll
      for (int m = 0; m < 4; ++m) {
        const int slot = mu * 256 + 64 * wm + 16 * m + fr;
        if (slot < cnt) {
          if (UP) {
            bf16_t* hp = p.HBb + (size_t)(seg + slot) * DE + nt * 64 + 32 * wn + 4 * fq;
#pragma unroll
            for (int j = 0; j < 2; ++j) {
              float h[4];
#pragma unroll
              for (int r = 0; r < 4; ++r) { const float a = acc[m][j][r]; h[r] = a / (1.f + __expf(-a)) * acc[m][j + 2][r]; }
              *(uint2*)(hp + 16 * j) = make_uint2(cvt_pk_bf16(h[0], h[1]), cvt_pk_bf16(h[2], h[3]));
            }
          } else {
            const int pair = p.LIST[e * T + slot];
            const float gt = p.GATE[pair];
            bf16_t* yp = p.YB2b + (size_t)pair * D + nt * 128 + 64 * wn + 4 * fq;
#pragma unroll
            for (int j = 0; j < 4; ++j)
              *(uint2*)(yp + 16 * j) = make_uint2(cvt_pk_bf16(gt * acc[m][j][0], gt * acc[m][j][1]), cvt_pk_bf16(gt * acc[m][j][2], gt * acc[m][j][3]));
          }
        }
      }
    }
   }
  }
}

__device__ void ph_final(const Params& p) {
  const int tid = threadIdx.x, wid = tid >> 6, lane = tid & 63;
  for (int row = blockIdx.x * 8 + wid; row < T; row += gridDim.x * 8) {
    const float* ga2 = p.MOD + (row / L) * 6144 + 5120;
    float4 v[4];
    float ss = 0.f;
#pragma unroll
    for (int i = 0; i < 4; ++i) {
      const int col = i * 256 + lane * 4;
      float4 xv = *(const float4*)(p.X1 + (size_t)row * D + col);
      uint2 a = *(const uint2*)(p.YB2b + (size_t)(row * 2) * D + col);
      uint2 b = *(const uint2*)(p.YB2b + (size_t)(row * 2 + 1) * D + col);
      float4 ga = *(const float4*)(ga2 + col);
      v[i].x = xv.x + ga.x * (__uint_as_float(a.x << 16) + __uint_as_float(b.x << 16));
      v[i].y = xv.y + ga.y * (__uint_as_float(a.x & 0xffff0000u) + __uint_as_float(b.x & 0xffff0000u));
      v[i].z = xv.z + ga.z * (__uint_as_float(a.y << 16) + __uint_as_float(b.y << 16));
      v[i].w = xv.w + ga.w * (__uint_as_float(a.y & 0xffff0000u) + __uint_as_float(b.y & 0xffff0000u));
      ss += v[i].x * v[i].x + v[i].y * v[i].y + v[i].z * v[i].z + v[i].w * v[i].w;
    }
    ss = wave_sum(ss);
    const float rstd = rsqrtf(ss * (1.f / D) + EPS);
#pragma unroll
    for (int i = 0; i < 4; ++i) {
      const int col = i * 256 + lane * 4;
      float4 gf = *(const float4*)(p.g_final + col);
      float4 o;
      o.x = v[i].x * rstd * gf.x; o.y = v[i].y * rstd * gf.y; o.z = v[i].z * rstd * gf.z; o.w = v[i].w * rstd * gf.w;
      *(float4*)(p.out + (size_t)row * D + col) = o;
    }
  }
}

constexpr int NPHASE = 11;

__global__ void __launch_bounds__(NTHR, 2) mega(Params p) {
  extern __shared__ __attribute__((aligned(16))) unsigned char lds_raw[];
  float* sm = (float*)lds_raw;
  PG8_LAS unsigned char* lds = (PG8_LAS unsigned char*)lds_raw;
  const int lo = p.lo, hi = p.hi;
  volatile LAS unsigned* xbst = (volatile LAS unsigned*)(lds + pg8::STAGE_BYTES + 2048);
  if (threadIdx.x < 4) xbst[threadIdx.x] = 0u;
  __syncthreads();
  XcdBarrier xbar; xbar.bar = p.BAR; xbar.x = 0; xbar.st = xbst;
  if (hi - lo > 1) xbar = xcd_barrier_post(p.BAR, xbst);
#define IN(k) (lo <= (k) && (k) < hi)
#define SYNC(k) do { if (IN(k) && IN((k) + 1)) xcd_barrier(xbar); } while (0)
#ifndef DUPK
#define DUPK -1
#endif
#ifndef SKIP_OTHER
  if (IN(0)) { ph_adaln(p, sm); ph_filters(p, sm); ph_wcvt(p, sm); }
#if DUPK == 0
  xcd_barrier(xbar);
  if (IN(0)) { ph_adaln(p, sm); ph_filters(p, sm); ph_wcvt(p, sm); }
#endif
  SYNC(0);
  if (IN(1)) ph_norm1(p);
#if DUPK == 1
  xcd_barrier(xbar);
  if (IN(1)) ph_norm1(p);
#endif
  SYNC(1);
#endif
#ifndef SKIP_GEMM
  if (IN(2)) {
    pg8::DenseOrder S{p.XNb, p.WinT, TT / 256, DP / 256 + 1, D, (int)gridDim.x, (int)blockIdx.x};
    pg8::EpiBf16 E{p.PXb, DP, p.DT, p.dt_bias};
    pg8::gemm_phase<pg8::EpiBf16, pg8::DenseOrder>(lds, D, S, E);
  }
#if DUPK == 2
  xcd_barrier(xbar);
  if (IN(2)) {
    pg8::DenseOrder S{p.XNb, p.WinT, TT / 256, DP / 256 + 1, D, (int)gridDim.x, (int)blockIdx.x};
    pg8::EpiBf16 E{p.PXb, DP, p.DT, p.dt_bias};
    pg8::gemm_phase<pg8::EpiBf16, pg8::DenseOrder>(lds, D, S, E);
  }
#endif
  SYNC(2);
#endif
#ifndef SKIP_OTHER
  if (IN(3)) {
    ph_hy_convT(p, sm);
    for (int it = blockIdx.x; it < 288; it += gridDim.x) ssd_states_unit(p, it, lds_raw);
  }
#if DUPK == 3
  xcd_barrier(xbar);
  if (IN(3)) {
    ph_hy_convT(p, sm);
    for (int it = blockIdx.x; it < 288; it += gridDim.x) ssd_states_unit(p, it, lds_raw);
  }
#endif
  SYNC(3);
  if (IN(4)) {
    for (int it = blockIdx.x; it < 256; it += gridDim.x) ssd_scan_unit(p, it);
    for (int it = blockIdx.x; it < 512; it += gridDim.x) hyena_unit(p, it, lds_raw);
  }
#if DUPK == 4
  xcd_barrier(xbar);
  if (IN(4)) {
    for (int it = blockIdx.x; it < 256; it += gridDim.x) ssd_scan_unit(p, it);
    for (int it = blockIdx.x; it < 512; it += gridDim.x) hyena_unit(p, it, lds_raw);
  }
#endif
  SYNC(4);
  if (IN(5)) {
    for (int it = blockIdx.x; it < 256; it += gridDim.x) { ssd_out_unit(p, it, lds_raw); __syncthreads(); }
    ph_hy_backT(p, sm);
  }
#if DUPK == 5
  xcd_barrier(xbar);
  if (IN(5)) {
    for (int it = blockIdx.x; it < 256; it += gridDim.x) { ssd_out_unit(p, it, lds_raw); __syncthreads(); }
    ph_hy_backT(p, sm);
  }
#endif
  SYNC(5);
#endif
#ifndef SKIP_GEMM
  if (IN(6)) {
    pg8::DenseOrder S{p.YMIXb, p.WoutT, T / 256, D / 256, D, (int)gridDim.x, (int)blockIdx.x};
    pg8::EpiX1 E{p.x, p.MOD, p.X1, p.SSQP};
    pg8::gemm_phase<pg8::EpiX1, pg8::DenseOrder>(lds, D, S, E);
  }
#if DUPK == 6
  xcd_barrier(xbar);
  if (IN(6)) {
    pg8::DenseOrder S{p.YMIXb, p.WoutT, T / 256, D / 256, D, (int)gridDim.x, (int)blockIdx.x};
    pg8::EpiX1 E{p.x, p.MOD, p.X1, p.SSQP};
    pg8::gemm_phase<pg8::EpiX1, pg8::DenseOrder>(lds, D, S, E);
  }
#endif
  SYNC(6);
#endif
#ifndef SKIP_OTHER
  if (IN(7)) ph_router(p, lds_raw);
#if DUPK == 7
  xcd_barrier(xbar);
  if (IN(7)) ph_router(p, lds_raw);
#endif
  SYNC(7);
#endif
#ifndef SKIP_GEMM
  if (IN(8)) {
    int* tab = (int*)(lds_raw + pg8::STAGE_BYTES);
    moe_table(p, tab);
    moe_gemm_phase<true>(p, lds_raw, lds, tab);
  }
#if DUPK == 8
  xcd_barrier(xbar);
  if (IN(8)) {
    int* tab = (int*)(lds_raw + pg8::STAGE_BYTES);
    moe_table(p, tab);
    moe_gemm_phase<true>(p, lds_raw, lds, tab);
  }
#endif
  SYNC(8);
  if (IN(9)) {
    int* tab = (int*)(lds_raw + pg8::STAGE_BYTES);
    moe_table(p, tab);
    moe_gemm_phase<false>(p, lds_raw, lds, tab);
  }
#if DUPK == 9
  xcd_barrier(xbar);
  if (IN(9)) {
    int* tab = (int*)(lds_raw + pg8::STAGE_BYTES);
    moe_table(p, tab);
    moe_gemm_phase<false>(p, lds_raw, lds, tab);
  }
#endif
  SYNC(9);
#endif
#ifndef SKIP_OTHER
  if (IN(10)) ph_final(p);
#if DUPK == 10
  xcd_barrier(xbar);
  if (IN(10)) ph_final(p);
#endif
#endif
#undef IN
#undef SYNC
}

extern "C" void kernel_launch(void* const* d_in, const int* in_sizes, int n_in, void* d_out, int out_size,
                              void* d_ws, size_t ws_size, hipStream_t stream) {
  Params p{};
  const float* const* in = (const float* const*)d_in;
  p.x = in[0]; p.c = in[1]; p.ctx = in[2]; p.c_ctx = in[3]; p.w_ada = in[4]; p.b_ada = in[5];
  p.g1 = in[6]; p.g2 = in[7]; p.w_in = in[8]; p.hy_conv_w = in[9]; p.hy_conv_b = in[10];
  p.f_w1 = in[11]; p.f_b1 = in[12]; p.f_freq = in[13]; p.f_w2 = in[14]; p.f_b2 = in[15]; p.f_w3 = in[16];
  p.hy_bias = in[17]; p.ssd_conv_w = in[18]; p.ssd_conv_b = in[19]; p.a_log = in[20]; p.dt_bias = in[21];
  p.ssd_d = in[22]; p.ssd_norm_g = in[23]; p.w_out = in[24]; p.w_group = in[25]; p.b_group = in[26];
  p.w_expert = in[27]; p.b_expert = in[28]; p.w1 = in[29]; p.w3 = in[30]; p.w2 = in[31]; p.g_final = in[32];
  p.out = (float*)d_out;

  char* ws = (char*)d_ws;
  size_t off = 0;
  auto take = [&](size_t bytes) { char* r = ws + off; off += (bytes + 255) & ~(size_t)255; return r; };
  p.BAR = (unsigned*)take((size_t)XCD_BAR_WORDS * 4);
  p.MOD = (float*)take((size_t)9 * 6144 * 4);
  p.CNT = (int*)take(NE * 4);
  p.GATE = (float*)take((size_t)T * 2 * 4);
  p.LIST = (int*)take((size_t)NE * T * 4);
  p.DT = (float*)take((size_t)TT * 16 * 4);
  p.ACUM = (float*)take((size_t)T * 16 * 4);
  p.SSQP = (float*)take((size_t)T * 16 * 4);
  p.CDEC = (float*)take((size_t)128 * 18 * 32 * 4);
  p.FILTt = (bf16_t*)take((size_t)1024 * FLEN * 2);
  p.WRhi = (bf16_t*)take((size_t)96 * 1024 * 2);
  p.WRlo = (bf16_t*)take((size_t)96 * 1024 * 2);
  p.WinT = (bf16_t*)take((size_t)(DP + 256) * D * 2);
  p.WoutT = (bf16_t*)take((size_t)D * D * 2);
  char* rPX = take((size_t)TT * DP * 2);
  char* rXBC = take((size_t)128 * 18 * 8192 * 2);
  char* rYF = take((size_t)T * DS * 4);
  char* rZ1 = take((size_t)HYC * T * 2);
  char* rYB = take((size_t)T * DS * 4);
  char* rYM = take((size_t)T * D * 2);
  p.PXb = (bf16_t*)rPX; p.SST = (bf16_t*)rXBC; p.Ut = (bf16_t*)rZ1; p.YMIXb = (bf16_t*)rYM;
  p.HIN = (bf16_t*)rYF;
  p.Yt = (bf16_t*)rYB;
  p.XNb = (bf16_t*)rZ1;
  p.X1 = (float*)rPX;
  p.H2b = (bf16_t*)rYM;
  p.HBb = (bf16_t*)(rPX + (size_t)T * D * 4);
  p.YB2b = (bf16_t*)rZ1;
  if (off > ws_size) { fprintf(stderr, "workspace too small: need %zu have %zu\n", off, ws_size); return; }

  static int grid_blocks = 0;
  if (!grid_blocks) {
    int dev = 0, cus = 0, per_cu = 0;
    (void)hipGetDevice(&dev);
    (void)hipDeviceGetAttribute(&cus, hipDeviceAttributeMultiprocessorCount, dev);
    (void)hipFuncSetAttribute((const void*)mega, hipFuncAttributeMaxDynamicSharedMemorySize, LDS_BYTES);
    (void)hipOccupancyMaxActiveBlocksPerMultiprocessor(&per_cu, mega, NTHR, LDS_BYTES);
    if (per_cu < 1) { fprintf(stderr, "occupancy query returned %d\n", per_cu); per_cu = 1; }
    grid_blocks = cus;
  }
#ifndef ONE_LAUNCH
  for (int ph = 0; ph < NPHASE; ++ph) {
    p.lo = ph; p.hi = ph + 1;
    hipLaunchKernelGGL(mega, dim3(grid_blocks), dim3(NTHR), LDS_BYTES, stream, p);
  }
#else
  p.lo = 0; p.hi = NPHASE;
  (void)hipMemsetAsync(p.BAR, 0, (size_t)XCD_BAR_WORDS * 4, stream);
  void* args[] = {&p};
  hipError_t e = hipLaunchCooperativeKernel((void*)mega, dim3(grid_blocks), dim3(NTHR), args, LDS_BYTES, stream);
  if (e != hipSuccess) fprintf(stderr, "cooperative launch failed: %s (grid %d)\n", hipGetErrorString(e), grid_blocks);
#endif
}
```

```cpp
#define ONE_LAUNCH 1
#include <hip/hip_runtime.h>
#include <hip/hip_cooperative_groups.h>
#include <cstdio>
#include <cstdint>
namespace cg = cooperative_groups;

constexpr int D = 1024, NB = 8, L = 2048, LC = 256;
constexpr int T = NB * L;
constexpr int TC = NB * LC;
constexpr int TT = T + TC;
constexpr int DH = 512, HYC = 1536, DS = 512, DXBC = 1024, DIN = 3088, DP = 3072;
constexpr int COL_Z = 1536, COL_XBC = 2048, COL_DT = 3072;
constexpr int NE = 64, DE = 512;
constexpr float EPS = 1e-6f;
constexpr int NTHR = 512;
constexpr int LDS_BYTES = 132 * 1024;
constexpr int FLEN = 4232, HX0 = 2112, FCLEN = 4240, ZSTRB = 4240;

typedef unsigned short bf16_t;

struct Params {
  const float *x, *c, *ctx, *c_ctx, *w_ada, *b_ada, *g1, *g2, *w_in, *hy_conv_w, *hy_conv_b;
  const float *f_w1, *f_b1, *f_freq, *f_w2, *f_b2, *f_w3, *hy_bias;
  const float *ssd_conv_w, *ssd_conv_b, *a_log, *dt_bias, *ssd_d, *ssd_norm_g, *w_out;
  const float *w_group, *b_group, *w_expert, *b_expert, *w1, *w3, *w2, *g_final;
  float* out;
  float *MOD, *DT, *X1, *GATE, *ACUM, *CDEC, *SSQP;
  bf16_t *WRhi, *WRlo, *FILTt, *Ut, *Yt, *HIN, *XNb, *WinT, *WoutT, *PXb, *SST, *YMIXb, *YB2b, *H2b, *HBb;
  int *CNT, *LIST;
  unsigned* BAR;
  int lo, hi;
};

__device__ __forceinline__ float silu_f(float v) { return v / (1.f + __expf(-v)); }
__device__ __forceinline__ float softplus_f(float v) { return v > 20.f ? v : log1pf(expf(v)); }
__device__ __forceinline__ float bf2f(bf16_t v) { return __uint_as_float(((unsigned)v) << 16); }
__device__ __forceinline__ unsigned cvt_pk_bf16(float lo, float hi) {
  typedef __bf16 bf2_t __attribute__((ext_vector_type(2)));
  typedef float f2_t __attribute__((ext_vector_type(2)));
  const f2_t v = {lo, hi};
  const bf2_t r = __builtin_convertvector(v, bf2_t);
  return __builtin_bit_cast(unsigned, r);
}
__device__ __forceinline__ bf16_t f2bf(float f) { return (bf16_t)(cvt_pk_bf16(f, 0.f) & 0xffffu); }
__device__ __forceinline__ void st_agent64(void* p, unsigned lo, unsigned hi) {
  __hip_atomic_store((unsigned long long*)p, ((unsigned long long)hi << 32) | lo, __ATOMIC_RELAXED, __HIP_MEMORY_SCOPE_AGENT);
}
__device__ __forceinline__ uint2 ld_agent64(const void* p) {
  const unsigned long long v = __hip_atomic_load((const unsigned long long*)p, __ATOMIC_RELAXED, __HIP_MEMORY_SCOPE_AGENT);
  return make_uint2((unsigned)v, (unsigned)(v >> 32));
}
__device__ __forceinline__ void st_agent32(float* p, float v) { __hip_atomic_store(p, v, __ATOMIC_RELAXED, __HIP_MEMORY_SCOPE_AGENT); }
__device__ __forceinline__ float ld_agent32(const float* p) { return __hip_atomic_load(p, __ATOMIC_RELAXED, __HIP_MEMORY_SCOPE_AGENT); }
__device__ __forceinline__ float wave_sum(float v) {
#pragma unroll
  for (int o = 32; o > 0; o >>= 1) v += __shfl_xor(v, o);
  return v;
}


#define XB_TMO      128
#define XB_XCNT(j)  (256  + 64 * (j))
#define XB_XSUB(j)  (1280 + 64 * (j))
#define XB_XGEN(j)  (2304 + 64 * (j))
#define XB_TOP      3328
#define XB_TOPGEN   3392
#define XCD_BAR_WORDS 3456
#define XB_SPIN_CAP (1u << 18)
#define LAS __attribute__((address_space(3)))
__device__ __forceinline__ unsigned xb_ld(unsigned* p) { return __hip_atomic_load(p, __ATOMIC_RELAXED, __HIP_MEMORY_SCOPE_AGENT); }
__device__ __forceinline__ unsigned xb_add(unsigned* p, unsigned v) { return __hip_atomic_fetch_add(p, v, __ATOMIC_RELAXED, __HIP_MEMORY_SCOPE_AGENT); }
__device__ __forceinline__ unsigned xb_xcc_id() { return (unsigned)__builtin_amdgcn_s_getreg((3 << 11) | 20) & 0xFu; }
#define XB_SPIN(cond, bar) do { unsigned _sp = 0; while (cond) { __builtin_amdgcn_s_sleep(1); \
    if ((++_sp & 255u) == 0u) { if (xb_ld(&(bar)[XB_TMO])) break; if (_sp > XB_SPIN_CAP) { atomicAdd(&(bar)[XB_TMO], 1u); break; } } } } while (0)
struct XcdBarrier { unsigned* bar; unsigned x; volatile LAS unsigned* st; };
__device__ __forceinline__ XcdBarrier xcd_barrier_post(unsigned* bar, volatile LAS unsigned* st) {
  XcdBarrier b; b.bar = bar; b.x = xb_xcc_id(); b.st = st;
  if (threadIdx.x == 0) (void)xb_add(&bar[XB_XCNT(b.x)], 1u);
  return b;
}
__device__ __forceinline__ void xcd_barrier_complete(unsigned* bar, unsigned x, unsigned& nloc, unsigned& nx) {
  const unsigned G = gridDim.x * gridDim.y * gridDim.z;
  unsigned sum, cnt, mine, sp = 0u;
  for (;;) {
    sum = 0u; cnt = 0u; mine = 0u;
#pragma unroll
    for (unsigned j = 0; j < 16; ++j) { const unsigned c = xb_ld(&bar[XB_XCNT(j)]); sum += c; cnt += (c > 0u) ? 1u : 0u; mine = (j == x) ? c : mine; }
    if (sum == G) break;
    __builtin_amdgcn_s_sleep(1);
    if ((++sp & 255u) == 0u) { if (xb_ld(&bar[XB_TMO])) break; if (sp > XB_SPIN_CAP) { atomicAdd(&bar[XB_TMO], 1u); break; } }
  }
  nloc = mine > 0u ? mine : 1u; nx = cnt > 0u ? cnt : 1u;
}
__device__ __forceinline__ void xcd_barrier(const XcdBarrier& b) {
  asm volatile("s_waitcnt vmcnt(0)" ::: "memory");
  __syncthreads();
  if (threadIdx.x == 0) {
    unsigned* bar = b.bar;
    __builtin_amdgcn_s_waitcnt(0);
    unsigned nloc = b.st[0], nx = b.st[1];
    if (nloc == 0u) { xcd_barrier_complete(bar, b.x, nloc, nx); b.st[0] = nloc; b.st[1] = nx; }
    const unsigned old = xb_add(&bar[XB_XSUB(b.x)], 1u);
    const unsigned gen = old / nloc;
    if (old + 1u == (gen + 1u) * nloc) {
      __builtin_amdgcn_fence(__ATOMIC_RELEASE, "agent");
      asm volatile("s_waitcnt vmcnt(0)" ::: "memory");
      const unsigned og = xb_add(&bar[XB_TOP], 1u);
      const unsigned tg = og / nx;
      if (og + 1u == (tg + 1u) * nx) xb_add(&bar[XB_TOPGEN], 1u);
      else XB_SPIN(xb_ld(&bar[XB_TOPGEN]) == tg, bar);
      __builtin_amdgcn_fence(__ATOMIC_ACQUIRE, "agent");
      xb_add(&bar[XB_XGEN(b.x)], 1u);
      asm volatile("s_waitcnt vmcnt(0)" ::: "memory");
    } else {
      XB_SPIN(xb_ld(&bar[XB_XGEN(b.x)]) == gen, bar);
      __builtin_amdgcn_fence(__ATOMIC_ACQUIRE, "agent");
      asm volatile("s_waitcnt vmcnt(0)" ::: "memory");
    }
  }
  __syncthreads();
}

namespace pg8 {
#define PG8_LAS __attribute__((address_space(3)))
typedef short bf16x8 __attribute__((ext_vector_type(8)));
typedef float f32x4 __attribute__((ext_vector_type(4)));
typedef unsigned u32x4 __attribute__((ext_vector_type(4)));
typedef unsigned u32x2 __attribute__((ext_vector_type(2)));
constexpr int BM = 256, BK = 64, HALF = 128, HTB = HALF * BK * 2, STAGE_BYTES = 8 * HTB, NXCD = 8, WGM = 8;

__host__ __device__ __forceinline__ int lds_byte(int r, int c) {
  const int st = (r >> 4) * 2 + (c >> 5), rr = r & 15, cc = c & 31, ob = rr * 64 + cc * 2;
  return st * 1024 + (ob ^ (((ob >> 9) & 1) << 5));
}
__host__ __device__ __forceinline__ void stage_rc(int b, int& R, int& C) {
  const int st = b / 1024, sb = b % 1024, swz = sb ^ (((sb >> 9) & 1) << 5);
  R = (st >> 1) * 16 + swz / 64; C = (st & 1) * 32 + (swz % 64) / 2;
}
__host__ __device__ __forceinline__ int perm32(int rho) { const int n = rho >> 4, i = rho & 15; return 8 * (i >> 2) + 4 * n + (i & 3); }

struct Unit { int pm, pn, e, mu, nv, cnt, seg; };

__device__ __forceinline__ bool static_next(int nM, int nN, int G, int c, int i, int& pm, int& pn) {
  const int nwg = nM * nN;
  const long Lx = (long)i * G + c; if (Lx >= nwg) return false;
  int wgid = (int)Lx;
  { const int q = nwg / NXCD, r = nwg % NXCD, xcd = wgid % NXCD, off = wgid / NXCD; wgid = (xcd < r ? xcd * (q + 1) : r * (q + 1) + (xcd - r) * q) + off; }
  const int nig = WGM * nN, gid = wgid / nig, fm = gid * WGM, gsz = (nM - fm) < WGM ? (nM - fm) : WGM;
  pm = fm + ((wgid % nig) % gsz); pn = (wgid % nig) / gsz; return true;
}

struct DenseOrder {
  const bf16_t* A; const bf16_t* Bt; int nM, nN, K, G, c;
  __device__ __forceinline__ bool next(int i, Unit& u) const {
    if (!static_next(nM, nN, G, c, i, u.pm, u.pn)) return false;
    u.e = 0; u.mu = 0; u.nv = 256; u.cnt = 256; u.seg = 0; return true;
  }
  __device__ __forceinline__ const char* a_base() const { return (const char*)A; }
  __device__ __forceinline__ const char* b_ptr(const Unit& u) const { return (const char*)Bt + (size_t)u.pn * 256 * K * 2; }
  __device__ __forceinline__ void a_offs(const Unit& u, const int (&R)[2], const int (&C)[2], unsigned (&ao)[2][2]) const {
#pragma unroll
    for (int h = 0; h < 2; ++h)
#pragma unroll
      for (int i = 0; i < 2; ++i) ao[h][i] = (unsigned)((u.pm * 256 + h * 128 + R[i]) * K + C[i]) * 2u;
  }
};

struct MoeOrder {
  const int* tab; const bf16_t* A; const bf16_t* Bt; const int* list; int NTn, K, G, c; bool gather;
  __device__ __forceinline__ bool next(int i, Unit& u) const {
    const int Lx = i * G + c;
    if (Lx >= tab[64] * NTn) return false;
    const int mg = Lx / NTn; u.pn = Lx - mg * NTn;
    int e = 0;
    while (tab[e + 1] <= mg) ++e;
    u.e = e; u.mu = mg - tab[e]; u.cnt = tab[130 + e]; u.seg = tab[65 + e];
    const int rem = u.cnt - u.mu * 256; u.nv = rem < 256 ? rem : 256; u.pm = 0; return true;
  }
  __device__ __forceinline__ const char* a_base() const { return (const char*)A; }
  __device__ __forceinline__ const char* b_ptr(const Unit& u) const { return (const char*)Bt + ((size_t)u.e * NTn + u.pn) * 256 * K * 2; }
  __device__ __forceinline__ void a_offs(const Unit& u, const int (&R)[2], const int (&C)[2], unsigned (&ao)[2][2]) const {
#pragma unroll
    for (int h = 0; h < 2; ++h)
#pragma unroll
      for (int i = 0; i < 2; ++i) {
        int idx = u.mu * 256 + h * 128 + R[i];
        int row;
        if (gather) { if (idx > u.cnt - 1) idx = u.cnt - 1; row = list[u.e * T + idx] >> 1; }
        else row = u.seg + idx;
        ao[h][i] = (unsigned)(row * K + C[i]) * 2u;
      }
  }
};

struct EpiBf16 {
  static constexpr bool PERM = true;
  bf16_t* O; int ldc; float* DT; const float* dt_bias;
  __device__ __forceinline__ void operator()(const f32x4 (&acc)[2][2][4][2], const Unit& u, int wr, int wc, int fr, int fq) const {
    const int row0 = u.pm * BM + wr * 64 + fr;
    if (u.pn == 12) {
      if (wc == 0 && fq < 2) {
        const f32x4 b0 = *(const f32x4*)(dt_bias + 8 * fq), b1 = *(const f32x4*)(dt_bias + 8 * fq + 4);
#pragma unroll
        for (int ai = 0; ai < 2; ++ai)
#pragma unroll
          for (int m = 0; m < 4; ++m) {
            float* dp = DT + (size_t)(row0 + ai * HALF + m * 16) * 16 + 8 * fq;
            *(f32x4*)dp = acc[ai][0][m][0] + b0; *(f32x4*)(dp + 4) = acc[ai][0][m][1] + b1;
          }
      }
      return;
    }
    const int col0 = u.pn * BM + wc * 32 + 8 * fq;
#pragma unroll
    for (int ai = 0; ai < 2; ++ai)
#pragma unroll
      for (int m = 0; m < 4; ++m) {
        bf16_t* rowp = O + (size_t)(row0 + ai * HALF + m * 16) * ldc + col0;
#pragma unroll
        for (int bj = 0; bj < 2; ++bj) {
          f32x4 v0 = acc[ai][bj][m][0], v1 = acc[ai][bj][m][1];
          u32x4 w; w.x = cvt_pk_bf16(v0[0], v0[1]); w.y = cvt_pk_bf16(v0[2], v0[3]); w.z = cvt_pk_bf16(v1[0], v1[1]); w.w = cvt_pk_bf16(v1[2], v1[3]);
          *(u32x4*)(rowp + bj * HALF) = w;
        }
      }
  }
};

struct EpiX1 {
  static constexpr bool PERM = false;
  const float* x; const float* mod; float* X1; float* SSQP;
  __device__ __forceinline__ void operator()(const f32x4 (&acc)[2][2][4][2], const Unit& u, int wr, int wc, int fr, int fq) const {
    const int row0 = u.pm * BM + wr * 64 + fr, col0 = u.pn * BM + wc * 32 + 4 * fq;
    const float* ga = mod + ((u.pm * BM) / L) * 6144 + 2048 + col0;
    f32x4 gv[2][2];
#pragma unroll
    for (int bj = 0; bj < 2; ++bj)
#pragma unroll
      for (int n = 0; n < 2; ++n) gv[bj][n] = *(const f32x4*)(ga + bj * HALF + n * 16);
#pragma unroll
    for (int ai = 0; ai < 2; ++ai)
#pragma unroll
      for (int m = 0; m < 4; ++m) {
        const size_t off = (size_t)(row0 + ai * HALF + m * 16) * D + col0;
        float ssq = 0.f;
#pragma unroll
        for (int bj = 0; bj < 2; ++bj)
#pragma unroll
          for (int n = 0; n < 2; ++n) {
            const f32x4 xv = *(const f32x4*)(x + off + bj * HALF + n * 16);
            const f32x4 o = xv + gv[bj][n] * acc[ai][bj][m][n];
            *(f32x4*)(X1 + off + bj * HALF + n * 16) = o;
            ssq += (o[0] * o[0] + o[1] * o[1]) + (o[2] * o[2] + o[3] * o[3]);
          }
        ssq += __shfl_xor(ssq, 16); ssq += __shfl_xor(ssq, 32);
        if (fq == 0) SSQP[(size_t)(row0 + ai * HALF + m * 16) * 16 + u.pn * 4 + wc] = ssq;
      }
  }
};

struct EpiSwiGLU {
  static constexpr bool PERM = true;
  bf16_t* HBb;
  __device__ __forceinline__ void operator()(const f32x4 (&acc)[2][2][4][2], const Unit& u, int wr, int wc, int fr, int fq) const {
    const int col0 = u.pn * 128 + wc * 32 + 8 * fq;
#pragma unroll
    for (int ai = 0; ai < 2; ++ai)
#pragma unroll
      for (int m = 0; m < 4; ++m) {
        const int slot = u.mu * 256 + ai * HALF + wr * 64 + m * 16 + fr;
        if (slot < u.cnt) {
          float h[8];
#pragma unroll
          for (int n = 0; n < 2; ++n)
#pragma unroll
            for (int j = 0; j < 4; ++j) { const float a = acc[ai][0][m][n][j]; h[n * 4 + j] = a / (1.f + __expf(-a)) * acc[ai][1][m][n][j]; }
          u32x4 w; w.x = cvt_pk_bf16(h[0], h[1]); w.y = cvt_pk_bf16(h[2], h[3]); w.z = cvt_pk_bf16(h[4], h[5]); w.w = cvt_pk_bf16(h[6], h[7]);
          *(u32x4*)(HBb + (size_t)(u.seg + slot) * DE + col0) = w;
        }
      }
  }
};

struct EpiDown {
  static constexpr bool PERM = true;
  bf16_t* YB2b; const int* list; const float* gate;
  __device__ __forceinline__ void operator()(const f32x4 (&acc)[2][2][4][2], const Unit& u, int wr, int wc, int fr, int fq) const {
    const int col0 = u.pn * 256 + wc * 32 + 8 * fq;
#pragma unroll
    for (int ai = 0; ai < 2; ++ai)
#pragma unroll
      for (int m = 0; m < 4; ++m) {
        const int slot = u.mu * 256 + ai * HALF + wr * 64 + m * 16 + fr;
        if (slot < u.cnt) {
          const int pair = list[u.e * T + slot];
          const float gt = gate[pair];
          bf16_t* rowp = YB2b + (size_t)pair * D + col0;
#pragma unroll
          for (int bj = 0; bj < 2; ++bj) {
            f32x4 v0 = acc[ai][bj][m][0] * gt, v1 = acc[ai][bj][m][1] * gt;
            u32x4 w; w.x = cvt_pk_bf16(v0[0], v0[1]); w.y = cvt_pk_bf16(v0[2], v0[3]); w.z = cvt_pk_bf16(v1[0], v1[1]); w.w = cvt_pk_bf16(v1[2], v1[3]);
            *(u32x4*)(rowp + bj * HALF) = w;
          }
        }
      }
  }
};

template <class Epi, class Sched>
__device__ __forceinline__ void gemm_phase(PG8_LAS unsigned char* lds, const int K, const Sched& S, const Epi& E) {
  const int tid = threadIdx.x, wid = __builtin_amdgcn_readfirstlane(tid >> 6), lane = tid & 63, wr = wid >> 2, wc = wid & 3, fr = lane & 15, fq = lane >> 4;
  const int nt = K / BK;
  int Rr[2], Cc[2];
  unsigned voffB[2];
#pragma unroll
  for (int i = 0; i < 2; ++i) {
    stage_rc(tid * 16 + i * 8192, Rr[i], Cc[i]);
    const int Rb = Epi::PERM ? ((Rr[i] & ~31) + perm32(Rr[i] & 31)) : Rr[i];
    voffB[i] = (unsigned)(Rb * K + Cc[i]) * 2u;
  }
  const size_t kstep = (size_t)(BK * 2);
  const size_t hstep = (size_t)HALF * K * 2;
  const unsigned ldsw = (unsigned)wid * 1024u;
  const int aoff = lds_byte(wr * 64 + fr, fq * 8), boff = lds_byte(wc * 32 + fr, fq * 8);
#define PG8_SA(b, h) (((b) * 2 + (h)) * HTB)
#define PG8_SB(b, h) ((4 + (b) * 2 + (h)) * HTB)
#define PG8_STAGE(bufoff, gbase, voff) do { _Pragma("unroll") for (int _i = 0; _i < 2; ++_i) \
    __builtin_amdgcn_global_load_lds((const unsigned*)((const char*)(gbase) + (voff)[_i]), (PG8_LAS unsigned*)(lds + (bufoff) + ldsw + _i * 8192), 16, 0, 0); } while (0)
#define PG8_LDA(dst, b, h) do { _Pragma("unroll") for (int m = 0; m < 4; ++m) _Pragma("unroll") for (int k = 0; k < 2; ++k) dst[m][k] = *(const PG8_LAS bf16x8*)(lds + PG8_SA(b, h) + aoff + m * 2048 + k * 1024); } while (0)
#define PG8_LDB(dst, b, h) do { _Pragma("unroll") for (int n = 0; n < 2; ++n) _Pragma("unroll") for (int k = 0; k < 2; ++k) dst[n][k] = *(const PG8_LAS bf16x8*)(lds + PG8_SB(b, h) + boff + n * 2048 + k * 1024); } while (0)
#define PG8_MMA(ai, bj, At, Bt) do { __builtin_amdgcn_s_setprio(1); _Pragma("unroll") for (int m = 0; m < 4; ++m) _Pragma("unroll") for (int n = 0; n < 2; ++n) _Pragma("unroll") for (int k = 0; k < 2; ++k) \
    acc[ai][bj][m][n] = __builtin_amdgcn_mfma_f32_16x16x32_bf16(Bt[n][k], At[m][k], acc[ai][bj][m][n], 0, 0, 0); __builtin_amdgcn_s_setprio(0); } while (0)
#define PG8_WAIT_V(n) asm volatile("s_waitcnt vmcnt(" #n ")" ::: "memory")
#define PG8_WAIT_L(n) asm volatile("s_waitcnt lgkmcnt(" #n ")" ::: "memory")
#define PG8_BAR __builtin_amdgcn_s_barrier()
#define PG8_SCHED __builtin_amdgcn_sched_barrier(0)
  Unit cur, nxt; int ui = 0;
  if (!S.next(0, cur)) return;
  f32x4 acc[2][2][4][2];
#pragma unroll
  for (int a = 0; a < 2; ++a)
#pragma unroll
    for (int b = 0; b < 2; ++b)
#pragma unroll
      for (int m = 0; m < 4; ++m)
#pragma unroll
        for (int n = 0; n < 2; ++n) acc[a][b][m][n] = (f32x4){0.f, 0.f, 0.f, 0.f};
  bf16x8 At[4][2], B0[2][2], B1[2][2];
  unsigned cao[2][2], nao[2][2];
  S.a_offs(cur, Rr, Cc, cao);
  const char* const aB = S.a_base();
  const char* cB = S.b_ptr(cur);
  PG8_STAGE(PG8_SB(0, 0), cB, voffB); PG8_STAGE(PG8_SA(0, 0), aB, cao[0]); PG8_STAGE(PG8_SB(0, 1), cB + hstep, voffB); PG8_STAGE(PG8_SA(0, 1), aB, cao[1]);
  if (wr == 1) PG8_BAR;
  PG8_WAIT_V(4); PG8_BAR;
  PG8_STAGE(PG8_SB(1, 0), cB + kstep, voffB); PG8_STAGE(PG8_SA(1, 0), aB + kstep, cao[0]); PG8_STAGE(PG8_SB(1, 1), cB + hstep + kstep, voffB);
  PG8_WAIT_V(6); PG8_BAR;
  for (;;) {
    const bool has_next = S.next(ui + 1, nxt);
    const char* nB = cB;
    if (has_next) { S.a_offs(nxt, Rr, Cc, nao); nB = S.b_ptr(nxt); }
    else {
#pragma unroll
      for (int h = 0; h < 2; ++h)
#pragma unroll
        for (int i = 0; i < 2; ++i) nao[h][i] = cao[h][i];
    }
    const bool full = cur.nv > 128;
    for (int t = 0; t < nt; t += 2) {
      const bool last = (t == nt - 2);
      const char* a1 = aB + (size_t)(t + 1) * kstep;
      const char* a2 = last ? aB : aB + (size_t)(t + 2) * kstep; const char* b2 = last ? nB : cB + (size_t)(t + 2) * kstep;
      const char* a3 = a2 + kstep; const char* b3 = b2 + kstep;
      unsigned so[2][2];
#pragma unroll
      for (int h = 0; h < 2; ++h)
#pragma unroll
        for (int i = 0; i < 2; ++i) so[h][i] = last ? nao[h][i] : cao[h][i];
      PG8_LDB(B0, 0, 0); PG8_SCHED; PG8_LDA(At, 0, 0); PG8_STAGE(PG8_SA(1, 1), a1, cao[1]);
      PG8_WAIT_L(8); PG8_BAR; PG8_WAIT_L(0); PG8_MMA(0, 0, At, B0); PG8_BAR; PG8_SCHED;
      PG8_LDB(B1, 0, 1); PG8_STAGE(PG8_SB(0, 0), b2, voffB);
      PG8_BAR; PG8_WAIT_L(0); PG8_MMA(0, 1, At, B1); PG8_BAR;
      PG8_LDA(At, 0, 1); PG8_STAGE(PG8_SA(0, 0), a2, so[0]);
      PG8_BAR; PG8_WAIT_L(0); if (full) PG8_MMA(1, 0, At, B0); PG8_BAR; PG8_SCHED;
      PG8_STAGE(PG8_SB(0, 1), b2 + hstep, voffB);
      PG8_WAIT_V(6); PG8_BAR; if (full) PG8_MMA(1, 1, At, B1); PG8_BAR;
      PG8_LDB(B0, 1, 0); PG8_SCHED; PG8_LDA(At, 1, 0); PG8_STAGE(PG8_SA(0, 1), a2, so[1]);
      PG8_WAIT_L(8); PG8_BAR; PG8_WAIT_L(0); PG8_MMA(0, 0, At, B0); PG8_BAR; PG8_SCHED;
      PG8_LDB(B1, 1, 1); PG8_STAGE(PG8_SB(1, 0), b3, voffB);
      PG8_BAR; PG8_WAIT_L(0); PG8_MMA(0, 1, At, B1); PG8_BAR;
      PG8_LDA(At, 1, 1); PG8_STAGE(PG8_SA(1, 0), a3, so[0]);
      PG8_BAR; PG8_WAIT_L(0); if (full) PG8_MMA(1, 0, At, B0); PG8_BAR; PG8_SCHED;
      PG8_STAGE(PG8_SB(1, 1), b3 + hstep, voffB);
      PG8_WAIT_V(6); PG8_BAR; if (full) PG8_MMA(1, 1, At, B1); PG8_BAR;
    }
    E(acc, cur, wr, wc, fr, fq);
    if (!has_next) break;
#pragma unroll
    for (int a = 0; a < 2; ++a)
#pragma unroll
      for (int b = 0; b < 2; ++b)
#pragma unroll
        for (int m = 0; m < 4; ++m)
#pragma unroll
          for (int n = 0; n < 2; ++n) acc[a][b][m][n] = (f32x4){0.f, 0.f, 0.f, 0.f};
    cur = nxt; cB = nB; ++ui;
#pragma unroll
    for (int h = 0; h < 2; ++h)
#pragma unroll
      for (int i = 0; i < 2; ++i) cao[h][i] = nao[h][i];
  }
  PG8_WAIT_V(0);
  if (wr == 0) PG8_BAR;
  PG8_BAR;
#undef PG8_SA
#undef PG8_SB
#undef PG8_STAGE
#undef PG8_LDA
#undef PG8_LDB
#undef PG8_MMA
#undef PG8_WAIT_V
#undef PG8_WAIT_L
#undef PG8_BAR
#undef PG8_SCHED
}
}

__device__ void ph_adaln(const Params& p, float* sm) {
  const int tid = threadIdx.x;
  if (blockIdx.x == 0 && tid < NE) p.CNT[tid * 32] = 0;
  for (int e = blockIdx.x * NTHR + tid; e < 96 * 1024; e += gridDim.x * NTHR) {
    const int j = e >> 10, k = e & 1023;
    float w = 0.f;
    if (j < 64) w = p.w_expert[k * 64 + j]; else if (j < 72) w = p.w_group[k * 8 + (j - 64)];
    const unsigned hi = cvt_pk_bf16(w, 0.f) & 0xffffu;
    const float rem = w - __uint_as_float(hi << 16);
    p.WRhi[e] = (bf16_t)hi; p.WRlo[e] = (bf16_t)(cvt_pk_bf16(rem, 0.f) & 0xffffu);
  }
  float* sc = sm;
  float* red = sm + 9 * 1024;
  for (int e = tid; e < 9 * 1024; e += NTHR) {
    const int r = e >> 10, k = e & 1023;
    sc[e] = silu_f(r < 8 ? p.c[r * D + k] : p.c_ctx[k]);
  }
  __syncthreads();
  for (int item = blockIdx.x; item < 192; item += gridDim.x) {
    const int col0 = item * 32;
    const int kq = tid >> 3, c4 = (tid & 7) * 4;
    float acc[9][4];
#pragma unroll
    for (int r = 0; r < 9; ++r)
#pragma unroll
      for (int j = 0; j < 4; ++j) acc[r][j] = 0.f;
    float4 wv[16];
#pragma unroll
    for (int i = 0; i < 16; ++i) wv[i] = *(const float4*)(p.w_ada + (size_t)(kq + i * 64) * 6144 + col0 + c4);
#pragma unroll
    for (int i = 0; i < 16; ++i) {
      const int k = kq + i * 64;
      const float4 w = wv[i];
#pragma unroll
      for (int r = 0; r < 9; ++r) {
        const float sv = sc[r * 1024 + k];
        acc[r][0] += sv * w.x; acc[r][1] += sv * w.y; acc[r][2] += sv * w.z; acc[r][3] += sv * w.w;
      }
    }
#pragma unroll
    for (int r = 0; r < 9; ++r)
#pragma unroll
      for (int j = 0; j < 4; ++j) red[kq * 292 + r * 32 + c4 + j] = acc[r][j];
    __syncthreads();
    if (tid < 288) {
      float a = 0.f;
      for (int q = 0; q < 64; ++q) a += red[q * 292 + tid];
      const int r = tid >> 5, j = tid & 31;
      p.MOD[r * 6144 + col0 + j] = a + p.b_ada[col0 + j];
    }
    __syncthreads();
  }
}

__device__ void ph_filters(const Params& p, float* sm) {
  const int tid = threadIdx.x, wid = tid >> 6, lane = tid & 63;
  float* feats = sm;
  float* h1 = sm + 64 * 20;
  float* h2 = h1 + 64 * 64;
  float* w3s = h2 + 64 * 64;
  bf16_t* tile = (bf16_t*)w3s;
  float* w2s = w3s + 64 * 256;
  float* w1s = w2s + 4096;
  for (int e = tid; e < 4096; e += NTHR) w2s[e] = p.f_w2[e];
  for (int e = tid; e < 17 * 64; e += NTHR) w1s[e] = p.f_w1[e];
  __syncthreads();
  for (int e = blockIdx.x * NTHR + tid; e < 1024 * 137; e += gridDim.x * NTHR) {
    int rowi = e / 137, k = e - rowi * 137;
    int x = (k < 65) ? k : (4160 + (k - 65));
    p.FILTt[(size_t)rowi * FLEN + x] = 0;
  }
  for (int item = blockIdx.x; item < 256; item += gridDim.x) {
    const int tt = item >> 3, ct = item & 7;
    for (int e = tid; e < 64 * 17; e += NTHR) {
      int tp = e / 17, i = e - tp * 17;
      int t = tt * 64 + tp;
      float f;
      if (i == 0) f = (float)t / (float)(L - 1);
      else {
        int bi = (i - 1) & 7;
        float bandf = (float)(1e-4 + (double)bi * ((7.0 - 1e-4) / 7.0));
        float ang = (float)(2.0 * 3.14159265358979323846 / (double)L) * (float)t * bandf;
        f = (i <= 8) ? cosf(ang) : -sinf(ang);
      }
      feats[tp * 20 + i] = f;
    }
    __syncthreads();
    for (int e = tid; e < 4096; e += NTHR) {
      int tp = e >> 6, j = e & 63;
      float a = p.f_b1[j];
      for (int i = 0; i < 17; ++i) a += feats[tp * 20 + i] * w1s[i * 64 + j];
      h1[e] = __sinf(p.f_freq[j] * a);
    }
    __syncthreads();
    for (int e = tid; e < 4096; e += NTHR) {
      int tp = e >> 6, j = e & 63;
      float a = p.f_b2[j];
      for (int i = 0; i < 64; ++i) a += h1[tp * 64 + i] * w2s[i * 64 + j];
      h2[e] = __sinf(p.f_freq[j] * a);
    }
    __syncthreads();
    for (int e = tid; e < 4096; e += NTHR) {
      const int i = e >> 6, c4 = (e & 63) * 4;
      *(float4*)(w3s + i * 256 + c4) = *(const float4*)(p.f_w3 + i * 2048 + ct * 256 + c4);
    }
    __syncthreads();
    {
      const int cg = tid & 31, tg = tid >> 5;
      float acc[4][8];
#pragma unroll
      for (int a = 0; a < 4; ++a)
#pragma unroll
        for (int c = 0; c < 8; ++c) acc[a][c] = 0.f;
#pragma unroll 4
      for (int i = 0; i < 64; ++i) {
        const float4 w0 = *(const float4*)(w3s + i * 256 + cg * 8), w1 = *(const float4*)(w3s + i * 256 + cg * 8 + 4);
        const float wv[8] = {w0.x, w0.y, w0.z, w0.w, w1.x, w1.y, w1.z, w1.w};
#pragma unroll
        for (int a = 0; a < 4; ++a) {
          const float hv = h2[(tg * 4 + a) * 64 + i];
#pragma unroll
          for (int c = 0; c < 8; ++c) acc[a][c] += hv * wv[c];
        }
      }
      __syncthreads();
      const float d0 = -4.605170185988091f / 1.5f, d1 = -4.605170185988091f / 0.3f;
#pragma unroll
      for (int c = 0; c < 8; ++c) {
        const int col = cg * 8 + c;
        const int cch = (ct * 256 + col) & 511;
        const float delta = fabsf(d0 + (float)cch * ((d1 - d0) / 511.f));
#pragma unroll
        for (int a = 0; a < 4; ++a) {
          const int t = tt * 64 + tg * 4 + a;
          const float tn = (float)t / (float)(L - 1);
          tile[col * 66 + tg * 4 + a] = f2bf(acc[a][c] * __expf(-tn * delta));
        }
      }
    }
    __syncthreads();
    for (int cl = wid * 32; cl < wid * 32 + 32; ++cl) {
      const int gcol = ct * 256 + cl;
      const int o = gcol >> 10, dir = (gcol >> 9) & 1, cch = gcol & 511;
      const int t = tt * 64 + lane;
      const int x = dir ? (HX0 + t) : (HX0 - t);
      if (!(dir && t == 0)) p.FILTt[(size_t)(o * 512 + cch) * FLEN + x] = tile[cl * 66 + lane];
    }
    __syncthreads();
  }
}

__device__ __forceinline__ void cvt_tile256(const float* src, int ld, int k0, int n0, bf16_t* dst, int ldd, int dmap0, int dmap1, int nsplit, float* sm) {
  const int tid = threadIdx.x;
  float* ts = sm;
  float4 v[8];
#pragma unroll
  for (int i = 0; i < 8; ++i) {
    const int e = tid + i * NTHR; const int k = e >> 6, n4 = (e & 63) * 4;
    v[i] = *(const float4*)(src + (size_t)(k0 + k) * ld + n0 + n4);
  }
#pragma unroll
  for (int i = 0; i < 8; ++i) {
    const int e = tid + i * NTHR; const int k = e >> 6, n4 = (e & 63) * 4;
    ts[k * 257 + n4 + 0] = v[i].x; ts[k * 257 + n4 + 1] = v[i].y; ts[k * 257 + n4 + 2] = v[i].z; ts[k * 257 + n4 + 3] = v[i].w;
  }
  __syncthreads();
#pragma unroll
  for (int i = 0; i < 4; ++i) {
    const int e = tid + i * NTHR; const int n = e >> 3, kq = (e & 7) * 8;
    uint4 w;
    w.x = cvt_pk_bf16(ts[(kq + 0) * 257 + n], ts[(kq + 1) * 257 + n]);
    w.y = cvt_pk_bf16(ts[(kq + 2) * 257 + n], ts[(kq + 3) * 257 + n]);
    w.z = cvt_pk_bf16(ts[(kq + 4) * 257 + n], ts[(kq + 5) * 257 + n]);
    w.w = cvt_pk_bf16(ts[(kq + 6) * 257 + n], ts[(kq + 7) * 257 + n]);
    const int drow = (n < nsplit) ? (dmap0 + n) : (dmap1 + (n - nsplit));
    *(uint4*)(dst + (size_t)drow * ldd + k0 + kq) = w;
  }
  __syncthreads();
}

__device__ void ph_wcvt(const Params& p, float* sm) {
  for (int e = blockIdx.x * NTHR + threadIdx.x; e < 16 * 1024; e += gridDim.x * NTHR) {
    const int j = e >> 10, k = e & 1023;
    p.WinT[(size_t)(DP + j) * D + k] = f2bf(p.w_in[(size_t)k * DIN + COL_DT + j]);
  }
  for (int it = blockIdx.x; it < 192 + 64; it += gridDim.x) {
    if (it < 192) { const int kt = it / 12, nt = it - kt * 12; cvt_tile256(p.w_in, DIN, kt * 64, nt * 256, p.WinT, D, nt * 256, 0, 256, sm); }
    else if (it < 256) { const int i = it - 192; const int kt = i >> 2, nt = i & 3; cvt_tile256(p.w_out, D, kt * 64, nt * 256, p.WoutT, D, nt * 256, 0, 256, sm); }
  }
}

__device__ void ph_norm1(const Params& p) {
  const int tid = threadIdx.x, wid = tid >> 6, lane = tid & 63;
  for (int row = blockIdx.x * 8 + wid; row < TT; row += gridDim.x * 8) {
    const float* src = (row < T) ? (p.x + (size_t)row * D) : (p.ctx + (size_t)(row - T) * D);
    const int mr = (row < T) ? (row / L) : 8;
    const float* sh = p.MOD + mr * 6144;
    const float* sc = sh + 1024;
    float4 v[4];
    float ss = 0.f;
#pragma unroll
    for (int i = 0; i < 4; ++i) {
      v[i] = *(const float4*)(src + i * 256 + lane * 4);
      ss += v[i].x * v[i].x + v[i].y * v[i].y + v[i].z * v[i].z + v[i].w * v[i].w;
    }
    ss = wave_sum(ss);
    const float rstd = rsqrtf(ss * (1.f / D) + EPS);
#pragma unroll
    for (int i = 0; i < 4; ++i) {
      const int col = i * 256 + lane * 4;
      float4 g = *(const float4*)(p.g1 + col);
      float4 s4 = *(const float4*)(sc + col);
      float4 h4 = *(const float4*)(sh + col);
      float4 o;
      o.x = v[i].x * rstd * g.x * (1.f + s4.x) + h4.x;
      o.y = v[i].y * rstd * g.y * (1.f + s4.y) + h4.y;
      o.z = v[i].z * rstd * g.z * (1.f + s4.z) + h4.z;
      o.w = v[i].w * rstd * g.w * (1.f + s4.w) + h4.w;
      uint2 w; w.x = cvt_pk_bf16(o.x, o.y); w.y = cvt_pk_bf16(o.z, o.w);
      *(uint2*)(p.XNb + (size_t)row * D + col) = w;
    }
  }
}

__device__ void ph_hy_convT(const Params& p, float* sm) {
  const int tid = threadIdx.x;
  float* tile = sm;
  const int bid = blockIdx.x;
  int it0, it1;
  if (gridDim.x == 256) { if (bid < 32) { it0 = bid * 3; it1 = it0 + 3; } else { it0 = 96 + (bid - 32) * 27; it1 = it0 + 27; } }
  else { const int per = (256 * 24 + gridDim.x - 1) / gridDim.x; it0 = bid * per; it1 = it0 + per; if (it1 > 256 * 24) it1 = 256 * 24; }
  for (int item = it0; item < it1; ++item) {
    const int gr = item / 24, ct = item - gr * 24;
    const int row0 = gr * 64;
    {
      const int t = tid >> 3, c8 = (tid & 7) * 8;
      uint4 v = *(const uint4*)(p.PXb + (size_t)(row0 + t) * DP + ct * 64 + c8);
      unsigned w[4] = {v.x, v.y, v.z, v.w};
#pragma unroll
      for (int k = 0; k < 4; ++k) {
        tile[t * 65 + c8 + 2 * k] = __uint_as_float(w[k] << 16);
        tile[t * 65 + c8 + 2 * k + 1] = __uint_as_float(w[k] & 0xffff0000u);
      }
    }
    __syncthreads();
    {
      const int cc = tid >> 3, t8 = (tid & 7) * 8;
      const int col = ct * 64 + cc;
      const float w0 = p.hy_conv_w[col], w1 = p.hy_conv_w[HYC + col], w2 = p.hy_conv_w[2 * HYC + col], bb = p.hy_conv_b[col];
      float o[8];
#pragma unroll
      for (int k = 0; k < 8; ++k) {
        const int t = t8 + k;
        float v = bb + w1 * tile[t * 65 + cc];
        if (t > 0) v += w0 * tile[(t - 1) * 65 + cc];
        if (t < 63) v += w2 * tile[(t + 1) * 65 + cc];
        o[k] = v;
      }
      uint4 w; w.x = cvt_pk_bf16(o[0], o[1]); w.y = cvt_pk_bf16(o[2], o[3]); w.z = cvt_pk_bf16(o[4], o[5]); w.w = cvt_pk_bf16(o[6], o[7]);
      *(uint4*)(p.Ut + (size_t)col * T + row0 + t8) = w;
    }
    __syncthreads();
  }
}

__device__ void ph_hy_backT(const Params& p, float* sm) {
  const int tid = threadIdx.x;
  bf16_t* tile = (bf16_t*)sm;
  for (int item = blockIdx.x; item < 256 * 8; item += gridDim.x) {
    const int gr = item >> 3, ct = item & 7;
    const int row0 = gr * 64;
    {
      const int cc = tid >> 3, r8 = (tid & 7) * 8;
      uint4 v = *(const uint4*)(p.Yt + (size_t)(ct * 64 + cc) * T + row0 + r8);
      unsigned w[4] = {v.x, v.y, v.z, v.w};
#pragma unroll
      for (int k = 0; k < 4; ++k) {
        tile[cc * 66 + r8 + 2 * k] = (bf16_t)(w[k] & 0xffffu);
        tile[cc * 66 + r8 + 2 * k + 1] = (bf16_t)(w[k] >> 16);
      }
    }
    __syncthreads();
    {
      const int r = tid >> 3, c8 = (tid & 7) * 8;
      unsigned w[4];
#pragma unroll
      for (int k = 0; k < 4; ++k) w[k] = (unsigned)tile[(c8 + 2 * k) * 66 + r] | ((unsigned)tile[(c8 + 2 * k + 1) * 66 + r] << 16);
      uint4 o; o.x = w[0]; o.y = w[1]; o.z = w[2]; o.w = w[3];
      *(uint4*)(p.YMIXb + (size_t)(row0 + r) * D + ct * 64 + c8) = o;
    }
    __syncthreads();
  }
}

typedef short hbf16x8 __attribute__((ext_vector_type(8)));
typedef float hf32x4 __attribute__((ext_vector_type(4)));

constexpr int HY_FC = 0, HY_ZT0 = 4 * FCLEN * 2, HY_ZT1 = HY_ZT0 + 8 * ZSTRB;

__device__ __forceinline__ void hy_build_filter(const Params& p, int o, int c, unsigned char* lds) {
  const int tid = threadIdx.x;
  const bf16_t* gsrc = p.FILTt + (size_t)(o * 512 + c) * FLEN;
  for (int e = tid; e < 530; e += NTHR) {
    uint4 v = make_uint4(0u, 0u, 0u, 0u);
    if (e < 529) v = *(const uint4*)(gsrc + e * 8);
    *(uint4*)(lds + HY_FC + e * 16) = v;
  }
  __syncthreads();
  for (int g = tid; g < 3 * 530; g += NTHR) {
    const int r = 1 + g / 530, ch = g % 530;
    uint4 lo = make_uint4(0u, 0u, 0u, 0u);
    if (ch > 0) lo = *(const uint4*)(lds + HY_FC + (ch - 1) * 16);
    uint4 hi = *(const uint4*)(lds + HY_FC + ch * 16);
    unsigned W[8] = {lo.x, lo.y, lo.z, lo.w, hi.x, hi.y, hi.z, hi.w};
    uint4 ov;
    if (r == 1) {
      ov.x = __builtin_amdgcn_alignbyte(W[4], W[3], 2); ov.y = __builtin_amdgcn_alignbyte(W[5], W[4], 2);
      ov.z = __builtin_amdgcn_alignbyte(W[6], W[5], 2); ov.w = __builtin_amdgcn_alignbyte(W[7], W[6], 2);
    } else if (r == 2) {
      ov.x = W[3]; ov.y = W[4]; ov.z = W[5]; ov.w = W[6];
    } else {
      ov.x = __builtin_amdgcn_alignbyte(W[3], W[2], 2); ov.y = __builtin_amdgcn_alignbyte(W[4], W[3], 2);
      ov.z = __builtin_amdgcn_alignbyte(W[5], W[4], 2); ov.w = __builtin_amdgcn_alignbyte(W[6], W[5], 2);
    }
    *(uint4*)(lds + HY_FC + r * (FCLEN * 2) + ch * 16) = ov;
  }
  __syncthreads();
}

__device__ __forceinline__ void hy_order(const Params& p, int o, int c, unsigned char* lds) {
  const int tid = threadIdx.x, wid = __builtin_amdgcn_readfirstlane(tid >> 6), lane = tid & 63;
  const int g0 = wid * 4;
  const int n16 = lane & 15, h = lane >> 4, bb = n16 & 7, pp = n16 >> 3;
  const unsigned char* Zin = lds + (o ? HY_ZT1 : HY_ZT0);
  const bf16_t* gate = p.Ut + (size_t)((o + 1) * 512 + c) * T + bb * L;
  uint2 xg[4][2];
#pragma unroll
  for (int i = 0; i < 4; ++i)
#pragma unroll
    for (int u = 0; u < 2; ++u) xg[i][u] = *(const uint2*)(gate + 32 * (2 * (g0 + i) + pp) + 16 * u + 4 * h);
  const float bias = p.hy_bias[o * 512 + c];
  hf32x4 acc[4][2];
#pragma unroll
  for (int i = 0; i < 4; ++i)
#pragma unroll
    for (int u = 0; u < 2; ++u) acc[i][u] = (hf32x4){0.f, 0.f, 0.f, 0.f};
  const int ai = lane & 15, ar = ai & 3, aq = ai >> 2;
  const unsigned char* laneA = lds + HY_FC + ar * (FCLEN * 2) + 2 * (HX0 - 4 * aq + 8 * h);
  const unsigned char* laneB = Zin + bb * ZSTRB + 64 + 64 * pp + 16 * h;
#define HY_LDA(dst, Dd) do { const uint2 _lo = *(const uint2*)(laneA - 32 * (Dd)); const uint2 _hi = *(const uint2*)(laneA - 32 * (Dd) + 8); \
    union { uint4 u4; hbf16x8 v; } _cv; _cv.u4 = make_uint4(_lo.x, _lo.y, _hi.x, _hi.y); dst = _cv.v; } while (0)
#define HY_LDB(dst, Qq) do { dst = *(const hbf16x8*)(laneB + 64 * (Qq)); } while (0)
#pragma unroll 1
  for (int pass = 0; pass < 2; ++pass) {
    const int Es = 2 * g0 - 63 + pass;
    hbf16x8 R[4];
    HY_LDB(R[1], 2 * (g0 + 1) - Es); HY_LDB(R[2], 2 * (g0 + 2) - Es); HY_LDB(R[3], 2 * (g0 + 3) - Es);
#pragma unroll 1
    for (int n4 = 0; n4 < 9; ++n4) {
#pragma unroll
      for (int j = 0; j < 4; ++j) {
        const int n = n4 * 4 + j;
        const int E = Es + 2 * n;
        HY_LDB(R[(4 - j) & 3], 2 * (g0 - n) - Es);
        hbf16x8 A0, A1;
        HY_LDA(A0, 2 * E); HY_LDA(A1, 2 * E + 1);
#pragma unroll
        for (int i = 0; i < 4; ++i) {
          const int Q = 2 * (g0 + i - n) - Es;
          if (Q >= -1 && Q <= 63) {
            acc[i][0] = __builtin_amdgcn_mfma_f32_16x16x32_bf16(A0, R[(i - j) & 3], acc[i][0], 0, 0, 0);
            acc[i][1] = __builtin_amdgcn_mfma_f32_16x16x32_bf16(A1, R[(i - j) & 3], acc[i][1], 0, 0, 0);
          }
        }
      }
    }
  }
#undef HY_LDA
#undef HY_LDB
#pragma unroll
  for (int i = 0; i < 4; ++i)
#pragma unroll
    for (int u = 0; u < 2; ++u) {
      const int t0 = 32 * (2 * (g0 + i) + pp) + 16 * u + 4 * h;
      const uint2 zv = *(const uint2*)(Zin + bb * ZSTRB + 64 + 2 * t0);
      const float z0 = __uint_as_float(zv.x << 16), z1 = __uint_as_float(zv.x & 0xffff0000u), z2 = __uint_as_float(zv.y << 16), z3 = __uint_as_float(zv.y & 0xffff0000u);
      const float x0 = __uint_as_float(xg[i][u].x << 16), x1 = __uint_as_float(xg[i][u].x & 0xffff0000u), x2 = __uint_as_float(xg[i][u].y << 16), x3 = __uint_as_float(xg[i][u].y & 0xffff0000u);
      const float r0 = x0 * (acc[i][u][0] + z0 * bias), r1 = x1 * (acc[i][u][1] + z1 * bias), r2 = x2 * (acc[i][u][2] + z2 * bias), r3 = x3 * (acc[i][u][3] + z3 * bias);
      uint2 w; w.x = cvt_pk_bf16(r0, r1); w.y = cvt_pk_bf16(r2, r3);
      if (o == 0) *(uint2*)(lds + HY_ZT1 + bb * ZSTRB + 64 + 2 * t0) = w;
      else *(uint2*)(p.Yt + (size_t)c * T + bb * L + t0) = w;
    }
}

__device__ void hyena_unit(const Params& p, int c, unsigned char* lds) {
  const int tid = threadIdx.x;
  if (tid < 144) {
    const int buf = tid / 72, rem = tid % 72, b = rem / 9, k = rem % 9;
    const int off = (k < 4) ? (k * 16) : (4160 + (k - 4) * 16);
    *(uint4*)(lds + (buf ? HY_ZT1 : HY_ZT0) + b * ZSTRB + off) = make_uint4(0u, 0u, 0u, 0u);
  }
  for (int e = tid; e < 2048; e += NTHR) {
    const int b = e >> 8, ch = e & 255;
    *(uint4*)(lds + HY_ZT0 + b * ZSTRB + 64 + ch * 16) = *(const uint4*)(p.Ut + (size_t)c * T + b * L + ch * 8);
  }
#pragma unroll 1
  for (int o = 0; o < 2; ++o) {
    hy_build_filter(p, o, c, lds);
    hy_order(p, o, c, lds);
    __syncthreads();
  }
}

constexpr int SROW = 272;

__device__ __forceinline__ void ssd_stage_nat(const Params& p, int row0, int pxcol0, int cvcol0, unsigned char* dst) {
  for (int e = threadIdx.x; e < 2048; e += NTHR) {
    const int l = e >> 4, cg = e & 15;
    const int row = row0 + l, li = row & 63;
    const bf16_t* src = p.PXb + (size_t)row * DP + pxcol0 + cg * 8;
    const uint4 zero4 = make_uint4(0u, 0u, 0u, 0u);
    const uint4 cur = *(const uint4*)src;
    const uint4 prv = (li > 0) ? *(const uint4*)(src - DP) : zero4;
    const uint4 nxt = (li < 63) ? *(const uint4*)(src + DP) : zero4;
    const float* cw = p.ssd_conv_w + cvcol0 + cg * 8;
    const float* cb = p.ssd_conv_b + cvcol0 + cg * 8;
    const unsigned pc[4] = {prv.x, prv.y, prv.z, prv.w}, cc[4] = {cur.x, cur.y, cur.z, cur.w}, nc[4] = {nxt.x, nxt.y, nxt.z, nxt.w};
    float o[8];
#pragma unroll
    for (int k = 0; k < 4; ++k) {
      const float p0 = __uint_as_float(pc[k] << 16), p1 = __uint_as_float(pc[k] & 0xffff0000u);
      const float c0 = __uint_as_float(cc[k] << 16), c1 = __uint_as_float(cc[k] & 0xffff0000u);
      const float n0 = __uint_as_float(nc[k] << 16), n1 = __uint_as_float(nc[k] & 0xffff0000u);
      const float v0 = cb[2 * k] + cw[2 * k] * p0 + cw[DXBC + 2 * k] * c0 + cw[2 * DXBC + 2 * k] * n0;
      const float v1 = cb[2 * k + 1] + cw[2 * k + 1] * p1 + cw[DXBC + 2 * k + 1] * c1 + cw[2 * DXBC + 2 * k + 1] * n1;
      o[2 * k] = silu_f(v0); o[2 * k + 1] = silu_f(v1);
    }
    uint4 w; w.x = cvt_pk_bf16(o[0], o[1]); w.y = cvt_pk_bf16(o[2], o[3]); w.z = cvt_pk_bf16(o[4], o[5]); w.w = cvt_pk_bf16(o[6], o[7]);
    *(uint4*)(dst + l * SROW + cg * 16) = w;
  }
}

__device__ __forceinline__ void ssd_stage_tr(const Params& p, int row0, bool is_ctx, int pxcol0, int cvcol0, int ncols, unsigned char* dst) {
  const int ncg = ncols >> 2;
  for (int e = threadIdx.x; e < ncg * 16; e += NTHR) {
    const int cg = e % ncg, l8 = e / ncg;
    const int rowf = row0 + l8 * 8;
    bool has_prev, has_next;
    if (is_ctx) { const int tc = (rowf - T) & (LC - 1); has_prev = tc > 0; has_next = tc + 7 < LC - 1; }
    else { const int li = rowf & 63; has_prev = li > 0; has_next = li + 7 < 63; }
    const bf16_t* src = p.PXb + (size_t)rowf * DP + pxcol0 + cg * 4;
    const uint2 z2 = make_uint2(0u, 0u);
    uint2 raw[10];
    raw[0] = *(const uint2*)((cvcol0 >= 0 && has_prev) ? (src - DP) : src);
    if (!(cvcol0 >= 0 && has_prev)) raw[0] = z2;
#pragma unroll
    for (int k = 0; k < 8; ++k) raw[k + 1] = *(const uint2*)(src + (size_t)k * DP);
    raw[9] = *(const uint2*)((cvcol0 >= 0 && has_next) ? (src + (size_t)8 * DP) : src);
    if (!(cvcol0 >= 0 && has_next)) raw[9] = z2;
    unsigned outw[4][4];
    if (cvcol0 >= 0) {
      const float* cw = p.ssd_conv_w + cvcol0 + cg * 4; const float* cb = p.ssd_conv_b + cvcol0 + cg * 4;
      const float4 a0 = *(const float4*)cw, b0 = *(const float4*)(cw + DXBC), c0 = *(const float4*)(cw + 2 * DXBC), d0 = *(const float4*)cb;
      const float w0[4] = {a0.x, a0.y, a0.z, a0.w}, w1[4] = {b0.x, b0.y, b0.z, b0.w}, w2[4] = {c0.x, c0.y, c0.z, c0.w}, bb[4] = {d0.x, d0.y, d0.z, d0.w};
#pragma unroll
      for (int kp = 0; kp < 4; ++kp) {
#pragma unroll
        for (int c = 0; c < 4; ++c) {
          const unsigned q0 = (c >> 1) ? raw[2 * kp].y : raw[2 * kp].x, q1 = (c >> 1) ? raw[2 * kp + 1].y : raw[2 * kp + 1].x;
          const unsigned q2 = (c >> 1) ? raw[2 * kp + 2].y : raw[2 * kp + 2].x, q3 = (c >> 1) ? raw[2 * kp + 3].y : raw[2 * kp + 3].x;
          float x0, x1, x2, x3;
          if (c & 1) { x0 = __uint_as_float(q0 & 0xffff0000u); x1 = __uint_as_float(q1 & 0xffff0000u); x2 = __uint_as_float(q2 & 0xffff0000u); x3 = __uint_as_float(q3 & 0xffff0000u); }
          else { x0 = __uint_as_float(q0 << 16); x1 = __uint_as_float(q1 << 16); x2 = __uint_as_float(q2 << 16); x3 = __uint_as_float(q3 << 16); }
          const float oa = silu_f(bb[c] + w0[c] * x0 + w1[c] * x1 + w2[c] * x2);
          const float ob = silu_f(bb[c] + w0[c] * x1 + w1[c] * x2 + w2[c] * x3);
          outw[c][kp] = cvt_pk_bf16(oa, ob);
        }
      }
    } else {
#pragma unroll
      for (int kp = 0; kp < 4; ++kp) {
#pragma unroll
        for (int c = 0; c < 4; ++c) {
          const unsigned q1 = (c >> 1) ? raw[2 * kp + 1].y : raw[2 * kp + 1].x, q2 = (c >> 1) ? raw[2 * kp + 2].y : raw[2 * kp + 2].x;
          outw[c][kp] = (c & 1) ? ((q1 >> 16) | (q2 & 0xffff0000u)) : ((q1 & 0xffffu) | (q2 << 16));
        }
      }
    }
#pragma unroll
    for (int c = 0; c < 4; ++c)
      *(uint4*)(dst + (cg * 4 + c) * SROW + l8 * 16) = make_uint4(outw[c][0], outw[c][1], outw[c][2], outw[c][3]);
  }
}

__device__ __forceinline__ void ssd_stage_tr_s(const Params& p, int row0, bool is_ctx, int pxcol0, int cvcol0, int ncols, unsigned char* dst) {
  for (int e = threadIdx.x; e < ncols * 16; e += NTHR) {
    const int col = e & (ncols - 1), l8 = e / ncols;
    const int rowf = row0 + l8 * 8;
    bool has_prev, has_next;
    if (is_ctx) { const int tc = (rowf - T) & (LC - 1); has_prev = tc > 0; has_next = tc + 7 < LC - 1; }
    else { const int li = rowf & 63; has_prev = li > 0; has_next = li + 7 < 63; }
    const bf16_t* src = p.PXb + (size_t)rowf * DP + pxcol0 + col;
    float x[10];
    x[0] = (cvcol0 >= 0 && has_prev) ? bf2f(src[-DP]) : 0.f;
#pragma unroll
    for (int k = 0; k < 8; ++k) x[k + 1] = bf2f(src[(size_t)k * DP]);
    x[9] = (cvcol0 >= 0 && has_next) ? bf2f(src[(size_t)8 * DP]) : 0.f;
    float o[8];
    if (cvcol0 >= 0) {
      const float w0 = p.ssd_conv_w[cvcol0 + col], w1 = p.ssd_conv_w[DXBC + cvcol0 + col], w2 = p.ssd_conv_w[2 * DXBC + cvcol0 + col], bb = p.ssd_conv_b[cvcol0 + col];
#pragma unroll
      for (int k = 0; k < 8; ++k) o[k] = silu_f(bb + w0 * x[k] + w1 * x[k + 1] + w2 * x[k + 2]);
    } else {
#pragma unroll
      for (int k = 0; k < 8; ++k) o[k] = x[k + 1];
    }
    uint4 w; w.x = cvt_pk_bf16(o[0], o[1]); w.y = cvt_pk_bf16(o[2], o[3]); w.z = cvt_pk_bf16(o[4], o[5]); w.w = cvt_pk_bf16(o[6], o[7]);
    *(uint4*)(dst + col * SROW + l8 * 16) = w;
  }
}

__device__ void ssd_states_unit(const Params& p, int unit, unsigned char* lds) {
  const int tid = threadIdx.x, wid = __builtin_amdgcn_readfirstlane(tid >> 6), lane = tid & 63;
  const int g = unit & 1, bc = unit >> 1, cidx = bc % 18, b = bc / 18;
  const bool is_ctx = cidx < 2;
  const int row0 = is_ctx ? (T + b * LC + cidx * 128) : (b * L + (cidx - 2) * 128);
  unsigned char* XT = lds;
  unsigned char* BT = lds + 69632;
  unsigned char* XD = lds + 104448;
  float* WG = (float*)(lds + 121856);
  ssd_stage_tr(p, row0, is_ctx, COL_XBC + g * 256, g * 256, 256, XT);
  ssd_stage_tr(p, row0, is_ctx, COL_XBC + 512 + g * 128, 512 + g * 128, 128, BT);
  {
    const int dir = wid >> 2, hh = wid & 3, h = g * 4 + hh;
    const float A = expf(p.a_log[dir * 8 + h]);
    const int l0 = 2 * lane, l1 = l0 + 1;
    const float dt0 = softplus_f(p.DT[(size_t)(row0 + l0) * 16 + dir * 8 + h]), dt1 = softplus_f(p.DT[(size_t)(row0 + l1) * 16 + dir * 8 + h]);
    const float a0 = -A * dt0, a1 = -A * dt1, pair = a0 + a1;
    float incl = pair;
#pragma unroll
    for (int o = 1; o < 64; o <<= 1) { float t = __shfl_up(incl, o); if (lane >= o) incl += t; }
    const float excl = incl - pair;
    const float total = __shfl(incl, 63);
    float w0, w1, c0, c1;
    if (dir == 0) { c0 = excl + a0; c1 = excl + pair; w0 = dt0 * expf(total - c0); w1 = dt1 * expf(total - c1); }
    else { const float pe0 = excl, pe1 = excl + a0; w0 = dt0 * expf(pe0); w1 = dt1 * expf(pe1); c0 = total - pe0; c1 = total - pe1; }
    WG[wid * 128 + l0] = w0; WG[wid * 128 + l1] = w1;
    if (!is_ctx) { float* ac = p.ACUM + (size_t)(b * 16 + dir * 8 + h) * L + (cidx - 2) * 128; *(float2*)(ac + l0) = make_float2(c0, c1); }
    if (lane == 0) {
      const int k = dir ? (is_ctx ? (1 - cidx) : (19 - cidx)) : cidx;
      p.CDEC[(size_t)(((b * 2 + dir) * 8 + h) * 18 + k) * 32] = expf(total);
    }
  }
  __syncthreads();
  const int fr = lane & 15, fq = lane >> 4;
#pragma unroll 1
  for (int it = 0; it < 8; ++it) {
    const int dir = it >> 2, hh = it & 3, h = g * 4 + hh;
    for (int e = tid; e < 1024; e += NTHR) {
      const int pr = e >> 4, ch = e & 15;
      const uint4 v = *(const uint4*)(XT + (hh * 64 + pr) * SROW + ch * 16);
      const float4 wa = *(const float4*)(WG + it * 128 + ch * 8), wb = *(const float4*)(WG + it * 128 + ch * 8 + 4);
      uint4 w;
      w.x = cvt_pk_bf16(__uint_as_float(v.x << 16) * wa.x, __uint_as_float(v.x & 0xffff0000u) * wa.y);
      w.y = cvt_pk_bf16(__uint_as_float(v.y << 16) * wa.z, __uint_as_float(v.y & 0xffff0000u) * wa.w);
      w.z = cvt_pk_bf16(__uint_as_float(v.z << 16) * wb.x, __uint_as_float(v.z & 0xffff0000u) * wb.y);
      w.w = cvt_pk_bf16(__uint_as_float(v.w << 16) * wb.z, __uint_as_float(v.w & 0xffff0000u) * wb.w);
      *(uint4*)(XD + pr * SROW + ch * 16) = w;
    }
    __syncthreads();
    hf32x4 acc[4];
#pragma unroll
    for (int pt = 0; pt < 4; ++pt) acc[pt] = (hf32x4){0.f, 0.f, 0.f, 0.f};
#pragma unroll
    for (int kk = 0; kk < 4; ++kk) {
      const hbf16x8 Bf = *(const hbf16x8*)(BT + (16 * wid + fr) * SROW + 2 * (32 * kk + 8 * fq));
#pragma unroll
      for (int pt = 0; pt < 4; ++pt) {
        const hbf16x8 Af = *(const hbf16x8*)(XD + (16 * pt + fr) * SROW + 2 * (32 * kk + 8 * fq));
        acc[pt] = __builtin_amdgcn_mfma_f32_16x16x32_bf16(Bf, Af, acc[pt], 0, 0, 0);
      }
    }
    const int k = dir ? (is_ctx ? (1 - cidx) : (19 - cidx)) : cidx;
    bf16_t* slot = p.SST + ((size_t)(((b * 2 + dir) * 8 + h) * 18 + k)) * 8192;
#pragma unroll
    for (int pt = 0; pt < 4; ++pt)
      *(uint2*)(slot + (16 * pt + fr) * 128 + 16 * wid + 4 * fq) = make_uint2(cvt_pk_bf16(acc[pt][0], acc[pt][1]), cvt_pk_bf16(acc[pt][2], acc[pt][3]));
    __syncthreads();
  }
}

__device__ void ssd_scan_unit(const Params& p, int unit) {
  const int tid = threadIdx.x;
  const int half = unit & 1, seq = unit >> 1;
  const int pr = half * 32 + (tid >> 4), n8 = (tid & 15) * 8;
  const bf16_t* base = p.SST + (size_t)seq * 18 * 8192 + pr * 128 + n8;
  uint4 sv[18];
#pragma unroll
  for (int k = 0; k < 18; ++k) sv[k] = *(const uint4*)(base + (size_t)k * 8192);
  float hst[8];
#pragma unroll
  for (int j = 0; j < 8; ++j) hst[j] = 0.f;
#pragma unroll
  for (int k = 0; k < 18; ++k) {
    const float dec = p.CDEC[(size_t)(seq * 18 + k) * 32];
    if (k >= 2) {
      uint4 w; w.x = cvt_pk_bf16(hst[0], hst[1]); w.y = cvt_pk_bf16(hst[2], hst[3]); w.z = cvt_pk_bf16(hst[4], hst[5]); w.w = cvt_pk_bf16(hst[6], hst[7]);
      *(uint4*)(p.HIN + ((size_t)seq * 16 + (k - 2)) * 8192 + pr * 128 + n8) = w;
    }
    const unsigned sw[4] = {sv[k].x, sv[k].y, sv[k].z, sv[k].w};
#pragma unroll
    for (int u = 0; u < 4; ++u) {
      hst[2 * u] = dec * hst[2 * u] + __uint_as_float(sw[u] << 16);
      hst[2 * u + 1] = dec * hst[2 * u + 1] + __uint_as_float(sw[u] & 0xffff0000u);
    }
  }
}

__device__ void ssd_out_unit(const Params& p, int unit, unsigned char* lds) {
  const int tid = threadIdx.x, wid = __builtin_amdgcn_readfirstlane(tid >> 6), lane = tid & 63;
  const int fr = lane & 15, fq = lane >> 4;
  const int g = unit & 1, bc = unit >> 1, c = bc & 15, b = bc >> 4;
  const int row0 = b * L + c * 128;
  unsigned char* CS = lds;
  unsigned char* ML = lds + 34816;
  unsigned char* XT = lds + 69632;
  unsigned char* ZT = lds + 87040;
  unsigned char* HS = lds + 104448;
  float* CUM = (float*)(lds + 121856);
  float* DTL = (float*)(lds + 125952);
  ssd_stage_nat(p, row0, COL_XBC + 768 + g * 128, 768 + g * 128, CS);
  ssd_stage_nat(p, row0, COL_XBC + 512 + g * 128, 512 + g * 128, ML);
  for (int e = tid; e < 1024; e += NTHR) {
    const int it = e >> 7, l = e & 127, dir = it >> 2, hh = it & 3;
    CUM[e] = p.ACUM[(size_t)(b * 16 + dir * 8 + g * 4 + hh) * L + c * 128 + l];
    DTL[e] = softplus_f(p.DT[(size_t)(row0 + l) * 16 + dir * 8 + g * 4 + hh]);
  }
  __syncthreads();
  hf32x4 cbt[8];
#pragma unroll
  for (int lt = 0; lt < 8; ++lt) cbt[lt] = (hf32x4){0.f, 0.f, 0.f, 0.f};
#pragma unroll
  for (int kk = 0; kk < 4; ++kk) {
    const hbf16x8 Af = *(const hbf16x8*)(ML + (16 * wid + fr) * SROW + 2 * (32 * kk + 8 * fq));
#pragma unroll
    for (int lt = 0; lt < 8; ++lt) {
      const hbf16x8 Bf = *(const hbf16x8*)(CS + (16 * lt + fr) * SROW + 2 * (32 * kk + 8 * fq));
      cbt[lt] = __builtin_amdgcn_mfma_f32_16x16x32_bf16(Af, Bf, cbt[lt], 0, 0, 0);
    }
  }
  __syncthreads();
  hf32x4 y[4][4];
#pragma unroll
  for (int hh = 0; hh < 4; ++hh)
#pragma unroll
    for (int pt = 0; pt < 4; ++pt) y[hh][pt] = (hf32x4){0.f, 0.f, 0.f, 0.f};
  const int sb = 16 * wid + 4 * fq;
#pragma unroll 1
  for (int hh = 0; hh < 4; ++hh) {
    const int h = g * 4 + hh;
    hf32x4 yc[4];
#pragma unroll
    for (int pt = 0; pt < 4; ++pt) yc[pt] = (hf32x4){0.f, 0.f, 0.f, 0.f};
    ssd_stage_tr_s(p, row0, false, COL_XBC + g * 256 + hh * 64, g * 256 + hh * 64, 64, XT);
    ssd_stage_tr_s(p, row0, false, COL_Z + g * 256 + hh * 64, -1, 64, ZT);
#pragma unroll 1
    for (int dir = 0; dir < 2; ++dir) {
      const int it = dir * 4 + hh;
      const int k = dir ? (17 - c) : (c + 2);
      const bf16_t* slot = p.HIN + ((size_t)(((b * 2 + dir) * 8 + h) * 16 + (k - 2))) * 8192;
      for (int e = tid; e < 1024; e += NTHR) {
        const int pr = e >> 4, ch = e & 15;
        *(uint4*)(HS + pr * SROW + ch * 16) = *(const uint4*)(slot + pr * 128 + ch * 8);
      }
      {
        const float* cu = CUM + it * 128; const float* dl = DTL + it * 128;
        float cs[4], ds[4];
#pragma unroll
        for (int r = 0; r < 4; ++r) { cs[r] = cu[sb + r]; ds[r] = dl[sb + r]; }
#pragma unroll
        for (int lt = 0; lt < 8; ++lt) {
          const int l = 16 * lt + fr;
          const float cl = cu[l];
          float m[4];
#pragma unroll
          for (int r = 0; r < 4; ++r) {
            const int sidx = sb + r;
            const bool ok = dir ? (sidx >= l) : (sidx <= l);
            m[r] = ok ? cbt[lt][r] * __expf(cl - cs[r]) * ds[r] : 0.f;
          }
          uint2 w; w.x = cvt_pk_bf16(m[0], m[1]); w.y = cvt_pk_bf16(m[2], m[3]);
          *(uint2*)(ML + l * SROW + 2 * sb) = w;
        }
      }
      __syncthreads();
      hf32x4 ad[4], ao[4];
#pragma unroll
      for (int pt = 0; pt < 4; ++pt) { ad[pt] = (hf32x4){0.f, 0.f, 0.f, 0.f}; ao[pt] = (hf32x4){0.f, 0.f, 0.f, 0.f}; }
#pragma unroll
      for (int kk = 0; kk < 4; ++kk) {
        const hbf16x8 Am = *(const hbf16x8*)(ML + (16 * wid + fr) * SROW + 2 * (32 * kk + 8 * fq));
        const hbf16x8 Ac = *(const hbf16x8*)(CS + (16 * wid + fr) * SROW + 2 * (32 * kk + 8 * fq));
#pragma unroll
        for (int pt = 0; pt < 4; ++pt) {
          const hbf16x8 Bx = *(const hbf16x8*)(XT + (16 * pt + fr) * SROW + 2 * (32 * kk + 8 * fq));
          const hbf16x8 Bh = *(const hbf16x8*)(HS + (16 * pt + fr) * SROW + 2 * (32 * kk + 8 * fq));
          ad[pt] = __builtin_amdgcn_mfma_f32_16x16x32_bf16(Am, Bx, ad[pt], 0, 0, 0);
          ao[pt] = __builtin_amdgcn_mfma_f32_16x16x32_bf16(Ac, Bh, ao[pt], 0, 0, 0);
        }
      }
      {
        const float* cu = CUM + it * 128;
        float ex[4];
#pragma unroll
        for (int r = 0; r < 4; ++r) ex[r] = __expf(cu[sb + r]);
#pragma unroll
        for (int pt = 0; pt < 4; ++pt)
#pragma unroll
          for (int r = 0; r < 4; ++r) yc[pt][r] += ad[pt][r] + ex[r] * ao[pt][r];
      }
      __syncthreads();
    }
    {
      const float dsk = p.ssd_d[h];
#pragma unroll
      for (int pt = 0; pt < 4; ++pt) {
        const uint2 xv = *(const uint2*)(XT + (16 * pt + fr) * SROW + 2 * sb);
        const uint2 zv = *(const uint2*)(ZT + (16 * pt + fr) * SROW + 2 * sb);
        const float xs4[4] = {__uint_as_float(xv.x << 16), __uint_as_float(xv.x & 0xffff0000u), __uint_as_float(xv.y << 16), __uint_as_float(xv.y & 0xffff0000u)};
        const float zs4[4] = {__uint_as_float(zv.x << 16), __uint_as_float(zv.x & 0xffff0000u), __uint_as_float(zv.y << 16), __uint_as_float(zv.y & 0xffff0000u)};
#pragma unroll
        for (int r = 0; r < 4; ++r) yc[pt][r] = (yc[pt][r] + dsk * xs4[r]) * silu_f(zs4[r]);
      }
    }
    if (hh == 0) {
#pragma unroll
      for (int pt = 0; pt < 4; ++pt) y[0][pt] = yc[pt];
    } else if (hh == 1) {
#pragma unroll
      for (int pt = 0; pt < 4; ++pt) y[1][pt] = yc[pt];
    } else if (hh == 2) {
#pragma unroll
      for (int pt = 0; pt < 4; ++pt) y[2][pt] = yc[pt];
    } else {
#pragma unroll
      for (int pt = 0; pt < 4; ++pt) y[3][pt] = yc[pt];
    }
    __syncthreads();
  }
  float rinv[4];
#pragma unroll
  for (int r = 0; r < 4; ++r) {
    float ss = 0.f;
#pragma unroll
    for (int hh = 0; hh < 4; ++hh)
#pragma unroll
      for (int pt = 0; pt < 4; ++pt) ss += y[hh][pt][r] * y[hh][pt][r];
    ss += __shfl_xor(ss, 1); ss += __shfl_xor(ss, 2); ss += __shfl_xor(ss, 4); ss += __shfl_xor(ss, 8);
    rinv[r] = rsqrtf(ss * (1.f / 256.f) + EPS);
  }
  {
    bf16_t* OT = (bf16_t*)lds;
#pragma unroll
    for (int hh = 0; hh < 4; ++hh)
#pragma unroll
      for (int pt = 0; pt < 4; ++pt) {
        const int chl = hh * 64 + 16 * pt + fr;
        const float ng = p.ssd_norm_g[g * 256 + chl];
#pragma unroll
        for (int r = 0; r < 4; ++r) OT[(sb + r) * 264 + chl] = f2bf(y[hh][pt][r] * rinv[r] * ng);
      }
    __syncthreads();
    for (int e = tid; e < 128 * 32; e += NTHR) {
      const int l = e >> 5, ch8 = (e & 31) * 8;
      *(uint4*)(p.YMIXb + (size_t)(row0 + l) * D + 512 + g * 256 + ch8) = *(const uint4*)(OT + l * 264 + ch8);
    }
  }
}

__device__ void ph_router(const Params& p, unsigned char* lds) {
  const int tid = threadIdx.x, wid = __builtin_amdgcn_readfirstlane(tid >> 6), lane = tid & 63;
  const int fr = lane & 15, fq = lane >> 4;
  constexpr int AROW = 272;
  unsigned char* AH = lds;
  unsigned char* AL = lds + 64 * AROW;
  unsigned char* WH = lds + 128 * AROW;
  unsigned char* WL = lds + 224 * AROW;
  float* RS = (float*)(lds + 320 * AROW);
  float* LOG = RS + 64;
  float* GM = LOG + 6400;
  float* SH = GM + 1024;
  int* LC = (int*)(SH + 1024);
  int* LB = LC + 64;
  for (int tile = blockIdx.x; tile < T / 64; tile += gridDim.x) {
    const int row0 = tile * 64;
    const float* shp = p.MOD + (row0 / L) * 6144 + 3072;
    const float* scp = shp + 1024;
    if (tid < 64) {
      const float4* sp = (const float4*)(p.SSQP + (size_t)(row0 + tid) * 16);
      const float4 a0 = sp[0], a1 = sp[1], a2 = sp[2], a3 = sp[3];
      const float ss = ((a0.x + a0.y) + (a0.z + a0.w)) + ((a1.x + a1.y) + (a1.z + a1.w)) + ((a2.x + a2.y) + (a2.z + a2.w)) + ((a3.x + a3.y) + (a3.z + a3.w));
      RS[tid] = rsqrtf(ss * (1.f / D) + EPS);
    }
    for (int e = tid; e < 256; e += NTHR) {
      const float4 g = *(const float4*)(p.g2 + e * 4), s4 = *(const float4*)(scp + e * 4), h4 = *(const float4*)(shp + e * 4);
      *(float4*)(GM + e * 4) = make_float4(g.x * (1.f + s4.x), g.y * (1.f + s4.y), g.z * (1.f + s4.z), g.w * (1.f + s4.w));
      *(float4*)(SH + e * 4) = h4;
    }
    float4 xv[4];
#pragma unroll
    for (int i = 0; i < 4; ++i) { const int e = tid + i * NTHR; xv[i] = *(const float4*)(p.X1 + (size_t)(row0 + (e >> 5)) * D + (e & 31) * 4); }
    const int wj = tid >> 4, wch = tid & 15;
    uint4 wh0, wh1, wh2, wl0, wl1, wl2;
#define RT_LOADW(kn) do { \
      wh0 = *(const uint4*)(p.WRhi + (size_t)(wj) * 1024 + (kn) * 128 + wch * 8); wl0 = *(const uint4*)(p.WRlo + (size_t)(wj) * 1024 + (kn) * 128 + wch * 8); \
      wh1 = *(const uint4*)(p.WRhi + (size_t)(wj + 32) * 1024 + (kn) * 128 + wch * 8); wl1 = *(const uint4*)(p.WRlo + (size_t)(wj + 32) * 1024 + (kn) * 128 + wch * 8); \
      wh2 = *(const uint4*)(p.WRhi + (size_t)(wj + 64) * 1024 + (kn) * 128 + wch * 8); wl2 = *(const uint4*)(p.WRlo + (size_t)(wj + 64) * 1024 + (kn) * 128 + wch * 8); } while (0)
    RT_LOADW(0);
    __syncthreads();
    hf32x4 acc[3];
#pragma unroll
    for (int nt = 0; nt < 3; ++nt) acc[nt] = (hf32x4){0.f, 0.f, 0.f, 0.f};
    const int mt = wid & 3, nh = wid >> 2;
#pragma unroll 1
    for (int kc = 0; kc < 8; ++kc) {
#pragma unroll
      for (int i = 0; i < 4; ++i) {
        const int e = tid + i * NTHR; const int tok = e >> 5, k4 = (e & 31) * 4;
        const int kg = kc * 128 + k4;
        const float4 v = xv[i];
        const float4 g = *(const float4*)(GM + kg);
        const float4 h4 = *(const float4*)(SH + kg);
        const float rstd = RS[tok];
        const float h0 = v.x * rstd * g.x + h4.x, h1 = v.y * rstd * g.y + h4.y;
        const float h2 = v.z * rstd * g.z + h4.z, h3 = v.w * rstd * g.w + h4.w;
        const unsigned hi01 = cvt_pk_bf16(h0, h1), hi23 = cvt_pk_bf16(h2, h3);
        const unsigned lo01 = cvt_pk_bf16(h0 - __uint_as_float(hi01 << 16), h1 - __uint_as_float(hi01 & 0xffff0000u));
        const unsigned lo23 = cvt_pk_bf16(h2 - __uint_as_float(hi23 << 16), h3 - __uint_as_float(hi23 & 0xffff0000u));
        *(uint2*)(AH + tok * AROW + k4 * 2) = make_uint2(hi01, hi23);
        *(uint2*)(AL + tok * AROW + k4 * 2) = make_uint2(lo01, lo23);
        *(uint2*)(p.H2b + (size_t)(row0 + tok) * D + kg) = make_uint2(hi01, hi23);
      }
      *(uint4*)(WH + wj * AROW + wch * 16) = wh0; *(uint4*)(WL + wj * AROW + wch * 16) = wl0;
      *(uint4*)(WH + (wj + 32) * AROW + wch * 16) = wh1; *(uint4*)(WL + (wj + 32) * AROW + wch * 16) = wl1;
      *(uint4*)(WH + (wj + 64) * AROW + wch * 16) = wh2; *(uint4*)(WL + (wj + 64) * AROW + wch * 16) = wl2;
      {
        const int kn = (kc + 1 < 8) ? (kc + 1) : kc;
#pragma unroll
        for (int i = 0; i < 4; ++i) { const int e = tid + i * NTHR; xv[i] = *(const float4*)(p.X1 + (size_t)(row0 + (e >> 5)) * D + kn * 128 + (e & 31) * 4); }
        RT_LOADW(kn);
      }
      __syncthreads();
#pragma unroll
      for (int kk = 0; kk < 4; ++kk) {
        const hbf16x8 Ahi = *(const hbf16x8*)(AH + (16 * mt + fr) * AROW + 2 * (32 * kk + 8 * fq));
        const hbf16x8 Alo = *(const hbf16x8*)(AL + (16 * mt + fr) * AROW + 2 * (32 * kk + 8 * fq));
#pragma unroll
        for (int nt = 0; nt < 3; ++nt) {
          const int wo = (16 * (nh * 3 + nt) + fr) * AROW + 2 * (32 * kk + 8 * fq);
          const hbf16x8 Bhi = *(const hbf16x8*)(WH + wo);
          const hbf16x8 Blo = *(const hbf16x8*)(WL + wo);
          acc[nt] = __builtin_amdgcn_mfma_f32_16x16x32_bf16(Ahi, Bhi, acc[nt], 0, 0, 0);
          acc[nt] = __builtin_amdgcn_mfma_f32_16x16x32_bf16(Ahi, Blo, acc[nt], 0, 0, 0);
          acc[nt] = __builtin_amdgcn_mfma_f32_16x16x32_bf16(Alo, Bhi, acc[nt], 0, 0, 0);
        }
      }
      __syncthreads();
    }
    if (tid < 64) LC[tid] = 0;
#pragma unroll
    for (int nt = 0; nt < 3; ++nt)
#pragma unroll
      for (int r = 0; r < 4; ++r) LOG[(16 * mt + 4 * fq + r) * 100 + 16 * (nh * 3 + nt) + fr] = acc[nt][r];
    __syncthreads();
    int ea = 0, eb = 0, sa = 0, sb2 = 0;
    if (tid < 64) {
      const float* lg = LOG + tid * 100;
      const int row = row0 + tid;
      int gs = 0; float gm = lg[64] + p.b_group[0];
      float gl[8];
      gl[0] = gm;
#pragma unroll
      for (int j = 1; j < 8; ++j) { gl[j] = lg[64 + j] + p.b_group[j]; if (gl[j] > gm) { gm = gl[j]; gs = j; } }
      float den = 0.f;
#pragma unroll
      for (int j = 0; j < 8; ++j) den += expf(gl[j] - gm);
      const float pg = 1.f / den;
      float el[8];
#pragma unroll
      for (int j = 0; j < 8; ++j) el[j] = 0.f;
      for (int j = 0; j < 8; ++j) el[j] = lg[gs * 8 + j] + p.b_expert[gs * 8 + j];
      int i0 = 0; float l0 = el[0];
#pragma unroll
      for (int j = 1; j < 8; ++j) if (el[j] > l0) { l0 = el[j]; i0 = j; }
      int i1 = -1; float l1 = -3.0e38f;
#pragma unroll
      for (int j = 0; j < 8; ++j) if (j != i0 && el[j] > l1) { l1 = el[j]; i1 = j; }
      const float e1 = expf(l1 - l0);
      const float w0 = 1.f / (1.f + e1), w1 = e1 / (1.f + e1);
      p.GATE[row * 2 + 0] = w0 * pg;
      p.GATE[row * 2 + 1] = w1 * pg;
      ea = gs * 8 + i0; eb = gs * 8 + i1;
      sa = atomicAdd(&LC[ea], 1);
      sb2 = atomicAdd(&LC[eb], 1);
    }
    __syncthreads();
    if (tid < 64) { const int n = LC[tid]; LB[tid] = n ? atomicAdd(&p.CNT[tid * 32], n) : 0; }
    __syncthreads();
    if (tid < 64) {
      const int row = row0 + tid;
      p.LIST[ea * T + LB[ea] + sa] = row * 2 + 0;
      p.LIST[eb * T + LB[eb] + sb2] = row * 2 + 1;
    }
    __syncthreads();
  }
}

__device__ __forceinline__ void moe_table(const Params& p, int* tab) {
  if (threadIdx.x == 0) {
    int a = 0, sg = 0;
    for (int e = 0; e < NE; ++e) {
      int cn = p.CNT[e * 32];
      tab[e] = a; tab[65 + e] = sg; tab[130 + e] = cn;
      a += (cn + 255) >> 8; sg += ((cn + 127) >> 7) << 7;
    }
    tab[NE] = a; tab[65 + NE] = sg;
  }
  __syncthreads();
}

template <bool UP>
__device__ void moe_gemm_phase(const Params& p, unsigned char* lds, PG8_LAS unsigned char* ldsl, const int* tab) {
  constexpr int K = UP ? 1024 : 512;
  constexpr int NKT = K / 64;
  constexpr int LDB = UP ? 512 : 1024;
  const int tid = threadIdx.x, wid = __builtin_amdgcn_readfirstlane(tid >> 6), lane = tid & 63, fr = lane & 15, fq = lane >> 4;
  const int wm = wid >> 1, wn = wid & 1;
  constexpr int AOFF0 = 0, AOFF1 = 32768, BOFF0 = 65536, BOFF1 = 65536 + 128 * 144;
  const int total = tab[64] * 8;
  for (int ui = blockIdx.x; ui < total; ui += gridDim.x) {
   {
    int e = 0;
    while (tab[e + 1] * 8 <= ui) ++e;
    const int local = ui - tab[e] * 8;
    const int mu = local >> 3, nt = local & 7;
    const int cnt = tab[130 + e], seg = tab[65 + e];
    const int rem = cnt - mu * 256;
    const bool full = rem > 128;
    const bool active = full || wm < 2;
    unsigned aoffs[4];
#pragma unroll
    for (int i = 0; i < 4; ++i) {
      const int row = (tid >> 3) + 64 * i;
      int idx = mu * 256 + row;
      unsigned rowb;
      if (UP) { if (idx > cnt - 1) idx = cnt - 1; rowb = (unsigned)(p.LIST[e * T + idx] >> 1) * (unsigned)(K * 2); }
      else rowb = (unsigned)(seg + idx) * (unsigned)(K * 2);
      aoffs[i] = rowb + (unsigned)(((tid & 7) ^ (row & 7)) * 16);
    }
    const char* Abase = UP ? (const char*)p.H2b : (const char*)p.HBb;
    const float* bsrc;
    if (UP) bsrc = ((lane < 32) ? p.w1 : p.w3) + (size_t)e * 1024 * 512 + nt * 64 + 2 * (lane & 31) + (size_t)(8 * wid) * LDB;
    else bsrc = p.w2 + (size_t)e * 512 * 1024 + nt * 128 + 2 * lane + (size_t)(8 * wid) * LDB;
    hf32x4 acc[4][4];
#pragma unroll
    for (int m = 0; m < 4; ++m)
#pragma unroll
      for (int j = 0; j < 4; ++j) acc[m][j] = (hf32x4){0.f, 0.f, 0.f, 0.f};
    uint4 P0a0, P0a1, P0a2, P0a3, P1a0, P1a1, P1a2, P1a3;
    float2 P0b0, P0b1, P0b2, P0b3, P0b4, P0b5, P0b6, P0b7, P1b0, P1b1, P1b2, P1b3, P1b4, P1b5, P1b6, P1b7;
    const int srow = tid >> 3, spc = tid & 7;
#define MG_LOAD(kt, S) do { \
      S##a0 = *(const uint4*)(Abase + aoffs[0] + (kt) * 128); S##a1 = *(const uint4*)(Abase + aoffs[1] + (kt) * 128); \
      S##a2 = *(const uint4*)(Abase + aoffs[2] + (kt) * 128); S##a3 = *(const uint4*)(Abase + aoffs[3] + (kt) * 128); \
      S##b0 = *(const float2*)(bsrc + (size_t)((kt) * 64 + 0) * LDB); S##b1 = *(const float2*)(bsrc + (size_t)((kt) * 64 + 1) * LDB); \
      S##b2 = *(const float2*)(bsrc + (size_t)((kt) * 64 + 2) * LDB); S##b3 = *(const float2*)(bsrc + (size_t)((kt) * 64 + 3) * LDB); \
      S##b4 = *(const float2*)(bsrc + (size_t)((kt) * 64 + 4) * LDB); S##b5 = *(const float2*)(bsrc + (size_t)((kt) * 64 + 5) * LDB); \
      S##b6 = *(const float2*)(bsrc + (size_t)((kt) * 64 + 6) * LDB); S##b7 = *(const float2*)(bsrc + (size_t)((kt) * 64 + 7) * LDB); } while (0)
#define MG_WRITE(aoff, boff, S) do { \
      *(uint4*)(lds + (aoff) + (srow) * 128 + spc * 16) = S##a0; *(uint4*)(lds + (aoff) + (srow + 64) * 128 + spc * 16) = S##a1; \
      if (full) { *(uint4*)(lds + (aoff) + (srow + 128) * 128 + spc * 16) = S##a2; *(uint4*)(lds + (aoff) + (srow + 192) * 128 + spc * 16) = S##a3; } \
      *(uint4*)(lds + (boff) + (2 * lane) * 144 + 16 * wid) = make_uint4(cvt_pk_bf16(S##b0.x, S##b1.x), cvt_pk_bf16(S##b2.x, S##b3.x), cvt_pk_bf16(S##b4.x, S##b5.x), cvt_pk_bf16(S##b6.x, S##b7.x)); \
      *(uint4*)(lds + (boff) + (2 * lane + 1) * 144 + 16 * wid) = make_uint4(cvt_pk_bf16(S##b0.y, S##b1.y), cvt_pk_bf16(S##b2.y, S##b3.y), cvt_pk_bf16(S##b4.y, S##b5.y), cvt_pk_bf16(S##b6.y, S##b7.y)); } while (0)
#define MG_MMA(aoff, boff) do { if (active) { \
      _Pragma("unroll") for (int kk = 0; kk < 2; ++kk) { \
        hbf16x8 Af[4], Bf[4]; \
        _Pragma("unroll") for (int m = 0; m < 4; ++m) Af[m] = *(const hbf16x8*)(lds + (aoff) + (64 * wm + 16 * m + fr) * 128 + (((4 * kk + fq) ^ (fr & 7)) * 16)); \
        _Pragma("unroll") for (int j = 0; j < 4; ++j) { \
          const int nrow = UP ? ((j < 2) ? (32 * wn + 16 * j + fr) : (64 + 32 * wn + 16 * (j - 2) + fr)) : (64 * wn + 16 * j + fr); \
          Bf[j] = *(const hbf16x8*)(lds + (boff) + nrow * 144 + 2 * (32 * kk + 8 * fq)); } \
        _Pragma("unroll") for (int m = 0; m < 4; ++m) _Pragma("unroll") for (int j = 0; j < 4; ++j) \
          acc[m][j] = __builtin_amdgcn_mfma_f32_16x16x32_bf16(Bf[j], Af[m], acc[m][j], 0, 0, 0); } } } while (0)
    MG_LOAD(0, P0);
    MG_LOAD(1, P1);
    MG_WRITE(AOFF0, BOFF0, P0);
    __syncthreads();
#pragma unroll 1
    for (int kt = 0; kt < NKT; kt += 2) {
      if (kt + 2 < NKT) MG_LOAD(kt + 2, P0);
      MG_MMA(AOFF0, BOFF0);
      MG_WRITE(AOFF1, BOFF1, P1);
      __syncthreads();
      if (kt + 3 < NKT) MG_LOAD(kt + 3, P1);
      MG_MMA(AOFF1, BOFF1);
      if (kt + 2 < NKT) MG_WRITE(AOFF0, BOFF0, P0);
      __syncthreads();
    }
#undef MG_LOAD
#undef MG_WRITE
#undef MG_MMA
    if (active) {
#pragma unroll
      for (int m = 0; m < 4; ++m) {
        const int slot = mu * 256 + 64 * wm + 16 * m + fr;
        if (slot < cnt) {
          if (UP) {
            bf16_t* hp = p.HBb + (size_t)(seg + slot) * DE + nt * 64 + 32 * wn + 4 * fq;
#pragma unroll
            for (int j = 0; j < 2; ++j) {
              float h[4];
#pragma unroll
              for (int r = 0; r < 4; ++r) { const float a = acc[m][j][r]; h[r] = a / (1.f + __expf(-a)) * acc[m][j + 2][r]; }
              *(uint2*)(hp + 16 * j) = make_uint2(cvt_pk_bf16(h[0], h[1]), cvt_pk_bf16(h[2], h[3]));
            }
          } else {
            const int pair = p.LIST[e * T + slot];
            const float gt = p.GATE[pair];
            bf16_t* yp = p.YB2b + (size_t)pair * D + nt * 128 + 64 * wn + 4 * fq;
#pragma unroll
            for (int j = 0; j < 4; ++j)
              *(uint2*)(yp + 16 * j) = make_uint2(cvt_pk_bf16(gt * acc[m][j][0], gt * acc[m][j][1]), cvt_pk_bf16(gt * acc[m][j][2], gt * acc[m][j][3]));
          }
        }
      }
    }
   }
  }
}

__device__ void ph_final(const Params& p) {
  const int tid = threadIdx.x, wid = tid >> 6, lane = tid & 63;
  for (int row = blockIdx.x * 8 + wid; row < T; row += gridDim.x * 8) {
    const float* ga2 = p.MOD + (row / L) * 6144 + 5120;
    float4 v[4];
    float ss = 0.f;
#pragma unroll
    for (int i = 0; i < 4; ++i) {
      const int col = i * 256 + lane * 4;
      float4 xv = *(const float4*)(p.X1 + (size_t)row * D + col);
      uint2 a = *(const uint2*)(p.YB2b + (size_t)(row * 2) * D + col);
      uint2 b = *(const uint2*)(p.YB2b + (size_t)(row * 2 + 1) * D + col);
      float4 ga = *(const float4*)(ga2 + col);
      v[i].x = xv.x + ga.x * (__uint_as_float(a.x << 16) + __uint_as_float(b.x << 16));
      v[i].y = xv.y + ga.y * (__uint_as_float(a.x & 0xffff0000u) + __uint_as_float(b.x & 0xffff0000u));
      v[i].z = xv.z + ga.z * (__uint_as_float(a.y << 16) + __uint_as_float(b.y << 16));
      v[i].w = xv.w + ga.w * (__uint_as_float(a.y & 0xffff0000u) + __uint_as_float(b.y & 0xffff0000u));
      ss += v[i].x * v[i].x + v[i].y * v[i].y + v[i].z * v[i].z + v[i].w * v[i].w;
    }
    ss = wave_sum(ss);
    const float rstd = rsqrtf(ss * (1.f / D) + EPS);
#pragma unroll
    for (int i = 0; i < 4; ++i) {
      const int col = i * 256 + lane * 4;
      float4 gf = *(const float4*)(p.g_final + col);
      float4 o;
      o.x = v[i].x * rstd * gf.x; o.y = v[i].y * rstd * gf.y; o.z = v[i].z * rstd * gf.z; o.w = v[i].w * rstd * gf.w;
      *(float4*)(p.out + (size_t)row * D + col) = o;
    }
  }
}

constexpr int NPHASE = 11;

__global__ void __launch_bounds__(NTHR, 2) mega(Params p) {
  extern __shared__ __attribute__((aligned(16))) unsigned char lds_raw[];
  float* sm = (float*)lds_raw;
  PG8_LAS unsigned char* lds = (PG8_LAS unsigned char*)lds_raw;
  const int lo = p.lo, hi = p.hi;
  volatile LAS unsigned* xbst = (volatile LAS unsigned*)(lds + pg8::STAGE_BYTES + 2048);
  if (threadIdx.x < 4) xbst[threadIdx.x] = 0u;
  __syncthreads();
  XcdBarrier xbar; xbar.bar = p.BAR; xbar.x = 0; xbar.st = xbst;
  if (hi - lo > 1) xbar = xcd_barrier_post(p.BAR, xbst);
#define IN(k) (lo <= (k) && (k) < hi)
#define SYNC(k) do { if (IN(k) && IN((k) + 1)) xcd_barrier(xbar); } while (0)
#ifndef DUPK
#define DUPK -1
#endif
#ifndef SKIP_OTHER
  if (IN(0)) { ph_adaln(p, sm); ph_filters(p, sm); ph_wcvt(p, sm); }
#if DUPK == 0
  xcd_barrier(xbar);
  if (IN(0)) { ph_adaln(p, sm); ph_filters(p, sm); ph_wcvt(p, sm); }
#endif
  SYNC(0);
  if (IN(1)) ph_norm1(p);
#if DUPK == 1
  xcd_barrier(xbar);
  if (IN(1)) ph_norm1(p);
#endif
  SYNC(1);
#endif
#ifndef SKIP_GEMM
  if (IN(2)) {
    pg8::DenseOrder S{p.XNb, p.WinT, TT / 256, DP / 256 + 1, D, (int)gridDim.x, (int)blockIdx.x};
    pg8::EpiBf16 E{p.PXb, DP, p.DT, p.dt_bias};
    pg8::gemm_phase<pg8::EpiBf16, pg8::DenseOrder>(lds, D, S, E);
  }
#if DUPK == 2
  xcd_barrier(xbar);
  if (IN(2)) {
    pg8::DenseOrder S{p.XNb, p.WinT, TT / 256, DP / 256 + 1, D, (int)gridDim.x, (int)blockIdx.x};
    pg8::EpiBf16 E{p.PXb, DP, p.DT, p.dt_bias};
    pg8::gemm_phase<pg8::EpiBf16, pg8::DenseOrder>(lds, D, S, E);
  }
#endif
  SYNC(2);
#endif
#ifndef SKIP_OTHER
  if (IN(3)) {
    ph_hy_convT(p, sm);
    for (int it = blockIdx.x; it < 288; it += gridDim.x) ssd_states_unit(p, it, lds_raw);
  }
#if DUPK == 3
  xcd_barrier(xbar);
  if (IN(3)) {
    ph_hy_convT(p, sm);
    for (int it = blockIdx.x; it < 288; it += gridDim.x) ssd_states_unit(p, it, lds_raw);
  }
#endif
  SYNC(3);
  if (IN(4)) {
    for (int it = blockIdx.x; it < 256; it += gridDim.x) ssd_scan_unit(p, it);
    for (int it = blockIdx.x; it < 512; it += gridDim.x) hyena_unit(p, it, lds_raw);
  }
#if DUPK == 4
  xcd_barrier(xbar);
  if (IN(4)) {
    for (int it = blockIdx.x; it < 256; it += gridDim.x) ssd_scan_unit(p, it);
    for (int it = blockIdx.x; it < 512; it += gridDim.x) hyena_unit(p, it, lds_raw);
  }
#endif
  SYNC(4);
  if (IN(5)) {
    for (int it = blockIdx.x; it < 256; it += gridDim.x) { ssd_out_unit(p, it, lds_raw); __syncthreads(); }
    ph_hy_backT(p, sm);
  }
#if DUPK == 5
  xcd_barrier(xbar);
  if (IN(5)) {
    for (int it = blockIdx.x; it < 256; it += gridDim.x) { ssd_out_unit(p, it, lds_raw); __syncthreads(); }
    ph_hy_backT(p, sm);
  }
#endif
  SYNC(5);
#endif
#ifndef SKIP_GEMM
  if (IN(6)) {
    pg8::DenseOrder S{p.YMIXb, p.WoutT, T / 256, D / 256, D, (int)gridDim.x, (int)blockIdx.x};
    pg8::EpiX1 E{p.x, p.MOD, p.X1, p.SSQP};
    pg8::gemm_phase<pg8::EpiX1, pg8::DenseOrder>(lds, D, S, E);
  }
#if DUPK == 6
  xcd_barrier(xbar);
  if (IN(6)) {
    pg8::DenseOrder S{p.YMIXb, p.WoutT, T / 256, D / 256, D, (int)gridDim.x, (int)blockIdx.x};
    pg8::EpiX1 E{p.x, p.MOD, p.X1, p.SSQP};
    pg8::gemm_phase<pg8::EpiX1, pg8::DenseOrder>(lds, D, S, E);
  }
#endif
  SYNC(6);
#endif
#ifndef SKIP_OTHER
  if (IN(7)) ph_router(p, lds_raw);
#if DUPK == 7
  xcd_barrier(xbar);
  if (IN(7)) ph_router(p, lds_raw);
#endif
  SYNC(7);
#endif
#ifndef SKIP_GEMM
  if (IN(8)) {
    int* tab = (int*)(lds_raw + pg8::STAGE_BYTES);
    moe_table(p, tab);
    moe_gemm_phase<true>(p, lds_raw, lds, tab);
  }
#if DUPK == 8
  xcd_barrier(xbar);
  if (IN(8)) {
    int* tab = (int*)(lds_raw + pg8::STAGE_BYTES);
    moe_table(p, tab);
    moe_gemm_phase<true>(p, lds_raw, lds, tab);
  }
#endif
  SYNC(8);
  if (IN(9)) {
    int* tab = (int*)(lds_raw + pg8::STAGE_BYTES);
    moe_table(p, tab);
    moe_gemm_phase<false>(p, lds_raw, lds, tab);
  }
#if DUPK == 9
  xcd_barrier(xbar);
  if (IN(9)) {
    int* tab = (int*)(lds_raw + pg8::STAGE_BYTES);
    moe_table(p, tab);
    moe_gemm_phase<false>(p, lds_raw, lds, tab);
  }
#endif
  SYNC(9);
#endif
#ifndef SKIP_OTHER
  if (IN(10)) ph_final(p);
#if DUPK == 10
  xcd_barrier(xbar);
  if (IN(10)) ph_final(p);
#endif
#endif
#undef IN
#undef SYNC
}

extern "C" void kernel_launch(void* const* d_in, const int* in_sizes, int n_in, void* d_out, int out_size,
                              void* d_ws, size_t ws_size, hipStream_t stream) {
  Params p{};
  const float* const* in = (const float* const*)d_in;
  p.x = in[0]; p.c = in[1]; p.ctx = in[2]; p.c_ctx = in[3]; p.w_ada = in[4]; p.b_ada = in[5];
  p.g1 = in[6]; p.g2 = in[7]; p.w_in = in[8]; p.hy_conv_w = in[9]; p.hy_conv_b = in[10];
  p.f_w1 = in[11]; p.f_b1 = in[12]; p.f_freq = in[13]; p.f_w2 = in[14]; p.f_b2 = in[15]; p.f_w3 = in[16];
  p.hy_bias = in[17]; p.ssd_conv_w = in[18]; p.ssd_conv_b = in[19]; p.a_log = in[20]; p.dt_bias = in[21];
  p.ssd_d = in[22]; p.ssd_norm_g = in[23]; p.w_out = in[24]; p.w_group = in[25]; p.b_group = in[26];
  p.w_expert = in[27]; p.b_expert = in[28]; p.w1 = in[29]; p.w3 = in[30]; p.w2 = in[31]; p.g_final = in[32];
  p.out = (float*)d_out;

  char* ws = (char*)d_ws;
  size_t off = 0;
  auto take = [&](size_t bytes) { char* r = ws + off; off += (bytes + 255) & ~(size_t)255; return r; };
  p.BAR = (unsigned*)take((size_t)XCD_BAR_WORDS * 4);
  p.MOD = (float*)take((size_t)9 * 6144 * 4);
  p.CNT = (int*)take(NE * 32 * 4);
  p.GATE = (float*)take((size_t)T * 2 * 4);
  p.LIST = (int*)take((size_t)NE * T * 4);
  p.DT = (float*)take((size_t)TT * 16 * 4);
  p.ACUM = (float*)take((size_t)T * 16 * 4);
  p.SSQP = (float*)take((size_t)T * 16 * 4);
  p.CDEC = (float*)take((size_t)128 * 18 * 32 * 4);
  p.FILTt = (bf16_t*)take((size_t)1024 * FLEN * 2);
  p.WRhi = (bf16_t*)take((size_t)96 * 1024 * 2);
  p.WRlo = (bf16_t*)take((size_t)96 * 1024 * 2);
  p.WinT = (bf16_t*)take((size_t)(DP + 256) * D * 2);
  p.WoutT = (bf16_t*)take((size_t)D * D * 2);
  char* rPX = take((size_t)TT * DP * 2);
  char* rXBC = take((size_t)128 * 18 * 8192 * 2);
  char* rYF = take((size_t)T * DS * 4);
  char* rZ1 = take((size_t)HYC * T * 2);
  char* rYB = take((size_t)T * DS * 4);
  char* rYM = take((size_t)T * D * 2);
  p.PXb = (bf16_t*)rPX; p.SST = (bf16_t*)rXBC; p.Ut = (bf16_t*)rZ1; p.YMIXb = (bf16_t*)rYM;
  p.HIN = (bf16_t*)rYF;
  p.Yt = (bf16_t*)rYB;
  p.XNb = (bf16_t*)rZ1;
  p.X1 = (float*)rPX;
  p.H2b = (bf16_t*)rYM;
  p.HBb = (bf16_t*)(rPX + (size_t)T * D * 4);
  p.YB2b = (bf16_t*)rZ1;
  if (off > ws_size) { fprintf(stderr, "workspace too small: need %zu have %zu\n", off, ws_size); return; }

  static int grid_blocks = 0;
  if (!grid_blocks) {
    int dev = 0, cus = 0, per_cu = 0;
    (void)hipGetDevice(&dev);
    (void)hipDeviceGetAttribute(&cus, hipDeviceAttributeMultiprocessorCount, dev);
    (void)hipFuncSetAttribute((const void*)mega, hipFuncAttributeMaxDynamicSharedMemorySize, LDS_BYTES);
    (void)hipOccupancyMaxActiveBlocksPerMultiprocessor(&per_cu, mega, NTHR, LDS_BYTES);
    if (per_cu < 1) { fprintf(stderr, "occupancy query returned %d\n", per_cu); per_cu = 1; }
    grid_blocks = cus;
  }
#ifndef ONE_LAUNCH
  for (int ph = 0; ph < NPHASE; ++ph) {
    p.lo = ph; p.hi = ph + 1;
    hipLaunchKernelGGL(mega, dim3(grid_blocks), dim3(NTHR), LDS_BYTES, stream, p);
  }
#else
  p.lo = 0; p.hi = NPHASE;
  (void)hipMemsetAsync(p.BAR, 0, (size_t)XCD_BAR_WORDS * 4, stream);
  void* args[] = {&p};
  hipError_t e = hipLaunchCooperativeKernel((void*)mega, dim3(grid_blocks), dim3(NTHR), args, LDS_BYTES, stream);
  if (e != hipSuccess) fprintf(stderr, "cooperative launch failed: %s (grid %d)\n", hipGetErrorString(e), grid_blocks);
#endif
}
```

```cpp
#define ONE_LAUNCH 1
#include <hip/hip_runtime.h>
#include <hip/hip_cooperative_groups.h>
#include <cstdio>
#include <cstdint>
namespace cg = cooperative_groups;

constexpr int D = 1024, NB = 8, L = 2048, LC = 256;
constexpr int T = NB * L;
constexpr int TC = NB * LC;
constexpr int TT = T + TC;
constexpr int DH = 512, HYC = 1536, DS = 512, DXBC = 1024, DIN = 3088, DP = 3072;
constexpr int COL_Z = 1536, COL_XBC = 2048, COL_DT = 3072;
constexpr int NE = 64, DE = 512;
constexpr float EPS = 1e-6f;
constexpr int NTHR = 512;
constexpr int LDS_BYTES = 132 * 1024;
constexpr int FLEN = 4232, HX0 = 2112, FCLEN = 4240, ZSTRB = 4240;

typedef unsigned short bf16_t;

struct Params {
  const float *x, *c, *ctx, *c_ctx, *w_ada, *b_ada, *g1, *g2, *w_in, *hy_conv_w, *hy_conv_b;
  const float *f_w1, *f_b1, *f_freq, *f_w2, *f_b2, *f_w3, *hy_bias;
  const float *ssd_conv_w, *ssd_conv_b, *a_log, *dt_bias, *ssd_d, *ssd_norm_g, *w_out;
  const float *w_group, *b_group, *w_expert, *b_expert, *w1, *w3, *w2, *g_final;
  float* out;
  float *MOD, *DT, *X1, *GATE, *ACUM, *CDEC, *SSQP;
  bf16_t *WRhi, *WRlo, *FILTt, *Ut, *Yt, *HIN, *XNb, *WinT, *WoutT, *PXb, *SST, *YMIXb, *YB2b, *H2b, *HBb;
  int *CNT, *LIST;
  unsigned* BAR;
  int lo, hi;
};

__device__ __forceinline__ float silu_f(float v) { return v / (1.f + __expf(-v)); }
__device__ __forceinline__ float softplus_f(float v) { return v > 20.f ? v : log1pf(expf(v)); }
__device__ __forceinline__ float bf2f(bf16_t v) { return __uint_as_float(((unsigned)v) << 16); }
__device__ __forceinline__ unsigned cvt_pk_bf16(float lo, float hi) {
  typedef __bf16 bf2_t __attribute__((ext_vector_type(2)));
  typedef float f2_t __attribute__((ext_vector_type(2)));
  const f2_t v = {lo, hi};
  const bf2_t r = __builtin_convertvector(v, bf2_t);
  return __builtin_bit_cast(unsigned, r);
}
__device__ __forceinline__ bf16_t f2bf(float f) { return (bf16_t)(cvt_pk_bf16(f, 0.f) & 0xffffu); }
__device__ __forceinline__ void st_agent64(void* p, unsigned lo, unsigned hi) {
  __hip_atomic_store((unsigned long long*)p, ((unsigned long long)hi << 32) | lo, __ATOMIC_RELAXED, __HIP_MEMORY_SCOPE_AGENT);
}
__device__ __forceinline__ uint2 ld_agent64(const void* p) {
  const unsigned long long v = __hip_atomic_load((const unsigned long long*)p, __ATOMIC_RELAXED, __HIP_MEMORY_SCOPE_AGENT);
  return make_uint2((unsigned)v, (unsigned)(v >> 32));
}
__device__ __forceinline__ void st_agent32(float* p, float v) { __hip_atomic_store(p, v, __ATOMIC_RELAXED, __HIP_MEMORY_SCOPE_AGENT); }
__device__ __forceinline__ float ld_agent32(const float* p) { return __hip_atomic_load(p, __ATOMIC_RELAXED, __HIP_MEMORY_SCOPE_AGENT); }
__device__ __forceinline__ float wave_sum(float v) {
#pragma unroll
  for (int o = 32; o > 0; o >>= 1) v += __shfl_xor(v, o);
  return v;
}


#define XB_TMO      128
#define XB_XCNT(j)  (256  + 64 * (j))
#define XB_XSUB(j)  (1280 + 64 * (j))
#define XB_XGEN(j)  (2304 + 64 * (j))
#define XB_TOP      3328
#define XB_TOPGEN   3392
#define XCD_BAR_WORDS 3456
#define XB_SPIN_CAP (1u << 18)
#define LAS __attribute__((address_space(3)))
__device__ __forceinline__ unsigned xb_ld(unsigned* p) { return __hip_atomic_load(p, __ATOMIC_RELAXED, __HIP_MEMORY_SCOPE_AGENT); }
__device__ __forceinline__ unsigned xb_add(unsigned* p, unsigned v) { return __hip_atomic_fetch_add(p, v, __ATOMIC_RELAXED, __HIP_MEMORY_SCOPE_AGENT); }
__device__ __forceinline__ unsigned xb_xcc_id() { return (unsigned)__builtin_amdgcn_s_getreg((3 << 11) | 20) & 0xFu; }
#define XB_SPIN(cond, bar) do { unsigned _sp = 0; while (cond) { __builtin_amdgcn_s_sleep(1); \
    if ((++_sp & 255u) == 0u) { if (xb_ld(&(bar)[XB_TMO])) break; if (_sp > XB_SPIN_CAP) { atomicAdd(&(bar)[XB_TMO], 1u); break; } } } } while (0)
struct XcdBarrier { unsigned* bar; unsigned x; volatile LAS unsigned* st; };
__device__ __forceinline__ XcdBarrier xcd_barrier_post(unsigned* bar, volatile LAS unsigned* st) {
  XcdBarrier b; b.bar = bar; b.x = xb_xcc_id(); b.st = st;
  if (threadIdx.x == 0) (void)xb_add(&bar[XB_XCNT(b.x)], 1u);
  return b;
}
__device__ __forceinline__ void xcd_barrier_complete(unsigned* bar, unsigned x, unsigned& nloc, unsigned& nx) {
  const unsigned G = gridDim.x * gridDim.y * gridDim.z;
  unsigned sum, cnt, mine, sp = 0u;
  for (;;) {
    sum = 0u; cnt = 0u; mine = 0u;
#pragma unroll
    for (unsigned j = 0; j < 16; ++j) { const unsigned c = xb_ld(&bar[XB_XCNT(j)]); sum += c; cnt += (c > 0u) ? 1u : 0u; mine = (j == x) ? c : mine; }
    if (sum == G) break;
    __builtin_amdgcn_s_sleep(1);
    if ((++sp & 255u) == 0u) { if (xb_ld(&bar[XB_TMO])) break; if (sp > XB_SPIN_CAP) { atomicAdd(&bar[XB_TMO], 1u); break; } }
  }
  nloc = mine > 0u ? mine : 1u; nx = cnt > 0u ? cnt : 1u;
}
__device__ __forceinline__ void xcd_barrier(const XcdBarrier& b) {
  asm volatile("s_waitcnt vmcnt(0)" ::: "memory");
  __syncthreads();
  if (threadIdx.x == 0) {
    unsigned* bar = b.bar;
    __builtin_amdgcn_s_waitcnt(0);
    unsigned nloc = b.st[0], nx = b.st[1];
    if (nloc == 0u) { xcd_barrier_complete(bar, b.x, nloc, nx); b.st[0] = nloc; b.st[1] = nx; }
    const unsigned old = xb_add(&bar[XB_XSUB(b.x)], 1u);
    const unsigned gen = old / nloc;
    if (old + 1u == (gen + 1u) * nloc) {
      __builtin_amdgcn_fence(__ATOMIC_RELEASE, "agent");
      asm volatile("s_waitcnt vmcnt(0)" ::: "memory");
      const unsigned og = xb_add(&bar[XB_TOP], 1u);
      const unsigned tg = og / nx;
      if (og + 1u == (tg + 1u) * nx) xb_add(&bar[XB_TOPGEN], 1u);
      else XB_SPIN(xb_ld(&bar[XB_TOPGEN]) == tg, bar);
      __builtin_amdgcn_fence(__ATOMIC_ACQUIRE, "agent");
      xb_add(&bar[XB_XGEN(b.x)], 1u);
      asm volatile("s_waitcnt vmcnt(0)" ::: "memory");
    } else {
      XB_SPIN(xb_ld(&bar[XB_XGEN(b.x)]) == gen, bar);
      __builtin_amdgcn_fence(__ATOMIC_ACQUIRE, "agent");
      asm volatile("s_waitcnt vmcnt(0)" ::: "memory");
    }
  }
  __syncthreads();
}

namespace pg8 {
#define PG8_LAS __attribute__((address_space(3)))
typedef short bf16x8 __attribute__((ext_vector_type(8)));
typedef float f32x4 __attribute__((ext_vector_type(4)));
typedef unsigned u32x4 __attribute__((ext_vector_type(4)));
typedef unsigned u32x2 __attribute__((ext_vector_type(2)));
constexpr int BM = 256, BK = 64, HALF = 128, HTB = HALF * BK * 2, STAGE_BYTES = 8 * HTB, NXCD = 8, WGM = 8;

__host__ __device__ __forceinline__ int lds_byte(int r, int c) {
  const int st = (r >> 4) * 2 + (c >> 5), rr = r & 15, cc = c & 31, ob = rr * 64 + cc * 2;
  return st * 1024 + (ob ^ (((ob >> 9) & 1) << 5));
}
__host__ __device__ __forceinline__ void stage_rc(int b, int& R, int& C) {
  const int st = b / 1024, sb = b % 1024, swz = sb ^ (((sb >> 9) & 1) << 5);
  R = (st >> 1) * 16 + swz / 64; C = (st & 1) * 32 + (swz % 64) / 2;
}
__host__ __device__ __forceinline__ int perm32(int rho) { const int n = rho >> 4, i = rho & 15; return 8 * (i >> 2) + 4 * n + (i & 3); }

struct Unit { int pm, pn, e, mu, nv, cnt, seg; };

__device__ __forceinline__ bool static_next(int nM, int nN, int G, int c, int i, int& pm, int& pn) {
  const int nwg = nM * nN;
  const long Lx = (long)i * G + c; if (Lx >= nwg) return false;
  int wgid = (int)Lx;
  { const int q = nwg / NXCD, r = nwg % NXCD, xcd = wgid % NXCD, off = wgid / NXCD; wgid = (xcd < r ? xcd * (q + 1) : r * (q + 1) + (xcd - r) * q) + off; }
  const int nig = WGM * nN, gid = wgid / nig, fm = gid * WGM, gsz = (nM - fm) < WGM ? (nM - fm) : WGM;
  pm = fm + ((wgid % nig) % gsz); pn = (wgid % nig) / gsz; return true;
}

struct DenseOrder {
  const bf16_t* A; const bf16_t* Bt; int nM, nN, K, G, c;
  __device__ __forceinline__ bool next(int i, Unit& u) const {
    if (!static_next(nM, nN, G, c, i, u.pm, u.pn)) return false;
    u.e = 0; u.mu = 0; u.nv = 256; u.cnt = 256; u.seg = 0; return true;
  }
  __device__ __forceinline__ const char* a_base() const { return (const char*)A; }
  __device__ __forceinline__ const char* b_ptr(const Unit& u) const { return (const char*)Bt + (size_t)u.pn * 256 * K * 2; }
  __device__ __forceinline__ void a_offs(const Unit& u, const int (&R)[2], const int (&C)[2], unsigned (&ao)[2][2]) const {
#pragma unroll
    for (int h = 0; h < 2; ++h)
#pragma unroll
      for (int i = 0; i < 2; ++i) ao[h][i] = (unsigned)((u.pm * 256 + h * 128 + R[i]) * K + C[i]) * 2u;
  }
};

struct MoeOrder {
  const int* tab; const bf16_t* A; const bf16_t* Bt; const int* list; int NTn, K, G, c; bool gather;
  __device__ __forceinline__ bool next(int i, Unit& u) const {
    const int Lx = i * G + c;
    if (Lx >= tab[64] * NTn) return false;
    const int mg = Lx / NTn; u.pn = Lx - mg * NTn;
    int e = 0;
    while (tab[e + 1] <= mg) ++e;
    u.e = e; u.mu = mg - tab[e]; u.cnt = tab[130 + e]; u.seg = tab[65 + e];
    const int rem = u.cnt - u.mu * 256; u.nv = rem < 256 ? rem : 256; u.pm = 0; return true;
  }
  __device__ __forceinline__ const char* a_base() const { return (const char*)A; }
  __device__ __forceinline__ const char* b_ptr(const Unit& u) const { return (const char*)Bt + ((size_t)u.e * NTn + u.pn) * 256 * K * 2; }
  __device__ __forceinline__ void a_offs(const Unit& u, const int (&R)[2], const int (&C)[2], unsigned (&ao)[2][2]) const {
#pragma unroll
    for (int h = 0; h < 2; ++h)
#pragma unroll
      for (int i = 0; i < 2; ++i) {
        int idx = u.mu * 256 + h * 128 + R[i];
        int row;
        if (gather) { if (idx > u.cnt - 1) idx = u.cnt - 1; row = list[u.e * T + idx] >> 1; }
        else row = u.seg + idx;
        ao[h][i] = (unsigned)(row * K + C[i]) * 2u;
      }
  }
};

struct EpiBf16 {
  static constexpr bool PERM = true;
  bf16_t* O; int ldc; float* DT; const float* dt_bias;
  __device__ __forceinline__ void operator()(const f32x4 (&acc)[2][2][4][2], const Unit& u, int wr, int wc, int fr, int fq) const {
    const int row0 = u.pm * BM + wr * 64 + fr;
    if (u.pn == 12) {
      if (wc == 0 && fq < 2) {
        const f32x4 b0 = *(const f32x4*)(dt_bias + 8 * fq), b1 = *(const f32x4*)(dt_bias + 8 * fq + 4);
#pragma unroll
        for (int ai = 0; ai < 2; ++ai)
#pragma unroll
          for (int m = 0; m < 4; ++m) {
            float* dp = DT + (size_t)(row0 + ai * HALF + m * 16) * 16 + 8 * fq;
            *(f32x4*)dp = acc[ai][0][m][0] + b0; *(f32x4*)(dp + 4) = acc[ai][0][m][1] + b1;
          }
      }
      return;
    }
    const int col0 = u.pn * BM + wc * 32 + 8 * fq;
#pragma unroll
    for (int ai = 0; ai < 2; ++ai)
#pragma unroll
      for (int m = 0; m < 4; ++m) {
        bf16_t* rowp = O + (size_t)(row0 + ai * HALF + m * 16) * ldc + col0;
#pragma unroll
        for (int bj = 0; bj < 2; ++bj) {
          f32x4 v0 = acc[ai][bj][m][0], v1 = acc[ai][bj][m][1];
          u32x4 w; w.x = cvt_pk_bf16(v0[0], v0[1]); w.y = cvt_pk_bf16(v0[2], v0[3]); w.z = cvt_pk_bf16(v1[0], v1[1]); w.w = cvt_pk_bf16(v1[2], v1[3]);
          *(u32x4*)(rowp + bj * HALF) = w;
        }
      }
  }
};

struct EpiX1 {
  static constexpr bool PERM = false;
  const float* x; const float* mod; float* X1; float* SSQP;
  __device__ __forceinline__ void operator()(const f32x4 (&acc)[2][2][4][2], const Unit& u, int wr, int wc, int fr, int fq) const {
    const int row0 = u.pm * BM + wr * 64 + fr, col0 = u.pn * BM + wc * 32 + 4 * fq;
    const float* ga = mod + ((u.pm * BM) / L) * 6144 + 2048 + col0;
    f32x4 gv[2][2];
#pragma unroll
    for (int bj = 0; bj < 2; ++bj)
#pragma unroll
      for (int n = 0; n < 2; ++n) gv[bj][n] = *(const f32x4*)(ga + bj * HALF + n * 16);
#pragma unroll
    for (int ai = 0; ai < 2; ++ai)
#pragma unroll
      for (int m = 0; m < 4; ++m) {
        const size_t off = (size_t)(row0 + ai * HALF + m * 16) * D + col0;
        float ssq = 0.f;
#pragma unroll
        for (int bj = 0; bj < 2; ++bj)
#pragma unroll
          for (int n = 0; n < 2; ++n) {
            const f32x4 xv = *(const f32x4*)(x + off + bj * HALF + n * 16);
            const f32x4 o = xv + gv[bj][n] * acc[ai][bj][m][n];
            *(f32x4*)(X1 + off + bj * HALF + n * 16) = o;
            ssq += (o[0] * o[0] + o[1] * o[1]) + (o[2] * o[2] + o[3] * o[3]);
          }
        ssq += __shfl_xor(ssq, 16); ssq += __shfl_xor(ssq, 32);
        if (fq == 0) SSQP[(size_t)(row0 + ai * HALF + m * 16) * 16 + u.pn * 4 + wc] = ssq;
      }
  }
};

struct EpiSwiGLU {
  static constexpr bool PERM = true;
  bf16_t* HBb;
  __device__ __forceinline__ void operator()(const f32x4 (&acc)[2][2][4][2], const Unit& u, int wr, int wc, int fr, int fq) const {
    const int col0 = u.pn * 128 + wc * 32 + 8 * fq;
#pragma unroll
    for (int ai = 0; ai < 2; ++ai)
#pragma unroll
      for (int m = 0; m < 4; ++m) {
        const int slot = u.mu * 256 + ai * HALF + wr * 64 + m * 16 + fr;
        if (slot < u.cnt) {
          float h[8];
#pragma unroll
          for (int n = 0; n < 2; ++n)
#pragma unroll
            for (int j = 0; j < 4; ++j) { const float a = acc[ai][0][m][n][j]; h[n * 4 + j] = a / (1.f + __expf(-a)) * acc[ai][1][m][n][j]; }
          u32x4 w; w.x = cvt_pk_bf16(h[0], h[1]); w.y = cvt_pk_bf16(h[2], h[3]); w.z = cvt_pk_bf16(h[4], h[5]); w.w = cvt_pk_bf16(h[6], h[7]);
          *(u32x4*)(HBb + (size_t)(u.seg + slot) * DE + col0) = w;
        }
      }
  }
};

struct EpiDown {
  static constexpr bool PERM = true;
  bf16_t* YB2b; const int* list; const float* gate;
  __device__ __forceinline__ void operator()(const f32x4 (&acc)[2][2][4][2], const Unit& u, int wr, int wc, int fr, int fq) const {
    const int col0 = u.pn * 256 + wc * 32 + 8 * fq;
#pragma unroll
    for (int ai = 0; ai < 2; ++ai)
#pragma unroll
      for (int m = 0; m < 4; ++m) {
        const int slot = u.mu * 256 + ai * HALF + wr * 64 + m * 16 + fr;
        if (slot < u.cnt) {
          const int pair = list[u.e * T + slot];
          const float gt = gate[pair];
          bf16_t* rowp = YB2b + (size_t)pair * D + col0;
#pragma unroll
          for (int bj = 0; bj < 2; ++bj) {
            f32x4 v0 = acc[ai][bj][m][0] * gt, v1 = acc[ai][bj][m][1] * gt;
            u32x4 w; w.x = cvt_pk_bf16(v0[0], v0[1]); w.y = cvt_pk_bf16(v0[2], v0[3]); w.z = cvt_pk_bf16(v1[0], v1[1]); w.w = cvt_pk_bf16(v1[2], v1[3]);
            *(u32x4*)(rowp + bj * HALF) = w;
          }
        }
      }
  }
};

template <class Epi, class Sched>
__device__ __forceinline__ void gemm_phase(PG8_LAS unsigned char* lds, const int K, const Sched& S, const Epi& E) {
  const int tid = threadIdx.x, wid = __builtin_amdgcn_readfirstlane(tid >> 6), lane = tid & 63, wr = wid >> 2, wc = wid & 3, fr = lane & 15, fq = lane >> 4;
  const int nt = K / BK;
  int Rr[2], Cc[2];
  unsigned voffB[2];
#pragma unroll
  for (int i = 0; i < 2; ++i) {
    stage_rc(tid * 16 + i * 8192, Rr[i], Cc[i]);
    const int Rb = Epi::PERM ? ((Rr[i] & ~31) + perm32(Rr[i] & 31)) : Rr[i];
    voffB[i] = (unsigned)(Rb * K + Cc[i]) * 2u;
  }
  const size_t kstep = (size_t)(BK * 2);
  const size_t hstep = (size_t)HALF * K * 2;
  const unsigned ldsw = (unsigned)wid * 1024u;
  const int aoff = lds_byte(wr * 64 + fr, fq * 8), boff = lds_byte(wc * 32 + fr, fq * 8);
#define PG8_SA(b, h) (((b) * 2 + (h)) * HTB)
#define PG8_SB(b, h) ((4 + (b) * 2 + (h)) * HTB)
#define PG8_STAGE(bufoff, gbase, voff) do { _Pragma("unroll") for (int _i = 0; _i < 2; ++_i) \
    __builtin_amdgcn_global_load_lds((const unsigned*)((const char*)(gbase) + (voff)[_i]), (PG8_LAS unsigned*)(lds + (bufoff) + ldsw + _i * 8192), 16, 0, 0); } while (0)
#define PG8_LDA(dst, b, h) do { _Pragma("unroll") for (int m = 0; m < 4; ++m) _Pragma("unroll") for (int k = 0; k < 2; ++k) dst[m][k] = *(const PG8_LAS bf16x8*)(lds + PG8_SA(b, h) + aoff + m * 2048 + k * 1024); } while (0)
#define PG8_LDB(dst, b, h) do { _Pragma("unroll") for (int n = 0; n < 2; ++n) _Pragma("unroll") for (int k = 0; k < 2; ++k) dst[n][k] = *(const PG8_LAS bf16x8*)(lds + PG8_SB(b, h) + boff + n * 2048 + k * 1024); } while (0)
#define PG8_MMA(ai, bj, At, Bt) do { __builtin_amdgcn_s_setprio(1); _Pragma("unroll") for (int m = 0; m < 4; ++m) _Pragma("unroll") for (int n = 0; n < 2; ++n) _Pragma("unroll") for (int k = 0; k < 2; ++k) \
    acc[ai][bj][m][n] = __builtin_amdgcn_mfma_f32_16x16x32_bf16(Bt[n][k], At[m][k], acc[ai][bj][m][n], 0, 0, 0); __builtin_amdgcn_s_setprio(0); } while (0)
#define PG8_WAIT_V(n) asm volatile("s_waitcnt vmcnt(" #n ")" ::: "memory")
#define PG8_WAIT_L(n) asm volatile("s_waitcnt lgkmcnt(" #n ")" ::: "memory")
#define PG8_BAR __builtin_amdgcn_s_barrier()
#define PG8_SCHED __builtin_amdgcn_sched_barrier(0)
  Unit cur, nxt; int ui = 0;
  if (!S.next(0, cur)) return;
  f32x4 acc[2][2][4][2];
#pragma unroll
  for (int a = 0; a < 2; ++a)
#pragma unroll
    for (int b = 0; b < 2; ++b)
#pragma unroll
      for (int m = 0; m < 4; ++m)
#pragma unroll
        for (int n = 0; n < 2; ++n) acc[a][b][m][n] = (f32x4){0.f, 0.f, 0.f, 0.f};
  bf16x8 At[4][2], B0[2][2], B1[2][2];
  unsigned cao[2][2], nao[2][2];
  S.a_offs(cur, Rr, Cc, cao);
  const char* const aB = S.a_base();
  const char* cB = S.b_ptr(cur);
  PG8_STAGE(PG8_SB(0, 0), cB, voffB); PG8_STAGE(PG8_SA(0, 0), aB, cao[0]); PG8_STAGE(PG8_SB(0, 1), cB + hstep, voffB); PG8_STAGE(PG8_SA(0, 1), aB, cao[1]);
  if (wr == 1) PG8_BAR;
  PG8_WAIT_V(4); PG8_BAR;
  PG8_STAGE(PG8_SB(1, 0), cB + kstep, voffB); PG8_STAGE(PG8_SA(1, 0), aB + kstep, cao[0]); PG8_STAGE(PG8_SB(1, 1), cB + hstep + kstep, voffB);
  PG8_WAIT_V(6); PG8_BAR;
  for (;;) {
    const bool has_next = S.next(ui + 1, nxt);
    const char* nB = cB;
    if (has_next) { S.a_offs(nxt, Rr, Cc, nao); nB = S.b_ptr(nxt); }
    else {
#pragma unroll
      for (int h = 0; h < 2; ++h)
#pragma unroll
        for (int i = 0; i < 2; ++i) nao[h][i] = cao[h][i];
    }
    const bool full = cur.nv > 128;
    for (int t = 0; t < nt; t += 2) {
      const bool last = (t == nt - 2);
      const char* a1 = aB + (size_t)(t + 1) * kstep;
      const char* a2 = last ? aB : aB + (size_t)(t + 2) * kstep; const char* b2 = last ? nB : cB + (size_t)(t + 2) * kstep;
      const char* a3 = a2 + kstep; const char* b3 = b2 + kstep;
      unsigned so[2][2];
#pragma unroll
      for (int h = 0; h < 2; ++h)
#pragma unroll
        for (int i = 0; i < 2; ++i) so[h][i] = last ? nao[h][i] : cao[h][i];
      PG8_LDB(B0, 0, 0); PG8_SCHED; PG8_LDA(At, 0, 0); PG8_STAGE(PG8_SA(1, 1), a1, cao[1]);
      PG8_WAIT_L(8); PG8_BAR; PG8_WAIT_L(0); PG8_MMA(0, 0, At, B0); PG8_BAR; PG8_SCHED;
      PG8_LDB(B1, 0, 1); PG8_STAGE(PG8_SB(0, 0), b2, voffB);
      PG8_BAR; PG8_WAIT_L(0); PG8_MMA(0, 1, At, B1); PG8_BAR;
      PG8_LDA(At, 0, 1); PG8_STAGE(PG8_SA(0, 0), a2, so[0]);
      PG8_BAR; PG8_WAIT_L(0); if (full) PG8_MMA(1, 0, At, B0); PG8_BAR; PG8_SCHED;
      PG8_STAGE(PG8_SB(0, 1), b2 + hstep, voffB);
      PG8_WAIT_V(6); PG8_BAR; if (full) PG8_MMA(1, 1, At, B1); PG8_BAR;
      PG8_LDB(B0, 1, 0); PG8_SCHED; PG8_LDA(At, 1, 0); PG8_STAGE(PG8_SA(0, 1), a2, so[1]);
      PG8_WAIT_L(8); PG8_BAR; PG8_WAIT_L(0); PG8_MMA(0, 0, At, B0); PG8_BAR; PG8_SCHED;
      PG8_LDB(B1, 1, 1); PG8_STAGE(PG8_SB(1, 0), b3, voffB);
      PG8_BAR; PG8_WAIT_L(0); PG8_MMA(0, 1, At, B1); PG8_BAR;
      PG8_LDA(At, 1, 1); PG8_STAGE(PG8_SA(1, 0), a3, so[0]);
      PG8_BAR; PG8_WAIT_L(0); if (full) PG8_MMA(1, 0, At, B0); PG8_BAR; PG8_SCHED;
      PG8_STAGE(PG8_SB(1, 1), b3 + hstep, voffB);
      PG8_WAIT_V(6); PG8_BAR; if (full) PG8_MMA(1, 1, At, B1); PG8_BAR;
    }
    E(acc, cur, wr, wc, fr, fq);
    if (!has_next) break;
#pragma unroll
    for (int a = 0; a < 2; ++a)
#pragma unroll
      for (int b = 0; b < 2; ++b)
#pragma unroll
        for (int m = 0; m < 4; ++m)
#pragma unroll
          for (int n = 0; n < 2; ++n) acc[a][b][m][n] = (f32x4){0.f, 0.f, 0.f, 0.f};
    cur = nxt; cB = nB; ++ui;
#pragma unroll
    for (int h = 0; h < 2; ++h)
#pragma unroll
      for (int i = 0; i < 2; ++i) cao[h][i] = nao[h][i];
  }
  PG8_WAIT_V(0);
  if (wr == 0) PG8_BAR;
  PG8_BAR;
#undef PG8_SA
#undef PG8_SB
#undef PG8_STAGE
#undef PG8_LDA
#undef PG8_LDB
#undef PG8_MMA
#undef PG8_WAIT_V
#undef PG8_WAIT_L
#undef PG8_BAR
#undef PG8_SCHED
}
}

__device__ void ph_adaln(const Params& p, float* sm) {
  const int tid = threadIdx.x;
  if (blockIdx.x == 0 && tid < NE) p.CNT[tid * 32] = 0;
  for (int e = blockIdx.x * NTHR + tid; e < 96 * 1024; e += gridDim.x * NTHR) {
    const int j = e >> 10, k = e & 1023;
    float w = 0.f;
    if (j < 64) w = p.w_expert[k * 64 + j]; else if (j < 72) w = p.w_group[k * 8 + (j - 64)];
    const unsigned hi = cvt_pk_bf16(w, 0.f) & 0xffffu;
    const float rem = w - __uint_as_float(hi << 16);
    p.WRhi[e] = (bf16_t)hi; p.WRlo[e] = (bf16_t)(cvt_pk_bf16(rem, 0.f) & 0xffffu);
  }
  float* sc = sm;
  float* red = sm + 9 * 1024;
  for (int e = tid; e < 9 * 1024; e += NTHR) {
    const int r = e >> 10, k = e & 1023;
    sc[e] = silu_f(r < 8 ? p.c[r * D + k] : p.c_ctx[k]);
  }
  __syncthreads();
  for (int item = blockIdx.x; item < 192; item += gridDim.x) {
    const int col0 = item * 32;
    const int kq = tid >> 3, c4 = (tid & 7) * 4;
    float acc[9][4];
#pragma unroll
    for (int r = 0; r < 9; ++r)
#pragma unroll
      for (int j = 0; j < 4; ++j) acc[r][j] = 0.f;
    float4 wv[16];
#pragma unroll
    for (int i = 0; i < 16; ++i) wv[i] = *(const float4*)(p.w_ada + (size_t)(kq + i * 64) * 6144 + col0 + c4);
#pragma unroll
    for (int i = 0; i < 16; ++i) {
      const int k = kq + i * 64;
      const float4 w = wv[i];
#pragma unroll
      for (int r = 0; r < 9; ++r) {
        const float sv = sc[r * 1024 + k];
        acc[r][0] += sv * w.x; acc[r][1] += sv * w.y; acc[r][2] += sv * w.z; acc[r][3] += sv * w.w;
      }
    }
#pragma unroll
    for (int r = 0; r < 9; ++r)
#pragma unroll
      for (int j = 0; j < 4; ++j) red[kq * 292 + r * 32 + c4 + j] = acc[r][j];
    __syncthreads();
    if (tid < 288) {
      float a = 0.f;
      for (int q = 0; q < 64; ++q) a += red[q * 292 + tid];
      const int r = tid >> 5, j = tid & 31;
      p.MOD[r * 6144 + col0 + j] = a + p.b_ada[col0 + j];
    }
    __syncthreads();
  }
}

__device__ void ph_filters(const Params& p, float* sm) {
  const int tid = threadIdx.x, wid = tid >> 6, lane = tid & 63;
  float* feats = sm;
  float* h1 = sm + 64 * 20;
  float* h2 = h1 + 64 * 64;
  float* w3s = h2 + 64 * 64;
  bf16_t* tile = (bf16_t*)w3s;
  float* w2s = w3s + 64 * 256;
  float* w1s = w2s + 4096;
  for (int e = tid; e < 4096; e += NTHR) w2s[e] = p.f_w2[e];
  for (int e = tid; e < 17 * 64; e += NTHR) w1s[e] = p.f_w1[e];
  __syncthreads();
  for (int e = blockIdx.x * NTHR + tid; e < 1024 * 137; e += gridDim.x * NTHR) {
    int rowi = e / 137, k = e - rowi * 137;
    int x = (k < 65) ? k : (4160 + (k - 65));
    p.FILTt[(size_t)rowi * FLEN + x] = 0;
  }
  for (int item = blockIdx.x; item < 256; item += gridDim.x) {
    const int tt = item >> 3, ct = item & 7;
    for (int e = tid; e < 64 * 17; e += NTHR) {
      int tp = e / 17, i = e - tp * 17;
      int t = tt * 64 + tp;
      float f;
      if (i == 0) f = (float)t / (float)(L - 1);
      else {
        int bi = (i - 1) & 7;
        float bandf = (float)(1e-4 + (double)bi * ((7.0 - 1e-4) / 7.0));
        float ang = (float)(2.0 * 3.14159265358979323846 / (double)L) * (float)t * bandf;
        f = (i <= 8) ? cosf(ang) : -sinf(ang);
      }
      feats[tp * 20 + i] = f;
    }
    __syncthreads();
    for (int e = tid; e < 4096; e += NTHR) {
      int tp = e >> 6, j = e & 63;
      float a = p.f_b1[j];
      for (int i = 0; i < 17; ++i) a += feats[tp * 20 + i] * w1s[i * 64 + j];
      h1[e] = __sinf(p.f_freq[j] * a);
    }
    __syncthreads();
    for (int e = tid; e < 4096; e += NTHR) {
      int tp = e >> 6, j = e & 63;
      float a = p.f_b2[j];
      for (int i = 0; i < 64; ++i) a += h1[tp * 64 + i] * w2s[i * 64 + j];
      h2[e] = __sinf(p.f_freq[j] * a);
    }
    __syncthreads();
    for (int e = tid; e < 4096; e += NTHR) {
      const int i = e >> 6, c4 = (e & 63) * 4;
      *(float4*)(w3s + i * 256 + c4) = *(const float4*)(p.f_w3 + i * 2048 + ct * 256 + c4);
    }
    __syncthreads();
    {
      const int cg = tid & 31, tg = tid >> 5;
      float acc[4][8];
#pragma unroll
      for (int a = 0; a < 4; ++a)
#pragma unroll
        for (int c = 0; c < 8; ++c) acc[a][c] = 0.f;
#pragma unroll 4
      for (int i = 0; i < 64; ++i) {
        const float4 w0 = *(const float4*)(w3s + i * 256 + cg * 8), w1 = *(const float4*)(w3s + i * 256 + cg * 8 + 4);
        const float wv[8] = {w0.x, w0.y, w0.z, w0.w, w1.x, w1.y, w1.z, w1.w};
#pragma unroll
        for (int a = 0; a < 4; ++a) {
          const float hv = h2[(tg * 4 + a) * 64 + i];
#pragma unroll
          for (int c = 0; c < 8; ++c) acc[a][c] += hv * wv[c];
        }
      }
      __syncthreads();
      const float d0 = -4.605170185988091f / 1.5f, d1 = -4.605170185988091f / 0.3f;
#pragma unroll
      for (int c = 0; c < 8; ++c) {
        const int col = cg * 8 + c;
        const int cch = (ct * 256 + col) & 511;
        const float delta = fabsf(d0 + (float)cch * ((d1 - d0) / 511.f));
#pragma unroll
        for (int a = 0; a < 4; ++a) {
          const int t = tt * 64 + tg * 4 + a;
          const float tn = (float)t / (float)(L - 1);
          tile[col * 66 + tg * 4 + a] = f2bf(acc[a][c] * __expf(-tn * delta));
        }
      }
    }
    __syncthreads();
    for (int cl = wid * 32; cl < wid * 32 + 32; ++cl) {
      const int gcol = ct * 256 + cl;
      const int o = gcol >> 10, dir = (gcol >> 9) & 1, cch = gcol & 511;
      const int t = tt * 64 + lane;
      const int x = dir ? (HX0 + t) : (HX0 - t);
      if (!(dir && t == 0)) p.FILTt[(size_t)(o * 512 + cch) * FLEN + x] = tile[cl * 66 + lane];
    }
    __syncthreads();
  }
}

__device__ __forceinline__ void cvt_tile256(const float* src, int ld, int k0, int n0, bf16_t* dst, int ldd, int dmap0, int dmap1, int nsplit, float* sm) {
  const int tid = threadIdx.x;
  float* ts = sm;
  float4 v[8];
#pragma unroll
  for (int i = 0; i < 8; ++i) {
    const int e = tid + i * NTHR; const int k = e >> 6, n4 = (e & 63) * 4;
    v[i] = *(const float4*)(src + (size_t)(k0 + k) * ld + n0 + n4);
  }
#pragma unroll
  for (int i = 0; i < 8; ++i) {
    const int e = tid + i * NTHR; const int k = e >> 6, n4 = (e & 63) * 4;
    ts[k * 257 + n4 + 0] = v[i].x; ts[k * 257 + n4 + 1] = v[i].y; ts[k * 257 + n4 + 2] = v[i].z; ts[k * 257 + n4 + 3] = v[i].w;
  }
  __syncthreads();
#pragma unroll
  for (int i = 0; i < 4; ++i) {
    const int e = tid + i * NTHR; const int n = e >> 3, kq = (e & 7) * 8;
    uint4 w;
    w.x = cvt_pk_bf16(ts[(kq + 0) * 257 + n], ts[(kq + 1) * 257 + n]);
    w.y = cvt_pk_bf16(ts[(kq + 2) * 257 + n], ts[(kq + 3) * 257 + n]);
    w.z = cvt_pk_bf16(ts[(kq + 4) * 257 + n], ts[(kq + 5) * 257 + n]);
    w.w = cvt_pk_bf16(ts[(kq + 6) * 257 + n], ts[(kq + 7) * 257 + n]);
    const int drow = (n < nsplit) ? (dmap0 + n) : (dmap1 + (n - nsplit));
    *(uint4*)(dst + (size_t)drow * ldd + k0 + kq) = w;
  }
  __syncthreads();
}

__device__ void ph_wcvt(const Params& p, float* sm) {
  for (int e = blockIdx.x * NTHR + threadIdx.x; e < 16 * 1024; e += gridDim.x * NTHR) {
    const int j = e >> 10, k = e & 1023;
    p.WinT[(size_t)(DP + j) * D + k] = f2bf(p.w_in[(size_t)k * DIN + COL_DT + j]);
  }
  for (int it = blockIdx.x; it < 192 + 64; it += gridDim.x) {
    if (it < 192) { const int kt = it / 12, nt = it - kt * 12; cvt_tile256(p.w_in, DIN, kt * 64, nt * 256, p.WinT, D, nt * 256, 0, 256, sm); }
    else if (it < 256) { const int i = it - 192; const int kt = i >> 2, nt = i & 3; cvt_tile256(p.w_out, D, kt * 64, nt * 256, p.WoutT, D, nt * 256, 0, 256, sm); }
  }
}

__device__ void ph_norm1(const Params& p) {
  const int tid = threadIdx.x, wid = tid >> 6, lane = tid & 63;
  for (int row = blockIdx.x * 8 + wid; row < TT; row += gridDim.x * 8) {
    const float* src = (row < T) ? (p.x + (size_t)row * D) : (p.ctx + (size_t)(row - T) * D);
    const int mr = (row < T) ? (row / L) : 8;
    const float* sh = p.MOD + mr * 6144;
    const float* sc = sh + 1024;
    float4 v[4];
    float ss = 0.f;
#pragma unroll
    for (int i = 0; i < 4; ++i) {
      v[i] = *(const float4*)(src + i * 256 + lane * 4);
      ss += v[i].x * v[i].x + v[i].y * v[i].y + v[i].z * v[i].z + v[i].w * v[i].w;
    }
    ss = wave_sum(ss);
    const float rstd = rsqrtf(ss * (1.f / D) + EPS);
#pragma unroll
    for (int i = 0; i < 4; ++i) {
      const int col = i * 256 + lane * 4;
      float4 g = *(const float4*)(p.g1 + col);
      float4 s4 = *(const float4*)(sc + col);
      float4 h4 = *(const float4*)(sh + col);
      float4 o;
      o.x = v[i].x * rstd * g.x * (1.f + s4.x) + h4.x;
      o.y = v[i].y * rstd * g.y * (1.f + s4.y) + h4.y;
      o.z = v[i].z * rstd * g.z * (1.f + s4.z) + h4.z;
      o.w = v[i].w * rstd * g.w * (1.f + s4.w) + h4.w;
      uint2 w; w.x = cvt_pk_bf16(o.x, o.y); w.y = cvt_pk_bf16(o.z, o.w);
      *(uint2*)(p.XNb + (size_t)row * D + col) = w;
    }
  }
}

__device__ void ph_hy_convT(const Params& p, float* sm) {
  const int tid = threadIdx.x;
  float* tile = sm;
  const int bid = blockIdx.x;
  int it0, it1;
  if (gridDim.x == 256) { if (bid < 32) { it0 = bid * 3; it1 = it0 + 3; } else { it0 = 96 + (bid - 32) * 27; it1 = it0 + 27; } }
  else { const int per = (256 * 24 + gridDim.x - 1) / gridDim.x; it0 = bid * per; it1 = it0 + per; if (it1 > 256 * 24) it1 = 256 * 24; }
  for (int item = it0; item < it1; ++item) {
    const int gr = item / 24, ct = item - gr * 24;
    const int row0 = gr * 64;
    {
      const int t = tid >> 3, c8 = (tid & 7) * 8;
      uint4 v = *(const uint4*)(p.PXb + (size_t)(row0 + t) * DP + ct * 64 + c8);
      unsigned w[4] = {v.x, v.y, v.z, v.w};
#pragma unroll
      for (int k = 0; k < 4; ++k) {
        tile[t * 65 + c8 + 2 * k] = __uint_as_float(w[k] << 16);
        tile[t * 65 + c8 + 2 * k + 1] = __uint_as_float(w[k] & 0xffff0000u);
      }
    }
    __syncthreads();
    {
      const int cc = tid >> 3, t8 = (tid & 7) * 8;
      const int col = ct * 64 + cc;
      const float w0 = p.hy_conv_w[col], w1 = p.hy_conv_w[HYC + col], w2 = p.hy_conv_w[2 * HYC + col], bb = p.hy_conv_b[col];
      float o[8];
#pragma unroll
      for (int k = 0; k < 8; ++k) {
        const int t = t8 + k;
        float v = bb + w1 * tile[t * 65 + cc];
        if (t > 0) v += w0 * tile[(t - 1) * 65 + cc];
        if (t < 63) v += w2 * tile[(t + 1) * 65 + cc];
        o[k] = v;
      }
      uint4 w; w.x = cvt_pk_bf16(o[0], o[1]); w.y = cvt_pk_bf16(o[2], o[3]); w.z = cvt_pk_bf16(o[4], o[5]); w.w = cvt_pk_bf16(o[6], o[7]);
      *(uint4*)(p.Ut + (size_t)col * T + row0 + t8) = w;
    }
    __syncthreads();
  }
}

__device__ void ph_hy_backT(const Params& p, float* sm) {
  const int tid = threadIdx.x;
  bf16_t* tile = (bf16_t*)sm;
  for (int item = blockIdx.x; item < 256 * 8; item += gridDim.x) {
    const int gr = item >> 3, ct = item & 7;
    const int row0 = gr * 64;
    {
      const int cc = tid >> 3, r8 = (tid & 7) * 8;
      uint4 v = *(const uint4*)(p.Yt + (size_t)(ct * 64 + cc) * T + row0 + r8);
      unsigned w[4] = {v.x, v.y, v.z, v.w};
#pragma unroll
      for (int k = 0; k < 4; ++k) {
        tile[cc * 66 + r8 + 2 * k] = (bf16_t)(w[k] & 0xffffu);
        tile[cc * 66 + r8 + 2 * k + 1] = (bf16_t)(w[k] >> 16);
      }
    }
    __syncthreads();
    {
      const int r = tid >> 3, c8 = (tid & 7) * 8;
      unsigned w[4];
#pragma unroll
      for (int k = 0; k < 4; ++k) w[k] = (unsigned)tile[(c8 + 2 * k) * 66 + r] | ((unsigned)tile[(c8 + 2 * k + 1) * 66 + r] << 16);
      uint4 o; o.x = w[0]; o.y = w[1]; o.z = w[2]; o.w = w[3];
      *(uint4*)(p.YMIXb + (size_t)(row0 + r) * D + ct * 64 + c8) = o;
    }
    __syncthreads();
  }
}

typedef short hbf16x8 __attribute__((ext_vector_type(8)));
typedef float hf32x4 __attribute__((ext_vector_type(4)));

constexpr int HY_FC = 0, HY_ZT0 = 4 * FCLEN * 2, HY_ZT1 = HY_ZT0 + 8 * ZSTRB;

__device__ __forceinline__ void hy_build_filter(const Params& p, int o, int c, unsigned char* lds) {
  const int tid = threadIdx.x;
  const bf16_t* gsrc = p.FILTt + (size_t)(o * 512 + c) * FLEN;
  for (int e = tid; e < 530; e += NTHR) {
    uint4 v = make_uint4(0u, 0u, 0u, 0u);
    if (e < 529) v = *(const uint4*)(gsrc + e * 8);
    *(uint4*)(lds + HY_FC + e * 16) = v;
  }
  __syncthreads();
  for (int g = tid; g < 3 * 530; g += NTHR) {
    const int r = 1 + g / 530, ch = g % 530;
    uint4 lo = make_uint4(0u, 0u, 0u, 0u);
    if (ch > 0) lo = *(const uint4*)(lds + HY_FC + (ch - 1) * 16);
    uint4 hi = *(const uint4*)(lds + HY_FC + ch * 16);
    unsigned W[8] = {lo.x, lo.y, lo.z, lo.w, hi.x, hi.y, hi.z, hi.w};
    uint4 ov;
    if (r == 1) {
      ov.x = __builtin_amdgcn_alignbyte(W[4], W[3], 2); ov.y = __builtin_amdgcn_alignbyte(W[5], W[4], 2);
      ov.z = __builtin_amdgcn_alignbyte(W[6], W[5], 2); ov.w = __builtin_amdgcn_alignbyte(W[7], W[6], 2);
    } else if (r == 2) {
      ov.x = W[3]; ov.y = W[4]; ov.z = W[5]; ov.w = W[6];
    } else {
      ov.x = __builtin_amdgcn_alignbyte(W[3], W[2], 2); ov.y = __builtin_amdgcn_alignbyte(W[4], W[3], 2);
      ov.z = __builtin_amdgcn_alignbyte(W[5], W[4], 2); ov.w = __builtin_amdgcn_alignbyte(W[6], W[5], 2);
    }
    *(uint4*)(lds + HY_FC + r * (FCLEN * 2) + ch * 16) = ov;
  }
  __syncthreads();
}

__device__ __forceinline__ void hy_order(const Params& p, int o, int c, unsigned char* lds) {
  const int tid = threadIdx.x, wid = __builtin_amdgcn_readfirstlane(tid >> 6), lane = tid & 63;
  const int g0 = wid * 4;
  const int n16 = lane & 15, h = lane >> 4, bb = n16 & 7, pp = n16 >> 3;
  const unsigned char* Zin = lds + (o ? HY_ZT1 : HY_ZT0);
  const bf16_t* gate = p.Ut + (size_t)((o + 1) * 512 + c) * T + bb * L;
  uint2 xg[4][2];
#pragma unroll
  for (int i = 0; i < 4; ++i)
#pragma unroll
    for (int u = 0; u < 2; ++u) xg[i][u] = *(const uint2*)(gate + 32 * (2 * (g0 + i) + pp) + 16 * u + 4 * h);
  const float bias = p.hy_bias[o * 512 + c];
  hf32x4 acc[4][2];
#pragma unroll
  for (int i = 0; i < 4; ++i)
#pragma unroll
    for (int u = 0; u < 2; ++u) acc[i][u] = (hf32x4){0.f, 0.f, 0.f, 0.f};
  const int ai = lane & 15, ar = ai & 3, aq = ai >> 2;
  const unsigned char* laneA = lds + HY_FC + ar * (FCLEN * 2) + 2 * (HX0 - 4 * aq + 8 * h);
  const unsigned char* laneB = Zin + bb * ZSTRB + 64 + 64 * pp + 16 * h;
#define HY_LDA(dst, Dd) do { const uint2 _lo = *(const uint2*)(laneA - 32 * (Dd)); const uint2 _hi = *(const uint2*)(laneA - 32 * (Dd) + 8); \
    union { uint4 u4; hbf16x8 v; } _cv; _cv.u4 = make_uint4(_lo.x, _lo.y, _hi.x, _hi.y); dst = _cv.v; } while (0)
#define HY_LDB(dst, Qq) do { dst = *(const hbf16x8*)(laneB + 64 * (Qq)); } while (0)
#pragma unroll 1
  for (int pass = 0; pass < 2; ++pass) {
    const int Es = 2 * g0 - 63 + pass;
    hbf16x8 R[4];
    HY_LDB(R[1], 2 * (g0 + 1) - Es); HY_LDB(R[2], 2 * (g0 + 2) - Es); HY_LDB(R[3], 2 * (g0 + 3) - Es);
#pragma unroll 1
    for (int n4 = 0; n4 < 9; ++n4) {
#pragma unroll
      for (int j = 0; j < 4; ++j) {
        const int n = n4 * 4 + j;
        const int E = Es + 2 * n;
        HY_LDB(R[(4 - j) & 3], 2 * (g0 - n) - Es);
        hbf16x8 A0, A1;
        HY_LDA(A0, 2 * E); HY_LDA(A1, 2 * E + 1);
#pragma unroll
        for (int i = 0; i < 4; ++i) {
          const int Q = 2 * (g0 + i - n) - Es;
          if (Q >= -1 && Q <= 63) {
            acc[i][0] = __builtin_amdgcn_mfma_f32_16x16x32_bf16(A0, R[(i - j) & 3], acc[i][0], 0, 0, 0);
            acc[i][1] = __builtin_amdgcn_mfma_f32_16x16x32_bf16(A1, R[(i - j) & 3], acc[i][1], 0, 0, 0);
          }
        }
      }
    }
  }
#undef HY_LDA
#undef HY_LDB
#pragma unroll
  for (int i = 0; i < 4; ++i)
#pragma unroll
    for (int u = 0; u < 2; ++u) {
      const int t0 = 32 * (2 * (g0 + i) + pp) + 16 * u + 4 * h;
      const uint2 zv = *(const uint2*)(Zin + bb * ZSTRB + 64 + 2 * t0);
      const float z0 = __uint_as_float(zv.x << 16), z1 = __uint_as_float(zv.x & 0xffff0000u), z2 = __uint_as_float(zv.y << 16), z3 = __uint_as_float(zv.y & 0xffff0000u);
      const float x0 = __uint_as_float(xg[i][u].x << 16), x1 = __uint_as_float(xg[i][u].x & 0xffff0000u), x2 = __uint_as_float(xg[i][u].y << 16), x3 = __uint_as_float(xg[i][u].y & 0xffff0000u);
      const float r0 = x0 * (acc[i][u][0] + z0 * bias), r1 = x1 * (acc[i][u][1] + z1 * bias), r2 = x2 * (acc[i][u][2] + z2 * bias), r3 = x3 * (acc[i][u][3] + z3 * bias);
      uint2 w; w.x = cvt_pk_bf16(r0, r1); w.y = cvt_pk_bf16(r2, r3);
      if (o == 0) *(uint2*)(lds + HY_ZT1 + bb * ZSTRB + 64 + 2 * t0) = w;
      else *(uint2*)(p.Yt + (size_t)c * T + bb * L + t0) = w;
    }
}

__device__ void hyena_unit(const Params& p, int c, unsigned char* lds) {
  const int tid = threadIdx.x;
  if (tid < 144) {
    const int buf = tid / 72, rem = tid % 72, b = rem / 9, k = rem % 9;
    const int off = (k < 4) ? (k * 16) : (4160 + (k - 4) * 16);
    *(uint4*)(lds + (buf ? HY_ZT1 : HY_ZT0) + b * ZSTRB + off) = make_uint4(0u, 0u, 0u, 0u);
  }
  for (int e = tid; e < 2048; e += NTHR) {
    const int b = e >> 8, ch = e & 255;
    *(uint4*)(lds + HY_ZT0 + b * ZSTRB + 64 + ch * 16) = *(const uint4*)(p.Ut + (size_t)c * T + b * L + ch * 8);
  }
#pragma unroll 1
  for (int o = 0; o < 2; ++o) {
    hy_build_filter(p, o, c, lds);
    hy_order(p, o, c, lds);
    __syncthreads();
  }
}

constexpr int SROW = 272;

__device__ __forceinline__ void ssd_stage_nat(const Params& p, int row0, int pxcol0, int cvcol0, unsigned char* dst) {
  for (int e = threadIdx.x; e < 2048; e += NTHR) {
    const int l = e >> 4, cg = e & 15;
    const int row = row0 + l, li = row & 63;
    const bf16_t* src = p.PXb + (size_t)row * DP + pxcol0 + cg * 8;
    const uint4 zero4 = make_uint4(0u, 0u, 0u, 0u);
    const uint4 cur = *(const uint4*)src;
    const uint4 prv = (li > 0) ? *(const uint4*)(src - DP) : zero4;
    const uint4 nxt = (li < 63) ? *(const uint4*)(src + DP) : zero4;
    const float* cw = p.ssd_conv_w + cvcol0 + cg * 8;
    const float* cb = p.ssd_conv_b + cvcol0 + cg * 8;
    const unsigned pc[4] = {prv.x, prv.y, prv.z, prv.w}, cc[4] = {cur.x, cur.y, cur.z, cur.w}, nc[4] = {nxt.x, nxt.y, nxt.z, nxt.w};
    float o[8];
#pragma unroll
    for (int k = 0; k < 4; ++k) {
      const float p0 = __uint_as_float(pc[k] << 16), p1 = __uint_as_float(pc[k] & 0xffff0000u);
      const float c0 = __uint_as_float(cc[k] << 16), c1 = __uint_as_float(cc[k] & 0xffff0000u);
      const float n0 = __uint_as_float(nc[k] << 16), n1 = __uint_as_float(nc[k] & 0xffff0000u);
      const float v0 = cb[2 * k] + cw[2 * k] * p0 + cw[DXBC + 2 * k] * c0 + cw[2 * DXBC + 2 * k] * n0;
      const float v1 = cb[2 * k + 1] + cw[2 * k + 1] * p1 + cw[DXBC + 2 * k + 1] * c1 + cw[2 * DXBC + 2 * k + 1] * n1;
      o[2 * k] = silu_f(v0); o[2 * k + 1] = silu_f(v1);
    }
    uint4 w; w.x = cvt_pk_bf16(o[0], o[1]); w.y = cvt_pk_bf16(o[2], o[3]); w.z = cvt_pk_bf16(o[4], o[5]); w.w = cvt_pk_bf16(o[6], o[7]);
    *(uint4*)(dst + l * SROW + cg * 16) = w;
  }
}

__device__ __forceinline__ void ssd_stage_tr(const Params& p, int row0, bool is_ctx, int pxcol0, int cvcol0, int ncols, unsigned char* dst) {
  const int ncg = ncols >> 2;
  for (int e = threadIdx.x; e < ncg * 16; e += NTHR) {
    const int cg = e % ncg, l8 = e / ncg;
    const int rowf = row0 + l8 * 8;
    bool has_prev, has_next;
    if (is_ctx) { const int tc = (rowf - T) & (LC - 1); has_prev = tc > 0; has_next = tc + 7 < LC - 1; }
    else { const int li = rowf & 63; has_prev = li > 0; has_next = li + 7 < 63; }
    const bf16_t* src = p.PXb + (size_t)rowf * DP + pxcol0 + cg * 4;
    const uint2 z2 = make_uint2(0u, 0u);
    uint2 raw[10];
    raw[0] = *(const uint2*)((cvcol0 >= 0 && has_prev) ? (src - DP) : src);
    if (!(cvcol0 >= 0 && has_prev)) raw[0] = z2;
#pragma unroll
    for (int k = 0; k < 8; ++k) raw[k + 1] = *(const uint2*)(src + (size_t)k * DP);
    raw[9] = *(const uint2*)((cvcol0 >= 0 && has_next) ? (src + (size_t)8 * DP) : src);
    if (!(cvcol0 >= 0 && has_next)) raw[9] = z2;
    unsigned outw[4][4];
    if (cvcol0 >= 0) {
      const float* cw = p.ssd_conv_w + cvcol0 + cg * 4; const float* cb = p.ssd_conv_b + cvcol0 + cg * 4;
      const float4 a0 = *(const float4*)cw, b0 = *(const float4*)(cw + DXBC), c0 = *(const float4*)(cw + 2 * DXBC), d0 = *(const float4*)cb;
      const float w0[4] = {a0.x, a0.y, a0.z, a0.w}, w1[4] = {b0.x, b0.y, b0.z, b0.w}, w2[4] = {c0.x, c0.y, c0.z, c0.w}, bb[4] = {d0.x, d0.y, d0.z, d0.w};
#pragma unroll
      for (int kp = 0; kp < 4; ++kp) {
#pragma unroll
        for (int c = 0; c < 4; ++c) {
          const unsigned q0 = (c >> 1) ? raw[2 * kp].y : raw[2 * kp].x, q1 = (c >> 1) ? raw[2 * kp + 1].y : raw[2 * kp + 1].x;
          const unsigned q2 = (c >> 1) ? raw[2 * kp + 2].y : raw[2 * kp + 2].x, q3 = (c >> 1) ? raw[2 * kp + 3].y : raw[2 * kp + 3].x;
          float x0, x1, x2, x3;
          if (c & 1) { x0 = __uint_as_float(q0 & 0xffff0000u); x1 = __uint_as_float(q1 & 0xffff0000u); x2 = __uint_as_float(q2 & 0xffff0000u); x3 = __uint_as_float(q3 & 0xffff0000u); }
          else { x0 = __uint_as_float(q0 << 16); x1 = __uint_as_float(q1 << 16); x2 = __uint_as_float(q2 << 16); x3 = __uint_as_float(q3 << 16); }
          const float oa = silu_f(bb[c] + w0[c] * x0 + w1[c] * x1 + w2[c] * x2);
          const float ob = silu_f(bb[c] + w0[c] * x1 + w1[c] * x2 + w2[c] * x3);
          outw[c][kp] = cvt_pk_bf16(oa, ob);
        }
      }
    } else {
#pragma unroll
      for (int kp = 0; kp < 4; ++kp) {
#pragma unroll
        for (int c = 0; c < 4; ++c) {
          const unsigned q1 = (c >> 1) ? raw[2 * kp + 1].y : raw[2 * kp + 1].x, q2 = (c >> 1) ? raw[2 * kp + 2].y : raw[2 * kp + 2].x;
          outw[c][kp] = (c & 1) ? ((q1 >> 16) | (q2 & 0xffff0000u)) : ((q1 & 0xffffu) | (q2 << 16));
        }
      }
    }
#pragma unroll
    for (int c = 0; c < 4; ++c)
      *(uint4*)(dst + (cg * 4 + c) * SROW + l8 * 16) = make_uint4(outw[c][0], outw[c][1], outw[c][2], outw[c][3]);
  }
}

__device__ __forceinline__ void ssd_stage_tr_s(const Params& p, int row0, bool is_ctx, int pxcol0, int cvcol0, int ncols, unsigned char* dst) {
  for (int e = threadIdx.x; e < ncols * 16; e += NTHR) {
    const int col = e & (ncols - 1), l8 = e / ncols;
    const int rowf = row0 + l8 * 8;
    bool has_prev, has_next;
    if (is_ctx) { const int tc = (rowf - T) & (LC - 1); has_prev = tc > 0; has_next = tc + 7 < LC - 1; }
    else { const int li = rowf & 63; has_prev = li > 0; has_next = li + 7 < 63; }
    const bf16_t* src = p.PXb + (size_t)rowf * DP + pxcol0 + col;
    float x[10];
    x[0] = (cvcol0 >= 0 && has_prev) ? bf2f(src[-DP]) : 0.f;
#pragma unroll
    for (int k = 0; k < 8; ++k) x[k + 1] = bf2f(src[(size_t)k * DP]);
    x[9] = (cvcol0 >= 0 && has_next) ? bf2f(src[(size_t)8 * DP]) : 0.f;
    float o[8];
    if (cvcol0 >= 0) {
      const float w0 = p.ssd_conv_w[cvcol0 + col], w1 = p.ssd_conv_w[DXBC + cvcol0 + col], w2 = p.ssd_conv_w[2 * DXBC + cvcol0 + col], bb = p.ssd_conv_b[cvcol0 + col];
#pragma unroll
      for (int k = 0; k < 8; ++k) o[k] = silu_f(bb + w0 * x[k] + w1 * x[k + 1] + w2 * x[k + 2]);
    } else {
#pragma unroll
      for (int k = 0; k < 8; ++k) o[k] = x[k + 1];
    }
    uint4 w; w.x = cvt_pk_bf16(o[0], o[1]); w.y = cvt_pk_bf16(o[2], o[3]); w.z = cvt_pk_bf16(o[4], o[5]); w.w = cvt_pk_bf16(o[6], o[7]);
    *(uint4*)(dst + col * SROW + l8 * 16) = w;
  }
}

__device__ void ssd_states_unit(const Params& p, int unit, unsigned char* lds) {
  const int tid = threadIdx.x, wid = __builtin_amdgcn_readfirstlane(tid >> 6), lane = tid & 63;
  const int g = unit & 1, bc = unit >> 1, cidx = bc % 18, b = bc / 18;
  const bool is_ctx = cidx < 2;
  const int row0 = is_ctx ? (T + b * LC + cidx * 128) : (b * L + (cidx - 2) * 128);
  unsigned char* XT = lds;
  unsigned char* BT = lds + 69632;
  unsigned char* XD = lds + 104448;
  float* WG = (float*)(lds + 121856);
  ssd_stage_tr(p, row0, is_ctx, COL_XBC + g * 256, g * 256, 256, XT);
  ssd_stage_tr(p, row0, is_ctx, COL_XBC + 512 + g * 128, 512 + g * 128, 128, BT);
  {
    const int dir = wid >> 2, hh = wid & 3, h = g * 4 + hh;
    const float A = expf(p.a_log[dir * 8 + h]);
    const int l0 = 2 * lane, l1 = l0 + 1;
    const float dt0 = softplus_f(p.DT[(size_t)(row0 + l0) * 16 + dir * 8 + h]), dt1 = softplus_f(p.DT[(size_t)(row0 + l1) * 16 + dir * 8 + h]);
    const float a0 = -A * dt0, a1 = -A * dt1, pair = a0 + a1;
    float incl = pair;
#pragma unroll
    for (int o = 1; o < 64; o <<= 1) { float t = __shfl_up(incl, o); if (lane >= o) incl += t; }
    const float excl = incl - pair;
    const float total = __shfl(incl, 63);
    float w0, w1, c0, c1;
    if (dir == 0) { c0 = excl + a0; c1 = excl + pair; w0 = dt0 * expf(total - c0); w1 = dt1 * expf(total - c1); }
    else { const float pe0 = excl, pe1 = excl + a0; w0 = dt0 * expf(pe0); w1 = dt1 * expf(pe1); c0 = total - pe0; c1 = total - pe1; }
    WG[wid * 128 + l0] = w0; WG[wid * 128 + l1] = w1;
    if (!is_ctx) { float* ac = p.ACUM + (size_t)(b * 16 + dir * 8 + h) * L + (cidx - 2) * 128; *(float2*)(ac + l0) = make_float2(c0, c1); }
    if (lane == 0) {
      const int k = dir ? (is_ctx ? (1 - cidx) : (19 - cidx)) : cidx;
      p.CDEC[(size_t)(((b * 2 + dir) * 8 + h) * 18 + k) * 32] = expf(total);
    }
  }
  __syncthreads();
  const int fr = lane & 15, fq = lane >> 4;
#pragma unroll 1
  for (int it = 0; it < 8; ++it) {
    const int dir = it >> 2, hh = it & 3, h = g * 4 + hh;
    for (int e = tid; e < 1024; e += NTHR) {
      const int pr = e >> 4, ch = e & 15;
      const uint4 v = *(const uint4*)(XT + (hh * 64 + pr) * SROW + ch * 16);
      const float4 wa = *(const float4*)(WG + it * 128 + ch * 8), wb = *(const float4*)(WG + it * 128 + ch * 8 + 4);
      uint4 w;
      w.x = cvt_pk_bf16(__uint_as_float(v.x << 16) * wa.x, __uint_as_float(v.x & 0xffff0000u) * wa.y);
      w.y = cvt_pk_bf16(__uint_as_float(v.y << 16) * wa.z, __uint_as_float(v.y & 0xffff0000u) * wa.w);
      w.z = cvt_pk_bf16(__uint_as_float(v.z << 16) * wb.x, __uint_as_float(v.z & 0xffff0000u) * wb.y);
      w.w = cvt_pk_bf16(__uint_as_float(v.w << 16) * wb.z, __uint_as_float(v.w & 0xffff0000u) * wb.w);
      *(uint4*)(XD + pr * SROW + ch * 16) = w;
    }
    __syncthreads();
    hf32x4 acc[4];
#pragma unroll
    for (int pt = 0; pt < 4; ++pt) acc[pt] = (hf32x4){0.f, 0.f, 0.f, 0.f};
#pragma unroll
    for (int kk = 0; kk < 4; ++kk) {
      const hbf16x8 Bf = *(const hbf16x8*)(BT + (16 * wid + fr) * SROW + 2 * (32 * kk + 8 * fq));
#pragma unroll
      for (int pt = 0; pt < 4; ++pt) {
        const hbf16x8 Af = *(const hbf16x8*)(XD + (16 * pt + fr) * SROW + 2 * (32 * kk + 8 * fq));
        acc[pt] = __builtin_amdgcn_mfma_f32_16x16x32_bf16(Bf, Af, acc[pt], 0, 0, 0);
      }
    }
    const int k = dir ? (is_ctx ? (1 - cidx) : (19 - cidx)) : cidx;
    bf16_t* slot = p.SST + ((size_t)(((b * 2 + dir) * 8 + h) * 18 + k)) * 8192;
#pragma unroll
    for (int pt = 0; pt < 4; ++pt)
      *(uint2*)(slot + (16 * pt + fr) * 128 + 16 * wid + 4 * fq) = make_uint2(cvt_pk_bf16(acc[pt][0], acc[pt][1]), cvt_pk_bf16(acc[pt][2], acc[pt][3]));
    __syncthreads();
  }
}

__device__ void ssd_scan_unit(const Params& p, int unit) {
  const int tid = threadIdx.x;
  const int half = unit & 1, seq = unit >> 1;
  const int pr = half * 32 + (tid >> 4), n8 = (tid & 15) * 8;
  const bf16_t* base = p.SST + (size_t)seq * 18 * 8192 + pr * 128 + n8;
  uint4 sv[18];
#pragma unroll
  for (int k = 0; k < 18; ++k) sv[k] = *(const uint4*)(base + (size_t)k * 8192);
  float hst[8];
#pragma unroll
  for (int j = 0; j < 8; ++j) hst[j] = 0.f;
#pragma unroll
  for (int k = 0; k < 18; ++k) {
    const float dec = p.CDEC[(size_t)(seq * 18 + k) * 32];
    if (k >= 2) {
      uint4 w; w.x = cvt_pk_bf16(hst[0], hst[1]); w.y = cvt_pk_bf16(hst[2], hst[3]); w.z = cvt_pk_bf16(hst[4], hst[5]); w.w = cvt_pk_bf16(hst[6], hst[7]);
      *(uint4*)(p.HIN + ((size_t)seq * 16 + (k - 2)) * 8192 + pr * 128 + n8) = w;
    }
    const unsigned sw[4] = {sv[k].x, sv[k].y, sv[k].z, sv[k].w};
#pragma unroll
    for (int u = 0; u < 4; ++u) {
      hst[2 * u] = dec * hst[2 * u] + __uint_as_float(sw[u] << 16);
      hst[2 * u + 1] = dec * hst[2 * u + 1] + __uint_as_float(sw[u] & 0xffff0000u);
    }
  }
}

__device__ void ssd_out_unit(const Params& p, int unit, unsigned char* lds) {
  const int tid = threadIdx.x, wid = __builtin_amdgcn_readfirstlane(tid >> 6), lane = tid & 63;
  const int fr = lane & 15, fq = lane >> 4;
  const int g = unit & 1, bc = unit >> 1, c = bc & 15, b = bc >> 4;
  const int row0 = b * L + c * 128;
  unsigned char* CS = lds;
  unsigned char* ML = lds + 34816;
  unsigned char* XT = lds + 69632;
  unsigned char* ZT = lds + 87040;
  unsigned char* HS = lds + 104448;
  float* CUM = (float*)(lds + 121856);
  float* DTL = (float*)(lds + 125952);
  ssd_stage_nat(p, row0, COL_XBC + 768 + g * 128, 768 + g * 128, CS);
  ssd_stage_nat(p, row0, COL_XBC + 512 + g * 128, 512 + g * 128, ML);
  for (int e = tid; e < 1024; e += NTHR) {
    const int it = e >> 7, l = e & 127, dir = it >> 2, hh = it & 3;
    CUM[e] = p.ACUM[(size_t)(b * 16 + dir * 8 + g * 4 + hh) * L + c * 128 + l];
    DTL[e] = softplus_f(p.DT[(size_t)(row0 + l) * 16 + dir * 8 + g * 4 + hh]);
  }
  __syncthreads();
  hf32x4 cbt[8];
#pragma unroll
  for (int lt = 0; lt < 8; ++lt) cbt[lt] = (hf32x4){0.f, 0.f, 0.f, 0.f};
#pragma unroll
  for (int kk = 0; kk < 4; ++kk) {
    const hbf16x8 Af = *(const hbf16x8*)(ML + (16 * wid + fr) * SROW + 2 * (32 * kk + 8 * fq));
#pragma unroll
    for (int lt = 0; lt < 8; ++lt) {
      const hbf16x8 Bf = *(const hbf16x8*)(CS + (16 * lt + fr) * SROW + 2 * (32 * kk + 8 * fq));
      cbt[lt] = __builtin_amdgcn_mfma_f32_16x16x32_bf16(Af, Bf, cbt[lt], 0, 0, 0);
    }
  }
  __syncthreads();
  hf32x4 y[4][4];
#pragma unroll
  for (int hh = 0; hh < 4; ++hh)
#pragma unroll
    for (int pt = 0; pt < 4; ++pt) y[hh][pt] = (hf32x4){0.f, 0.f, 0.f, 0.f};
  const int sb = 16 * wid + 4 * fq;
#pragma unroll 1
  for (int hh = 0; hh < 4; ++hh) {
    const int h = g * 4 + hh;
    hf32x4 yc[4];
#pragma unroll
    for (int pt = 0; pt < 4; ++pt) yc[pt] = (hf32x4){0.f, 0.f, 0.f, 0.f};
    ssd_stage_tr_s(p, row0, false, COL_XBC + g * 256 + hh * 64, g * 256 + hh * 64, 64, XT);
    ssd_stage_tr_s(p, row0, false, COL_Z + g * 256 + hh * 64, -1, 64, ZT);
#pragma unroll 1
    for (int dir = 0; dir < 2; ++dir) {
      const int it = dir * 4 + hh;
      const int k = dir ? (17 - c) : (c + 2);
      const bf16_t* slot = p.HIN + ((size_t)(((b * 2 + dir) * 8 + h) * 16 + (k - 2))) * 8192;
      for (int e = tid; e < 1024; e += NTHR) {
        const int pr = e >> 4, ch = e & 15;
        *(uint4*)(HS + pr * SROW + ch * 16) = *(const uint4*)(slot + pr * 128 + ch * 8);
      }
      {
        const float* cu = CUM + it * 128; const float* dl = DTL + it * 128;
        float cs[4], ds[4];
#pragma unroll
        for (int r = 0; r < 4; ++r) { cs[r] = cu[sb + r]; ds[r] = dl[sb + r]; }
#pragma unroll
        for (int lt = 0; lt < 8; ++lt) {
          const int l = 16 * lt + fr;
          const float cl = cu[l];
          float m[4];
#pragma unroll
          for (int r = 0; r < 4; ++r) {
            const int sidx = sb + r;
            const bool ok = dir ? (sidx >= l) : (sidx <= l);
            m[r] = ok ? cbt[lt][r] * __expf(cl - cs[r]) * ds[r] : 0.f;
          }
          uint2 w; w.x = cvt_pk_bf16(m[0], m[1]); w.y = cvt_pk_bf16(m[2], m[3]);
          *(uint2*)(ML + l * SROW + 2 * sb) = w;
        }
      }
      __syncthreads();
      hf32x4 ad[4], ao[4];
#pragma unroll
      for (int pt = 0; pt < 4; ++pt) { ad[pt] = (hf32x4){0.f, 0.f, 0.f, 0.f}; ao[pt] = (hf32x4){0.f, 0.f, 0.f, 0.f}; }
#pragma unroll
      for (int kk = 0; kk < 4; ++kk) {
        const hbf16x8 Am = *(const hbf16x8*)(ML + (16 * wid + fr) * SROW + 2 * (32 * kk + 8 * fq));
        const hbf16x8 Ac = *(const hbf16x8*)(CS + (16 * wid + fr) * SROW + 2 * (32 * kk + 8 * fq));
#pragma unroll
        for (int pt = 0; pt < 4; ++pt) {
          const hbf16x8 Bx = *(const hbf16x8*)(XT + (16 * pt + fr) * SROW + 2 * (32 * kk + 8 * fq));
          const hbf16x8 Bh = *(const hbf16x8*)(HS + (16 * pt + fr) * SROW + 2 * (32 * kk + 8 * fq));
          ad[pt] = __builtin_amdgcn_mfma_f32_16x16x32_bf16(Am, Bx, ad[pt], 0, 0, 0);
          ao[pt] = __builtin_amdgcn_mfma_f32_16x16x32_bf16(Ac, Bh, ao[pt], 0, 0, 0);
        }
      }
      {
        const float* cu = CUM + it * 128;
        float ex[4];
#pragma unroll
        for (int r = 0; r < 4; ++r) ex[r] = __expf(cu[sb + r]);
#pragma unroll
        for (int pt = 0; pt < 4; ++pt)
#pragma unroll
          for (int r = 0; r < 4; ++r) yc[pt][r] += ad[pt][r] + ex[r] * ao[pt][r];
      }
      __syncthreads();
    }
    {
      const float dsk = p.ssd_d[h];
#pragma unroll
      for (int pt = 0; pt < 4; ++pt) {
        const uint2 xv = *(const uint2*)(XT + (16 * pt + fr) * SROW + 2 * sb);
        const uint2 zv = *(const uint2*)(ZT + (16 * pt + fr) * SROW + 2 * sb);
        const float xs4[4] = {__uint_as_float(xv.x << 16), __uint_as_float(xv.x & 0xffff0000u), __uint_as_float(xv.y << 16), __uint_as_float(xv.y & 0xffff0000u)};
        const float zs4[4] = {__uint_as_float(zv.x << 16), __uint_as_float(zv.x & 0xffff0000u), __uint_as_float(zv.y << 16), __uint_as_float(zv.y & 0xffff0000u)};
#pragma unroll
        for (int r = 0; r < 4; ++r) yc[pt][r] = (yc[pt][r] + dsk * xs4[r]) * silu_f(zs4[r]);
      }
    }
    if (hh == 0) {
#pragma unroll
      for (int pt = 0; pt < 4; ++pt) y[0][pt] = yc[pt];
    } else if (hh == 1) {
#pragma unroll
      for (int pt = 0; pt < 4; ++pt) y[1][pt] = yc[pt];
    } else if (hh == 2) {
#pragma unroll
      for (int pt = 0; pt < 4; ++pt) y[2][pt] = yc[pt];
    } else {
#pragma unroll
      for (int pt = 0; pt < 4; ++pt) y[3][pt] = yc[pt];
    }
    __syncthreads();
  }
  float rinv[4];
#pragma unroll
  for (int r = 0; r < 4; ++r) {
    float ss = 0.f;
#pragma unroll
    for (int hh = 0; hh < 4; ++hh)
#pragma unroll
      for (int pt = 0; pt < 4; ++pt) ss += y[hh][pt][r] * y[hh][pt][r];
    ss += __shfl_xor(ss, 1); ss += __shfl_xor(ss, 2); ss += __shfl_xor(ss, 4); ss += __shfl_xor(ss, 8);
    rinv[r] = rsqrtf(ss * (1.f / 256.f) + EPS);
  }
  {
    bf16_t* OT = (bf16_t*)lds;
#pragma unroll
    for (int hh = 0; hh < 4; ++hh)
#pragma unroll
      for (int pt = 0; pt < 4; ++pt) {
        const int chl = hh * 64 + 16 * pt + fr;
        const float ng = p.ssd_norm_g[g * 256 + chl];
#pragma unroll
        for (int r = 0; r < 4; ++r) OT[(sb + r) * 264 + chl] = f2bf(y[hh][pt][r] * rinv[r] * ng);
      }
    __syncthreads();
    for (int e = tid; e < 128 * 32; e += NTHR) {
      const int l = e >> 5, ch8 = (e & 31) * 8;
      *(uint4*)(p.YMIXb + (size_t)(row0 + l) * D + 512 + g * 256 + ch8) = *(const uint4*)(OT + l * 264 + ch8);
    }
  }
}

__device__ void ph_router(const Params& p, unsigned char* lds) {
  const int tid = threadIdx.x, wid = __builtin_amdgcn_readfirstlane(tid >> 6), lane = tid & 63;
  const int fr = lane & 15, fq = lane >> 4;
  constexpr int AROW = 272;
  unsigned char* AH = lds;
  unsigned char* AL = lds + 64 * AROW;
  unsigned char* WH = lds + 128 * AROW;
  unsigned char* WL = lds + 224 * AROW;
  float* RS = (float*)(lds + 320 * AROW);
  float* LOG = RS + 64;
  float* GM = LOG + 6400;
  float* SH = GM + 1024;
  int* LC = (int*)(SH + 1024);
  int* LB = LC + 64;
  for (int tile = blockIdx.x; tile < T / 64; tile += gridDim.x) {
    const int row0 = tile * 64;
    const float* shp = p.MOD + (row0 / L) * 6144 + 3072;
    const float* scp = shp + 1024;
    if (tid < 64) {
      const float4* sp = (const float4*)(p.SSQP + (size_t)(row0 + tid) * 16);
      const float4 a0 = sp[0], a1 = sp[1], a2 = sp[2], a3 = sp[3];
      const float ss = ((a0.x + a0.y) + (a0.z + a0.w)) + ((a1.x + a1.y) + (a1.z + a1.w)) + ((a2.x + a2.y) + (a2.z + a2.w)) + ((a3.x + a3.y) + (a3.z + a3.w));
      RS[tid] = rsqrtf(ss * (1.f / D) + EPS);
    }
    for (int e = tid; e < 256; e += NTHR) {
      const float4 g = *(const float4*)(p.g2 + e * 4), s4 = *(const float4*)(scp + e * 4), h4 = *(const float4*)(shp + e * 4);
      *(float4*)(GM + e * 4) = make_float4(g.x * (1.f + s4.x), g.y * (1.f + s4.y), g.z * (1.f + s4.z), g.w * (1.f + s4.w));
      *(float4*)(SH + e * 4) = h4;
    }
    float4 xv[4];
#pragma unroll
    for (int i = 0; i < 4; ++i) { const int e = tid + i * NTHR; xv[i] = *(const float4*)(p.X1 + (size_t)(row0 + (e >> 5)) * D + (e & 31) * 4); }
    const int wj = tid >> 4, wch = tid & 15;
    uint4 wh0, wh1, wh2, wl0, wl1, wl2;
#define RT_LOADW(kn) do { \
      wh0 = *(const uint4*)(p.WRhi + (size_t)(wj) * 1024 + (kn) * 128 + wch * 8); wl0 = *(const uint4*)(p.WRlo + (size_t)(wj) * 1024 + (kn) * 128 + wch * 8); \
      wh1 = *(const uint4*)(p.WRhi + (size_t)(wj + 32) * 1024 + (kn) * 128 + wch * 8); wl1 = *(const uint4*)(p.WRlo + (size_t)(wj + 32) * 1024 + (kn) * 128 + wch * 8); \
      wh2 = *(const uint4*)(p.WRhi + (size_t)(wj + 64) * 1024 + (kn) * 128 + wch * 8); wl2 = *(const uint4*)(p.WRlo + (size_t)(wj + 64) * 1024 + (kn) * 128 + wch * 8); } while (0)
    RT_LOADW(0);
    __syncthreads();
    hf32x4 acc[3];
#pragma unroll
    for (int nt = 0; nt < 3; ++nt) acc[nt] = (hf32x4){0.f, 0.f, 0.f, 0.f};
    const int mt = wid & 3, nh = wid >> 2;
#pragma unroll 1
    for (int kc = 0; kc < 8; ++kc) {
#pragma unroll
      for (int i = 0; i < 4; ++i) {
        const int e = tid + i * NTHR; const int tok = e >> 5, k4 = (e & 31) * 4;
        const int kg = kc * 128 + k4;
        const float4 v = xv[i];
        const float4 g = *(const float4*)(GM + kg);
        const float4 h4 = *(const float4*)(SH + kg);
        const float rstd = RS[tok];
        const float h0 = v.x * rstd * g.x + h4.x, h1 = v.y * rstd * g.y + h4.y;
        const float h2 = v.z * rstd * g.z + h4.z, h3 = v.w * rstd * g.w + h4.w;
        const unsigned hi01 = cvt_pk_bf16(h0, h1), hi23 = cvt_pk_bf16(h2, h3);
        const unsigned lo01 = cvt_pk_bf16(h0 - __uint_as_float(hi01 << 16), h1 - __uint_as_float(hi01 & 0xffff0000u));
        const unsigned lo23 = cvt_pk_bf16(h2 - __uint_as_float(hi23 << 16), h3 - __uint_as_float(hi23 & 0xffff0000u));
        *(uint2*)(AH + tok * AROW + k4 * 2) = make_uint2(hi01, hi23);
        *(uint2*)(AL + tok * AROW + k4 * 2) = make_uint2(lo01, lo23);
        *(uint2*)(p.H2b + (size_t)(row0 + tok) * D + kg) = make_uint2(hi01, hi23);
      }
      *(uint4*)(WH + wj * AROW + wch * 16) = wh0; *(uint4*)(WL + wj * AROW + wch * 16) = wl0;
      *(uint4*)(WH + (wj + 32) * AROW + wch * 16) = wh1; *(uint4*)(WL + (wj + 32) * AROW + wch * 16) = wl1;
      *(uint4*)(WH + (wj + 64) * AROW + wch * 16) = wh2; *(uint4*)(WL + (wj + 64) * AROW + wch * 16) = wl2;
      {
        const int kn = (kc + 1 < 8) ? (kc + 1) : kc;
#pragma unroll
        for (int i = 0; i < 4; ++i) { const int e = tid + i * NTHR; xv[i] = *(const float4*)(p.X1 + (size_t)(row0 + (e >> 5)) * D + kn * 128 + (e & 31) * 4); }
        RT_LOADW(kn);
      }
      __syncthreads();
#pragma unroll
      for (int kk = 0; kk < 4; ++kk) {
        const hbf16x8 Ahi = *(const hbf16x8*)(AH + (16 * mt + fr) * AROW + 2 * (32 * kk + 8 * fq));
        const hbf16x8 Alo = *(const hbf16x8*)(AL + (16 * mt + fr) * AROW + 2 * (32 * kk + 8 * fq));
#pragma unroll
        for (int nt = 0; nt < 3; ++nt) {
          const int wo = (16 * (nh * 3 + nt) + fr) * AROW + 2 * (32 * kk + 8 * fq);
          const hbf16x8 Bhi = *(const hbf16x8*)(WH + wo);
          const hbf16x8 Blo = *(const hbf16x8*)(WL + wo);
          acc[nt] = __builtin_amdgcn_mfma_f32_16x16x32_bf16(Ahi, Bhi, acc[nt], 0, 0, 0);
          acc[nt] = __builtin_amdgcn_mfma_f32_16x16x32_bf16(Ahi, Blo, acc[nt], 0, 0, 0);
          acc[nt] = __builtin_amdgcn_mfma_f32_16x16x32_bf16(Alo, Bhi, acc[nt], 0, 0, 0);
        }
      }
      __syncthreads();
    }
    if (tid < 64) LC[tid] = 0;
#pragma unroll
    for (int nt = 0; nt < 3; ++nt)
#pragma unroll
      for (int r = 0; r < 4; ++r) LOG[(16 * mt + 4 * fq + r) * 100 + 16 * (nh * 3 + nt) + fr] = acc[nt][r];
    __syncthreads();
    int ea = 0, eb = 0, sa = 0, sb2 = 0;
    if (tid < 64) {
      const float* lg = LOG + tid * 100;
      const int row = row0 + tid;
      int gs = 0; float gm = lg[64] + p.b_group[0];
      float gl[8];
      gl[0] = gm;
#pragma unroll
      for (int j = 1; j < 8; ++j) { gl[j] = lg[64 + j] + p.b_group[j]; if (gl[j] > gm) { gm = gl[j]; gs = j; } }
      float den = 0.f;
#pragma unroll
      for (int j = 0; j < 8; ++j) den += expf(gl[j] - gm);
      const float pg = 1.f / den;
      float el[8];
#pragma unroll
      for (int j = 0; j < 8; ++j) el[j] = 0.f;
      for (int j = 0; j < 8; ++j) el[j] = lg[gs * 8 + j] + p.b_expert[gs * 8 + j];
      int i0 = 0; float l0 = el[0];
#pragma unroll
      for (int j = 1; j < 8; ++j) if (el[j] > l0) { l0 = el[j]; i0 = j; }
      int i1 = -1; float l1 = -3.0e38f;
#pragma unroll
      for (int j = 0; j < 8; ++j) if (j != i0 && el[j] > l1) { l1 = el[j]; i1 = j; }
      const float e1 = expf(l1 - l0);
      const float w0 = 1.f / (1.f + e1), w1 = e1 / (1.f + e1);
      p.GATE[row * 2 + 0] = w0 * pg;
      p.GATE[row * 2 + 1] = w1 * pg;
      ea = gs * 8 + i0; eb = gs * 8 + i1;
      sa = atomicAdd(&LC[ea], 1);
      sb2 = atomicAdd(&LC[eb], 1);
    }
    __syncthreads();
    if (tid < 64) { const int n = LC[tid]; LB[tid] = n ? atomicAdd(&p.CNT[tid * 32], n) : 0; }
    __syncthreads();
    if (tid < 64) {
      const int row = row0 + tid;
      p.LIST[ea * T + LB[ea] + sa] = row * 2 + 0;
      p.LIST[eb * T + LB[eb] + sb2] = row * 2 + 1;
    }
    __syncthreads();
  }
}

__device__ __forceinline__ void moe_table(const Params& p, int* tab) {
  if (threadIdx.x == 0) {
    int a = 0, sg = 0;
    for (int e = 0; e < NE; ++e) {
      int cn = p.CNT[e * 32];
      tab[e] = a; tab[65 + e] = sg; tab[130 + e] = cn;
      a += (cn + 255) >> 8; sg += ((cn + 127) >> 7) << 7;
    }
    tab[NE] = a; tab[65 + NE] = sg;
  }
  __syncthreads();
}

template <bool UP>
__device__ void moe_gemm_phase(const Params& p, unsigned char* lds, const int* tab) {
  constexpr int K = UP ? 1024 : 512;
  constexpr int NKT = K / 32;
  constexpr int LDB = UP ? 512 : 1024;
  const int tid = threadIdx.x, wid = __builtin_amdgcn_readfirstlane(tid >> 6), lane = tid & 63, fr = lane & 15, fq = lane >> 4;
  const int wm = wid >> 1, wn = wid & 1;
  constexpr int AOFF0 = 0, AOFF1 = 16384, BOFF0 = 32768, BOFF1 = 32768 + 256 * 80;
  const int total = tab[64] * 4;
  for (int ui = blockIdx.x; ui < total; ui += gridDim.x) {
    int e = 0;
    while (tab[e + 1] * 4 <= ui) ++e;
    const int local = ui - tab[e] * 4;
    const int mu = local >> 2, nt = local & 3;
    const int cnt = tab[130 + e], seg = tab[65 + e];
    const int rem = cnt - mu * 256;
    const bool full = rem > 128;
    const bool active = full || wm < 2;
    const int srow = tid >> 2, spc = tid & 3;
    unsigned aoffs[2];
#pragma unroll
    for (int i = 0; i < 2; ++i) {
      const int row = srow + 128 * i;
      int idx = mu * 256 + row;
      unsigned rowb;
      if (UP) { if (idx > cnt - 1) idx = cnt - 1; rowb = (unsigned)(p.LIST[e * T + idx] >> 1) * (unsigned)(K * 2); }
      else rowb = (unsigned)(seg + idx) * (unsigned)(K * 2);
      aoffs[i] = rowb + (unsigned)((spc ^ ((row >> 2) & 3)) * 16);
    }
    const char* Abase = UP ? (const char*)p.H2b : (const char*)p.HBb;
    const float* bsrc;
    if (UP) bsrc = ((lane < 32) ? p.w1 : p.w3) + (size_t)e * 1024 * 512 + nt * 128 + 4 * (lane & 31) + (size_t)(4 * wid) * LDB;
    else bsrc = p.w2 + (size_t)e * 512 * 1024 + nt * 256 + 4 * lane + (size_t)(4 * wid) * LDB;
    hf32x4 acc[4][8];
#pragma unroll
    for (int m = 0; m < 4; ++m)
#pragma unroll
      for (int j = 0; j < 8; ++j) acc[m][j] = (hf32x4){0.f, 0.f, 0.f, 0.f};
    uint4 P0a0, P0a1, P1a0, P1a1;
    float4 P0b0, P0b1, P0b2, P0b3, P1b0, P1b1, P1b2, P1b3;
#define MG_LOAD(kt, S) do { \
      S##a0 = *(const uint4*)(Abase + aoffs[0] + (kt) * 64); S##a1 = *(const uint4*)(Abase + aoffs[1] + (kt) * 64); \
      S##b0 = *(const float4*)(bsrc + (size_t)((kt) * 32 + 0) * LDB); S##b1 = *(const float4*)(bsrc + (size_t)((kt) * 32 + 1) * LDB); \
      S##b2 = *(const float4*)(bsrc + (size_t)((kt) * 32 + 2) * LDB); S##b3 = *(const float4*)(bsrc + (size_t)((kt) * 32 + 3) * LDB); } while (0)
#define MG_WRITE(aoff, boff, S) do { \
      *(uint4*)(lds + (aoff) + (srow) * 64 + spc * 16) = S##a0; \
      if (full) *(uint4*)(lds + (aoff) + (srow + 128) * 64 + spc * 16) = S##a1; \
      *(uint2*)(lds + (boff) + (4 * lane + 0) * 80 + 8 * wid) = make_uint2(cvt_pk_bf16(S##b0.x, S##b1.x), cvt_pk_bf16(S##b2.x, S##b3.x)); \
      *(uint2*)(lds + (boff) + (4 * lane + 1) * 80 + 8 * wid) = make_uint2(cvt_pk_bf16(S##b0.y, S##b1.y), cvt_pk_bf16(S##b2.y, S##b3.y)); \
      *(uint2*)(lds + (boff) + (4 * lane + 2) * 80 + 8 * wid) = make_uint2(cvt_pk_bf16(S##b0.z, S##b1.z), cvt_pk_bf16(S##b2.z, S##b3.z)); \
      *(uint2*)(lds + (boff) + (4 * lane + 3) * 80 + 8 * wid) = make_uint2(cvt_pk_bf16(S##b0.w, S##b1.w), cvt_pk_bf16(S##b2.w, S##b3.w)); } while (0)
#define MG_MMA(aoff, boff) do { if (active) { \
      hbf16x8 Af[4]; \
      _Pragma("unroll") for (int m = 0; m < 4; ++m) { const int row = 64 * wm + 16 * m + fr; \
        Af[m] = *(const hbf16x8*)(lds + (aoff) + row * 64 + ((fq ^ ((row >> 2) & 3)) * 16)); } \
      _Pragma("unroll") for (int jh = 0; jh < 2; ++jh) { \
        hbf16x8 Bf[4]; \
        _Pragma("unroll") for (int j4 = 0; j4 < 4; ++j4) { const int j = jh * 4 + j4; \
          const int nrow = UP ? ((j < 4) ? (64 * wn + 16 * j + fr) : (128 + 64 * wn + 16 * (j - 4) + fr)) : (128 * wn + 16 * j + fr); \
          Bf[j4] = *(const hbf16x8*)(lds + (boff) + nrow * 80 + 16 * fq); } \
        _Pragma("unroll") for (int m = 0; m < 4; ++m) _Pragma("unroll") for (int j4 = 0; j4 < 4; ++j4) \
          acc[m][jh * 4 + j4] = __builtin_amdgcn_mfma_f32_16x16x32_bf16(Bf[j4], Af[m], acc[m][jh * 4 + j4], 0, 0, 0); } } } while (0)
    MG_LOAD(0, P0);
    MG_LOAD(1, P1);
    MG_WRITE(AOFF0, BOFF0, P0);
    __syncthreads();
#pragma unroll 1
    for (int kt = 0; kt < NKT; kt += 2) {
      { const int kn = (kt + 2 < NKT) ? (kt + 2) : kt; MG_LOAD(kn, P0); }
      MG_MMA(AOFF0, BOFF0);
      MG_WRITE(AOFF1, BOFF1, P1);
      __syncthreads();
      { const int kn = (kt + 3 < NKT) ? (kt + 3) : (kt + 1); MG_LOAD(kn, P1); }
      MG_MMA(AOFF1, BOFF1);
      MG_WRITE(AOFF0, BOFF0, P0);
      __syncthreads();
    }
#undef MG_LOAD
#undef MG_WRITE
#undef MG_MMA
    if (active) {
#pragma unroll
      for (int m = 0; m < 4; ++m) {
        const int slot = mu * 256 + 64 * wm + 16 * m + fr;
        if (slot < cnt) {
          if (UP) {
            bf16_t* hp = p.HBb + (size_t)(seg + slot) * DE + nt * 128 + 64 * wn + 4 * fq;
#pragma unroll
            for (int j = 0; j < 4; ++j) {
              float h[4];
#pragma unroll
              for (int r = 0; r < 4; ++r) { const float av = acc[m][j][r]; h[r] = av / (1.f + __expf(-av)) * acc[m][j + 4][r]; }
              *(uint2*)(hp + 16 * j) = make_uint2(cvt_pk_bf16(h[0], h[1]), cvt_pk_bf16(h[2], h[3]));
            }
          } else {
            const int pair = p.LIST[e * T + slot];
            const float gt = p.GATE[pair];
            bf16_t* yp = p.YB2b + (size_t)pair * D + nt * 256 + 128 * wn + 4 * fq;
#pragma unroll
            for (int j = 0; j < 8; ++j)
              *(uint2*)(yp + 16 * j) = make_uint2(cvt_pk_bf16(gt * acc[m][j][0], gt * acc[m][j][1]), cvt_pk_bf16(gt * acc[m][j][2], gt * acc[m][j][3]));
          }
        }
      }
    }
  }
}

__device__ void ph_final(const Params& p) {
  const int tid = threadIdx.x, wid = tid >> 6, lane = tid & 63;
  for (int row = blockIdx.x * 8 + wid; row < T; row += gridDim.x * 8) {
    const float* ga2 = p.MOD + (row / L) * 6144 + 5120;
    float4 v[4];
    float ss = 0.f;
#pragma unroll
    for (int i = 0; i < 4; ++i) {
      const int col = i * 256 + lane * 4;
      float4 xv = *(const float4*)(p.X1 + (size_t)row * D + col);
      uint2 a = *(const uint2*)(p.YB2b + (size_t)(row * 2) * D + col);
      uint2 b = *(const uint2*)(p.YB2b + (size_t)(row * 2 + 1) * D + col);
      float4 ga = *(const float4*)(ga2 + col);
      v[i].x = xv.x + ga.x * (__uint_as_float(a.x << 16) + __uint_as_float(b.x << 16));
      v[i].y = xv.y + ga.y * (__uint_as_float(a.x & 0xffff0000u) + __uint_as_float(b.x & 0xffff0000u));
      v[i].z = xv.z + ga.z * (__uint_as_float(a.y << 16) + __uint_as_float(b.y << 16));
      v[i].w = xv.w + ga.w * (__uint_as_float(a.y & 0xffff0000u) + __uint_as_float(b.y & 0xffff0000u));
      ss += v[i].x * v[i].x + v[i].y * v[i].y + v[i].z * v[i].z + v[i].w * v[i].w;
    }
    ss = wave_sum(ss);
    const float rstd = rsqrtf(ss * (1.f / D) + EPS);
#pragma unroll
    for (int i = 0; i < 4; ++i) {
      const int col = i * 256 + lane * 4;
      float4 gf = *(const float4*)(p.g_final + col);
      float4 o;
      o.x = v[i].x * rstd * gf.x; o.y = v[i].y * rstd * gf.y; o.z = v[i].z * rstd * gf.z; o.w = v[i].w * rstd * gf.w;
      *(float4*)(p.out + (size_t)row * D + col) = o;
    }
  }
}

constexpr int NPHASE = 11;

__global__ void __launch_bounds__(NTHR, 2) mega(Params p) {
  extern __shared__ __attribute__((aligned(16))) unsigned char lds_raw[];
  float* sm = (float*)lds_raw;
  PG8_LAS unsigned char* lds = (PG8_LAS unsigned char*)lds_raw;
  const int lo = p.lo, hi = p.hi;
  volatile LAS unsigned* xbst = (volatile LAS unsigned*)(lds + pg8::STAGE_BYTES + 2048);
  if (threadIdx.x < 4) xbst[threadIdx.x] = 0u;
  __syncthreads();
  XcdBarrier xbar; xbar.bar = p.BAR; xbar.x = 0; xbar.st = xbst;
  if (hi - lo > 1) xbar = xcd_barrier_post(p.BAR, xbst);
#define IN(k) (lo <= (k) && (k) < hi)
#define SYNC(k) do { if (IN(k) && IN((k) + 1)) xcd_barrier(xbar); } while (0)
#ifndef DUPK
#define DUPK -1
#endif
#ifndef SKIP_OTHER
  if (IN(0)) { ph_adaln(p, sm); ph_filters(p, sm); ph_wcvt(p, sm); }
#if DUPK == 0
  xcd_barrier(xbar);
  if (IN(0)) { ph_adaln(p, sm); ph_filters(p, sm); ph_wcvt(p, sm); }
#endif
  SYNC(0);
  if (IN(1)) ph_norm1(p);
#if DUPK == 1
  xcd_barrier(xbar);
  if (IN(1)) ph_norm1(p);
#endif
  SYNC(1);
#endif
#ifndef SKIP_GEMM
  if (IN(2)) {
    pg8::DenseOrder S{p.XNb, p.WinT, TT / 256, DP / 256 + 1, D, (int)gridDim.x, (int)blockIdx.x};
    pg8::EpiBf16 E{p.PXb, DP, p.DT, p.dt_bias};
    pg8::gemm_phase<pg8::EpiBf16, pg8::DenseOrder>(lds, D, S, E);
  }
#if DUPK == 2
  xcd_barrier(xbar);
  if (IN(2)) {
    pg8::DenseOrder S{p.XNb, p.WinT, TT / 256, DP / 256 + 1, D, (int)gridDim.x, (int)blockIdx.x};
    pg8::EpiBf16 E{p.PXb, DP, p.DT, p.dt_bias};
    pg8::gemm_phase<pg8::EpiBf16, pg8::DenseOrder>(lds, D, S, E);
  }
#endif
  SYNC(2);
#endif
#ifndef SKIP_OTHER
  if (IN(3)) {
    ph_hy_convT(p, sm);
    for (int it = blockIdx.x; it < 288; it += gridDim.x) ssd_states_unit(p, it, lds_raw);
  }
#if DUPK == 3
  xcd_barrier(xbar);
  if (IN(3)) {
    ph_hy_convT(p, sm);
    for (int it = blockIdx.x; it < 288; it += gridDim.x) ssd_states_unit(p, it, lds_raw);
  }
#endif
  SYNC(3);
  if (IN(4)) {
    for (int it = blockIdx.x; it < 256; it += gridDim.x) ssd_scan_unit(p, it);
    for (int it = blockIdx.x; it < 512; it += gridDim.x) hyena_unit(p, it, lds_raw);
  }
#if DUPK == 4
  xcd_barrier(xbar);
  if (IN(4)) {
    for (int it = blockIdx.x; it < 256; it += gridDim.x) ssd_scan_unit(p, it);
    for (int it = blockIdx.x; it < 512; it += gridDim.x) hyena_unit(p, it, lds_raw);
  }
#endif
  SYNC(4);
  if (IN(5)) {
    for (int it = blockIdx.x; it < 256; it += gridDim.x) { ssd_out_unit(p, it, lds_raw); __syncthreads(); }
    ph_hy_backT(p, sm);
  }
#if DUPK == 5
  xcd_barrier(xbar);
  if (IN(5)) {
    for (int it = blockIdx.x; it < 256; it += gridDim.x) { ssd_out_unit(p, it, lds_raw); __syncthreads(); }
    ph_hy_backT(p, sm);
  }
#endif
  SYNC(5);
#endif
#ifndef SKIP_GEMM
  if (IN(6)) {
    pg8::DenseOrder S{p.YMIXb, p.WoutT, T / 256, D / 256, D, (int)gridDim.x, (int)blockIdx.x};
    pg8::EpiX1 E{p.x, p.MOD, p.X1, p.SSQP};
    pg8::gemm_phase<pg8::EpiX1, pg8::DenseOrder>(lds, D, S, E);
  }
#if DUPK == 6
  xcd_barrier(xbar);
  if (IN(6)) {
    pg8::DenseOrder S{p.YMIXb, p.WoutT, T / 256, D / 256, D, (int)gridDim.x, (int)blockIdx.x};
    pg8::EpiX1 E{p.x, p.MOD, p.X1, p.SSQP};
    pg8::gemm_phase<pg8::EpiX1, pg8::DenseOrder>(lds, D, S, E);
  }
#endif
  SYNC(6);
#endif
#ifndef SKIP_OTHER
  if (IN(7)) ph_router(p, lds_raw);
#if DUPK == 7
  xcd_barrier(xbar);
  if (IN(7)) ph_router(p, lds_raw);
#endif
  SYNC(7);
#endif
#ifndef SKIP_GEMM
  if (IN(8)) {
    int* tab = (int*)(lds_raw + pg8::STAGE_BYTES);
    moe_table(p, tab);
    moe_gemm_phase<true>(p, lds_raw, tab);
  }
#if DUPK == 8
  xcd_barrier(xbar);
  if (IN(8)) {
    int* tab = (int*)(lds_raw + pg8::STAGE_BYTES);
    moe_table(p, tab);
    moe_gemm_phase<true>(p, lds_raw, tab);
  }
#endif
  SYNC(8);
  if (IN(9)) {
    int* tab = (int*)(lds_raw + pg8::STAGE_BYTES);
    moe_table(p, tab);
    moe_gemm_phase<false>(p, lds_raw, tab);
  }
#if DUPK == 9
  xcd_barrier(xbar);
  if (IN(9)) {
    int* tab = (int*)(lds_raw + pg8::STAGE_BYTES);
    moe_table(p, tab);
    moe_gemm_phase<false>(p, lds_raw, tab);
  }
#endif
  SYNC(9);
#endif
#ifndef SKIP_OTHER
  if (IN(10)) ph_final(p);
#if DUPK == 10
  xcd_barrier(xbar);
  if (IN(10)) ph_final(p);
#endif
#endif
#undef IN
#undef SYNC
}

extern "C" void kernel_launch(void* const* d_in, const int* in_sizes, int n_in, void* d_out, int out_size,
                              void* d_ws, size_t ws_size, hipStream_t stream) {
  Params p{};
  const float* const* in = (const float* const*)d_in;
  p.x = in[0]; p.c = in[1]; p.ctx = in[2]; p.c_ctx = in[3]; p.w_ada = in[4]; p.b_ada = in[5];
  p.g1 = in[6]; p.g2 = in[7]; p.w_in = in[8]; p.hy_conv_w = in[9]; p.hy_conv_b = in[10];
  p.f_w1 = in[11]; p.f_b1 = in[12]; p.f_freq = in[13]; p.f_w2 = in[14]; p.f_b2 = in[15]; p.f_w3 = in[16];
  p.hy_bias = in[17]; p.ssd_conv_w = in[18]; p.ssd_conv_b = in[19]; p.a_log = in[20]; p.dt_bias = in[21];
  p.ssd_d = in[22]; p.ssd_norm_g = in[23]; p.w_out = in[24]; p.w_group = in[25]; p.b_group = in[26];
  p.w_expert = in[27]; p.b_expert = in[28]; p.w1 = in[29]; p.w3 = in[30]; p.w2 = in[31]; p.g_final = in[32];
  p.out = (float*)d_out;

  char* ws = (char*)d_ws;
  size_t off = 0;
  auto take = [&](size_t bytes) { char* r = ws + off; off += (bytes + 255) & ~(size_t)255; return r; };
  p.BAR = (unsigned*)take((size_t)XCD_BAR_WORDS * 4);
  p.MOD = (float*)take((size_t)9 * 6144 * 4);
  p.CNT = (int*)take(NE * 32 * 4);
  p.GATE = (float*)take((size_t)T * 2 * 4);
  p.LIST = (int*)take((size_t)NE * T * 4);
  p.DT = (float*)take((size_t)TT * 16 * 4);
  p.ACUM = (float*)take((size_t)T * 16 * 4);
  p.SSQP = (float*)take((size_t)T * 16 * 4);
  p.CDEC = (float*)take((size_t)128 * 18 * 32 * 4);
  p.FILTt = (bf16_t*)take((size_t)1024 * FLEN * 2);
  p.WRhi = (bf16_t*)take((size_t)96 * 1024 * 2);
  p.WRlo = (bf16_t*)take((size_t)96 * 1024 * 2);
  p.WinT = (bf16_t*)take((size_t)(DP + 256) * D * 2);
  p.WoutT = (bf16_t*)take((size_t)D * D * 2);
  char* rPX = take((size_t)TT * DP * 2);
  char* rXBC = take((size_t)128 * 18 * 8192 * 2);
  char* rYF = take((size_t)T * DS * 4);
  char* rZ1 = take((size_t)HYC * T * 2);
  char* rYB = take((size_t)T * DS * 4);
  char* rYM = take((size_t)T * D * 2);
  p.PXb = (bf16_t*)rPX; p.SST = (bf16_t*)rXBC; p.Ut = (bf16_t*)rZ1; p.YMIXb = (bf16_t*)rYM;
  p.HIN = (bf16_t*)rYF;
  p.Yt = (bf16_t*)rYB;
  p.XNb = (bf16_t*)rZ1;
  p.X1 = (float*)rPX;
  p.H2b = (bf16_t*)rYM;
  p.HBb = (bf16_t*)(rPX + (size_t)T * D * 4);
  p.YB2b = (bf16_t*)rZ1;
  if (off > ws_size) { fprintf(stderr, "workspace too small: need %zu have %zu\n", off, ws_size); return; }

  static int grid_blocks = 0;
  if (!grid_blocks) {
    int dev = 0, cus = 0, per_cu = 0;
    (void)hipGetDevice(&dev);
    (void)hipDeviceGetAttribute(&cus, hipDeviceAttributeMultiprocessorCount, dev);
    (void)hipFuncSetAttribute((const void*)mega, hipFuncAttributeMaxDynamicSharedMemorySize, LDS_BYTES);
    (void)hipOccupancyMaxActiveBlocksPerMultiprocessor(&per_cu, mega, NTHR, LDS_BYTES);
    if (per_cu < 1) { fprintf(stderr, "occupancy query returned %d\n", per_cu); per_cu = 1; }
    grid_blocks = cus;
  }
#ifndef ONE_LAUNCH
  for (int ph = 0; ph < NPHASE; ++ph) {
    p.lo = ph; p.hi = ph + 1;
    hipLaunchKernelGGL(mega, dim3(grid_blocks), dim3(NTHR), LDS_BYTES, stream, p);
  }
#else
  p.lo = 0; p.hi = NPHASE;
  (void)hipMemsetAsync(p.BAR, 0, (size_t)XCD_BAR_WORDS * 4, stream);
  void* args[] = {&p};
  hipError_t e = hipLaunchCooperativeKernel((void*)mega, dim3(grid_blocks), dim3(NTHR), args, LDS_BYTES, stream);
  if (e != hipSuccess) fprintf(stderr, "cooperative launch failed: %s (grid %d)\n", hipGetErrorString(e), grid_blocks);
#endif
}
```

```cpp
#define ONE_LAUNCH 1
#include <hip/hip_runtime.h>
#include <hip/hip_cooperative_groups.h>
#include <cstdio>
#include <cstdint>
namespace cg = cooperative_groups;

constexpr int D = 1024, NB = 8, L = 2048, LC = 256;
constexpr int T = NB * L;
constexpr int TC = NB * LC;
constexpr int TT = T + TC;
constexpr int DH = 512, HYC = 1536, DS = 512, DXBC = 1024, DIN = 3088, DP = 3072;
constexpr int COL_Z = 1536, COL_XBC = 2048, COL_DT = 3072;
constexpr int NE = 64, DE = 512;
constexpr float EPS = 1e-6f;
constexpr int NTHR = 512;
constexpr int LDS_BYTES = 132 * 1024;
constexpr int FLEN = 4232, HX0 = 2112, FCLEN = 4240, ZSTRB = 4240;

typedef unsigned short bf16_t;

struct Params {
  const float *x, *c, *ctx, *c_ctx, *w_ada, *b_ada, *g1, *g2, *w_in, *hy_conv_w, *hy_conv_b;
  const float *f_w1, *f_b1, *f_freq, *f_w2, *f_b2, *f_w3, *hy_bias;
  const float *ssd_conv_w, *ssd_conv_b, *a_log, *dt_bias, *ssd_d, *ssd_norm_g, *w_out;
  const float *w_group, *b_group, *w_expert, *b_expert, *w1, *w3, *w2, *g_final;
  float* out;
  float *MOD, *DT, *X1, *GATE, *ACUM, *CDEC, *SSQP;
  bf16_t *WRhi, *WRlo, *FILTt, *Ut, *Yt, *HIN, *XNb, *WinT, *WoutT, *PXb, *SST, *YMIXb, *YB2b, *H2b, *HBb;
  int *CNT, *LIST;
  unsigned* BAR;
  int lo, hi;
};

__device__ __forceinline__ float silu_f(float v) { return v / (1.f + __expf(-v)); }
__device__ __forceinline__ float softplus_f(float v) { return v > 20.f ? v : log1pf(expf(v)); }
__device__ __forceinline__ float bf2f(bf16_t v) { return __uint_as_float(((unsigned)v) << 16); }
__device__ __forceinline__ unsigned cvt_pk_bf16(float lo, float hi) {
  typedef __bf16 bf2_t __attribute__((ext_vector_type(2)));
  typedef float f2_t __attribute__((ext_vector_type(2)));
  const f2_t v = {lo, hi};
  const bf2_t r = __builtin_convertvector(v, bf2_t);
  return __builtin_bit_cast(unsigned, r);
}
__device__ __forceinline__ bf16_t f2bf(float f) { return (bf16_t)(cvt_pk_bf16(f, 0.f) & 0xffffu); }
__device__ __forceinline__ void st_agent64(void* p, unsigned lo, unsigned hi) {
  __hip_atomic_store((unsigned long long*)p, ((unsigned long long)hi << 32) | lo, __ATOMIC_RELAXED, __HIP_MEMORY_SCOPE_AGENT);
}
__device__ __forceinline__ uint2 ld_agent64(const void* p) {
  const unsigned long long v = __hip_atomic_load((const unsigned long long*)p, __ATOMIC_RELAXED, __HIP_MEMORY_SCOPE_AGENT);
  return make_uint2((unsigned)v, (unsigned)(v >> 32));
}
__device__ __forceinline__ void st_agent32(float* p, float v) { __hip_atomic_store(p, v, __ATOMIC_RELAXED, __HIP_MEMORY_SCOPE_AGENT); }
__device__ __forceinline__ float ld_agent32(const float* p) { return __hip_atomic_load(p, __ATOMIC_RELAXED, __HIP_MEMORY_SCOPE_AGENT); }
__device__ __forceinline__ float wave_sum(float v) {
#pragma unroll
  for (int o = 32; o > 0; o >>= 1) v += __shfl_xor(v, o);
  return v;
}


#define XB_TMO      128
#define XB_XCNT(j)  (256  + 64 * (j))
#define XB_XSUB(j)  (1280 + 64 * (j))
#define XB_XGEN(j)  (2304 + 64 * (j))
#define XB_TOP      3328
#define XB_TOPGEN   3392
#define XCD_BAR_WORDS 3456
#define XB_SPIN_CAP (1u << 18)
#define LAS __attribute__((address_space(3)))
__device__ __forceinline__ unsigned xb_ld(unsigned* p) { return __hip_atomic_load(p, __ATOMIC_RELAXED, __HIP_MEMORY_SCOPE_AGENT); }
__device__ __forceinline__ unsigned xb_add(unsigned* p, unsigned v) { return __hip_atomic_fetch_add(p, v, __ATOMIC_RELAXED, __HIP_MEMORY_SCOPE_AGENT); }
__device__ __forceinline__ unsigned xb_xcc_id() { return (unsigned)__builtin_amdgcn_s_getreg((3 << 11) | 20) & 0xFu; }
#define XB_SPIN(cond, bar) do { unsigned _sp = 0; while (cond) { __builtin_amdgcn_s_sleep(1); \
    if ((++_sp & 255u) == 0u) { if (xb_ld(&(bar)[XB_TMO])) break; if (_sp > XB_SPIN_CAP) { atomicAdd(&(bar)[XB_TMO], 1u); break; } } } } while (0)
struct XcdBarrier { unsigned* bar; unsigned x; volatile LAS unsigned* st; };
__device__ __forceinline__ XcdBarrier xcd_barrier_post(unsigned* bar, volatile LAS unsigned* st) {
  XcdBarrier b; b.bar = bar; b.x = xb_xcc_id(); b.st = st;
  if (threadIdx.x == 0) (void)xb_add(&bar[XB_XCNT(b.x)], 1u);
  return b;
}
__device__ __forceinline__ void xcd_barrier_complete(unsigned* bar, unsigned x, unsigned& nloc, unsigned& nx) {
  const unsigned G = gridDim.x * gridDim.y * gridDim.z;
  unsigned sum, cnt, mine, sp = 0u;
  for (;;) {
    sum = 0u; cnt = 0u; mine = 0u;
#pragma unroll
    for (unsigned j = 0; j < 16; ++j) { const unsigned c = xb_ld(&bar[XB_XCNT(j)]); sum += c; cnt += (c > 0u) ? 1u : 0u; mine = (j == x) ? c : mine; }
    if (sum == G) break;
    __builtin_amdgcn_s_sleep(1);
    if ((++sp & 255u) == 0u) { if (xb_ld(&bar[XB_TMO])) break; if (sp > XB_SPIN_CAP) { atomicAdd(&bar[XB_TMO], 1u); break; } }
  }
  nloc = mine > 0u ? mine : 1u; nx = cnt > 0u ? cnt : 1u;
}
__device__ __forceinline__ void xcd_barrier(const XcdBarrier& b) {
  asm volatile("s_waitcnt vmcnt(0)" ::: "memory");
  __syncthreads();
  if (threadIdx.x == 0) {
    unsigned* bar = b.bar;
    __builtin_amdgcn_s_waitcnt(0);
    unsigned nloc = b.st[0], nx = b.st[1];
    if (nloc == 0u) { xcd_barrier_complete(bar, b.x, nloc, nx); b.st[0] = nloc; b.st[1] = nx; }
    const unsigned old = xb_add(&bar[XB_XSUB(b.x)], 1u);
    const unsigned gen = old / nloc;
    if (old + 1u == (gen + 1u) * nloc) {
      __builtin_amdgcn_fence(__ATOMIC_RELEASE, "agent");
      asm volatile("s_waitcnt vmcnt(0)" ::: "memory");
      const unsigned og = xb_add(&bar[XB_TOP], 1u);
      const unsigned tg = og / nx;
      if (og + 1u == (tg + 1u) * nx) xb_add(&bar[XB_TOPGEN], 1u);
      else XB_SPIN(xb_ld(&bar[XB_TOPGEN]) == tg, bar);
      __builtin_amdgcn_fence(__ATOMIC_ACQUIRE, "agent");
      xb_add(&bar[XB_XGEN(b.x)], 1u);
      asm volatile("s_waitcnt vmcnt(0)" ::: "memory");
    } else {
      XB_SPIN(xb_ld(&bar[XB_XGEN(b.x)]) == gen, bar);
      __builtin_amdgcn_fence(__ATOMIC_ACQUIRE, "agent");
      asm volatile("s_waitcnt vmcnt(0)" ::: "memory");
    }
  }
  __syncthreads();
}

namespace pg8 {
#define PG8_LAS __attribute__((address_space(3)))
typedef short bf16x8 __attribute__((ext_vector_type(8)));
typedef float f32x4 __attribute__((ext_vector_type(4)));
typedef unsigned u32x4 __attribute__((ext_vector_type(4)));
typedef unsigned u32x2 __attribute__((ext_vector_type(2)));
constexpr int BM = 256, BK = 64, HALF = 128, HTB = HALF * BK * 2, STAGE_BYTES = 8 * HTB, NXCD = 8, WGM = 8;

__host__ __device__ __forceinline__ int lds_byte(int r, int c) {
  const int st = (r >> 4) * 2 + (c >> 5), rr = r & 15, cc = c & 31, ob = rr * 64 + cc * 2;
  return st * 1024 + (ob ^ (((ob >> 9) & 1) << 5));
}
__host__ __device__ __forceinline__ void stage_rc(int b, int& R, int& C) {
  const int st = b / 1024, sb = b % 1024, swz = sb ^ (((sb >> 9) & 1) << 5);
  R = (st >> 1) * 16 + swz / 64; C = (st & 1) * 32 + (swz % 64) / 2;
}
__host__ __device__ __forceinline__ int perm32(int rho) { const int n = rho >> 4, i = rho & 15; return 8 * (i >> 2) + 4 * n + (i & 3); }

struct Unit { int pm, pn, e, mu, nv, cnt, seg; };

__device__ __forceinline__ bool static_next(int nM, int nN, int G, int c, int i, int& pm, int& pn) {
  const int nwg = nM * nN;
  const long Lx = (long)i * G + c; if (Lx >= nwg) return false;
  int wgid = (int)Lx;
  { const int q = nwg / NXCD, r = nwg % NXCD, xcd = wgid % NXCD, off = wgid / NXCD; wgid = (xcd < r ? xcd * (q + 1) : r * (q + 1) + (xcd - r) * q) + off; }
  const int nig = WGM * nN, gid = wgid / nig, fm = gid * WGM, gsz = (nM - fm) < WGM ? (nM - fm) : WGM;
  pm = fm + ((wgid % nig) % gsz); pn = (wgid % nig) / gsz; return true;
}

struct DenseOrder {
  const bf16_t* A; const bf16_t* Bt; int nM, nN, K, G, c;
  __device__ __forceinline__ bool next(int i, Unit& u) const {
    if (!static_next(nM, nN, G, c, i, u.pm, u.pn)) return false;
    u.e = 0; u.mu = 0; u.nv = 256; u.cnt = 256; u.seg = 0; return true;
  }
  __device__ __forceinline__ const char* a_base() const { return (const char*)A; }
  __device__ __forceinline__ const char* b_ptr(const Unit& u) const { return (const char*)Bt + (size_t)u.pn * 256 * K * 2; }
  __device__ __forceinline__ void a_offs(const Unit& u, const int (&R)[2], const int (&C)[2], unsigned (&ao)[2][2]) const {
#pragma unroll
    for (int h = 0; h < 2; ++h)
#pragma unroll
      for (int i = 0; i < 2; ++i) ao[h][i] = (unsigned)((u.pm * 256 + h * 128 + R[i]) * K + C[i]) * 2u;
  }
};

struct MoeOrder {
  const int* tab; const bf16_t* A; const bf16_t* Bt; const int* list; int NTn, K, G, c; bool gather;
  __device__ __forceinline__ bool next(int i, Unit& u) const {
    const int Lx = i * G + c;
    if (Lx >= tab[64] * NTn) return false;
    const int mg = Lx / NTn; u.pn = Lx - mg * NTn;
    int e = 0;
    while (tab[e + 1] <= mg) ++e;
    u.e = e; u.mu = mg - tab[e]; u.cnt = tab[130 + e]; u.seg = tab[65 + e];
    const int rem = u.cnt - u.mu * 256; u.nv = rem < 256 ? rem : 256; u.pm = 0; return true;
  }
  __device__ __forceinline__ const char* a_base() const { return (const char*)A; }
  __device__ __forceinline__ const char* b_ptr(const Unit& u) const { return (const char*)Bt + ((size_t)u.e * NTn + u.pn) * 256 * K * 2; }
  __device__ __forceinline__ void a_offs(const Unit& u, const int (&R)[2], const int (&C)[2], unsigned (&ao)[2][2]) const {
#pragma unroll
    for (int h = 0; h < 2; ++h)
#pragma unroll
      for (int i = 0; i < 2; ++i) {
        int idx = u.mu * 256 + h * 128 + R[i];
        int row;
        if (gather) { if (idx > u.cnt - 1) idx = u.cnt - 1; row = list[u.e * T + idx] >> 1; }
        else row = u.seg + idx;
        ao[h][i] = (unsigned)(row * K + C[i]) * 2u;
      }
  }
};

struct EpiBf16 {
  static constexpr bool PERM = true;
  bf16_t* O; int ldc; float* DT; const float* dt_bias;
  __device__ __forceinline__ void operator()(const f32x4 (&acc)[2][2][4][2], const Unit& u, int wr, int wc, int fr, int fq) const {
    const int row0 = u.pm * BM + wr * 64 + fr;
    if (u.pn == 12) {
      if (wc == 0 && fq < 2) {
        const f32x4 b0 = *(const f32x4*)(dt_bias + 8 * fq), b1 = *(const f32x4*)(dt_bias + 8 * fq + 4);
#pragma unroll
        for (int ai = 0; ai < 2; ++ai)
#pragma unroll
          for (int m = 0; m < 4; ++m) {
            float* dp = DT + (size_t)(row0 + ai * HALF + m * 16) * 16 + 8 * fq;
            *(f32x4*)dp = acc[ai][0][m][0] + b0; *(f32x4*)(dp + 4) = acc[ai][0][m][1] + b1;
          }
      }
      return;
    }
    const int col0 = u.pn * BM + wc * 32 + 8 * fq;
#pragma unroll
    for (int ai = 0; ai < 2; ++ai)
#pragma unroll
      for (int m = 0; m < 4; ++m) {
        bf16_t* rowp = O + (size_t)(row0 + ai * HALF + m * 16) * ldc + col0;
#pragma unroll
        for (int bj = 0; bj < 2; ++bj) {
          f32x4 v0 = acc[ai][bj][m][0], v1 = acc[ai][bj][m][1];
          u32x4 w; w.x = cvt_pk_bf16(v0[0], v0[1]); w.y = cvt_pk_bf16(v0[2], v0[3]); w.z = cvt_pk_bf16(v1[0], v1[1]); w.w = cvt_pk_bf16(v1[2], v1[3]);
          *(u32x4*)(rowp + bj * HALF) = w;
        }
      }
  }
};

struct EpiX1 {
  static constexpr bool PERM = false;
  const float* x; const float* mod; float* X1; float* SSQP;
  __device__ __forceinline__ void operator()(const f32x4 (&acc)[2][2][4][2], const Unit& u, int wr, int wc, int fr, int fq) const {
    const int row0 = u.pm * BM + wr * 64 + fr, col0 = u.pn * BM + wc * 32 + 4 * fq;
    const float* ga = mod + ((u.pm * BM) / L) * 6144 + 2048 + col0;
    f32x4 gv[2][2];
#pragma unroll
    for (int bj = 0; bj < 2; ++bj)
#pragma unroll
      for (int n = 0; n < 2; ++n) gv[bj][n] = *(const f32x4*)(ga + bj * HALF + n * 16);
#pragma unroll
    for (int ai = 0; ai < 2; ++ai)
#pragma unroll
      for (int m = 0; m < 4; ++m) {
        const size_t off = (size_t)(row0 + ai * HALF + m * 16) * D + col0;
        float ssq = 0.f;
#pragma unroll
        for (int bj = 0; bj < 2; ++bj)
#pragma unroll
          for (int n = 0; n < 2; ++n) {
            const f32x4 xv = *(const f32x4*)(x + off + bj * HALF + n * 16);
            const f32x4 o = xv + gv[bj][n] * acc[ai][bj][m][n];
            *(f32x4*)(X1 + off + bj * HALF + n * 16) = o;
            ssq += (o[0] * o[0] + o[1] * o[1]) + (o[2] * o[2] + o[3] * o[3]);
          }
        ssq += __shfl_xor(ssq, 16); ssq += __shfl_xor(ssq, 32);
        if (fq == 0) SSQP[(size_t)(row0 + ai * HALF + m * 16) * 16 + u.pn * 4 + wc] = ssq;
      }
  }
};

struct EpiSwiGLU {
  static constexpr bool PERM = true;
  bf16_t* HBb;
  __device__ __forceinline__ void operator()(const f32x4 (&acc)[2][2][4][2], const Unit& u, int wr, int wc, int fr, int fq) const {
    const int col0 = u.pn * 128 + wc * 32 + 8 * fq;
#pragma unroll
    for (int ai = 0; ai < 2; ++ai)
#pragma unroll
      for (int m = 0; m < 4; ++m) {
        const int slot = u.mu * 256 + ai * HALF + wr * 64 + m * 16 + fr;
        if (slot < u.cnt) {
          float h[8];
#pragma unroll
          for (int n = 0; n < 2; ++n)
#pragma unroll
            for (int j = 0; j < 4; ++j) { const float a = acc[ai][0][m][n][j]; h[n * 4 + j] = a / (1.f + __expf(-a)) * acc[ai][1][m][n][j]; }
          u32x4 w; w.x = cvt_pk_bf16(h[0], h[1]); w.y = cvt_pk_bf16(h[2], h[3]); w.z = cvt_pk_bf16(h[4], h[5]); w.w = cvt_pk_bf16(h[6], h[7]);
          *(u32x4*)(HBb + (size_t)(u.seg + slot) * DE + col0) = w;
        }
      }
  }
};

struct EpiDown {
  static constexpr bool PERM = true;
  bf16_t* YB2b; const int* list; const float* gate;
  __device__ __forceinline__ void operator()(const f32x4 (&acc)[2][2][4][2], const Unit& u, int wr, int wc, int fr, int fq) const {
    const int col0 = u.pn * 256 + wc * 32 + 8 * fq;
#pragma unroll
    for (int ai = 0; ai < 2; ++ai)
#pragma unroll
      for (int m = 0; m < 4; ++m) {
        const int slot = u.mu * 256 + ai * HALF + wr * 64 + m * 16 + fr;
        if (slot < u.cnt) {
          const int pair = list[u.e * T + slot];
          const float gt = gate[pair];
          bf16_t* rowp = YB2b + (size_t)pair * D + col0;
#pragma unroll
          for (int bj = 0; bj < 2; ++bj) {
            f32x4 v0 = acc[ai][bj][m][0] * gt, v1 = acc[ai][bj][m][1] * gt;
            u32x4 w; w.x = cvt_pk_bf16(v0[0], v0[1]); w.y = cvt_pk_bf16(v0[2], v0[3]); w.z = cvt_pk_bf16(v1[0], v1[1]); w.w = cvt_pk_bf16(v1[2], v1[3]);
            *(u32x4*)(rowp + bj * HALF) = w;
          }
        }
      }
  }
};

template <class Epi, class Sched>
__device__ __forceinline__ void gemm_phase(PG8_LAS unsigned char* lds, const int K, const Sched& S, const Epi& E) {
  const int tid = threadIdx.x, wid = __builtin_amdgcn_readfirstlane(tid >> 6), lane = tid & 63, wr = wid >> 2, wc = wid & 3, fr = lane & 15, fq = lane >> 4;
  const int nt = K / BK;
  int Rr[2], Cc[2];
  unsigned voffB[2];
#pragma unroll
  for (int i = 0; i < 2; ++i) {
    stage_rc(tid * 16 + i * 8192, Rr[i], Cc[i]);
    const int Rb = Epi::PERM ? ((Rr[i] & ~31) + perm32(Rr[i] & 31)) : Rr[i];
    voffB[i] = (unsigned)(Rb * K + Cc[i]) * 2u;
  }
  const size_t kstep = (size_t)(BK * 2);
  const size_t hstep = (size_t)HALF * K * 2;
  const unsigned ldsw = (unsigned)wid * 1024u;
  const int aoff = lds_byte(wr * 64 + fr, fq * 8), boff = lds_byte(wc * 32 + fr, fq * 8);
#define PG8_SA(b, h) (((b) * 2 + (h)) * HTB)
#define PG8_SB(b, h) ((4 + (b) * 2 + (h)) * HTB)
#define PG8_STAGE(bufoff, gbase, voff) do { _Pragma("unroll") for (int _i = 0; _i < 2; ++_i) \
    __builtin_amdgcn_global_load_lds((const unsigned*)((const char*)(gbase) + (voff)[_i]), (PG8_LAS unsigned*)(lds + (bufoff) + ldsw + _i * 8192), 16, 0, 0); } while (0)
#define PG8_LDA(dst, b, h) do { _Pragma("unroll") for (int m = 0; m < 4; ++m) _Pragma("unroll") for (int k = 0; k < 2; ++k) dst[m][k] = *(const PG8_LAS bf16x8*)(lds + PG8_SA(b, h) + aoff + m * 2048 + k * 1024); } while (0)
#define PG8_LDB(dst, b, h) do { _Pragma("unroll") for (int n = 0; n < 2; ++n) _Pragma("unroll") for (int k = 0; k < 2; ++k) dst[n][k] = *(const PG8_LAS bf16x8*)(lds + PG8_SB(b, h) + boff + n * 2048 + k * 1024); } while (0)
#define PG8_MMA(ai, bj, At, Bt) do { __builtin_amdgcn_s_setprio(1); _Pragma("unroll") for (int m = 0; m < 4; ++m) _Pragma("unroll") for (int n = 0; n < 2; ++n) _Pragma("unroll") for (int k = 0; k < 2; ++k) \
    acc[ai][bj][m][n] = __builtin_amdgcn_mfma_f32_16x16x32_bf16(Bt[n][k], At[m][k], acc[ai][bj][m][n], 0, 0, 0); __builtin_amdgcn_s_setprio(0); } while (0)
#define PG8_WAIT_V(n) asm volatile("s_waitcnt vmcnt(" #n ")" ::: "memory")
#define PG8_WAIT_L(n) asm volatile("s_waitcnt lgkmcnt(" #n ")" ::: "memory")
#define PG8_BAR __builtin_amdgcn_s_barrier()
#define PG8_SCHED __builtin_amdgcn_sched_barrier(0)
  Unit cur, nxt; int ui = 0;
  if (!S.next(0, cur)) return;
  f32x4 acc[2][2][4][2];
#pragma unroll
  for (int a = 0; a < 2; ++a)
#pragma unroll
    for (int b = 0; b < 2; ++b)
#pragma unroll
      for (int m = 0; m < 4; ++m)
#pragma unroll
        for (int n = 0; n < 2; ++n) acc[a][b][m][n] = (f32x4){0.f, 0.f, 0.f, 0.f};
  bf16x8 At[4][2], B0[2][2], B1[2][2];
  unsigned cao[2][2], nao[2][2];
  S.a_offs(cur, Rr, Cc, cao);
  const char* const aB = S.a_base();
  const char* cB = S.b_ptr(cur);
  PG8_STAGE(PG8_SB(0, 0), cB, voffB); PG8_STAGE(PG8_SA(0, 0), aB, cao[0]); PG8_STAGE(PG8_SB(0, 1), cB + hstep, voffB); PG8_STAGE(PG8_SA(0, 1), aB, cao[1]);
  if (wr == 1) PG8_BAR;
  PG8_WAIT_V(4); PG8_BAR;
  PG8_STAGE(PG8_SB(1, 0), cB + kstep, voffB); PG8_STAGE(PG8_SA(1, 0), aB + kstep, cao[0]); PG8_STAGE(PG8_SB(1, 1), cB + hstep + kstep, voffB);
  PG8_WAIT_V(6); PG8_BAR;
  for (;;) {
    const bool has_next = S.next(ui + 1, nxt);
    const char* nB = cB;
    if (has_next) { S.a_offs(nxt, Rr, Cc, nao); nB = S.b_ptr(nxt); }
    else {
#pragma unroll
      for (int h = 0; h < 2; ++h)
#pragma unroll
        for (int i = 0; i < 2; ++i) nao[h][i] = cao[h][i];
    }
    const bool full = cur.nv > 128;
    for (int t = 0; t < nt; t += 2) {
      const bool last = (t == nt - 2);
      const char* a1 = aB + (size_t)(t + 1) * kstep;
      const char* a2 = last ? aB : aB + (size_t)(t + 2) * kstep; const char* b2 = last ? nB : cB + (size_t)(t + 2) * kstep;
      const char* a3 = a2 + kstep; const char* b3 = b2 + kstep;
      unsigned so[2][2];
#pragma unroll
      for (int h = 0; h < 2; ++h)
#pragma unroll
        for (int i = 0; i < 2; ++i) so[h][i] = last ? nao[h][i] : cao[h][i];
      PG8_LDB(B0, 0, 0); PG8_SCHED; PG8_LDA(At, 0, 0); PG8_STAGE(PG8_SA(1, 1), a1, cao[1]);
      PG8_WAIT_L(8); PG8_BAR; PG8_WAIT_L(0); PG8_MMA(0, 0, At, B0); PG8_BAR; PG8_SCHED;
      PG8_LDB(B1, 0, 1); PG8_STAGE(PG8_SB(0, 0), b2, voffB);
      PG8_BAR; PG8_WAIT_L(0); PG8_MMA(0, 1, At, B1); PG8_BAR;
      PG8_LDA(At, 0, 1); PG8_STAGE(PG8_SA(0, 0), a2, so[0]);
      PG8_BAR; PG8_WAIT_L(0); if (full) PG8_MMA(1, 0, At, B0); PG8_BAR; PG8_SCHED;
      PG8_STAGE(PG8_SB(0, 1), b2 + hstep, voffB);
      PG8_WAIT_V(6); PG8_BAR; if (full) PG8_MMA(1, 1, At, B1); PG8_BAR;
      PG8_LDB(B0, 1, 0); PG8_SCHED; PG8_LDA(At, 1, 0); PG8_STAGE(PG8_SA(0, 1), a2, so[1]);
      PG8_WAIT_L(8); PG8_BAR; PG8_WAIT_L(0); PG8_MMA(0, 0, At, B0); PG8_BAR; PG8_SCHED;
      PG8_LDB(B1, 1, 1); PG8_STAGE(PG8_SB(1, 0), b3, voffB);
      PG8_BAR; PG8_WAIT_L(0); PG8_MMA(0, 1, At, B1); PG8_BAR;
      PG8_LDA(At, 1, 1); PG8_STAGE(PG8_SA(1, 0), a3, so[0]);
      PG8_BAR; PG8_WAIT_L(0); if (full) PG8_MMA(1, 0, At, B0); PG8_BAR; PG8_SCHED;
      PG8_STAGE(PG8_SB(1, 1), b3 + hstep, voffB);
      PG8_WAIT_V(6); PG8_BAR; if (full) PG8_MMA(1, 1, At, B1); PG8_BAR;
    }
    E(acc, cur, wr, wc, fr, fq);
    if (!has_next) break;
#pragma unroll
    for (int a = 0; a < 2; ++a)
#pragma unroll
      for (int b = 0; b < 2; ++b)
#pragma unroll
        for (int m = 0; m < 4; ++m)
#pragma unroll
          for (int n = 0; n < 2; ++n) acc[a][b][m][n] = (f32x4){0.f, 0.f, 0.f, 0.f};
    cur = nxt; cB = nB; ++ui;
#pragma unroll
    for (int h = 0; h < 2; ++h)
#pragma unroll
      for (int i = 0; i < 2; ++i) cao[h][i] = nao[h][i];
  }
  PG8_WAIT_V(0);
  if (wr == 0) PG8_BAR;
  PG8_BAR;
#undef PG8_SA
#undef PG8_SB
#undef PG8_STAGE
#undef PG8_LDA
#undef PG8_LDB
#undef PG8_MMA
#undef PG8_WAIT_V
#undef PG8_WAIT_L
#undef PG8_BAR
#undef PG8_SCHED
}
}

__device__ void ph_adaln(const Params& p, float* sm) {
  const int tid = threadIdx.x;
  if (blockIdx.x == 0 && tid < NE) p.CNT[tid * 32] = 0;
  for (int e = blockIdx.x * NTHR + tid; e < 96 * 1024; e += gridDim.x * NTHR) {
    const int j = e >> 10, k = e & 1023;
    float w = 0.f;
    if (j < 64) w = p.w_expert[k * 64 + j]; else if (j < 72) w = p.w_group[k * 8 + (j - 64)];
    const unsigned hi = cvt_pk_bf16(w, 0.f) & 0xffffu;
    const float rem = w - __uint_as_float(hi << 16);
    p.WRhi[e] = (bf16_t)hi; p.WRlo[e] = (bf16_t)(cvt_pk_bf16(rem, 0.f) & 0xffffu);
  }
  float* sc = sm;
  float* red = sm + 9 * 1024;
  for (int e = tid; e < 9 * 1024; e += NTHR) {
    const int r = e >> 10, k = e & 1023;
    sc[e] = silu_f(r < 8 ? p.c[r * D + k] : p.c_ctx[k]);
  }
  __syncthreads();
  for (int item = blockIdx.x; item < 192; item += gridDim.x) {
    const int col0 = item * 32;
    const int kq = tid >> 3, c4 = (tid & 7) * 4;
    float acc[9][4];
#pragma unroll
    for (int r = 0; r < 9; ++r)
#pragma unroll
      for (int j = 0; j < 4; ++j) acc[r][j] = 0.f;
    float4 wv[16];
#pragma unroll
    for (int i = 0; i < 16; ++i) wv[i] = *(const float4*)(p.w_ada + (size_t)(kq + i * 64) * 6144 + col0 + c4);
#pragma unroll
    for (int i = 0; i < 16; ++i) {
      const int k = kq + i * 64;
      const float4 w = wv[i];
#pragma unroll
      for (int r = 0; r < 9; ++r) {
        const float sv = sc[r * 1024 + k];
        acc[r][0] += sv * w.x; acc[r][1] += sv * w.y; acc[r][2] += sv * w.z; acc[r][3] += sv * w.w;
      }
    }
#pragma unroll
    for (int r = 0; r < 9; ++r)
#pragma unroll
      for (int j = 0; j < 4; ++j) red[kq * 292 + r * 32 + c4 + j] = acc[r][j];
    __syncthreads();
    if (tid < 288) {
      float a = 0.f;
      for (int q = 0; q < 64; ++q) a += red[q * 292 + tid];
      const int r = tid >> 5, j = tid & 31;
      p.MOD[r * 6144 + col0 + j] = a + p.b_ada[col0 + j];
    }
    __syncthreads();
  }
}

__device__ void ph_filters(const Params& p, float* sm) {
  const int tid = threadIdx.x, wid = tid >> 6, lane = tid & 63;
  float* feats = sm;
  float* h1 = sm + 64 * 20;
  float* h2 = h1 + 64 * 64;
  float* w3s = h2 + 64 * 64;
  bf16_t* tile = (bf16_t*)w3s;
  float* w2s = w3s + 64 * 256;
  float* w1s = w2s + 4096;
  for (int e = tid; e < 4096; e += NTHR) w2s[e] = p.f_w2[e];
  for (int e = tid; e < 17 * 64; e += NTHR) w1s[e] = p.f_w1[e];
  __syncthreads();
  for (int e = blockIdx.x * NTHR + tid; e < 1024 * 137; e += gridDim.x * NTHR) {
    int rowi = e / 137, k = e - rowi * 137;
    int x = (k < 65) ? k : (4160 + (k - 65));
    p.FILTt[(size_t)rowi * FLEN + x] = 0;
  }
  for (int item = blockIdx.x; item < 256; item += gridDim.x) {
    const int tt = item >> 3, ct = item & 7;
    for (int e = tid; e < 4096; e += NTHR) {
      const int i = e >> 6, c4 = (e & 63) * 4;
      *(float4*)(w3s + i * 256 + c4) = *(const float4*)(p.f_w3 + i * 2048 + ct * 256 + c4);
    }
    for (int e = tid; e < 64 * 17; e += NTHR) {
      int tp = e / 17, i = e - tp * 17;
      int t = tt * 64 + tp;
      float f;
      if (i == 0) f = (float)t / (float)(L - 1);
      else {
        int bi = (i - 1) & 7;
        float bandf = (float)(1e-4 + (double)bi * ((7.0 - 1e-4) / 7.0));
        float ang = (float)(2.0 * 3.14159265358979323846 / (double)L) * (float)t * bandf;
        f = (i <= 8) ? cosf(ang) : -sinf(ang);
      }
      feats[tp * 20 + i] = f;
    }
    __syncthreads();
    for (int e = tid; e < 4096; e += NTHR) {
      int tp = e >> 6, j = e & 63;
      float a = p.f_b1[j];
      for (int i = 0; i < 17; ++i) a += feats[tp * 20 + i] * w1s[i * 64 + j];
      h1[e] = __sinf(p.f_freq[j] * a);
    }
    __syncthreads();
    {
      const int tp = tid >> 3, j8 = (tid & 7) * 8;
      float a[8];
#pragma unroll
      for (int c = 0; c < 8; ++c) a[c] = p.f_b2[j8 + c];
#pragma unroll 4
      for (int i = 0; i < 64; ++i) {
        const float hv = h1[tp * 64 + i];
        const float4 w0 = *(const float4*)(w2s + i * 64 + j8), w1 = *(const float4*)(w2s + i * 64 + j8 + 4);
        a[0] += hv * w0.x; a[1] += hv * w0.y; a[2] += hv * w0.z; a[3] += hv * w0.w;
        a[4] += hv * w1.x; a[5] += hv * w1.y; a[6] += hv * w1.z; a[7] += hv * w1.w;
      }
#pragma unroll
      for (int c = 0; c < 8; ++c) h2[tp * 64 + j8 + c] = __sinf(p.f_freq[j8 + c] * a[c]);
    }
    __syncthreads();
    {
      const int cg = tid & 31, tg = tid >> 5;
      float acc[4][8];
#pragma unroll
      for (int a = 0; a < 4; ++a)
#pragma unroll
        for (int c = 0; c < 8; ++c) acc[a][c] = 0.f;
#pragma unroll 4
      for (int i = 0; i < 64; ++i) {
        const float4 w0 = *(const float4*)(w3s + i * 256 + cg * 8), w1 = *(const float4*)(w3s + i * 256 + cg * 8 + 4);
        const float wv[8] = {w0.x, w0.y, w0.z, w0.w, w1.x, w1.y, w1.z, w1.w};
#pragma unroll
        for (int a = 0; a < 4; ++a) {
          const float hv = h2[(tg * 4 + a) * 64 + i];
#pragma unroll
          for (int c = 0; c < 8; ++c) acc[a][c] += hv * wv[c];
        }
      }
      __syncthreads();
      const float d0 = -4.605170185988091f / 1.5f, d1 = -4.605170185988091f / 0.3f;
#pragma unroll
      for (int c = 0; c < 8; ++c) {
        const int col = cg * 8 + c;
        const int cch = (ct * 256 + col) & 511;
        const float delta = fabsf(d0 + (float)cch * ((d1 - d0) / 511.f));
#pragma unroll
        for (int a = 0; a < 4; ++a) {
          const int t = tt * 64 + tg * 4 + a;
          const float tn = (float)t / (float)(L - 1);
          tile[col * 66 + tg * 4 + a] = f2bf(acc[a][c] * __expf(-tn * delta));
        }
      }
    }
    __syncthreads();
    for (int cl = wid * 32; cl < wid * 32 + 32; ++cl) {
      const int gcol = ct * 256 + cl;
      const int o = gcol >> 10, dir = (gcol >> 9) & 1, cch = gcol & 511;
      const int t = tt * 64 + lane;
      const int x = dir ? (HX0 + t) : (HX0 - t);
      if (!(dir && t == 0)) p.FILTt[(size_t)(o * 512 + cch) * FLEN + x] = tile[cl * 66 + lane];
    }
    __syncthreads();
  }
}

__device__ __forceinline__ void cvt_tile256(const float* src, int ld, int k0, int n0, bf16_t* dst, int ldd, int dmap0, int dmap1, int nsplit, float* sm) {
  const int tid = threadIdx.x;
  float* ts = sm;
  float4 v[8];
#pragma unroll
  for (int i = 0; i < 8; ++i) {
    const int e = tid + i * NTHR; const int k = e >> 6, n4 = (e & 63) * 4;
    v[i] = *(const float4*)(src + (size_t)(k0 + k) * ld + n0 + n4);
  }
#pragma unroll
  for (int i = 0; i < 8; ++i) {
    const int e = tid + i * NTHR; const int k = e >> 6, n4 = (e & 63) * 4;
    ts[k * 257 + n4 + 0] = v[i].x; ts[k * 257 + n4 + 1] = v[i].y; ts[k * 257 + n4 + 2] = v[i].z; ts[k * 257 + n4 + 3] = v[i].w;
  }
  __syncthreads();
#pragma unroll
  for (int i = 0; i < 4; ++i) {
    const int e = tid + i * NTHR; const int n = e >> 3, kq = (e & 7) * 8;
    uint4 w;
    w.x = cvt_pk_bf16(ts[(kq + 0) * 257 + n], ts[(kq + 1) * 257 + n]);
    w.y = cvt_pk_bf16(ts[(kq + 2) * 257 + n], ts[(kq + 3) * 257 + n]);
    w.z = cvt_pk_bf16(ts[(kq + 4) * 257 + n], ts[(kq + 5) * 257 + n]);
    w.w = cvt_pk_bf16(ts[(kq + 6) * 257 + n], ts[(kq + 7) * 257 + n]);
    const int drow = (n < nsplit) ? (dmap0 + n) : (dmap1 + (n - nsplit));
    *(uint4*)(dst + (size_t)drow * ldd + k0 + kq) = w;
  }
  __syncthreads();
}

__device__ void ph_wcvt(const Params& p, float* sm) {
  for (int e = blockIdx.x * NTHR + threadIdx.x; e < 16 * 1024; e += gridDim.x * NTHR) {
    const int j = e >> 10, k = e & 1023;
    p.WinT[(size_t)(DP + j) * D + k] = f2bf(p.w_in[(size_t)k * DIN + COL_DT + j]);
  }
  for (int it = blockIdx.x; it < 192 + 64; it += gridDim.x) {
    if (it < 192) { const int kt = it / 12, nt = it - kt * 12; cvt_tile256(p.w_in, DIN, kt * 64, nt * 256, p.WinT, D, nt * 256, 0, 256, sm); }
    else if (it < 256) { const int i = it - 192; const int kt = i >> 2, nt = i & 3; cvt_tile256(p.w_out, D, kt * 64, nt * 256, p.WoutT, D, nt * 256, 0, 256, sm); }
  }
}

__device__ void ph_norm1(const Params& p) {
  const int tid = threadIdx.x, wid = tid >> 6, lane = tid & 63;
  for (int row = blockIdx.x * 8 + wid; row < TT; row += gridDim.x * 8) {
    const float* src = (row < T) ? (p.x + (size_t)row * D) : (p.ctx + (size_t)(row - T) * D);
    const int mr = (row < T) ? (row / L) : 8;
    const float* sh = p.MOD + mr * 6144;
    const float* sc = sh + 1024;
    float4 v[4];
    float ss = 0.f;
#pragma unroll
    for (int i = 0; i < 4; ++i) {
      v[i] = *(const float4*)(src + i * 256 + lane * 4);
      ss += v[i].x * v[i].x + v[i].y * v[i].y + v[i].z * v[i].z + v[i].w * v[i].w;
    }
    ss = wave_sum(ss);
    const float rstd = rsqrtf(ss * (1.f / D) + EPS);
#pragma unroll
    for (int i = 0; i < 4; ++i) {
      const int col = i * 256 + lane * 4;
      float4 g = *(const float4*)(p.g1 + col);
      float4 s4 = *(const float4*)(sc + col);
      float4 h4 = *(const float4*)(sh + col);
      float4 o;
      o.x = v[i].x * rstd * g.x * (1.f + s4.x) + h4.x;
      o.y = v[i].y * rstd * g.y * (1.f + s4.y) + h4.y;
      o.z = v[i].z * rstd * g.z * (1.f + s4.z) + h4.z;
      o.w = v[i].w * rstd * g.w * (1.f + s4.w) + h4.w;
      uint2 w; w.x = cvt_pk_bf16(o.x, o.y); w.y = cvt_pk_bf16(o.z, o.w);
      *(uint2*)(p.XNb + (size_t)row * D + col) = w;
    }
  }
}

__device__ void ph_hy_convT(const Params& p, float* sm) {
  const int tid = threadIdx.x;
  float* tile = sm;
  const int bid = blockIdx.x;
  int it0, it1;
  if (gridDim.x == 256) { if (bid < 32) { it0 = bid * 3; it1 = it0 + 3; } else { it0 = 96 + (bid - 32) * 27; it1 = it0 + 27; } }
  else { const int per = (256 * 24 + gridDim.x - 1) / gridDim.x; it0 = bid * per; it1 = it0 + per; if (it1 > 256 * 24) it1 = 256 * 24; }
  for (int item = it0; item < it1; item += 3) {
    uint4 v[3];
    const int lt = tid >> 3, c8 = (tid & 7) * 8;
#pragma unroll
    for (int u = 0; u < 3; ++u) {
      const int it = (item + u < it1) ? (item + u) : item;
      const int gr = it / 24, ct = it - gr * 24;
      v[u] = *(const uint4*)(p.PXb + (size_t)(gr * 64 + lt) * DP + ct * 64 + c8);
    }
#pragma unroll
    for (int u = 0; u < 3; ++u) {
      float* tl = tile + u * (64 * 65);
      const unsigned w[4] = {v[u].x, v[u].y, v[u].z, v[u].w};
#pragma unroll
      for (int k = 0; k < 4; ++k) {
        tl[lt * 65 + c8 + 2 * k] = __uint_as_float(w[k] << 16);
        tl[lt * 65 + c8 + 2 * k + 1] = __uint_as_float(w[k] & 0xffff0000u);
      }
    }
    __syncthreads();
#pragma unroll
    for (int u = 0; u < 3; ++u) {
      if (item + u < it1) {
        const int it = item + u;
        const int gr = it / 24, ct = it - gr * 24;
        const int row0 = gr * 64;
        const float* tl = tile + u * (64 * 65);
        const int cc = tid >> 3, t8 = (tid & 7) * 8;
        const int col = ct * 64 + cc;
        const float w0 = p.hy_conv_w[col], w1 = p.hy_conv_w[HYC + col], w2 = p.hy_conv_w[2 * HYC + col], bb = p.hy_conv_b[col];
        float o[8];
#pragma unroll
        for (int k = 0; k < 8; ++k) {
          const int t = t8 + k;
          float vv = bb + w1 * tl[t * 65 + cc];
          if (t > 0) vv += w0 * tl[(t - 1) * 65 + cc];
          if (t < 63) vv += w2 * tl[(t + 1) * 65 + cc];
          o[k] = vv;
        }
        uint4 w; w.x = cvt_pk_bf16(o[0], o[1]); w.y = cvt_pk_bf16(o[2], o[3]); w.z = cvt_pk_bf16(o[4], o[5]); w.w = cvt_pk_bf16(o[6], o[7]);
        *(uint4*)(p.Ut + (size_t)col * T + row0 + t8) = w;
      }
    }
    __syncthreads();
  }
}

__device__ void ph_hy_backT(const Params& p, float* sm) {
  const int tid = threadIdx.x;
  bf16_t* tile = (bf16_t*)sm;
  for (int item = blockIdx.x; item < 256 * 8; item += gridDim.x) {
    const int gr = item >> 3, ct = item & 7;
    const int row0 = gr * 64;
    {
      const int cc = tid >> 3, r8 = (tid & 7) * 8;
      uint4 v = *(const uint4*)(p.Yt + (size_t)(ct * 64 + cc) * T + row0 + r8);
      unsigned w[4] = {v.x, v.y, v.z, v.w};
#pragma unroll
      for (int k = 0; k < 4; ++k) {
        tile[cc * 66 + r8 + 2 * k] = (bf16_t)(w[k] & 0xffffu);
        tile[cc * 66 + r8 + 2 * k + 1] = (bf16_t)(w[k] >> 16);
      }
    }
    __syncthreads();
    {
      const int r = tid >> 3, c8 = (tid & 7) * 8;
      unsigned w[4];
#pragma unroll
      for (int k = 0; k < 4; ++k) w[k] = (unsigned)tile[(c8 + 2 * k) * 66 + r] | ((unsigned)tile[(c8 + 2 * k + 1) * 66 + r] << 16);
      uint4 o; o.x = w[0]; o.y = w[1]; o.z = w[2]; o.w = w[3];
      *(uint4*)(p.YMIXb + (size_t)(row0 + r) * D + ct * 64 + c8) = o;
    }
    __syncthreads();
  }
}

typedef short hbf16x8 __attribute__((ext_vector_type(8)));
typedef float hf32x4 __attribute__((ext_vector_type(4)));

constexpr int HY_FC = 0, HY_ZT0 = 4 * FCLEN * 2, HY_ZT1 = HY_ZT0 + 8 * ZSTRB;

__device__ __forceinline__ void hy_build_filter(const Params& p, int o, int c, unsigned char* lds) {
  const int tid = threadIdx.x;
  const bf16_t* gsrc = p.FILTt + (size_t)(o * 512 + c) * FLEN;
  for (int e = tid; e < 530; e += NTHR) {
    uint4 v = make_uint4(0u, 0u, 0u, 0u);
    if (e < 529) v = *(const uint4*)(gsrc + e * 8);
    *(uint4*)(lds + HY_FC + e * 16) = v;
  }
  __syncthreads();
  for (int g = tid; g < 3 * 530; g += NTHR) {
    const int r = 1 + g / 530, ch = g % 530;
    uint4 lo = make_uint4(0u, 0u, 0u, 0u);
    if (ch > 0) lo = *(const uint4*)(lds + HY_FC + (ch - 1) * 16);
    uint4 hi = *(const uint4*)(lds + HY_FC + ch * 16);
    unsigned W[8] = {lo.x, lo.y, lo.z, lo.w, hi.x, hi.y, hi.z, hi.w};
    uint4 ov;
    if (r == 1) {
      ov.x = __builtin_amdgcn_alignbyte(W[4], W[3], 2); ov.y = __builtin_amdgcn_alignbyte(W[5], W[4], 2);
      ov.z = __builtin_amdgcn_alignbyte(W[6], W[5], 2); ov.w = __builtin_amdgcn_alignbyte(W[7], W[6], 2);
    } else if (r == 2) {
      ov.x = W[3]; ov.y = W[4]; ov.z = W[5]; ov.w = W[6];
    } else {
      ov.x = __builtin_amdgcn_alignbyte(W[3], W[2], 2); ov.y = __builtin_amdgcn_alignbyte(W[4], W[3], 2);
      ov.z = __builtin_amdgcn_alignbyte(W[5], W[4], 2); ov.w = __builtin_amdgcn_alignbyte(W[6], W[5], 2);
    }
    *(uint4*)(lds + HY_FC + r * (FCLEN * 2) + ch * 16) = ov;
  }
  __syncthreads();
}

__device__ __forceinline__ void hy_order(const Params& p, int o, int c, unsigned char* lds) {
  const int tid = threadIdx.x, wid = __builtin_amdgcn_readfirstlane(tid >> 6), lane = tid & 63;
  const int g0 = wid * 4;
  const int n16 = lane & 15, h = lane >> 4, bb = n16 & 7, pp = n16 >> 3;
  const unsigned char* Zin = lds + (o ? HY_ZT1 : HY_ZT0);
  const bf16_t* gate = p.Ut + (size_t)((o + 1) * 512 + c) * T + bb * L;
  uint2 xg[4][2];
#pragma unroll
  for (int i = 0; i < 4; ++i)
#pragma unroll
    for (int u = 0; u < 2; ++u) xg[i][u] = *(const uint2*)(gate + 32 * (2 * (g0 + i) + pp) + 16 * u + 4 * h);
  const float bias = p.hy_bias[o * 512 + c];
  hf32x4 acc[4][2];
#pragma unroll
  for (int i = 0; i < 4; ++i)
#pragma unroll
    for (int u = 0; u < 2; ++u) acc[i][u] = (hf32x4){0.f, 0.f, 0.f, 0.f};
  const int ai = lane & 15, ar = ai & 3, aq = ai >> 2;
  const unsigned char* laneA = lds + HY_FC + ar * (FCLEN * 2) + 2 * (HX0 - 4 * aq + 8 * h);
  const unsigned char* laneB = Zin + bb * ZSTRB + 64 + 64 * pp + 16 * h;
#define HY_LDA(dst, Dd) do { const uint2 _lo = *(const uint2*)(laneA - 32 * (Dd)); const uint2 _hi = *(const uint2*)(laneA - 32 * (Dd) + 8); \
    union { uint4 u4; hbf16x8 v; } _cv; _cv.u4 = make_uint4(_lo.x, _lo.y, _hi.x, _hi.y); dst = _cv.v; } while (0)
#define HY_LDB(dst, Qq) do { dst = *(const hbf16x8*)(laneB + 64 * (Qq)); } while (0)
#pragma unroll 1
  for (int pass = 0; pass < 2; ++pass) {
    const int Es = 2 * g0 - 63 + pass;
    hbf16x8 R[4];
    HY_LDB(R[1], 2 * (g0 + 1) - Es); HY_LDB(R[2], 2 * (g0 + 2) - Es); HY_LDB(R[3], 2 * (g0 + 3) - Es);
#pragma unroll 1
    for (int n4 = 0; n4 < 9; ++n4) {
#pragma unroll
      for (int j = 0; j < 4; ++j) {
        const int n = n4 * 4 + j;
        const int E = Es + 2 * n;
        HY_LDB(R[(4 - j) & 3], 2 * (g0 - n) - Es);
        hbf16x8 A0, A1;
        HY_LDA(A0, 2 * E); HY_LDA(A1, 2 * E + 1);
#pragma unroll
        for (int i = 0; i < 4; ++i) {
          const int Q = 2 * (g0 + i - n) - Es;
          if (Q >= -1 && Q <= 63) {
            acc[i][0] = __builtin_amdgcn_mfma_f32_16x16x32_bf16(A0, R[(i - j) & 3], acc[i][0], 0, 0, 0);
            acc[i][1] = __builtin_amdgcn_mfma_f32_16x16x32_bf16(A1, R[(i - j) & 3], acc[i][1], 0, 0, 0);
          }
        }
      }
    }
  }
#undef HY_LDA
#undef HY_LDB
#pragma unroll
  for (int i = 0; i < 4; ++i)
#pragma unroll
    for (int u = 0; u < 2; ++u) {
      const int t0 = 32 * (2 * (g0 + i) + pp) + 16 * u + 4 * h;
      const uint2 zv = *(const uint2*)(Zin + bb * ZSTRB + 64 + 2 * t0);
      const float z0 = __uint_as_float(zv.x << 16), z1 = __uint_as_float(zv.x & 0xffff0000u), z2 = __uint_as_float(zv.y << 16), z3 = __uint_as_float(zv.y & 0xffff0000u);
      const float x0 = __uint_as_float(xg[i][u].x << 16), x1 = __uint_as_float(xg[i][u].x & 0xffff0000u), x2 = __uint_as_float(xg[i][u].y << 16), x3 = __uint_as_float(xg[i][u].y & 0xffff0000u);
      const float r0 = x0 * (acc[i][u][0] + z0 * bias), r1 = x1 * (acc[i][u][1] + z1 * bias), r2 = x2 * (acc[i][u][2] + z2 * bias), r3 = x3 * (acc[i][u][3] + z3 * bias);
      uint2 w; w.x = cvt_pk_bf16(r0, r1); w.y = cvt_pk_bf16(r2, r3);
      if (o == 0) *(uint2*)(lds + HY_ZT1 + bb * ZSTRB + 64 + 2 * t0) = w;
      else *(uint2*)(p.Yt + (size_t)c * T + bb * L + t0) = w;
    }
}

__device__ void hyena_unit(const Params& p, int c, unsigned char* lds) {
  const int tid = threadIdx.x;
  if (tid < 144) {
    const int buf = tid / 72, rem = tid % 72, b = rem / 9, k = rem % 9;
    const int off = (k < 4) ? (k * 16) : (4160 + (k - 4) * 16);
    *(uint4*)(lds + (buf ? HY_ZT1 : HY_ZT0) + b * ZSTRB + off) = make_uint4(0u, 0u, 0u, 0u);
  }
  for (int e = tid; e < 2048; e += NTHR) {
    const int b = e >> 8, ch = e & 255;
    *(uint4*)(lds + HY_ZT0 + b * ZSTRB + 64 + ch * 16) = *(const uint4*)(p.Ut + (size_t)c * T + b * L + ch * 8);
  }
#pragma unroll 1
  for (int o = 0; o < 2; ++o) {
    hy_build_filter(p, o, c, lds);
    hy_order(p, o, c, lds);
    __syncthreads();
  }
}

constexpr int SROW = 272;

__device__ __forceinline__ void ssd_stage_nat(const Params& p, int row0, int pxcol0, int cvcol0, unsigned char* dst) {
  for (int e = threadIdx.x; e < 2048; e += NTHR) {
    const int l = e >> 4, cg = e & 15;
    const int row = row0 + l, li = row & 63;
    const bf16_t* src = p.PXb + (size_t)row * DP + pxcol0 + cg * 8;
    const uint4 zero4 = make_uint4(0u, 0u, 0u, 0u);
    const uint4 cur = *(const uint4*)src;
    const uint4 prv = (li > 0) ? *(const uint4*)(src - DP) : zero4;
    const uint4 nxt = (li < 63) ? *(const uint4*)(src + DP) : zero4;
    const float* cw = p.ssd_conv_w + cvcol0 + cg * 8;
    const float* cb = p.ssd_conv_b + cvcol0 + cg * 8;
    const unsigned pc[4] = {prv.x, prv.y, prv.z, prv.w}, cc[4] = {cur.x, cur.y, cur.z, cur.w}, nc[4] = {nxt.x, nxt.y, nxt.z, nxt.w};
    float o[8];
#pragma unroll
    for (int k = 0; k < 4; ++k) {
      const float p0 = __uint_as_float(pc[k] << 16), p1 = __uint_as_float(pc[k] & 0xffff0000u);
      const float c0 = __uint_as_float(cc[k] << 16), c1 = __uint_as_float(cc[k] & 0xffff0000u);
      const float n0 = __uint_as_float(nc[k] << 16), n1 = __uint_as_float(nc[k] & 0xffff0000u);
      const float v0 = cb[2 * k] + cw[2 * k] * p0 + cw[DXBC + 2 * k] * c0 + cw[2 * DXBC + 2 * k] * n0;
      const float v1 = cb[2 * k + 1] + cw[2 * k + 1] * p1 + cw[DXBC + 2 * k + 1] * c1 + cw[2 * DXBC + 2 * k + 1] * n1;
      o[2 * k] = silu_f(v0); o[2 * k + 1] = silu_f(v1);
    }
    uint4 w; w.x = cvt_pk_bf16(o[0], o[1]); w.y = cvt_pk_bf16(o[2], o[3]); w.z = cvt_pk_bf16(o[4], o[5]); w.w = cvt_pk_bf16(o[6], o[7]);
    *(uint4*)(dst + l * SROW + cg * 16) = w;
  }
}

__device__ __forceinline__ void ssd_stage_tr(const Params& p, int row0, bool is_ctx, int pxcol0, int cvcol0, int ncols, unsigned char* dst) {
  const int ncg = ncols >> 2;
  for (int e = threadIdx.x; e < ncg * 16; e += NTHR) {
    const int cg = e % ncg, l8 = e / ncg;
    const int rowf = row0 + l8 * 8;
    bool has_prev, has_next;
    if (is_ctx) { const int tc = (rowf - T) & (LC - 1); has_prev = tc > 0; has_next = tc + 7 < LC - 1; }
    else { const int li = rowf & 63; has_prev = li > 0; has_next = li + 7 < 63; }
    const bf16_t* src = p.PXb + (size_t)rowf * DP + pxcol0 + cg * 4;
    const uint2 z2 = make_uint2(0u, 0u);
    uint2 raw[10];
    raw[0] = *(const uint2*)((cvcol0 >= 0 && has_prev) ? (src - DP) : src);
    if (!(cvcol0 >= 0 && has_prev)) raw[0] = z2;
#pragma unroll
    for (int k = 0; k < 8; ++k) raw[k + 1] = *(const uint2*)(src + (size_t)k * DP);
    raw[9] = *(const uint2*)((cvcol0 >= 0 && has_next) ? (src + (size_t)8 * DP) : src);
    if (!(cvcol0 >= 0 && has_next)) raw[9] = z2;
    unsigned outw[4][4];
    if (cvcol0 >= 0) {
      const float* cw = p.ssd_conv_w + cvcol0 + cg * 4; const float* cb = p.ssd_conv_b + cvcol0 + cg * 4;
      const float4 a0 = *(const float4*)cw, b0 = *(const float4*)(cw + DXBC), c0 = *(const float4*)(cw + 2 * DXBC), d0 = *(const float4*)cb;
      const float w0[4] = {a0.x, a0.y, a0.z, a0.w}, w1[4] = {b0.x, b0.y, b0.z, b0.w}, w2[4] = {c0.x, c0.y, c0.z, c0.w}, bb[4] = {d0.x, d0.y, d0.z, d0.w};
#pragma unroll
      for (int kp = 0; kp < 4; ++kp) {
#pragma unroll
        for (int c = 0; c < 4; ++c) {
          const unsigned q0 = (c >> 1) ? raw[2 * kp].y : raw[2 * kp].x, q1 = (c >> 1) ? raw[2 * kp + 1].y : raw[2 * kp + 1].x;
          const unsigned q2 = (c >> 1) ? raw[2 * kp + 2].y : raw[2 * kp + 2].x, q3 = (c >> 1) ? raw[2 * kp + 3].y : raw[2 * kp + 3].x;
          float x0, x1, x2, x3;
          if (c & 1) { x0 = __uint_as_float(q0 & 0xffff0000u); x1 = __uint_as_float(q1 & 0xffff0000u); x2 = __uint_as_float(q2 & 0xffff0000u); x3 = __uint_as_float(q3 & 0xffff0000u); }
          else { x0 = __uint_as_float(q0 << 16); x1 = __uint_as_float(q1 << 16); x2 = __uint_as_float(q2 << 16); x3 = __uint_as_float(q3 << 16); }
          const float oa = silu_f(bb[c] + w0[c] * x0 + w1[c] * x1 + w2[c] * x2);
          const float ob = silu_f(bb[c] + w0[c] * x1 + w1[c] * x2 + w2[c] * x3);
          outw[c][kp] = cvt_pk_bf16(oa, ob);
        }
      }
    } else {
#pragma unroll
      for (int kp = 0; kp < 4; ++kp) {
#pragma unroll
        for (int c = 0; c < 4; ++c) {
          const unsigned q1 = (c >> 1) ? raw[2 * kp + 1].y : raw[2 * kp + 1].x, q2 = (c >> 1) ? raw[2 * kp + 2].y : raw[2 * kp + 2].x;
          outw[c][kp] = (c & 1) ? ((q1 >> 16) | (q2 & 0xffff0000u)) : ((q1 & 0xffffu) | (q2 << 16));
        }
      }
    }
#pragma unroll
    for (int c = 0; c < 4; ++c)
      *(uint4*)(dst + (cg * 4 + c) * SROW + l8 * 16) = make_uint4(outw[c][0], outw[c][1], outw[c][2], outw[c][3]);
  }
}

__device__ __forceinline__ void ssd_stage_tr_s(const Params& p, int row0, bool is_ctx, int pxcol0, int cvcol0, int ncols, unsigned char* dst) {
  for (int e = threadIdx.x; e < ncols * 16; e += NTHR) {
    const int col = e & (ncols - 1), l8 = e / ncols;
    const int rowf = row0 + l8 * 8;
    bool has_prev, has_next;
    if (is_ctx) { const int tc = (rowf - T) & (LC - 1); has_prev = tc > 0; has_next = tc + 7 < LC - 1; }
    else { const int li = rowf & 63; has_prev = li > 0; has_next = li + 7 < 63; }
    const bf16_t* src = p.PXb + (size_t)rowf * DP + pxcol0 + col;
    float x[10];
    x[0] = (cvcol0 >= 0 && has_prev) ? bf2f(src[-DP]) : 0.f;
#pragma unroll
    for (int k = 0; k < 8; ++k) x[k + 1] = bf2f(src[(size_t)k * DP]);
    x[9] = (cvcol0 >= 0 && has_next) ? bf2f(src[(size_t)8 * DP]) : 0.f;
    float o[8];
    if (cvcol0 >= 0) {
      const float w0 = p.ssd_conv_w[cvcol0 + col], w1 = p.ssd_conv_w[DXBC + cvcol0 + col], w2 = p.ssd_conv_w[2 * DXBC + cvcol0 + col], bb = p.ssd_conv_b[cvcol0 + col];
#pragma unroll
      for (int k = 0; k < 8; ++k) o[k] = silu_f(bb + w0 * x[k] + w1 * x[k + 1] + w2 * x[k + 2]);
    } else {
#pragma unroll
      for (int k = 0; k < 8; ++k) o[k] = x[k + 1];
    }
    uint4 w; w.x = cvt_pk_bf16(o[0], o[1]); w.y = cvt_pk_bf16(o[2], o[3]); w.z = cvt_pk_bf16(o[4], o[5]); w.w = cvt_pk_bf16(o[6], o[7]);
    *(uint4*)(dst + col * SROW + l8 * 16) = w;
  }
}

__device__ void ssd_states_unit(const Params& p, int unit, unsigned char* lds) {
  const int tid = threadIdx.x, wid = __builtin_amdgcn_readfirstlane(tid >> 6), lane = tid & 63;
  const int g = unit & 1, bc = unit >> 1, cidx = bc % 18, b = bc / 18;
  const bool is_ctx = cidx < 2;
  const int row0 = is_ctx ? (T + b * LC + cidx * 128) : (b * L + (cidx - 2) * 128);
  unsigned char* XT = lds;
  unsigned char* BT = lds + 69632;
  unsigned char* XD = lds + 104448;
  float* WG = (float*)(lds + 121856);
  ssd_stage_tr(p, row0, is_ctx, COL_XBC + g * 256, g * 256, 256, XT);
  ssd_stage_tr(p, row0, is_ctx, COL_XBC + 512 + g * 128, 512 + g * 128, 128, BT);
  {
    const int dir = wid >> 2, hh = wid & 3, h = g * 4 + hh;
    const float A = expf(p.a_log[dir * 8 + h]);
    const int l0 = 2 * lane, l1 = l0 + 1;
    const float dt0 = softplus_f(p.DT[(size_t)(row0 + l0) * 16 + dir * 8 + h]), dt1 = softplus_f(p.DT[(size_t)(row0 + l1) * 16 + dir * 8 + h]);
    const float a0 = -A * dt0, a1 = -A * dt1, pair = a0 + a1;
    float incl = pair;
#pragma unroll
    for (int o = 1; o < 64; o <<= 1) { float t = __shfl_up(incl, o); if (lane >= o) incl += t; }
    const float excl = incl - pair;
    const float total = __shfl(incl, 63);
    float w0, w1, c0, c1;
    if (dir == 0) { c0 = excl + a0; c1 = excl + pair; w0 = dt0 * expf(total - c0); w1 = dt1 * expf(total - c1); }
    else { const float pe0 = excl, pe1 = excl + a0; w0 = dt0 * expf(pe0); w1 = dt1 * expf(pe1); c0 = total - pe0; c1 = total - pe1; }
    WG[wid * 128 + l0] = w0; WG[wid * 128 + l1] = w1;
    if (!is_ctx) { float* ac = p.ACUM + (size_t)(b * 16 + dir * 8 + h) * L + (cidx - 2) * 128; *(float2*)(ac + l0) = make_float2(c0, c1); }
    if (lane == 0) {
      const int k = dir ? (is_ctx ? (1 - cidx) : (19 - cidx)) : cidx;
      p.CDEC[(size_t)(((b * 2 + dir) * 8 + h) * 18 + k) * 32] = expf(total);
    }
  }
  __syncthreads();
  const int fr = lane & 15, fq = lane >> 4;
#pragma unroll 1
  for (int it = 0; it < 8; ++it) {
    const int dir = it >> 2, hh = it & 3, h = g * 4 + hh;
    for (int e = tid; e < 1024; e += NTHR) {
      const int pr = e >> 4, ch = e & 15;
      const uint4 v = *(const uint4*)(XT + (hh * 64 + pr) * SROW + ch * 16);
      const float4 wa = *(const float4*)(WG + it * 128 + ch * 8), wb = *(const float4*)(WG + it * 128 + ch * 8 + 4);
      uint4 w;
      w.x = cvt_pk_bf16(__uint_as_float(v.x << 16) * wa.x, __uint_as_float(v.x & 0xffff0000u) * wa.y);
      w.y = cvt_pk_bf16(__uint_as_float(v.y << 16) * wa.z, __uint_as_float(v.y & 0xffff0000u) * wa.w);
      w.z = cvt_pk_bf16(__uint_as_float(v.z << 16) * wb.x, __uint_as_float(v.z & 0xffff0000u) * wb.y);
      w.w = cvt_pk_bf16(__uint_as_float(v.w << 16) * wb.z, __uint_as_float(v.w & 0xffff0000u) * wb.w);
      *(uint4*)(XD + pr * SROW + ch * 16) = w;
    }
    __syncthreads();
    hf32x4 acc[4];
#pragma unroll
    for (int pt = 0; pt < 4; ++pt) acc[pt] = (hf32x4){0.f, 0.f, 0.f, 0.f};
#pragma unroll
    for (int kk = 0; kk < 4; ++kk) {
      const hbf16x8 Bf = *(const hbf16x8*)(BT + (16 * wid + fr) * SROW + 2 * (32 * kk + 8 * fq));
#pragma unroll
      for (int pt = 0; pt < 4; ++pt) {
        const hbf16x8 Af = *(const hbf16x8*)(XD + (16 * pt + fr) * SROW + 2 * (32 * kk + 8 * fq));
        acc[pt] = __builtin_amdgcn_mfma_f32_16x16x32_bf16(Bf, Af, acc[pt], 0, 0, 0);
      }
    }
    const int k = dir ? (is_ctx ? (1 - cidx) : (19 - cidx)) : cidx;
    bf16_t* slot = p.SST + ((size_t)(((b * 2 + dir) * 8 + h) * 18 + k)) * 8192;
#pragma unroll
    for (int pt = 0; pt < 4; ++pt)
      *(uint2*)(slot + (16 * pt + fr) * 128 + 16 * wid + 4 * fq) = make_uint2(cvt_pk_bf16(acc[pt][0], acc[pt][1]), cvt_pk_bf16(acc[pt][2], acc[pt][3]));
    __syncthreads();
  }
}

__device__ void ssd_scan_unit(const Params& p, int unit) {
  const int tid = threadIdx.x;
  const int half = unit & 1, seq = unit >> 1;
  const int pr = half * 32 + (tid >> 4), n8 = (tid & 15) * 8;
  const bf16_t* base = p.SST + (size_t)seq * 18 * 8192 + pr * 128 + n8;
  uint4 sv[18];
#pragma unroll
  for (int k = 0; k < 18; ++k) sv[k] = *(const uint4*)(base + (size_t)k * 8192);
  float hst[8];
#pragma unroll
  for (int j = 0; j < 8; ++j) hst[j] = 0.f;
#pragma unroll
  for (int k = 0; k < 18; ++k) {
    const float dec = p.CDEC[(size_t)(seq * 18 + k) * 32];
    if (k >= 2) {
      uint4 w; w.x = cvt_pk_bf16(hst[0], hst[1]); w.y = cvt_pk_bf16(hst[2], hst[3]); w.z = cvt_pk_bf16(hst[4], hst[5]); w.w = cvt_pk_bf16(hst[6], hst[7]);
      *(uint4*)(p.HIN + ((size_t)seq * 16 + (k - 2)) * 8192 + pr * 128 + n8) = w;
    }
    const unsigned sw[4] = {sv[k].x, sv[k].y, sv[k].z, sv[k].w};
#pragma unroll
    for (int u = 0; u < 4; ++u) {
      hst[2 * u] = dec * hst[2 * u] + __uint_as_float(sw[u] << 16);
      hst[2 * u + 1] = dec * hst[2 * u + 1] + __uint_as_float(sw[u] & 0xffff0000u);
    }
  }
}

__device__ void ssd_out_unit(const Params& p, int unit, unsigned char* lds) {
  const int tid = threadIdx.x, wid = __builtin_amdgcn_readfirstlane(tid >> 6), lane = tid & 63;
  const int fr = lane & 15, fq = lane >> 4;
  const int g = unit & 1, bc = unit >> 1, c = bc & 15, b = bc >> 4;
  const int row0 = b * L + c * 128;
  unsigned char* CS = lds;
  unsigned char* ML = lds + 34816;
  unsigned char* XT = lds + 69632;
  unsigned char* ZT = lds + 87040;
  unsigned char* HS = lds + 104448;
  float* CUM = (float*)(lds + 121856);
  float* DTL = (float*)(lds + 125952);
  ssd_stage_nat(p, row0, COL_XBC + 768 + g * 128, 768 + g * 128, CS);
  ssd_stage_nat(p, row0, COL_XBC + 512 + g * 128, 512 + g * 128, ML);
  for (int e = tid; e < 1024; e += NTHR) {
    const int it = e >> 7, l = e & 127, dir = it >> 2, hh = it & 3;
    CUM[e] = p.ACUM[(size_t)(b * 16 + dir * 8 + g * 4 + hh) * L + c * 128 + l];
    DTL[e] = softplus_f(p.DT[(size_t)(row0 + l) * 16 + dir * 8 + g * 4 + hh]);
  }
  __syncthreads();
  hf32x4 cbt[8];
#pragma unroll
  for (int lt = 0; lt < 8; ++lt) cbt[lt] = (hf32x4){0.f, 0.f, 0.f, 0.f};
#pragma unroll
  for (int kk = 0; kk < 4; ++kk) {
    const hbf16x8 Af = *(const hbf16x8*)(ML + (16 * wid + fr) * SROW + 2 * (32 * kk + 8 * fq));
#pragma unroll
    for (int lt = 0; lt < 8; ++lt) {
      const hbf16x8 Bf = *(const hbf16x8*)(CS + (16 * lt + fr) * SROW + 2 * (32 * kk + 8 * fq));
      cbt[lt] = __builtin_amdgcn_mfma_f32_16x16x32_bf16(Af, Bf, cbt[lt], 0, 0, 0);
    }
  }
  __syncthreads();
  hf32x4 y[4][4];
#pragma unroll
  for (int hh = 0; hh < 4; ++hh)
#pragma unroll
    for (int pt = 0; pt < 4; ++pt) y[hh][pt] = (hf32x4){0.f, 0.f, 0.f, 0.f};
  const int sb = 16 * wid + 4 * fq;
  uint4 hsv0, hsv1;
  {
    const bf16_t* slot0 = p.HIN + ((size_t)(((b * 2 + 0) * 8 + g * 4) * 16 + c)) * 8192;
    hsv0 = *(const uint4*)(slot0 + (tid >> 4) * 128 + (tid & 15) * 8);
    hsv1 = *(const uint4*)(slot0 + ((tid >> 4) + 32) * 128 + (tid & 15) * 8);
  }
#pragma unroll 1
  for (int hh = 0; hh < 4; ++hh) {
    const int h = g * 4 + hh;
    hf32x4 yc[4];
#pragma unroll
    for (int pt = 0; pt < 4; ++pt) yc[pt] = (hf32x4){0.f, 0.f, 0.f, 0.f};
    ssd_stage_tr_s(p, row0, false, COL_XBC + g * 256 + hh * 64, g * 256 + hh * 64, 64, XT);
    ssd_stage_tr_s(p, row0, false, COL_Z + g * 256 + hh * 64, -1, 64, ZT);
#pragma unroll 1
    for (int dir = 0; dir < 2; ++dir) {
      const int it = dir * 4 + hh;
      const int k = dir ? (17 - c) : (c + 2);
      (void)k;
      *(uint4*)(HS + (tid >> 4) * SROW + (tid & 15) * 16) = hsv0;
      *(uint4*)(HS + ((tid >> 4) + 32) * SROW + (tid & 15) * 16) = hsv1;
      {
        int nh = h, nd = dir + 1;
        if (nd == 2) { nd = 0; nh = (hh < 3) ? (h + 1) : h; }
        const int nk = nd ? (17 - c) : (c + 2);
        const bf16_t* nslot = p.HIN + ((size_t)(((b * 2 + nd) * 8 + nh) * 16 + (nk - 2))) * 8192;
        hsv0 = *(const uint4*)(nslot + (tid >> 4) * 128 + (tid & 15) * 8);
        hsv1 = *(const uint4*)(nslot + ((tid >> 4) + 32) * 128 + (tid & 15) * 8);
      }
      {
        const float* cu = CUM + it * 128; const float* dl = DTL + it * 128;
        float cs[4], ds[4];
#pragma unroll
        for (int r = 0; r < 4; ++r) { cs[r] = cu[sb + r]; ds[r] = dl[sb + r]; }
#pragma unroll
        for (int lt = 0; lt < 8; ++lt) {
          const int l = 16 * lt + fr;
          const float cl = cu[l];
          float m[4];
#pragma unroll
          for (int r = 0; r < 4; ++r) {
            const int sidx = sb + r;
            const bool ok = dir ? (sidx >= l) : (sidx <= l);
            m[r] = ok ? cbt[lt][r] * __expf(cl - cs[r]) * ds[r] : 0.f;
          }
          uint2 w; w.x = cvt_pk_bf16(m[0], m[1]); w.y = cvt_pk_bf16(m[2], m[3]);
          *(uint2*)(ML + l * SROW + 2 * sb) = w;
        }
      }
      __syncthreads();
      hf32x4 ad[4], ao[4];
#pragma unroll
      for (int pt = 0; pt < 4; ++pt) { ad[pt] = (hf32x4){0.f, 0.f, 0.f, 0.f}; ao[pt] = (hf32x4){0.f, 0.f, 0.f, 0.f}; }
#pragma unroll
      for (int kk = 0; kk < 4; ++kk) {
        const hbf16x8 Am = *(const hbf16x8*)(ML + (16 * wid + fr) * SROW + 2 * (32 * kk + 8 * fq));
        const hbf16x8 Ac = *(const hbf16x8*)(CS + (16 * wid + fr) * SROW + 2 * (32 * kk + 8 * fq));
#pragma unroll
        for (int pt = 0; pt < 4; ++pt) {
          const hbf16x8 Bx = *(const hbf16x8*)(XT + (16 * pt + fr) * SROW + 2 * (32 * kk + 8 * fq));
          const hbf16x8 Bh = *(const hbf16x8*)(HS + (16 * pt + fr) * SROW + 2 * (32 * kk + 8 * fq));
          ad[pt] = __builtin_amdgcn_mfma_f32_16x16x32_bf16(Am, Bx, ad[pt], 0, 0, 0);
          ao[pt] = __builtin_amdgcn_mfma_f32_16x16x32_bf16(Ac, Bh, ao[pt], 0, 0, 0);
        }
      }
      {
        const float* cu = CUM + it * 128;
        float ex[4];
#pragma unroll
        for (int r = 0; r < 4; ++r) ex[r] = __expf(cu[sb + r]);
#pragma unroll
        for (int pt = 0; pt < 4; ++pt)
#pragma unroll
          for (int r = 0; r < 4; ++r) yc[pt][r] += ad[pt][r] + ex[r] * ao[pt][r];
      }
      __syncthreads();
    }
    {
      const float dsk = p.ssd_d[h];
#pragma unroll
      for (int pt = 0; pt < 4; ++pt) {
        const uint2 xv = *(const uint2*)(XT + (16 * pt + fr) * SROW + 2 * sb);
        const uint2 zv = *(const uint2*)(ZT + (16 * pt + fr) * SROW + 2 * sb);
        const float xs4[4] = {__uint_as_float(xv.x << 16), __uint_as_float(xv.x & 0xffff0000u), __uint_as_float(xv.y << 16), __uint_as_float(xv.y & 0xffff0000u)};
        const float zs4[4] = {__uint_as_float(zv.x << 16), __uint_as_float(zv.x & 0xffff0000u), __uint_as_float(zv.y << 16), __uint_as_float(zv.y & 0xffff0000u)};
#pragma unroll
        for (int r = 0; r < 4; ++r) yc[pt][r] = (yc[pt][r] + dsk * xs4[r]) * silu_f(zs4[r]);
      }
    }
    if (hh == 0) {
#pragma unroll
      for (int pt = 0; pt < 4; ++pt) y[0][pt] = yc[pt];
    } else if (hh == 1) {
#pragma unroll
      for (int pt = 0; pt < 4; ++pt) y[1][pt] = yc[pt];
    } else if (hh == 2) {
#pragma unroll
      for (int pt = 0; pt < 4; ++pt) y[2][pt] = yc[pt];
    } else {
#pragma unroll
      for (int pt = 0; pt < 4; ++pt) y[3][pt] = yc[pt];
    }
    __syncthreads();
  }
  float rinv[4];
#pragma unroll
  for (int r = 0; r < 4; ++r) {
    float ss = 0.f;
#pragma unroll
    for (int hh = 0; hh < 4; ++hh)
#pragma unroll
      for (int pt = 0; pt < 4; ++pt) ss += y[hh][pt][r] * y[hh][pt][r];
    ss += __shfl_xor(ss, 1); ss += __shfl_xor(ss, 2); ss += __shfl_xor(ss, 4); ss += __shfl_xor(ss, 8);
    rinv[r] = rsqrtf(ss * (1.f / 256.f) + EPS);
  }
  {
    bf16_t* OT = (bf16_t*)lds;
#pragma unroll
    for (int hh = 0; hh < 4; ++hh)
#pragma unroll
      for (int pt = 0; pt < 4; ++pt) {
        const int chl = hh * 64 + 16 * pt + fr;
        const float ng = p.ssd_norm_g[g * 256 + chl];
#pragma unroll
        for (int r = 0; r < 4; ++r) OT[(sb + r) * 264 + chl] = f2bf(y[hh][pt][r] * rinv[r] * ng);
      }
    __syncthreads();
    for (int e = tid; e < 128 * 32; e += NTHR) {
      const int l = e >> 5, ch8 = (e & 31) * 8;
      *(uint4*)(p.YMIXb + (size_t)(row0 + l) * D + 512 + g * 256 + ch8) = *(const uint4*)(OT + l * 264 + ch8);
    }
  }
}

__device__ void ph_router(const Params& p, unsigned char* lds) {
  const int tid = threadIdx.x, wid = __builtin_amdgcn_readfirstlane(tid >> 6), lane = tid & 63;
  const int fr = lane & 15, fq = lane >> 4;
  constexpr int AROW = 272;
  unsigned char* AH = lds;
  unsigned char* AL = lds + 64 * AROW;
  unsigned char* WH = lds + 128 * AROW;
  unsigned char* WL = lds + 224 * AROW;
  float* RS = (float*)(lds + 320 * AROW);
  float* LOG = RS + 64;
  float* GM = LOG + 6400;
  float* SH = GM + 1024;
  int* LC = (int*)(SH + 1024);
  int* LB = LC + 64;
  for (int tile = blockIdx.x; tile < T / 64; tile += gridDim.x) {
    const int row0 = tile * 64;
    const float* shp = p.MOD + (row0 / L) * 6144 + 3072;
    const float* scp = shp + 1024;
    if (tid < 64) {
      const float4* sp = (const float4*)(p.SSQP + (size_t)(row0 + tid) * 16);
      const float4 a0 = sp[0], a1 = sp[1], a2 = sp[2], a3 = sp[3];
      const float ss = ((a0.x + a0.y) + (a0.z + a0.w)) + ((a1.x + a1.y) + (a1.z + a1.w)) + ((a2.x + a2.y) + (a2.z + a2.w)) + ((a3.x + a3.y) + (a3.z + a3.w));
      RS[tid] = rsqrtf(ss * (1.f / D) + EPS);
    }
    for (int e = tid; e < 256; e += NTHR) {
      const float4 g = *(const float4*)(p.g2 + e * 4), s4 = *(const float4*)(scp + e * 4), h4 = *(const float4*)(shp + e * 4);
      *(float4*)(GM + e * 4) = make_float4(g.x * (1.f + s4.x), g.y * (1.f + s4.y), g.z * (1.f + s4.z), g.w * (1.f + s4.w));
      *(float4*)(SH + e * 4) = h4;
    }
    float4 xv[4];
#pragma unroll
    for (int i = 0; i < 4; ++i) { const int e = tid + i * NTHR; xv[i] = *(const float4*)(p.X1 + (size_t)(row0 + (e >> 5)) * D + (e & 31) * 4); }
    const int wj = tid >> 4, wch = tid & 15;
    uint4 wh0, wh1, wh2, wl0, wl1, wl2;
#define RT_LOADW(kn) do { \
      wh0 = *(const uint4*)(p.WRhi + (size_t)(wj) * 1024 + (kn) * 128 + wch * 8); wl0 = *(const uint4*)(p.WRlo + (size_t)(wj) * 1024 + (kn) * 128 + wch * 8); \
      wh1 = *(const uint4*)(p.WRhi + (size_t)(wj + 32) * 1024 + (kn) * 128 + wch * 8); wl1 = *(const uint4*)(p.WRlo + (size_t)(wj + 32) * 1024 + (kn) * 128 + wch * 8); \
      wh2 = *(const uint4*)(p.WRhi + (size_t)(wj + 64) * 1024 + (kn) * 128 + wch * 8); wl2 = *(const uint4*)(p.WRlo + (size_t)(wj + 64) * 1024 + (kn) * 128 + wch * 8); } while (0)
    RT_LOADW(0);
    __syncthreads();
    hf32x4 acc[3];
#pragma unroll
    for (int nt = 0; nt < 3; ++nt) acc[nt] = (hf32x4){0.f, 0.f, 0.f, 0.f};
    const int mt = wid & 3, nh = wid >> 2;
#pragma unroll 1
    for (int kc = 0; kc < 8; ++kc) {
#pragma unroll
      for (int i = 0; i < 4; ++i) {
        const int e = tid + i * NTHR; const int tok = e >> 5, k4 = (e & 31) * 4;
        const int kg = kc * 128 + k4;
        const float4 v = xv[i];
        const float4 g = *(const float4*)(GM + kg);
        const float4 h4 = *(const float4*)(SH + kg);
        const float rstd = RS[tok];
        const float h0 = v.x * rstd * g.x + h4.x, h1 = v.y * rstd * g.y + h4.y;
        const float h2 = v.z * rstd * g.z + h4.z, h3 = v.w * rstd * g.w + h4.w;
        const unsigned hi01 = cvt_pk_bf16(h0, h1), hi23 = cvt_pk_bf16(h2, h3);
        const unsigned lo01 = cvt_pk_bf16(h0 - __uint_as_float(hi01 << 16), h1 - __uint_as_float(hi01 & 0xffff0000u));
        const unsigned lo23 = cvt_pk_bf16(h2 - __uint_as_float(hi23 << 16), h3 - __uint_as_float(hi23 & 0xffff0000u));
        *(uint2*)(AH + tok * AROW + k4 * 2) = make_uint2(hi01, hi23);
        *(uint2*)(AL + tok * AROW + k4 * 2) = make_uint2(lo01, lo23);
        *(uint2*)(p.H2b + (size_t)(row0 + tok) * D + kg) = make_uint2(hi01, hi23);
      }
      *(uint4*)(WH + wj * AROW + wch * 16) = wh0; *(uint4*)(WL + wj * AROW + wch * 16) = wl0;
      *(uint4*)(WH + (wj + 32) * AROW + wch * 16) = wh1; *(uint4*)(WL + (wj + 32) * AROW + wch * 16) = wl1;
      *(uint4*)(WH + (wj + 64) * AROW + wch * 16) = wh2; *(uint4*)(WL + (wj + 64) * AROW + wch * 16) = wl2;
      {
        const int kn = (kc + 1 < 8) ? (kc + 1) : kc;
#pragma unroll
        for (int i = 0; i < 4; ++i) { const int e = tid + i * NTHR; xv[i] = *(const float4*)(p.X1 + (size_t)(row0 + (e >> 5)) * D + kn * 128 + (e & 31) * 4); }
        RT_LOADW(kn);
      }
      __syncthreads();
#pragma unroll
      for (int kk = 0; kk < 4; ++kk) {
        const hbf16x8 Ahi = *(const hbf16x8*)(AH + (16 * mt + fr) * AROW + 2 * (32 * kk + 8 * fq));
        const hbf16x8 Alo = *(const hbf16x8*)(AL + (16 * mt + fr) * AROW + 2 * (32 * kk + 8 * fq));
#pragma unroll
        for (int nt = 0; nt < 3; ++nt) {
          const int wo = (16 * (nh * 3 + nt) + fr) * AROW + 2 * (32 * kk + 8 * fq);
          const hbf16x8 Bhi = *(const hbf16x8*)(WH + wo);
          const hbf16x8 Blo = *(const hbf16x8*)(WL + wo);
          acc[nt] = __builtin_amdgcn_mfma_f32_16x16x32_bf16(Ahi, Bhi, acc[nt], 0, 0, 0);
          acc[nt] = __builtin_amdgcn_mfma_f32_16x16x32_bf16(Ahi, Blo, acc[nt], 0, 0, 0);
          acc[nt] = __builtin_amdgcn_mfma_f32_16x16x32_bf16(Alo, Bhi, acc[nt], 0, 0, 0);
        }
      }
      __syncthreads();
    }
    if (tid < 64) LC[tid] = 0;
#pragma unroll
    for (int nt = 0; nt < 3; ++nt)
#pragma unroll
      for (int r = 0; r < 4; ++r) LOG[(16 * mt + 4 * fq + r) * 100 + 16 * (nh * 3 + nt) + fr] = acc[nt][r];
    __syncthreads();
    int ea = 0, eb = 0, sa = 0, sb2 = 0;
    if (tid < 64) {
      const float* lg = LOG + tid * 100;
      const int row = row0 + tid;
      int gs = 0; float gm = lg[64] + p.b_group[0];
      float gl[8];
      gl[0] = gm;
#pragma unroll
      for (int j = 1; j < 8; ++j) { gl[j] = lg[64 + j] + p.b_group[j]; if (gl[j] > gm) { gm = gl[j]; gs = j; } }
      float den = 0.f;
#pragma unroll
      for (int j = 0; j < 8; ++j) den += expf(gl[j] - gm);
      const float pg = 1.f / den;
      float el[8];
#pragma unroll
      for (int j = 0; j < 8; ++j) el[j] = 0.f;
      for (int j = 0; j < 8; ++j) el[j] = lg[gs * 8 + j] + p.b_expert[gs * 8 + j];
      int i0 = 0; float l0 = el[0];
#pragma unroll
      for (int j = 1; j < 8; ++j) if (el[j] > l0) { l0 = el[j]; i0 = j; }
      int i1 = -1; float l1 = -3.0e38f;
#pragma unroll
      for (int j = 0; j < 8; ++j) if (j != i0 && el[j] > l1) { l1 = el[j]; i1 = j; }
      const float e1 = expf(l1 - l0);
      const float w0 = 1.f / (1.f + e1), w1 = e1 / (1.f + e1);
      p.GATE[row * 2 + 0] = w0 * pg;
      p.GATE[row * 2 + 1] = w1 * pg;
      ea = gs * 8 + i0; eb = gs * 8 + i1;
      sa = atomicAdd(&LC[ea], 1);
      sb2 = atomicAdd(&LC[eb], 1);
    }
    __syncthreads();
    if (tid < 64) { const int n = LC[tid]; LB[tid] = n ? atomicAdd(&p.CNT[tid * 32], n) : 0; }
    __syncthreads();
    if (tid < 64) {
      const int row = row0 + tid;
      p.LIST[ea * T + LB[ea] + sa] = row * 2 + 0;
      p.LIST[eb * T + LB[eb] + sb2] = row * 2 + 1;
    }
    __syncthreads();
  }
}

__device__ __forceinline__ void moe_table(const Params& p, int* tab) {
  if (threadIdx.x == 0) {
    int a = 0, sg = 0;
    for (int e = 0; e < NE; ++e) {
      int cn = p.CNT[e * 32];
      tab[e] = a; tab[65 + e] = sg; tab[130 + e] = cn;
      a += (cn + 255) >> 8; sg += ((cn + 127) >> 7) << 7;
    }
    tab[NE] = a; tab[65 + NE] = sg;
  }
  __syncthreads();
}

template <bool UP>
__device__ void moe_gemm_phase(const Params& p, unsigned char* lds, const int* tab) {
  constexpr int K = UP ? 1024 : 512;
  constexpr int NKT = K / 32;
  constexpr int LDB = UP ? 512 : 1024;
  const int tid = threadIdx.x, wid = __builtin_amdgcn_readfirstlane(tid >> 6), lane = tid & 63, fr = lane & 15, fq = lane >> 4;
  const int wm = wid >> 1, wn = wid & 1;
  constexpr int AOFF0 = 0, AOFF1 = 16384, BOFF0 = 32768, BOFF1 = 32768 + 256 * 80;
  const int total = tab[64] * 4;
  for (int ui = blockIdx.x; ui < total; ui += gridDim.x) {
    int e = 0;
    while (tab[e + 1] * 4 <= ui) ++e;
    const int local = ui - tab[e] * 4;
    const int mu = local >> 2, nt = local & 3;
    const int cnt = tab[130 + e], seg = tab[65 + e];
    const int rem = cnt - mu * 256;
    const bool full = rem > 128;
    const bool active = full || wm < 2;
    const int srow = tid >> 2, spc = tid & 3;
    unsigned aoffs[2];
#pragma unroll
    for (int i = 0; i < 2; ++i) {
      const int row = srow + 128 * i;
      int idx = mu * 256 + row;
      unsigned rowb;
      if (UP) { if (idx > cnt - 1) idx = cnt - 1; rowb = (unsigned)(p.LIST[e * T + idx] >> 1) * (unsigned)(K * 2); }
      else rowb = (unsigned)(seg + idx) * (unsigned)(K * 2);
      aoffs[i] = rowb + (unsigned)((spc ^ ((row >> 2) & 3)) * 16);
    }
    const char* Abase = UP ? (const char*)p.H2b : (const char*)p.HBb;
    const float* bsrc;
    if (UP) bsrc = ((lane < 32) ? p.w1 : p.w3) + (size_t)e * 1024 * 512 + nt * 128 + 4 * (lane & 31) + (size_t)(4 * wid) * LDB;
    else bsrc = p.w2 + (size_t)e * 512 * 1024 + nt * 256 + 4 * lane + (size_t)(4 * wid) * LDB;
    hf32x4 acc[4][8];
#pragma unroll
    for (int m = 0; m < 4; ++m)
#pragma unroll
      for (int j = 0; j < 8; ++j) acc[m][j] = (hf32x4){0.f, 0.f, 0.f, 0.f};
    uint4 P0a0, P0a1, P1a0, P1a1;
    float4 P0b0, P0b1, P0b2, P0b3, P1b0, P1b1, P1b2, P1b3;
#define MG_LOAD(kt, S) do { \
      S##a0 = *(const uint4*)(Abase + aoffs[0] + (kt) * 64); S##a1 = *(const uint4*)(Abase + aoffs[1] + (kt) * 64); \
      S##b0 = *(const float4*)(bsrc + (size_t)((kt) * 32 + 0) * LDB); S##b1 = *(const float4*)(bsrc + (size_t)((kt) * 32 + 1) * LDB); \
      S##b2 = *(const float4*)(bsrc + (size_t)((kt) * 32 + 2) * LDB); S##b3 = *(const float4*)(bsrc + (size_t)((kt) * 32 + 3) * LDB); } while (0)
#define MG_WRITE(aoff, boff, S) do { \
      *(uint4*)(lds + (aoff) + (srow) * 64 + spc * 16) = S##a0; \
      if (full) *(uint4*)(lds + (aoff) + (srow + 128) * 64 + spc * 16) = S##a1; \
      *(uint2*)(lds + (boff) + (4 * lane + 0) * 80 + 8 * wid) = make_uint2(cvt_pk_bf16(S##b0.x, S##b1.x), cvt_pk_bf16(S##b2.x, S##b3.x)); \
      *(uint2*)(lds + (boff) + (4 * lane + 1) * 80 + 8 * wid) = make_uint2(cvt_pk_bf16(S##b0.y, S##b1.y), cvt_pk_bf16(S##b2.y, S##b3.y)); \
      *(uint2*)(lds + (boff) + (4 * lane + 2) * 80 + 8 * wid) = make_uint2(cvt_pk_bf16(S##b0.z, S##b1.z), cvt_pk_bf16(S##b2.z, S##b3.z)); \
      *(uint2*)(lds + (boff) + (4 * lane + 3) * 80 + 8 * wid) = make_uint2(cvt_pk_bf16(S##b0.w, S##b1.w), cvt_pk_bf16(S##b2.w, S##b3.w)); } while (0)
#define MG_MMA(aoff, boff) do { if (active) { \
      hbf16x8 Af[4]; \
      _Pragma("unroll") for (int m = 0; m < 4; ++m) { const int row = 64 * wm + 16 * m + fr; \
        Af[m] = *(const hbf16x8*)(lds + (aoff) + row * 64 + ((fq ^ ((row >> 2) & 3)) * 16)); } \
      _Pragma("unroll") for (int jh = 0; jh < 2; ++jh) { \
        hbf16x8 Bf[4]; \
        _Pragma("unroll") for (int j4 = 0; j4 < 4; ++j4) { const int j = jh * 4 + j4; \
          const int nrow = UP ? ((j < 4) ? (64 * wn + 16 * j + fr) : (128 + 64 * wn + 16 * (j - 4) + fr)) : (128 * wn + 16 * j + fr); \
          Bf[j4] = *(const hbf16x8*)(lds + (boff) + nrow * 80 + 16 * fq); } \
        _Pragma("unroll") for (int m = 0; m < 4; ++m) _Pragma("unroll") for (int j4 = 0; j4 < 4; ++j4) \
          acc[m][jh * 4 + j4] = __builtin_amdgcn_mfma_f32_16x16x32_bf16(Bf[j4], Af[m], acc[m][jh * 4 + j4], 0, 0, 0); } } } while (0)
    MG_LOAD(0, P0);
    MG_LOAD(1, P1);
    MG_WRITE(AOFF0, BOFF0, P0);
    __syncthreads();
#pragma unroll 1
    for (int kt = 0; kt < NKT; kt += 2) {
      { const int kn = (kt + 2 < NKT) ? (kt + 2) : kt; MG_LOAD(kn, P0); }
      MG_MMA(AOFF0, BOFF0);
      MG_WRITE(AOFF1, BOFF1, P1);
      __syncthreads();
      { const int kn = (kt + 3 < NKT) ? (kt + 3) : (kt + 1); MG_LOAD(kn, P1); }
      MG_MMA(AOFF1, BOFF1);
      MG_WRITE(AOFF0, BOFF0, P0);
      __syncthreads();
    }
#undef MG_LOAD
#undef MG_WRITE
#undef MG_MMA
    if (active) {
#pragma unroll
      for (int m = 0; m < 4; ++m) {
        const int slot = mu * 256 + 64 * wm + 16 * m + fr;
        if (slot < cnt) {
          if (UP) {
            bf16_t* hp = p.HBb + (size_t)(seg + slot) * DE + nt * 128 + 64 * wn + 4 * fq;
#pragma unroll
            for (int j = 0; j < 4; ++j) {
              float h[4];
#pragma unroll
              for (int r = 0; r < 4; ++r) { const float av = acc[m][j][r]; h[r] = av / (1.f + __expf(-av)) * acc[m][j + 4][r]; }
              *(uint2*)(hp + 16 * j) = make_uint2(cvt_pk_bf16(h[0], h[1]), cvt_pk_bf16(h[2], h[3]));
            }
          } else {
            const int pair = p.LIST[e * T + slot];
            const float gt = p.GATE[pair];
            bf16_t* yp = p.YB2b + (size_t)pair * D + nt * 256 + 128 * wn + 4 * fq;
#pragma unroll
            for (int j = 0; j < 8; ++j)
              *(uint2*)(yp + 16 * j) = make_uint2(cvt_pk_bf16(gt * acc[m][j][0], gt * acc[m][j][1]), cvt_pk_bf16(gt * acc[m][j][2], gt * acc[m][j][3]));
          }
        }
      }
    }
  }
}

__device__ void ph_final(const Params& p) {
  const int tid = threadIdx.x, wid = tid >> 6, lane = tid & 63;
  for (int row = blockIdx.x * 8 + wid; row < T; row += gridDim.x * 8) {
    const float* ga2 = p.MOD + (row / L) * 6144 + 5120;
    float4 v[4];
    float ss = 0.f;
#pragma unroll
    for (int i = 0; i < 4; ++i) {
      const int col = i * 256 + lane * 4;
      float4 xv = *(const float4*)(p.X1 + (size_t)row * D + col);
      uint2 a = *(const uint2*)(p.YB2b + (size_t)(row * 2) * D + col);
      uint2 b = *(const uint2*)(p.YB2b + (size_t)(row * 2 + 1) * D + col);
      float4 ga = *(const float4*)(ga2 + col);
      v[i].x = xv.x + ga.x * (__uint_as_float(a.x << 16) + __uint_as_float(b.x << 16));
      v[i].y = xv.y + ga.y * (__uint_as_float(a.x & 0xffff0000u) + __uint_as_float(b.x & 0xffff0000u));
      v[i].z = xv.z + ga.z * (__uint_as_float(a.y << 16) + __uint_as_float(b.y << 16));
      v[i].w = xv.w + ga.w * (__uint_as_float(a.y & 0xffff0000u) + __uint_as_float(b.y & 0xffff0000u));
      ss += v[i].x * v[i].x + v[i].y * v[i].y + v[i].z * v[i].z + v[i].w * v[i].w;
    }
    ss = wave_sum(ss);
    const float rstd = rsqrtf(ss * (1.f / D) + EPS);
#pragma unroll
    for (int i = 0; i < 4; ++i) {
      const int col = i * 256 + lane * 4;
      float4 gf = *(const float4*)(p.g_final + col);
      float4 o;
      o.x = v[i].x * rstd * gf.x; o.y = v[i].y * rstd * gf.y; o.z = v[i].z * rstd * gf.z; o.w = v[i].w * rstd * gf.w;
      *(float4*)(p.out + (size_t)row * D + col) = o;
    }
  }
}

constexpr int NPHASE = 11;

__global__ void __launch_bounds__(NTHR, 2) mega(Params p) {
  extern __shared__ __attribute__((aligned(16))) unsigned char lds_raw[];
  float* sm = (float*)lds_raw;
  PG8_LAS unsigned char* lds = (PG8_LAS unsigned char*)lds_raw;
  const int lo = p.lo, hi = p.hi;
  volatile LAS unsigned* xbst = (volatile LAS unsigned*)(lds + pg8::STAGE_BYTES + 2048);
  if (threadIdx.x < 4) xbst[threadIdx.x] = 0u;
  __syncthreads();
  XcdBarrier xbar; xbar.bar = p.BAR; xbar.x = 0; xbar.st = xbst;
  if (hi - lo > 1) xbar = xcd_barrier_post(p.BAR, xbst);
#define IN(k) (lo <= (k) && (k) < hi)
#define SYNC(k) do { if (IN(k) && IN((k) + 1)) xcd_barrier(xbar); } while (0)
#ifndef DUPK
#define DUPK -1
#endif
#ifndef SKIP_OTHER
  if (IN(0)) { ph_adaln(p, sm); ph_filters(p, sm); ph_wcvt(p, sm); }
#if DUPK == 0
  xcd_barrier(xbar);
  if (IN(0)) { ph_adaln(p, sm); ph_filters(p, sm); ph_wcvt(p, sm); }
#endif
  SYNC(0);
  if (IN(1)) ph_norm1(p);
#if DUPK == 1
  xcd_barrier(xbar);
  if (IN(1)) ph_norm1(p);
#endif
  SYNC(1);
#endif
#ifndef SKIP_GEMM
  if (IN(2)) {
    pg8::DenseOrder S{p.XNb, p.WinT, TT / 256, DP / 256 + 1, D, (int)gridDim.x, (int)blockIdx.x};
    pg8::EpiBf16 E{p.PXb, DP, p.DT, p.dt_bias};
    pg8::gemm_phase<pg8::EpiBf16, pg8::DenseOrder>(lds, D, S, E);
  }
#if DUPK == 2
  xcd_barrier(xbar);
  if (IN(2)) {
    pg8::DenseOrder S{p.XNb, p.WinT, TT / 256, DP / 256 + 1, D, (int)gridDim.x, (int)blockIdx.x};
    pg8::EpiBf16 E{p.PXb, DP, p.DT, p.dt_bias};
    pg8::gemm_phase<pg8::EpiBf16, pg8::DenseOrder>(lds, D, S, E);
  }
#endif
  SYNC(2);
#endif
#ifndef SKIP_OTHER
  if (IN(3)) {
    ph_hy_convT(p, sm);
    for (int it = blockIdx.x; it < 288; it += gridDim.x) ssd_states_unit(p, it, lds_raw);
  }
#if DUPK == 3
  xcd_barrier(xbar);
  if (IN(3)) {
    ph_hy_convT(p, sm);
    for (int it = blockIdx.x; it < 288; it += gridDim.x) ssd_states_unit(p, it, lds_raw);
  }
#endif
  SYNC(3);
  if (IN(4)) {
    for (int it = blockIdx.x; it < 256; it += gridDim.x) ssd_scan_unit(p, it);
    for (int it = blockIdx.x; it < 512; it += gridDim.x) hyena_unit(p, it, lds_raw);
  }
#if DUPK == 4
  xcd_barrier(xbar);
  if (IN(4)) {
    for (int it = blockIdx.x; it < 256; it += gridDim.x) ssd_scan_unit(p, it);
    for (int it = blockIdx.x; it < 512; it += gridDim.x) hyena_unit(p, it, lds_raw);
  }
#endif
  SYNC(4);
  if (IN(5)) {
    for (int it = blockIdx.x; it < 256; it += gridDim.x) { ssd_out_unit(p, it, lds_raw); __syncthreads(); }
    ph_hy_backT(p, sm);
  }
#if DUPK == 5
  xcd_barrier(xbar);
  if (IN(5)) {
    for (int it = blockIdx.x; it < 256; it += gridDim.x) { ssd_out_unit(p, it, lds_raw); __syncthreads(); }
    ph_hy_backT(p, sm);
  }
#endif
  SYNC(5);
#endif
#ifndef SKIP_GEMM
  if (IN(6)) {
    pg8::DenseOrder S{p.YMIXb, p.WoutT, T / 256, D / 256, D, (int)gridDim.x, (int)blockIdx.x};
    pg8::EpiX1 E{p.x, p.MOD, p.X1, p.SSQP};
    pg8::gemm_phase<pg8::EpiX1, pg8::DenseOrder>(lds, D, S, E);
  }
#if DUPK == 6
  xcd_barrier(xbar);
  if (IN(6)) {
    pg8::DenseOrder S{p.YMIXb, p.WoutT, T / 256, D / 256, D, (int)gridDim.x, (int)blockIdx.x};
    pg8::EpiX1 E{p.x, p.MOD, p.X1, p.SSQP};
    pg8::gemm_phase<pg8::EpiX1, pg8::DenseOrder>(lds, D, S, E);
  }
#endif
  SYNC(6);
#endif
#ifndef SKIP_OTHER
  if (IN(7)) ph_router(p, lds_raw);
#if DUPK == 7
  xcd_barrier(xbar);
  if (IN(7)) ph_router(p, lds_raw);
#endif
  SYNC(7);
#endif
#ifndef SKIP_GEMM
  if (IN(8)) {
    int* tab = (int*)(lds_raw + pg8::STAGE_BYTES);
    moe_table(p, tab);
    moe_gemm_phase<true>(p, lds_raw, tab);
  }
#if DUPK == 8
  xcd_barrier(xbar);
  if (IN(8)) {
    int* tab = (int*)(lds_raw + pg8::STAGE_BYTES);
    moe_table(p, tab);
    moe_gemm_phase<true>(p, lds_raw, tab);
  }
#endif
  SYNC(8);
  if (IN(9)) {
    int* tab = (int*)(lds_raw + pg8::STAGE_BYTES);
    moe_table(p, tab);
    moe_gemm_phase<false>(p, lds_raw, tab);
  }
#if DUPK == 9
  xcd_barrier(xbar);
  if (IN(9)) {
    int* tab = (int*)(lds_raw + pg8::STAGE_BYTES);
    moe_table(p, tab);
    moe_gemm_phase<false>(p, lds_raw, tab);
  }
#endif
  SYNC(9);
#endif
#ifndef SKIP_OTHER
  if (IN(10)) ph_final(p);
#if DUPK == 10
  xcd_barrier(xbar);
  if (IN(10)) ph_final(p);
#endif
#endif
#undef IN
#undef SYNC
}

extern "C" void kernel_launch(void* const* d_in, const int* in_sizes, int n_in, void* d_out, int out_size,
                              void* d_ws, size_t ws_size, hipStream_t stream) {
  Params p{};
  const float* const* in = (const float* const*)d_in;
  p.x = in[0]; p.c = in[1]; p.ctx = in[2]; p.c_ctx = in[3]; p.w_ada = in[4]; p.b_ada = in[5];
  p.g1 = in[6]; p.g2 = in[7]; p.w_in = in[8]; p.hy_conv_w = in[9]; p.hy_conv_b = in[10];
  p.f_w1 = in[11]; p.f_b1 = in[12]; p.f_freq = in[13]; p.f_w2 = in[14]; p.f_b2 = in[15]; p.f_w3 = in[16];
  p.hy_bias = in[17]; p.ssd_conv_w = in[18]; p.ssd_conv_b = in[19]; p.a_log = in[20]; p.dt_bias = in[21];
  p.ssd_d = in[22]; p.ssd_norm_g = in[23]; p.w_out = in[24]; p.w_group = in[25]; p.b_group = in[26];
  p.w_expert = in[27]; p.b_expert = in[28]; p.w1 = in[29]; p.w3 = in[30]; p.w2 = in[31]; p.g_final = in[32];
  p.out = (float*)d_out;

  char* ws = (char*)d_ws;
  size_t off = 0;
  auto take = [&](size_t bytes) { char* r = ws + off; off += (bytes + 255) & ~(size_t)255; return r; };
  p.BAR = (unsigned*)take((size_t)XCD_BAR_WORDS * 4);
  p.MOD = (float*)take((size_t)9 * 6144 * 4);
  p.CNT = (int*)take(NE * 32 * 4);
  p.GATE = (float*)take((size_t)T * 2 * 4);
  p.LIST = (int*)take((size_t)NE * T * 4);
  p.DT = (float*)take((size_t)TT * 16 * 4);
  p.ACUM = (float*)take((size_t)T * 16 * 4);
  p.SSQP = (float*)take((size_t)T * 16 * 4);
  p.CDEC = (float*)take((size_t)128 * 18 * 32 * 4);
  p.FILTt = (bf16_t*)take((size_t)1024 * FLEN * 2);
  p.WRhi = (bf16_t*)take((size_t)96 * 1024 * 2);
  p.WRlo = (bf16_t*)take((size_t)96 * 1024 * 2);
  p.WinT = (bf16_t*)take((size_t)(DP + 256) * D * 2);
  p.WoutT = (bf16_t*)take((size_t)D * D * 2);
  char* rPX = take((size_t)TT * DP * 2);
  char* rXBC = take((size_t)128 * 18 * 8192 * 2);
  char* rYF = take((size_t)T * DS * 4);
  char* rZ1 = take((size_t)HYC * T * 2);
  char* rYB = take((size_t)T * DS * 4);
  char* rYM = take((size_t)T * D * 2);
  p.PXb = (bf16_t*)rPX; p.SST = (bf16_t*)rXBC; p.Ut = (bf16_t*)rZ1; p.YMIXb = (bf16_t*)rYM;
  p.HIN = (bf16_t*)rYF;
  p.Yt = (bf16_t*)rYB;
  p.XNb = (bf16_t*)rZ1;
  p.X1 = (float*)rPX;
  p.H2b = (bf16_t*)rYM;
  p.HBb = (bf16_t*)(rPX + (size_t)T * D * 4);
  p.YB2b = (bf16_t*)rZ1;
  if (off > ws_size) { fprintf(stderr, "workspace too small: need %zu have %zu\n", off, ws_size); return; }

  static int grid_blocks = 0;
  if (!grid_blocks) {
    int dev = 0, cus = 0, per_cu = 0;
    (void)hipGetDevice(&dev);
    (void)hipDeviceGetAttribute(&cus, hipDeviceAttributeMultiprocessorCount, dev);
    (void)hipFuncSetAttribute((const void*)mega, hipFuncAttributeMaxDynamicSharedMemorySize, LDS_BYTES);
    (void)hipOccupancyMaxActiveBlocksPerMultiprocessor(&per_cu, mega, NTHR, LDS_BYTES);
    if (per_cu < 1) { fprintf(stderr, "occupancy query returned %d\n", per_cu); per_cu = 1; }
    grid_blocks = cus;
  }
#ifndef ONE_LAUNCH
  for (int ph = 0; ph < NPHASE; ++ph) {
    p.lo = ph; p.hi = ph + 1;
    hipLaunchKernelGGL(mega, dim3(grid_blocks), dim3(NTHR), LDS_BYTES, stream, p);
  }
#else
  p.lo = 0; p.hi = NPHASE;
  (void)hipMemsetAsync(p.BAR, 0, (size_t)XCD_BAR_WORDS * 4, stream);
  void* args[] = {&p};
  hipError_t e = hipLaunchCooperativeKernel((void*)mega, dim3(grid_blocks), dim3(NTHR), args, LDS_BYTES, stream);
  if (e != hipSuccess) fprintf(stderr, "cooperative launch failed: %s (grid %d)\n", hipGetErrorString(e), grid_blocks);
#endif
}
```

```cpp
#define ONE_LAUNCH 1
#include <hip/hip_runtime.h>
#include <hip/hip_cooperative_groups.h>
#include <cstdio>
#include <cstdint>
namespace cg = cooperative_groups;

constexpr int D = 1024, NB = 8, L = 2048, LC = 256;
constexpr int T = NB * L;
constexpr int TC = NB * LC;
constexpr int TT = T + TC;
constexpr int DH = 512, HYC = 1536, DS = 512, DXBC = 1024, DIN = 3088, DP = 3072;
constexpr int COL_Z = 1536, COL_XBC = 2048, COL_DT = 3072;
constexpr int NE = 64, DE = 512;
constexpr float EPS = 1e-6f;
constexpr int NTHR = 512;
constexpr int LDS_BYTES = 132 * 1024;
constexpr int FLEN = 4232, HX0 = 2112, FCLEN = 4240, ZSTRB = 4240;

typedef unsigned short bf16_t;

struct Params {
  const float *x, *c, *ctx, *c_ctx, *w_ada, *b_ada, *g1, *g2, *w_in, *hy_conv_w, *hy_conv_b;
  const float *f_w1, *f_b1, *f_freq, *f_w2, *f_b2, *f_w3, *hy_bias;
  const float *ssd_conv_w, *ssd_conv_b, *a_log, *dt_bias, *ssd_d, *ssd_norm_g, *w_out;
  const float *w_group, *b_group, *w_expert, *b_expert, *w1, *w3, *w2, *g_final;
  float* out;
  float *MOD, *DT, *X1, *GATE, *ACUM, *CDEC, *SSQP;
  bf16_t *WRhi, *WRlo, *FILTt, *Ut, *Yt, *HIN, *XNb, *WinT, *WoutT, *PXb, *SST, *YMIXb, *YB2b, *H2b, *HBb;
  int *CNT, *LIST;
  unsigned* BAR;
  int lo, hi;
};

__device__ __forceinline__ float silu_f(float v) { return v / (1.f + __expf(-v)); }
__device__ __forceinline__ float softplus_f(float v) { return v > 20.f ? v : log1pf(expf(v)); }
__device__ __forceinline__ float bf2f(bf16_t v) { return __uint_as_float(((unsigned)v) << 16); }
__device__ __forceinline__ unsigned cvt_pk_bf16(float lo, float hi) {
  typedef __bf16 bf2_t __attribute__((ext_vector_type(2)));
  typedef float f2_t __attribute__((ext_vector_type(2)));
  const f2_t v = {lo, hi};
  const bf2_t r = __builtin_convertvector(v, bf2_t);
  return __builtin_bit_cast(unsigned, r);
}
__device__ __forceinline__ bf16_t f2bf(float f) { return (bf16_t)(cvt_pk_bf16(f, 0.f) & 0xffffu); }
__device__ __forceinline__ void st_agent64(void* p, unsigned lo, unsigned hi) {
  __hip_atomic_store((unsigned long long*)p, ((unsigned long long)hi << 32) | lo, __ATOMIC_RELAXED, __HIP_MEMORY_SCOPE_AGENT);
}
__device__ __forceinline__ uint2 ld_agent64(const void* p) {
  const unsigned long long v = __hip_atomic_load((const unsigned long long*)p, __ATOMIC_RELAXED, __HIP_MEMORY_SCOPE_AGENT);
  return make_uint2((unsigned)v, (unsigned)(v >> 32));
}
__device__ __forceinline__ void st_agent32(float* p, float v) { __hip_atomic_store(p, v, __ATOMIC_RELAXED, __HIP_MEMORY_SCOPE_AGENT); }
__device__ __forceinline__ float ld_agent32(const float* p) { return __hip_atomic_load(p, __ATOMIC_RELAXED, __HIP_MEMORY_SCOPE_AGENT); }
__device__ __forceinline__ float wave_sum(float v) {
#pragma unroll
  for (int o = 32; o > 0; o >>= 1) v += __shfl_xor(v, o);
  return v;
}


#define XB_TMO      128
#define XB_XCNT(j)  (256  + 64 * (j))
#define XB_XSUB(j)  (1280 + 64 * (j))
#define XB_XGEN(j)  (2304 + 64 * (j))
#define XB_TOP      3328
#define XB_TOPGEN   3392
#define XCD_BAR_WORDS 3456
#define XB_SPIN_CAP (1u << 18)
#define LAS __attribute__((address_space(3)))
__device__ __forceinline__ unsigned xb_ld(unsigned* p) { return __hip_atomic_load(p, __ATOMIC_RELAXED, __HIP_MEMORY_SCOPE_AGENT); }
__device__ __forceinline__ unsigned xb_add(unsigned* p, unsigned v) { return __hip_atomic_fetch_add(p, v, __ATOMIC_RELAXED, __HIP_MEMORY_SCOPE_AGENT); }
__device__ __forceinline__ unsigned xb_xcc_id() { return (unsigned)__builtin_amdgcn_s_getreg((3 << 11) | 20) & 0xFu; }
#define XB_SPIN(cond, bar) do { unsigned _sp = 0; while (cond) { __builtin_amdgcn_s_sleep(1); \
    if ((++_sp & 255u) == 0u) { if (xb_ld(&(bar)[XB_TMO])) break; if (_sp > XB_SPIN_CAP) { atomicAdd(&(bar)[XB_TMO], 1u); break; } } } } while (0)
struct XcdBarrier { unsigned* bar; unsigned x; volatile LAS unsigned* st; };
__device__ __forceinline__ XcdBarrier xcd_barrier_post(unsigned* bar, volatile LAS unsigned* st) {
  XcdBarrier b; b.bar = bar; b.x = xb_xcc_id(); b.st = st;
  if (threadIdx.x == 0) (void)xb_add(&bar[XB_XCNT(b.x)], 1u);
  return b;
}
__device__ __forceinline__ void xcd_barrier_complete(unsigned* bar, unsigned x, unsigned& nloc, unsigned& nx) {
  const unsigned G = gridDim.x * gridDim.y * gridDim.z;
  unsigned sum, cnt, mine, sp = 0u;
  for (;;) {
    sum = 0u; cnt = 0u; mine = 0u;
#pragma unroll
    for (unsigned j = 0; j < 16; ++j) { const unsigned c = xb_ld(&bar[XB_XCNT(j)]); sum += c; cnt += (c > 0u) ? 1u : 0u; mine = (j == x) ? c : mine; }
    if (sum == G) break;
    __builtin_amdgcn_s_sleep(1);
    if ((++sp & 255u) == 0u) { if (xb_ld(&bar[XB_TMO])) break; if (sp > XB_SPIN_CAP) { atomicAdd(&bar[XB_TMO], 1u); break; } }
  }
  nloc = mine > 0u ? mine : 1u; nx = cnt > 0u ? cnt : 1u;
}
__device__ __forceinline__ void xcd_barrier(const XcdBarrier& b) {
  asm volatile("s_waitcnt vmcnt(0)" ::: "memory");
  __syncthreads();
  if (threadIdx.x == 0) {
    unsigned* bar = b.bar;
    __builtin_amdgcn_s_waitcnt(0);
    unsigned nloc = b.st[0], nx = b.st[1];
    if (nloc == 0u) { xcd_barrier_complete(bar, b.x, nloc, nx); b.st[0] = nloc; b.st[1] = nx; }
    const unsigned old = xb_add(&bar[XB_XSUB(b.x)], 1u);
    const unsigned gen = old / nloc;
    if (old + 1u == (gen + 1u) * nloc) {
      __builtin_amdgcn_fence(__ATOMIC_RELEASE, "agent");
      asm volatile("s_waitcnt vmcnt(0)" ::: "memory");
      const unsigned og = xb_add(&bar[XB_TOP], 1u);
      const unsigned tg = og / nx;
      if (og + 1u == (tg + 1u) * nx) xb_add(&bar[XB_TOPGEN], 1u);
      else XB_SPIN(xb_ld(&bar[XB_TOPGEN]) == tg, bar);
      __builtin_amdgcn_fence(__ATOMIC_ACQUIRE, "agent");
      xb_add(&bar[XB_XGEN(b.x)], 1u);
      asm volatile("s_waitcnt vmcnt(0)" ::: "memory");
    } else {
      XB_SPIN(xb_ld(&bar[XB_XGEN(b.x)]) == gen, bar);
      __builtin_amdgcn_fence(__ATOMIC_ACQUIRE, "agent");
      asm volatile("s_waitcnt vmcnt(0)" ::: "memory");
    }
  }
  __syncthreads();
}

namespace pg8 {
#define PG8_LAS __attribute__((address_space(3)))
typedef short bf16x8 __attribute__((ext_vector_type(8)));
typedef float f32x4 __attribute__((ext_vector_type(4)));
typedef unsigned u32x4 __attribute__((ext_vector_type(4)));
typedef unsigned u32x2 __attribute__((ext_vector_type(2)));
constexpr int BM = 256, BK = 64, HALF = 128, HTB = HALF * BK * 2, STAGE_BYTES = 8 * HTB, NXCD = 8, WGM = 8;

__host__ __device__ __forceinline__ int lds_byte(int r, int c) {
  const int st = (r >> 4) * 2 + (c >> 5), rr = r & 15, cc = c & 31, ob = rr * 64 + cc * 2;
  return st * 1024 + (ob ^ (((ob >> 9) & 1) << 5));
}
__host__ __device__ __forceinline__ void stage_rc(int b, int& R, int& C) {
  const int st = b / 1024, sb = b % 1024, swz = sb ^ (((sb >> 9) & 1) << 5);
  R = (st >> 1) * 16 + swz / 64; C = (st & 1) * 32 + (swz % 64) / 2;
}
__host__ __device__ __forceinline__ int perm32(int rho) { const int n = rho >> 4, i = rho & 15; return 8 * (i >> 2) + 4 * n + (i & 3); }

struct Unit { int pm, pn, e, mu, nv, cnt, seg; };

__device__ __forceinline__ bool static_next(int nM, int nN, int G, int c, int i, int& pm, int& pn) {
  const int nwg = nM * nN;
  const long Lx = (long)i * G + c; if (Lx >= nwg) return false;
  int wgid = (int)Lx;
  { const int q = nwg / NXCD, r = nwg % NXCD, xcd = wgid % NXCD, off = wgid / NXCD; wgid = (xcd < r ? xcd * (q + 1) : r * (q + 1) + (xcd - r) * q) + off; }
  const int nig = WGM * nN, gid = wgid / nig, fm = gid * WGM, gsz = (nM - fm) < WGM ? (nM - fm) : WGM;
  pm = fm + ((wgid % nig) % gsz); pn = (wgid % nig) / gsz; return true;
}

struct DenseOrder {
  const bf16_t* A; const bf16_t* Bt; int nM, nN, K, G, c;
  __device__ __forceinline__ bool next(int i, Unit& u) const {
    if (!static_next(nM, nN, G, c, i, u.pm, u.pn)) return false;
    u.e = 0; u.mu = 0; u.nv = 256; u.cnt = 256; u.seg = 0; return true;
  }
  __device__ __forceinline__ const char* a_base() const { return (const char*)A; }
  __device__ __forceinline__ const char* b_ptr(const Unit& u) const { return (const char*)Bt + (size_t)u.pn * 256 * K * 2; }
  __device__ __forceinline__ void a_offs(const Unit& u, const int (&R)[2], const int (&C)[2], unsigned (&ao)[2][2]) const {
#pragma unroll
    for (int h = 0; h < 2; ++h)
#pragma unroll
      for (int i = 0; i < 2; ++i) ao[h][i] = (unsigned)((u.pm * 256 + h * 128 + R[i]) * K + C[i]) * 2u;
  }
};

struct MoeOrder {
  const int* tab; const bf16_t* A; const bf16_t* Bt; const int* list; int NTn, K, G, c; bool gather;
  __device__ __forceinline__ bool next(int i, Unit& u) const {
    const int Lx = i * G + c;
    if (Lx >= tab[64] * NTn) return false;
    const int mg = Lx / NTn; u.pn = Lx - mg * NTn;
    int e = 0;
    while (tab[e + 1] <= mg) ++e;
    u.e = e; u.mu = mg - tab[e]; u.cnt = tab[130 + e]; u.seg = tab[65 + e];
    const int rem = u.cnt - u.mu * 256; u.nv = rem < 256 ? rem : 256; u.pm = 0; return true;
  }
  __device__ __forceinline__ const char* a_base() const { return (const char*)A; }
  __device__ __forceinline__ const char* b_ptr(const Unit& u) const { return (const char*)Bt + ((size_t)u.e * NTn + u.pn) * 256 * K * 2; }
  __device__ __forceinline__ void a_offs(const Unit& u, const int (&R)[2], const int (&C)[2], unsigned (&ao)[2][2]) const {
#pragma unroll
    for (int h = 0; h < 2; ++h)
#pragma unroll
      for (int i = 0; i < 2; ++i) {
        int idx = u.mu * 256 + h * 128 + R[i];
        int row;
        if (gather) { if (idx > u.cnt - 1) idx = u.cnt - 1; row = list[u.e * T + idx] >> 1; }
        else row = u.seg + idx;
        ao[h][i] = (unsigned)(row * K + C[i]) * 2u;
      }
  }
};

struct EpiBf16 {
  static constexpr bool PERM = true;
  bf16_t* O; int ldc; float* DT; const float* dt_bias;
  __device__ __forceinline__ void operator()(const f32x4 (&acc)[2][2][4][2], const Unit& u, int wr, int wc, int fr, int fq) const {
    const int row0 = u.pm * BM + wr * 64 + fr;
    if (u.pn == 12) {
      if (wc == 0 && fq < 2) {
        const f32x4 b0 = *(const f32x4*)(dt_bias + 8 * fq), b1 = *(const f32x4*)(dt_bias + 8 * fq + 4);
#pragma unroll
        for (int ai = 0; ai < 2; ++ai)
#pragma unroll
          for (int m = 0; m < 4; ++m) {
            float* dp = DT + (size_t)(row0 + ai * HALF + m * 16) * 16 + 8 * fq;
            *(f32x4*)dp = acc[ai][0][m][0] + b0; *(f32x4*)(dp + 4) = acc[ai][0][m][1] + b1;
          }
      }
      return;
    }
    const int col0 = u.pn * BM + wc * 32 + 8 * fq;
#pragma unroll
    for (int ai = 0; ai < 2; ++ai)
#pragma unroll
      for (int m = 0; m < 4; ++m) {
        bf16_t* rowp = O + (size_t)(row0 + ai * HALF + m * 16) * ldc + col0;
#pragma unroll
        for (int bj = 0; bj < 2; ++bj) {
          f32x4 v0 = acc[ai][bj][m][0], v1 = acc[ai][bj][m][1];
          u32x4 w; w.x = cvt_pk_bf16(v0[0], v0[1]); w.y = cvt_pk_bf16(v0[2], v0[3]); w.z = cvt_pk_bf16(v1[0], v1[1]); w.w = cvt_pk_bf16(v1[2], v1[3]);
          *(u32x4*)(rowp + bj * HALF) = w;
        }
      }
  }
};

struct EpiX1 {
  static constexpr bool PERM = false;
  const float* x; const float* mod; float* X1; float* SSQP;
  __device__ __forceinline__ void operator()(const f32x4 (&acc)[2][2][4][2], const Unit& u, int wr, int wc, int fr, int fq) const {
    const int row0 = u.pm * BM + wr * 64 + fr, col0 = u.pn * BM + wc * 32 + 4 * fq;
    const float* ga = mod + ((u.pm * BM) / L) * 6144 + 2048 + col0;
    f32x4 gv[2][2];
#pragma unroll
    for (int bj = 0; bj < 2; ++bj)
#pragma unroll
      for (int n = 0; n < 2; ++n) gv[bj][n] = *(const f32x4*)(ga + bj * HALF + n * 16);
#pragma unroll
    for (int ai = 0; ai < 2; ++ai)
#pragma unroll
      for (int m = 0; m < 4; ++m) {
        const size_t off = (size_t)(row0 + ai * HALF + m * 16) * D + col0;
        float ssq = 0.f;
#pragma unroll
        for (int bj = 0; bj < 2; ++bj)
#pragma unroll
          for (int n = 0; n < 2; ++n) {
            const f32x4 xv = *(const f32x4*)(x + off + bj * HALF + n * 16);
            const f32x4 o = xv + gv[bj][n] * acc[ai][bj][m][n];
            *(f32x4*)(X1 + off + bj * HALF + n * 16) = o;
            ssq += (o[0] * o[0] + o[1] * o[1]) + (o[2] * o[2] + o[3] * o[3]);
          }
        ssq += __shfl_xor(ssq, 16); ssq += __shfl_xor(ssq, 32);
        if (fq == 0) SSQP[(size_t)(row0 + ai * HALF + m * 16) * 16 + u.pn * 4 + wc] = ssq;
      }
  }
};

struct EpiSwiGLU {
  static constexpr bool PERM = true;
  bf16_t* HBb;
  __device__ __forceinline__ void operator()(const f32x4 (&acc)[2][2][4][2], const Unit& u, int wr, int wc, int fr, int fq) const {
    const int col0 = u.pn * 128 + wc * 32 + 8 * fq;
#pragma unroll
    for (int ai = 0; ai < 2; ++ai)
#pragma unroll
      for (int m = 0; m < 4; ++m) {
        const int slot = u.mu * 256 + ai * HALF + wr * 64 + m * 16 + fr;
        if (slot < u.cnt) {
          float h[8];
#pragma unroll
          for (int n = 0; n < 2; ++n)
#pragma unroll
            for (int j = 0; j < 4; ++j) { const float a = acc[ai][0][m][n][j]; h[n * 4 + j] = a / (1.f + __expf(-a)) * acc[ai][1][m][n][j]; }
          u32x4 w; w.x = cvt_pk_bf16(h[0], h[1]); w.y = cvt_pk_bf16(h[2], h[3]); w.z = cvt_pk_bf16(h[4], h[5]); w.w = cvt_pk_bf16(h[6], h[7]);
          *(u32x4*)(HBb + (size_t)(u.seg + slot) * DE + col0) = w;
        }
      }
  }
};

struct EpiDown {
  static constexpr bool PERM = true;
  bf16_t* YB2b; const int* list; const float* gate;
  __device__ __forceinline__ void operator()(const f32x4 (&acc)[2][2][4][2], const Unit& u, int wr, int wc, int fr, int fq) const {
    const int col0 = u.pn * 256 + wc * 32 + 8 * fq;
#pragma unroll
    for (int ai = 0; ai < 2; ++ai)
#pragma unroll
      for (int m = 0; m < 4; ++m) {
        const int slot = u.mu * 256 + ai * HALF + wr * 64 + m * 16 + fr;
        if (slot < u.cnt) {
          const int pair = list[u.e * T + slot];
          const float gt = gate[pair];
          bf16_t* rowp = YB2b + (size_t)pair * D + col0;
#pragma unroll
          for (int bj = 0; bj < 2; ++bj) {
            f32x4 v0 = acc[ai][bj][m][0] * gt, v1 = acc[ai][bj][m][1] * gt;
            u32x4 w; w.x = cvt_pk_bf16(v0[0], v0[1]); w.y = cvt_pk_bf16(v0[2], v0[3]); w.z = cvt_pk_bf16(v1[0], v1[1]); w.w = cvt_pk_bf16(v1[2], v1[3]);
            *(u32x4*)(rowp + bj * HALF) = w;
          }
        }
      }
  }
};

template <class Epi, class Sched>
__device__ __forceinline__ void gemm_phase(PG8_LAS unsigned char* lds, const int K, const Sched& S, const Epi& E) {
  const int tid = threadIdx.x, wid = __builtin_amdgcn_readfirstlane(tid >> 6), lane = tid & 63, wr = wid >> 2, wc = wid & 3, fr = lane & 15, fq = lane >> 4;
  const int nt = K / BK;
  int Rr[2], Cc[2];
  unsigned voffB[2];
#pragma unroll
  for (int i = 0; i < 2; ++i) {
    stage_rc(tid * 16 + i * 8192, Rr[i], Cc[i]);
    const int Rb = Epi::PERM ? ((Rr[i] & ~31) + perm32(Rr[i] & 31)) : Rr[i];
    voffB[i] = (unsigned)(Rb * K + Cc[i]) * 2u;
  }
  const size_t kstep = (size_t)(BK * 2);
  const size_t hstep = (size_t)HALF * K * 2;
  const unsigned ldsw = (unsigned)wid * 1024u;
  const int aoff = lds_byte(wr * 64 + fr, fq * 8), boff = lds_byte(wc * 32 + fr, fq * 8);
#define PG8_SA(b, h) (((b) * 2 + (h)) * HTB)
#define PG8_SB(b, h) ((4 + (b) * 2 + (h)) * HTB)
#define PG8_STAGE(bufoff, gbase, voff) do { _Pragma("unroll") for (int _i = 0; _i < 2; ++_i) \
    __builtin_amdgcn_global_load_lds((const unsigned*)((const char*)(gbase) + (voff)[_i]), (PG8_LAS unsigned*)(lds + (bufoff) + ldsw + _i * 8192), 16, 0, 0); } while (0)
#define PG8_LDA(dst, b, h) do { _Pragma("unroll") for (int m = 0; m < 4; ++m) _Pragma("unroll") for (int k = 0; k < 2; ++k) dst[m][k] = *(const PG8_LAS bf16x8*)(lds + PG8_SA(b, h) + aoff + m * 2048 + k * 1024); } while (0)
#define PG8_LDB(dst, b, h) do { _Pragma("unroll") for (int n = 0; n < 2; ++n) _Pragma("unroll") for (int k = 0; k < 2; ++k) dst[n][k] = *(const PG8_LAS bf16x8*)(lds + PG8_SB(b, h) + boff + n * 2048 + k * 1024); } while (0)
#define PG8_MMA(ai, bj, At, Bt) do { __builtin_amdgcn_s_setprio(1); _Pragma("unroll") for (int m = 0; m < 4; ++m) _Pragma("unroll") for (int n = 0; n < 2; ++n) _Pragma("unroll") for (int k = 0; k < 2; ++k) \
    acc[ai][bj][m][n] = __builtin_amdgcn_mfma_f32_16x16x32_bf16(Bt[n][k], At[m][k], acc[ai][bj][m][n], 0, 0, 0); __builtin_amdgcn_s_setprio(0); } while (0)
#define PG8_WAIT_V(n) asm volatile("s_waitcnt vmcnt(" #n ")" ::: "memory")
#define PG8_WAIT_L(n) asm volatile("s_waitcnt lgkmcnt(" #n ")" ::: "memory")
#define PG8_BAR __builtin_amdgcn_s_barrier()
#define PG8_SCHED __builtin_amdgcn_sched_barrier(0)
  Unit cur, nxt; int ui = 0;
  if (!S.next(0, cur)) return;
  f32x4 acc[2][2][4][2];
#pragma unroll
  for (int a = 0; a < 2; ++a)
#pragma unroll
    for (int b = 0; b < 2; ++b)
#pragma unroll
      for (int m = 0; m < 4; ++m)
#pragma unroll
        for (int n = 0; n < 2; ++n) acc[a][b][m][n] = (f32x4){0.f, 0.f, 0.f, 0.f};
  bf16x8 At[4][2], B0[2][2], B1[2][2];
  unsigned cao[2][2], nao[2][2];
  S.a_offs(cur, Rr, Cc, cao);
  const char* const aB = S.a_base();
  const char* cB = S.b_ptr(cur);
  PG8_STAGE(PG8_SB(0, 0), cB, voffB); PG8_STAGE(PG8_SA(0, 0), aB, cao[0]); PG8_STAGE(PG8_SB(0, 1), cB + hstep, voffB); PG8_STAGE(PG8_SA(0, 1), aB, cao[1]);
  if (wr == 1) PG8_BAR;
  PG8_WAIT_V(4); PG8_BAR;
  PG8_STAGE(PG8_SB(1, 0), cB + kstep, voffB); PG8_STAGE(PG8_SA(1, 0), aB + kstep, cao[0]); PG8_STAGE(PG8_SB(1, 1), cB + hstep + kstep, voffB);
  PG8_WAIT_V(6); PG8_BAR;
  for (;;) {
    const bool has_next = S.next(ui + 1, nxt);
    const char* nB = cB;
    if (has_next) { S.a_offs(nxt, Rr, Cc, nao); nB = S.b_ptr(nxt); }
    else {
#pragma unroll
      for (int h = 0; h < 2; ++h)
#pragma unroll
        for (int i = 0; i < 2; ++i) nao[h][i] = cao[h][i];
    }
    const bool full = cur.nv > 128;
    for (int t = 0; t < nt; t += 2) {
      const bool last = (t == nt - 2);
      const char* a1 = aB + (size_t)(t + 1) * kstep;
      const char* a2 = last ? aB : aB + (size_t)(t + 2) * kstep; const char* b2 = last ? nB : cB + (size_t)(t + 2) * kstep;
      const char* a3 = a2 + kstep; const char* b3 = b2 + kstep;
      unsigned so[2][2];
#pragma unroll
      for (int h = 0; h < 2; ++h)
#pragma unroll
        for (int i = 0; i < 2; ++i) so[h][i] = last ? nao[h][i] : cao[h][i];
      PG8_LDB(B0, 0, 0); PG8_SCHED; PG8_LDA(At, 0, 0); PG8_STAGE(PG8_SA(1, 1), a1, cao[1]);
      PG8_WAIT_L(8); PG8_BAR; PG8_WAIT_L(0); PG8_MMA(0, 0, At, B0); PG8_BAR; PG8_SCHED;
      PG8_LDB(B1, 0, 1); PG8_STAGE(PG8_SB(0, 0), b2, voffB);
      PG8_BAR; PG8_WAIT_L(0); PG8_MMA(0, 1, At, B1); PG8_BAR;
      PG8_LDA(At, 0, 1); PG8_STAGE(PG8_SA(0, 0), a2, so[0]);
      PG8_BAR; PG8_WAIT_L(0); if (full) PG8_MMA(1, 0, At, B0); PG8_BAR; PG8_SCHED;
      PG8_STAGE(PG8_SB(0, 1), b2 + hstep, voffB);
      PG8_WAIT_V(6); PG8_BAR; if (full) PG8_MMA(1, 1, At, B1); PG8_BAR;
      PG8_LDB(B0, 1, 0); PG8_SCHED; PG8_LDA(At, 1, 0); PG8_STAGE(PG8_SA(0, 1), a2, so[1]);
      PG8_WAIT_L(8); PG8_BAR; PG8_WAIT_L(0); PG8_MMA(0, 0, At, B0); PG8_BAR; PG8_SCHED;
      PG8_LDB(B1, 1, 1); PG8_STAGE(PG8_SB(1, 0), b3, voffB);
      PG8_BAR; PG8_WAIT_L(0); PG8_MMA(0, 1, At, B1); PG8_BAR;
      PG8_LDA(At, 1, 1); PG8_STAGE(PG8_SA(1, 0), a3, so[0]);
      PG8_BAR; PG8_WAIT_L(0); if (full) PG8_MMA(1, 0, At, B0); PG8_BAR; PG8_SCHED;
      PG8_STAGE(PG8_SB(1, 1), b3 + hstep, voffB);
      PG8_WAIT_V(6); PG8_BAR; if (full) PG8_MMA(1, 1, At, B1); PG8_BAR;
    }
    E(acc, cur, wr, wc, fr, fq);
    if (!has_next) break;
#pragma unroll
    for (int a = 0; a < 2; ++a)
#pragma unroll
      for (int b = 0; b < 2; ++b)
#pragma unroll
        for (int m = 0; m < 4; ++m)
#pragma unroll
          for (int n = 0; n < 2; ++n) acc[a][b][m][n] = (f32x4){0.f, 0.f, 0.f, 0.f};
    cur = nxt; cB = nB; ++ui;
#pragma unroll
    for (int h = 0; h < 2; ++h)
#pragma unroll
      for (int i = 0; i < 2; ++i) cao[h][i] = nao[h][i];
  }
  PG8_WAIT_V(0);
  if (wr == 0) PG8_BAR;
  PG8_BAR;
#undef PG8_SA
#undef PG8_SB
#undef PG8_STAGE
#undef PG8_LDA
#undef PG8_LDB
#undef PG8_MMA
#undef PG8_WAIT_V
#undef PG8_WAIT_L
#undef PG8_BAR
#undef PG8_SCHED
}
}

__device__ void ph_adaln(const Params& p, float* sm) {
  const int tid = threadIdx.x;
  if (blockIdx.x == 0 && tid < NE) p.CNT[tid * 32] = 0;
  for (int e = blockIdx.x * NTHR + tid; e < 96 * 1024; e += gridDim.x * NTHR) {
    const int j = e >> 10, k = e & 1023;
    float w = 0.f;
    if (j < 64) w = p.w_expert[k * 64 + j]; else if (j < 72) w = p.w_group[k * 8 + (j - 64)];
    const unsigned hi = cvt_pk_bf16(w, 0.f) & 0xffffu;
    const float rem = w - __uint_as_float(hi << 16);
    p.WRhi[e] = (bf16_t)hi; p.WRlo[e] = (bf16_t)(cvt_pk_bf16(rem, 0.f) & 0xffffu);
  }
  float* sc = sm;
  float* red = sm + 9 * 1024;
  for (int e = tid; e < 9 * 1024; e += NTHR) {
    const int r = e >> 10, k = e & 1023;
    sc[e] = silu_f(r < 8 ? p.c[r * D + k] : p.c_ctx[k]);
  }
  __syncthreads();
  for (int item = blockIdx.x; item < 192; item += gridDim.x) {
    const int col0 = item * 32;
    const int kq = tid >> 3, c4 = (tid & 7) * 4;
    float acc[9][4];
#pragma unroll
    for (int r = 0; r < 9; ++r)
#pragma unroll
      for (int j = 0; j < 4; ++j) acc[r][j] = 0.f;
    float4 wv[16];
#pragma unroll
    for (int i = 0; i < 16; ++i) wv[i] = *(const float4*)(p.w_ada + (size_t)(kq + i * 64) * 6144 + col0 + c4);
#pragma unroll
    for (int i = 0; i < 16; ++i) {
      const int k = kq + i * 64;
      const float4 w = wv[i];
#pragma unroll
      for (int r = 0; r < 9; ++r) {
        const float sv = sc[r * 1024 + k];
        acc[r][0] += sv * w.x; acc[r][1] += sv * w.y; acc[r][2] += sv * w.z; acc[r][3] += sv * w.w;
      }
    }
#pragma unroll
    for (int r = 0; r < 9; ++r)
#pragma unroll
      for (int j = 0; j < 4; ++j) red[kq * 292 + r * 32 + c4 + j] = acc[r][j];
    __syncthreads();
    if (tid < 288) {
      float a = 0.f;
      for (int q = 0; q < 64; ++q) a += red[q * 292 + tid];
      const int r = tid >> 5, j = tid & 31;
      p.MOD[r * 6144 + col0 + j] = a + p.b_ada[col0 + j];
    }
    __syncthreads();
  }
}

__device__ void ph_filters(const Params& p, float* sm) {
  const int tid = threadIdx.x, wid = tid >> 6, lane = tid & 63;
  float* feats = sm;
  float* h1 = sm + 64 * 20;
  float* h2 = h1 + 64 * 64;
  float* w3s = h2 + 64 * 64;
  bf16_t* tile = (bf16_t*)w3s;
  float* w2s = w3s + 64 * 256;
  float* w1s = w2s + 4096;
  for (int e = tid; e < 4096; e += NTHR) w2s[e] = p.f_w2[e];
  for (int e = tid; e < 17 * 64; e += NTHR) w1s[e] = p.f_w1[e];
  __syncthreads();
  for (int e = blockIdx.x * NTHR + tid; e < 1024 * 137; e += gridDim.x * NTHR) {
    int rowi = e / 137, k = e - rowi * 137;
    int x = (k < 65) ? k : (4160 + (k - 65));
    p.FILTt[(size_t)rowi * FLEN + x] = 0;
  }
  for (int item = blockIdx.x; item < 256; item += gridDim.x) {
    const int tt = item >> 3, ct = item & 7;
    for (int e = tid; e < 4096; e += NTHR) {
      const int i = e >> 6, c4 = (e & 63) * 4;
      *(float4*)(w3s + i * 256 + c4) = *(const float4*)(p.f_w3 + i * 2048 + ct * 256 + c4);
    }
    for (int e = tid; e < 64 * 17; e += NTHR) {
      int tp = e / 17, i = e - tp * 17;
      int t = tt * 64 + tp;
      float f;
      if (i == 0) f = (float)t / (float)(L - 1);
      else {
        int bi = (i - 1) & 7;
        float bandf = (float)(1e-4 + (double)bi * ((7.0 - 1e-4) / 7.0));
        float ang = (float)(2.0 * 3.14159265358979323846 / (double)L) * (float)t * bandf;
        f = (i <= 8) ? cosf(ang) : -sinf(ang);
      }
      feats[tp * 20 + i] = f;
    }
    __syncthreads();
    for (int e = tid; e < 4096; e += NTHR) {
      int tp = e >> 6, j = e & 63;
      float a = p.f_b1[j];
      for (int i = 0; i < 17; ++i) a += feats[tp * 20 + i] * w1s[i * 64 + j];
      h1[e] = __sinf(p.f_freq[j] * a);
    }
    __syncthreads();
    {
      const int tp = tid >> 3, j8 = (tid & 7) * 8;
      float a[8];
#pragma unroll
      for (int c = 0; c < 8; ++c) a[c] = p.f_b2[j8 + c];
#pragma unroll 4
      for (int i = 0; i < 64; ++i) {
        const float hv = h1[tp * 64 + i];
        const float4 w0 = *(const float4*)(w2s + i * 64 + j8), w1 = *(const float4*)(w2s + i * 64 + j8 + 4);
        a[0] += hv * w0.x; a[1] += hv * w0.y; a[2] += hv * w0.z; a[3] += hv * w0.w;
        a[4] += hv * w1.x; a[5] += hv * w1.y; a[6] += hv * w1.z; a[7] += hv * w1.w;
      }
#pragma unroll
      for (int c = 0; c < 8; ++c) h2[tp * 64 + j8 + c] = __sinf(p.f_freq[j8 + c] * a[c]);
    }
    __syncthreads();
    {
      const int cg = tid & 31, tg = tid >> 5;
      float acc[4][8];
#pragma unroll
      for (int a = 0; a < 4; ++a)
#pragma unroll
        for (int c = 0; c < 8; ++c) acc[a][c] = 0.f;
#pragma unroll 4
      for (int i = 0; i < 64; ++i) {
        const float4 w0 = *(const float4*)(w3s + i * 256 + cg * 8), w1 = *(const float4*)(w3s + i * 256 + cg * 8 + 4);
        const float wv[8] = {w0.x, w0.y, w0.z, w0.w, w1.x, w1.y, w1.z, w1.w};
#pragma unroll
        for (int a = 0; a < 4; ++a) {
          const float hv = h2[(tg * 4 + a) * 64 + i];
#pragma unroll
          for (int c = 0; c < 8; ++c) acc[a][c] += hv * wv[c];
        }
      }
      __syncthreads();
      const float d0 = -4.605170185988091f / 1.5f, d1 = -4.605170185988091f / 0.3f;
#pragma unroll
      for (int c = 0; c < 8; ++c) {
        const int col = cg * 8 + c;
        const int cch = (ct * 256 + col) & 511;
        const float delta = fabsf(d0 + (float)cch * ((d1 - d0) / 511.f));
#pragma unroll
        for (int a = 0; a < 4; ++a) {
          const int t = tt * 64 + tg * 4 + a;
          const float tn = (float)t / (float)(L - 1);
          tile[col * 66 + tg * 4 + a] = f2bf(acc[a][c] * __expf(-tn * delta));
        }
      }
    }
    __syncthreads();
    for (int cl = wid * 32; cl < wid * 32 + 32; ++cl) {
      const int gcol = ct * 256 + cl;
      const int o = gcol >> 10, dir = (gcol >> 9) & 1, cch = gcol & 511;
      const int t = tt * 64 + lane;
      const int x = dir ? (HX0 + t) : (HX0 - t);
      if (!(dir && t == 0)) p.FILTt[(size_t)(o * 512 + cch) * FLEN + x] = tile[cl * 66 + lane];
    }
    __syncthreads();
  }
}

__device__ __forceinline__ void cvt_tile256(const float* src, int ld, int k0, int n0, bf16_t* dst, int ldd, int dmap0, int dmap1, int nsplit, float* sm) {
  const int tid = threadIdx.x;
  float* ts = sm;
  float4 v[8];
#pragma unroll
  for (int i = 0; i < 8; ++i) {
    const int e = tid + i * NTHR; const int k = e >> 6, n4 = (e & 63) * 4;
    v[i] = *(const float4*)(src + (size_t)(k0 + k) * ld + n0 + n4);
  }
#pragma unroll
  for (int i = 0; i < 8; ++i) {
    const int e = tid + i * NTHR; const int k = e >> 6, n4 = (e & 63) * 4;
    ts[k * 257 + n4 + 0] = v[i].x; ts[k * 257 + n4 + 1] = v[i].y; ts[k * 257 + n4 + 2] = v[i].z; ts[k * 257 + n4 + 3] = v[i].w;
  }
  __syncthreads();
#pragma unroll
  for (int i = 0; i < 4; ++i) {
    const int e = tid + i * NTHR; const int n = e >> 3, kq = (e & 7) * 8;
    uint4 w;
    w.x = cvt_pk_bf16(ts[(kq + 0) * 257 + n], ts[(kq + 1) * 257 + n]);
    w.y = cvt_pk_bf16(ts[(kq + 2) * 257 + n], ts[(kq + 3) * 257 + n]);
    w.z = cvt_pk_bf16(ts[(kq + 4) * 257 + n], ts[(kq + 5) * 257 + n]);
    w.w = cvt_pk_bf16(ts[(kq + 6) * 257 + n], ts[(kq + 7) * 257 + n]);
    const int drow = (n < nsplit) ? (dmap0 + n) : (dmap1 + (n - nsplit));
    *(uint4*)(dst + (size_t)drow * ldd + k0 + kq) = w;
  }
  __syncthreads();
}

__device__ void ph_wcvt(const Params& p, float* sm) {
  for (int e = blockIdx.x * NTHR + threadIdx.x; e < 16 * 1024; e += gridDim.x * NTHR) {
    const int j = e >> 10, k = e & 1023;
    p.WinT[(size_t)(DP + j) * D + k] = f2bf(p.w_in[(size_t)k * DIN + COL_DT + j]);
  }
  for (int it = blockIdx.x; it < 192 + 64; it += gridDim.x) {
    if (it < 192) { const int kt = it / 12, nt = it - kt * 12; cvt_tile256(p.w_in, DIN, kt * 64, nt * 256, p.WinT, D, nt * 256, 0, 256, sm); }
    else if (it < 256) { const int i = it - 192; const int kt = i >> 2, nt = i & 3; cvt_tile256(p.w_out, D, kt * 64, nt * 256, p.WoutT, D, nt * 256, 0, 256, sm); }
  }
}

__device__ void ph_norm1(const Params& p) {
  const int tid = threadIdx.x, wid = tid >> 6, lane = tid & 63;
  for (int row = blockIdx.x * 8 + wid; row < TT; row += gridDim.x * 8) {
    const float* src = (row < T) ? (p.x + (size_t)row * D) : (p.ctx + (size_t)(row - T) * D);
    const int mr = (row < T) ? (row / L) : 8;
    const float* sh = p.MOD + mr * 6144;
    const float* sc = sh + 1024;
    float4 v[4];
    float ss = 0.f;
#pragma unroll
    for (int i = 0; i < 4; ++i) {
      v[i] = *(const float4*)(src + i * 256 + lane * 4);
      ss += v[i].x * v[i].x + v[i].y * v[i].y + v[i].z * v[i].z + v[i].w * v[i].w;
    }
    ss = wave_sum(ss);
    const float rstd = rsqrtf(ss * (1.f / D) + EPS);
#pragma unroll
    for (int i = 0; i < 4; ++i) {
      const int col = i * 256 + lane * 4;
      float4 g = *(const float4*)(p.g1 + col);
      float4 s4 = *(const float4*)(sc + col);
      float4 h4 = *(const float4*)(sh + col);
      float4 o;
      o.x = v[i].x * rstd * g.x * (1.f + s4.x) + h4.x;
      o.y = v[i].y * rstd * g.y * (1.f + s4.y) + h4.y;
      o.z = v[i].z * rstd * g.z * (1.f + s4.z) + h4.z;
      o.w = v[i].w * rstd * g.w * (1.f + s4.w) + h4.w;
      uint2 w; w.x = cvt_pk_bf16(o.x, o.y); w.y = cvt_pk_bf16(o.z, o.w);
      *(uint2*)(p.XNb + (size_t)row * D + col) = w;
    }
  }
}

__device__ void ph_hy_convT(const Params& p, float* sm) {
  const int tid = threadIdx.x;
  float* tile = sm;
  const int bid = blockIdx.x;
  int it0, it1;
  if (gridDim.x == 256) { if (bid < 32) { it0 = bid * 3; it1 = it0 + 3; } else { it0 = 96 + (bid - 32) * 27; it1 = it0 + 27; } }
  else { const int per = (256 * 24 + gridDim.x - 1) / gridDim.x; it0 = bid * per; it1 = it0 + per; if (it1 > 256 * 24) it1 = 256 * 24; }
  for (int item = it0; item < it1; item += 3) {
    uint4 v[3];
    const int lt = tid >> 3, c8 = (tid & 7) * 8;
#pragma unroll
    for (int u = 0; u < 3; ++u) {
      const int it = (item + u < it1) ? (item + u) : item;
      const int gr = it / 24, ct = it - gr * 24;
      v[u] = *(const uint4*)(p.PXb + (size_t)(gr * 64 + lt) * DP + ct * 64 + c8);
    }
#pragma unroll
    for (int u = 0; u < 3; ++u) {
      float* tl = tile + u * (64 * 65);
      const unsigned w[4] = {v[u].x, v[u].y, v[u].z, v[u].w};
#pragma unroll
      for (int k = 0; k < 4; ++k) {
        tl[lt * 65 + c8 + 2 * k] = __uint_as_float(w[k] << 16);
        tl[lt * 65 + c8 + 2 * k + 1] = __uint_as_float(w[k] & 0xffff0000u);
      }
    }
    __syncthreads();
#pragma unroll
    for (int u = 0; u < 3; ++u) {
      if (item + u < it1) {
        const int it = item + u;
        const int gr = it / 24, ct = it - gr * 24;
        const int row0 = gr * 64;
        const float* tl = tile + u * (64 * 65);
        const int cc = tid >> 3, t8 = (tid & 7) * 8;
        const int col = ct * 64 + cc;
        const float w0 = p.hy_conv_w[col], w1 = p.hy_conv_w[HYC + col], w2 = p.hy_conv_w[2 * HYC + col], bb = p.hy_conv_b[col];
        float o[8];
#pragma unroll
        for (int k = 0; k < 8; ++k) {
          const int t = t8 + k;
          float vv = bb + w1 * tl[t * 65 + cc];
          if (t > 0) vv += w0 * tl[(t - 1) * 65 + cc];
          if (t < 63) vv += w2 * tl[(t + 1) * 65 + cc];
          o[k] = vv;
        }
        uint4 w; w.x = cvt_pk_bf16(o[0], o[1]); w.y = cvt_pk_bf16(o[2], o[3]); w.z = cvt_pk_bf16(o[4], o[5]); w.w = cvt_pk_bf16(o[6], o[7]);
        *(uint4*)(p.Ut + (size_t)col * T + row0 + t8) = w;
      }
    }
    __syncthreads();
  }
}

__device__ void ph_hy_backT(const Params& p, float* sm) {
  const int tid = threadIdx.x;
  bf16_t* tile = (bf16_t*)sm;
  for (int item = blockIdx.x; item < 256 * 8; item += gridDim.x) {
    const int gr = item >> 3, ct = item & 7;
    const int row0 = gr * 64;
    {
      const int cc = tid >> 3, r8 = (tid & 7) * 8;
      uint4 v = *(const uint4*)(p.Yt + (size_t)(ct * 64 + cc) * T + row0 + r8);
      unsigned w[4] = {v.x, v.y, v.z, v.w};
#pragma unroll
      for (int k = 0; k < 4; ++k) {
        tile[cc * 66 + r8 + 2 * k] = (bf16_t)(w[k] & 0xffffu);
        tile[cc * 66 + r8 + 2 * k + 1] = (bf16_t)(w[k] >> 16);
      }
    }
    __syncthreads();
    {
      const int r = tid >> 3, c8 = (tid & 7) * 8;
      unsigned w[4];
#pragma unroll
      for (int k = 0; k < 4; ++k) w[k] = (unsigned)tile[(c8 + 2 * k) * 66 + r] | ((unsigned)tile[(c8 + 2 * k + 1) * 66 + r] << 16);
      uint4 o; o.x = w[0]; o.y = w[1]; o.z = w[2]; o.w = w[3];
      *(uint4*)(p.YMIXb + (size_t)(row0 + r) * D + ct * 64 + c8) = o;
    }
    __syncthreads();
  }
}

typedef short hbf16x8 __attribute__((ext_vector_type(8)));
typedef float hf32x4 __attribute__((ext_vector_type(4)));

constexpr int HY_FC = 0, HY_ZT0 = 4 * FCLEN * 2, HY_ZT1 = HY_ZT0 + 8 * ZSTRB;

__device__ __forceinline__ void hy_build_filter(const Params& p, int o, int c, unsigned char* lds) {
  const int tid = threadIdx.x;
  const bf16_t* gsrc = p.FILTt + (size_t)(o * 512 + c) * FLEN;
  for (int e = tid; e < 530; e += NTHR) {
    uint4 v = make_uint4(0u, 0u, 0u, 0u);
    if (e < 529) v = *(const uint4*)(gsrc + e * 8);
    *(uint4*)(lds + HY_FC + e * 16) = v;
  }
  __syncthreads();
  for (int g = tid; g < 3 * 530; g += NTHR) {
    const int r = 1 + g / 530, ch = g % 530;
    uint4 lo = make_uint4(0u, 0u, 0u, 0u);
    if (ch > 0) lo = *(const uint4*)(lds + HY_FC + (ch - 1) * 16);
    uint4 hi = *(const uint4*)(lds + HY_FC + ch * 16);
    unsigned W[8] = {lo.x, lo.y, lo.z, lo.w, hi.x, hi.y, hi.z, hi.w};
    uint4 ov;
    if (r == 1) {
      ov.x = __builtin_amdgcn_alignbyte(W[4], W[3], 2); ov.y = __builtin_amdgcn_alignbyte(W[5], W[4], 2);
      ov.z = __builtin_amdgcn_alignbyte(W[6], W[5], 2); ov.w = __builtin_amdgcn_alignbyte(W[7], W[6], 2);
    } else if (r == 2) {
      ov.x = W[3]; ov.y = W[4]; ov.z = W[5]; ov.w = W[6];
    } else {
      ov.x = __builtin_amdgcn_alignbyte(W[3], W[2], 2); ov.y = __builtin_amdgcn_alignbyte(W[4], W[3], 2);
      ov.z = __builtin_amdgcn_alignbyte(W[5], W[4], 2); ov.w = __builtin_amdgcn_alignbyte(W[6], W[5], 2);
    }
    *(uint4*)(lds + HY_FC + r * (FCLEN * 2) + ch * 16) = ov;
  }
  __syncthreads();
}

__device__ __forceinline__ void hy_order(const Params& p, int o, int c, unsigned char* lds) {
  const int tid = threadIdx.x, wid = __builtin_amdgcn_readfirstlane(tid >> 6), lane = tid & 63;
  const int g0 = wid * 4;
  const int n16 = lane & 15, h = lane >> 4, bb = n16 & 7, pp = n16 >> 3;
  const unsigned char* Zin = lds + (o ? HY_ZT1 : HY_ZT0);
  const bf16_t* gate = p.Ut + (size_t)((o + 1) * 512 + c) * T + bb * L;
  uint2 xg[4][2];
#pragma unroll
  for (int i = 0; i < 4; ++i)
#pragma unroll
    for (int u = 0; u < 2; ++u) xg[i][u] = *(const uint2*)(gate + 32 * (2 * (g0 + i) + pp) + 16 * u + 4 * h);
  const float bias = p.hy_bias[o * 512 + c];
  hf32x4 acc[4][2];
#pragma unroll
  for (int i = 0; i < 4; ++i)
#pragma unroll
    for (int u = 0; u < 2; ++u) acc[i][u] = (hf32x4){0.f, 0.f, 0.f, 0.f};
  const int ai = lane & 15, ar = ai & 3, aq = ai >> 2;
  const unsigned char* laneA = lds + HY_FC + ar * (FCLEN * 2) + 2 * (HX0 - 4 * aq + 8 * h);
  const unsigned char* laneB = Zin + bb * ZSTRB + 64 + 64 * pp + 16 * h;
#define HY_LDA(dst, Dd) do { const uint2 _lo = *(const uint2*)(laneA - 32 * (Dd)); const uint2 _hi = *(const uint2*)(laneA - 32 * (Dd) + 8); \
    union { uint4 u4; hbf16x8 v; } _cv; _cv.u4 = make_uint4(_lo.x, _lo.y, _hi.x, _hi.y); dst = _cv.v; } while (0)
#define HY_LDB(dst, Qq) do { dst = *(const hbf16x8*)(laneB + 64 * (Qq)); } while (0)
#pragma unroll 1
  for (int pass = 0; pass < 2; ++pass) {
    const int Es = 2 * g0 - 63 + pass;
    hbf16x8 R[4];
    HY_LDB(R[1], 2 * (g0 + 1) - Es); HY_LDB(R[2], 2 * (g0 + 2) - Es); HY_LDB(R[3], 2 * (g0 + 3) - Es);
#pragma unroll 1
    for (int n4 = 0; n4 < 9; ++n4) {
#pragma unroll
      for (int j = 0; j < 4; ++j) {
        const int n = n4 * 4 + j;
        const int E = Es + 2 * n;
        HY_LDB(R[(4 - j) & 3], 2 * (g0 - n) - Es);
        hbf16x8 A0, A1;
        HY_LDA(A0, 2 * E); HY_LDA(A1, 2 * E + 1);
#pragma unroll
        for (int i = 0; i < 4; ++i) {
          const int Q = 2 * (g0 + i - n) - Es;
          if (Q >= -1 && Q <= 63) {
            acc[i][0] = __builtin_amdgcn_mfma_f32_16x16x32_bf16(A0, R[(i - j) & 3], acc[i][0], 0, 0, 0);
            acc[i][1] = __builtin_amdgcn_mfma_f32_16x16x32_bf16(A1, R[(i - j) & 3], acc[i][1], 0, 0, 0);
          }
        }
      }
    }
  }
#undef HY_LDA
#undef HY_LDB
#pragma unroll
  for (int i = 0; i < 4; ++i)
#pragma unroll
    for (int u = 0; u < 2; ++u) {
      const int t0 = 32 * (2 * (g0 + i) + pp) + 16 * u + 4 * h;
      const uint2 zv = *(const uint2*)(Zin + bb * ZSTRB + 64 + 2 * t0);
      const float z0 = __uint_as_float(zv.x << 16), z1 = __uint_as_float(zv.x & 0xffff0000u), z2 = __uint_as_float(zv.y << 16), z3 = __uint_as_float(zv.y & 0xffff0000u);
      const float x0 = __uint_as_float(xg[i][u].x << 16), x1 = __uint_as_float(xg[i][u].x & 0xffff0000u), x2 = __uint_as_float(xg[i][u].y << 16), x3 = __uint_as_float(xg[i][u].y & 0xffff0000u);
      const float r0 = x0 * (acc[i][u][0] + z0 * bias), r1 = x1 * (acc[i][u][1] + z1 * bias), r2 = x2 * (acc[i][u][2] + z2 * bias), r3 = x3 * (acc[i][u][3] + z3 * bias);
      uint2 w; w.x = cvt_pk_bf16(r0, r1); w.y = cvt_pk_bf16(r2, r3);
      if (o == 0) *(uint2*)(lds + HY_ZT1 + bb * ZSTRB + 64 + 2 * t0) = w;
      else *(uint2*)(p.Yt + (size_t)c * T + bb * L + t0) = w;
    }
}

__device__ void hyena_unit(const Params& p, int c, unsigned char* lds) {
  const int tid = threadIdx.x;
  if (tid < 144) {
    const int buf = tid / 72, rem = tid % 72, b = rem / 9, k = rem % 9;
    const int off = (k < 4) ? (k * 16) : (4160 + (k - 4) * 16);
    *(uint4*)(lds + (buf ? HY_ZT1 : HY_ZT0) + b * ZSTRB + off) = make_uint4(0u, 0u, 0u, 0u);
  }
  for (int e = tid; e < 2048; e += NTHR) {
    const int b = e >> 8, ch = e & 255;
    *(uint4*)(lds + HY_ZT0 + b * ZSTRB + 64 + ch * 16) = *(const uint4*)(p.Ut + (size_t)c * T + b * L + ch * 8);
  }
#pragma unroll 1
  for (int o = 0; o < 2; ++o) {
    hy_build_filter(p, o, c, lds);
    hy_order(p, o, c, lds);
    __syncthreads();
  }
}

constexpr int SROW = 272;

__device__ __forceinline__ void ssd_stage_nat(const Params& p, int row0, int pxcol0, int cvcol0, unsigned char* dst) {
  for (int e = threadIdx.x; e < 2048; e += NTHR) {
    const int l = e >> 4, cg = e & 15;
    const int row = row0 + l, li = row & 63;
    const bf16_t* src = p.PXb + (size_t)row * DP + pxcol0 + cg * 8;
    const uint4 zero4 = make_uint4(0u, 0u, 0u, 0u);
    const uint4 cur = *(const uint4*)src;
    const uint4 prv = (li > 0) ? *(const uint4*)(src - DP) : zero4;
    const uint4 nxt = (li < 63) ? *(const uint4*)(src + DP) : zero4;
    const float* cw = p.ssd_conv_w + cvcol0 + cg * 8;
    const float* cb = p.ssd_conv_b + cvcol0 + cg * 8;
    const unsigned pc[4] = {prv.x, prv.y, prv.z, prv.w}, cc[4] = {cur.x, cur.y, cur.z, cur.w}, nc[4] = {nxt.x, nxt.y, nxt.z, nxt.w};
    float o[8];
#pragma unroll
    for (int k = 0; k < 4; ++k) {
      const float p0 = __uint_as_float(pc[k] << 16), p1 = __uint_as_float(pc[k] & 0xffff0000u);
      const float c0 = __uint_as_float(cc[k] << 16), c1 = __uint_as_float(cc[k] & 0xffff0000u);
      const float n0 = __uint_as_float(nc[k] << 16), n1 = __uint_as_float(nc[k] & 0xffff0000u);
      const float v0 = cb[2 * k] + cw[2 * k] * p0 + cw[DXBC + 2 * k] * c0 + cw[2 * DXBC + 2 * k] * n0;
      const float v1 = cb[2 * k + 1] + cw[2 * k + 1] * p1 + cw[DXBC + 2 * k + 1] * c1 + cw[2 * DXBC + 2 * k + 1] * n1;
      o[2 * k] = silu_f(v0); o[2 * k + 1] = silu_f(v1);
    }
    uint4 w; w.x = cvt_pk_bf16(o[0], o[1]); w.y = cvt_pk_bf16(o[2], o[3]); w.z = cvt_pk_bf16(o[4], o[5]); w.w = cvt_pk_bf16(o[6], o[7]);
    *(uint4*)(dst + l * SROW + cg * 16) = w;
  }
}

__device__ __forceinline__ void ssd_stage_tr(const Params& p, int row0, bool is_ctx, int pxcol0, int cvcol0, int ncols, unsigned char* dst) {
  const int ncg = ncols >> 2;
  for (int e = threadIdx.x; e < ncg * 16; e += NTHR) {
    const int cg = e % ncg, l8 = e / ncg;
    const int rowf = row0 + l8 * 8;
    bool has_prev, has_next;
    if (is_ctx) { const int tc = (rowf - T) & (LC - 1); has_prev = tc > 0; has_next = tc + 7 < LC - 1; }
    else { const int li = rowf & 63; has_prev = li > 0; has_next = li + 7 < 63; }
    const bf16_t* src = p.PXb + (size_t)rowf * DP + pxcol0 + cg * 4;
    const uint2 z2 = make_uint2(0u, 0u);
    uint2 raw[10];
    raw[0] = *(const uint2*)((cvcol0 >= 0 && has_prev) ? (src - DP) : src);
    if (!(cvcol0 >= 0 && has_prev)) raw[0] = z2;
#pragma unroll
    for (int k = 0; k < 8; ++k) raw[k + 1] = *(const uint2*)(src + (size_t)k * DP);
    raw[9] = *(const uint2*)((cvcol0 >= 0 && has_next) ? (src + (size_t)8 * DP) : src);
    if (!(cvcol0 >= 0 && has_next)) raw[9] = z2;
    unsigned outw[4][4];
    if (cvcol0 >= 0) {
      const float* cw = p.ssd_conv_w + cvcol0 + cg * 4; const float* cb = p.ssd_conv_b + cvcol0 + cg * 4;
      const float4 a0 = *(const float4*)cw, b0 = *(const float4*)(cw + DXBC), c0 = *(const float4*)(cw + 2 * DXBC), d0 = *(const float4*)cb;
      const float w0[4] = {a0.x, a0.y, a0.z, a0.w}, w1[4] = {b0.x, b0.y, b0.z, b0.w}, w2[4] = {c0.x, c0.y, c0.z, c0.w}, bb[4] = {d0.x, d0.y, d0.z, d0.w};
#pragma unroll
      for (int kp = 0; kp < 4; ++kp) {
#pragma unroll
        for (int c = 0; c < 4; ++c) {
          const unsigned q0 = (c >> 1) ? raw[2 * kp].y : raw[2 * kp].x, q1 = (c >> 1) ? raw[2 * kp + 1].y : raw[2 * kp + 1].x;
          const unsigned q2 = (c >> 1) ? raw[2 * kp + 2].y : raw[2 * kp + 2].x, q3 = (c >> 1) ? raw[2 * kp + 3].y : raw[2 * kp + 3].x;
          float x0, x1, x2, x3;
          if (c & 1) { x0 = __uint_as_float(q0 & 0xffff0000u); x1 = __uint_as_float(q1 & 0xffff0000u); x2 = __uint_as_float(q2 & 0xffff0000u); x3 = __uint_as_float(q3 & 0xffff0000u); }
          else { x0 = __uint_as_float(q0 << 16); x1 = __uint_as_float(q1 << 16); x2 = __uint_as_float(q2 << 16); x3 = __uint_as_float(q3 << 16); }
          const float oa = silu_f(bb[c] + w0[c] * x0 + w1[c] * x1 + w2[c] * x2);
          const float ob = silu_f(bb[c] + w0[c] * x1 + w1[c] * x2 + w2[c] * x3);
          outw[c][kp] = cvt_pk_bf16(oa, ob);
        }
      }
    } else {
#pragma unroll
      for (int kp = 0; kp < 4; ++kp) {
#pragma unroll
        for (int c = 0; c < 4; ++c) {
          const unsigned q1 = (c >> 1) ? raw[2 * kp + 1].y : raw[2 * kp + 1].x, q2 = (c >> 1) ? raw[2 * kp + 2].y : raw[2 * kp + 2].x;
          outw[c][kp] = (c & 1) ? ((q1 >> 16) | (q2 & 0xffff0000u)) : ((q1 & 0xffffu) | (q2 << 16));
        }
      }
    }
#pragma unroll
    for (int c = 0; c < 4; ++c)
      *(uint4*)(dst + (cg * 4 + c) * SROW + l8 * 16) = make_uint4(outw[c][0], outw[c][1], outw[c][2], outw[c][3]);
  }
}

__device__ __forceinline__ void ssd_stage_tr_s(const Params& p, int row0, bool is_ctx, int pxcol0, int cvcol0, int ncols, unsigned char* dst) {
  for (int e = threadIdx.x; e < ncols * 16; e += NTHR) {
    const int col = e & (ncols - 1), l8 = e / ncols;
    const int rowf = row0 + l8 * 8;
    bool has_prev, has_next;
    if (is_ctx) { const int tc = (rowf - T) & (LC - 1); has_prev = tc > 0; has_next = tc + 7 < LC - 1; }
    else { const int li = rowf & 63; has_prev = li > 0; has_next = li + 7 < 63; }
    const bf16_t* src = p.PXb + (size_t)rowf * DP + pxcol0 + col;
    float x[10];
    x[0] = (cvcol0 >= 0 && has_prev) ? bf2f(src[-DP]) : 0.f;
#pragma unroll
    for (int k = 0; k < 8; ++k) x[k + 1] = bf2f(src[(size_t)k * DP]);
    x[9] = (cvcol0 >= 0 && has_next) ? bf2f(src[(size_t)8 * DP]) : 0.f;
    float o[8];
    if (cvcol0 >= 0) {
      const float w0 = p.ssd_conv_w[cvcol0 + col], w1 = p.ssd_conv_w[DXBC + cvcol0 + col], w2 = p.ssd_conv_w[2 * DXBC + cvcol0 + col], bb = p.ssd_conv_b[cvcol0 + col];
#pragma unroll
      for (int k = 0; k < 8; ++k) o[k] = silu_f(bb + w0 * x[k] + w1 * x[k + 1] + w2 * x[k + 2]);
    } else {
#pragma unroll
      for (int k = 0; k < 8; ++k) o[k] = x[k + 1];
    }
    uint4 w; w.x = cvt_pk_bf16(o[0], o[1]); w.y = cvt_pk_bf16(o[2], o[3]); w.z = cvt_pk_bf16(o[4], o[5]); w.w = cvt_pk_bf16(o[6], o[7]);
    *(uint4*)(dst + col * SROW + l8 * 16) = w;
  }
}

__device__ void ssd_states_unit(const Params& p, int unit, unsigned char* lds) {
  const int tid = threadIdx.x, wid = __builtin_amdgcn_readfirstlane(tid >> 6), lane = tid & 63;
  const int g = unit & 1, bc = unit >> 1, cidx = bc % 18, b = bc / 18;
  const bool is_ctx = cidx < 2;
  const int row0 = is_ctx ? (T + b * LC + cidx * 128) : (b * L + (cidx - 2) * 128);
  unsigned char* XT = lds;
  unsigned char* BT = lds + 69632;
  unsigned char* XD = lds + 104448;
  float* WG = (float*)(lds + 121856);
  ssd_stage_tr(p, row0, is_ctx, COL_XBC + g * 256, g * 256, 256, XT);
  ssd_stage_tr(p, row0, is_ctx, COL_XBC + 512 + g * 128, 512 + g * 128, 128, BT);
  {
    const int dir = wid >> 2, hh = wid & 3, h = g * 4 + hh;
    const float A = expf(p.a_log[dir * 8 + h]);
    const int l0 = 2 * lane, l1 = l0 + 1;
    const float dt0 = softplus_f(p.DT[(size_t)(row0 + l0) * 16 + dir * 8 + h]), dt1 = softplus_f(p.DT[(size_t)(row0 + l1) * 16 + dir * 8 + h]);
    const float a0 = -A * dt0, a1 = -A * dt1, pair = a0 + a1;
    float incl = pair;
#pragma unroll
    for (int o = 1; o < 64; o <<= 1) { float t = __shfl_up(incl, o); if (lane >= o) incl += t; }
    const float excl = incl - pair;
    const float total = __shfl(incl, 63);
    float w0, w1, c0, c1;
    if (dir == 0) { c0 = excl + a0; c1 = excl + pair; w0 = dt0 * expf(total - c0); w1 = dt1 * expf(total - c1); }
    else { const float pe0 = excl, pe1 = excl + a0; w0 = dt0 * expf(pe0); w1 = dt1 * expf(pe1); c0 = total - pe0; c1 = total - pe1; }
    WG[wid * 128 + l0] = w0; WG[wid * 128 + l1] = w1;
    if (!is_ctx) { float* ac = p.ACUM + (size_t)(b * 16 + dir * 8 + h) * L + (cidx - 2) * 128; *(float2*)(ac + l0) = make_float2(c0, c1); }
    if (lane == 0) {
      const int k = dir ? (is_ctx ? (1 - cidx) : (19 - cidx)) : cidx;
      p.CDEC[(size_t)(((b * 2 + dir) * 8 + h) * 18 + k) * 32] = expf(total);
    }
  }
  __syncthreads();
  const int fr = lane & 15, fq = lane >> 4;
#pragma unroll 1
  for (int it = 0; it < 8; ++it) {
    const int dir = it >> 2, hh = it & 3, h = g * 4 + hh;
    for (int e = tid; e < 1024; e += NTHR) {
      const int pr = e >> 4, ch = e & 15;
      const uint4 v = *(const uint4*)(XT + (hh * 64 + pr) * SROW + ch * 16);
      const float4 wa = *(const float4*)(WG + it * 128 + ch * 8), wb = *(const float4*)(WG + it * 128 + ch * 8 + 4);
      uint4 w;
      w.x = cvt_pk_bf16(__uint_as_float(v.x << 16) * wa.x, __uint_as_float(v.x & 0xffff0000u) * wa.y);
      w.y = cvt_pk_bf16(__uint_as_float(v.y << 16) * wa.z, __uint_as_float(v.y & 0xffff0000u) * wa.w);
      w.z = cvt_pk_bf16(__uint_as_float(v.z << 16) * wb.x, __uint_as_float(v.z & 0xffff0000u) * wb.y);
      w.w = cvt_pk_bf16(__uint_as_float(v.w << 16) * wb.z, __uint_as_float(v.w & 0xffff0000u) * wb.w);
      *(uint4*)(XD + pr * SROW + ch * 16) = w;
    }
    __syncthreads();
    hf32x4 acc[4];
#pragma unroll
    for (int pt = 0; pt < 4; ++pt) acc[pt] = (hf32x4){0.f, 0.f, 0.f, 0.f};
#pragma unroll
    for (int kk = 0; kk < 4; ++kk) {
      const hbf16x8 Bf = *(const hbf16x8*)(BT + (16 * wid + fr) * SROW + 2 * (32 * kk + 8 * fq));
#pragma unroll
      for (int pt = 0; pt < 4; ++pt) {
        const hbf16x8 Af = *(const hbf16x8*)(XD + (16 * pt + fr) * SROW + 2 * (32 * kk + 8 * fq));
        acc[pt] = __builtin_amdgcn_mfma_f32_16x16x32_bf16(Bf, Af, acc[pt], 0, 0, 0);
      }
    }
    const int k = dir ? (is_ctx ? (1 - cidx) : (19 - cidx)) : cidx;
    bf16_t* slot = p.SST + ((size_t)(((b * 2 + dir) * 8 + h) * 18 + k)) * 8192;
#pragma unroll
    for (int pt = 0; pt < 4; ++pt)
      *(uint2*)(slot + (16 * pt + fr) * 128 + 16 * wid + 4 * fq) = make_uint2(cvt_pk_bf16(acc[pt][0], acc[pt][1]), cvt_pk_bf16(acc[pt][2], acc[pt][3]));
    __syncthreads();
  }
}

__device__ void ssd_scan_unit(const Params& p, int unit) {
  const int tid = threadIdx.x;
  const int half = unit & 1, seq = unit >> 1;
  const int pr = half * 32 + (tid >> 4), n8 = (tid & 15) * 8;
  const bf16_t* base = p.SST + (size_t)seq * 18 * 8192 + pr * 128 + n8;
  uint4 sv[18];
#pragma unroll
  for (int k = 0; k < 18; ++k) sv[k] = *(const uint4*)(base + (size_t)k * 8192);
  float hst[8];
#pragma unroll
  for (int j = 0; j < 8; ++j) hst[j] = 0.f;
#pragma unroll
  for (int k = 0; k < 18; ++k) {
    const float dec = p.CDEC[(size_t)(seq * 18 + k) * 32];
    if (k >= 2) {
      uint4 w; w.x = cvt_pk_bf16(hst[0], hst[1]); w.y = cvt_pk_bf16(hst[2], hst[3]); w.z = cvt_pk_bf16(hst[4], hst[5]); w.w = cvt_pk_bf16(hst[6], hst[7]);
      *(uint4*)(p.HIN + ((size_t)seq * 16 + (k - 2)) * 8192 + pr * 128 + n8) = w;
    }
    const unsigned sw[4] = {sv[k].x, sv[k].y, sv[k].z, sv[k].w};
#pragma unroll
    for (int u = 0; u < 4; ++u) {
      hst[2 * u] = dec * hst[2 * u] + __uint_as_float(sw[u] << 16);
      hst[2 * u + 1] = dec * hst[2 * u + 1] + __uint_as_float(sw[u] & 0xffff0000u);
    }
  }
}

__device__ void ssd_out_unit(const Params& p, int unit, unsigned char* lds) {
  const int tid = threadIdx.x, wid = __builtin_amdgcn_readfirstlane(tid >> 6), lane = tid & 63;
  const int fr = lane & 15, fq = lane >> 4;
  const int g = unit & 1, bc = unit >> 1, c = bc & 15, b = bc >> 4;
  const int row0 = b * L + c * 128;
  unsigned char* CS = lds;
  unsigned char* ML = lds + 34816;
  unsigned char* XT = lds + 69632;
  unsigned char* ZT = lds + 87040;
  unsigned char* HS = lds + 104448;
  float* CUM = (float*)(lds + 121856);
  float* DTL = (float*)(lds + 125952);
  ssd_stage_nat(p, row0, COL_XBC + 768 + g * 128, 768 + g * 128, CS);
  ssd_stage_nat(p, row0, COL_XBC + 512 + g * 128, 512 + g * 128, ML);
  for (int e = tid; e < 1024; e += NTHR) {
    const int it = e >> 7, l = e & 127, dir = it >> 2, hh = it & 3;
    CUM[e] = p.ACUM[(size_t)(b * 16 + dir * 8 + g * 4 + hh) * L + c * 128 + l];
    DTL[e] = softplus_f(p.DT[(size_t)(row0 + l) * 16 + dir * 8 + g * 4 + hh]);
  }
  __syncthreads();
  hf32x4 cbt[8];
#pragma unroll
  for (int lt = 0; lt < 8; ++lt) cbt[lt] = (hf32x4){0.f, 0.f, 0.f, 0.f};
#pragma unroll
  for (int kk = 0; kk < 4; ++kk) {
    const hbf16x8 Af = *(const hbf16x8*)(ML + (16 * wid + fr) * SROW + 2 * (32 * kk + 8 * fq));
#pragma unroll
    for (int lt = 0; lt < 8; ++lt) {
      const hbf16x8 Bf = *(const hbf16x8*)(CS + (16 * lt + fr) * SROW + 2 * (32 * kk + 8 * fq));
      cbt[lt] = __builtin_amdgcn_mfma_f32_16x16x32_bf16(Af, Bf, cbt[lt], 0, 0, 0);
    }
  }
  __syncthreads();
  hf32x4 y[4][4];
#pragma unroll
  for (int hh = 0; hh < 4; ++hh)
#pragma unroll
    for (int pt = 0; pt < 4; ++pt) y[hh][pt] = (hf32x4){0.f, 0.f, 0.f, 0.f};
  const int sb = 16 * wid + 4 * fq;
  uint4 hsa0, hsa1, hsb0, hsb1;
  {
    const bf16_t* slotA = p.HIN + ((size_t)(((b * 2 + 0) * 8 + g * 4) * 16 + c)) * 8192;
    const bf16_t* slotB = p.HIN + ((size_t)(((b * 2 + 1) * 8 + g * 4) * 16 + (15 - c))) * 8192;
    hsa0 = *(const uint4*)(slotA + (tid >> 4) * 128 + (tid & 15) * 8);
    hsa1 = *(const uint4*)(slotA + ((tid >> 4) + 32) * 128 + (tid & 15) * 8);
    hsb0 = *(const uint4*)(slotB + (tid >> 4) * 128 + (tid & 15) * 8);
    hsb1 = *(const uint4*)(slotB + ((tid >> 4) + 32) * 128 + (tid & 15) * 8);
  }
#pragma unroll 1
  for (int hh = 0; hh < 4; ++hh) {
    const int h = g * 4 + hh;
    hf32x4 yc[4];
#pragma unroll
    for (int pt = 0; pt < 4; ++pt) yc[pt] = (hf32x4){0.f, 0.f, 0.f, 0.f};
    ssd_stage_tr_s(p, row0, false, COL_XBC + g * 256 + hh * 64, g * 256 + hh * 64, 64, XT);
    ssd_stage_tr_s(p, row0, false, COL_Z + g * 256 + hh * 64, -1, 64, ZT);
#pragma unroll 1
    for (int dir = 0; dir < 2; ++dir) {
      const int it = dir * 4 + hh;
      const int k = dir ? (17 - c) : (c + 2);
      (void)k;
      {
        const int nh = (hh < 3) ? (h + 1) : h;
        const int nk = dir ? (17 - c) : (c + 2);
        const bf16_t* nslot = p.HIN + ((size_t)(((b * 2 + dir) * 8 + nh) * 16 + (nk - 2))) * 8192;
        const uint4 c0 = dir ? hsb0 : hsa0, c1 = dir ? hsb1 : hsa1;
        *(uint4*)(HS + (tid >> 4) * SROW + (tid & 15) * 16) = c0;
        *(uint4*)(HS + ((tid >> 4) + 32) * SROW + (tid & 15) * 16) = c1;
        const uint4 t0 = *(const uint4*)(nslot + (tid >> 4) * 128 + (tid & 15) * 8);
        const uint4 t1 = *(const uint4*)(nslot + ((tid >> 4) + 32) * 128 + (tid & 15) * 8);
        if (dir == 0) { hsa0 = t0; hsa1 = t1; } else { hsb0 = t0; hsb1 = t1; }
      }
      {
        const float* cu = CUM + it * 128; const float* dl = DTL + it * 128;
        float cs[4], ds[4];
#pragma unroll
        for (int r = 0; r < 4; ++r) { cs[r] = cu[sb + r]; ds[r] = dl[sb + r]; }
#pragma unroll
        for (int lt = 0; lt < 8; ++lt) {
          const int l = 16 * lt + fr;
          const float cl = cu[l];
          float m[4];
#pragma unroll
          for (int r = 0; r < 4; ++r) {
            const int sidx = sb + r;
            const bool ok = dir ? (sidx >= l) : (sidx <= l);
            m[r] = ok ? cbt[lt][r] * __expf(cl - cs[r]) * ds[r] : 0.f;
          }
          uint2 w; w.x = cvt_pk_bf16(m[0], m[1]); w.y = cvt_pk_bf16(m[2], m[3]);
          *(uint2*)(ML + l * SROW + 2 * sb) = w;
        }
      }
      __syncthreads();
      {
        hf32x4 ad[4];
#pragma unroll
        for (int pt = 0; pt < 4; ++pt) ad[pt] = (hf32x4){0.f, 0.f, 0.f, 0.f};
#pragma unroll
        for (int kk = 0; kk < 4; ++kk) {
          const hbf16x8 Am = *(const hbf16x8*)(ML + (16 * wid + fr) * SROW + 2 * (32 * kk + 8 * fq));
#pragma unroll
          for (int pt = 0; pt < 4; ++pt) {
            const hbf16x8 Bx = *(const hbf16x8*)(XT + (16 * pt + fr) * SROW + 2 * (32 * kk + 8 * fq));
            ad[pt] = __builtin_amdgcn_mfma_f32_16x16x32_bf16(Am, Bx, ad[pt], 0, 0, 0);
          }
        }
#pragma unroll
        for (int pt = 0; pt < 4; ++pt) yc[pt] += ad[pt];
      }
      {
        hf32x4 ao[4];
#pragma unroll
        for (int pt = 0; pt < 4; ++pt) ao[pt] = (hf32x4){0.f, 0.f, 0.f, 0.f};
#pragma unroll
        for (int kk = 0; kk < 4; ++kk) {
          const hbf16x8 Ac = *(const hbf16x8*)(CS + (16 * wid + fr) * SROW + 2 * (32 * kk + 8 * fq));
#pragma unroll
          for (int pt = 0; pt < 4; ++pt) {
            const hbf16x8 Bh = *(const hbf16x8*)(HS + (16 * pt + fr) * SROW + 2 * (32 * kk + 8 * fq));
            ao[pt] = __builtin_amdgcn_mfma_f32_16x16x32_bf16(Ac, Bh, ao[pt], 0, 0, 0);
          }
        }
        const float* cu = CUM + it * 128;
        float ex[4];
#pragma unroll
        for (int r = 0; r < 4; ++r) ex[r] = __expf(cu[sb + r]);
#pragma unroll
        for (int pt = 0; pt < 4; ++pt)
#pragma unroll
          for (int r = 0; r < 4; ++r) yc[pt][r] += ex[r] * ao[pt][r];
      }
      __syncthreads();
    }
    {
      const float dsk = p.ssd_d[h];
#pragma unroll
      for (int pt = 0; pt < 4; ++pt) {
        const uint2 xv = *(const uint2*)(XT + (16 * pt + fr) * SROW + 2 * sb);
        const uint2 zv = *(const uint2*)(ZT + (16 * pt + fr) * SROW + 2 * sb);
        const float xs4[4] = {__uint_as_float(xv.x << 16), __uint_as_float(xv.x & 0xffff0000u), __uint_as_float(xv.y << 16), __uint_as_float(xv.y & 0xffff0000u)};
        const float zs4[4] = {__uint_as_float(zv.x << 16), __uint_as_float(zv.x & 0xffff0000u), __uint_as_float(zv.y << 16), __uint_as_float(zv.y & 0xffff0000u)};
#pragma unroll
        for (int r = 0; r < 4; ++r) yc[pt][r] = (yc[pt][r] + dsk * xs4[r]) * silu_f(zs4[r]);
      }
    }
    if (hh == 0) {
#pragma unroll
      for (int pt = 0; pt < 4; ++pt) y[0][pt] = yc[pt];
    } else if (hh == 1) {
#pragma unroll
      for (int pt = 0; pt < 4; ++pt) y[1][pt] = yc[pt];
    } else if (hh == 2) {
#pragma unroll
      for (int pt = 0; pt < 4; ++pt) y[2][pt] = yc[pt];
    } else {
#pragma unroll
      for (int pt = 0; pt < 4; ++pt) y[3][pt] = yc[pt];
    }
    __syncthreads();
  }
  float rinv[4];
#pragma unroll
  for (int r = 0; r < 4; ++r) {
    float ss = 0.f;
#pragma unroll
    for (int hh = 0; hh < 4; ++hh)
#pragma unroll
      for (int pt = 0; pt < 4; ++pt) ss += y[hh][pt][r] * y[hh][pt][r];
    ss += __shfl_xor(ss, 1); ss += __shfl_xor(ss, 2); ss += __shfl_xor(ss, 4); ss += __shfl_xor(ss, 8);
    rinv[r] = rsqrtf(ss * (1.f / 256.f) + EPS);
  }
  {
    bf16_t* OT = (bf16_t*)lds;
#pragma unroll
    for (int hh = 0; hh < 4; ++hh)
#pragma unroll
      for (int pt = 0; pt < 4; ++pt) {
        const int chl = hh * 64 + 16 * pt + fr;
        const float ng = p.ssd_norm_g[g * 256 + chl];
#pragma unroll
        for (int r = 0; r < 4; ++r) OT[(sb + r) * 264 + chl] = f2bf(y[hh][pt][r] * rinv[r] * ng);
      }
    __syncthreads();
    for (int e = tid; e < 128 * 32; e += NTHR) {
      const int l = e >> 5, ch8 = (e & 31) * 8;
      *(uint4*)(p.YMIXb + (size_t)(row0 + l) * D + 512 + g * 256 + ch8) = *(const uint4*)(OT + l * 264 + ch8);
    }
  }
}

__device__ void ph_router(const Params& p, unsigned char* lds) {
  const int tid = threadIdx.x, wid = __builtin_amdgcn_readfirstlane(tid >> 6), lane = tid & 63;
  const int fr = lane & 15, fq = lane >> 4;
  constexpr int AROW = 272;
  unsigned char* AH = lds;
  unsigned char* AL = lds + 64 * AROW;
  unsigned char* WH = lds + 128 * AROW;
  unsigned char* WL = lds + 224 * AROW;
  float* RS = (float*)(lds + 320 * AROW);
  float* LOG = RS + 64;
  float* GM = LOG + 6400;
  float* SH = GM + 1024;
  int* LC = (int*)(SH + 1024);
  int* LB = LC + 64;
  for (int tile = blockIdx.x; tile < T / 64; tile += gridDim.x) {
    const int row0 = tile * 64;
    const float* shp = p.MOD + (row0 / L) * 6144 + 3072;
    const float* scp = shp + 1024;
    if (tid < 64) {
      const float4* sp = (const float4*)(p.SSQP + (size_t)(row0 + tid) * 16);
      const float4 a0 = sp[0], a1 = sp[1], a2 = sp[2], a3 = sp[3];
      const float ss = ((a0.x + a0.y) + (a0.z + a0.w)) + ((a1.x + a1.y) + (a1.z + a1.w)) + ((a2.x + a2.y) + (a2.z + a2.w)) + ((a3.x + a3.y) + (a3.z + a3.w));
      RS[tid] = rsqrtf(ss * (1.f / D) + EPS);
    }
    for (int e = tid; e < 256; e += NTHR) {
      const float4 g = *(const float4*)(p.g2 + e * 4), s4 = *(const float4*)(scp + e * 4), h4 = *(const float4*)(shp + e * 4);
      *(float4*)(GM + e * 4) = make_float4(g.x * (1.f + s4.x), g.y * (1.f + s4.y), g.z * (1.f + s4.z), g.w * (1.f + s4.w));
      *(float4*)(SH + e * 4) = h4;
    }
    float4 xv[4];
#pragma unroll
    for (int i = 0; i < 4; ++i) { const int e = tid + i * NTHR; xv[i] = *(const float4*)(p.X1 + (size_t)(row0 + (e >> 5)) * D + (e & 31) * 4); }
    const int wj = tid >> 4, wch = tid & 15;
    uint4 wh0, wh1, wh2, wl0, wl1, wl2;
#define RT_LOADW(kn) do { \
      wh0 = *(const uint4*)(p.WRhi + (size_t)(wj) * 1024 + (kn) * 128 + wch * 8); wl0 = *(const uint4*)(p.WRlo + (size_t)(wj) * 1024 + (kn) * 128 + wch * 8); \
      wh1 = *(const uint4*)(p.WRhi + (size_t)(wj + 32) * 1024 + (kn) * 128 + wch * 8); wl1 = *(const uint4*)(p.WRlo + (size_t)(wj + 32) * 1024 + (kn) * 128 + wch * 8); \
      wh2 = *(const uint4*)(p.WRhi + (size_t)(wj + 64) * 1024 + (kn) * 128 + wch * 8); wl2 = *(const uint4*)(p.WRlo + (size_t)(wj + 64) * 1024 + (kn) * 128 + wch * 8); } while (0)
    RT_LOADW(0);
    __syncthreads();
    hf32x4 acc[3];
#pragma unroll
    for (int nt = 0; nt < 3; ++nt) acc[nt] = (hf32x4){0.f, 0.f, 0.f, 0.f};
    const int mt = wid & 3, nh = wid >> 2;
#pragma unroll 1
    for (int kc = 0; kc < 8; ++kc) {
#pragma unroll
      for (int i = 0; i < 4; ++i) {
        const int e = tid + i * NTHR; const int tok = e >> 5, k4 = (e & 31) * 4;
        const int kg = kc * 128 + k4;
        const float4 v = xv[i];
        const float4 g = *(const float4*)(GM + kg);
        const float4 h4 = *(const float4*)(SH + kg);
        const float rstd = RS[tok];
        const float h0 = v.x * rstd * g.x + h4.x, h1 = v.y * rstd * g.y + h4.y;
        const float h2 = v.z * rstd * g.z + h4.z, h3 = v.w * rstd * g.w + h4.w;
        const unsigned hi01 = cvt_pk_bf16(h0, h1), hi23 = cvt_pk_bf16(h2, h3);
        const unsigned lo01 = cvt_pk_bf16(h0 - __uint_as_float(hi01 << 16), h1 - __uint_as_float(hi01 & 0xffff0000u));
        const unsigned lo23 = cvt_pk_bf16(h2 - __uint_as_float(hi23 << 16), h3 - __uint_as_float(hi23 & 0xffff0000u));
        *(uint2*)(AH + tok * AROW + k4 * 2) = make_uint2(hi01, hi23);
        *(uint2*)(AL + tok * AROW + k4 * 2) = make_uint2(lo01, lo23);
        *(uint2*)(p.H2b + (size_t)(row0 + tok) * D + kg) = make_uint2(hi01, hi23);
      }
      *(uint4*)(WH + wj * AROW + wch * 16) = wh0; *(uint4*)(WL + wj * AROW + wch * 16) = wl0;
      *(uint4*)(WH + (wj + 32) * AROW + wch * 16) = wh1; *(uint4*)(WL + (wj + 32) * AROW + wch * 16) = wl1;
      *(uint4*)(WH + (wj + 64) * AROW + wch * 16) = wh2; *(uint4*)(WL + (wj + 64) * AROW + wch * 16) = wl2;
      {
        const int kn = (kc + 1 < 8) ? (kc + 1) : kc;
#pragma unroll
        for (int i = 0; i < 4; ++i) { const int e = tid + i * NTHR; xv[i] = *(const float4*)(p.X1 + (size_t)(row0 + (e >> 5)) * D + kn * 128 + (e & 31) * 4); }
        RT_LOADW(kn);
      }
      __syncthreads();
#pragma unroll
      for (int kk = 0; kk < 4; ++kk) {
        const hbf16x8 Ahi = *(const hbf16x8*)(AH + (16 * mt + fr) * AROW + 2 * (32 * kk + 8 * fq));
        const hbf16x8 Alo = *(const hbf16x8*)(AL + (16 * mt + fr) * AROW + 2 * (32 * kk + 8 * fq));
#pragma unroll
        for (int nt = 0; nt < 3; ++nt) {
          const int wo = (16 * (nh * 3 + nt) + fr) * AROW + 2 * (32 * kk + 8 * fq);
          const hbf16x8 Bhi = *(const hbf16x8*)(WH + wo);
          const hbf16x8 Blo = *(const hbf16x8*)(WL + wo);
          acc[nt] = __builtin_amdgcn_mfma_f32_16x16x32_bf16(Ahi, Bhi, acc[nt], 0, 0, 0);
          acc[nt] = __builtin_amdgcn_mfma_f32_16x16x32_bf16(Ahi, Blo, acc[nt], 0, 0, 0);
          acc[nt] = __builtin_amdgcn_mfma_f32_16x16x32_bf16(Alo, Bhi, acc[nt], 0, 0, 0);
        }
      }
      __syncthreads();
    }
    if (tid < 64) LC[tid] = 0;
#pragma unroll
    for (int nt = 0; nt < 3; ++nt)
#pragma unroll
      for (int r = 0; r < 4; ++r) LOG[(16 * mt + 4 * fq + r) * 100 + 16 * (nh * 3 + nt) + fr] = acc[nt][r];
    __syncthreads();
    int ea = 0, eb = 0, sa = 0, sb2 = 0;
    if (tid < 64) {
      const float* lg = LOG + tid * 100;
      const int row = row0 + tid;
      int gs = 0; float gm = lg[64] + p.b_group[0];
      float gl[8];
      gl[0] = gm;
#pragma unroll
      for (int j = 1; j < 8; ++j) { gl[j] = lg[64 + j] + p.b_group[j]; if (gl[j] > gm) { gm = gl[j]; gs = j; } }
      float den = 0.f;
#pragma unroll
      for (int j = 0; j < 8; ++j) den += expf(gl[j] - gm);
      const float pg = 1.f / den;
      float el[8];
#pragma unroll
      for (int j = 0; j < 8; ++j) el[j] = 0.f;
      for (int j = 0; j < 8; ++j) el[j] = lg[gs * 8 + j] + p.b_expert[gs * 8 + j];
      int i0 = 0; float l0 = el[0];
#pragma unroll
      for (int j = 1; j < 8; ++j) if (el[j] > l0) { l0 = el[j]; i0 = j; }
      int i1 = -1; float l1 = -3.0e38f;
#pragma unroll
      for (int j = 0; j < 8; ++j) if (j != i0 && el[j] > l1) { l1 = el[j]; i1 = j; }
      const float e1 = expf(l1 - l0);
      const float w0 = 1.f / (1.f + e1), w1 = e1 / (1.f + e1);
      p.GATE[row * 2 + 0] = w0 * pg;
      p.GATE[row * 2 + 1] = w1 * pg;
      ea = gs * 8 + i0; eb = gs * 8 + i1;
      sa = atomicAdd(&LC[ea], 1);
      sb2 = atomicAdd(&LC[eb], 1);
    }
    __syncthreads();
    if (tid < 64) { const int n = LC[tid]; LB[tid] = n ? atomicAdd(&p.CNT[tid * 32], n) : 0; }
    __syncthreads();
    if (tid < 64) {
      const int row = row0 + tid;
      p.LIST[ea * T + LB[ea] + sa] = row * 2 + 0;
      p.LIST[eb * T + LB[eb] + sb2] = row * 2 + 1;
    }
    __syncthreads();
  }
}

__device__ __forceinline__ void moe_table(const Params& p, int* tab) {
  if (threadIdx.x == 0) {
    int a = 0, sg = 0;
    for (int e = 0; e < NE; ++e) {
      int cn = p.CNT[e * 32];
      tab[e] = a; tab[65 + e] = sg; tab[130 + e] = cn;
      a += (cn + 255) >> 8; sg += ((cn + 127) >> 7) << 7;
    }
    tab[NE] = a; tab[65 + NE] = sg;
  }
  __syncthreads();
}

template <bool UP>
__device__ void moe_gemm_phase(const Params& p, unsigned char* lds, const int* tab) {
  constexpr int K = UP ? 1024 : 512;
  constexpr int NKT = K / 32;
  constexpr int LDB = UP ? 512 : 1024;
  const int tid = threadIdx.x, wid = __builtin_amdgcn_readfirstlane(tid >> 6), lane = tid & 63, fr = lane & 15, fq = lane >> 4;
  const int wm = wid >> 1, wn = wid & 1;
  constexpr int AOFF0 = 0, AOFF1 = 16384, BOFF0 = 32768, BOFF1 = 32768 + 256 * 80;
  const int total = tab[64] * 4;
  for (int ui = blockIdx.x; ui < total; ui += gridDim.x) {
    int e = 0;
    while (tab[e + 1] * 4 <= ui) ++e;
    const int local = ui - tab[e] * 4;
    const int mu = local >> 2, nt = local & 3;
    const int cnt = tab[130 + e], seg = tab[65 + e];
    const int rem = cnt - mu * 256;
    const bool full = rem > 128;
    const bool active = full || wm < 2;
    const int srow = tid >> 2, spc = tid & 3;
    unsigned aoffs[2];
#pragma unroll
    for (int i = 0; i < 2; ++i) {
      const int row = srow + 128 * i;
      int idx = mu * 256 + row;
      unsigned rowb;
      if (UP) { if (idx > cnt - 1) idx = cnt - 1; rowb = (unsigned)(p.LIST[e * T + idx] >> 1) * (unsigned)(K * 2); }
      else rowb = (unsigned)(seg + idx) * (unsigned)(K * 2);
      aoffs[i] = rowb + (unsigned)((spc ^ ((row >> 2) & 3)) * 16);
    }
    const char* Abase = UP ? (const char*)p.H2b : (const char*)p.HBb;
    const float* bsrc;
    if (UP) bsrc = ((lane < 32) ? p.w1 : p.w3) + (size_t)e * 1024 * 512 + nt * 128 + 4 * (lane & 31) + (size_t)(4 * wid) * LDB;
    else bsrc = p.w2 + (size_t)e * 512 * 1024 + nt * 256 + 4 * lane + (size_t)(4 * wid) * LDB;
    hf32x4 acc[4][8];
#pragma unroll
    for (int m = 0; m < 4; ++m)
#pragma unroll
      for (int j = 0; j < 8; ++j) acc[m][j] = (hf32x4){0.f, 0.f, 0.f, 0.f};
    uint4 P0a0, P0a1, P1a0, P1a1;
    float4 P0b0, P0b1, P0b2, P0b3, P1b0, P1b1, P1b2, P1b3;
#define MG_LOAD(kt, S) do { \
      S##a0 = *(const uint4*)(Abase + aoffs[0] + (kt) * 64); S##a1 = *(const uint4*)(Abase + aoffs[1] + (kt) * 64); \
      S##b0 = *(const float4*)(bsrc + (size_t)((kt) * 32 + 0) * LDB); S##b1 = *(const float4*)(bsrc + (size_t)((kt) * 32 + 1) * LDB); \
      S##b2 = *(const float4*)(bsrc + (size_t)((kt) * 32 + 2) * LDB); S##b3 = *(const float4*)(bsrc + (size_t)((kt) * 32 + 3) * LDB); } while (0)
#define MG_WRITE(aoff, boff, S) do { \
      *(uint4*)(lds + (aoff) + (srow) * 64 + spc * 16) = S##a0; \
      if (full) *(uint4*)(lds + (aoff) + (srow + 128) * 64 + spc * 16) = S##a1; \
      *(uint2*)(lds + (boff) + (4 * lane + 0) * 80 + 8 * wid) = make_uint2(cvt_pk_bf16(S##b0.x, S##b1.x), cvt_pk_bf16(S##b2.x, S##b3.x)); \
      *(uint2*)(lds + (boff) + (4 * lane + 1) * 80 + 8 * wid) = make_uint2(cvt_pk_bf16(S##b0.y, S##b1.y), cvt_pk_bf16(S##b2.y, S##b3.y)); \
      *(uint2*)(lds + (boff) + (4 * lane + 2) * 80 + 8 * wid) = make_uint2(cvt_pk_bf16(S##b0.z, S##b1.z), cvt_pk_bf16(S##b2.z, S##b3.z)); \
      *(uint2*)(lds + (boff) + (4 * lane + 3) * 80 + 8 * wid) = make_uint2(cvt_pk_bf16(S##b0.w, S##b1.w), cvt_pk_bf16(S##b2.w, S##b3.w)); } while (0)
#define MG_MMA(aoff, boff) do { if (active) { \
      hbf16x8 Af[4]; \
      _Pragma("unroll") for (int m = 0; m < 4; ++m) { const int row = 64 * wm + 16 * m + fr; \
        Af[m] = *(const hbf16x8*)(lds + (aoff) + row * 64 + ((fq ^ ((row >> 2) & 3)) * 16)); } \
      _Pragma("unroll") for (int jh = 0; jh < 2; ++jh) { \
        hbf16x8 Bf[4]; \
        _Pragma("unroll") for (int j4 = 0; j4 < 4; ++j4) { const int j = jh * 4 + j4; \
          const int nrow = UP ? ((j < 4) ? (64 * wn + 16 * j + fr) : (128 + 64 * wn + 16 * (j - 4) + fr)) : (128 * wn + 16 * j + fr); \
          Bf[j4] = *(const hbf16x8*)(lds + (boff) + nrow * 80 + 16 * fq); } \
        _Pragma("unroll") for (int m = 0; m < 4; ++m) _Pragma("unroll") for (int j4 = 0; j4 < 4; ++j4) \
          acc[m][jh * 4 + j4] = __builtin_amdgcn_mfma_f32_16x16x32_bf16(Bf[j4], Af[m], acc[m][jh * 4 + j4], 0, 0, 0); } } } while (0)
    MG_LOAD(0, P0);
    MG_LOAD(1, P1);
    MG_WRITE(AOFF0, BOFF0, P0);
    __syncthreads();
#pragma unroll 1
    for (int kt = 0; kt < NKT; kt += 2) {
      { const int kn = (kt + 2 < NKT) ? (kt + 2) : kt; MG_LOAD(kn, P0); }
      MG_MMA(AOFF0, BOFF0);
      MG_WRITE(AOFF1, BOFF1, P1);
      __syncthreads();
      { const int kn = (kt + 3 < NKT) ? (kt + 3) : (kt + 1); MG_LOAD(kn, P1); }
      MG_MMA(AOFF1, BOFF1);
      MG_WRITE(AOFF0, BOFF0, P0);
      __syncthreads();
    }
#undef MG_LOAD
#undef MG_WRITE
#undef MG_MMA
    if (active) {
#pragma unroll
      for (int m = 0; m < 4; ++m) {
        const int slot = mu * 256 + 64 * wm + 16 * m + fr;
        if (slot < cnt) {
          if (UP) {
            bf16_t* hp = p.HBb + (size_t)(seg + slot) * DE + nt * 128 + 64 * wn + 4 * fq;
#pragma unroll
            for (int j = 0; j < 4; ++j) {
              float h[4];
#pragma unroll
              for (int r = 0; r < 4; ++r) { const float av = acc[m][j][r]; h[r] = av / (1.f + __expf(-av)) * acc[m][j + 4][r]; }
              *(uint2*)(hp + 16 * j) = make_uint2(cvt_pk_bf16(h[0], h[1]), cvt_pk_bf16(h[2], h[3]));
            }
          } else {
            const int pair = p.LIST[e * T + slot];
            const float gt = p.GATE[pair];
            bf16_t* yp = p.YB2b + (size_t)pair * D + nt * 256 + 128 * wn + 4 * fq;
#pragma unroll
            for (int j = 0; j < 8; ++j)
              *(uint2*)(yp + 16 * j) = make_uint2(cvt_pk_bf16(gt * acc[m][j][0], gt * acc[m][j][1]), cvt_pk_bf16(gt * acc[m][j][2], gt * acc[m][j][3]));
          }
        }
      }
    }
  }
}

__device__ void ph_final(const Params& p) {
  const int tid = threadIdx.x, wid = tid >> 6, lane = tid & 63;
  for (int row = blockIdx.x * 8 + wid; row < T; row += gridDim.x * 8) {
    const float* ga2 = p.MOD + (row / L) * 6144 + 5120;
    float4 v[4];
    float ss = 0.f;
#pragma unroll
    for (int i = 0; i < 4; ++i) {
      const int col = i * 256 + lane * 4;
      float4 xv = *(const float4*)(p.X1 + (size_t)row * D + col);
      uint2 a = *(const uint2*)(p.YB2b + (size_t)(row * 2) * D + col);
      uint2 b = *(const uint2*)(p.YB2b + (size_t)(row * 2 + 1) * D + col);
      float4 ga = *(const float4*)(ga2 + col);
      v[i].x = xv.x + ga.x * (__uint_as_float(a.x << 16) + __uint_as_float(b.x << 16));
      v[i].y = xv.y + ga.y * (__uint_as_float(a.x & 0xffff0000u) + __uint_as_float(b.x & 0xffff0000u));
      v[i].z = xv.z + ga.z * (__uint_as_float(a.y << 16) + __uint_as_float(b.y << 16));
      v[i].w = xv.w + ga.w * (__uint_as_float(a.y & 0xffff0000u) + __uint_as_float(b.y & 0xffff0000u));
      ss += v[i].x * v[i].x + v[i].y * v[i].y + v[i].z * v[i].z + v[i].w * v[i].w;
    }
    ss = wave_sum(ss);
    const float rstd = rsqrtf(ss * (1.f / D) + EPS);
#pragma unroll
    for (int i = 0; i < 4; ++i) {
      const int col = i * 256 + lane * 4;
      float4 gf = *(const float4*)(p.g_final + col);
      float4 o;
      o.x = v[i].x * rstd * gf.x; o.y = v[i].y * rstd * gf.y; o.z = v[i].z * rstd * gf.z; o.w = v[i].w * rstd * gf.w;
      *(float4*)(p.out + (size_t)row * D + col) = o;
    }
  }
}

constexpr int NPHASE = 11;

__global__ void __launch_bounds__(NTHR, 2) mega(Params p) {
  extern __shared__ __attribute__((aligned(16))) unsigned char lds_raw[];
  float* sm = (float*)lds_raw;
  PG8_LAS unsigned char* lds = (PG8_LAS unsigned char*)lds_raw;
  const int lo = p.lo, hi = p.hi;
  volatile LAS unsigned* xbst = (volatile LAS unsigned*)(lds + pg8::STAGE_BYTES + 2048);
  if (threadIdx.x < 4) xbst[threadIdx.x] = 0u;
  __syncthreads();
  XcdBarrier xbar; xbar.bar = p.BAR; xbar.x = 0; xbar.st = xbst;
  if (hi - lo > 1) xbar = xcd_barrier_post(p.BAR, xbst);
#define IN(k) (lo <= (k) && (k) < hi)
#define SYNC(k) do { if (IN(k) && IN((k) + 1)) xcd_barrier(xbar); } while (0)
#ifndef DUPK
#define DUPK -1
#endif
#ifndef SKIP_OTHER
  if (IN(0)) { ph_adaln(p, sm); ph_filters(p, sm); ph_wcvt(p, sm); }
#if DUPK == 0
  xcd_barrier(xbar);
  if (IN(0)) { ph_adaln(p, sm); ph_filters(p, sm); ph_wcvt(p, sm); }
#endif
  SYNC(0);
  if (IN(1)) ph_norm1(p);
#if DUPK == 1
  xcd_barrier(xbar);
  if (IN(1)) ph_norm1(p);
#endif
  SYNC(1);
#endif
#ifndef SKIP_GEMM
  if (IN(2)) {
    pg8::DenseOrder S{p.XNb, p.WinT, TT / 256, DP / 256 + 1, D, (int)gridDim.x, (int)blockIdx.x};
    pg8::EpiBf16 E{p.PXb, DP, p.DT, p.dt_bias};
    pg8::gemm_phase<pg8::EpiBf16, pg8::DenseOrder>(lds, D, S, E);
  }
#if DUPK == 2
  xcd_barrier(xbar);
  if (IN(2)) {
    pg8::DenseOrder S{p.XNb, p.WinT, TT / 256, DP / 256 + 1, D, (int)gridDim.x, (int)blockIdx.x};
    pg8::EpiBf16 E{p.PXb, DP, p.DT, p.dt_bias};
    pg8::gemm_phase<pg8::EpiBf16, pg8::DenseOrder>(lds, D, S, E);
  }
#endif
  SYNC(2);
#endif
#ifndef SKIP_OTHER
  if (IN(3)) {
    ph_hy_convT(p, sm);
    for (int it = blockIdx.x; it < 288; it += gridDim.x) ssd_states_unit(p, it, lds_raw);
  }
#if DUPK == 3
  xcd_barrier(xbar);
  if (IN(3)) {
    ph_hy_convT(p, sm);
    for (int it = blockIdx.x; it < 288; it += gridDim.x) ssd_states_unit(p, it, lds_raw);
  }
#endif
  SYNC(3);
  if (IN(4)) {
    for (int it = blockIdx.x; it < 256; it += gridDim.x) ssd_scan_unit(p, it);
    for (int it = blockIdx.x; it < 512; it += gridDim.x) hyena_unit(p, it, lds_raw);
  }
#if DUPK == 4
  xcd_barrier(xbar);
  if (IN(4)) {
    for (int it = blockIdx.x; it < 256; it += gridDim.x) ssd_scan_unit(p, it);
    for (int it = blockIdx.x; it < 512; it += gridDim.x) hyena_unit(p, it, lds_raw);
  }
#endif
  SYNC(4);
  if (IN(5)) {
    for (int it = blockIdx.x; it < 256; it += gridDim.x) { ssd_out_unit(p, it, lds_raw); __syncthreads(); }
    ph_hy_backT(p, sm);
  }
#if DUPK == 5
  xcd_barrier(xbar);
  if (IN(5)) {
    for (int it = blockIdx.x; it < 256; it += gridDim.x) { ssd_out_unit(p, it, lds_raw); __syncthreads(); }
    ph_hy_backT(p, sm);
  }
#endif
  SYNC(5);
#endif
#ifndef SKIP_GEMM
  if (IN(6)) {
    pg8::DenseOrder S{p.YMIXb, p.WoutT, T / 256, D / 256, D, (int)gridDim.x, (int)blockIdx.x};
    pg8::EpiX1 E{p.x, p.MOD, p.X1, p.SSQP};
    pg8::gemm_phase<pg8::EpiX1, pg8::DenseOrder>(lds, D, S, E);
  }
#if DUPK == 6
  xcd_barrier(xbar);
  if (IN(6)) {
    pg8::DenseOrder S{p.YMIXb, p.WoutT, T / 256, D / 256, D, (int)gridDim.x, (int)blockIdx.x};
    pg8::EpiX1 E{p.x, p.MOD, p.X1, p.SSQP};
    pg8::gemm_phase<pg8::EpiX1, pg8::DenseOrder>(lds, D, S, E);
  }
#endif
  SYNC(6);
#endif
#ifndef SKIP_OTHER
  if (IN(7)) ph_router(p, lds_raw);
#if DUPK == 7
  xcd_barrier(xbar);
  if (IN(7)) ph_router(p, lds_raw);
#endif
  SYNC(7);
#endif
#ifndef SKIP_GEMM
  if (IN(8)) {
    int* tab = (int*)(lds_raw + pg8::STAGE_BYTES);
    moe_table(p, tab);
    moe_gemm_phase<true>(p, lds_raw, tab);
  }
#if DUPK == 8
  xcd_barrier(xbar);
  if (IN(8)) {
    int* tab = (int*)(lds_raw + pg8::STAGE_BYTES);
    moe_table(p, tab);
    moe_gemm_phase<true>(p, lds_raw, tab);
  }
#endif
  SYNC(8);
  if (IN(9)) {
    int* tab = (int*)(lds_raw + pg8::STAGE_BYTES);
    moe_table(p, tab);
    moe_gemm_phase<false>(p, lds_raw, tab);
  }
#if DUPK == 9
  xcd_barrier(xbar);
  if (IN(9)) {
    int* tab = (int*)(lds_raw + pg8::STAGE_BYTES);
    moe_table(p, tab);
    moe_gemm_phase<false>(p, lds_raw, tab);
  }
#endif
  SYNC(9);
#endif
#ifndef SKIP_OTHER
  if (IN(10)) ph_final(p);
#if DUPK == 10
  xcd_barrier(xbar);
  if (IN(10)) ph_final(p);
#endif
#endif
#undef IN
#undef SYNC
}

extern "C" void kernel_launch(void* const* d_in, const int* in_sizes, int n_in, void* d_out, int out_size,
                              void* d_ws, size_t ws_size, hipStream_t stream) {
  Params p{};
  const float* const* in = (const float* const*)d_in;
  p.x = in[0]; p.c = in[1]; p.ctx = in[2]; p.c_ctx = in[3]; p.w_ada = in[4]; p.b_ada = in[5];
  p.g1 = in[6]; p.g2 = in[7]; p.w_in = in[8]; p.hy_conv_w = in[9]; p.hy_conv_b = in[10];
  p.f_w1 = in[11]; p.f_b1 = in[12]; p.f_freq = in[13]; p.f_w2 = in[14]; p.f_b2 = in[15]; p.f_w3 = in[16];
  p.hy_bias = in[17]; p.ssd_conv_w = in[18]; p.ssd_conv_b = in[19]; p.a_log = in[20]; p.dt_bias = in[21];
  p.ssd_d = in[22]; p.ssd_norm_g = in[23]; p.w_out = in[24]; p.w_group = in[25]; p.b_group = in[26];
  p.w_expert = in[27]; p.b_expert = in[28]; p.w1 = in[29]; p.w3 = in[30]; p.w2 = in[31]; p.g_final = in[32];
  p.out = (float*)d_out;

  char* ws = (char*)d_ws;
  size_t off = 0;
  auto take = [&](size_t bytes) { char* r = ws + off; off += (bytes + 255) & ~(size_t)255; return r; };
  p.BAR = (unsigned*)take((size_t)XCD_BAR_WORDS * 4);
  p.MOD = (float*)take((size_t)9 * 6144 * 4);
  p.CNT = (int*)take(NE * 32 * 4);
  p.GATE = (float*)take((size_t)T * 2 * 4);
  p.LIST = (int*)take((size_t)NE * T * 4);
  p.DT = (float*)take((size_t)TT * 16 * 4);
  p.ACUM = (float*)take((size_t)T * 16 * 4);
  p.SSQP = (float*)take((size_t)T * 16 * 4);
  p.CDEC = (float*)take((size_t)128 * 18 * 32 * 4);
  p.FILTt = (bf16_t*)take((size_t)1024 * FLEN * 2);
  p.WRhi = (bf16_t*)take((size_t)96 * 1024 * 2);
  p.WRlo = (bf16_t*)take((size_t)96 * 1024 * 2);
  p.WinT = (bf16_t*)take((size_t)(DP + 256) * D * 2);
  p.WoutT = (bf16_t*)take((size_t)D * D * 2);
  char* rPX = take((size_t)TT * DP * 2);
  char* rXBC = take((size_t)128 * 18 * 8192 * 2);
  char* rYF = take((size_t)T * DS * 4);
  char* rZ1 = take((size_t)HYC * T * 2);
  char* rYB = take((size_t)T * DS * 4);
  char* rYM = take((size_t)T * D * 2);
  p.PXb = (bf16_t*)rPX; p.SST = (bf16_t*)rXBC; p.Ut = (bf16_t*)rZ1; p.YMIXb = (bf16_t*)rYM;
  p.HIN = (bf16_t*)rYF;
  p.Yt = (bf16_t*)rYB;
  p.XNb = (bf16_t*)rZ1;
  p.X1 = (float*)rPX;
  p.H2b = (bf16_t*)rYM;
  p.HBb = (bf16_t*)(rPX + (size_t)T * D * 4);
  p.YB2b = (bf16_t*)rZ1;
  if (off > ws_size) { fprintf(stderr, "workspace too small: need %zu have %zu\n", off, ws_size); return; }

  static int grid_blocks = 0;
  if (!grid_blocks) {
    int dev = 0, cus = 0, per_cu = 0;
    (void)hipGetDevice(&dev);
    (void)hipDeviceGetAttribute(&cus, hipDeviceAttributeMultiprocessorCount, dev);
    (void)hipFuncSetAttribute((const void*)mega, hipFuncAttributeMaxDynamicSharedMemorySize, LDS_BYTES);
    (void)hipOccupancyMaxActiveBlocksPerMultiprocessor(&per_cu, mega, NTHR, LDS_BYTES);
    if (per_cu < 1) { fprintf(stderr, "occupancy query returned %d\n", per_cu); per_cu = 1; }
    grid_blocks = cus;
  }
#ifndef ONE_LAUNCH
  for (int ph = 0; ph < NPHASE; ++ph) {
    p.lo = ph; p.hi = ph + 1;
    hipLaunchKernelGGL(mega, dim3(grid_blocks), dim3(NTHR), LDS_BYTES, stream, p);
  }
#else
  p.lo = 0; p.hi = NPHASE;
  (void)hipMemsetAsync(p.BAR, 0, (size_t)XCD_BAR_WORDS * 4, stream);
  void* args[] = {&p};
  hipError_t e = hipLaunchCooperativeKernel((void*)mega, dim3(grid_blocks), dim3(NTHR), args, LDS_BYTES, stream);
  if (e != hipSuccess) fprintf(stderr, "cooperative launch failed: %s (grid %d)\n", hipGetErrorString(e), grid_blocks);
#endif
}
```

```cpp
#define ONE_LAUNCH 1
#include <hip/hip_runtime.h>
#include <hip/hip_cooperative_groups.h>
#include <cstdio>
#include <cstdint>
namespace cg = cooperative_groups;

constexpr int D = 1024, NB = 8, L = 2048, LC = 256;
constexpr int T = NB * L;
constexpr int TC = NB * LC;
constexpr int TT = T + TC;
constexpr int DH = 512, HYC = 1536, DS = 512, DXBC = 1024, DIN = 3088, DP = 3072;
constexpr int COL_Z = 1536, COL_XBC = 2048, COL_DT = 3072;
constexpr int NE = 64, DE = 512;
constexpr float EPS = 1e-6f;
constexpr int NTHR = 512;
constexpr int LDS_BYTES = 132 * 1024;
constexpr int FLEN = 4232, HX0 = 2112, FCLEN = 4240, ZSTRB = 4240;

typedef unsigned short bf16_t;

struct Params {
  const float *x, *c, *ctx, *c_ctx, *w_ada, *b_ada, *g1, *g2, *w_in, *hy_conv_w, *hy_conv_b;
  const float *f_w1, *f_b1, *f_freq, *f_w2, *f_b2, *f_w3, *hy_bias;
  const float *ssd_conv_w, *ssd_conv_b, *a_log, *dt_bias, *ssd_d, *ssd_norm_g, *w_out;
  const float *w_group, *b_group, *w_expert, *b_expert, *w1, *w3, *w2, *g_final;
  float* out;
  float *MOD, *DT, *X1, *GATE, *ACUM, *CDEC, *SSQP;
  bf16_t *WRhi, *WRlo, *FILTt, *Ut, *Yt, *HIN, *XNb, *WinT, *WoutT, *PXb, *SST, *YMIXb, *YB2b, *H2b, *HBb;
  int *CNT, *LIST;
  unsigned* BAR;
  int lo, hi;
};

__device__ __forceinline__ float silu_f(float v) { return v / (1.f + __expf(-v)); }
__device__ __forceinline__ float softplus_f(float v) { return v > 20.f ? v : log1pf(expf(v)); }
__device__ __forceinline__ float bf2f(bf16_t v) { return __uint_as_float(((unsigned)v) << 16); }
__device__ __forceinline__ unsigned cvt_pk_bf16(float lo, float hi) {
  typedef __bf16 bf2_t __attribute__((ext_vector_type(2)));
  typedef float f2_t __attribute__((ext_vector_type(2)));
  const f2_t v = {lo, hi};
  const bf2_t r = __builtin_convertvector(v, bf2_t);
  return __builtin_bit_cast(unsigned, r);
}
__device__ __forceinline__ bf16_t f2bf(float f) { return (bf16_t)(cvt_pk_bf16(f, 0.f) & 0xffffu); }
__device__ __forceinline__ void st_agent64(void* p, unsigned lo, unsigned hi) {
  __hip_atomic_store((unsigned long long*)p, ((unsigned long long)hi << 32) | lo, __ATOMIC_RELAXED, __HIP_MEMORY_SCOPE_AGENT);
}
__device__ __forceinline__ uint2 ld_agent64(const void* p) {
  const unsigned long long v = __hip_atomic_load((const unsigned long long*)p, __ATOMIC_RELAXED, __HIP_MEMORY_SCOPE_AGENT);
  return make_uint2((unsigned)v, (unsigned)(v >> 32));
}
__device__ __forceinline__ void st_agent32(float* p, float v) { __hip_atomic_store(p, v, __ATOMIC_RELAXED, __HIP_MEMORY_SCOPE_AGENT); }
__device__ __forceinline__ float ld_agent32(const float* p) { return __hip_atomic_load(p, __ATOMIC_RELAXED, __HIP_MEMORY_SCOPE_AGENT); }
__device__ __forceinline__ float wave_sum(float v) {
#pragma unroll
  for (int o = 32; o > 0; o >>= 1) v += __shfl_xor(v, o);
  return v;
}


#define XB_TMO      128
#define XB_XCNT(j)  (256  + 64 * (j))
#define XB_XSUB(j)  (1280 + 64 * (j))
#define XB_XGEN(j)  (2304 + 64 * (j))
#define XB_TOP      3328
#define XB_TOPGEN   3392
#define XCD_BAR_WORDS 3456
#define XB_SPIN_CAP (1u << 18)
#define LAS __attribute__((address_space(3)))
__device__ __forceinline__ unsigned xb_ld(unsigned* p) { return __hip_atomic_load(p, __ATOMIC_RELAXED, __HIP_MEMORY_SCOPE_AGENT); }
__device__ __forceinline__ unsigned xb_add(unsigned* p, unsigned v) { return __hip_atomic_fetch_add(p, v, __ATOMIC_RELAXED, __HIP_MEMORY_SCOPE_AGENT); }
__device__ __forceinline__ unsigned xb_xcc_id() { return (unsigned)__builtin_amdgcn_s_getreg((3 << 11) | 20) & 0xFu; }
#define XB_SPIN(cond, bar) do { unsigned _sp = 0; while (cond) { __builtin_amdgcn_s_sleep(1); \
    if ((++_sp & 255u) == 0u) { if (xb_ld(&(bar)[XB_TMO])) break; if (_sp > XB_SPIN_CAP) { atomicAdd(&(bar)[XB_TMO], 1u); break; } } } } while (0)
struct XcdBarrier { unsigned* bar; unsigned x; volatile LAS unsigned* st; };
__device__ __forceinline__ XcdBarrier xcd_barrier_post(unsigned* bar, volatile LAS unsigned* st) {
  XcdBarrier b; b.bar = bar; b.x = xb_xcc_id(); b.st = st;
  if (threadIdx.x == 0) (void)xb_add(&bar[XB_XCNT(b.x)], 1u);
  return b;
}
__device__ __forceinline__ void xcd_barrier_complete(unsigned* bar, unsigned x, unsigned& nloc, unsigned& nx) {
  const unsigned G = gridDim.x * gridDim.y * gridDim.z;
  unsigned sum, cnt, mine, sp = 0u;
  for (;;) {
    sum = 0u; cnt = 0u; mine = 0u;
#pragma unroll
    for (unsigned j = 0; j < 16; ++j) { const unsigned c = xb_ld(&bar[XB_XCNT(j)]); sum += c; cnt += (c > 0u) ? 1u : 0u; mine = (j == x) ? c : mine; }
    if (sum == G) break;
    __builtin_amdgcn_s_sleep(1);
    if ((++sp & 255u) == 0u) { if (xb_ld(&bar[XB_TMO])) break; if (sp > XB_SPIN_CAP) { atomicAdd(&bar[XB_TMO], 1u); break; } }
  }
  nloc = mine > 0u ? mine : 1u; nx = cnt > 0u ? cnt : 1u;
}
__device__ __forceinline__ void xcd_barrier(const XcdBarrier& b) {
  asm volatile("s_waitcnt vmcnt(0)" ::: "memory");
  __syncthreads();
  if (threadIdx.x == 0) {
    unsigned* bar = b.bar;
    __builtin_amdgcn_s_waitcnt(0);
    unsigned nloc = b.st[0], nx = b.st[1];
    if (nloc == 0u) { xcd_barrier_complete(bar, b.x, nloc, nx); b.st[0] = nloc; b.st[1] = nx; }
    const unsigned old = xb_add(&bar[XB_XSUB(b.x)], 1u);
    const unsigned gen = old / nloc;
    if (old + 1u == (gen + 1u) * nloc) {
      __builtin_amdgcn_fence(__ATOMIC_RELEASE, "agent");
      asm volatile("s_waitcnt vmcnt(0)" ::: "memory");
      const unsigned og = xb_add(&bar[XB_TOP], 1u);
      const unsigned tg = og / nx;
      if (og + 1u == (tg + 1u) * nx) xb_add(&bar[XB_TOPGEN], 1u);
      else XB_SPIN(xb_ld(&bar[XB_TOPGEN]) == tg, bar);
      __builtin_amdgcn_fence(__ATOMIC_ACQUIRE, "agent");
      xb_add(&bar[XB_XGEN(b.x)], 1u);
      asm volatile("s_waitcnt vmcnt(0)" ::: "memory");
    } else {
      XB_SPIN(xb_ld(&bar[XB_XGEN(b.x)]) == gen, bar);
      __builtin_amdgcn_fence(__ATOMIC_ACQUIRE, "agent");
      asm volatile("s_waitcnt vmcnt(0)" ::: "memory");
    }
  }
  __syncthreads();
}

namespace pg8 {
#define PG8_LAS __attribute__((address_space(3)))
typedef short bf16x8 __attribute__((ext_vector_type(8)));
typedef float f32x4 __attribute__((ext_vector_type(4)));
typedef unsigned u32x4 __attribute__((ext_vector_type(4)));
typedef unsigned u32x2 __attribute__((ext_vector_type(2)));
constexpr int BM = 256, BK = 64, HALF = 128, HTB = HALF * BK * 2, STAGE_BYTES = 8 * HTB, NXCD = 8, WGM = 8;

__host__ __device__ __forceinline__ int lds_byte(int r, int c) {
  const int st = (r >> 4) * 2 + (c >> 5), rr = r & 15, cc = c & 31, ob = rr * 64 + cc * 2;
  return st * 1024 + (ob ^ (((ob >> 9) & 1) << 5));
}
__host__ __device__ __forceinline__ void stage_rc(int b, int& R, int& C) {
  const int st = b / 1024, sb = b % 1024, swz = sb ^ (((sb >> 9) & 1) << 5);
  R = (st >> 1) * 16 + swz / 64; C = (st & 1) * 32 + (swz % 64) / 2;
}
__host__ __device__ __forceinline__ int perm32(int rho) { const int n = rho >> 4, i = rho & 15; return 8 * (i >> 2) + 4 * n + (i & 3); }

struct Unit { int pm, pn, e, mu, nv, cnt, seg; };

__device__ __forceinline__ bool static_next(int nM, int nN, int G, int c, int i, int& pm, int& pn) {
  const int nwg = nM * nN;
  const long Lx = (long)i * G + c; if (Lx >= nwg) return false;
  int wgid = (int)Lx;
  { const int q = nwg / NXCD, r = nwg % NXCD, xcd = wgid % NXCD, off = wgid / NXCD; wgid = (xcd < r ? xcd * (q + 1) : r * (q + 1) + (xcd - r) * q) + off; }
  const int nig = WGM * nN, gid = wgid / nig, fm = gid * WGM, gsz = (nM - fm) < WGM ? (nM - fm) : WGM;
  pm = fm + ((wgid % nig) % gsz); pn = (wgid % nig) / gsz; return true;
}

struct DenseOrder {
  const bf16_t* A; const bf16_t* Bt; int nM, nN, K, G, c;
  __device__ __forceinline__ bool next(int i, Unit& u) const {
    if (!static_next(nM, nN, G, c, i, u.pm, u.pn)) return false;
    u.e = 0; u.mu = 0; u.nv = 256; u.cnt = 256; u.seg = 0; return true;
  }
  __device__ __forceinline__ const char* a_base() const { return (const char*)A; }
  __device__ __forceinline__ const char* b_ptr(const Unit& u) const { return (const char*)Bt + (size_t)u.pn * 256 * K * 2; }
  __device__ __forceinline__ void a_offs(const Unit& u, const int (&R)[2], const int (&C)[2], unsigned (&ao)[2][2]) const {
#pragma unroll
    for (int h = 0; h < 2; ++h)
#pragma unroll
      for (int i = 0; i < 2; ++i) ao[h][i] = (unsigned)((u.pm * 256 + h * 128 + R[i]) * K + C[i]) * 2u;
  }
};

struct MoeOrder {
  const int* tab; const bf16_t* A; const bf16_t* Bt; const int* list; int NTn, K, G, c; bool gather;
  __device__ __forceinline__ bool next(int i, Unit& u) const {
    const int Lx = i * G + c;
    if (Lx >= tab[64] * NTn) return false;
    const int mg = Lx / NTn; u.pn = Lx - mg * NTn;
    int e = 0;
    while (tab[e + 1] <= mg) ++e;
    u.e = e; u.mu = mg - tab[e]; u.cnt = tab[130 + e]; u.seg = tab[65 + e];
    const int rem = u.cnt - u.mu * 256; u.nv = rem < 256 ? rem : 256; u.pm = 0; return true;
  }
  __device__ __forceinline__ const char* a_base() const { return (const char*)A; }
  __device__ __forceinline__ const char* b_ptr(const Unit& u) const { return (const char*)Bt + ((size_t)u.e * NTn + u.pn) * 256 * K * 2; }
  __device__ __forceinline__ void a_offs(const Unit& u, const int (&R)[2], const int (&C)[2], unsigned (&ao)[2][2]) const {
#pragma unroll
    for (int h = 0; h < 2; ++h)
#pragma unroll
      for (int i = 0; i < 2; ++i) {
        int idx = u.mu * 256 + h * 128 + R[i];
        int row;
        if (gather) { if (idx > u.cnt - 1) idx = u.cnt - 1; row = list[u.e * T + idx] >> 1; }
        else row = u.seg + idx;
        ao[h][i] = (unsigned)(row * K + C[i]) * 2u;
      }
  }
};

struct EpiBf16 {
  static constexpr bool PERM = true;
  bf16_t* O; int ldc; float* DT; const float* dt_bias;
  __device__ __forceinline__ void operator()(const f32x4 (&acc)[2][2][4][2], const Unit& u, int wr, int wc, int fr, int fq) const {
    const int row0 = u.pm * BM + wr * 64 + fr;
    if (u.pn == 12) {
      if (wc == 0 && fq < 2) {
        const f32x4 b0 = *(const f32x4*)(dt_bias + 8 * fq), b1 = *(const f32x4*)(dt_bias + 8 * fq + 4);
#pragma unroll
        for (int ai = 0; ai < 2; ++ai)
#pragma unroll
          for (int m = 0; m < 4; ++m) {
            float* dp = DT + (size_t)(row0 + ai * HALF + m * 16) * 16 + 8 * fq;
            *(f32x4*)dp = acc[ai][0][m][0] + b0; *(f32x4*)(dp + 4) = acc[ai][0][m][1] + b1;
          }
      }
      return;
    }
    const int col0 = u.pn * BM + wc * 32 + 8 * fq;
#pragma unroll
    for (int ai = 0; ai < 2; ++ai)
#pragma unroll
      for (int m = 0; m < 4; ++m) {
        bf16_t* rowp = O + (size_t)(row0 + ai * HALF + m * 16) * ldc + col0;
#pragma unroll
        for (int bj = 0; bj < 2; ++bj) {
          f32x4 v0 = acc[ai][bj][m][0], v1 = acc[ai][bj][m][1];
          u32x4 w; w.x = cvt_pk_bf16(v0[0], v0[1]); w.y = cvt_pk_bf16(v0[2], v0[3]); w.z = cvt_pk_bf16(v1[0], v1[1]); w.w = cvt_pk_bf16(v1[2], v1[3]);
          *(u32x4*)(rowp + bj * HALF) = w;
        }
      }
  }
};

struct EpiX1 {
  static constexpr bool PERM = false;
  const float* x; const float* mod; float* X1; float* SSQP;
  __device__ __forceinline__ void operator()(const f32x4 (&acc)[2][2][4][2], const Unit& u, int wr, int wc, int fr, int fq) const {
    const int row0 = u.pm * BM + wr * 64 + fr, col0 = u.pn * BM + wc * 32 + 4 * fq;
    const float* ga = mod + ((u.pm * BM) / L) * 6144 + 2048 + col0;
    f32x4 gv[2][2];
#pragma unroll
    for (int bj = 0; bj < 2; ++bj)
#pragma unroll
      for (int n = 0; n < 2; ++n) gv[bj][n] = *(const f32x4*)(ga + bj * HALF + n * 16);
#pragma unroll
    for (int ai = 0; ai < 2; ++ai)
#pragma unroll
      for (int mp = 0; mp < 2; ++mp) {
        f32x4 xv[2][2][2];
#pragma unroll
        for (int mm = 0; mm < 2; ++mm) {
          const size_t off = (size_t)(row0 + ai * HALF + (2 * mp + mm) * 16) * D + col0;
#pragma unroll
          for (int bj = 0; bj < 2; ++bj)
#pragma unroll
            for (int n = 0; n < 2; ++n) xv[mm][bj][n] = *(const f32x4*)(x + off + bj * HALF + n * 16);
        }
#pragma unroll
        for (int mm = 0; mm < 2; ++mm) {
          const int m = 2 * mp + mm;
          const size_t off = (size_t)(row0 + ai * HALF + m * 16) * D + col0;
          float ssq = 0.f;
#pragma unroll
          for (int bj = 0; bj < 2; ++bj)
#pragma unroll
            for (int n = 0; n < 2; ++n) {
              const f32x4 o = xv[mm][bj][n] + gv[bj][n] * acc[ai][bj][m][n];
              *(f32x4*)(X1 + off + bj * HALF + n * 16) = o;
              ssq += (o[0] * o[0] + o[1] * o[1]) + (o[2] * o[2] + o[3] * o[3]);
            }
          ssq += __shfl_xor(ssq, 16); ssq += __shfl_xor(ssq, 32);
          if (fq == 0) SSQP[(size_t)(row0 + ai * HALF + m * 16) * 16 + u.pn * 4 + wc] = ssq;
        }
      }
  }
};

struct EpiSwiGLU {
  static constexpr bool PERM = true;
  bf16_t* HBb;
  __device__ __forceinline__ void operator()(const f32x4 (&acc)[2][2][4][2], const Unit& u, int wr, int wc, int fr, int fq) const {
    const int col0 = u.pn * 128 + wc * 32 + 8 * fq;
#pragma unroll
    for (int ai = 0; ai < 2; ++ai)
#pragma unroll
      for (int m = 0; m < 4; ++m) {
        const int slot = u.mu * 256 + ai * HALF + wr * 64 + m * 16 + fr;
        if (slot < u.cnt) {
          float h[8];
#pragma unroll
          for (int n = 0; n < 2; ++n)
#pragma unroll
            for (int j = 0; j < 4; ++j) { const float a = acc[ai][0][m][n][j]; h[n * 4 + j] = a / (1.f + __expf(-a)) * acc[ai][1][m][n][j]; }
          u32x4 w; w.x = cvt_pk_bf16(h[0], h[1]); w.y = cvt_pk_bf16(h[2], h[3]); w.z = cvt_pk_bf16(h[4], h[5]); w.w = cvt_pk_bf16(h[6], h[7]);
          *(u32x4*)(HBb + (size_t)(u.seg + slot) * DE + col0) = w;
        }
      }
  }
};

struct EpiDown {
  static constexpr bool PERM = true;
  bf16_t* YB2b; const int* list; const float* gate;
  __device__ __forceinline__ void operator()(const f32x4 (&acc)[2][2][4][2], const Unit& u, int wr, int wc, int fr, int fq) const {
    const int col0 = u.pn * 256 + wc * 32 + 8 * fq;
#pragma unroll
    for (int ai = 0; ai < 2; ++ai)
#pragma unroll
      for (int m = 0; m < 4; ++m) {
        const int slot = u.mu * 256 + ai * HALF + wr * 64 + m * 16 + fr;
        if (slot < u.cnt) {
          const int pair = list[u.e * T + slot];
          const float gt = gate[pair];
          bf16_t* rowp = YB2b + (size_t)pair * D + col0;
#pragma unroll
          for (int bj = 0; bj < 2; ++bj) {
            f32x4 v0 = acc[ai][bj][m][0] * gt, v1 = acc[ai][bj][m][1] * gt;
            u32x4 w; w.x = cvt_pk_bf16(v0[0], v0[1]); w.y = cvt_pk_bf16(v0[2], v0[3]); w.z = cvt_pk_bf16(v1[0], v1[1]); w.w = cvt_pk_bf16(v1[2], v1[3]);
            *(u32x4*)(rowp + bj * HALF) = w;
          }
        }
      }
  }
};

template <class Epi, class Sched>
__device__ __forceinline__ void gemm_phase(PG8_LAS unsigned char* lds, const int K, const Sched& S, const Epi& E) {
  const int tid = threadIdx.x, wid = __builtin_amdgcn_readfirstlane(tid >> 6), lane = tid & 63, wr = wid >> 2, wc = wid & 3, fr = lane & 15, fq = lane >> 4;
  const int nt = K / BK;
  int Rr[2], Cc[2];
  unsigned voffB[2];
#pragma unroll
  for (int i = 0; i < 2; ++i) {
    stage_rc(tid * 16 + i * 8192, Rr[i], Cc[i]);
    const int Rb = Epi::PERM ? ((Rr[i] & ~31) + perm32(Rr[i] & 31)) : Rr[i];
    voffB[i] = (unsigned)(Rb * K + Cc[i]) * 2u;
  }
  const size_t kstep = (size_t)(BK * 2);
  const size_t hstep = (size_t)HALF * K * 2;
  const unsigned ldsw = (unsigned)wid * 1024u;
  const int aoff = lds_byte(wr * 64 + fr, fq * 8), boff = lds_byte(wc * 32 + fr, fq * 8);
#define PG8_SA(b, h) (((b) * 2 + (h)) * HTB)
#define PG8_SB(b, h) ((4 + (b) * 2 + (h)) * HTB)
#define PG8_STAGE(bufoff, gbase, voff) do { _Pragma("unroll") for (int _i = 0; _i < 2; ++_i) \
    __builtin_amdgcn_global_load_lds((const unsigned*)((const char*)(gbase) + (voff)[_i]), (PG8_LAS unsigned*)(lds + (bufoff) + ldsw + _i * 8192), 16, 0, 0); } while (0)
#define PG8_LDA(dst, b, h) do { _Pragma("unroll") for (int m = 0; m < 4; ++m) _Pragma("unroll") for (int k = 0; k < 2; ++k) dst[m][k] = *(const PG8_LAS bf16x8*)(lds + PG8_SA(b, h) + aoff + m * 2048 + k * 1024); } while (0)
#define PG8_LDB(dst, b, h) do { _Pragma("unroll") for (int n = 0; n < 2; ++n) _Pragma("unroll") for (int k = 0; k < 2; ++k) dst[n][k] = *(const PG8_LAS bf16x8*)(lds + PG8_SB(b, h) + boff + n * 2048 + k * 1024); } while (0)
#define PG8_MMA(ai, bj, At, Bt) do { __builtin_amdgcn_s_setprio(1); _Pragma("unroll") for (int m = 0; m < 4; ++m) _Pragma("unroll") for (int n = 0; n < 2; ++n) _Pragma("unroll") for (int k = 0; k < 2; ++k) \
    acc[ai][bj][m][n] = __builtin_amdgcn_mfma_f32_16x16x32_bf16(Bt[n][k], At[m][k], acc[ai][bj][m][n], 0, 0, 0); __builtin_amdgcn_s_setprio(0); } while (0)
#define PG8_WAIT_V(n) asm volatile("s_waitcnt vmcnt(" #n ")" ::: "memory")
#define PG8_WAIT_L(n) asm volatile("s_waitcnt lgkmcnt(" #n ")" ::: "memory")
#define PG8_BAR __builtin_amdgcn_s_barrier()
#define PG8_SCHED __builtin_amdgcn_sched_barrier(0)
  Unit cur, nxt; int ui = 0;
  if (!S.next(0, cur)) return;
  f32x4 acc[2][2][4][2];
#pragma unroll
  for (int a = 0; a < 2; ++a)
#pragma unroll
    for (int b = 0; b < 2; ++b)
#pragma unroll
      for (int m = 0; m < 4; ++m)
#pragma unroll
        for (int n = 0; n < 2; ++n) acc[a][b][m][n] = (f32x4){0.f, 0.f, 0.f, 0.f};
  bf16x8 At[4][2], B0[2][2], B1[2][2];
  unsigned cao[2][2], nao[2][2];
  S.a_offs(cur, Rr, Cc, cao);
  const char* const aB = S.a_base();
  const char* cB = S.b_ptr(cur);
  PG8_STAGE(PG8_SB(0, 0), cB, voffB); PG8_STAGE(PG8_SA(0, 0), aB, cao[0]); PG8_STAGE(PG8_SB(0, 1), cB + hstep, voffB); PG8_STAGE(PG8_SA(0, 1), aB, cao[1]);
  if (wr == 1) PG8_BAR;
  PG8_WAIT_V(4); PG8_BAR;
  PG8_STAGE(PG8_SB(1, 0), cB + kstep, voffB); PG8_STAGE(PG8_SA(1, 0), aB + kstep, cao[0]); PG8_STAGE(PG8_SB(1, 1), cB + hstep + kstep, voffB);
  PG8_WAIT_V(6); PG8_BAR;
  for (;;) {
    const bool has_next = S.next(ui + 1, nxt);
    const char* nB = cB;
    if (has_next) { S.a_offs(nxt, Rr, Cc, nao); nB = S.b_ptr(nxt); }
    else {
#pragma unroll
      for (int h = 0; h < 2; ++h)
#pragma unroll
        for (int i = 0; i < 2; ++i) nao[h][i] = cao[h][i];
    }
    const bool full = cur.nv > 128;
    for (int t = 0; t < nt; t += 2) {
      const bool last = (t == nt - 2);
      const char* a1 = aB + (size_t)(t + 1) * kstep;
      const char* a2 = last ? aB : aB + (size_t)(t + 2) * kstep; const char* b2 = last ? nB : cB + (size_t)(t + 2) * kstep;
      const char* a3 = a2 + kstep; const char* b3 = b2 + kstep;
      unsigned so[2][2];
#pragma unroll
      for (int h = 0; h < 2; ++h)
#pragma unroll
        for (int i = 0; i < 2; ++i) so[h][i] = last ? nao[h][i] : cao[h][i];
      PG8_LDB(B0, 0, 0); PG8_SCHED; PG8_LDA(At, 0, 0); PG8_STAGE(PG8_SA(1, 1), a1, cao[1]);
      PG8_WAIT_L(8); PG8_BAR; PG8_WAIT_L(0); PG8_MMA(0, 0, At, B0); PG8_BAR; PG8_SCHED;
      PG8_LDB(B1, 0, 1); PG8_STAGE(PG8_SB(0, 0), b2, voffB);
      PG8_BAR; PG8_WAIT_L(0); PG8_MMA(0, 1, At, B1); PG8_BAR;
      PG8_LDA(At, 0, 1); PG8_STAGE(PG8_SA(0, 0), a2, so[0]);
      PG8_BAR; PG8_WAIT_L(0); if (full) PG8_MMA(1, 0, At, B0); PG8_BAR; PG8_SCHED;
      PG8_STAGE(PG8_SB(0, 1), b2 + hstep, voffB);
      PG8_WAIT_V(6); PG8_BAR; if (full) PG8_MMA(1, 1, At, B1); PG8_BAR;
      PG8_LDB(B0, 1, 0); PG8_SCHED; PG8_LDA(At, 1, 0); PG8_STAGE(PG8_SA(0, 1), a2, so[1]);
      PG8_WAIT_L(8); PG8_BAR; PG8_WAIT_L(0); PG8_MMA(0, 0, At, B0); PG8_BAR; PG8_SCHED;
      PG8_LDB(B1, 1, 1); PG8_STAGE(PG8_SB(1, 0), b3, voffB);
      PG8_BAR; PG8_WAIT_L(0); PG8_MMA(0, 1, At, B1); PG8_BAR;
      PG8_LDA(At, 1, 1); PG8_STAGE(PG8_SA(1, 0), a3, so[0]);
      PG8_BAR; PG8_WAIT_L(0); if (full) PG8_MMA(1, 0, At, B0); PG8_BAR; PG8_SCHED;
      PG8_STAGE(PG8_SB(1, 1), b3 + hstep, voffB);
      PG8_WAIT_V(6); PG8_BAR; if (full) PG8_MMA(1, 1, At, B1); PG8_BAR;
    }
    E(acc, cur, wr, wc, fr, fq);
    if (!has_next) break;
#pragma unroll
    for (int a = 0; a < 2; ++a)
#pragma unroll
      for (int b = 0; b < 2; ++b)
#pragma unroll
        for (int m = 0; m < 4; ++m)
#pragma unroll
          for (int n = 0; n < 2; ++n) acc[a][b][m][n] = (f32x4){0.f, 0.f, 0.f, 0.f};
    cur = nxt; cB = nB; ++ui;
#pragma unroll
    for (int h = 0; h < 2; ++h)
#pragma unroll
      for (int i = 0; i < 2; ++i) cao[h][i] = nao[h][i];
  }
  PG8_WAIT_V(0);
  if (wr == 0) PG8_BAR;
  PG8_BAR;
#undef PG8_SA
#undef PG8_SB
#undef PG8_STAGE
#undef PG8_LDA
#undef PG8_LDB
#undef PG8_MMA
#undef PG8_WAIT_V
#undef PG8_WAIT_L
#undef PG8_BAR
#undef PG8_SCHED
}
}

__device__ void ph_adaln(const Params& p, float* sm) {
  const int tid = threadIdx.x;
  if (blockIdx.x == 0 && tid < NE) p.CNT[tid * 32] = 0;
  for (int e = blockIdx.x * NTHR + tid; e < 96 * 1024; e += gridDim.x * NTHR) {
    const int j = e >> 10, k = e & 1023;
    float w = 0.f;
    if (j < 64) w = p.w_expert[k * 64 + j]; else if (j < 72) w = p.w_group[k * 8 + (j - 64)];
    const unsigned hi = cvt_pk_bf16(w, 0.f) & 0xffffu;
    const float rem = w - __uint_as_float(hi << 16);
    p.WRhi[e] = (bf16_t)hi; p.WRlo[e] = (bf16_t)(cvt_pk_bf16(rem, 0.f) & 0xffffu);
  }
  float* sc = sm;
  float* red = sm + 9 * 1024;
  for (int e = tid; e < 9 * 1024; e += NTHR) {
    const int r = e >> 10, k = e & 1023;
    sc[e] = silu_f(r < 8 ? p.c[r * D + k] : p.c_ctx[k]);
  }
  __syncthreads();
  for (int item = blockIdx.x; item < 192; item += gridDim.x) {
    const int col0 = item * 32;
    const int kq = tid >> 3, c4 = (tid & 7) * 4;
    float acc[9][4];
#pragma unroll
    for (int r = 0; r < 9; ++r)
#pragma unroll
      for (int j = 0; j < 4; ++j) acc[r][j] = 0.f;
    float4 wv[16];
#pragma unroll
    for (int i = 0; i < 16; ++i) wv[i] = *(const float4*)(p.w_ada + (size_t)(kq + i * 64) * 6144 + col0 + c4);
#pragma unroll
    for (int i = 0; i < 16; ++i) {
      const int k = kq + i * 64;
      const float4 w = wv[i];
#pragma unroll
      for (int r = 0; r < 9; ++r) {
        const float sv = sc[r * 1024 + k];
        acc[r][0] += sv * w.x; acc[r][1] += sv * w.y; acc[r][2] += sv * w.z; acc[r][3] += sv * w.w;
      }
    }
#pragma unroll
    for (int r = 0; r < 9; ++r)
#pragma unroll
      for (int j = 0; j < 4; ++j) red[kq * 292 + r * 32 + c4 + j] = acc[r][j];
    __syncthreads();
    if (tid < 288) {
      float a = 0.f;
      for (int q = 0; q < 64; ++q) a += red[q * 292 + tid];
      const int r = tid >> 5, j = tid & 31;
      p.MOD[r * 6144 + col0 + j] = a + p.b_ada[col0 + j];
    }
    __syncthreads();
  }
}

__device__ void ph_filters(const Params& p, float* sm) {
  const int tid = threadIdx.x, wid = tid >> 6, lane = tid & 63;
  float* feats = sm;
  float* h1 = sm + 64 * 20;
  float* h2 = h1 + 64 * 64;
  float* w3s = h2 + 64 * 64;
  bf16_t* tile = (bf16_t*)w3s;
  float* w2s = w3s + 64 * 256;
  float* w1s = w2s + 4096;
  for (int e = tid; e < 4096; e += NTHR) w2s[e] = p.f_w2[e];
  for (int e = tid; e < 17 * 64; e += NTHR) w1s[e] = p.f_w1[e];
  __syncthreads();
  for (int e = blockIdx.x * NTHR + tid; e < 1024 * 137; e += gridDim.x * NTHR) {
    int rowi = e / 137, k = e - rowi * 137;
    int x = (k < 65) ? k : (4160 + (k - 65));
    p.FILTt[(size_t)rowi * FLEN + x] = 0;
  }
  for (int item = blockIdx.x; item < 256; item += gridDim.x) {
    const int tt = item >> 3, ct = item & 7;
    for (int e = tid; e < 4096; e += NTHR) {
      const int i = e >> 6, c4 = (e & 63) * 4;
      *(float4*)(w3s + i * 256 + c4) = *(const float4*)(p.f_w3 + i * 2048 + ct * 256 + c4);
    }
    for (int e = tid; e < 64 * 17; e += NTHR) {
      int tp = e / 17, i = e - tp * 17;
      int t = tt * 64 + tp;
      float f;
      if (i == 0) f = (float)t / (float)(L - 1);
      else {
        int bi = (i - 1) & 7;
        float bandf = (float)(1e-4 + (double)bi * ((7.0 - 1e-4) / 7.0));
        float ang = (float)(2.0 * 3.14159265358979323846 / (double)L) * (float)t * bandf;
        f = (i <= 8) ? cosf(ang) : -sinf(ang);
      }
      feats[tp * 20 + i] = f;
    }
    __syncthreads();
    for (int e = tid; e < 4096; e += NTHR) {
      int tp = e >> 6, j = e & 63;
      float a = p.f_b1[j];
      for (int i = 0; i < 17; ++i) a += feats[tp * 20 + i] * w1s[i * 64 + j];
      h1[e] = __sinf(p.f_freq[j] * a);
    }
    __syncthreads();
    {
      const int tp = tid >> 3, j8 = (tid & 7) * 8;
      float a[8];
#pragma unroll
      for (int c = 0; c < 8; ++c) a[c] = p.f_b2[j8 + c];
#pragma unroll 4
      for (int i = 0; i < 64; ++i) {
        const float hv = h1[tp * 64 + i];
        const float4 w0 = *(const float4*)(w2s + i * 64 + j8), w1 = *(const float4*)(w2s + i * 64 + j8 + 4);
        a[0] += hv * w0.x; a[1] += hv * w0.y; a[2] += hv * w0.z; a[3] += hv * w0.w;
        a[4] += hv * w1.x; a[5] += hv * w1.y; a[6] += hv * w1.z; a[7] += hv * w1.w;
      }
#pragma unroll
      for (int c = 0; c < 8; ++c) h2[tp * 64 + j8 + c] = __sinf(p.f_freq[j8 + c] * a[c]);
    }
    __syncthreads();
    {
      const int cg = tid & 31, tg = tid >> 5;
      float acc[4][8];
#pragma unroll
      for (int a = 0; a < 4; ++a)
#pragma unroll
        for (int c = 0; c < 8; ++c) acc[a][c] = 0.f;
#pragma unroll 4
      for (int i = 0; i < 64; ++i) {
        const float4 w0 = *(const float4*)(w3s + i * 256 + cg * 8), w1 = *(const float4*)(w3s + i * 256 + cg * 8 + 4);
        const float wv[8] = {w0.x, w0.y, w0.z, w0.w, w1.x, w1.y, w1.z, w1.w};
#pragma unroll
        for (int a = 0; a < 4; ++a) {
          const float hv = h2[(tg * 4 + a) * 64 + i];
#pragma unroll
          for (int c = 0; c < 8; ++c) acc[a][c] += hv * wv[c];
        }
      }
      __syncthreads();
      const float d0 = -4.605170185988091f / 1.5f, d1 = -4.605170185988091f / 0.3f;
#pragma unroll
      for (int c = 0; c < 8; ++c) {
        const int col = cg * 8 + c;
        const int cch = (ct * 256 + col) & 511;
        const float delta = fabsf(d0 + (float)cch * ((d1 - d0) / 511.f));
#pragma unroll
        for (int a = 0; a < 4; ++a) {
          const int t = tt * 64 + tg * 4 + a;
          const float tn = (float)t / (float)(L - 1);
          tile[col * 66 + tg * 4 + a] = f2bf(acc[a][c] * __expf(-tn * delta));
        }
      }
    }
    __syncthreads();
    for (int cl = wid * 32; cl < wid * 32 + 32; ++cl) {
      const int gcol = ct * 256 + cl;
      const int o = gcol >> 10, dir = (gcol >> 9) & 1, cch = gcol & 511;
      const int t = tt * 64 + lane;
      const int x = dir ? (HX0 + t) : (HX0 - t);
      if (!(dir && t == 0)) p.FILTt[(size_t)(o * 512 + cch) * FLEN + x] = tile[cl * 66 + lane];
    }
    __syncthreads();
  }
}

__device__ __forceinline__ void cvt_tile256(const float* src, int ld, int k0, int n0, bf16_t* dst, int ldd, int dmap0, int dmap1, int nsplit, float* sm) {
  const int tid = threadIdx.x;
  float* ts = sm;
  float4 v[8];
#pragma unroll
  for (int i = 0; i < 8; ++i) {
    const int e = tid + i * NTHR; const int k = e >> 6, n4 = (e & 63) * 4;
    v[i] = *(const float4*)(src + (size_t)(k0 + k) * ld + n0 + n4);
  }
#pragma unroll
  for (int i = 0; i < 8; ++i) {
    const int e = tid + i * NTHR; const int k = e >> 6, n4 = (e & 63) * 4;
    ts[k * 257 + n4 + 0] = v[i].x; ts[k * 257 + n4 + 1] = v[i].y; ts[k * 257 + n4 + 2] = v[i].z; ts[k * 257 + n4 + 3] = v[i].w;
  }
  __syncthreads();
#pragma unroll
  for (int i = 0; i < 4; ++i) {
    const int e = tid + i * NTHR; const int n = e >> 3, kq = (e & 7) * 8;
    uint4 w;
    w.x = cvt_pk_bf16(ts[(kq + 0) * 257 + n], ts[(kq + 1) * 257 + n]);
    w.y = cvt_pk_bf16(ts[(kq + 2) * 257 + n], ts[(kq + 3) * 257 + n]);
    w.z = cvt_pk_bf16(ts[(kq + 4) * 257 + n], ts[(kq + 5) * 257 + n]);
    w.w = cvt_pk_bf16(ts[(kq + 6) * 257 + n], ts[(kq + 7) * 257 + n]);
    const int drow = (n < nsplit) ? (dmap0 + n) : (dmap1 + (n - nsplit));
    *(uint4*)(dst + (size_t)drow * ldd + k0 + kq) = w;
  }
  __syncthreads();
}

__device__ void ph_wcvt(const Params& p, float* sm) {
  for (int e = blockIdx.x * NTHR + threadIdx.x; e < 16 * 1024; e += gridDim.x * NTHR) {
    const int j = e >> 10, k = e & 1023;
    p.WinT[(size_t)(DP + j) * D + k] = f2bf(p.w_in[(size_t)k * DIN + COL_DT + j]);
  }
  for (int it = blockIdx.x; it < 192 + 64; it += gridDim.x) {
    if (it < 192) { const int kt = it / 12, nt = it - kt * 12; cvt_tile256(p.w_in, DIN, kt * 64, nt * 256, p.WinT, D, nt * 256, 0, 256, sm); }
    else if (it < 256) { const int i = it - 192; const int kt = i >> 2, nt = i & 3; cvt_tile256(p.w_out, D, kt * 64, nt * 256, p.WoutT, D, nt * 256, 0, 256, sm); }
  }
}

__device__ void ph_norm1(const Params& p) {
  const int tid = threadIdx.x, wid = tid >> 6, lane = tid & 63;
  for (int row = blockIdx.x * 8 + wid; row < TT; row += gridDim.x * 8) {
    const float* src = (row < T) ? (p.x + (size_t)row * D) : (p.ctx + (size_t)(row - T) * D);
    const int mr = (row < T) ? (row / L) : 8;
    const float* sh = p.MOD + mr * 6144;
    const float* sc = sh + 1024;
    float4 v[4];
    float ss = 0.f;
#pragma unroll
    for (int i = 0; i < 4; ++i) {
      v[i] = *(const float4*)(src + i * 256 + lane * 4);
      ss += v[i].x * v[i].x + v[i].y * v[i].y + v[i].z * v[i].z + v[i].w * v[i].w;
    }
    ss = wave_sum(ss);
    const float rstd = rsqrtf(ss * (1.f / D) + EPS);
#pragma unroll
    for (int i = 0; i < 4; ++i) {
      const int col = i * 256 + lane * 4;
      float4 g = *(const float4*)(p.g1 + col);
      float4 s4 = *(const float4*)(sc + col);
      float4 h4 = *(const float4*)(sh + col);
      float4 o;
      o.x = v[i].x * rstd * g.x * (1.f + s4.x) + h4.x;
      o.y = v[i].y * rstd * g.y * (1.f + s4.y) + h4.y;
      o.z = v[i].z * rstd * g.z * (1.f + s4.z) + h4.z;
      o.w = v[i].w * rstd * g.w * (1.f + s4.w) + h4.w;
      uint2 w; w.x = cvt_pk_bf16(o.x, o.y); w.y = cvt_pk_bf16(o.z, o.w);
      *(uint2*)(p.XNb + (size_t)row * D + col) = w;
    }
  }
}

__device__ void ph_hy_convT(const Params& p, float* sm) {
  const int tid = threadIdx.x;
  float* tile = sm;
  const int bid = blockIdx.x;
  int it0, it1;
  if (gridDim.x == 256) { if (bid < 32) { it0 = bid * 3; it1 = it0 + 3; } else { it0 = 96 + (bid - 32) * 27; it1 = it0 + 27; } }
  else { const int per = (256 * 24 + gridDim.x - 1) / gridDim.x; it0 = bid * per; it1 = it0 + per; if (it1 > 256 * 24) it1 = 256 * 24; }
  for (int item = it0; item < it1; item += 3) {
    uint4 v[3];
    const int lt = tid >> 3, c8 = (tid & 7) * 8;
#pragma unroll
    for (int u = 0; u < 3; ++u) {
      const int it = (item + u < it1) ? (item + u) : item;
      const int gr = it / 24, ct = it - gr * 24;
      v[u] = *(const uint4*)(p.PXb + (size_t)(gr * 64 + lt) * DP + ct * 64 + c8);
    }
#pragma unroll
    for (int u = 0; u < 3; ++u) {
      float* tl = tile + u * (64 * 65);
      const unsigned w[4] = {v[u].x, v[u].y, v[u].z, v[u].w};
#pragma unroll
      for (int k = 0; k < 4; ++k) {
        tl[lt * 65 + c8 + 2 * k] = __uint_as_float(w[k] << 16);
        tl[lt * 65 + c8 + 2 * k + 1] = __uint_as_float(w[k] & 0xffff0000u);
      }
    }
    __syncthreads();
#pragma unroll
    for (int u = 0; u < 3; ++u) {
      if (item + u < it1) {
        const int it = item + u;
        const int gr = it / 24, ct = it - gr * 24;
        const int row0 = gr * 64;
        const float* tl = tile + u * (64 * 65);
        const int cc = tid >> 3, t8 = (tid & 7) * 8;
        const int col = ct * 64 + cc;
        const float w0 = p.hy_conv_w[col], w1 = p.hy_conv_w[HYC + col], w2 = p.hy_conv_w[2 * HYC + col], bb = p.hy_conv_b[col];
        float o[8];
#pragma unroll
        for (int k = 0; k < 8; ++k) {
          const int t = t8 + k;
          float vv = bb + w1 * tl[t * 65 + cc];
          if (t > 0) vv += w0 * tl[(t - 1) * 65 + cc];
          if (t < 63) vv += w2 * tl[(t + 1) * 65 + cc];
          o[k] = vv;
        }
        uint4 w; w.x = cvt_pk_bf16(o[0], o[1]); w.y = cvt_pk_bf16(o[2], o[3]); w.z = cvt_pk_bf16(o[4], o[5]); w.w = cvt_pk_bf16(o[6], o[7]);
        *(uint4*)(p.Ut + (size_t)col * T + row0 + t8) = w;
      }
    }
    __syncthreads();
  }
}

__device__ void ph_hy_backT(const Params& p, float* sm) {
  const int tid = threadIdx.x;
  bf16_t* tile = (bf16_t*)sm;
  for (int item = blockIdx.x; item < 256 * 8; item += gridDim.x) {
    const int gr = item >> 3, ct = item & 7;
    const int row0 = gr * 64;
    {
      const int cc = tid >> 3, r8 = (tid & 7) * 8;
      uint4 v = *(const uint4*)(p.Yt + (size_t)(ct * 64 + cc) * T + row0 + r8);
      unsigned w[4] = {v.x, v.y, v.z, v.w};
#pragma unroll
      for (int k = 0; k < 4; ++k) {
        tile[cc * 66 + r8 + 2 * k] = (bf16_t)(w[k] & 0xffffu);
        tile[cc * 66 + r8 + 2 * k + 1] = (bf16_t)(w[k] >> 16);
      }
    }
    __syncthreads();
    {
      const int r = tid >> 3, c8 = (tid & 7) * 8;
      unsigned w[4];
#pragma unroll
      for (int k = 0; k < 4; ++k) w[k] = (unsigned)tile[(c8 + 2 * k) * 66 + r] | ((unsigned)tile[(c8 + 2 * k + 1) * 66 + r] << 16);
      uint4 o; o.x = w[0]; o.y = w[1]; o.z = w[2]; o.w = w[3];
      *(uint4*)(p.YMIXb + (size_t)(row0 + r) * D + ct * 64 + c8) = o;
    }
    __syncthreads();
  }
}

typedef short hbf16x8 __attribute__((ext_vector_type(8)));
typedef float hf32x4 __attribute__((ext_vector_type(4)));

constexpr int HY_FC = 0, HY_ZT0 = 4 * FCLEN * 2, HY_ZT1 = HY_ZT0 + 8 * ZSTRB;

__device__ __forceinline__ void hy_build_filter(const Params& p, int o, int c, unsigned char* lds) {
  const int tid = threadIdx.x;
  const bf16_t* gsrc = p.FILTt + (size_t)(o * 512 + c) * FLEN;
  for (int e = tid; e < 530; e += NTHR) {
    uint4 v = make_uint4(0u, 0u, 0u, 0u);
    if (e < 529) v = *(const uint4*)(gsrc + e * 8);
    *(uint4*)(lds + HY_FC + e * 16) = v;
  }
  __syncthreads();
  for (int g = tid; g < 3 * 530; g += NTHR) {
    const int r = 1 + g / 530, ch = g % 530;
    uint4 lo = make_uint4(0u, 0u, 0u, 0u);
    if (ch > 0) lo = *(const uint4*)(lds + HY_FC + (ch - 1) * 16);
    uint4 hi = *(const uint4*)(lds + HY_FC + ch * 16);
    unsigned W[8] = {lo.x, lo.y, lo.z, lo.w, hi.x, hi.y, hi.z, hi.w};
    uint4 ov;
    if (r == 1) {
      ov.x = __builtin_amdgcn_alignbyte(W[4], W[3], 2); ov.y = __builtin_amdgcn_alignbyte(W[5], W[4], 2);
      ov.z = __builtin_amdgcn_alignbyte(W[6], W[5], 2); ov.w = __builtin_amdgcn_alignbyte(W[7], W[6], 2);
    } else if (r == 2) {
      ov.x = W[3]; ov.y = W[4]; ov.z = W[5]; ov.w = W[6];
    } else {
      ov.x = __builtin_amdgcn_alignbyte(W[3], W[2], 2); ov.y = __builtin_amdgcn_alignbyte(W[4], W[3], 2);
      ov.z = __builtin_amdgcn_alignbyte(W[5], W[4], 2); ov.w = __builtin_amdgcn_alignbyte(W[6], W[5], 2);
    }
    *(uint4*)(lds + HY_FC + r * (FCLEN * 2) + ch * 16) = ov;
  }
  __syncthreads();
}

__device__ __forceinline__ void hy_order(const Params& p, int o, int c, unsigned char* lds) {
  const int tid = threadIdx.x, wid = __builtin_amdgcn_readfirstlane(tid >> 6), lane = tid & 63;
  const int g0 = wid * 4;
  const int n16 = lane & 15, h = lane >> 4, bb = n16 & 7, pp = n16 >> 3;
  const unsigned char* Zin = lds + (o ? HY_ZT1 : HY_ZT0);
  const bf16_t* gate = p.Ut + (size_t)((o + 1) * 512 + c) * T + bb * L;
  uint2 xg[4][2];
#pragma unroll
  for (int i = 0; i < 4; ++i)
#pragma unroll
    for (int u = 0; u < 2; ++u) xg[i][u] = *(const uint2*)(gate + 32 * (2 * (g0 + i) + pp) + 16 * u + 4 * h);
  const float bias = p.hy_bias[o * 512 + c];
  hf32x4 acc[4][2];
#pragma unroll
  for (int i = 0; i < 4; ++i)
#pragma unroll
    for (int u = 0; u < 2; ++u) acc[i][u] = (hf32x4){0.f, 0.f, 0.f, 0.f};
  const int ai = lane & 15, ar = ai & 3, aq = ai >> 2;
  const unsigned char* laneA = lds + HY_FC + ar * (FCLEN * 2) + 2 * (HX0 - 4 * aq + 8 * h);
  const unsigned char* laneB = Zin + bb * ZSTRB + 64 + 64 * pp + 16 * h;
#define HY_LDA(dst, Dd) do { const uint2 _lo = *(const uint2*)(laneA - 32 * (Dd)); const uint2 _hi = *(const uint2*)(laneA - 32 * (Dd) + 8); \
    union { uint4 u4; hbf16x8 v; } _cv; _cv.u4 = make_uint4(_lo.x, _lo.y, _hi.x, _hi.y); dst = _cv.v; } while (0)
#define HY_LDB(dst, Qq) do { dst = *(const hbf16x8*)(laneB + 64 * (Qq)); } while (0)
#pragma unroll 1
  for (int pass = 0; pass < 2; ++pass) {
    const int Es = 2 * g0 - 63 + pass;
    hbf16x8 R[4];
    HY_LDB(R[1], 2 * (g0 + 1) - Es); HY_LDB(R[2], 2 * (g0 + 2) - Es); HY_LDB(R[3], 2 * (g0 + 3) - Es);
#pragma unroll 1
    for (int n4 = 0; n4 < 9; ++n4) {
#pragma unroll
      for (int j = 0; j < 4; ++j) {
        const int n = n4 * 4 + j;
        const int E = Es + 2 * n;
        HY_LDB(R[(4 - j) & 3], 2 * (g0 - n) - Es);
        hbf16x8 A0, A1;
        HY_LDA(A0, 2 * E); HY_LDA(A1, 2 * E + 1);
#pragma unroll
        for (int i = 0; i < 4; ++i) {
          const int Q = 2 * (g0 + i - n) - Es;
          if (Q >= -1 && Q <= 63) {
            acc[i][0] = __builtin_amdgcn_mfma_f32_16x16x32_bf16(A0, R[(i - j) & 3], acc[i][0], 0, 0, 0);
            acc[i][1] = __builtin_amdgcn_mfma_f32_16x16x32_bf16(A1, R[(i - j) & 3], acc[i][1], 0, 0, 0);
          }
        }
      }
    }
  }
#undef HY_LDA
#undef HY_LDB
#pragma unroll
  for (int i = 0; i < 4; ++i)
#pragma unroll
    for (int u = 0; u < 2; ++u) {
      const int t0 = 32 * (2 * (g0 + i) + pp) + 16 * u + 4 * h;
      const uint2 zv = *(const uint2*)(Zin + bb * ZSTRB + 64 + 2 * t0);
      const float z0 = __uint_as_float(zv.x << 16), z1 = __uint_as_float(zv.x & 0xffff0000u), z2 = __uint_as_float(zv.y << 16), z3 = __uint_as_float(zv.y & 0xffff0000u);
      const float x0 = __uint_as_float(xg[i][u].x << 16), x1 = __uint_as_float(xg[i][u].x & 0xffff0000u), x2 = __uint_as_float(xg[i][u].y << 16), x3 = __uint_as_float(xg[i][u].y & 0xffff0000u);
      const float r0 = x0 * (acc[i][u][0] + z0 * bias), r1 = x1 * (acc[i][u][1] + z1 * bias), r2 = x2 * (acc[i][u][2] + z2 * bias), r3 = x3 * (acc[i][u][3] + z3 * bias);
      uint2 w; w.x = cvt_pk_bf16(r0, r1); w.y = cvt_pk_bf16(r2, r3);
      if (o == 0) *(uint2*)(lds + HY_ZT1 + bb * ZSTRB + 64 + 2 * t0) = w;
      else *(uint2*)(p.Yt + (size_t)c * T + bb * L + t0) = w;
    }
}

__device__ void hyena_block(const Params& p, unsigned char* lds) {
  const int tid = threadIdx.x;
  uint4 fv0, fv1;
#define HY_FLOAD(o_, c_) do { const bf16_t* _g = p.FILTt + (size_t)((o_) * 512 + (c_)) * FLEN; \
    fv0 = *(const uint4*)(_g + tid * 8); fv1 = *(const uint4*)(_g + ((tid < 17) ? (512 + tid) : 0) * 8); } while (0)
  if ((int)blockIdx.x < 512) HY_FLOAD(0, blockIdx.x);
  for (int c = blockIdx.x; c < 512; c += gridDim.x) {
    if (tid < 144) {
      const int buf = tid / 72, rem = tid % 72, b = rem / 9, k = rem % 9;
      const int off = (k < 4) ? (k * 16) : (4160 + (k - 4) * 16);
      *(uint4*)(lds + (buf ? HY_ZT1 : HY_ZT0) + b * ZSTRB + off) = make_uint4(0u, 0u, 0u, 0u);
    }
    for (int e = tid; e < 2048; e += NTHR) {
      const int b = e >> 8, ch = e & 255;
      *(uint4*)(lds + HY_ZT0 + b * ZSTRB + 64 + ch * 16) = *(const uint4*)(p.Ut + (size_t)c * T + b * L + ch * 8);
    }
#pragma unroll 1
    for (int o = 0; o < 2; ++o) {
      *(uint4*)(lds + HY_FC + tid * 16) = fv0;
      if (tid < 18) *(uint4*)(lds + HY_FC + (512 + tid) * 16) = (tid < 17) ? fv1 : make_uint4(0u, 0u, 0u, 0u);
      __syncthreads();
      for (int g = tid; g < 3 * 530; g += NTHR) {
        const int r = 1 + g / 530, ch = g % 530;
        uint4 lo = make_uint4(0u, 0u, 0u, 0u);
        if (ch > 0) lo = *(const uint4*)(lds + HY_FC + (ch - 1) * 16);
        uint4 hi = *(const uint4*)(lds + HY_FC + ch * 16);
        unsigned W[8] = {lo.x, lo.y, lo.z, lo.w, hi.x, hi.y, hi.z, hi.w};
        uint4 ov;
        if (r == 1) {
          ov.x = __builtin_amdgcn_alignbyte(W[4], W[3], 2); ov.y = __builtin_amdgcn_alignbyte(W[5], W[4], 2);
          ov.z = __builtin_amdgcn_alignbyte(W[6], W[5], 2); ov.w = __builtin_amdgcn_alignbyte(W[7], W[6], 2);
        } else if (r == 2) {
          ov.x = W[3]; ov.y = W[4]; ov.z = W[5]; ov.w = W[6];
        } else {
          ov.x = __builtin_amdgcn_alignbyte(W[3], W[2], 2); ov.y = __builtin_amdgcn_alignbyte(W[4], W[3], 2);
          ov.z = __builtin_amdgcn_alignbyte(W[5], W[4], 2); ov.w = __builtin_amdgcn_alignbyte(W[6], W[5], 2);
        }
        *(uint4*)(lds + HY_FC + r * (FCLEN * 2) + ch * 16) = ov;
      }
      __syncthreads();
      {
        const int no = (o == 0) ? 1 : 0;
        const int nc = (o == 0) ? c : ((c + (int)gridDim.x < 512) ? (c + (int)gridDim.x) : c);
        HY_FLOAD(no, nc);
      }
      hy_order(p, o, c, lds);
      __syncthreads();
    }
  }
#undef HY_FLOAD
}

constexpr int SROW = 272;

__device__ __forceinline__ void ssd_stage_nat(const Params& p, int row0, int pxcol0, int cvcol0, unsigned char* dst) {
  for (int e = threadIdx.x; e < 2048; e += NTHR) {
    const int l = e >> 4, cg = e & 15;
    const int row = row0 + l, li = row & 63;
    const bf16_t* src = p.PXb + (size_t)row * DP + pxcol0 + cg * 8;
    const uint4 zero4 = make_uint4(0u, 0u, 0u, 0u);
    const uint4 cur = *(const uint4*)src;
    const uint4 prv = (li > 0) ? *(const uint4*)(src - DP) : zero4;
    const uint4 nxt = (li < 63) ? *(const uint4*)(src + DP) : zero4;
    const float* cw = p.ssd_conv_w + cvcol0 + cg * 8;
    const float* cb = p.ssd_conv_b + cvcol0 + cg * 8;
    const unsigned pc[4] = {prv.x, prv.y, prv.z, prv.w}, cc[4] = {cur.x, cur.y, cur.z, cur.w}, nc[4] = {nxt.x, nxt.y, nxt.z, nxt.w};
    float o[8];
#pragma unroll
    for (int k = 0; k < 4; ++k) {
      const float p0 = __uint_as_float(pc[k] << 16), p1 = __uint_as_float(pc[k] & 0xffff0000u);
      const float c0 = __uint_as_float(cc[k] << 16), c1 = __uint_as_float(cc[k] & 0xffff0000u);
      const float n0 = __uint_as_float(nc[k] << 16), n1 = __uint_as_float(nc[k] & 0xffff0000u);
      const float v0 = cb[2 * k] + cw[2 * k] * p0 + cw[DXBC + 2 * k] * c0 + cw[2 * DXBC + 2 * k] * n0;
      const float v1 = cb[2 * k + 1] + cw[2 * k + 1] * p1 + cw[DXBC + 2 * k + 1] * c1 + cw[2 * DXBC + 2 * k + 1] * n1;
      o[2 * k] = silu_f(v0); o[2 * k + 1] = silu_f(v1);
    }
    uint4 w; w.x = cvt_pk_bf16(o[0], o[1]); w.y = cvt_pk_bf16(o[2], o[3]); w.z = cvt_pk_bf16(o[4], o[5]); w.w = cvt_pk_bf16(o[6], o[7]);
    *(uint4*)(dst + l * SROW + cg * 16) = w;
  }
}

__device__ __forceinline__ void ssd_stage_tr(const Params& p, int row0, bool is_ctx, int pxcol0, int cvcol0, int ncols, unsigned char* dst) {
  const int ncg = ncols >> 2;
  for (int e = threadIdx.x; e < ncg * 16; e += NTHR) {
    const int cg = e % ncg, l8 = e / ncg;
    const int rowf = row0 + l8 * 8;
    bool has_prev, has_next;
    if (is_ctx) { const int tc = (rowf - T) & (LC - 1); has_prev = tc > 0; has_next = tc + 7 < LC - 1; }
    else { const int li = rowf & 63; has_prev = li > 0; has_next = li + 7 < 63; }
    const bf16_t* src = p.PXb + (size_t)rowf * DP + pxcol0 + cg * 4;
    const uint2 z2 = make_uint2(0u, 0u);
    uint2 raw[10];
    raw[0] = *(const uint2*)((cvcol0 >= 0 && has_prev) ? (src - DP) : src);
    if (!(cvcol0 >= 0 && has_prev)) raw[0] = z2;
#pragma unroll
    for (int k = 0; k < 8; ++k) raw[k + 1] = *(const uint2*)(src + (size_t)k * DP);
    raw[9] = *(const uint2*)((cvcol0 >= 0 && has_next) ? (src + (size_t)8 * DP) : src);
    if (!(cvcol0 >= 0 && has_next)) raw[9] = z2;
    unsigned outw[4][4];
    if (cvcol0 >= 0) {
      const float* cw = p.ssd_conv_w + cvcol0 + cg * 4; const float* cb = p.ssd_conv_b + cvcol0 + cg * 4;
      const float4 a0 = *(const float4*)cw, b0 = *(const float4*)(cw + DXBC), c0 = *(const float4*)(cw + 2 * DXBC), d0 = *(const float4*)cb;
      const float w0[4] = {a0.x, a0.y, a0.z, a0.w}, w1[4] = {b0.x, b0.y, b0.z, b0.w}, w2[4] = {c0.x, c0.y, c0.z, c0.w}, bb[4] = {d0.x, d0.y, d0.z, d0.w};
#pragma unroll
      for (int kp = 0; kp < 4; ++kp) {
#pragma unroll
        for (int c = 0; c < 4; ++c) {
          const unsigned q0 = (c >> 1) ? raw[2 * kp].y : raw[2 * kp].x, q1 = (c >> 1) ? raw[2 * kp + 1].y : raw[2 * kp + 1].x;
          const unsigned q2 = (c >> 1) ? raw[2 * kp + 2].y : raw[2 * kp + 2].x, q3 = (c >> 1) ? raw[2 * kp + 3].y : raw[2 * kp + 3].x;
          float x0, x1, x2, x3;
          if (c & 1) { x0 = __uint_as_float(q0 & 0xffff0000u); x1 = __uint_as_float(q1 & 0xffff0000u); x2 = __uint_as_float(q2 & 0xffff0000u); x3 = __uint_as_float(q3 & 0xffff0000u); }
          else { x0 = __uint_as_float(q0 << 16); x1 = __uint_as_float(q1 << 16); x2 = __uint_as_float(q2 << 16); x3 = __uint_as_float(q3 << 16); }
          const float oa = silu_f(bb[c] + w0[c] * x0 + w1[c] * x1 + w2[c] * x2);
          const float ob = silu_f(bb[c] + w0[c] * x1 + w1[c] * x2 + w2[c] * x3);
          outw[c][kp] = cvt_pk_bf16(oa, ob);
        }
      }
    } else {
#pragma unroll
      for (int kp = 0; kp < 4; ++kp) {
#pragma unroll
        for (int c = 0; c < 4; ++c) {
          const unsigned q1 = (c >> 1) ? raw[2 * kp + 1].y : raw[2 * kp + 1].x, q2 = (c >> 1) ? raw[2 * kp + 2].y : raw[2 * kp + 2].x;
          outw[c][kp] = (c & 1) ? ((q1 >> 16) | (q2 & 0xffff0000u)) : ((q1 & 0xffffu) | (q2 << 16));
        }
      }
    }
#pragma unroll
    for (int c = 0; c < 4; ++c)
      *(uint4*)(dst + (cg * 4 + c) * SROW + l8 * 16) = make_uint4(outw[c][0], outw[c][1], outw[c][2], outw[c][3]);
  }
}

__device__ __forceinline__ void ssd_stage_tr_s(const Params& p, int row0, bool is_ctx, int pxcol0, int cvcol0, int ncols, unsigned char* dst) {
  for (int e = threadIdx.x; e < ncols * 16; e += NTHR) {
    const int col = e & (ncols - 1), l8 = e / ncols;
    const int rowf = row0 + l8 * 8;
    bool has_prev, has_next;
    if (is_ctx) { const int tc = (rowf - T) & (LC - 1); has_prev = tc > 0; has_next = tc + 7 < LC - 1; }
    else { const int li = rowf & 63; has_prev = li > 0; has_next = li + 7 < 63; }
    const bf16_t* src = p.PXb + (size_t)rowf * DP + pxcol0 + col;
    float x[10];
    x[0] = (cvcol0 >= 0 && has_prev) ? bf2f(src[-DP]) : 0.f;
#pragma unroll
    for (int k = 0; k < 8; ++k) x[k + 1] = bf2f(src[(size_t)k * DP]);
    x[9] = (cvcol0 >= 0 && has_next) ? bf2f(src[(size_t)8 * DP]) : 0.f;
    float o[8];
    if (cvcol0 >= 0) {
      const float w0 = p.ssd_conv_w[cvcol0 + col], w1 = p.ssd_conv_w[DXBC + cvcol0 + col], w2 = p.ssd_conv_w[2 * DXBC + cvcol0 + col], bb = p.ssd_conv_b[cvcol0 + col];
#pragma unroll
      for (int k = 0; k < 8; ++k) o[k] = silu_f(bb + w0 * x[k] + w1 * x[k + 1] + w2 * x[k + 2]);
    } else {
#pragma unroll
      for (int k = 0; k < 8; ++k) o[k] = x[k + 1];
    }
    uint4 w; w.x = cvt_pk_bf16(o[0], o[1]); w.y = cvt_pk_bf16(o[2], o[3]); w.z = cvt_pk_bf16(o[4], o[5]); w.w = cvt_pk_bf16(o[6], o[7]);
    *(uint4*)(dst + col * SROW + l8 * 16) = w;
  }
}

__device__ void ssd_states_unit(const Params& p, int unit, unsigned char* lds) {
  const int tid = threadIdx.x, wid = __builtin_amdgcn_readfirstlane(tid >> 6), lane = tid & 63;
  const int g = unit & 1, bc = unit >> 1, cidx = bc % 18, b = bc / 18;
  const bool is_ctx = cidx < 2;
  const int row0 = is_ctx ? (T + b * LC + cidx * 128) : (b * L + (cidx - 2) * 128);
  unsigned char* XT = lds;
  unsigned char* BT = lds + 69632;
  unsigned char* XD = lds + 104448;
  float* WG = (float*)(lds + 121856);
  ssd_stage_tr(p, row0, is_ctx, COL_XBC + g * 256, g * 256, 256, XT);
  ssd_stage_tr(p, row0, is_ctx, COL_XBC + 512 + g * 128, 512 + g * 128, 128, BT);
  {
    const int dir = wid >> 2, hh = wid & 3, h = g * 4 + hh;
    const float A = expf(p.a_log[dir * 8 + h]);
    const int l0 = 2 * lane, l1 = l0 + 1;
    const float dt0 = softplus_f(p.DT[(size_t)(row0 + l0) * 16 + dir * 8 + h]), dt1 = softplus_f(p.DT[(size_t)(row0 + l1) * 16 + dir * 8 + h]);
    const float a0 = -A * dt0, a1 = -A * dt1, pair = a0 + a1;
    float incl = pair;
#pragma unroll
    for (int o = 1; o < 64; o <<= 1) { float t = __shfl_up(incl, o); if (lane >= o) incl += t; }
    const float excl = incl - pair;
    const float total = __shfl(incl, 63);
    float w0, w1, c0, c1;
    if (dir == 0) { c0 = excl + a0; c1 = excl + pair; w0 = dt0 * expf(total - c0); w1 = dt1 * expf(total - c1); }
    else { const float pe0 = excl, pe1 = excl + a0; w0 = dt0 * expf(pe0); w1 = dt1 * expf(pe1); c0 = total - pe0; c1 = total - pe1; }
    WG[wid * 128 + l0] = w0; WG[wid * 128 + l1] = w1;
    if (!is_ctx) { float* ac = p.ACUM + (size_t)(b * 16 + dir * 8 + h) * L + (cidx - 2) * 128; *(float2*)(ac + l0) = make_float2(c0, c1); }
    if (lane == 0) {
      const int k = dir ? (is_ctx ? (1 - cidx) : (19 - cidx)) : cidx;
      p.CDEC[(size_t)(((b * 2 + dir) * 8 + h) * 18 + k) * 32] = expf(total);
    }
  }
  __syncthreads();
  const int fr = lane & 15, fq = lane >> 4;
#pragma unroll 1
  for (int it = 0; it < 8; ++it) {
    const int dir = it >> 2, hh = it & 3, h = g * 4 + hh;
    for (int e = tid; e < 1024; e += NTHR) {
      const int pr = e >> 4, ch = e & 15;
      const uint4 v = *(const uint4*)(XT + (hh * 64 + pr) * SROW + ch * 16);
      const float4 wa = *(const float4*)(WG + it * 128 + ch * 8), wb = *(const float4*)(WG + it * 128 + ch * 8 + 4);
      uint4 w;
      w.x = cvt_pk_bf16(__uint_as_float(v.x << 16) * wa.x, __uint_as_float(v.x & 0xffff0000u) * wa.y);
      w.y = cvt_pk_bf16(__uint_as_float(v.y << 16) * wa.z, __uint_as_float(v.y & 0xffff0000u) * wa.w);
      w.z = cvt_pk_bf16(__uint_as_float(v.z << 16) * wb.x, __uint_as_float(v.z & 0xffff0000u) * wb.y);
      w.w = cvt_pk_bf16(__uint_as_float(v.w << 16) * wb.z, __uint_as_float(v.w & 0xffff0000u) * wb.w);
      *(uint4*)(XD + pr * SROW + ch * 16) = w;
    }
    __syncthreads();
    hf32x4 acc[4];
#pragma unroll
    for (int pt = 0; pt < 4; ++pt) acc[pt] = (hf32x4){0.f, 0.f, 0.f, 0.f};
#pragma unroll
    for (int kk = 0; kk < 4; ++kk) {
      const hbf16x8 Bf = *(const hbf16x8*)(BT + (16 * wid + fr) * SROW + 2 * (32 * kk + 8 * fq));
#pragma unroll
      for (int pt = 0; pt < 4; ++pt) {
        const hbf16x8 Af = *(const hbf16x8*)(XD + (16 * pt + fr) * SROW + 2 * (32 * kk + 8 * fq));
        acc[pt] = __builtin_amdgcn_mfma_f32_16x16x32_bf16(Bf, Af, acc[pt], 0, 0, 0);
      }
    }
    const int k = dir ? (is_ctx ? (1 - cidx) : (19 - cidx)) : cidx;
    bf16_t* slot = p.SST + ((size_t)(((b * 2 + dir) * 8 + h) * 18 + k)) * 8192;
#pragma unroll
    for (int pt = 0; pt < 4; ++pt)
      *(uint2*)(slot + (16 * pt + fr) * 128 + 16 * wid + 4 * fq) = make_uint2(cvt_pk_bf16(acc[pt][0], acc[pt][1]), cvt_pk_bf16(acc[pt][2], acc[pt][3]));
    __syncthreads();
  }
}

__device__ void ssd_scan_unit(const Params& p, int unit) {
  const int tid = threadIdx.x;
  const int half = unit & 1, seq = unit >> 1;
  const int pr = half * 32 + (tid >> 4), n8 = (tid & 15) * 8;
  const bf16_t* base = p.SST + (size_t)seq * 18 * 8192 + pr * 128 + n8;
  uint4 sv[18];
#pragma unroll
  for (int k = 0; k < 18; ++k) sv[k] = *(const uint4*)(base + (size_t)k * 8192);
  float hst[8];
#pragma unroll
  for (int j = 0; j < 8; ++j) hst[j] = 0.f;
#pragma unroll
  for (int k = 0; k < 18; ++k) {
    const float dec = p.CDEC[(size_t)(seq * 18 + k) * 32];
    if (k >= 2) {
      uint4 w; w.x = cvt_pk_bf16(hst[0], hst[1]); w.y = cvt_pk_bf16(hst[2], hst[3]); w.z = cvt_pk_bf16(hst[4], hst[5]); w.w = cvt_pk_bf16(hst[6], hst[7]);
      *(uint4*)(p.HIN + ((size_t)seq * 16 + (k - 2)) * 8192 + pr * 128 + n8) = w;
    }
    const unsigned sw[4] = {sv[k].x, sv[k].y, sv[k].z, sv[k].w};
#pragma unroll
    for (int u = 0; u < 4; ++u) {
      hst[2 * u] = dec * hst[2 * u] + __uint_as_float(sw[u] << 16);
      hst[2 * u + 1] = dec * hst[2 * u + 1] + __uint_as_float(sw[u] & 0xffff0000u);
    }
  }
}

__device__ void ssd_out_unit(const Params& p, int unit, unsigned char* lds) {
  const int tid = threadIdx.x, wid = __builtin_amdgcn_readfirstlane(tid >> 6), lane = tid & 63;
  const int fr = lane & 15, fq = lane >> 4;
  const int g = unit & 1, bc = unit >> 1, c = bc & 15, b = bc >> 4;
  const int row0 = b * L + c * 128;
  unsigned char* CS = lds;
  unsigned char* ML = lds + 34816;
  unsigned char* XT = lds + 69632;
  unsigned char* ZT = lds + 87040;
  unsigned char* HS = lds + 104448;
  float* CUM = (float*)(lds + 121856);
  float* DTL = (float*)(lds + 125952);
  ssd_stage_nat(p, row0, COL_XBC + 768 + g * 128, 768 + g * 128, CS);
  ssd_stage_nat(p, row0, COL_XBC + 512 + g * 128, 512 + g * 128, ML);
  for (int e = tid; e < 1024; e += NTHR) {
    const int it = e >> 7, l = e & 127, dir = it >> 2, hh = it & 3;
    CUM[e] = p.ACUM[(size_t)(b * 16 + dir * 8 + g * 4 + hh) * L + c * 128 + l];
    DTL[e] = softplus_f(p.DT[(size_t)(row0 + l) * 16 + dir * 8 + g * 4 + hh]);
  }
  __syncthreads();
  hf32x4 cbt[8];
#pragma unroll
  for (int lt = 0; lt < 8; ++lt) cbt[lt] = (hf32x4){0.f, 0.f, 0.f, 0.f};
#pragma unroll
  for (int kk = 0; kk < 4; ++kk) {
    const hbf16x8 Af = *(const hbf16x8*)(ML + (16 * wid + fr) * SROW + 2 * (32 * kk + 8 * fq));
#pragma unroll
    for (int lt = 0; lt < 8; ++lt) {
      const hbf16x8 Bf = *(const hbf16x8*)(CS + (16 * lt + fr) * SROW + 2 * (32 * kk + 8 * fq));
      cbt[lt] = __builtin_amdgcn_mfma_f32_16x16x32_bf16(Af, Bf, cbt[lt], 0, 0, 0);
    }
  }
  __syncthreads();
  hf32x4 y[4][4];
#pragma unroll
  for (int hh = 0; hh < 4; ++hh)
#pragma unroll
    for (int pt = 0; pt < 4; ++pt) y[hh][pt] = (hf32x4){0.f, 0.f, 0.f, 0.f};
  const int sb = 16 * wid + 4 * fq;
  uint4 hsa0, hsa1, hsb0, hsb1;
  {
    const bf16_t* slotA = p.HIN + ((size_t)(((b * 2 + 0) * 8 + g * 4) * 16 + c)) * 8192;
    const bf16_t* slotB = p.HIN + ((size_t)(((b * 2 + 1) * 8 + g * 4) * 16 + (15 - c))) * 8192;
    hsa0 = *(const uint4*)(slotA + (tid >> 4) * 128 + (tid & 15) * 8);
    hsa1 = *(const uint4*)(slotA + ((tid >> 4) + 32) * 128 + (tid & 15) * 8);
    hsb0 = *(const uint4*)(slotB + (tid >> 4) * 128 + (tid & 15) * 8);
    hsb1 = *(const uint4*)(slotB + ((tid >> 4) + 32) * 128 + (tid & 15) * 8);
  }
#pragma unroll 1
  for (int hh = 0; hh < 4; ++hh) {
    const int h = g * 4 + hh;
    hf32x4 yc[4];
#pragma unroll
    for (int pt = 0; pt < 4; ++pt) yc[pt] = (hf32x4){0.f, 0.f, 0.f, 0.f};
    ssd_stage_tr_s(p, row0, false, COL_XBC + g * 256 + hh * 64, g * 256 + hh * 64, 64, XT);
    ssd_stage_tr_s(p, row0, false, COL_Z + g * 256 + hh * 64, -1, 64, ZT);
#pragma unroll 1
    for (int dir = 0; dir < 2; ++dir) {
      const int it = dir * 4 + hh;
      const int k = dir ? (17 - c) : (c + 2);
      (void)k;
      {
        const int nh = (hh < 3) ? (h + 1) : h;
        const int nk = dir ? (17 - c) : (c + 2);
        const bf16_t* nslot = p.HIN + ((size_t)(((b * 2 + dir) * 8 + nh) * 16 + (nk - 2))) * 8192;
        const uint4 c0 = dir ? hsb0 : hsa0, c1 = dir ? hsb1 : hsa1;
        *(uint4*)(HS + (tid >> 4) * SROW + (tid & 15) * 16) = c0;
        *(uint4*)(HS + ((tid >> 4) + 32) * SROW + (tid & 15) * 16) = c1;
        const uint4 t0 = *(const uint4*)(nslot + (tid >> 4) * 128 + (tid & 15) * 8);
        const uint4 t1 = *(const uint4*)(nslot + ((tid >> 4) + 32) * 128 + (tid & 15) * 8);
        if (dir == 0) { hsa0 = t0; hsa1 = t1; } else { hsb0 = t0; hsb1 = t1; }
      }
      {
        const float* cu = CUM + it * 128; const float* dl = DTL + it * 128;
        float cs[4], ds[4];
#pragma unroll
        for (int r = 0; r < 4; ++r) { cs[r] = cu[sb + r]; ds[r] = dl[sb + r]; }
#pragma unroll
        for (int lt = 0; lt < 8; ++lt) {
          const int l = 16 * lt + fr;
          const float cl = cu[l];
          float m[4];
#pragma unroll
          for (int r = 0; r < 4; ++r) {
            const int sidx = sb + r;
            const bool ok = dir ? (sidx >= l) : (sidx <= l);
            m[r] = ok ? cbt[lt][r] * __expf(cl - cs[r]) * ds[r] : 0.f;
          }
          uint2 w; w.x = cvt_pk_bf16(m[0], m[1]); w.y = cvt_pk_bf16(m[2], m[3]);
          *(uint2*)(ML + l * SROW + 2 * sb) = w;
        }
      }
      __syncthreads();
      {
        hf32x4 ad[4];
#pragma unroll
        for (int pt = 0; pt < 4; ++pt) ad[pt] = (hf32x4){0.f, 0.f, 0.f, 0.f};
#pragma unroll
        for (int kk = 0; kk < 4; ++kk) {
          const hbf16x8 Am = *(const hbf16x8*)(ML + (16 * wid + fr) * SROW + 2 * (32 * kk + 8 * fq));
#pragma unroll
          for (int pt = 0; pt < 4; ++pt) {
            const hbf16x8 Bx = *(const hbf16x8*)(XT + (16 * pt + fr) * SROW + 2 * (32 * kk + 8 * fq));
            ad[pt] = __builtin_amdgcn_mfma_f32_16x16x32_bf16(Am, Bx, ad[pt], 0, 0, 0);
          }
        }
#pragma unroll
        for (int pt = 0; pt < 4; ++pt) yc[pt] += ad[pt];
      }
      {
        hf32x4 ao[4];
#pragma unroll
        for (int pt = 0; pt < 4; ++pt) ao[pt] = (hf32x4){0.f, 0.f, 0.f, 0.f};
#pragma unroll
        for (int kk = 0; kk < 4; ++kk) {
          const hbf16x8 Ac = *(const hbf16x8*)(CS + (16 * wid + fr) * SROW + 2 * (32 * kk + 8 * fq));
#pragma unroll
          for (int pt = 0; pt < 4; ++pt) {
            const hbf16x8 Bh = *(const hbf16x8*)(HS + (16 * pt + fr) * SROW + 2 * (32 * kk + 8 * fq));
            ao[pt] = __builtin_amdgcn_mfma_f32_16x16x32_bf16(Ac, Bh, ao[pt], 0, 0, 0);
          }
        }
        const float* cu = CUM + it * 128;
        float ex[4];
#pragma unroll
        for (int r = 0; r < 4; ++r) ex[r] = __expf(cu[sb + r]);
#pragma unroll
        for (int pt = 0; pt < 4; ++pt)
#pragma unroll
          for (int r = 0; r < 4; ++r) yc[pt][r] += ex[r] * ao[pt][r];
      }
      __syncthreads();
    }
    {
      const float dsk = p.ssd_d[h];
#pragma unroll
      for (int pt = 0; pt < 4; ++pt) {
        const uint2 xv = *(const uint2*)(XT + (16 * pt + fr) * SROW + 2 * sb);
        const uint2 zv = *(const uint2*)(ZT + (16 * pt + fr) * SROW + 2 * sb);
        const float xs4[4] = {__uint_as_float(xv.x << 16), __uint_as_float(xv.x & 0xffff0000u), __uint_as_float(xv.y << 16), __uint_as_float(xv.y & 0xffff0000u)};
        const float zs4[4] = {__uint_as_float(zv.x << 16), __uint_as_float(zv.x & 0xffff0000u), __uint_as_float(zv.y << 16), __uint_as_float(zv.y & 0xffff0000u)};
#pragma unroll
        for (int r = 0; r < 4; ++r) yc[pt][r] = (yc[pt][r] + dsk * xs4[r]) * silu_f(zs4[r]);
      }
    }
    if (hh == 0) {
#pragma unroll
      for (int pt = 0; pt < 4; ++pt) y[0][pt] = yc[pt];
    } else if (hh == 1) {
#pragma unroll
      for (int pt = 0; pt < 4; ++pt) y[1][pt] = yc[pt];
    } else if (hh == 2) {
#pragma unroll
      for (int pt = 0; pt < 4; ++pt) y[2][pt] = yc[pt];
    } else {
#pragma unroll
      for (int pt = 0; pt < 4; ++pt) y[3][pt] = yc[pt];
    }
    __syncthreads();
  }
  float rinv[4];
#pragma unroll
  for (int r = 0; r < 4; ++r) {
    float ss = 0.f;
#pragma unroll
    for (int hh = 0; hh < 4; ++hh)
#pragma unroll
      for (int pt = 0; pt < 4; ++pt) ss += y[hh][pt][r] * y[hh][pt][r];
    ss += __shfl_xor(ss, 1); ss += __shfl_xor(ss, 2); ss += __shfl_xor(ss, 4); ss += __shfl_xor(ss, 8);
    rinv[r] = rsqrtf(ss * (1.f / 256.f) + EPS);
  }
  {
    bf16_t* OT = (bf16_t*)lds;
#pragma unroll
    for (int hh = 0; hh < 4; ++hh)
#pragma unroll
      for (int pt = 0; pt < 4; ++pt) {
        const int chl = hh * 64 + 16 * pt + fr;
        const float ng = p.ssd_norm_g[g * 256 + chl];
#pragma unroll
        for (int r = 0; r < 4; ++r) OT[(sb + r) * 264 + chl] = f2bf(y[hh][pt][r] * rinv[r] * ng);
      }
    __syncthreads();
    for (int e = tid; e < 128 * 32; e += NTHR) {
      const int l = e >> 5, ch8 = (e & 31) * 8;
      *(uint4*)(p.YMIXb + (size_t)(row0 + l) * D + 512 + g * 256 + ch8) = *(const uint4*)(OT + l * 264 + ch8);
    }
  }
}

__device__ void ph_router(const Params& p, unsigned char* lds) {
  const int tid = threadIdx.x, wid = __builtin_amdgcn_readfirstlane(tid >> 6), lane = tid & 63;
  const int fr = lane & 15, fq = lane >> 4;
  constexpr int AROW = 272;
  unsigned char* AH = lds;
  unsigned char* AL = lds + 64 * AROW;
  unsigned char* WH = lds + 128 * AROW;
  unsigned char* WL = lds + 224 * AROW;
  float* RS = (float*)(lds + 320 * AROW);
  float* LOG = RS + 64;
  float* GM = LOG + 6400;
  float* SH = GM + 1024;
  int* LC = (int*)(SH + 1024);
  int* LB = LC + 64;
  for (int tile = blockIdx.x; tile < T / 64; tile += gridDim.x) {
    const int row0 = tile * 64;
    const float* shp = p.MOD + (row0 / L) * 6144 + 3072;
    const float* scp = shp + 1024;
    if (tid < 64) {
      const float4* sp = (const float4*)(p.SSQP + (size_t)(row0 + tid) * 16);
      const float4 a0 = sp[0], a1 = sp[1], a2 = sp[2], a3 = sp[3];
      const float ss = ((a0.x + a0.y) + (a0.z + a0.w)) + ((a1.x + a1.y) + (a1.z + a1.w)) + ((a2.x + a2.y) + (a2.z + a2.w)) + ((a3.x + a3.y) + (a3.z + a3.w));
      RS[tid] = rsqrtf(ss * (1.f / D) + EPS);
    }
    for (int e = tid; e < 256; e += NTHR) {
      const float4 g = *(const float4*)(p.g2 + e * 4), s4 = *(const float4*)(scp + e * 4), h4 = *(const float4*)(shp + e * 4);
      *(float4*)(GM + e * 4) = make_float4(g.x * (1.f + s4.x), g.y * (1.f + s4.y), g.z * (1.f + s4.z), g.w * (1.f + s4.w));
      *(float4*)(SH + e * 4) = h4;
    }
    float4 xv[4];
#pragma unroll
    for (int i = 0; i < 4; ++i) { const int e = tid + i * NTHR; xv[i] = *(const float4*)(p.X1 + (size_t)(row0 + (e >> 5)) * D + (e & 31) * 4); }
    const int wj = tid >> 4, wch = tid & 15;
    uint4 wh0, wh1, wh2, wl0, wl1, wl2;
#define RT_LOADW(kn) do { \
      wh0 = *(const uint4*)(p.WRhi + (size_t)(wj) * 1024 + (kn) * 128 + wch * 8); wl0 = *(const uint4*)(p.WRlo + (size_t)(wj) * 1024 + (kn) * 128 + wch * 8); \
      wh1 = *(const uint4*)(p.WRhi + (size_t)(wj + 32) * 1024 + (kn) * 128 + wch * 8); wl1 = *(const uint4*)(p.WRlo + (size_t)(wj + 32) * 1024 + (kn) * 128 + wch * 8); \
      wh2 = *(const uint4*)(p.WRhi + (size_t)(wj + 64) * 1024 + (kn) * 128 + wch * 8); wl2 = *(const uint4*)(p.WRlo + (size_t)(wj + 64) * 1024 + (kn) * 128 + wch * 8); } while (0)
    RT_LOADW(0);
    __syncthreads();
    hf32x4 acc[3];
#pragma unroll
    for (int nt = 0; nt < 3; ++nt) acc[nt] = (hf32x4){0.f, 0.f, 0.f, 0.f};
    const int mt = wid & 3, nh = wid >> 2;
#pragma unroll 1
    for (int kc = 0; kc < 8; ++kc) {
#pragma unroll
      for (int i = 0; i < 4; ++i) {
        const int e = tid + i * NTHR; const int tok = e >> 5, k4 = (e & 31) * 4;
        const int kg = kc * 128 + k4;
        const float4 v = xv[i];
        const float4 g = *(const float4*)(GM + kg);
        const float4 h4 = *(const float4*)(SH + kg);
        const float rstd = RS[tok];
        const float h0 = v.x * rstd * g.x + h4.x, h1 = v.y * rstd * g.y + h4.y;
        const float h2 = v.z * rstd * g.z + h4.z, h3 = v.w * rstd * g.w + h4.w;
        const unsigned hi01 = cvt_pk_bf16(h0, h1), hi23 = cvt_pk_bf16(h2, h3);
        const unsigned lo01 = cvt_pk_bf16(h0 - __uint_as_float(hi01 << 16), h1 - __uint_as_float(hi01 & 0xffff0000u));
        const unsigned lo23 = cvt_pk_bf16(h2 - __uint_as_float(hi23 << 16), h3 - __uint_as_float(hi23 & 0xffff0000u));
        *(uint2*)(AH + tok * AROW + k4 * 2) = make_uint2(hi01, hi23);
        *(uint2*)(AL + tok * AROW + k4 * 2) = make_uint2(lo01, lo23);
        *(uint2*)(p.H2b + (size_t)(row0 + tok) * D + kg) = make_uint2(hi01, hi23);
      }
      *(uint4*)(WH + wj * AROW + wch * 16) = wh0; *(uint4*)(WL + wj * AROW + wch * 16) = wl0;
      *(uint4*)(WH + (wj + 32) * AROW + wch * 16) = wh1; *(uint4*)(WL + (wj + 32) * AROW + wch * 16) = wl1;
      *(uint4*)(WH + (wj + 64) * AROW + wch * 16) = wh2; *(uint4*)(WL + (wj + 64) * AROW + wch * 16) = wl2;
      {
        const int kn = (kc + 1 < 8) ? (kc + 1) : kc;
#pragma unroll
        for (int i = 0; i < 4; ++i) { const int e = tid + i * NTHR; xv[i] = *(const float4*)(p.X1 + (size_t)(row0 + (e >> 5)) * D + kn * 128 + (e & 31) * 4); }
        RT_LOADW(kn);
      }
      __syncthreads();
#pragma unroll
      for (int kk = 0; kk < 4; ++kk) {
        const hbf16x8 Ahi = *(const hbf16x8*)(AH + (16 * mt + fr) * AROW + 2 * (32 * kk + 8 * fq));
        const hbf16x8 Alo = *(const hbf16x8*)(AL + (16 * mt + fr) * AROW + 2 * (32 * kk + 8 * fq));
#pragma unroll
        for (int nt = 0; nt < 3; ++nt) {
          const int wo = (16 * (nh * 3 + nt) + fr) * AROW + 2 * (32 * kk + 8 * fq);
          const hbf16x8 Bhi = *(const hbf16x8*)(WH + wo);
          const hbf16x8 Blo = *(const hbf16x8*)(WL + wo);
          acc[nt] = __builtin_amdgcn_mfma_f32_16x16x32_bf16(Ahi, Bhi, acc[nt], 0, 0, 0);
          acc[nt] = __builtin_amdgcn_mfma_f32_16x16x32_bf16(Ahi, Blo, acc[nt], 0, 0, 0);
          acc[nt] = __builtin_amdgcn_mfma_f32_16x16x32_bf16(Alo, Bhi, acc[nt], 0, 0, 0);
        }
      }
      __syncthreads();
    }
    if (tid < 64) LC[tid] = 0;
#pragma unroll
    for (int nt = 0; nt < 3; ++nt)
#pragma unroll
      for (int r = 0; r < 4; ++r) LOG[(16 * mt + 4 * fq + r) * 100 + 16 * (nh * 3 + nt) + fr] = acc[nt][r];
    __syncthreads();
    int ea = 0, eb = 0, sa = 0, sb2 = 0;
    if (tid < 64) {
      const float* lg = LOG + tid * 100;
      const int row = row0 + tid;
      int gs = 0; float gm = lg[64] + p.b_group[0];
      float gl[8];
      gl[0] = gm;
#pragma unroll
      for (int j = 1; j < 8; ++j) { gl[j] = lg[64 + j] + p.b_group[j]; if (gl[j] > gm) { gm = gl[j]; gs = j; } }
      float den = 0.f;
#pragma unroll
      for (int j = 0; j < 8; ++j) den += expf(gl[j] - gm);
      const float pg = 1.f / den;
      float el[8];
#pragma unroll
      for (int j = 0; j < 8; ++j) el[j] = 0.f;
      for (int j = 0; j < 8; ++j) el[j] = lg[gs * 8 + j] + p.b_expert[gs * 8 + j];
      int i0 = 0; float l0 = el[0];
#pragma unroll
      for (int j = 1; j < 8; ++j) if (el[j] > l0) { l0 = el[j]; i0 = j; }
      int i1 = -1; float l1 = -3.0e38f;
#pragma unroll
      for (int j = 0; j < 8; ++j) if (j != i0 && el[j] > l1) { l1 = el[j]; i1 = j; }
      const float e1 = expf(l1 - l0);
      const float w0 = 1.f / (1.f + e1), w1 = e1 / (1.f + e1);
      p.GATE[row * 2 + 0] = w0 * pg;
      p.GATE[row * 2 + 1] = w1 * pg;
      ea = gs * 8 + i0; eb = gs * 8 + i1;
      sa = atomicAdd(&LC[ea], 1);
      sb2 = atomicAdd(&LC[eb], 1);
    }
    __syncthreads();
    if (tid < 64) { const int n = LC[tid]; LB[tid] = n ? atomicAdd(&p.CNT[tid * 32], n) : 0; }
    __syncthreads();
    if (tid < 64) {
      const int row = row0 + tid;
      p.LIST[ea * T + LB[ea] + sa] = row * 2 + 0;
      p.LIST[eb * T + LB[eb] + sb2] = row * 2 + 1;
    }
    __syncthreads();
  }
}

__device__ __forceinline__ void moe_table(const Params& p, int* tab) {
  if (threadIdx.x == 0) {
    int a = 0, sg = 0;
    for (int e = 0; e < NE; ++e) {
      int cn = p.CNT[e * 32];
      tab[e] = a; tab[65 + e] = sg; tab[130 + e] = cn;
      a += (cn + 255) >> 8; sg += ((cn + 127) >> 7) << 7;
    }
    tab[NE] = a; tab[65 + NE] = sg;
  }
  __syncthreads();
}

template <bool UP>
__device__ void moe_gemm_phase(const Params& p, unsigned char* lds, const int* tab) {
  constexpr int K = UP ? 1024 : 512;
  constexpr int NKT = K / 32;
  constexpr int LDB = UP ? 512 : 1024;
  const int tid = threadIdx.x, wid = __builtin_amdgcn_readfirstlane(tid >> 6), lane = tid & 63, fr = lane & 15, fq = lane >> 4;
  const int wm = wid >> 1, wn = wid & 1;
  constexpr int AOFF0 = 0, AOFF1 = 16384, BOFF0 = 32768, BOFF1 = 32768 + 256 * 80;
  const int total = tab[64] * 4;
  for (int ui = blockIdx.x; ui < total; ui += gridDim.x) {
    int e = 0;
    while (tab[e + 1] * 4 <= ui) ++e;
    const int local = ui - tab[e] * 4;
    const int mu = local >> 2, nt = local & 3;
    const int cnt = tab[130 + e], seg = tab[65 + e];
    const int rem = cnt - mu * 256;
    const bool full = rem > 128;
    const bool active = full || wm < 2;
    const int srow = tid >> 2, spc = tid & 3;
    unsigned aoffs[2];
#pragma unroll
    for (int i = 0; i < 2; ++i) {
      const int row = srow + 128 * i;
      int idx = mu * 256 + row;
      unsigned rowb;
      if (UP) { if (idx > cnt - 1) idx = cnt - 1; rowb = (unsigned)(p.LIST[e * T + idx] >> 1) * (unsigned)(K * 2); }
      else rowb = (unsigned)(seg + idx) * (unsigned)(K * 2);
      aoffs[i] = rowb + (unsigned)((spc ^ ((row >> 2) & 3)) * 16);
    }
    const char* Abase = UP ? (const char*)p.H2b : (const char*)p.HBb;
    const float* bsrc;
    if (UP) bsrc = ((lane < 32) ? p.w1 : p.w3) + (size_t)e * 1024 * 512 + nt * 128 + 4 * (lane & 31) + (size_t)(4 * wid) * LDB;
    else bsrc = p.w2 + (size_t)e * 512 * 1024 + nt * 256 + 4 * lane + (size_t)(4 * wid) * LDB;
    hf32x4 acc[4][8];
#pragma unroll
    for (int m = 0; m < 4; ++m)
#pragma unroll
      for (int j = 0; j < 8; ++j) acc[m][j] = (hf32x4){0.f, 0.f, 0.f, 0.f};
    uint4 P0a0, P0a1, P1a0, P1a1;
    float4 P0b0, P0b1, P0b2, P0b3, P1b0, P1b1, P1b2, P1b3;
#define MG_LOAD(kt, S) do { \
      S##a0 = *(const uint4*)(Abase + aoffs[0] + (kt) * 64); S##a1 = *(const uint4*)(Abase + aoffs[1] + (kt) * 64); \
      S##b0 = *(const float4*)(bsrc + (size_t)((kt) * 32 + 0) * LDB); S##b1 = *(const float4*)(bsrc + (size_t)((kt) * 32 + 1) * LDB); \
      S##b2 = *(const float4*)(bsrc + (size_t)((kt) * 32 + 2) * LDB); S##b3 = *(const float4*)(bsrc + (size_t)((kt) * 32 + 3) * LDB); } while (0)
#define MG_WRITE(aoff, boff, S) do { \
      *(uint4*)(lds + (aoff) + (srow) * 64 + spc * 16) = S##a0; \
      if (full) *(uint4*)(lds + (aoff) + (srow + 128) * 64 + spc * 16) = S##a1; \
      *(uint2*)(lds + (boff) + (4 * lane + 0) * 80 + 8 * wid) = make_uint2(cvt_pk_bf16(S##b0.x, S##b1.x), cvt_pk_bf16(S##b2.x, S##b3.x)); \
      *(uint2*)(lds + (boff) + (4 * lane + 1) * 80 + 8 * wid) = make_uint2(cvt_pk_bf16(S##b0.y, S##b1.y), cvt_pk_bf16(S##b2.y, S##b3.y)); \
      *(uint2*)(lds + (boff) + (4 * lane + 2) * 80 + 8 * wid) = make_uint2(cvt_pk_bf16(S##b0.z, S##b1.z), cvt_pk_bf16(S##b2.z, S##b3.z)); \
      *(uint2*)(lds + (boff) + (4 * lane + 3) * 80 + 8 * wid) = make_uint2(cvt_pk_bf16(S##b0.w, S##b1.w), cvt_pk_bf16(S##b2.w, S##b3.w)); } while (0)
#define MG_MMA(aoff, boff) do { if (active) { \
      hbf16x8 Af[4]; \
      _Pragma("unroll") for (int m = 0; m < 4; ++m) { const int row = 64 * wm + 16 * m + fr; \
        Af[m] = *(const hbf16x8*)(lds + (aoff) + row * 64 + ((fq ^ ((row >> 2) & 3)) * 16)); } \
      _Pragma("unroll") for (int jh = 0; jh < 2; ++jh) { \
        hbf16x8 Bf[4]; \
        _Pragma("unroll") for (int j4 = 0; j4 < 4; ++j4) { const int j = jh * 4 + j4; \
          const int nrow = UP ? ((j < 4) ? (64 * wn + 16 * j + fr) : (128 + 64 * wn + 16 * (j - 4) + fr)) : (128 * wn + 16 * j + fr); \
          Bf[j4] = *(const hbf16x8*)(lds + (boff) + nrow * 80 + 16 * fq); } \
        _Pragma("unroll") for (int m = 0; m < 4; ++m) _Pragma("unroll") for (int j4 = 0; j4 < 4; ++j4) \
          acc[m][jh * 4 + j4] = __builtin_amdgcn_mfma_f32_16x16x32_bf16(Bf[j4], Af[m], acc[m][jh * 4 + j4], 0, 0, 0); } } } while (0)
    MG_LOAD(0, P0);
    MG_LOAD(1, P1);
    MG_WRITE(AOFF0, BOFF0, P0);
    __syncthreads();
#pragma unroll 1
    for (int kt = 0; kt < NKT; kt += 2) {
      { const int kn = (kt + 2 < NKT) ? (kt + 2) : kt; MG_LOAD(kn, P0); }
      MG_MMA(AOFF0, BOFF0);
      MG_WRITE(AOFF1, BOFF1, P1);
      __syncthreads();
      { const int kn = (kt + 3 < NKT) ? (kt + 3) : (kt + 1); MG_LOAD(kn, P1); }
      MG_MMA(AOFF1, BOFF1);
      MG_WRITE(AOFF0, BOFF0, P0);
      __syncthreads();
    }
#undef MG_LOAD
#undef MG_WRITE
#undef MG_MMA
    if (active) {
#pragma unroll
      for (int m = 0; m < 4; ++m) {
        const int slot = mu * 256 + 64 * wm + 16 * m + fr;
        if (slot < cnt) {
          if (UP) {
            bf16_t* hp = p.HBb + (size_t)(seg + slot) * DE + nt * 128 + 64 * wn + 4 * fq;
#pragma unroll
            for (int j = 0; j < 4; ++j) {
              float h[4];
#pragma unroll
              for (int r = 0; r < 4; ++r) { const float av = acc[m][j][r]; h[r] = av / (1.f + __expf(-av)) * acc[m][j + 4][r]; }
              *(uint2*)(hp + 16 * j) = make_uint2(cvt_pk_bf16(h[0], h[1]), cvt_pk_bf16(h[2], h[3]));
            }
          } else {
            const int pair = p.LIST[e * T + slot];
            const float gt = p.GATE[pair];
            bf16_t* yp = p.YB2b + (size_t)pair * D + nt * 256 + 128 * wn + 4 * fq;
#pragma unroll
            for (int j = 0; j < 8; ++j)
              *(uint2*)(yp + 16 * j) = make_uint2(cvt_pk_bf16(gt * acc[m][j][0], gt * acc[m][j][1]), cvt_pk_bf16(gt * acc[m][j][2], gt * acc[m][j][3]));
          }
        }
      }
    }
  }
}

__device__ void ph_final(const Params& p) {
  const int tid = threadIdx.x, wid = tid >> 6, lane = tid & 63;
  for (int row = blockIdx.x * 8 + wid; row < T; row += gridDim.x * 8) {
    const float* ga2 = p.MOD + (row / L) * 6144 + 5120;
    float4 v[4];
    float ss = 0.f;
#pragma unroll
    for (int i = 0; i < 4; ++i) {
      const int col = i * 256 + lane * 4;
      float4 xv = *(const float4*)(p.X1 + (size_t)row * D + col);
      uint2 a = *(const uint2*)(p.YB2b + (size_t)(row * 2) * D + col);
      uint2 b = *(const uint2*)(p.YB2b + (size_t)(row * 2 + 1) * D + col);
      float4 ga = *(const float4*)(ga2 + col);
      v[i].x = xv.x + ga.x * (__uint_as_float(a.x << 16) + __uint_as_float(b.x << 16));
      v[i].y = xv.y + ga.y * (__uint_as_float(a.x & 0xffff0000u) + __uint_as_float(b.x & 0xffff0000u));
      v[i].z = xv.z + ga.z * (__uint_as_float(a.y << 16) + __uint_as_float(b.y << 16));
      v[i].w = xv.w + ga.w * (__uint_as_float(a.y & 0xffff0000u) + __uint_as_float(b.y & 0xffff0000u));
      ss += v[i].x * v[i].x + v[i].y * v[i].y + v[i].z * v[i].z + v[i].w * v[i].w;
    }
    ss = wave_sum(ss);
    const float rstd = rsqrtf(ss * (1.f / D) + EPS);
#pragma unroll
    for (int i = 0; i < 4; ++i) {
      const int col = i * 256 + lane * 4;
      float4 gf = *(const float4*)(p.g_final + col);
      float4 o;
      o.x = v[i].x * rstd * gf.x; o.y = v[i].y * rstd * gf.y; o.z = v[i].z * rstd * gf.z; o.w = v[i].w * rstd * gf.w;
      *(float4*)(p.out + (size_t)row * D + col) = o;
    }
  }
}

constexpr int NPHASE = 11;

__global__ void __launch_bounds__(NTHR, 2) mega(Params p) {
  extern __shared__ __attribute__((aligned(16))) unsigned char lds_raw[];
  float* sm = (float*)lds_raw;
  PG8_LAS unsigned char* lds = (PG8_LAS unsigned char*)lds_raw;
  const int lo = p.lo, hi = p.hi;
  volatile LAS unsigned* xbst = (volatile LAS unsigned*)(lds + pg8::STAGE_BYTES + 2048);
  if (threadIdx.x < 4) xbst[threadIdx.x] = 0u;
  __syncthreads();
  XcdBarrier xbar; xbar.bar = p.BAR; xbar.x = 0; xbar.st = xbst;
  if (hi - lo > 1) xbar = xcd_barrier_post(p.BAR, xbst);
#define IN(k) (lo <= (k) && (k) < hi)
#define SYNC(k) do { if (IN(k) && IN((k) + 1)) xcd_barrier(xbar); } while (0)
#ifndef DUPK
#define DUPK -1
#endif
#ifndef SKIP_OTHER
  if (IN(0)) { ph_adaln(p, sm); ph_filters(p, sm); ph_wcvt(p, sm); }
#if DUPK == 0
  xcd_barrier(xbar);
  if (IN(0)) { ph_adaln(p, sm); ph_filters(p, sm); ph_wcvt(p, sm); }
#endif
  SYNC(0);
  if (IN(1)) ph_norm1(p);
#if DUPK == 1
  xcd_barrier(xbar);
  if (IN(1)) ph_norm1(p);
#endif
  SYNC(1);
#endif
#ifndef SKIP_GEMM
  if (IN(2)) {
    pg8::DenseOrder S{p.XNb, p.WinT, TT / 256, DP / 256 + 1, D, (int)gridDim.x, (int)blockIdx.x};
    pg8::EpiBf16 E{p.PXb, DP, p.DT, p.dt_bias};
    pg8::gemm_phase<pg8::EpiBf16, pg8::DenseOrder>(lds, D, S, E);
  }
#if DUPK == 2
  xcd_barrier(xbar);
  if (IN(2)) {
    pg8::DenseOrder S{p.XNb, p.WinT, TT / 256, DP / 256 + 1, D, (int)gridDim.x, (int)blockIdx.x};
    pg8::EpiBf16 E{p.PXb, DP, p.DT, p.dt_bias};
    pg8::gemm_phase<pg8::EpiBf16, pg8::DenseOrder>(lds, D, S, E);
  }
#endif
  SYNC(2);
#endif
#ifndef SKIP_OTHER
  if (IN(3)) {
    ph_hy_convT(p, sm);
    for (int it = blockIdx.x; it < 288; it += gridDim.x) ssd_states_unit(p, it, lds_raw);
  }
#if DUPK == 3
  xcd_barrier(xbar);
  if (IN(3)) {
    ph_hy_convT(p, sm);
    for (int it = blockIdx.x; it < 288; it += gridDim.x) ssd_states_unit(p, it, lds_raw);
  }
#endif
  SYNC(3);
  if (IN(4)) {
    for (int it = blockIdx.x; it < 256; it += gridDim.x) ssd_scan_unit(p, it);
    hyena_block(p, lds_raw);
  }
#if DUPK == 4
  xcd_barrier(xbar);
  if (IN(4)) {
    for (int it = blockIdx.x; it < 256; it += gridDim.x) ssd_scan_unit(p, it);
    hyena_block(p, lds_raw);
  }
#endif
  SYNC(4);
  if (IN(5)) {
    for (int it = blockIdx.x; it < 256; it += gridDim.x) { ssd_out_unit(p, it, lds_raw); __syncthreads(); }
    ph_hy_backT(p, sm);
  }
#if DUPK == 5
  xcd_barrier(xbar);
  if (IN(5)) {
    for (int it = blockIdx.x; it < 256; it += gridDim.x) { ssd_out_unit(p, it, lds_raw); __syncthreads(); }
    ph_hy_backT(p, sm);
  }
#endif
  SYNC(5);
#endif
#ifndef SKIP_GEMM
  if (IN(6)) {
    pg8::DenseOrder S{p.YMIXb, p.WoutT, T / 256, D / 256, D, (int)gridDim.x, (int)blockIdx.x};
    pg8::EpiX1 E{p.x, p.MOD, p.X1, p.SSQP};
    pg8::gemm_phase<pg8::EpiX1, pg8::DenseOrder>(lds, D, S, E);
  }
#if DUPK == 6
  xcd_barrier(xbar);
  if (IN(6)) {
    pg8::DenseOrder S{p.YMIXb, p.WoutT, T / 256, D / 256, D, (int)gridDim.x, (int)blockIdx.x};
    pg8::EpiX1 E{p.x, p.MOD, p.X1, p.SSQP};
    pg8::gemm_phase<pg8::EpiX1, pg8::DenseOrder>(lds, D, S, E);
  }
#endif
  SYNC(6);
#endif
#ifndef SKIP_OTHER
  if (IN(7)) ph_router(p, lds_raw);
#if DUPK == 7
  xcd_barrier(xbar);
  if (IN(7)) ph_router(p, lds_raw);
#endif
  SYNC(7);
#endif
#ifndef SKIP_GEMM
  if (IN(8)) {
    int* tab = (int*)(lds_raw + pg8::STAGE_BYTES);
    moe_table(p, tab);
    moe_gemm_phase<true>(p, lds_raw, tab);
  }
#if DUPK == 8
  xcd_barrier(xbar);
  if (IN(8)) {
    int* tab = (int*)(lds_raw + pg8::STAGE_BYTES);
    moe_table(p, tab);
    moe_gemm_phase<true>(p, lds_raw, tab);
  }
#endif
  SYNC(8);
  if (IN(9)) {
    int* tab = (int*)(lds_raw + pg8::STAGE_BYTES);
    moe_table(p, tab);
    moe_gemm_phase<false>(p, lds_raw, tab);
  }
#if DUPK == 9
  xcd_barrier(xbar);
  if (IN(9)) {
    int* tab = (int*)(lds_raw + pg8::STAGE_BYTES);
    moe_table(p, tab);
    moe_gemm_phase<false>(p, lds_raw, tab);
  }
#endif
  SYNC(9);
#endif
#ifndef SKIP_OTHER
  if (IN(10)) ph_final(p);
#if DUPK == 10
  xcd_barrier(xbar);
  if (IN(10)) ph_final(p);
#endif
#endif
#undef IN
#undef SYNC
}

extern "C" void kernel_launch(void* const* d_in, const int* in_sizes, int n_in, void* d_out, int out_size,
                              void* d_ws, size_t ws_size, hipStream_t stream) {
  Params p{};
  const float* const* in = (const float* const*)d_in;
  p.x = in[0]; p.c = in[1]; p.ctx = in[2]; p.c_ctx = in[3]; p.w_ada = in[4]; p.b_ada = in[5];
  p.g1 = in[6]; p.g2 = in[7]; p.w_in = in[8]; p.hy_conv_w = in[9]; p.hy_conv_b = in[10];
  p.f_w1 = in[11]; p.f_b1 = in[12]; p.f_freq = in[13]; p.f_w2 = in[14]; p.f_b2 = in[15]; p.f_w3 = in[16];
  p.hy_bias = in[17]; p.ssd_conv_w = in[18]; p.ssd_conv_b = in[19]; p.a_log = in[20]; p.dt_bias = in[21];
  p.ssd_d = in[22]; p.ssd_norm_g = in[23]; p.w_out = in[24]; p.w_group = in[25]; p.b_group = in[26];
  p.w_expert = in[27]; p.b_expert = in[28]; p.w1 = in[29]; p.w3 = in[30]; p.w2 = in[31]; p.g_final = in[32];
  p.out = (float*)d_out;

  char* ws = (char*)d_ws;
  size_t off = 0;
  auto take = [&](size_t bytes) { char* r = ws + off; off += (bytes + 255) & ~(size_t)255; return r; };
  p.BAR = (unsigned*)take((size_t)XCD_BAR_WORDS * 4);
  p.MOD = (float*)take((size_t)9 * 6144 * 4);
  p.CNT = (int*)take(NE * 32 * 4);
  p.GATE = (float*)take((size_t)T * 2 * 4);
  p.LIST = (int*)take((size_t)NE * T * 4);
  p.DT = (float*)take((size_t)TT * 16 * 4);
  p.ACUM = (float*)take((size_t)T * 16 * 4);
  p.SSQP = (float*)take((size_t)T * 16 * 4);
  p.CDEC = (float*)take((size_t)128 * 18 * 32 * 4);
  p.FILTt = (bf16_t*)take((size_t)1024 * FLEN * 2);
  p.WRhi = (bf16_t*)take((size_t)96 * 1024 * 2);
  p.WRlo = (bf16_t*)take((size_t)96 * 1024 * 2);
  p.WinT = (bf16_t*)take((size_t)(DP + 256) * D * 2);
  p.WoutT = (bf16_t*)take((size_t)D * D * 2);
  char* rPX = take((size_t)TT * DP * 2);
  char* rXBC = take((size_t)128 * 18 * 8192 * 2);
  char* rYF = take((size_t)T * DS * 4);
  char* rZ1 = take((size_t)HYC * T * 2);
  char* rYB = take((size_t)T * DS * 4);
  char* rYM = take((size_t)T * D * 2);
  p.PXb = (bf16_t*)rPX; p.SST = (bf16_t*)rXBC; p.Ut = (bf16_t*)rZ1; p.YMIXb = (bf16_t*)rYM;
  p.HIN = (bf16_t*)rYF;
  p.Yt = (bf16_t*)rYB;
  p.XNb = (bf16_t*)rZ1;
  p.X1 = (float*)rPX;
  p.H2b = (bf16_t*)rYM;
  p.HBb = (bf16_t*)(rPX + (size_t)T * D * 4);
  p.YB2b = (bf16_t*)rZ1;
  if (off > ws_size) { fprintf(stderr, "workspace too small: need %zu have %zu\n", off, ws_size); return; }

  static int grid_blocks = 0;
  if (!grid_blocks) {
    int dev = 0, cus = 0, per_cu = 0;
    (void)hipGetDevice(&dev);
    (void)hipDeviceGetAttribute(&cus, hipDeviceAttributeMultiprocessorCount, dev);
    (void)hipFuncSetAttribute((const void*)mega, hipFuncAttributeMaxDynamicSharedMemorySize, LDS_BYTES);
    (void)hipOccupancyMaxActiveBlocksPerMultiprocessor(&per_cu, mega, NTHR, LDS_BYTES);
    if (per_cu < 1) { fprintf(stderr, "occupancy query returned %d\n", per_cu); per_cu = 1; }
    grid_blocks = cus;
  }
#ifndef ONE_LAUNCH
  for (int ph = 0; ph < NPHASE; ++ph) {
    p.lo = ph; p.hi = ph + 1;
    hipLaunchKernelGGL(mega, dim3(grid_blocks), dim3(NTHR), LDS_BYTES, stream, p);
  }
#else
  p.lo = 0; p.hi = NPHASE;
  (void)hipMemsetAsync(p.BAR, 0, (size_t)XCD_BAR_WORDS * 4, stream);
  void* args[] = {&p};
  hipError_t e = hipLaunchCooperativeKernel((void*)mega, dim3(grid_blocks), dim3(NTHR), args, LDS_BYTES, stream);
  if (e != hipSuccess) fprintf(stderr, "cooperative launch failed: %s (grid %d)\n", hipGetErrorString(e), grid_blocks);
#endif
}
```

```cpp
#define ONE_LAUNCH 1
#include <hip/hip_runtime.h>
#include <hip/hip_cooperative_groups.h>
#include <cstdio>
#include <cstdint>
namespace cg = cooperative_groups;

constexpr int D = 1024, NB = 8, L = 2048, LC = 256;
constexpr int T = NB * L;
constexpr int TC = NB * LC;
constexpr int TT = T + TC;
constexpr int DH = 512, HYC = 1536, DS = 512, DXBC = 1024, DIN = 3088, DP = 3072;
constexpr int COL_Z = 1536, COL_XBC = 2048, COL_DT = 3072;
constexpr int NE = 64, DE = 512;
constexpr float EPS = 1e-6f;
constexpr int NTHR = 512;
constexpr int LDS_BYTES = 132 * 1024;
constexpr int FLEN = 4232, HX0 = 2112, FCLEN = 4240, ZSTRB = 4240;

typedef unsigned short bf16_t;

struct Params {
  const float *x, *c, *ctx, *c_ctx, *w_ada, *b_ada, *g1, *g2, *w_in, *hy_conv_w, *hy_conv_b;
  const float *f_w1, *f_b1, *f_freq, *f_w2, *f_b2, *f_w3, *hy_bias;
  const float *ssd_conv_w, *ssd_conv_b, *a_log, *dt_bias, *ssd_d, *ssd_norm_g, *w_out;
  const float *w_group, *b_group, *w_expert, *b_expert, *w1, *w3, *w2, *g_final;
  float* out;
  float *MOD, *DT, *X1, *GATE, *ACUM, *CDEC, *SSQP;
  bf16_t *WRhi, *WRlo, *FILTt, *Ut, *Yt, *HIN, *XNb, *WinT, *WoutT, *PXb, *SST, *YMIXb, *YB2b, *H2b, *HBb;
  int *CNT, *LIST;
  unsigned* BAR;
  int lo, hi;
};

__device__ __forceinline__ float silu_f(float v) { return v / (1.f + __expf(-v)); }
__device__ __forceinline__ float softplus_f(float v) { return v > 20.f ? v : log1pf(expf(v)); }
__device__ __forceinline__ float bf2f(bf16_t v) { return __uint_as_float(((unsigned)v) << 16); }
__device__ __forceinline__ unsigned cvt_pk_bf16(float lo, float hi) {
  typedef __bf16 bf2_t __attribute__((ext_vector_type(2)));
  typedef float f2_t __attribute__((ext_vector_type(2)));
  const f2_t v = {lo, hi};
  const bf2_t r = __builtin_convertvector(v, bf2_t);
  return __builtin_bit_cast(unsigned, r);
}
__device__ __forceinline__ bf16_t f2bf(float f) { return (bf16_t)(cvt_pk_bf16(f, 0.f) & 0xffffu); }
__device__ __forceinline__ void st_agent64(void* p, unsigned lo, unsigned hi) {
  __hip_atomic_store((unsigned long long*)p, ((unsigned long long)hi << 32) | lo, __ATOMIC_RELAXED, __HIP_MEMORY_SCOPE_AGENT);
}
__device__ __forceinline__ uint2 ld_agent64(const void* p) {
  const unsigned long long v = __hip_atomic_load((const unsigned long long*)p, __ATOMIC_RELAXED, __HIP_MEMORY_SCOPE_AGENT);
  return make_uint2((unsigned)v, (unsigned)(v >> 32));
}
__device__ __forceinline__ void st_agent32(float* p, float v) { __hip_atomic_store(p, v, __ATOMIC_RELAXED, __HIP_MEMORY_SCOPE_AGENT); }
__device__ __forceinline__ float ld_agent32(const float* p) { return __hip_atomic_load(p, __ATOMIC_RELAXED, __HIP_MEMORY_SCOPE_AGENT); }
__device__ __forceinline__ float wave_sum(float v) {
#pragma unroll
  for (int o = 32; o > 0; o >>= 1) v += __shfl_xor(v, o);
  return v;
}


#define XB_TMO      128
#define XB_XCNT(j)  (256  + 64 * (j))
#define XB_XSUB(j)  (1280 + 64 * (j))
#define XB_XGEN(j)  (2304 + 64 * (j))
#define XB_TOP      3328
#define XB_TOPGEN   3392
#define XCD_BAR_WORDS 3456
#define XB_SPIN_CAP (1u << 18)
#define LAS __attribute__((address_space(3)))
__device__ __forceinline__ unsigned xb_ld(unsigned* p) { return __hip_atomic_load(p, __ATOMIC_RELAXED, __HIP_MEMORY_SCOPE_AGENT); }
__device__ __forceinline__ unsigned xb_add(unsigned* p, unsigned v) { return __hip_atomic_fetch_add(p, v, __ATOMIC_RELAXED, __HIP_MEMORY_SCOPE_AGENT); }
__device__ __forceinline__ unsigned xb_xcc_id() { return (unsigned)__builtin_amdgcn_s_getreg((3 << 11) | 20) & 0xFu; }
#define XB_SPIN(cond, bar) do { unsigned _sp = 0; while (cond) { __builtin_amdgcn_s_sleep(1); \
    if ((++_sp & 255u) == 0u) { if (xb_ld(&(bar)[XB_TMO])) break; if (_sp > XB_SPIN_CAP) { atomicAdd(&(bar)[XB_TMO], 1u); break; } } } } while (0)
struct XcdBarrier { unsigned* bar; unsigned x; volatile LAS unsigned* st; };
__device__ __forceinline__ XcdBarrier xcd_barrier_post(unsigned* bar, volatile LAS unsigned* st) {
  XcdBarrier b; b.bar = bar; b.x = xb_xcc_id(); b.st = st;
  if (threadIdx.x == 0) (void)xb_add(&bar[XB_XCNT(b.x)], 1u);
  return b;
}
__device__ __forceinline__ void xcd_barrier_complete(unsigned* bar, unsigned x, unsigned& nloc, unsigned& nx) {
  const unsigned G = gridDim.x * gridDim.y * gridDim.z;
  unsigned sum, cnt, mine, sp = 0u;
  for (;;) {
    sum = 0u; cnt = 0u; mine = 0u;
#pragma unroll
    for (unsigned j = 0; j < 16; ++j) { const unsigned c = xb_ld(&bar[XB_XCNT(j)]); sum += c; cnt += (c > 0u) ? 1u : 0u; mine = (j == x) ? c : mine; }
    if (sum == G) break;
    __builtin_amdgcn_s_sleep(1);
    if ((++sp & 255u) == 0u) { if (xb_ld(&bar[XB_TMO])) break; if (sp > XB_SPIN_CAP) { atomicAdd(&bar[XB_TMO], 1u); break; } }
  }
  nloc = mine > 0u ? mine : 1u; nx = cnt > 0u ? cnt : 1u;
}
__device__ __forceinline__ void xcd_barrier(const XcdBarrier& b) {
  asm volatile("s_waitcnt vmcnt(0)" ::: "memory");
  __syncthreads();
  if (threadIdx.x == 0) {
    unsigned* bar = b.bar;
    __builtin_amdgcn_s_waitcnt(0);
    unsigned nloc = b.st[0], nx = b.st[1];
    if (nloc == 0u) { xcd_barrier_complete(bar, b.x, nloc, nx); b.st[0] = nloc; b.st[1] = nx; }
    const unsigned old = xb_add(&bar[XB_XSUB(b.x)], 1u);
    const unsigned gen = old / nloc;
    if (old + 1u == (gen + 1u) * nloc) {
      __builtin_amdgcn_fence(__ATOMIC_RELEASE, "agent");
      asm volatile("s_waitcnt vmcnt(0)" ::: "memory");
      const unsigned og = xb_add(&bar[XB_TOP], 1u);
      const unsigned tg = og / nx;
      if (og + 1u == (tg + 1u) * nx) xb_add(&bar[XB_TOPGEN], 1u);
      else XB_SPIN(xb_ld(&bar[XB_TOPGEN]) == tg, bar);
      __builtin_amdgcn_fence(__ATOMIC_ACQUIRE, "agent");
      xb_add(&bar[XB_XGEN(b.x)], 1u);
      asm volatile("s_waitcnt vmcnt(0)" ::: "memory");
    } else {
      XB_SPIN(xb_ld(&bar[XB_XGEN(b.x)]) == gen, bar);
      __builtin_amdgcn_fence(__ATOMIC_ACQUIRE, "agent");
      asm volatile("s_waitcnt vmcnt(0)" ::: "memory");
    }
  }
  __syncthreads();
}

namespace pg8 {
#define PG8_LAS __attribute__((address_space(3)))
typedef short bf16x8 __attribute__((ext_vector_type(8)));
typedef float f32x4 __attribute__((ext_vector_type(4)));
typedef unsigned u32x4 __attribute__((ext_vector_type(4)));
typedef unsigned u32x2 __attribute__((ext_vector_type(2)));
constexpr int BM = 256, BK = 64, HALF = 128, HTB = HALF * BK * 2, STAGE_BYTES = 8 * HTB, NXCD = 8, WGM = 8;

__host__ __device__ __forceinline__ int lds_byte(int r, int c) {
  const int st = (r >> 4) * 2 + (c >> 5), rr = r & 15, cc = c & 31, ob = rr * 64 + cc * 2;
  return st * 1024 + (ob ^ (((ob >> 9) & 1) << 5));
}
__host__ __device__ __forceinline__ void stage_rc(int b, int& R, int& C) {
  const int st = b / 1024, sb = b % 1024, swz = sb ^ (((sb >> 9) & 1) << 5);
  R = (st >> 1) * 16 + swz / 64; C = (st & 1) * 32 + (swz % 64) / 2;
}
__host__ __device__ __forceinline__ int perm32(int rho) { const int n = rho >> 4, i = rho & 15; return 8 * (i >> 2) + 4 * n + (i & 3); }

struct Unit { int pm, pn, e, mu, nv, cnt, seg; };

__device__ __forceinline__ bool static_next(int nM, int nN, int G, int c, int i, int& pm, int& pn) {
  const int nwg = nM * nN;
  const long Lx = (long)i * G + c; if (Lx >= nwg) return false;
  int wgid = (int)Lx;
  { const int q = nwg / NXCD, r = nwg % NXCD, xcd = wgid % NXCD, off = wgid / NXCD; wgid = (xcd < r ? xcd * (q + 1) : r * (q + 1) + (xcd - r) * q) + off; }
  const int nig = WGM * nN, gid = wgid / nig, fm = gid * WGM, gsz = (nM - fm) < WGM ? (nM - fm) : WGM;
  pm = fm + ((wgid % nig) % gsz); pn = (wgid % nig) / gsz; return true;
}

struct DenseOrder {
  const bf16_t* A; const bf16_t* Bt; int nM, nN, K, G, c;
  __device__ __forceinline__ bool next(int i, Unit& u) const {
    if (!static_next(nM, nN, G, c, i, u.pm, u.pn)) return false;
    u.e = 0; u.mu = 0; u.nv = 256; u.cnt = 256; u.seg = 0; return true;
  }
  __device__ __forceinline__ const char* a_base() const { return (const char*)A; }
  __device__ __forceinline__ const char* b_ptr(const Unit& u) const { return (const char*)Bt + (size_t)u.pn * 256 * K * 2; }
  __device__ __forceinline__ void a_offs(const Unit& u, const int (&R)[2], const int (&C)[2], unsigned (&ao)[2][2]) const {
#pragma unroll
    for (int h = 0; h < 2; ++h)
#pragma unroll
      for (int i = 0; i < 2; ++i) ao[h][i] = (unsigned)((u.pm * 256 + h * 128 + R[i]) * K + C[i]) * 2u;
  }
};

struct MoeOrder {
  const int* tab; const bf16_t* A; const bf16_t* Bt; const int* list; int NTn, K, G, c; bool gather;
  __device__ __forceinline__ bool next(int i, Unit& u) const {
    const int Lx = i * G + c;
    if (Lx >= tab[64] * NTn) return false;
    const int mg = Lx / NTn; u.pn = Lx - mg * NTn;
    int e = 0;
    while (tab[e + 1] <= mg) ++e;
    u.e = e; u.mu = mg - tab[e]; u.cnt = tab[130 + e]; u.seg = tab[65 + e];
    const int rem = u.cnt - u.mu * 256; u.nv = rem < 256 ? rem : 256; u.pm = 0; return true;
  }
  __device__ __forceinline__ const char* a_base() const { return (const char*)A; }
  __device__ __forceinline__ const char* b_ptr(const Unit& u) const { return (const char*)Bt + ((size_t)u.e * NTn + u.pn) * 256 * K * 2; }
  __device__ __forceinline__ void a_offs(const Unit& u, const int (&R)[2], const int (&C)[2], unsigned (&ao)[2][2]) const {
#pragma unroll
    for (int h = 0; h < 2; ++h)
#pragma unroll
      for (int i = 0; i < 2; ++i) {
        int idx = u.mu * 256 + h * 128 + R[i];
        int row;
        if (gather) { if (idx > u.cnt - 1) idx = u.cnt - 1; row = list[u.e * T + idx] >> 1; }
        else row = u.seg + idx;
        ao[h][i] = (unsigned)(row * K + C[i]) * 2u;
      }
  }
};

struct EpiBf16 {
  static constexpr bool PERM = true;
  bf16_t* O; int ldc; float* DT; const float* dt_bias;
  __device__ __forceinline__ void operator()(const f32x4 (&acc)[2][2][4][2], const Unit& u, int wr, int wc, int fr, int fq) const {
    const int row0 = u.pm * BM + wr * 64 + fr;
    if (u.pn == 12) {
      if (wc == 0 && fq < 2) {
        const f32x4 b0 = *(const f32x4*)(dt_bias + 8 * fq), b1 = *(const f32x4*)(dt_bias + 8 * fq + 4);
#pragma unroll
        for (int ai = 0; ai < 2; ++ai)
#pragma unroll
          for (int m = 0; m < 4; ++m) {
            float* dp = DT + (size_t)(row0 + ai * HALF + m * 16) * 16 + 8 * fq;
            *(f32x4*)dp = acc[ai][0][m][0] + b0; *(f32x4*)(dp + 4) = acc[ai][0][m][1] + b1;
          }
      }
      return;
    }
    const int col0 = u.pn * BM + wc * 32 + 8 * fq;
#pragma unroll
    for (int ai = 0; ai < 2; ++ai)
#pragma unroll
      for (int m = 0; m < 4; ++m) {
        bf16_t* rowp = O + (size_t)(row0 + ai * HALF + m * 16) * ldc + col0;
#pragma unroll
        for (int bj = 0; bj < 2; ++bj) {
          f32x4 v0 = acc[ai][bj][m][0], v1 = acc[ai][bj][m][1];
          u32x4 w; w.x = cvt_pk_bf16(v0[0], v0[1]); w.y = cvt_pk_bf16(v0[2], v0[3]); w.z = cvt_pk_bf16(v1[0], v1[1]); w.w = cvt_pk_bf16(v1[2], v1[3]);
          *(u32x4*)(rowp + bj * HALF) = w;
        }
      }
  }
};

struct EpiX1 {
  static constexpr bool PERM = false;
  const float* x; const float* mod; float* X1; float* SSQP;
  __device__ __forceinline__ void operator()(const f32x4 (&acc)[2][2][4][2], const Unit& u, int wr, int wc, int fr, int fq) const {
    const int row0 = u.pm * BM + wr * 64 + fr, col0 = u.pn * BM + wc * 32 + 4 * fq;
    const float* ga = mod + ((u.pm * BM) / L) * 6144 + 2048 + col0;
    f32x4 gv[2][2];
#pragma unroll
    for (int bj = 0; bj < 2; ++bj)
#pragma unroll
      for (int n = 0; n < 2; ++n) gv[bj][n] = *(const f32x4*)(ga + bj * HALF + n * 16);
#pragma unroll
    for (int ai = 0; ai < 2; ++ai)
#pragma unroll
      for (int mp = 0; mp < 2; ++mp) {
        f32x4 xv[2][2][2];
#pragma unroll
        for (int mm = 0; mm < 2; ++mm) {
          const size_t off = (size_t)(row0 + ai * HALF + (2 * mp + mm) * 16) * D + col0;
#pragma unroll
          for (int bj = 0; bj < 2; ++bj)
#pragma unroll
            for (int n = 0; n < 2; ++n) xv[mm][bj][n] = *(const f32x4*)(x + off + bj * HALF + n * 16);
        }
#pragma unroll
        for (int mm = 0; mm < 2; ++mm) {
          const int m = 2 * mp + mm;
          const size_t off = (size_t)(row0 + ai * HALF + m * 16) * D + col0;
          float ssq = 0.f;
#pragma unroll
          for (int bj = 0; bj < 2; ++bj)
#pragma unroll
            for (int n = 0; n < 2; ++n) {
              const f32x4 o = xv[mm][bj][n] + gv[bj][n] * acc[ai][bj][m][n];
              *(f32x4*)(X1 + off + bj * HALF + n * 16) = o;
              ssq += (o[0] * o[0] + o[1] * o[1]) + (o[2] * o[2] + o[3] * o[3]);
            }
          ssq += __shfl_xor(ssq, 16); ssq += __shfl_xor(ssq, 32);
          if (fq == 0) SSQP[(size_t)(row0 + ai * HALF + m * 16) * 16 + u.pn * 4 + wc] = ssq;
        }
      }
  }
};

struct EpiSwiGLU {
  static constexpr bool PERM = true;
  bf16_t* HBb;
  __device__ __forceinline__ void operator()(const f32x4 (&acc)[2][2][4][2], const Unit& u, int wr, int wc, int fr, int fq) const {
    const int col0 = u.pn * 128 + wc * 32 + 8 * fq;
#pragma unroll
    for (int ai = 0; ai < 2; ++ai)
#pragma unroll
      for (int m = 0; m < 4; ++m) {
        const int slot = u.mu * 256 + ai * HALF + wr * 64 + m * 16 + fr;
        if (slot < u.cnt) {
          float h[8];
#pragma unroll
          for (int n = 0; n < 2; ++n)
#pragma unroll
            for (int j = 0; j < 4; ++j) { const float a = acc[ai][0][m][n][j]; h[n * 4 + j] = a / (1.f + __expf(-a)) * acc[ai][1][m][n][j]; }
          u32x4 w; w.x = cvt_pk_bf16(h[0], h[1]); w.y = cvt_pk_bf16(h[2], h[3]); w.z = cvt_pk_bf16(h[4], h[5]); w.w = cvt_pk_bf16(h[6], h[7]);
          *(u32x4*)(HBb + (size_t)(u.seg + slot) * DE + col0) = w;
        }
      }
  }
};

struct EpiDown {
  static constexpr bool PERM = true;
  bf16_t* YB2b; const int* list; const float* gate;
  __device__ __forceinline__ void operator()(const f32x4 (&acc)[2][2][4][2], const Unit& u, int wr, int wc, int fr, int fq) const {
    const int col0 = u.pn * 256 + wc * 32 + 8 * fq;
#pragma unroll
    for (int ai = 0; ai < 2; ++ai)
#pragma unroll
      for (int m = 0; m < 4; ++m) {
        const int slot = u.mu * 256 + ai * HALF + wr * 64 + m * 16 + fr;
        if (slot < u.cnt) {
          const int pair = list[u.e * T + slot];
          const float gt = gate[pair];
          bf16_t* rowp = YB2b + (size_t)pair * D + col0;
#pragma unroll
          for (int bj = 0; bj < 2; ++bj) {
            f32x4 v0 = acc[ai][bj][m][0] * gt, v1 = acc[ai][bj][m][1] * gt;
            u32x4 w; w.x = cvt_pk_bf16(v0[0], v0[1]); w.y = cvt_pk_bf16(v0[2], v0[3]); w.z = cvt_pk_bf16(v1[0], v1[1]); w.w = cvt_pk_bf16(v1[2], v1[3]);
            *(u32x4*)(rowp + bj * HALF) = w;
          }
        }
      }
  }
};

template <class Epi, class Sched>
__device__ __forceinline__ void gemm_phase(PG8_LAS unsigned char* lds, const int K, const Sched& S, const Epi& E) {
  const int tid = threadIdx.x, wid = __builtin_amdgcn_readfirstlane(tid >> 6), lane = tid & 63, wr = wid >> 2, wc = wid & 3, fr = lane & 15, fq = lane >> 4;
  const int nt = K / BK;
  int Rr[2], Cc[2];
  unsigned voffB[2];
#pragma unroll
  for (int i = 0; i < 2; ++i) {
    stage_rc(tid * 16 + i * 8192, Rr[i], Cc[i]);
    const int Rb = Epi::PERM ? ((Rr[i] & ~31) + perm32(Rr[i] & 31)) : Rr[i];
    voffB[i] = (unsigned)(Rb * K + Cc[i]) * 2u;
  }
  const size_t kstep = (size_t)(BK * 2);
  const size_t hstep = (size_t)HALF * K * 2;
  const unsigned ldsw = (unsigned)wid * 1024u;
  const int aoff = lds_byte(wr * 64 + fr, fq * 8), boff = lds_byte(wc * 32 + fr, fq * 8);
#define PG8_SA(b, h) (((b) * 2 + (h)) * HTB)
#define PG8_SB(b, h) ((4 + (b) * 2 + (h)) * HTB)
#define PG8_STAGE(bufoff, gbase, voff) do { _Pragma("unroll") for (int _i = 0; _i < 2; ++_i) \
    __builtin_amdgcn_global_load_lds((const unsigned*)((const char*)(gbase) + (voff)[_i]), (PG8_LAS unsigned*)(lds + (bufoff) + ldsw + _i * 8192), 16, 0, 0); } while (0)
#define PG8_LDA(dst, b, h) do { _Pragma("unroll") for (int m = 0; m < 4; ++m) _Pragma("unroll") for (int k = 0; k < 2; ++k) dst[m][k] = *(const PG8_LAS bf16x8*)(lds + PG8_SA(b, h) + aoff + m * 2048 + k * 1024); } while (0)
#define PG8_LDB(dst, b, h) do { _Pragma("unroll") for (int n = 0; n < 2; ++n) _Pragma("unroll") for (int k = 0; k < 2; ++k) dst[n][k] = *(const PG8_LAS bf16x8*)(lds + PG8_SB(b, h) + boff + n * 2048 + k * 1024); } while (0)
#define PG8_MMA(ai, bj, At, Bt) do { __builtin_amdgcn_s_setprio(1); _Pragma("unroll") for (int m = 0; m < 4; ++m) _Pragma("unroll") for (int n = 0; n < 2; ++n) _Pragma("unroll") for (int k = 0; k < 2; ++k) \
    acc[ai][bj][m][n] = __builtin_amdgcn_mfma_f32_16x16x32_bf16(Bt[n][k], At[m][k], acc[ai][bj][m][n], 0, 0, 0); __builtin_amdgcn_s_setprio(0); } while (0)
#define PG8_WAIT_V(n) asm volatile("s_waitcnt vmcnt(" #n ")" ::: "memory")
#define PG8_WAIT_L(n) asm volatile("s_waitcnt lgkmcnt(" #n ")" ::: "memory")
#define PG8_BAR __builtin_amdgcn_s_barrier()
#define PG8_SCHED __builtin_amdgcn_sched_barrier(0)
  Unit cur, nxt; int ui = 0;
  if (!S.next(0, cur)) return;
  f32x4 acc[2][2][4][2];
#pragma unroll
  for (int a = 0; a < 2; ++a)
#pragma unroll
    for (int b = 0; b < 2; ++b)
#pragma unroll
      for (int m = 0; m < 4; ++m)
#pragma unroll
        for (int n = 0; n < 2; ++n) acc[a][b][m][n] = (f32x4){0.f, 0.f, 0.f, 0.f};
  bf16x8 At[4][2], B0[2][2], B1[2][2];
  unsigned cao[2][2], nao[2][2];
  S.a_offs(cur, Rr, Cc, cao);
  const char* const aB = S.a_base();
  const char* cB = S.b_ptr(cur);
  PG8_STAGE(PG8_SB(0, 0), cB, voffB); PG8_STAGE(PG8_SA(0, 0), aB, cao[0]); PG8_STAGE(PG8_SB(0, 1), cB + hstep, voffB); PG8_STAGE(PG8_SA(0, 1), aB, cao[1]);
  if (wr == 1) PG8_BAR;
  PG8_WAIT_V(4); PG8_BAR;
  PG8_STAGE(PG8_SB(1, 0), cB + kstep, voffB); PG8_STAGE(PG8_SA(1, 0), aB + kstep, cao[0]); PG8_STAGE(PG8_SB(1, 1), cB + hstep + kstep, voffB);
  PG8_WAIT_V(6); PG8_BAR;
  for (;;) {
    const bool has_next = S.next(ui + 1, nxt);
    const char* nB = cB;
    if (has_next) { S.a_offs(nxt, Rr, Cc, nao); nB = S.b_ptr(nxt); }
    else {
#pragma unroll
      for (int h = 0; h < 2; ++h)
#pragma unroll
        for (int i = 0; i < 2; ++i) nao[h][i] = cao[h][i];
    }
    const bool full = cur.nv > 128;
    for (int t = 0; t < nt; t += 2) {
      const bool last = (t == nt - 2);
      const char* a1 = aB + (size_t)(t + 1) * kstep;
      const char* a2 = last ? aB : aB + (size_t)(t + 2) * kstep; const char* b2 = last ? nB : cB + (size_t)(t + 2) * kstep;
      const char* a3 = a2 + kstep; const char* b3 = b2 + kstep;
      unsigned so[2][2];
#pragma unroll
      for (int h = 0; h < 2; ++h)
#pragma unroll
        for (int i = 0; i < 2; ++i) so[h][i] = last ? nao[h][i] : cao[h][i];
      PG8_LDB(B0, 0, 0); PG8_SCHED; PG8_LDA(At, 0, 0); PG8_STAGE(PG8_SA(1, 1), a1, cao[1]);
      PG8_WAIT_L(8); PG8_BAR; PG8_WAIT_L(0); PG8_MMA(0, 0, At, B0); PG8_BAR; PG8_SCHED;
      PG8_LDB(B1, 0, 1); PG8_STAGE(PG8_SB(0, 0), b2, voffB);
      PG8_BAR; PG8_WAIT_L(0); PG8_MMA(0, 1, At, B1); PG8_BAR;
      PG8_LDA(At, 0, 1); PG8_STAGE(PG8_SA(0, 0), a2, so[0]);
      PG8_BAR; PG8_WAIT_L(0); if (full) PG8_MMA(1, 0, At, B0); PG8_BAR; PG8_SCHED;
      PG8_STAGE(PG8_SB(0, 1), b2 + hstep, voffB);
      PG8_WAIT_V(6); PG8_BAR; if (full) PG8_MMA(1, 1, At, B1); PG8_BAR;
      PG8_LDB(B0, 1, 0); PG8_SCHED; PG8_LDA(At, 1, 0); PG8_STAGE(PG8_SA(0, 1), a2, so[1]);
      PG8_WAIT_L(8); PG8_BAR; PG8_WAIT_L(0); PG8_MMA(0, 0, At, B0); PG8_BAR; PG8_SCHED;
      PG8_LDB(B1, 1, 1); PG8_STAGE(PG8_SB(1, 0), b3, voffB);
      PG8_BAR; PG8_WAIT_L(0); PG8_MMA(0, 1, At, B1); PG8_BAR;
      PG8_LDA(At, 1, 1); PG8_STAGE(PG8_SA(1, 0), a3, so[0]);
      PG8_BAR; PG8_WAIT_L(0); if (full) PG8_MMA(1, 0, At, B0); PG8_BAR; PG8_SCHED;
      PG8_STAGE(PG8_SB(1, 1), b3 + hstep, voffB);
      PG8_WAIT_V(6); PG8_BAR; if (full) PG8_MMA(1, 1, At, B1); PG8_BAR;
    }
    E(acc, cur, wr, wc, fr, fq);
    if (!has_next) break;
#pragma unroll
    for (int a = 0; a < 2; ++a)
#pragma unroll
      for (int b = 0; b < 2; ++b)
#pragma unroll
        for (int m = 0; m < 4; ++m)
#pragma unroll
          for (int n = 0; n < 2; ++n) acc[a][b][m][n] = (f32x4){0.f, 0.f, 0.f, 0.f};
    cur = nxt; cB = nB; ++ui;
#pragma unroll
    for (int h = 0; h < 2; ++h)
#pragma unroll
      for (int i = 0; i < 2; ++i) cao[h][i] = nao[h][i];
  }
  PG8_WAIT_V(0);
  if (wr == 0) PG8_BAR;
  PG8_BAR;
#undef PG8_SA
#undef PG8_SB
#undef PG8_STAGE
#undef PG8_LDA
#undef PG8_LDB
#undef PG8_MMA
#undef PG8_WAIT_V
#undef PG8_WAIT_L
#undef PG8_BAR
#undef PG8_SCHED
}
}

__device__ void ph_adaln(const Params& p, float* sm) {
  const int tid = threadIdx.x;
  if (blockIdx.x == 0 && tid < NE) p.CNT[tid * 32] = 0;
  for (int e = blockIdx.x * NTHR + tid; e < 96 * 1024; e += gridDim.x * NTHR) {
    const int j = e >> 10, k = e & 1023;
    float w = 0.f;
    if (j < 64) w = p.w_expert[k * 64 + j]; else if (j < 72) w = p.w_group[k * 8 + (j - 64)];
    const unsigned hi = cvt_pk_bf16(w, 0.f) & 0xffffu;
    const float rem = w - __uint_as_float(hi << 16);
    p.WRhi[e] = (bf16_t)hi; p.WRlo[e] = (bf16_t)(cvt_pk_bf16(rem, 0.f) & 0xffffu);
  }
  float* sc = sm;
  float* red = sm + 9 * 1024;
  for (int e = tid; e < 9 * 1024; e += NTHR) {
    const int r = e >> 10, k = e & 1023;
    sc[e] = silu_f(r < 8 ? p.c[r * D + k] : p.c_ctx[k]);
  }
  __syncthreads();
  for (int item = blockIdx.x; item < 192; item += gridDim.x) {
    const int col0 = item * 32;
    const int kq = tid >> 3, c4 = (tid & 7) * 4;
    float acc[9][4];
#pragma unroll
    for (int r = 0; r < 9; ++r)
#pragma unroll
      for (int j = 0; j < 4; ++j) acc[r][j] = 0.f;
    float4 wv[16];
#pragma unroll
    for (int i = 0; i < 16; ++i) wv[i] = *(const float4*)(p.w_ada + (size_t)(kq + i * 64) * 6144 + col0 + c4);
#pragma unroll
    for (int i = 0; i < 16; ++i) {
      const int k = kq + i * 64;
      const float4 w = wv[i];
#pragma unroll
      for (int r = 0; r < 9; ++r) {
        const float sv = sc[r * 1024 + k];
        acc[r][0] += sv * w.x; acc[r][1] += sv * w.y; acc[r][2] += sv * w.z; acc[r][3] += sv * w.w;
      }
    }
#pragma unroll
    for (int r = 0; r < 9; ++r)
#pragma unroll
      for (int j = 0; j < 4; ++j) red[kq * 292 + r * 32 + c4 + j] = acc[r][j];
    __syncthreads();
    if (tid < 288) {
      float a = 0.f;
      for (int q = 0; q < 64; ++q) a += red[q * 292 + tid];
      const int r = tid >> 5, j = tid & 31;
      p.MOD[r * 6144 + col0 + j] = a + p.b_ada[col0 + j];
    }
    __syncthreads();
  }
}

__device__ void ph_filters(const Params& p, float* sm) {
  const int tid = threadIdx.x, wid = tid >> 6, lane = tid & 63;
  float* feats = sm;
  float* h1 = sm + 64 * 20;
  float* h2 = h1 + 64 * 64;
  float* w3s = h2 + 64 * 64;
  bf16_t* tile = (bf16_t*)w3s;
  float* w2s = w3s + 64 * 256;
  float* w1s = w2s + 4096;
  for (int e = tid; e < 4096; e += NTHR) w2s[e] = p.f_w2[e];
  for (int e = tid; e < 17 * 64; e += NTHR) w1s[e] = p.f_w1[e];
  __syncthreads();
  for (int e = blockIdx.x * NTHR + tid; e < 1024 * 137; e += gridDim.x * NTHR) {
    int rowi = e / 137, k = e - rowi * 137;
    int x = (k < 65) ? k : (4160 + (k - 65));
    p.FILTt[(size_t)rowi * FLEN + x] = 0;
  }
  for (int item = blockIdx.x; item < 256; item += gridDim.x) {
    const int tt = item >> 3, ct = item & 7;
    for (int e = tid; e < 4096; e += NTHR) {
      const int i = e >> 6, c4 = (e & 63) * 4;
      *(float4*)(w3s + i * 256 + c4) = *(const float4*)(p.f_w3 + i * 2048 + ct * 256 + c4);
    }
    for (int e = tid; e < 64 * 17; e += NTHR) {
      int tp = e / 17, i = e - tp * 17;
      int t = tt * 64 + tp;
      float f;
      if (i == 0) f = (float)t / (float)(L - 1);
      else {
        int bi = (i - 1) & 7;
        float bandf = (float)(1e-4 + (double)bi * ((7.0 - 1e-4) / 7.0));
        float ang = (float)(2.0 * 3.14159265358979323846 / (double)L) * (float)t * bandf;
        f = (i <= 8) ? cosf(ang) : -sinf(ang);
      }
      feats[tp * 20 + i] = f;
    }
    __syncthreads();
    for (int e = tid; e < 4096; e += NTHR) {
      int tp = e >> 6, j = e & 63;
      float a = p.f_b1[j];
      for (int i = 0; i < 17; ++i) a += feats[tp * 20 + i] * w1s[i * 64 + j];
      h1[e] = __sinf(p.f_freq[j] * a);
    }
    __syncthreads();
    {
      const int tp = tid >> 3, j8 = (tid & 7) * 8;
      float a[8];
#pragma unroll
      for (int c = 0; c < 8; ++c) a[c] = p.f_b2[j8 + c];
#pragma unroll 4
      for (int i = 0; i < 64; ++i) {
        const float hv = h1[tp * 64 + i];
        const float4 w0 = *(const float4*)(w2s + i * 64 + j8), w1 = *(const float4*)(w2s + i * 64 + j8 + 4);
        a[0] += hv * w0.x; a[1] += hv * w0.y; a[2] += hv * w0.z; a[3] += hv * w0.w;
        a[4] += hv * w1.x; a[5] += hv * w1.y; a[6] += hv * w1.z; a[7] += hv * w1.w;
      }
#pragma unroll
      for (int c = 0; c < 8; ++c) h2[tp * 64 + j8 + c] = __sinf(p.f_freq[j8 + c] * a[c]);
    }
    __syncthreads();
    {
      const int cg = tid & 31, tg = tid >> 5;
      float acc[4][8];
#pragma unroll
      for (int a = 0; a < 4; ++a)
#pragma unroll
        for (int c = 0; c < 8; ++c) acc[a][c] = 0.f;
#pragma unroll 4
      for (int i = 0; i < 64; ++i) {
        const float4 w0 = *(const float4*)(w3s + i * 256 + cg * 8), w1 = *(const float4*)(w3s + i * 256 + cg * 8 + 4);
        const float wv[8] = {w0.x, w0.y, w0.z, w0.w, w1.x, w1.y, w1.z, w1.w};
#pragma unroll
        for (int a = 0; a < 4; ++a) {
          const float hv = h2[(tg * 4 + a) * 64 + i];
#pragma unroll
          for (int c = 0; c < 8; ++c) acc[a][c] += hv * wv[c];
        }
      }
      __syncthreads();
      const float d0 = -4.605170185988091f / 1.5f, d1 = -4.605170185988091f / 0.3f;
#pragma unroll
      for (int c = 0; c < 8; ++c) {
        const int col = cg * 8 + c;
        const int cch = (ct * 256 + col) & 511;
        const float delta = fabsf(d0 + (float)cch * ((d1 - d0) / 511.f));
#pragma unroll
        for (int a = 0; a < 4; ++a) {
          const int t = tt * 64 + tg * 4 + a;
          const float tn = (float)t / (float)(L - 1);
          tile[col * 66 + tg * 4 + a] = f2bf(acc[a][c] * __expf(-tn * delta));
        }
      }
    }
    __syncthreads();
    for (int cl = wid * 32; cl < wid * 32 + 32; ++cl) {
      const int gcol = ct * 256 + cl;
      const int o = gcol >> 10, dir = (gcol >> 9) & 1, cch = gcol & 511;
      const int t = tt * 64 + lane;
      const int x = dir ? (HX0 + t) : (HX0 - t);
      if (!(dir && t == 0)) p.FILTt[(size_t)(o * 512 + cch) * FLEN + x] = tile[cl * 66 + lane];
    }
    __syncthreads();
  }
}

__device__ __forceinline__ void cvt_tile256(const float* src, int ld, int k0, int n0, bf16_t* dst, int ldd, int dmap0, int dmap1, int nsplit, float* sm) {
  const int tid = threadIdx.x;
  float* ts = sm;
  float4 v[8];
#pragma unroll
  for (int i = 0; i < 8; ++i) {
    const int e = tid + i * NTHR; const int k = e >> 6, n4 = (e & 63) * 4;
    v[i] = *(const float4*)(src + (size_t)(k0 + k) * ld + n0 + n4);
  }
#pragma unroll
  for (int i = 0; i < 8; ++i) {
    const int e = tid + i * NTHR; const int k = e >> 6, n4 = (e & 63) * 4;
    ts[k * 257 + n4 + 0] = v[i].x; ts[k * 257 + n4 + 1] = v[i].y; ts[k * 257 + n4 + 2] = v[i].z; ts[k * 257 + n4 + 3] = v[i].w;
  }
  __syncthreads();
#pragma unroll
  for (int i = 0; i < 4; ++i) {
    const int e = tid + i * NTHR; const int n = e >> 3, kq = (e & 7) * 8;
    uint4 w;
    w.x = cvt_pk_bf16(ts[(kq + 0) * 257 + n], ts[(kq + 1) * 257 + n]);
    w.y = cvt_pk_bf16(ts[(kq + 2) * 257 + n], ts[(kq + 3) * 257 + n]);
    w.z = cvt_pk_bf16(ts[(kq + 4) * 257 + n], ts[(kq + 5) * 257 + n]);
    w.w = cvt_pk_bf16(ts[(kq + 6) * 257 + n], ts[(kq + 7) * 257 + n]);
    const int drow = (n < nsplit) ? (dmap0 + n) : (dmap1 + (n - nsplit));
    *(uint4*)(dst + (size_t)drow * ldd + k0 + kq) = w;
  }
  __syncthreads();
}

__device__ void ph_wcvt(const Params& p, float* sm) {
  for (int e = blockIdx.x * NTHR + threadIdx.x; e < 16 * 1024; e += gridDim.x * NTHR) {
    const int j = e >> 10, k = e & 1023;
    p.WinT[(size_t)(DP + j) * D + k] = f2bf(p.w_in[(size_t)k * DIN + COL_DT + j]);
  }
  for (int it = blockIdx.x; it < 192 + 64; it += gridDim.x) {
    if (it < 192) { const int kt = it / 12, nt = it - kt * 12; cvt_tile256(p.w_in, DIN, kt * 64, nt * 256, p.WinT, D, nt * 256, 0, 256, sm); }
    else if (it < 256) { const int i = it - 192; const int kt = i >> 2, nt = i & 3; cvt_tile256(p.w_out, D, kt * 64, nt * 256, p.WoutT, D, nt * 256, 0, 256, sm); }
  }
}

__device__ void ph_norm1(const Params& p) {
  const int tid = threadIdx.x, wid = tid >> 6, lane = tid & 63;
  for (int row = blockIdx.x * 8 + wid; row < TT; row += gridDim.x * 8) {
    const float* src = (row < T) ? (p.x + (size_t)row * D) : (p.ctx + (size_t)(row - T) * D);
    const int mr = (row < T) ? (row / L) : 8;
    const float* sh = p.MOD + mr * 6144;
    const float* sc = sh + 1024;
    float4 v[4];
    float ss = 0.f;
#pragma unroll
    for (int i = 0; i < 4; ++i) {
      v[i] = *(const float4*)(src + i * 256 + lane * 4);
      ss += v[i].x * v[i].x + v[i].y * v[i].y + v[i].z * v[i].z + v[i].w * v[i].w;
    }
    ss = wave_sum(ss);
    const float rstd = rsqrtf(ss * (1.f / D) + EPS);
#pragma unroll
    for (int i = 0; i < 4; ++i) {
      const int col = i * 256 + lane * 4;
      float4 g = *(const float4*)(p.g1 + col);
      float4 s4 = *(const float4*)(sc + col);
      float4 h4 = *(const float4*)(sh + col);
      float4 o;
      o.x = v[i].x * rstd * g.x * (1.f + s4.x) + h4.x;
      o.y = v[i].y * rstd * g.y * (1.f + s4.y) + h4.y;
      o.z = v[i].z * rstd * g.z * (1.f + s4.z) + h4.z;
      o.w = v[i].w * rstd * g.w * (1.f + s4.w) + h4.w;
      uint2 w; w.x = cvt_pk_bf16(o.x, o.y); w.y = cvt_pk_bf16(o.z, o.w);
      *(uint2*)(p.XNb + (size_t)row * D + col) = w;
    }
  }
}

__device__ void ph_hy_convT(const Params& p, float* sm) {
  const int tid = threadIdx.x;
  float* tile = sm;
  const int bid = blockIdx.x;
  int it0, it1;
  if (gridDim.x == 256) { if (bid < 32) { it0 = bid * 3; it1 = it0 + 3; } else { it0 = 96 + (bid - 32) * 27; it1 = it0 + 27; } }
  else { const int per = (256 * 24 + gridDim.x - 1) / gridDim.x; it0 = bid * per; it1 = it0 + per; if (it1 > 256 * 24) it1 = 256 * 24; }
  for (int item = it0; item < it1; item += 3) {
    uint4 v[3];
    const int lt = tid >> 3, c8 = (tid & 7) * 8;
#pragma unroll
    for (int u = 0; u < 3; ++u) {
      const int it = (item + u < it1) ? (item + u) : item;
      const int gr = it / 24, ct = it - gr * 24;
      v[u] = *(const uint4*)(p.PXb + (size_t)(gr * 64 + lt) * DP + ct * 64 + c8);
    }
#pragma unroll
    for (int u = 0; u < 3; ++u) {
      float* tl = tile + u * (64 * 65);
      const unsigned w[4] = {v[u].x, v[u].y, v[u].z, v[u].w};
#pragma unroll
      for (int k = 0; k < 4; ++k) {
        tl[lt * 65 + c8 + 2 * k] = __uint_as_float(w[k] << 16);
        tl[lt * 65 + c8 + 2 * k + 1] = __uint_as_float(w[k] & 0xffff0000u);
      }
    }
    __syncthreads();
#pragma unroll
    for (int u = 0; u < 3; ++u) {
      if (item + u < it1) {
        const int it = item + u;
        const int gr = it / 24, ct = it - gr * 24;
        const int row0 = gr * 64;
        const float* tl = tile + u * (64 * 65);
        const int cc = tid >> 3, t8 = (tid & 7) * 8;
        const int col = ct * 64 + cc;
        const float w0 = p.hy_conv_w[col], w1 = p.hy_conv_w[HYC + col], w2 = p.hy_conv_w[2 * HYC + col], bb = p.hy_conv_b[col];
        float o[8];
#pragma unroll
        for (int k = 0; k < 8; ++k) {
          const int t = t8 + k;
          float vv = bb + w1 * tl[t * 65 + cc];
          if (t > 0) vv += w0 * tl[(t - 1) * 65 + cc];
          if (t < 63) vv += w2 * tl[(t + 1) * 65 + cc];
          o[k] = vv;
        }
        uint4 w; w.x = cvt_pk_bf16(o[0], o[1]); w.y = cvt_pk_bf16(o[2], o[3]); w.z = cvt_pk_bf16(o[4], o[5]); w.w = cvt_pk_bf16(o[6], o[7]);
        *(uint4*)(p.Ut + (size_t)col * T + row0 + t8) = w;
      }
    }
    __syncthreads();
  }
}

__device__ void ph_hy_backT(const Params& p, float* sm) {
  const int tid = threadIdx.x;
  bf16_t* tile = (bf16_t*)sm;
  for (int item = blockIdx.x; item < 256 * 8; item += gridDim.x) {
    const int gr = item >> 3, ct = item & 7;
    const int row0 = gr * 64;
    {
      const int cc = tid >> 3, r8 = (tid & 7) * 8;
      uint4 v = *(const uint4*)(p.Yt + (size_t)(ct * 64 + cc) * T + row0 + r8);
      unsigned w[4] = {v.x, v.y, v.z, v.w};
#pragma unroll
      for (int k = 0; k < 4; ++k) {
        tile[cc * 66 + r8 + 2 * k] = (bf16_t)(w[k] & 0xffffu);
        tile[cc * 66 + r8 + 2 * k + 1] = (bf16_t)(w[k] >> 16);
      }
    }
    __syncthreads();
    {
      const int r = tid >> 3, c8 = (tid & 7) * 8;
      unsigned w[4];
#pragma unroll
      for (int k = 0; k < 4; ++k) w[k] = (unsigned)tile[(c8 + 2 * k) * 66 + r] | ((unsigned)tile[(c8 + 2 * k + 1) * 66 + r] << 16);
      uint4 o; o.x = w[0]; o.y = w[1]; o.z = w[2]; o.w = w[3];
      *(uint4*)(p.YMIXb + (size_t)(row0 + r) * D + ct * 64 + c8) = o;
    }
    __syncthreads();
  }
}

typedef short hbf16x8 __attribute__((ext_vector_type(8)));
typedef float hf32x4 __attribute__((ext_vector_type(4)));

constexpr int HY_FC = 0, HY_ZT0 = 4 * FCLEN * 2, HY_ZT1 = HY_ZT0 + 8 * ZSTRB;

__device__ __forceinline__ void hy_build_filter(const Params& p, int o, int c, unsigned char* lds) {
  const int tid = threadIdx.x;
  const bf16_t* gsrc = p.FILTt + (size_t)(o * 512 + c) * FLEN;
  for (int e = tid; e < 530; e += NTHR) {
    uint4 v = make_uint4(0u, 0u, 0u, 0u);
    if (e < 529) v = *(const uint4*)(gsrc + e * 8);
    *(uint4*)(lds + HY_FC + e * 16) = v;
  }
  __syncthreads();
  for (int g = tid; g < 3 * 530; g += NTHR) {
    const int r = 1 + g / 530, ch = g % 530;
    uint4 lo = make_uint4(0u, 0u, 0u, 0u);
    if (ch > 0) lo = *(const uint4*)(lds + HY_FC + (ch - 1) * 16);
    uint4 hi = *(const uint4*)(lds + HY_FC + ch * 16);
    unsigned W[8] = {lo.x, lo.y, lo.z, lo.w, hi.x, hi.y, hi.z, hi.w};
    uint4 ov;
    if (r == 1) {
      ov.x = __builtin_amdgcn_alignbyte(W[4], W[3], 2); ov.y = __builtin_amdgcn_alignbyte(W[5], W[4], 2);
      ov.z = __builtin_amdgcn_alignbyte(W[6], W[5], 2); ov.w = __builtin_amdgcn_alignbyte(W[7], W[6], 2);
    } else if (r == 2) {
      ov.x = W[3]; ov.y = W[4]; ov.z = W[5]; ov.w = W[6];
    } else {
      ov.x = __builtin_amdgcn_alignbyte(W[3], W[2], 2); ov.y = __builtin_amdgcn_alignbyte(W[4], W[3], 2);
      ov.z = __builtin_amdgcn_alignbyte(W[5], W[4], 2); ov.w = __builtin_amdgcn_alignbyte(W[6], W[5], 2);
    }
    *(uint4*)(lds + HY_FC + r * (FCLEN * 2) + ch * 16) = ov;
  }
  __syncthreads();
}

__device__ __forceinline__ void hy_order(const Params& p, int o, int c, unsigned char* lds) {
  const int tid = threadIdx.x, wid = __builtin_amdgcn_readfirstlane(tid >> 6), lane = tid & 63;
  const int g0 = wid * 4;
  const int n16 = lane & 15, h = lane >> 4, bb = n16 & 7, pp = n16 >> 3;
  const unsigned char* Zin = lds + (o ? HY_ZT1 : HY_ZT0);
  const bf16_t* gate = p.Ut + (size_t)((o + 1) * 512 + c) * T + bb * L;
  uint2 xg[4][2];
#pragma unroll
  for (int i = 0; i < 4; ++i)
#pragma unroll
    for (int u = 0; u < 2; ++u) xg[i][u] = *(const uint2*)(gate + 32 * (2 * (g0 + i) + pp) + 16 * u + 4 * h);
  const float bias = p.hy_bias[o * 512 + c];
  hf32x4 acc[4][2];
#pragma unroll
  for (int i = 0; i < 4; ++i)
#pragma unroll
    for (int u = 0; u < 2; ++u) acc[i][u] = (hf32x4){0.f, 0.f, 0.f, 0.f};
  const int ai = lane & 15, ar = ai & 3, aq = ai >> 2;
  const unsigned char* laneA = lds + HY_FC + ar * (FCLEN * 2) + 2 * (HX0 - 4 * aq + 8 * h);
  const unsigned char* laneB = Zin + bb * ZSTRB + 64 + 64 * pp + 16 * h;
#define HY_LDA(dst, Dd) do { const uint2 _lo = *(const uint2*)(laneA - 32 * (Dd)); const uint2 _hi = *(const uint2*)(laneA - 32 * (Dd) + 8); \
    union { uint4 u4; hbf16x8 v; } _cv; _cv.u4 = make_uint4(_lo.x, _lo.y, _hi.x, _hi.y); dst = _cv.v; } while (0)
#define HY_LDB(dst, Qq) do { dst = *(const hbf16x8*)(laneB + 64 * (Qq)); } while (0)
#pragma unroll 1
  for (int pass = 0; pass < 2; ++pass) {
    const int Es = 2 * g0 - 63 + pass;
    hbf16x8 R[4];
    HY_LDB(R[1], 2 * (g0 + 1) - Es); HY_LDB(R[2], 2 * (g0 + 2) - Es); HY_LDB(R[3], 2 * (g0 + 3) - Es);
#pragma unroll 1
    for (int n4 = 0; n4 < 9; ++n4) {
#pragma unroll
      for (int j = 0; j < 4; ++j) {
        const int n = n4 * 4 + j;
        const int E = Es + 2 * n;
        HY_LDB(R[(4 - j) & 3], 2 * (g0 - n) - Es);
        hbf16x8 A0, A1;
        HY_LDA(A0, 2 * E); HY_LDA(A1, 2 * E + 1);
#pragma unroll
        for (int i = 0; i < 4; ++i) {
          const int Q = 2 * (g0 + i - n) - Es;
          if (Q >= -1 && Q <= 63) {
            acc[i][0] = __builtin_amdgcn_mfma_f32_16x16x32_bf16(A0, R[(i - j) & 3], acc[i][0], 0, 0, 0);
            acc[i][1] = __builtin_amdgcn_mfma_f32_16x16x32_bf16(A1, R[(i - j) & 3], acc[i][1], 0, 0, 0);
          }
        }
      }
    }
  }
#undef HY_LDA
#undef HY_LDB
#pragma unroll
  for (int i = 0; i < 4; ++i)
#pragma unroll
    for (int u = 0; u < 2; ++u) {
      const int t0 = 32 * (2 * (g0 + i) + pp) + 16 * u + 4 * h;
      const uint2 zv = *(const uint2*)(Zin + bb * ZSTRB + 64 + 2 * t0);
      const float z0 = __uint_as_float(zv.x << 16), z1 = __uint_as_float(zv.x & 0xffff0000u), z2 = __uint_as_float(zv.y << 16), z3 = __uint_as_float(zv.y & 0xffff0000u);
      const float x0 = __uint_as_float(xg[i][u].x << 16), x1 = __uint_as_float(xg[i][u].x & 0xffff0000u), x2 = __uint_as_float(xg[i][u].y << 16), x3 = __uint_as_float(xg[i][u].y & 0xffff0000u);
      const float r0 = x0 * (acc[i][u][0] + z0 * bias), r1 = x1 * (acc[i][u][1] + z1 * bias), r2 = x2 * (acc[i][u][2] + z2 * bias), r3 = x3 * (acc[i][u][3] + z3 * bias);
      uint2 w; w.x = cvt_pk_bf16(r0, r1); w.y = cvt_pk_bf16(r2, r3);
      if (o == 0) *(uint2*)(lds + HY_ZT1 + bb * ZSTRB + 64 + 2 * t0) = w;
      else *(uint2*)(p.Yt + (size_t)c * T + bb * L + t0) = w;
    }
}

__device__ void hyena_block(const Params& p, unsigned char* lds) {
  const int tid = threadIdx.x;
  uint4 fv0, fv1;
#define HY_FLOAD(o_, c_) do { const bf16_t* _g = p.FILTt + (size_t)((o_) * 512 + (c_)) * FLEN; \
    fv0 = *(const uint4*)(_g + tid * 8); fv1 = *(const uint4*)(_g + ((tid < 17) ? (512 + tid) : 0) * 8); } while (0)
  if ((int)blockIdx.x < 512) HY_FLOAD(0, blockIdx.x);
  for (int c = blockIdx.x; c < 512; c += gridDim.x) {
    if (tid < 144) {
      const int buf = tid / 72, rem = tid % 72, b = rem / 9, k = rem % 9;
      const int off = (k < 4) ? (k * 16) : (4160 + (k - 4) * 16);
      *(uint4*)(lds + (buf ? HY_ZT1 : HY_ZT0) + b * ZSTRB + off) = make_uint4(0u, 0u, 0u, 0u);
    }
    for (int e = tid; e < 2048; e += NTHR) {
      const int b = e >> 8, ch = e & 255;
      *(uint4*)(lds + HY_ZT0 + b * ZSTRB + 64 + ch * 16) = *(const uint4*)(p.Ut + (size_t)c * T + b * L + ch * 8);
    }
#pragma unroll 1
    for (int o = 0; o < 2; ++o) {
      *(uint4*)(lds + HY_FC + tid * 16) = fv0;
      if (tid < 18) *(uint4*)(lds + HY_FC + (512 + tid) * 16) = (tid < 17) ? fv1 : make_uint4(0u, 0u, 0u, 0u);
      __syncthreads();
      for (int g = tid; g < 3 * 530; g += NTHR) {
        const int r = 1 + g / 530, ch = g % 530;
        uint4 lo = make_uint4(0u, 0u, 0u, 0u);
        if (ch > 0) lo = *(const uint4*)(lds + HY_FC + (ch - 1) * 16);
        uint4 hi = *(const uint4*)(lds + HY_FC + ch * 16);
        unsigned W[8] = {lo.x, lo.y, lo.z, lo.w, hi.x, hi.y, hi.z, hi.w};
        uint4 ov;
        if (r == 1) {
          ov.x = __builtin_amdgcn_alignbyte(W[4], W[3], 2); ov.y = __builtin_amdgcn_alignbyte(W[5], W[4], 2);
          ov.z = __builtin_amdgcn_alignbyte(W[6], W[5], 2); ov.w = __builtin_amdgcn_alignbyte(W[7], W[6], 2);
        } else if (r == 2) {
          ov.x = W[3]; ov.y = W[4]; ov.z = W[5]; ov.w = W[6];
        } else {
          ov.x = __builtin_amdgcn_alignbyte(W[3], W[2], 2); ov.y = __builtin_amdgcn_alignbyte(W[4], W[3], 2);
          ov.z = __builtin_amdgcn_alignbyte(W[5], W[4], 2); ov.w = __builtin_amdgcn_alignbyte(W[6], W[5], 2);
        }
        *(uint4*)(lds + HY_FC + r * (FCLEN * 2) + ch * 16) = ov;
      }
      __syncthreads();
      {
        const int no = (o == 0) ? 1 : 0;
        const int nc = (o == 0) ? c : ((c + (int)gridDim.x < 512) ? (c + (int)gridDim.x) : c);
        HY_FLOAD(no, nc);
      }
      hy_order(p, o, c, lds);
      __syncthreads();
    }
  }
#undef HY_FLOAD
}

constexpr int SROW = 272;

__device__ __forceinline__ void ssd_stage_nat(const Params& p, int row0, int pxcol0, int cvcol0, unsigned char* dst) {
  for (int e = threadIdx.x; e < 2048; e += NTHR) {
    const int l = e >> 4, cg = e & 15;
    const int row = row0 + l, li = row & 63;
    const bf16_t* src = p.PXb + (size_t)row * DP + pxcol0 + cg * 8;
    const uint4 zero4 = make_uint4(0u, 0u, 0u, 0u);
    const uint4 cur = *(const uint4*)src;
    const uint4 prv = (li > 0) ? *(const uint4*)(src - DP) : zero4;
    const uint4 nxt = (li < 63) ? *(const uint4*)(src + DP) : zero4;
    const float* cw = p.ssd_conv_w + cvcol0 + cg * 8;
    const float* cb = p.ssd_conv_b + cvcol0 + cg * 8;
    const unsigned pc[4] = {prv.x, prv.y, prv.z, prv.w}, cc[4] = {cur.x, cur.y, cur.z, cur.w}, nc[4] = {nxt.x, nxt.y, nxt.z, nxt.w};
    float o[8];
#pragma unroll
    for (int k = 0; k < 4; ++k) {
      const float p0 = __uint_as_float(pc[k] << 16), p1 = __uint_as_float(pc[k] & 0xffff0000u);
      const float c0 = __uint_as_float(cc[k] << 16), c1 = __uint_as_float(cc[k] & 0xffff0000u);
      const float n0 = __uint_as_float(nc[k] << 16), n1 = __uint_as_float(nc[k] & 0xffff0000u);
      const float v0 = cb[2 * k] + cw[2 * k] * p0 + cw[DXBC + 2 * k] * c0 + cw[2 * DXBC + 2 * k] * n0;
      const float v1 = cb[2 * k + 1] + cw[2 * k + 1] * p1 + cw[DXBC + 2 * k + 1] * c1 + cw[2 * DXBC + 2 * k + 1] * n1;
      o[2 * k] = silu_f(v0); o[2 * k + 1] = silu_f(v1);
    }
    uint4 w; w.x = cvt_pk_bf16(o[0], o[1]); w.y = cvt_pk_bf16(o[2], o[3]); w.z = cvt_pk_bf16(o[4], o[5]); w.w = cvt_pk_bf16(o[6], o[7]);
    *(uint4*)(dst + l * SROW + cg * 16) = w;
  }
}

__device__ __forceinline__ void ssd_stage_tr(const Params& p, int row0, bool is_ctx, int pxcol0, int cvcol0, int ncols, unsigned char* dst) {
  const int ncg = ncols >> 2;
  for (int e = threadIdx.x; e < ncg * 16; e += NTHR) {
    const int cg = e % ncg, l8 = e / ncg;
    const int rowf = row0 + l8 * 8;
    bool has_prev, has_next;
    if (is_ctx) { const int tc = (rowf - T) & (LC - 1); has_prev = tc > 0; has_next = tc + 7 < LC - 1; }
    else { const int li = rowf & 63; has_prev = li > 0; has_next = li + 7 < 63; }
    const bf16_t* src = p.PXb + (size_t)rowf * DP + pxcol0 + cg * 4;
    const uint2 z2 = make_uint2(0u, 0u);
    uint2 raw[10];
    raw[0] = *(const uint2*)((cvcol0 >= 0 && has_prev) ? (src - DP) : src);
    if (!(cvcol0 >= 0 && has_prev)) raw[0] = z2;
#pragma unroll
    for (int k = 0; k < 8; ++k) raw[k + 1] = *(const uint2*)(src + (size_t)k * DP);
    raw[9] = *(const uint2*)((cvcol0 >= 0 && has_next) ? (src + (size_t)8 * DP) : src);
    if (!(cvcol0 >= 0 && has_next)) raw[9] = z2;
    unsigned outw[4][4];
    if (cvcol0 >= 0) {
      const float* cw = p.ssd_conv_w + cvcol0 + cg * 4; const float* cb = p.ssd_conv_b + cvcol0 + cg * 4;
      const float4 a0 = *(const float4*)cw, b0 = *(const float4*)(cw + DXBC), c0 = *(const float4*)(cw + 2 * DXBC), d0 = *(const float4*)cb;
      const float w0[4] = {a0.x, a0.y, a0.z, a0.w}, w1[4] = {b0.x, b0.y, b0.z, b0.w}, w2[4] = {c0.x, c0.y, c0.z, c0.w}, bb[4] = {d0.x, d0.y, d0.z, d0.w};
#pragma unroll
      for (int kp = 0; kp < 4; ++kp) {
#pragma unroll
        for (int c = 0; c < 4; ++c) {
          const unsigned q0 = (c >> 1) ? raw[2 * kp].y : raw[2 * kp].x, q1 = (c >> 1) ? raw[2 * kp + 1].y : raw[2 * kp + 1].x;
          const unsigned q2 = (c >> 1) ? raw[2 * kp + 2].y : raw[2 * kp + 2].x, q3 = (c >> 1) ? raw[2 * kp + 3].y : raw[2 * kp + 3].x;
          float x0, x1, x2, x3;
          if (c & 1) { x0 = __uint_as_float(q0 & 0xffff0000u); x1 = __uint_as_float(q1 & 0xffff0000u); x2 = __uint_as_float(q2 & 0xffff0000u); x3 = __uint_as_float(q3 & 0xffff0000u); }
          else { x0 = __uint_as_float(q0 << 16); x1 = __uint_as_float(q1 << 16); x2 = __uint_as_float(q2 << 16); x3 = __uint_as_float(q3 << 16); }
          const float oa = silu_f(bb[c] + w0[c] * x0 + w1[c] * x1 + w2[c] * x2);
          const float ob = silu_f(bb[c] + w0[c] * x1 + w1[c] * x2 + w2[c] * x3);
          outw[c][kp] = cvt_pk_bf16(oa, ob);
        }
      }
    } else {
#pragma unroll
      for (int kp = 0; kp < 4; ++kp) {
#pragma unroll
        for (int c = 0; c < 4; ++c) {
          const unsigned q1 = (c >> 1) ? raw[2 * kp + 1].y : raw[2 * kp + 1].x, q2 = (c >> 1) ? raw[2 * kp + 2].y : raw[2 * kp + 2].x;
          outw[c][kp] = (c & 1) ? ((q1 >> 16) | (q2 & 0xffff0000u)) : ((q1 & 0xffffu) | (q2 << 16));
        }
      }
    }
#pragma unroll
    for (int c = 0; c < 4; ++c)
      *(uint4*)(dst + (cg * 4 + c) * SROW + l8 * 16) = make_uint4(outw[c][0], outw[c][1], outw[c][2], outw[c][3]);
  }
}

__device__ __forceinline__ void ssd_stage_tr_s(const Params& p, int row0, bool is_ctx, int pxcol0, int cvcol0, int ncols, unsigned char* dst) {
  for (int e = threadIdx.x; e < ncols * 16; e += NTHR) {
    const int col = e & (ncols - 1), l8 = e / ncols;
    const int rowf = row0 + l8 * 8;
    bool has_prev, has_next;
    if (is_ctx) { const int tc = (rowf - T) & (LC - 1); has_prev = tc > 0; has_next = tc + 7 < LC - 1; }
    else { const int li = rowf & 63; has_prev = li > 0; has_next = li + 7 < 63; }
    const bf16_t* src = p.PXb + (size_t)rowf * DP + pxcol0 + col;
    float x[10];
    x[0] = (cvcol0 >= 0 && has_prev) ? bf2f(src[-DP]) : 0.f;
#pragma unroll
    for (int k = 0; k < 8; ++k) x[k + 1] = bf2f(src[(size_t)k * DP]);
    x[9] = (cvcol0 >= 0 && has_next) ? bf2f(src[(size_t)8 * DP]) : 0.f;
    float o[8];
    if (cvcol0 >= 0) {
      const float w0 = p.ssd_conv_w[cvcol0 + col], w1 = p.ssd_conv_w[DXBC + cvcol0 + col], w2 = p.ssd_conv_w[2 * DXBC + cvcol0 + col], bb = p.ssd_conv_b[cvcol0 + col];
#pragma unroll
      for (int k = 0; k < 8; ++k) o[k] = silu_f(bb + w0 * x[k] + w1 * x[k + 1] + w2 * x[k + 2]);
    } else {
#pragma unroll
      for (int k = 0; k < 8; ++k) o[k] = x[k + 1];
    }
    uint4 w; w.x = cvt_pk_bf16(o[0], o[1]); w.y = cvt_pk_bf16(o[2], o[3]); w.z = cvt_pk_bf16(o[4], o[5]); w.w = cvt_pk_bf16(o[6], o[7]);
    *(uint4*)(dst + col * SROW + l8 * 16) = w;
  }
}

__device__ void ssd_states_unit(const Params& p, int unit, unsigned char* lds) {
  const int tid = threadIdx.x, wid = __builtin_amdgcn_readfirstlane(tid >> 6), lane = tid & 63;
  const int g = unit & 1, bc = unit >> 1, cidx = bc % 18, b = bc / 18;
  const bool is_ctx = cidx < 2;
  const int row0 = is_ctx ? (T + b * LC + cidx * 128) : (b * L + (cidx - 2) * 128);
  unsigned char* XT = lds;
  unsigned char* BT = lds + 69632;
  unsigned char* XD = lds + 104448;
  float* WG = (float*)(lds + 121856);
  ssd_stage_tr(p, row0, is_ctx, COL_XBC + g * 256, g * 256, 256, XT);
  ssd_stage_tr(p, row0, is_ctx, COL_XBC + 512 + g * 128, 512 + g * 128, 128, BT);
  {
    const int dir = wid >> 2, hh = wid & 3, h = g * 4 + hh;
    const float A = expf(p.a_log[dir * 8 + h]);
    const int l0 = 2 * lane, l1 = l0 + 1;
    const float dt0 = softplus_f(p.DT[(size_t)(row0 + l0) * 16 + dir * 8 + h]), dt1 = softplus_f(p.DT[(size_t)(row0 + l1) * 16 + dir * 8 + h]);
    const float a0 = -A * dt0, a1 = -A * dt1, pair = a0 + a1;
    float incl = pair;
#pragma unroll
    for (int o = 1; o < 64; o <<= 1) { float t = __shfl_up(incl, o); if (lane >= o) incl += t; }
    const float excl = incl - pair;
    const float total = __shfl(incl, 63);
    float w0, w1, c0, c1;
    if (dir == 0) { c0 = excl + a0; c1 = excl + pair; w0 = dt0 * expf(total - c0); w1 = dt1 * expf(total - c1); }
    else { const float pe0 = excl, pe1 = excl + a0; w0 = dt0 * expf(pe0); w1 = dt1 * expf(pe1); c0 = total - pe0; c1 = total - pe1; }
    WG[wid * 128 + l0] = w0; WG[wid * 128 + l1] = w1;
    if (!is_ctx) { float* ac = p.ACUM + (size_t)(b * 16 + dir * 8 + h) * L + (cidx - 2) * 128; *(float2*)(ac + l0) = make_float2(c0, c1); }
    if (lane == 0) {
      const int k = dir ? (is_ctx ? (1 - cidx) : (19 - cidx)) : cidx;
      p.CDEC[(size_t)(((b * 2 + dir) * 8 + h) * 18 + k) * 32] = expf(total);
    }
  }
  __syncthreads();
  const int fr = lane & 15, fq = lane >> 4;
#pragma unroll 1
  for (int it = 0; it < 8; ++it) {
    const int dir = it >> 2, hh = it & 3, h = g * 4 + hh;
    for (int e = tid; e < 1024; e += NTHR) {
      const int pr = e >> 4, ch = e & 15;
      const uint4 v = *(const uint4*)(XT + (hh * 64 + pr) * SROW + ch * 16);
      const float4 wa = *(const float4*)(WG + it * 128 + ch * 8), wb = *(const float4*)(WG + it * 128 + ch * 8 + 4);
      uint4 w;
      w.x = cvt_pk_bf16(__uint_as_float(v.x << 16) * wa.x, __uint_as_float(v.x & 0xffff0000u) * wa.y);
      w.y = cvt_pk_bf16(__uint_as_float(v.y << 16) * wa.z, __uint_as_float(v.y & 0xffff0000u) * wa.w);
      w.z = cvt_pk_bf16(__uint_as_float(v.z << 16) * wb.x, __uint_as_float(v.z & 0xffff0000u) * wb.y);
      w.w = cvt_pk_bf16(__uint_as_float(v.w << 16) * wb.z, __uint_as_float(v.w & 0xffff0000u) * wb.w);
      *(uint4*)(XD + pr * SROW + ch * 16) = w;
    }
    __syncthreads();
    hf32x4 acc[4];
#pragma unroll
    for (int pt = 0; pt < 4; ++pt) acc[pt] = (hf32x4){0.f, 0.f, 0.f, 0.f};
#pragma unroll
    for (int kk = 0; kk < 4; ++kk) {
      const hbf16x8 Bf = *(const hbf16x8*)(BT + (16 * wid + fr) * SROW + 2 * (32 * kk + 8 * fq));
#pragma unroll
      for (int pt = 0; pt < 4; ++pt) {
        const hbf16x8 Af = *(const hbf16x8*)(XD + (16 * pt + fr) * SROW + 2 * (32 * kk + 8 * fq));
        acc[pt] = __builtin_amdgcn_mfma_f32_16x16x32_bf16(Bf, Af, acc[pt], 0, 0, 0);
      }
    }
    const int k = dir ? (is_ctx ? (1 - cidx) : (19 - cidx)) : cidx;
    bf16_t* slot = p.SST + ((size_t)(((b * 2 + dir) * 8 + h) * 18 + k)) * 8192;
#pragma unroll
    for (int pt = 0; pt < 4; ++pt)
      *(uint2*)(slot + (16 * pt + fr) * 128 + 16 * wid + 4 * fq) = make_uint2(cvt_pk_bf16(acc[pt][0], acc[pt][1]), cvt_pk_bf16(acc[pt][2], acc[pt][3]));
    __syncthreads();
  }
}

__device__ void ssd_scan_unit(const Params& p, int unit) {
  const int tid = threadIdx.x;
  const int half = unit & 1, seq = unit >> 1;
  const int pr = half * 32 + (tid >> 4), n8 = (tid & 15) * 8;
  const bf16_t* base = p.SST + (size_t)seq * 18 * 8192 + pr * 128 + n8;
  uint4 sv[18];
#pragma unroll
  for (int k = 0; k < 18; ++k) sv[k] = *(const uint4*)(base + (size_t)k * 8192);
  float hst[8];
#pragma unroll
  for (int j = 0; j < 8; ++j) hst[j] = 0.f;
#pragma unroll
  for (int k = 0; k < 18; ++k) {
    const float dec = p.CDEC[(size_t)(seq * 18 + k) * 32];
    if (k >= 2) {
      uint4 w; w.x = cvt_pk_bf16(hst[0], hst[1]); w.y = cvt_pk_bf16(hst[2], hst[3]); w.z = cvt_pk_bf16(hst[4], hst[5]); w.w = cvt_pk_bf16(hst[6], hst[7]);
      *(uint4*)(p.HIN + ((size_t)seq * 16 + (k - 2)) * 8192 + pr * 128 + n8) = w;
    }
    const unsigned sw[4] = {sv[k].x, sv[k].y, sv[k].z, sv[k].w};
#pragma unroll
    for (int u = 0; u < 4; ++u) {
      hst[2 * u] = dec * hst[2 * u] + __uint_as_float(sw[u] << 16);
      hst[2 * u + 1] = dec * hst[2 * u + 1] + __uint_as_float(sw[u] & 0xffff0000u);
    }
  }
}

__device__ void ssd_out_unit(const Params& p, int unit, unsigned char* lds) {
  const int tid = threadIdx.x, wid = __builtin_amdgcn_readfirstlane(tid >> 6), lane = tid & 63;
  const int fr = lane & 15, fq = lane >> 4;
  const int g = unit & 1, bc = unit >> 1, c = bc & 15, b = bc >> 4;
  const int row0 = b * L + c * 128;
  unsigned char* CS = lds;
  unsigned char* ML = lds + 34816;
  unsigned char* XT = lds + 69632;
  unsigned char* ZT = lds + 87040;
  unsigned char* HS = lds + 104448;
  float* CUM = (float*)(lds + 121856);
  float* DTL = (float*)(lds + 125952);
  ssd_stage_nat(p, row0, COL_XBC + 768 + g * 128, 768 + g * 128, CS);
  ssd_stage_nat(p, row0, COL_XBC + 512 + g * 128, 512 + g * 128, ML);
  for (int e = tid; e < 1024; e += NTHR) {
    const int it = e >> 7, l = e & 127, dir = it >> 2, hh = it & 3;
    CUM[e] = p.ACUM[(size_t)(b * 16 + dir * 8 + g * 4 + hh) * L + c * 128 + l];
    DTL[e] = softplus_f(p.DT[(size_t)(row0 + l) * 16 + dir * 8 + g * 4 + hh]);
  }
  __syncthreads();
  hf32x4 cbt[8];
#pragma unroll
  for (int lt = 0; lt < 8; ++lt) cbt[lt] = (hf32x4){0.f, 0.f, 0.f, 0.f};
#pragma unroll
  for (int kk = 0; kk < 4; ++kk) {
    const hbf16x8 Af = *(const hbf16x8*)(ML + (16 * wid + fr) * SROW + 2 * (32 * kk + 8 * fq));
#pragma unroll
    for (int lt = 0; lt < 8; ++lt) {
      const hbf16x8 Bf = *(const hbf16x8*)(CS + (16 * lt + fr) * SROW + 2 * (32 * kk + 8 * fq));
      cbt[lt] = __builtin_amdgcn_mfma_f32_16x16x32_bf16(Af, Bf, cbt[lt], 0, 0, 0);
    }
  }
  __syncthreads();
  hf32x4 y[4][4];
#pragma unroll
  for (int hh = 0; hh < 4; ++hh)
#pragma unroll
    for (int pt = 0; pt < 4; ++pt) y[hh][pt] = (hf32x4){0.f, 0.f, 0.f, 0.f};
  const int sb = 16 * wid + 4 * fq;
  uint4 hsa0, hsa1, hsb0, hsb1;
  {
    const bf16_t* slotA = p.HIN + ((size_t)(((b * 2 + 0) * 8 + g * 4) * 16 + c)) * 8192;
    const bf16_t* slotB = p.HIN + ((size_t)(((b * 2 + 1) * 8 + g * 4) * 16 + (15 - c))) * 8192;
    hsa0 = *(const uint4*)(slotA + (tid >> 4) * 128 + (tid & 15) * 8);
    hsa1 = *(const uint4*)(slotA + ((tid >> 4) + 32) * 128 + (tid & 15) * 8);
    hsb0 = *(const uint4*)(slotB + (tid >> 4) * 128 + (tid & 15) * 8);
    hsb1 = *(const uint4*)(slotB + ((tid >> 4) + 32) * 128 + (tid & 15) * 8);
  }
#pragma unroll 1
  for (int hh = 0; hh < 4; ++hh) {
    const int h = g * 4 + hh;
    hf32x4 yc[4];
#pragma unroll
    for (int pt = 0; pt < 4; ++pt) yc[pt] = (hf32x4){0.f, 0.f, 0.f, 0.f};
    ssd_stage_tr_s(p, row0, false, COL_XBC + g * 256 + hh * 64, g * 256 + hh * 64, 64, XT);
#pragma unroll 1
    for (int dir = 0; dir < 2; ++dir) {
      const int it = dir * 4 + hh;
      const int k = dir ? (17 - c) : (c + 2);
      (void)k;
      {
        const int nh = (hh < 3) ? (h + 1) : h;
        const int nk = dir ? (17 - c) : (c + 2);
        const bf16_t* nslot = p.HIN + ((size_t)(((b * 2 + dir) * 8 + nh) * 16 + (nk - 2))) * 8192;
        const uint4 c0 = dir ? hsb0 : hsa0, c1 = dir ? hsb1 : hsa1;
        *(uint4*)(HS + (tid >> 4) * SROW + (tid & 15) * 16) = c0;
        *(uint4*)(HS + ((tid >> 4) + 32) * SROW + (tid & 15) * 16) = c1;
        const uint4 t0 = *(const uint4*)(nslot + (tid >> 4) * 128 + (tid & 15) * 8);
        const uint4 t1 = *(const uint4*)(nslot + ((tid >> 4) + 32) * 128 + (tid & 15) * 8);
        if (dir == 0) { hsa0 = t0; hsa1 = t1; } else { hsb0 = t0; hsb1 = t1; }
      }
      {
        const float* cu = CUM + it * 128; const float* dl = DTL + it * 128;
        float cs[4], ds[4];
#pragma unroll
        for (int r = 0; r < 4; ++r) { cs[r] = cu[sb + r]; ds[r] = dl[sb + r]; }
#pragma unroll
        for (int lt = 0; lt < 8; ++lt) {
          const int l = 16 * lt + fr;
          const float cl = cu[l];
          float m[4];
#pragma unroll
          for (int r = 0; r < 4; ++r) {
            const int sidx = sb + r;
            const bool ok = dir ? (sidx >= l) : (sidx <= l);
            m[r] = ok ? cbt[lt][r] * __expf(cl - cs[r]) * ds[r] : 0.f;
          }
          uint2 w; w.x = cvt_pk_bf16(m[0], m[1]); w.y = cvt_pk_bf16(m[2], m[3]);
          *(uint2*)(ML + l * SROW + 2 * sb) = w;
        }
      }
      __syncthreads();
      {
        hf32x4 ad[4];
#pragma unroll
        for (int pt = 0; pt < 4; ++pt) ad[pt] = (hf32x4){0.f, 0.f, 0.f, 0.f};
#pragma unroll
        for (int kk = 0; kk < 4; ++kk) {
          const hbf16x8 Am = *(const hbf16x8*)(ML + (16 * wid + fr) * SROW + 2 * (32 * kk + 8 * fq));
#pragma unroll
          for (int pt = 0; pt < 4; ++pt) {
            const hbf16x8 Bx = *(const hbf16x8*)(XT + (16 * pt + fr) * SROW + 2 * (32 * kk + 8 * fq));
            ad[pt] = __builtin_amdgcn_mfma_f32_16x16x32_bf16(Am, Bx, ad[pt], 0, 0, 0);
          }
        }
#pragma unroll
        for (int pt = 0; pt < 4; ++pt) yc[pt] += ad[pt];
      }
      {
        hf32x4 ao[4];
#pragma unroll
        for (int pt = 0; pt < 4; ++pt) ao[pt] = (hf32x4){0.f, 0.f, 0.f, 0.f};
#pragma unroll
        for (int kk = 0; kk < 4; ++kk) {
          const hbf16x8 Ac = *(const hbf16x8*)(CS + (16 * wid + fr) * SROW + 2 * (32 * kk + 8 * fq));
#pragma unroll
          for (int pt = 0; pt < 4; ++pt) {
            const hbf16x8 Bh = *(const hbf16x8*)(HS + (16 * pt + fr) * SROW + 2 * (32 * kk + 8 * fq));
            ao[pt] = __builtin_amdgcn_mfma_f32_16x16x32_bf16(Ac, Bh, ao[pt], 0, 0, 0);
          }
        }
        const float* cu = CUM + it * 128;
        float ex[4];
#pragma unroll
        for (int r = 0; r < 4; ++r) ex[r] = __expf(cu[sb + r]);
#pragma unroll
        for (int pt = 0; pt < 4; ++pt)
#pragma unroll
          for (int r = 0; r < 4; ++r) yc[pt][r] += ex[r] * ao[pt][r];
      }
      __syncthreads();
    }
    {
      const float dsk = p.ssd_d[h];
#pragma unroll
      for (int pt = 0; pt < 4; ++pt) {
        const uint2 xv = *(const uint2*)(XT + (16 * pt + fr) * SROW + 2 * sb);
        const float xs4[4] = {__uint_as_float(xv.x << 16), __uint_as_float(xv.x & 0xffff0000u), __uint_as_float(xv.y << 16), __uint_as_float(xv.y & 0xffff0000u)};
#pragma unroll
        for (int r = 0; r < 4; ++r) yc[pt][r] += dsk * xs4[r];
      }
    }
    if (hh == 0) {
#pragma unroll
      for (int pt = 0; pt < 4; ++pt) y[0][pt] = yc[pt];
    } else if (hh == 1) {
#pragma unroll
      for (int pt = 0; pt < 4; ++pt) y[1][pt] = yc[pt];
    } else if (hh == 2) {
#pragma unroll
      for (int pt = 0; pt < 4; ++pt) y[2][pt] = yc[pt];
    } else {
#pragma unroll
      for (int pt = 0; pt < 4; ++pt) y[3][pt] = yc[pt];
    }
    __syncthreads();
  }
  {
    float* OT = (float*)lds;
#pragma unroll
    for (int hh = 0; hh < 4; ++hh)
#pragma unroll
      for (int pt = 0; pt < 4; ++pt) {
        const int chl = hh * 64 + 16 * pt + fr;
#pragma unroll
        for (int r = 0; r < 4; ++r) OT[(sb + r) * 256 + chl] = y[hh][pt][r];
      }
    __syncthreads();
    const int c8 = (tid & 31) * 8;
    const float4 ng0 = *(const float4*)(p.ssd_norm_g + g * 256 + c8), ng1 = *(const float4*)(p.ssd_norm_g + g * 256 + c8 + 4);
    const float ngv[8] = {ng0.x, ng0.y, ng0.z, ng0.w, ng1.x, ng1.y, ng1.z, ng1.w};
#pragma unroll 1
    for (int ih = 0; ih < 2; ++ih) {
    uint4 zv[4];
#pragma unroll
    for (int i4 = 0; i4 < 4; ++i4) {
      const int l = (tid >> 5) + 16 * (ih * 4 + i4);
      zv[i4] = *(const uint4*)(p.PXb + (size_t)(row0 + l) * DP + COL_Z + g * 256 + c8);
    }
#pragma unroll
    for (int i4 = 0; i4 < 4; ++i4) {
      const int l = (tid >> 5) + 16 * (ih * 4 + i4);
      const float4 a0 = *(const float4*)(OT + l * 256 + c8), a1 = *(const float4*)(OT + l * 256 + c8 + 4);
      const float yv[8] = {a0.x, a0.y, a0.z, a0.w, a1.x, a1.y, a1.z, a1.w};
      const unsigned zw[4] = {zv[i4].x, zv[i4].y, zv[i4].z, zv[i4].w};
      float gv[8];
      float ss = 0.f;
#pragma unroll
      for (int k = 0; k < 4; ++k) {
        gv[2 * k] = yv[2 * k] * silu_f(__uint_as_float(zw[k] << 16));
        gv[2 * k + 1] = yv[2 * k + 1] * silu_f(__uint_as_float(zw[k] & 0xffff0000u));
        ss += gv[2 * k] * gv[2 * k] + gv[2 * k + 1] * gv[2 * k + 1];
      }
      ss += __shfl_xor(ss, 1); ss += __shfl_xor(ss, 2); ss += __shfl_xor(ss, 4); ss += __shfl_xor(ss, 8); ss += __shfl_xor(ss, 16);
      const float rinv = rsqrtf(ss * (1.f / 256.f) + EPS);
      uint4 o;
      o.x = cvt_pk_bf16(gv[0] * rinv * ngv[0], gv[1] * rinv * ngv[1]);
      o.y = cvt_pk_bf16(gv[2] * rinv * ngv[2], gv[3] * rinv * ngv[3]);
      o.z = cvt_pk_bf16(gv[4] * rinv * ngv[4], gv[5] * rinv * ngv[5]);
      o.w = cvt_pk_bf16(gv[6] * rinv * ngv[6], gv[7] * rinv * ngv[7]);
      *(uint4*)(p.YMIXb + (size_t)(row0 + l) * D + 512 + g * 256 + c8) = o;
    }
    }
  }
}

__device__ void ph_router(const Params& p, unsigned char* lds) {
  const int tid = threadIdx.x, wid = __builtin_amdgcn_readfirstlane(tid >> 6), lane = tid & 63;
  const int fr = lane & 15, fq = lane >> 4;
  constexpr int AROW = 272;
  unsigned char* AH = lds;
  unsigned char* AL = lds + 64 * AROW;
  unsigned char* WH = lds + 128 * AROW;
  unsigned char* WL = lds + 224 * AROW;
  float* RS = (float*)(lds + 320 * AROW);
  float* LOG = RS + 64;
  float* GM = LOG + 6400;
  float* SH = GM + 1024;
  int* LC = (int*)(SH + 1024);
  int* LB = LC + 64;
  for (int tile = blockIdx.x; tile < T / 64; tile += gridDim.x) {
    const int row0 = tile * 64;
    const float* shp = p.MOD + (row0 / L) * 6144 + 3072;
    const float* scp = shp + 1024;
    if (tid < 64) {
      const float4* sp = (const float4*)(p.SSQP + (size_t)(row0 + tid) * 16);
      const float4 a0 = sp[0], a1 = sp[1], a2 = sp[2], a3 = sp[3];
      const float ss = ((a0.x + a0.y) + (a0.z + a0.w)) + ((a1.x + a1.y) + (a1.z + a1.w)) + ((a2.x + a2.y) + (a2.z + a2.w)) + ((a3.x + a3.y) + (a3.z + a3.w));
      RS[tid] = rsqrtf(ss * (1.f / D) + EPS);
    }
    for (int e = tid; e < 256; e += NTHR) {
      const float4 g = *(const float4*)(p.g2 + e * 4), s4 = *(const float4*)(scp + e * 4), h4 = *(const float4*)(shp + e * 4);
      *(float4*)(GM + e * 4) = make_float4(g.x * (1.f + s4.x), g.y * (1.f + s4.y), g.z * (1.f + s4.z), g.w * (1.f + s4.w));
      *(float4*)(SH + e * 4) = h4;
    }
    float4 xv[4];
#pragma unroll
    for (int i = 0; i < 4; ++i) { const int e = tid + i * NTHR; xv[i] = *(const float4*)(p.X1 + (size_t)(row0 + (e >> 5)) * D + (e & 31) * 4); }
    const int wj = tid >> 4, wch = tid & 15;
    uint4 wh0, wh1, wh2, wl0, wl1, wl2;
#define RT_LOADW(kn) do { \
      wh0 = *(const uint4*)(p.WRhi + (size_t)(wj) * 1024 + (kn) * 128 + wch * 8); wl0 = *(const uint4*)(p.WRlo + (size_t)(wj) * 1024 + (kn) * 128 + wch * 8); \
      wh1 = *(const uint4*)(p.WRhi + (size_t)(wj + 32) * 1024 + (kn) * 128 + wch * 8); wl1 = *(const uint4*)(p.WRlo + (size_t)(wj + 32) * 1024 + (kn) * 128 + wch * 8); \
      wh2 = *(const uint4*)(p.WRhi + (size_t)(wj + 64) * 1024 + (kn) * 128 + wch * 8); wl2 = *(const uint4*)(p.WRlo + (size_t)(wj + 64) * 1024 + (kn) * 128 + wch * 8); } while (0)
    RT_LOADW(0);
    __syncthreads();
    hf32x4 acc[3];
#pragma unroll
    for (int nt = 0; nt < 3; ++nt) acc[nt] = (hf32x4){0.f, 0.f, 0.f, 0.f};
    const int mt = wid & 3, nh = wid >> 2;
#pragma unroll 1
    for (int kc = 0; kc < 8; ++kc) {
#pragma unroll
      for (int i = 0; i < 4; ++i) {
        const int e = tid + i * NTHR; const int tok = e >> 5, k4 = (e & 31) * 4;
        const int kg = kc * 128 + k4;
        const float4 v = xv[i];
        const float4 g = *(const float4*)(GM + kg);
        const float4 h4 = *(const float4*)(SH + kg);
        const float rstd = RS[tok];
        const float h0 = v.x * rstd * g.x + h4.x, h1 = v.y * rstd * g.y + h4.y;
        const float h2 = v.z * rstd * g.z + h4.z, h3 = v.w * rstd * g.w + h4.w;
        const unsigned hi01 = cvt_pk_bf16(h0, h1), hi23 = cvt_pk_bf16(h2, h3);
        const unsigned lo01 = cvt_pk_bf16(h0 - __uint_as_float(hi01 << 16), h1 - __uint_as_float(hi01 & 0xffff0000u));
        const unsigned lo23 = cvt_pk_bf16(h2 - __uint_as_float(hi23 << 16), h3 - __uint_as_float(hi23 & 0xffff0000u));
        *(uint2*)(AH + tok * AROW + k4 * 2) = make_uint2(hi01, hi23);
        *(uint2*)(AL + tok * AROW + k4 * 2) = make_uint2(lo01, lo23);
        *(uint2*)(p.H2b + (size_t)(row0 + tok) * D + kg) = make_uint2(hi01, hi23);
      }
      *(uint4*)(WH + wj * AROW + wch * 16) = wh0; *(uint4*)(WL + wj * AROW + wch * 16) = wl0;
      *(uint4*)(WH + (wj + 32) * AROW + wch * 16) = wh1; *(uint4*)(WL + (wj + 32) * AROW + wch * 16) = wl1;
      *(uint4*)(WH + (wj + 64) * AROW + wch * 16) = wh2; *(uint4*)(WL + (wj + 64) * AROW + wch * 16) = wl2;
      {
        const int kn = (kc + 1 < 8) ? (kc + 1) : kc;
#pragma unroll
        for (int i = 0; i < 4; ++i) { const int e = tid + i * NTHR; xv[i] = *(const float4*)(p.X1 + (size_t)(row0 + (e >> 5)) * D + kn * 128 + (e & 31) * 4); }
        RT_LOADW(kn);
      }
      __syncthreads();
#pragma unroll
      for (int kk = 0; kk < 4; ++kk) {
        const hbf16x8 Ahi = *(const hbf16x8*)(AH + (16 * mt + fr) * AROW + 2 * (32 * kk + 8 * fq));
        const hbf16x8 Alo = *(const hbf16x8*)(AL + (16 * mt + fr) * AROW + 2 * (32 * kk + 8 * fq));
#pragma unroll
        for (int nt = 0; nt < 3; ++nt) {
          const int wo = (16 * (nh * 3 + nt) + fr) * AROW + 2 * (32 * kk + 8 * fq);
          const hbf16x8 Bhi = *(const hbf16x8*)(WH + wo);
          const hbf16x8 Blo = *(const hbf16x8*)(WL + wo);
          acc[nt] = __builtin_amdgcn_mfma_f32_16x16x32_bf16(Ahi, Bhi, acc[nt], 0, 0, 0);
          acc[nt] = __builtin_amdgcn_mfma_f32_16x16x32_bf16(Ahi, Blo, acc[nt], 0, 0, 0);
          acc[nt] = __builtin_amdgcn_mfma_f32_16x16x32_bf16(Alo, Bhi, acc[nt], 0, 0, 0);
        }
      }
      __syncthreads();
    }
    if (tid < 64) LC[tid] = 0;
#pragma unroll
    for (int nt = 0; nt < 3; ++nt)
#pragma unroll
      for (int r = 0; r < 4; ++r) LOG[(16 * mt + 4 * fq + r) * 100 + 16 * (nh * 3 + nt) + fr] = acc[nt][r];
    __syncthreads();
    int ea = 0, eb = 0, sa = 0, sb2 = 0;
    if (tid < 64) {
      const float* lg = LOG + tid * 100;
      const int row = row0 + tid;
      int gs = 0; float gm = lg[64] + p.b_group[0];
      float gl[8];
      gl[0] = gm;
#pragma unroll
      for (int j = 1; j < 8; ++j) { gl[j] = lg[64 + j] + p.b_group[j]; if (gl[j] > gm) { gm = gl[j]; gs = j; } }
      float den = 0.f;
#pragma unroll
      for (int j = 0; j < 8; ++j) den += expf(gl[j] - gm);
      const float pg = 1.f / den;
      float el[8];
#pragma unroll
      for (int j = 0; j < 8; ++j) el[j] = 0.f;
      for (int j = 0; j < 8; ++j) el[j] = lg[gs * 8 + j] + p.b_expert[gs * 8 + j];
      int i0 = 0; float l0 = el[0];
#pragma unroll
      for (int j = 1; j < 8; ++j) if (el[j] > l0) { l0 = el[j]; i0 = j; }
      int i1 = -1; float l1 = -3.0e38f;
#pragma unroll
      for (int j = 0; j < 8; ++j) if (j != i0 && el[j] > l1) { l1 = el[j]; i1 = j; }
      const float e1 = expf(l1 - l0);
      const float w0 = 1.f / (1.f + e1), w1 = e1 / (1.f + e1);
      p.GATE[row * 2 + 0] = w0 * pg;
      p.GATE[row * 2 + 1] = w1 * pg;
      ea = gs * 8 + i0; eb = gs * 8 + i1;
      sa = atomicAdd(&LC[ea], 1);
      sb2 = atomicAdd(&LC[eb], 1);
    }
    __syncthreads();
    if (tid < 64) { const int n = LC[tid]; LB[tid] = n ? atomicAdd(&p.CNT[tid * 32], n) : 0; }
    __syncthreads();
    if (tid < 64) {
      const int row = row0 + tid;
      p.LIST[ea * T + LB[ea] + sa] = row * 2 + 0;
      p.LIST[eb * T + LB[eb] + sb2] = row * 2 + 1;
    }
    __syncthreads();
  }
}

__device__ __forceinline__ void moe_table(const Params& p, int* tab) {
  if (threadIdx.x == 0) {
    int a = 0, sg = 0;
    for (int e = 0; e < NE; ++e) {
      int cn = p.CNT[e * 32];
      tab[e] = a; tab[65 + e] = sg; tab[130 + e] = cn;
      a += (cn + 255) >> 8; sg += ((cn + 127) >> 7) << 7;
    }
    tab[NE] = a; tab[65 + NE] = sg;
  }
  __syncthreads();
}

template <bool UP>
__device__ void moe_gemm_phase(const Params& p, unsigned char* lds, const int* tab) {
  constexpr int K = UP ? 1024 : 512;
  constexpr int NKT = K / 32;
  constexpr int LDB = UP ? 512 : 1024;
  const int tid = threadIdx.x, wid = __builtin_amdgcn_readfirstlane(tid >> 6), lane = tid & 63, fr = lane & 15, fq = lane >> 4;
  const int wm = wid >> 1, wn = wid & 1;
  constexpr int AOFF0 = 0, AOFF1 = 16384, BOFF0 = 32768, BOFF1 = 32768 + 256 * 80;
  const int total = tab[64] * 4;
  for (int ui = blockIdx.x; ui < total; ui += gridDim.x) {
    int e = 0;
    while (tab[e + 1] * 4 <= ui) ++e;
    const int local = ui - tab[e] * 4;
    const int mu = local >> 2, nt = local & 3;
    const int cnt = tab[130 + e], seg = tab[65 + e];
    const int rem = cnt - mu * 256;
    const bool full = rem > 128;
    const bool active = full || wm < 2;
    const int srow = tid >> 2, spc = tid & 3;
    unsigned aoffs[2];
#pragma unroll
    for (int i = 0; i < 2; ++i) {
      const int row = srow + 128 * i;
      int idx = mu * 256 + row;
      unsigned rowb;
      if (UP) { if (idx > cnt - 1) idx = cnt - 1; rowb = (unsigned)(p.LIST[e * T + idx] >> 1) * (unsigned)(K * 2); }
      else rowb = (unsigned)(seg + idx) * (unsigned)(K * 2);
      aoffs[i] = rowb + (unsigned)((spc ^ ((row >> 2) & 3)) * 16);
    }
    const char* Abase = UP ? (const char*)p.H2b : (const char*)p.HBb;
    const float* bsrc;
    if (UP) bsrc = ((lane < 32) ? p.w1 : p.w3) + (size_t)e * 1024 * 512 + nt * 128 + 4 * (lane & 31) + (size_t)(4 * wid) * LDB;
    else bsrc = p.w2 + (size_t)e * 512 * 1024 + nt * 256 + 4 * lane + (size_t)(4 * wid) * LDB;
    hf32x4 acc[4][8];
#pragma unroll
    for (int m = 0; m < 4; ++m)
#pragma unroll
      for (int j = 0; j < 8; ++j) acc[m][j] = (hf32x4){0.f, 0.f, 0.f, 0.f};
    uint4 P0a0, P0a1, P1a0, P1a1;
    float4 P0b0, P0b1, P0b2, P0b3, P1b0, P1b1, P1b2, P1b3;
#define MG_LOAD(kt, S) do { \
      S##a0 = *(const uint4*)(Abase + aoffs[0] + (kt) * 64); S##a1 = *(const uint4*)(Abase + aoffs[1] + (kt) * 64); \
      S##b0 = *(const float4*)(bsrc + (size_t)((kt) * 32 + 0) * LDB); S##b1 = *(const float4*)(bsrc + (size_t)((kt) * 32 + 1) * LDB); \
      S##b2 = *(const float4*)(bsrc + (size_t)((kt) * 32 + 2) * LDB); S##b3 = *(const float4*)(bsrc + (size_t)((kt) * 32 + 3) * LDB); } while (0)
#define MG_WRITE(aoff, boff, S) do { \
      *(uint4*)(lds + (aoff) + (srow) * 64 + spc * 16) = S##a0; \
      if (full) *(uint4*)(lds + (aoff) + (srow + 128) * 64 + spc * 16) = S##a1; \
      *(uint2*)(lds + (boff) + (4 * lane + 0) * 80 + 8 * wid) = make_uint2(cvt_pk_bf16(S##b0.x, S##b1.x), cvt_pk_bf16(S##b2.x, S##b3.x)); \
      *(uint2*)(lds + (boff) + (4 * lane + 1) * 80 + 8 * wid) = make_uint2(cvt_pk_bf16(S##b0.y, S##b1.y), cvt_pk_bf16(S##b2.y, S##b3.y)); \
      *(uint2*)(lds + (boff) + (4 * lane + 2) * 80 + 8 * wid) = make_uint2(cvt_pk_bf16(S##b0.z, S##b1.z), cvt_pk_bf16(S##b2.z, S##b3.z)); \
      *(uint2*)(lds + (boff) + (4 * lane + 3) * 80 + 8 * wid) = make_uint2(cvt_pk_bf16(S##b0.w, S##b1.w), cvt_pk_bf16(S##b2.w, S##b3.w)); } while (0)
#define MG_MMA(aoff, boff) do { if (active) { \
      hbf16x8 Af[4]; \
      _Pragma("unroll") for (int m = 0; m < 4; ++m) { const int row = 64 * wm + 16 * m + fr; \
        Af[m] = *(const hbf16x8*)(lds + (aoff) + row * 64 + ((fq ^ ((row >> 2) & 3)) * 16)); } \
      _Pragma("unroll") for (int jh = 0; jh < 2; ++jh) { \
        hbf16x8 Bf[4]; \
        _Pragma("unroll") for (int j4 = 0; j4 < 4; ++j4) { const int j = jh * 4 + j4; \
          const int nrow = UP ? ((j < 4) ? (64 * wn + 16 * j + fr) : (128 + 64 * wn + 16 * (j - 4) + fr)) : (128 * wn + 16 * j + fr); \
          Bf[j4] = *(const hbf16x8*)(lds + (boff) + nrow * 80 + 16 * fq); } \
        _Pragma("unroll") for (int m = 0; m < 4; ++m) _Pragma("unroll") for (int j4 = 0; j4 < 4; ++j4) \
          acc[m][jh * 4 + j4] = __builtin_amdgcn_mfma_f32_16x16x32_bf16(Bf[j4], Af[m], acc[m][jh * 4 + j4], 0, 0, 0); } } } while (0)
    MG_LOAD(0, P0);
    MG_LOAD(1, P1);
    MG_WRITE(AOFF0, BOFF0, P0);
    __syncthreads();
#pragma unroll 1
    for (int kt = 0; kt < NKT; kt += 2) {
      { const int kn = (kt + 2 < NKT) ? (kt + 2) : kt; MG_LOAD(kn, P0); }
      MG_MMA(AOFF0, BOFF0);
      MG_WRITE(AOFF1, BOFF1, P1);
      __syncthreads();
      { const int kn = (kt + 3 < NKT) ? (kt + 3) : (kt + 1); MG_LOAD(kn, P1); }
      MG_MMA(AOFF1, BOFF1);
      MG_WRITE(AOFF0, BOFF0, P0);
      __syncthreads();
    }
#undef MG_LOAD
#undef MG_WRITE
#undef MG_MMA
    if (active) {
#pragma unroll
      for (int m = 0; m < 4; ++m) {
        const int slot = mu * 256 + 64 * wm + 16 * m + fr;
        if (slot < cnt) {
          if (UP) {
            bf16_t* hp = p.HBb + (size_t)(seg + slot) * DE + nt * 128 + 64 * wn + 4 * fq;
#pragma unroll
            for (int j = 0; j < 4; ++j) {
              float h[4];
#pragma unroll
              for (int r = 0; r < 4; ++r) { const float av = acc[m][j][r]; h[r] = av / (1.f + __expf(-av)) * acc[m][j + 4][r]; }
              *(uint2*)(hp + 16 * j) = make_uint2(cvt_pk_bf16(h[0], h[1]), cvt_pk_bf16(h[2], h[3]));
            }
          } else {
            const int pair = p.LIST[e * T + slot];
            const float gt = p.GATE[pair];
            bf16_t* yp = p.YB2b + (size_t)pair * D + nt * 256 + 128 * wn + 4 * fq;
#pragma unroll
            for (int j = 0; j < 8; ++j)
              *(uint2*)(yp + 16 * j) = make_uint2(cvt_pk_bf16(gt * acc[m][j][0], gt * acc[m][j][1]), cvt_pk_bf16(gt * acc[m][j][2], gt * acc[m][j][3]));
          }
        }
      }
    }
  }
}

__device__ void ph_final(const Params& p) {
  const int tid = threadIdx.x, wid = tid >> 6, lane = tid & 63;
  for (int row = blockIdx.x * 8 + wid; row < T; row += gridDim.x * 8) {
    const float* ga2 = p.MOD + (row / L) * 6144 + 5120;
    float4 v[4];
    float ss = 0.f;
#pragma unroll
    for (int i = 0; i < 4; ++i) {
      const int col = i * 256 + lane * 4;
      float4 xv = *(const float4*)(p.X1 + (size_t)row * D + col);
      uint2 a = *(const uint2*)(p.YB2b + (size_t)(row * 2) * D + col);
      uint2 b = *(const uint2*)(p.YB2b + (size_t)(row * 2 + 1) * D + col);
      float4 ga = *(const float4*)(ga2 + col);
      v[i].x = xv.x + ga.x * (__uint_as_float(a.x << 16) + __uint_as_float(b.x << 16));
      v[i].y = xv.y + ga.y * (__uint_as_float(a.x & 0xffff0000u) + __uint_as_float(b.x & 0xffff0000u));
      v[i].z = xv.z + ga.z * (__uint_as_float(a.y << 16) + __uint_as_float(b.y << 16));
      v[i].w = xv.w + ga.w * (__uint_as_float(a.y & 0xffff0000u) + __uint_as_float(b.y & 0xffff0000u));
      ss += v[i].x * v[i].x + v[i].y * v[i].y + v[i].z * v[i].z + v[i].w * v[i].w;
    }
    ss = wave_sum(ss);
    const float rstd = rsqrtf(ss * (1.f / D) + EPS);
#pragma unroll
    for (int i = 0; i < 4; ++i) {
      const int col = i * 256 + lane * 4;
      float4 gf = *(const float4*)(p.g_final + col);
      float4 o;
      o.x = v[i].x * rstd * gf.x; o.y = v[i].y * rstd * gf.y; o.z = v[i].z * rstd * gf.z; o.w = v[i].w * rstd * gf.w;
      *(float4*)(p.out + (size_t)row * D + col) = o;
    }
  }
}

constexpr int NPHASE = 11;

__global__ void __launch_bounds__(NTHR, 2) mega(Params p) {
  extern __shared__ __attribute__((aligned(16))) unsigned char lds_raw[];
  float* sm = (float*)lds_raw;
  PG8_LAS unsigned char* lds = (PG8_LAS unsigned char*)lds_raw;
  const int lo = p.lo, hi = p.hi;
  volatile LAS unsigned* xbst = (volatile LAS unsigned*)(lds + pg8::STAGE_BYTES + 2048);
  if (threadIdx.x < 4) xbst[threadIdx.x] = 0u;
  __syncthreads();
  XcdBarrier xbar; xbar.bar = p.BAR; xbar.x = 0; xbar.st = xbst;
  if (hi - lo > 1) xbar = xcd_barrier_post(p.BAR, xbst);
#define IN(k) (lo <= (k) && (k) < hi)
#define SYNC(k) do { if (IN(k) && IN((k) + 1)) xcd_barrier(xbar); } while (0)
#ifndef DUPK
#define DUPK -1
#endif
#ifndef SKIP_OTHER
  if (IN(0)) { ph_adaln(p, sm); ph_filters(p, sm); ph_wcvt(p, sm); }
#if DUPK == 0
  xcd_barrier(xbar);
  if (IN(0)) { ph_adaln(p, sm); ph_filters(p, sm); ph_wcvt(p, sm); }
#endif
  SYNC(0);
  if (IN(1)) ph_norm1(p);
#if DUPK == 1
  xcd_barrier(xbar);
  if (IN(1)) ph_norm1(p);
#endif
  SYNC(1);
#endif
#ifndef SKIP_GEMM
  if (IN(2)) {
    pg8::DenseOrder S{p.XNb, p.WinT, TT / 256, DP / 256 + 1, D, (int)gridDim.x, (int)blockIdx.x};
    pg8::EpiBf16 E{p.PXb, DP, p.DT, p.dt_bias};
    pg8::gemm_phase<pg8::EpiBf16, pg8::DenseOrder>(lds, D, S, E);
  }
#if DUPK == 2
  xcd_barrier(xbar);
  if (IN(2)) {
    pg8::DenseOrder S{p.XNb, p.WinT, TT / 256, DP / 256 + 1, D, (int)gridDim.x, (int)blockIdx.x};
    pg8::EpiBf16 E{p.PXb, DP, p.DT, p.dt_bias};
    pg8::gemm_phase<pg8::EpiBf16, pg8::DenseOrder>(lds, D, S, E);
  }
#endif
  SYNC(2);
#endif
#ifndef SKIP_OTHER
  if (IN(3)) {
    ph_hy_convT(p, sm);
    for (int it = blockIdx.x; it < 288; it += gridDim.x) ssd_states_unit(p, it, lds_raw);
  }
#if DUPK == 3
  xcd_barrier(xbar);
  if (IN(3)) {
    ph_hy_convT(p, sm);
    for (int it = blockIdx.x; it < 288; it += gridDim.x) ssd_states_unit(p, it, lds_raw);
  }
#endif
  SYNC(3);
  if (IN(4)) {
    for (int it = blockIdx.x; it < 256; it += gridDim.x) ssd_scan_unit(p, it);
    hyena_block(p, lds_raw);
  }
#if DUPK == 4
  xcd_barrier(xbar);
  if (IN(4)) {
    for (int it = blockIdx.x; it < 256; it += gridDim.x) ssd_scan_unit(p, it);
    hyena_block(p, lds_raw);
  }
#endif
  SYNC(4);
  if (IN(5)) {
    for (int it = blockIdx.x; it < 256; it += gridDim.x) { ssd_out_unit(p, it, lds_raw); __syncthreads(); }
    ph_hy_backT(p, sm);
  }
#if DUPK == 5
  xcd_barrier(xbar);
  if (IN(5)) {
    for (int it = blockIdx.x; it < 256; it += gridDim.x) { ssd_out_unit(p, it, lds_raw); __syncthreads(); }
    ph_hy_backT(p, sm);
  }
#endif
  SYNC(5);
#endif
#ifndef SKIP_GEMM
  if (IN(6)) {
    pg8::DenseOrder S{p.YMIXb, p.WoutT, T / 256, D / 256, D, (int)gridDim.x, (int)blockIdx.x};
    pg8::EpiX1 E{p.x, p.MOD, p.X1, p.SSQP};
    pg8::gemm_phase<pg8::EpiX1, pg8::DenseOrder>(lds, D, S, E);
  }
#if DUPK == 6
  xcd_barrier(xbar);
  if (IN(6)) {
    pg8::DenseOrder S{p.YMIXb, p.WoutT, T / 256, D / 256, D, (int)gridDim.x, (int)blockIdx.x};
    pg8::EpiX1 E{p.x, p.MOD, p.X1, p.SSQP};
    pg8::gemm_phase<pg8::EpiX1, pg8::DenseOrder>(lds, D, S, E);
  }
#endif
  SYNC(6);
#endif
#ifndef SKIP_OTHER
  if (IN(7)) ph_router(p, lds_raw);
#if DUPK == 7
  xcd_barrier(xbar);
  if (IN(7)) ph_router(p, lds_raw);
#endif
  SYNC(7);
#endif
#ifndef SKIP_GEMM
  if (IN(8)) {
    int* tab = (int*)(lds_raw + pg8::STAGE_BYTES);
    moe_table(p, tab);
    moe_gemm_phase<true>(p, lds_raw, tab);
  }
#if DUPK == 8
  xcd_barrier(xbar);
  if (IN(8)) {
    int* tab = (int*)(lds_raw + pg8::STAGE_BYTES);
    moe_table(p, tab);
    moe_gemm_phase<true>(p, lds_raw, tab);
  }
#endif
  SYNC(8);
  if (IN(9)) {
    int* tab = (int*)(lds_raw + pg8::STAGE_BYTES);
    moe_table(p, tab);
    moe_gemm_phase<false>(p, lds_raw, tab);
  }
#if DUPK == 9
  xcd_barrier(xbar);
  if (IN(9)) {
    int* tab = (int*)(lds_raw + pg8::STAGE_BYTES);
    moe_table(p, tab);
    moe_gemm_phase<false>(p, lds_raw, tab);
  }
#endif
  SYNC(9);
#endif
#ifndef SKIP_OTHER
  if (IN(10)) ph_final(p);
#if DUPK == 10
  xcd_barrier(xbar);
  if (IN(10)) ph_final(p);
#endif
#endif
#undef IN
#undef SYNC
}

extern "C" void kernel_launch(void* const* d_in, const int* in_sizes, int n_in, void* d_out, int out_size,
                              void* d_ws, size_t ws_size, hipStream_t stream) {
  Params p{};
  const float* const* in = (const float* const*)d_in;
  p.x = in[0]; p.c = in[1]; p.ctx = in[2]; p.c_ctx = in[3]; p.w_ada = in[4]; p.b_ada = in[5];
  p.g1 = in[6]; p.g2 = in[7]; p.w_in = in[8]; p.hy_conv_w = in[9]; p.hy_conv_b = in[10];
  p.f_w1 = in[11]; p.f_b1 = in[12]; p.f_freq = in[13]; p.f_w2 = in[14]; p.f_b2 = in[15]; p.f_w3 = in[16];
  p.hy_bias = in[17]; p.ssd_conv_w = in[18]; p.ssd_conv_b = in[19]; p.a_log = in[20]; p.dt_bias = in[21];
  p.ssd_d = in[22]; p.ssd_norm_g = in[23]; p.w_out = in[24]; p.w_group = in[25]; p.b_group = in[26];
  p.w_expert = in[27]; p.b_expert = in[28]; p.w1 = in[29]; p.w3 = in[30]; p.w2 = in[31]; p.g_final = in[32];
  p.out = (float*)d_out;

  char* ws = (char*)d_ws;
  size_t off = 0;
  auto take = [&](size_t bytes) { char* r = ws + off; off += (bytes + 255) & ~(size_t)255; return r; };
  p.BAR = (unsigned*)take((size_t)XCD_BAR_WORDS * 4);
  p.MOD = (float*)take((size_t)9 * 6144 * 4);
  p.CNT = (int*)take(NE * 32 * 4);
  p.GATE = (float*)take((size_t)T * 2 * 4);
  p.LIST = (int*)take((size_t)NE * T * 4);
  p.DT = (float*)take((size_t)TT * 16 * 4);
  p.ACUM = (float*)take((size_t)T * 16 * 4);
  p.SSQP = (float*)take((size_t)T * 16 * 4);
  p.CDEC = (float*)take((size_t)128 * 18 * 32 * 4);
  p.FILTt = (bf16_t*)take((size_t)1024 * FLEN * 2);
  p.WRhi = (bf16_t*)take((size_t)96 * 1024 * 2);
  p.WRlo = (bf16_t*)take((size_t)96 * 1024 * 2);
  p.WinT = (bf16_t*)take((size_t)(DP + 256) * D * 2);
  p.WoutT = (bf16_t*)take((size_t)D * D * 2);
  char* rPX = take((size_t)TT * DP * 2);
  char* rXBC = take((size_t)128 * 18 * 8192 * 2);
  char* rYF = take((size_t)T * DS * 4);
  char* rZ1 = take((size_t)HYC * T * 2);
  char* rYB = take((size_t)T * DS * 4);
  char* rYM = take((size_t)T * D * 2);
  p.PXb = (bf16_t*)rPX; p.SST = (bf16_t*)rXBC; p.Ut = (bf16_t*)rZ1; p.YMIXb = (bf16_t*)rYM;
  p.HIN = (bf16_t*)rYF;
  p.Yt = (bf16_t*)rYB;
  p.XNb = (bf16_t*)rZ1;
  p.X1 = (float*)rPX;
  p.H2b = (bf16_t*)rYM;
  p.HBb = (bf16_t*)(rPX + (size_t)T * D * 4);
  p.YB2b = (bf16_t*)rZ1;
  if (off > ws_size) { fprintf(stderr, "workspace too small: need %zu have %zu\n", off, ws_size); return; }

  static int grid_blocks = 0;
  if (!grid_blocks) {
    int dev = 0, cus = 0, per_cu = 0;
    (void)hipGetDevice(&dev);
    (void)hipDeviceGetAttribute(&cus, hipDeviceAttributeMultiprocessorCount, dev);
    (void)hipFuncSetAttribute((const void*)mega, hipFuncAttributeMaxDynamicSharedMemorySize, LDS_BYTES);
    (void)hipOccupancyMaxActiveBlocksPerMultiprocessor(&per_cu, mega, NTHR, LDS_BYTES);
    if (per_cu < 1) { fprintf(stderr, "occupancy query returned %d\n", per_cu); per_cu = 1; }
    grid_blocks = cus;
  }
#ifndef ONE_LAUNCH
  for (int ph = 0; ph < NPHASE; ++ph) {
    p.lo = ph; p.hi = ph + 1;
    hipLaunchKernelGGL(mega, dim3(grid_blocks), dim3(NTHR), LDS_BYTES, stream, p);
  }
#else
  p.lo = 0; p.hi = NPHASE;
  (void)hipMemsetAsync(p.BAR, 0, (size_t)XCD_BAR_WORDS * 4, stream);
  void* args[] = {&p};
  hipError_t e = hipLaunchCooperativeKernel((void*)mega, dim3(grid_blocks), dim3(NTHR), args, LDS_BYTES, stream);
  if (e != hipSuccess) fprintf(stderr, "cooperative launch failed: %s (grid %d)\n", hipGetErrorString(e), grid_blocks);
#endif
}
```
